# Optimizing an MI355X kernel written in HIP

```python
import math
import jax, jax.numpy as jnp
from jax import lax
import numpy as np

D_MODEL = 1024
BATCH = 8
SEQ = 8192
DEPTH = 1
DEC_BATCH = 32
DEC_SEQ = 2048
PAST_LEN = 128

N_META = 16
ATTN_WIDTH = 512
HYENA_WIDTH = D_MODEL - ATTN_WIDTH
N_HEADS = 4
QK_NOPE = 128
QK_ROPE = 64
V_HEAD = ATTN_WIDTH // N_HEADS
Q_LORA = 256
KV_LORA = 128
ROPE_BASE = 10000.0
Q_BLOCK = 128
HYENA_ORDER = 2
SHORT_CONV = 3
FILTER_EMB = 33
FILTER_BANDS = (FILTER_EMB - 1) // 2
FILTER_HIDDEN = 64
N_FILTERS = HYENA_ORDER * 2 * HYENA_WIDTH
DECAY_TARGET = 1e-2
FAST_DECAY_PCT = 0.3
SLOW_DECAY_PCT = 1.5
D_FF = 4 * D_MODEL
NORM_EPS = 1e-6
IN_COLS = Q_LORA + KV_LORA + QK_ROPE + (HYENA_ORDER + 1) * HYENA_WIDTH

kernel_name = "hymba_mla_hyena_encoder"


def rms_norm(x, g):
    xf = x.astype(jnp.float32)
    y = xf * lax.rsqrt(jnp.mean(xf * xf, axis=-1, keepdims=True) + NORM_EPS)
    return (y * g.astype(jnp.float32)).astype(x.dtype)


def rope_tables(L):
    inv = 1.0 / (ROPE_BASE ** (jnp.arange(0, QK_ROPE, 2, dtype=jnp.float32) / QK_ROPE))
    ang = jnp.arange(L, dtype=jnp.float32)[:, None] * inv[None, :]
    ang = jnp.concatenate([ang, ang], axis=-1)
    return jnp.cos(ang), jnp.sin(ang)


def apply_rope(x, cos, sin):
    xf = x.astype(jnp.float32)
    x1, x2 = jnp.split(xf, 2, axis=-1)
    rot = jnp.concatenate([-x2, x1], axis=-1)
    return (xf * cos + rot * sin).astype(x.dtype)


def mla(c_q, c_kv, k_rope, q_norm_g, w_uq, kv_norm_g, w_ukv):
    B, L, _ = c_q.shape
    q = (rms_norm(c_q, q_norm_g) @ w_uq).reshape(B, L, N_HEADS, QK_NOPE + QK_ROPE)
    q_nope, q_rope = q[..., :QK_NOPE], q[..., QK_NOPE:]
    kv = (rms_norm(c_kv, kv_norm_g) @ w_ukv).reshape(B, L, N_HEADS, QK_NOPE + V_HEAD)
    k_nope, v = kv[..., :QK_NOPE], kv[..., QK_NOPE:]
    cos, sin = rope_tables(L)
    q_rope = apply_rope(q_rope, cos[None, :, None, :], sin[None, :, None, :])
    k_rope = apply_rope(k_rope, cos[None], sin[None])
    scale = (QK_NOPE + QK_ROPE) ** -0.5
    n_blk = -(-L // Q_BLOCK)
    pad = n_blk * Q_BLOCK - L

    def to_blocks(t):
        t = jnp.pad(t, ((0, 0), (0, pad), (0, 0), (0, 0)))
        return t.reshape(B, n_blk, Q_BLOCK, N_HEADS, t.shape[-1]).transpose(1, 0, 2, 3, 4)

    def attend(blk):
        qn, qr = blk
        s = (jnp.einsum('bqhd,bkhd->bhqk', qn, k_nope, preferred_element_type=jnp.float32)
             + jnp.einsum('bqhr,bkr->bhqk', qr, k_rope, preferred_element_type=jnp.float32))
        p = jax.nn.softmax(s * scale, axis=-1)
        return jnp.einsum('bhqk,bkhd->bqhd', p.astype(v.dtype), v)

    o = lax.map(attend, (to_blocks(q_nope), to_blocks(q_rope)))
    o = o.transpose(1, 0, 2, 3, 4).reshape(B, n_blk * Q_BLOCK, N_HEADS * V_HEAD)
    return o[:, :L]


def hyena_filters(L, f_w1, f_b1, f_freq, f_w2, f_b2, f_w3, f_decay):
    f32 = jnp.float32
    t = jnp.linspace(0.0, 1.0, L, dtype=f32)[:, None]
    w = 2.0 * math.pi * jnp.arange(L, dtype=f32)[:, None] / L
    f = jnp.linspace(1e-4, FILTER_BANDS - 1, FILTER_BANDS, dtype=f32)[None, :]
    feats = jnp.concatenate([t, jnp.cos(f * w), -jnp.sin(f * w)], axis=-1)
    freq = f_freq.astype(f32)
    h = jnp.sin(freq * (feats @ f_w1.astype(f32) + f_b1.astype(f32)))
    h = jnp.sin(freq * (h @ f_w2.astype(f32) + f_b2.astype(f32)))
    h = h @ f_w3.astype(f32)
    h = h * jnp.exp(-t * jnp.abs(f_decay.astype(f32)))
    h = h.reshape(L, HYENA_ORDER, 2, HYENA_WIDTH)
    h_fwd, h_bwd = h[:, :, 0], h[:, :, 1]
    zero = jnp.zeros_like(h_fwd[:1])
    k = jnp.concatenate([h_fwd, zero, h_bwd[1:][::-1]], axis=0)
    return jnp.fft.rfft(k, axis=0)


def hyena(u, conv_w, filt_fft, hy_bias):
    B, L, _ = u.shape
    C = HYENA_WIDTH
    up = jnp.pad(u, ((0, 0), (1, 1), (0, 0)))
    u = up[:, :-2] * conv_w[0] + up[:, 1:-1] * conv_w[1] + up[:, 2:] * conv_w[2]
    z = u[..., HYENA_ORDER * C:].astype(jnp.float32)
    for n in range(HYENA_ORDER):
        y = jnp.fft.irfft(jnp.fft.rfft(z, n=2 * L, axis=1) * filt_fft[None, :, n], n=2 * L, axis=1)[:, :L]
        z = u[..., n * C:(n + 1) * C].astype(jnp.float32) * (y + z * hy_bias[n].astype(jnp.float32))
    return z.astype(u.dtype)


def trunk(x, meta_tokens, pre_mix_g, w_in, q_norm_g, w_uq, kv_norm_g, w_ukv, conv_w,
          f_w1, f_b1, f_freq, f_w2, f_b2, f_w3, f_decay, hy_bias, attn_out_g, hy_out_g,
          w_o, post_mix_g, pre_mlp_g, w_ff1, w_ff2, post_mlp_g):
    B = x.shape[0]
    meta = jnp.broadcast_to(meta_tokens.astype(x.dtype)[None], (B, N_META, D_MODEL))
    h = jnp.concatenate([meta, x], axis=1)
    L = h.shape[1]
    s1 = Q_LORA
    s2 = Q_LORA + KV_LORA
    s3 = Q_LORA + KV_LORA + QK_ROPE
    for i in range(DEPTH):
        a = rms_norm(h, pre_mix_g[i])
        p = a @ w_in[i]
        c_q, c_kv, k_rope, u = p[..., :s1], p[..., s1:s2], p[..., s2:s3], p[..., s3:]
        o_attn = mla(c_q, c_kv, k_rope, q_norm_g[i], w_uq[i], kv_norm_g[i], w_ukv[i])
        filt = hyena_filters(L, f_w1[i], f_b1[i], f_freq[i], f_w2[i], f_b2[i], f_w3[i], f_decay[i])
        o_hy = hyena(u, conv_w[i], filt, hy_bias[i])
        mix = jnp.concatenate([rms_norm(o_attn, attn_out_g[i]), rms_norm(o_hy, hy_out_g[i])], axis=-1) @ w_o[i]
        h = h + rms_norm(mix, post_mix_g[i])
        m = rms_norm(h, pre_mlp_g[i]) @ w_ff1[i]
        m = jnp.square(jax.nn.relu(m)) @ w_ff2[i]
        h = h + rms_norm(m, post_mlp_g[i])
    return h[:, N_META:]


def setup_inputs(seed: int = 0) -> dict:
    key = jax.random.key(seed)
    ks = jax.random.split(key, 32)
    f32 = jnp.float32

    def nrm(k, shape, scale):
        return jax.random.normal(k, shape, f32) * scale

    def gain(k, shape):
        return 1.0 + 0.02 * jax.random.normal(k, shape, f32)

    min_decay = math.log(DECAY_TARGET) / SLOW_DECAY_PCT
    max_decay = math.log(DECAY_TARGET) / FAST_DECAY_PCT
    base = jnp.tile(jnp.abs(jnp.linspace(min_decay, max_decay, HYENA_WIDTH, dtype=f32)), HYENA_ORDER * 2)
    f_decay = base[None, :] * (1.0 + 0.05 * jax.random.normal(ks[15], (DEPTH, N_FILTERS), f32))
    return {
        "x_prompt": nrm(ks[0], (BATCH, SEQ, D_MODEL), 1.0),
        "x_sample": nrm(ks[1], (DEC_BATCH, DEC_SEQ, D_MODEL), 1.0),
        "meta_tokens": nrm(ks[2], (N_META, D_MODEL), 1.0),
        "pre_mix_g": gain(ks[3], (DEPTH, D_MODEL)),
        "w_in": nrm(ks[4], (DEPTH, D_MODEL, IN_COLS), D_MODEL ** -0.5),
        "q_norm_g": gain(ks[5], (DEPTH, Q_LORA)),
        "w_uq": nrm(ks[6], (DEPTH, Q_LORA, N_HEADS * (QK_NOPE + QK_ROPE)), Q_LORA ** -0.5),
        "kv_norm_g": gain(ks[7], (DEPTH, KV_LORA)),
        "w_ukv": nrm(ks[8], (DEPTH, KV_LORA, N_HEADS * (QK_NOPE + V_HEAD)), KV_LORA ** -0.5),
        "conv_w": nrm(ks[9], (DEPTH, SHORT_CONV, (HYENA_ORDER + 1) * HYENA_WIDTH), SHORT_CONV ** -0.5),
        "f_w1": nrm(ks[10], (DEPTH, FILTER_EMB, FILTER_HIDDEN), FILTER_EMB ** -0.5),
        "f_b1": nrm(ks[11], (DEPTH, FILTER_HIDDEN), 0.02),
        "f_freq": gain(ks[12], (DEPTH, FILTER_HIDDEN)),
        "f_w2": nrm(ks[13], (DEPTH, FILTER_HIDDEN, FILTER_HIDDEN), FILTER_HIDDEN ** -0.5),
        "f_b2": nrm(ks[14], (DEPTH, FILTER_HIDDEN), 0.02),
        "f_w3": nrm(ks[16], (DEPTH, FILTER_HIDDEN, N_FILTERS), FILTER_HIDDEN ** -0.5),
        "f_decay": f_decay,
        "hy_bias": nrm(ks[17], (DEPTH, HYENA_ORDER, HYENA_WIDTH), 1.0),
        "attn_out_g": gain(ks[18], (DEPTH, ATTN_WIDTH)),
        "hy_out_g": gain(ks[19], (DEPTH, HYENA_WIDTH)),
        "w_o": nrm(ks[20], (DEPTH, D_MODEL, D_MODEL), D_MODEL ** -0.5),
        "post_mix_g": gain(ks[21], (DEPTH, D_MODEL)),
        "pre_mlp_g": gain(ks[22], (DEPTH, D_MODEL)),
        "w_ff1": nrm(ks[23], (DEPTH, D_MODEL, D_FF), D_MODEL ** -0.5),
        "w_ff2": nrm(ks[24], (DEPTH, D_FF, D_MODEL), D_FF ** -0.5),
        "post_mlp_g": gain(ks[25], (DEPTH, D_MODEL)),
    }


def reference(x_prompt, x_sample, meta_tokens, pre_mix_g, w_in, q_norm_g, w_uq, kv_norm_g, w_ukv,
              conv_w, f_w1, f_b1, f_freq, f_w2, f_b2, f_w3, f_decay, hy_bias, attn_out_g, hy_out_g,
              w_o, post_mix_g, pre_mlp_g, w_ff1, w_ff2, post_mlp_g):
    y_prompt = trunk(x_prompt, meta_tokens, pre_mix_g, w_in, q_norm_g, w_uq, kv_norm_g, w_ukv, conv_w,
                     f_w1, f_b1, f_freq, f_w2, f_b2, f_w3, f_decay, hy_bias, attn_out_g, hy_out_g,
                     w_o, post_mix_g, pre_mlp_g, w_ff1, w_ff2, post_mlp_g)
    y_sample = trunk(x_sample, meta_tokens, pre_mix_g, w_in, q_norm_g, w_uq, kv_norm_g, w_ukv, conv_w,
                     f_w1, f_b1, f_freq, f_w2, f_b2, f_w3, f_decay, hy_bias, attn_out_g, hy_out_g,
                     w_o, post_mix_g, pre_mlp_g, w_ff1, w_ff2, post_mlp_g)
    return (y_prompt, y_sample)
```

```cpp
#include <hip/hip_runtime.h>
#include <hip/hip_cooperative_groups.h>
#include <cstdio>
#include <cstdint>
namespace cg = cooperative_groups;
#ifndef DBG_SEL0
#define DBG_SEL0 3
#endif
#ifndef DBG_SEL1
#define DBG_SEL1 0
#endif
#ifndef DEBUG_CHECK
#define DEBUG_CHECK 0
#endif
#ifndef EXPT
#define EXPT 0
#endif
#ifndef SUB_MASK
#define SUB_MASK 15
#endif
#ifndef SUB2
#define SUB2 7
#endif

#define LAS __attribute__((address_space(3)))
typedef unsigned short bf16_t;
typedef short bf16x8 __attribute__((ext_vector_type(8)));
typedef float f32x4 __attribute__((ext_vector_type(4)));
typedef float f32x16 __attribute__((ext_vector_type(16)));
typedef unsigned u32x4 __attribute__((ext_vector_type(4)));
typedef unsigned u32x2 __attribute__((ext_vector_type(2)));

constexpr int DM = 1024, LP = 8208, LS = 2064, NBP = 8, NBS = 32;
constexpr int TPR = NBP * LP;
constexpr int TSR = NBS * LS;
constexpr int T = TPR + TSR;
constexpr int TPAD = 131840;
constexpr int TN = 131072;
constexpr int NPP = 2048;
constexpr int LGP = 8256, LGS = 2112;
constexpr float EPS = 1e-6f;
constexpr float QSCALE = 0.07216878364870322f * 1.4426950408889634f;

constexpr size_t MiB = 1ull << 20;
constexpr size_t OFF_H0B = 0;
constexpr size_t XT_SET1 = (size_t)512 * NBP * LGP;
constexpr size_t OFF_X1T = 0;
constexpr size_t OFF_X2T = 131 * MiB;
constexpr size_t OFF_P = 262 * MiB;
constexpr size_t OFF_V0T = 778 * MiB;
constexpr size_t OFF_MIXN = 262 * MiB;
constexpr size_t OFF_MIX = 518 * MiB;
constexpr size_t OFF_H1B = 0;
constexpr size_t OFF_M = 256 * MiB;
constexpr size_t OFF_M2 = 768 * MiB;
constexpr size_t OFF_SQMIXP = 896 * MiB;
constexpr size_t OFF_SQM2P = 904 * MiB;
constexpr size_t OFF_SMALL = 912 * MiB;
constexpr size_t OFF_WIN = OFF_SMALL;
constexpr size_t OFF_WUQ = OFF_SMALL + 4 * MiB;
constexpr size_t OFF_WKN = OFF_SMALL + 4 * MiB + 512 * 1024;
constexpr size_t OFF_WV = OFF_SMALL + 4 * MiB + 768 * 1024;
constexpr size_t OFF_WO = OFF_SMALL + 5 * MiB;
constexpr size_t OFF_WF1 = OFF_SMALL + 7 * MiB;
constexpr size_t OFF_WF2 = OFF_SMALL + 15 * MiB;
constexpr size_t OFF_GR0 = OFF_SMALL + 23 * MiB;
constexpr size_t OFF_GR1 = OFF_SMALL + 56 * MiB;
constexpr size_t OFF_RT = OFF_SMALL + 65 * MiB;
constexpr size_t OFF_R0 = OFF_SMALL + 68 * MiB;
constexpr size_t OFF_R1 = OFF_SMALL + 69 * MiB;
constexpr size_t OFF_RQ = OFF_SMALL + 70 * MiB;
constexpr size_t OFF_RKV = OFF_SMALL + 71 * MiB;
constexpr size_t OFF_SQQP = OFF_SMALL + 72 * MiB;
constexpr size_t OFF_SQKVP = OFF_SMALL + 75 * MiB;
constexpr size_t OFF_DBGW = OFF_SMALL + 78 * MiB;
constexpr size_t DO_Q = 0;
constexpr size_t DO_KN = 194 * MiB;
constexpr size_t DO_KR = 323 * MiB;
constexpr size_t DO_VT = 340 * MiB;

constexpr size_t OFF_ODBG = 518 * MiB;
constexpr size_t OFF_HDBG = 647 * MiB;
constexpr int LDS_BYTES = 131072;

struct Params {
    const float* in[26];
    float* out;
    unsigned char* ws;
};

__device__ __forceinline__ f32x4 ld_sys(const float* q) { f32x4 v; asm volatile("global_load_dwordx4 %0, %1, off sc0 sc1\n\ts_waitcnt vmcnt(0)" : "=v"(v) : "v"(q) : "memory"); return v; }
__device__ __forceinline__ float ldco(const float* q) { return __builtin_bit_cast(float, __hip_atomic_load((const unsigned*)q, __ATOMIC_RELAXED, __HIP_MEMORY_SCOPE_AGENT)); }
__device__ __forceinline__ float2 ldco2(const float2* q) { const unsigned long long w = __hip_atomic_load((const unsigned long long*)q, __ATOMIC_RELAXED, __HIP_MEMORY_SCOPE_AGENT); return make_float2(__builtin_bit_cast(float, (unsigned)w), __builtin_bit_cast(float, (unsigned)(w >> 32))); }
template <class Tp> __device__ __forceinline__ Tp* launder(Tp* q) { asm volatile("" : "+s"(q)); return q; }
__device__ __forceinline__ int tid_l() { int t = threadIdx.x; asm volatile("" : "+v"(t)); return t; }
__device__ __forceinline__ unsigned cvt_pk_bf16(float lo, float hi) { unsigned r; asm volatile("v_cvt_pk_bf16_f32 %0, %1, %2" : "=v"(r) : "v"(lo), "v"(hi)); return r; }
__device__ __forceinline__ float bf2f(unsigned short b) { return __builtin_bit_cast(float, (unsigned)b << 16); }
__device__ __forceinline__ float bflo(unsigned w) { return __builtin_bit_cast(float, w << 16); }
__device__ __forceinline__ float bfhi(unsigned w) { return __builtin_bit_cast(float, w & 0xffff0000u); }
__device__ __forceinline__ float wave_sum(float v) {
#pragma unroll
    for (int o = 1; o < 64; o <<= 1) v += __shfl_xor(v, o);
    return v;
}
__device__ __forceinline__ void sincos_red(float x, float& s, float& c) {
    const double xd = (double)x; const double k = rint(xd * 0.15915494309189535); const float r = (float)(xd - k * 6.283185307179586);
    s = __sinf(r); c = __cosf(r);
}
__device__ __forceinline__ float sin_red(float x) { float s, c; sincos_red(x, s, c); return s; }
__device__ __forceinline__ void row_info(int r, int& pos, int& seq) {
    if (r < TPR) { seq = r / LP; pos = r - seq * LP; }
    else { int q = r - TPR; if (q >= TSR) q = TSR - 1; const int b = q / LS; pos = q - b * LS; seq = NBP + b; }
}
__device__ __forceinline__ int full_row(int n) {
    if (n < 65536) { const int b = n >> 13; return b * LP + 16 + (n & 8191); }
    const int q = n - 65536; const int b = q >> 11; return TPR + b * LS + 16 + (q & 2047);
}

namespace pg8 {
constexpr int BM = 256, BK = 64, HALF = 128, HTB = HALF * BK * 2, STAGE_BYTES = 8 * HTB, NXCD = 8, WGM = 8;
__host__ __device__ __forceinline__ int lds_byte(int r, int c) { const int st = (r >> 4) * 2 + (c >> 5), rr = r & 15, cc = c & 31, ob = rr * 64 + cc * 2; return st * 1024 + (ob ^ (((ob >> 9) & 1) << 5)); }
__host__ __device__ __forceinline__ void stage_rc(int b, int& R, int& C) { const int st = b / 1024, sb = b % 1024, swz = sb ^ (((sb >> 9) & 1) << 5); R = (st >> 1) * 16 + swz / 64; C = (st & 1) * 32 + (swz % 64) / 2; }
__host__ __device__ __forceinline__ int perm32(int rho) { const int n = rho >> 4, i = rho & 15; return 8 * (i >> 2) + 4 * n + (i & 3); }
struct Unit { int pm, pn; };
struct Gemm { const bf16_t* A; const bf16_t* Bt; int M, N, K, lda, ldb; };
struct StaticOrder {
    int nM, nN, nwg, G, c;
    __device__ void init(int M, int N, int G_, int c_) { nM = M / BM; nN = N / BM; nwg = nM * nN; G = G_; c = c_; }
    __device__ bool next(int i, Unit& u) const {
        const long L = (long)i * G + c; if (L >= nwg) return false;
        int wgid = (int)L; { const int q = nwg / NXCD, r = nwg % NXCD, xcd = wgid % NXCD, off = wgid / NXCD; wgid = (xcd < r ? xcd * (q + 1) : r * (q + 1) + (xcd - r) * q) + off; }
        const int nig = WGM * nN, gid = wgid / nig, fm = gid * WGM, gsz = (nM - fm) < WGM ? (nM - fm) : WGM;
        u.pm = fm + ((wgid % nig) % gsz); u.pn = (wgid % nig) / gsz; return true;
    }
};
template <class Epi>
__device__ __forceinline__ void gemm_phase(LAS unsigned char* lds, const Gemm g, const StaticOrder& S, const Epi& E) {
    const int tid = tid_l(), wid = __builtin_amdgcn_readfirstlane(tid >> 6), lane = tid & 63, wr = wid >> 2, wc = wid & 3, fr = lane & 15, fq = lane >> 4;
    const int K = g.K, nt = K / BK;
    unsigned voffA[2], voffB[2];
#pragma unroll
    for (int i = 0; i < 2; ++i) { int R, C; stage_rc(tid * 16 + i * 8192, R, C); const int Rb = (R & ~31) + perm32(R & 31);
        voffA[i] = (unsigned)(R * g.lda + C) * 2u; voffB[i] = (unsigned)(Rb * g.ldb + C) * 2u; }
    const size_t kstep = (size_t)(BK * 2);
    const size_t hstepA = (size_t)HALF * g.lda * 2, hstepB = (size_t)HALF * g.ldb * 2;
    const size_t tstepA = 2 * hstepA, tstepB = 2 * hstepB;
    const unsigned ldsw = (unsigned)wid * 1024u;
    const int aoff = lds_byte(wr * 64 + fr, fq * 8), boff = lds_byte(wc * 32 + fr, fq * 8);
#define PG8_SA(b, h) (((b) * 2 + (h)) * HTB)
#define PG8_SB(b, h) ((4 + (b) * 2 + (h)) * HTB)
#define PG8_STAGE(bufoff, gbase, voff) do { _Pragma("unroll") for (int _i = 0; _i < 2; ++_i) \
        __builtin_amdgcn_global_load_lds((const unsigned*)((const char*)(gbase) + (voff)[_i]), (LAS unsigned*)(lds + (bufoff) + ldsw + _i * 8192), 16, 0, 0); } while (0)
#define PG8_LDA(dst, b, h) do { _Pragma("unroll") for (int m = 0; m < 4; ++m) _Pragma("unroll") for (int k = 0; k < 2; ++k) dst[m][k] = *(const LAS bf16x8*)(lds + PG8_SA(b, h) + aoff + m * 2048 + k * 1024); } while (0)
#define PG8_LDB(dst, b, h) do { _Pragma("unroll") for (int n = 0; n < 2; ++n) _Pragma("unroll") for (int k = 0; k < 2; ++k) dst[n][k] = *(const LAS bf16x8*)(lds + PG8_SB(b, h) + boff + n * 2048 + k * 1024); } while (0)
#define PG8_MMA(ai, bj, At, Bt) do { __builtin_amdgcn_s_setprio(1); _Pragma("unroll") for (int m = 0; m < 4; ++m) _Pragma("unroll") for (int n = 0; n < 2; ++n) _Pragma("unroll") for (int k = 0; k < 2; ++k) \
        acc[ai][bj][m][n] = __builtin_amdgcn_mfma_f32_16x16x32_bf16(Bt[n][k], At[m][k], acc[ai][bj][m][n], 0, 0, 0); __builtin_amdgcn_s_setprio(0); } while (0)
#define PG8_WAIT_V(n) asm volatile("s_waitcnt vmcnt(" #n ")" ::: "memory")
#define PG8_WAIT_L(n) asm volatile("s_waitcnt lgkmcnt(" #n ")" ::: "memory")
#define PG8_BAR __builtin_amdgcn_s_barrier()
#define PG8_SCHED __builtin_amdgcn_sched_barrier(0)
    Unit cur, nxt; int ui = 0;
    if (!S.next(0, cur)) return;
    f32x4 acc[2][2][4][2];
#pragma unroll
    for (int a = 0; a < 2; ++a)
#pragma unroll
        for (int b = 0; b < 2; ++b)
#pragma unroll
            for (int m = 0; m < 4; ++m)
#pragma unroll
                for (int n = 0; n < 2; ++n) acc[a][b][m][n] = (f32x4){0.f, 0.f, 0.f, 0.f};
    bf16x8 At[4][2], B0[2][2], B1[2][2];
    const char* cA = (const char*)g.A + (size_t)cur.pm * tstepA; const char* cB = (const char*)g.Bt + (size_t)cur.pn * tstepB;
    PG8_STAGE(PG8_SB(0, 0), cB, voffB); PG8_STAGE(PG8_SB(0, 1), cB + hstepB, voffB); PG8_STAGE(PG8_SA(0, 0), cA, voffA); PG8_STAGE(PG8_SA(0, 1), cA + hstepA, voffA);
    if (wr == 1) PG8_BAR;
    PG8_WAIT_V(2); PG8_BAR;
    PG8_STAGE(PG8_SB(1, 0), cB + kstep, voffB); PG8_STAGE(PG8_SA(1, 0), cA + kstep, voffA); PG8_STAGE(PG8_SB(1, 1), cB + hstepB + kstep, voffB);
    PG8_WAIT_V(6); PG8_BAR;
    for (;;) {
        const bool has_next = S.next(ui + 1, nxt);
        const char* nA = has_next ? (const char*)g.A + (size_t)nxt.pm * tstepA : cA; const char* nB = has_next ? (const char*)g.Bt + (size_t)nxt.pn * tstepB : cB;
        for (int t = 0; t < nt; t += 2) {
            const bool last = (t == nt - 2);
            const char* a1 = cA + (size_t)(t + 1) * kstep;
            const char* a2 = last ? nA : cA + (size_t)(t + 2) * kstep; const char* b2 = last ? nB : cB + (size_t)(t + 2) * kstep;
            const char* a3 = a2 + kstep; const char* b3 = b2 + kstep;
            PG8_LDB(B0, 0, 0); PG8_LDB(B1, 0, 1); PG8_SCHED; PG8_LDA(At, 0, 0); PG8_STAGE(PG8_SA(1, 1), a1 + hstepA, voffA);
            PG8_WAIT_V(8); PG8_WAIT_L(0); PG8_BAR; PG8_MMA(0, 0, At, B0); PG8_MMA(0, 1, At, B1); PG8_BAR; PG8_SCHED;
            PG8_LDA(At, 0, 1); PG8_STAGE(PG8_SB(0, 0), b2, voffB); PG8_STAGE(PG8_SB(0, 1), b2 + hstepB, voffB); PG8_STAGE(PG8_SA(0, 0), a2, voffA);
            PG8_WAIT_V(8); PG8_WAIT_L(0); PG8_BAR; PG8_MMA(1, 0, At, B0); PG8_MMA(1, 1, At, B1); PG8_BAR; PG8_SCHED;
            PG8_LDB(B0, 1, 0); PG8_LDB(B1, 1, 1); PG8_SCHED; PG8_LDA(At, 1, 0); PG8_STAGE(PG8_SA(0, 1), a2 + hstepA, voffA);
            PG8_WAIT_V(8); PG8_WAIT_L(0); PG8_BAR; PG8_MMA(0, 0, At, B0); PG8_MMA(0, 1, At, B1); PG8_BAR; PG8_SCHED;
            PG8_LDA(At, 1, 1); PG8_STAGE(PG8_SB(1, 0), b3, voffB); PG8_STAGE(PG8_SB(1, 1), b3 + hstepB, voffB); PG8_STAGE(PG8_SA(1, 0), a3, voffA);
            PG8_WAIT_V(8); PG8_WAIT_L(0); PG8_BAR; PG8_MMA(1, 0, At, B0); PG8_MMA(1, 1, At, B1); PG8_BAR; PG8_SCHED;
        }
        if (wr == 0) PG8_BAR;
        E(acc, cur, wr, wc, fr, fq);
        if (!has_next) break;
#pragma unroll
        for (int a = 0; a < 2; ++a)
#pragma unroll
            for (int b = 0; b < 2; ++b)
#pragma unroll
                for (int m = 0; m < 4; ++m)
#pragma unroll
                    for (int n = 0; n < 2; ++n) acc[a][b][m][n] = (f32x4){0.f, 0.f, 0.f, 0.f};
        cur = nxt; cA = nA; cB = nB; ++ui;
        if (wr == 1) PG8_BAR;
    }
    PG8_WAIT_V(0);
    PG8_BAR;
#undef PG8_SA
#undef PG8_SB
#undef PG8_STAGE
#undef PG8_LDA
#undef PG8_LDB
#undef PG8_MMA
#undef PG8_WAIT_V
#undef PG8_WAIT_L
#undef PG8_BAR
#undef PG8_SCHED
}
}

__device__ __forceinline__ void rope8(f32x4& v0, f32x4& v1, const float2* rt  ) {
    const float2 c0 = ldco2(rt), c1 = ldco2(rt + 1), c2 = ldco2(rt + 2), c3 = ldco2(rt + 3);
    float a, b;
    a = v0[0]; b = v0[1]; v0[0] = a * c0.x - b * c0.y; v0[1] = b * c0.x + a * c0.y;
    a = v0[2]; b = v0[3]; v0[2] = a * c1.x - b * c1.y; v0[3] = b * c1.x + a * c1.y;
    a = v1[0]; b = v1[1]; v1[0] = a * c2.x - b * c2.y; v1[1] = b * c2.x + a * c2.y;
    a = v1[2]; b = v1[3]; v1[2] = a * c3.x - b * c3.y; v1[3] = b * c3.x + a * c3.y;
}
__device__ __forceinline__ u32x4 pack8(const f32x4& v0, const f32x4& v1) {
    u32x4 w; w.x = cvt_pk_bf16(v0[0], v0[1]); w.y = cvt_pk_bf16(v0[2], v0[3]); w.z = cvt_pk_bf16(v1[0], v1[1]); w.w = cvt_pk_bf16(v1[2], v1[3]); return w;
}
__device__ __forceinline__ float sq8(const f32x4& a, const f32x4& b) {
    return (a[0] * a[0] + a[1] * a[1]) + (a[2] * a[2] + a[3] * a[3]) + (b[0] * b[0] + b[1] * b[1]) + (b[2] * b[2] + b[3] * b[3]);
}
template <int MODE> struct Epi {
    bf16_t* O; int ldc; const float* rs; float* sq0; float* sq1; bf16_t* KR; const float2* RT;
    __device__ __forceinline__ void operator()(const f32x4 (&acc)[2][2][4][2], const pg8::Unit& u, int wr, int wc, int fr, int fq) const {
#pragma unroll
        for (int ai = 0; ai < 2; ++ai)
#pragma unroll
            for (int m = 0; m < 4; ++m) {
                const int row = u.pm * 256 + ai * 128 + wr * 64 + m * 16 + fr;
                float sc = 1.f;
                if (MODE == 0 || MODE == 1 || MODE == 2 || MODE == 5) sc = ldco(rs + row);
                float ssum[2];
#pragma unroll
                for (int bj = 0; bj < 2; ++bj) {
                    const int col0 = u.pn * 256 + bj * 128 + wc * 32 + 8 * fq;
                    f32x4 v0 = acc[ai][bj][m][0] * sc, v1 = acc[ai][bj][m][1] * sc;
                    if (MODE == 3) {
#pragma unroll
                        for (int j = 0; j < 4; ++j) { v0[j] *= ldco(rs + col0 + j); v1[j] *= ldco(rs + col0 + 4 + j); }
                    }
                    if (MODE == 5) {
#pragma unroll
                        for (int j = 0; j < 4; ++j) { const float a = fmaxf(v0[j], 0.f), b = fmaxf(v1[j], 0.f); v0[j] = a * a; v1[j] = b * b; }
                    }
                    ssum[bj] = sq8(v0, v1);
                    *(u32x4*)(O + (size_t)row * ldc + col0) = pack8(v0, v1);
                }
                if (MODE == 0) {
                    if (u.pn == 0) { float s = ssum[0] + ssum[1]; s += __shfl_xor(s, 16); s += __shfl_xor(s, 32); if (fq == 0) sq0[row * 4 + wc] = s; }
                    else if (u.pn == 1) { float s = ssum[0]; s += __shfl_xor(s, 16); s += __shfl_xor(s, 32); if (fq == 0) sq1[row * 4 + wc] = s; }
                }
                if (MODE == 4 || MODE == 6) { float s = ssum[0] + ssum[1]; s += __shfl_xor(s, 16); s += __shfl_xor(s, 32); if (fq == 0) sq0[(size_t)row * 16 + u.pn * 4 + wc] = s; }
            }
    }
};

__device__ __forceinline__ int src_col(int mode, int n) {
    if (mode == 0) return n;
    if (mode == 1) { if (n >= 1984) return -1; if (n >= 384 && n < 448) { const int j = n - 384; return 384 + ((j & 1) ? 32 + (j >> 1) : (j >> 1)); } return n; }
    if (mode == 2) { const int h = n / 192, w = n % 192; if (w < 128) return n; const int j = w - 128; return h * 192 + 128 + ((j & 1) ? 32 + (j >> 1) : (j >> 1)); }
    if (mode == 3) return (n >> 7) * 256 + (n & 127);
    return (n >> 7) * 256 + 128 + (n & 127);
}
__device__ __forceinline__ void conv_weight(const float* W, const float* g, bf16_t* out, int K, int Nsrc, int Nout, int mode, int gtid, int gthreads) {
    const int nch = Nout * (K / 8);
    for (int e = gtid; e < nch; e += gthreads) {
        const int n = e % Nout, kc = e / Nout, k0 = kc * 8; const int sc = src_col(mode, n);
        float v[8];
#pragma unroll
        for (int j = 0; j < 8; ++j) v[j] = (sc >= 0) ? W[(size_t)(k0 + j) * Nsrc + sc] * (g ? g[k0 + j] : 1.f) : 0.f;
        u32x4 w; w.x = cvt_pk_bf16(v[0], v[1]); w.y = cvt_pk_bf16(v[2], v[3]); w.z = cvt_pk_bf16(v[4], v[5]); w.w = cvt_pk_bf16(v[6], v[7]);
        *(u32x4*)(out + (size_t)n * K + k0) = w;
    }
}

__device__ __forceinline__ void p0_prologue(const Params& p, LAS unsigned char* lds) {
    unsigned char* ws = launder(p.ws);
    const int tid = tid_l(), lane = tid & 63, wave = tid >> 6, G = gridDim.x;
    const int gtid = blockIdx.x * 512 + tid, gthreads = G * 512;
    const int gw = blockIdx.x * 8 + wave, NGW = G * 8;
#if SUB_MASK & 1
    conv_weight(p.in[4], p.in[3], (bf16_t*)(ws + OFF_WIN), 1024, 1984, 2048, 1, gtid, gthreads);
    conv_weight(p.in[6], p.in[5], (bf16_t*)(ws + OFF_WUQ), 256, 768, 768, 2, gtid, gthreads);
    conv_weight(p.in[8], p.in[7], (bf16_t*)(ws + OFF_WKN), 128, 1024, 512, 3, gtid, gthreads);
    conv_weight(p.in[8], p.in[7], (bf16_t*)(ws + OFF_WV), 128, 1024, 512, 4, gtid, gthreads);
    conv_weight(p.in[20], nullptr, (bf16_t*)(ws + OFF_WO), 1024, 1024, 1024, 0, gtid, gthreads);
    conv_weight(p.in[23], p.in[22], (bf16_t*)(ws + OFF_WF1), 1024, 4096, 4096, 0, gtid, gthreads);
    conv_weight(p.in[24], nullptr, (bf16_t*)(ws + OFF_WF2), 4096, 1024, 1024, 0, gtid, gthreads);
#endif
#if SUB_MASK & 2
#if DEBUG_CHECK
    if (blockIdx.x == 0 && tid < 64) ((unsigned*)(ws + OFF_DBGW))[tid] = 0u;
#endif
    {
        float2* RT = (float2*)(ws + OFF_RT);
        for (int e = gtid; e < LP * 32; e += gthreads) {
            const int pos = e >> 5, i = e & 31;
            const float inv = 1.0f / exp2f((float)i * (13.287712379549449f / 32.f));
            float s, c; sincos_red((float)pos * inv, s, c);
            RT[e] = make_float2(c, s);
        }
    }
#endif
#if SUB_MASK & 4
    {
        bf16_t* h0b = (bf16_t*)(ws + OFF_H0B); float* r0 = (float*)(ws + OFF_R0);
        for (int r = gw; r < TPAD; r += NGW) {
            u32x2* o = (u32x2*)(h0b + (size_t)r * 1024) + lane;
            if (r >= T) {
#pragma unroll
                for (int j = 0; j < 4; ++j) o[64 * j] = (u32x2){0u, 0u};
                if (lane == 0) __hip_atomic_store(r0 + r, 0.f, __ATOMIC_RELAXED, __HIP_MEMORY_SCOPE_AGENT);
                continue;
            }
            int pos, seq; row_info(r, pos, seq);
            const float* src = pos < 16 ? p.in[2] + (size_t)pos * 1024
                                        : (seq < NBP ? p.in[0] + ((size_t)seq * 8192 + (pos - 16)) * 1024 : p.in[1] + ((size_t)(seq - NBP) * 2048 + (pos - 16)) * 1024);
            const f32x4* xr = (const f32x4*)src + lane;
            f32x4 v[4]; float ss = 0.f;
#pragma unroll
            for (int j = 0; j < 4; ++j) { v[j] = ld_sys((const float*)(xr + 64 * j)); ss += (v[j][0] * v[j][0] + v[j][1] * v[j][1]) + (v[j][2] * v[j][2] + v[j][3] * v[j][3]); }
            ss = wave_sum(ss);
#pragma unroll
            for (int j = 0; j < 4; ++j) o[64 * j] = (u32x2){cvt_pk_bf16(v[j][0], v[j][1]), cvt_pk_bf16(v[j][2], v[j][3])};
            if (lane == 0) __hip_atomic_store(r0 + r, rsqrtf(ss * (1.f / 1024.f) + EPS), __ATOMIC_RELAXED, __HIP_MEMORY_SCOPE_AGENT);
        }
    }
#endif
#if SUB_MASK & 8
    {
        const float* f_w1 = p.in[10]; const float* f_b1 = p.in[11]; const float* f_freq = p.in[12]; const float* f_w2 = p.in[13];
        const float* f_b2 = p.in[14]; const float* f_w3 = p.in[15]; const float* f_decay = p.in[16];
        LAS float* feats = (LAS float*)lds;
        LAS float* h1 = feats + 16 * 34;
        LAS float* h2 = h1 + 16 * 64;
        for (int u = blockIdx.x; u < 513 + 129; u += G) {
            const int set = u < 513 ? 0 : 1; const int t0 = 16 * (set ? u - 513 : u); const int L = set ? LS : LP; const int C0 = set ? LGS : LGP;
            bf16_t* GR = (bf16_t*)(ws + (set ? OFF_GR1 : OFF_GR0));
            const float invLm1 = 1.0f / (float)(L - 1);
            if (tid < 256) {
                const int tt = tid >> 4, k = tid & 15; const int t = t0 + tt;
                const float w = (6.2831853071795865f * (float)t) / (float)L;
                const float f = 1e-4f + (float)k * ((15.0f - 1e-4f) / 15.0f);
                float s, c; sincos_red(f * w, s, c);
                feats[tt * 34 + 1 + k] = c; feats[tt * 34 + 17 + k] = -s;
                if (k == 0) feats[tt * 34] = (float)t * invLm1;
            }
            __syncthreads();
#pragma unroll 1
            for (int q = 0; q < 2; ++q) {
                const int o = tid + 512 * q, tt = o >> 6, j = o & 63;
                float a = f_b1[j];
#pragma unroll 3
                for (int e = 0; e < 33; ++e) a += feats[tt * 34 + e] * f_w1[e * 64 + j];
                h1[tt * 64 + j] = sin_red(f_freq[j] * a);
            }
            __syncthreads();
#pragma unroll 1
            for (int q = 0; q < 2; ++q) {
                const int o = tid + 512 * q, tt = o >> 6, j = o & 63;
                float a = f_b2[j];
#pragma unroll 4
                for (int e = 0; e < 64; ++e) a += h1[tt * 64 + e] * f_w2[e * 64 + j];
                h2[tt * 64 + j] = sin_red(f_freq[j] * a);
            }
            __syncthreads();
#pragma unroll 1
            for (int q = 0; q < 4; ++q) {
                const int n = tid + 512 * q;
                float a[16];
#pragma unroll
                for (int i = 0; i < 16; ++i) a[i] = 0.f;
#pragma unroll 2
                for (int j = 0; j < 64; ++j) {
                    const float w = f_w3[j * 2048 + n];
#pragma unroll
                    for (int i = 0; i < 16; ++i) a[i] += h2[i * 64 + j] * w;
                }
                const float dec = fabsf(f_decay[n]);
                const int order = n >> 10, dir = (n >> 9) & 1, c = n & 511;
                bf16_t* row = GR + (size_t)(order * 512 + c) * (2 * C0);
#pragma unroll
                for (int i = 0; i < 16; ++i) {
                    const int t = t0 + i;
                    const float val = a[i] * __expf(-((float)t * invLm1) * dec);
                    const unsigned short b = (unsigned short)(cvt_pk_bf16(val, 0.f) & 0xffffu);
                    if (dir == 0) row[C0 - t] = b; else if (t > 0) row[C0 + t] = b;
                }
            }
            __syncthreads();
        }
        for (int e = gtid; e < 2 * 1024 * 97; e += gthreads) {
            const int set = e / (1024 * 97), r = (e / 97) % 1024, i = e % 97; const int L = set ? LS : LP; const int C0 = set ? LGS : LGP;
            bf16_t* row = (bf16_t*)(ws + (set ? OFF_GR1 : OFF_GR0)) + (size_t)r * (2 * C0);
            const int idx = i < 49 ? i : C0 + L + (i - 49);
            row[idx] = 0;
        }
    }
#endif
}

__device__ __forceinline__ void rownorm_phase(const Params& p) {
    unsigned char* ws = launder(p.ws); const int gtid = blockIdx.x * 512 + tid_l(), gthreads = gridDim.x * 512;
    const float* sqq = (const float*)(ws + OFF_SQQP); const float* sqkv = (const float*)(ws + OFF_SQKVP);
    float* rq = (float*)(ws + OFF_RQ); float* rkv = (float*)(ws + OFF_RKV);
    for (int r = gtid; r < TPAD; r += gthreads) {
        const float a = (ldco(sqq + r * 4) + ldco(sqq + r * 4 + 1)) + (ldco(sqq + r * 4 + 2) + ldco(sqq + r * 4 + 3));
        const float b = (ldco(sqkv + r * 4) + ldco(sqkv + r * 4 + 1)) + (ldco(sqkv + r * 4 + 2) + ldco(sqkv + r * 4 + 3));
        rq[r] = rsqrtf(a * (1.f / 256.f) + EPS) * QSCALE; rkv[r] = rsqrtf(b * (1.f / 128.f) + EPS);
    }
}
__device__ __forceinline__ void krope_phase(const Params& p) {
    unsigned char* ws = launder(p.ws); unsigned char* ob = launder((unsigned char*)p.out);
    const int gtid = blockIdx.x * 512 + tid_l(), gthreads = gridDim.x * 512;
    const bf16_t* P = (const bf16_t*)(ws + OFF_P); bf16_t* KR = (bf16_t*)(ob + DO_KR); const float2* RT = (const float2*)(ws + OFF_RT);
    for (int e = gtid; e < TPAD * 8; e += gthreads) {
        const int row = e >> 3, ch = e & 7;
        int pos, seq; row_info(row, pos, seq);
        const u32x4 v = *(const u32x4*)(P + (size_t)row * NPP + 384 + ch * 8);
        f32x4 v0 = (f32x4){bflo(v.x), bfhi(v.x), bflo(v.y), bfhi(v.y)}, v1 = (f32x4){bflo(v.z), bfhi(v.z), bflo(v.w), bfhi(v.w)};
        rope8(v0, v1, RT + pos * 32 + ch * 4);
        *(u32x4*)(KR + (size_t)row * 64 + ch * 8) = pack8(v0, v1);
    }
}
__device__ __forceinline__ void hyprep_phase(const Params& p, LAS unsigned char* lds) {
    unsigned char* ws = launder(p.ws); const int tid = tid_l(), G = gridDim.x;
    const bf16_t* P = (const bf16_t*)(ws + OFF_P); const float* conv_w = p.in[9];
    constexpr int RSB = 1040;
    for (int u = blockIdx.x; u < 3096 + 3168; u += G) {
        int seq, j, which;
        if (u < 3096) { seq = u / 387; const int rem = u % 387; j = rem / 3; which = rem % 3; }
        else { const int v = u - 3096; seq = NBP + v / 99; const int rem = v % 99; j = rem / 3; which = rem % 3; }
        const int set = seq < NBP ? 0 : 1; const int L = set ? LS : LP; const int Lg = set ? LGS : LGP; const int NB = set ? NBS : NBP;
        const int b = set ? seq - NBP : seq; const int row0 = set ? TPR + b * LS : b * LP;
        const int posb = 64 * j - 49;
        for (int i = 0; i < 9; ++i) {
            const int id = tid + 512 * i; if (id >= 66 * 64) break;
            const int rr = id >> 6, ch = id & 63; const int pos = posb + rr;
            u32x4 v = (u32x4){0u, 0u, 0u, 0u};
            if (pos >= 0 && pos < L) v = *(const u32x4*)(P + (size_t)(row0 + pos) * NPP + 448 + which * 512 + ch * 8);
            *(LAS u32x4*)(lds + rr * RSB + ch * 16) = v;
        }
        __syncthreads();
        {
            const int c = tid; const float w0 = conv_w[which * 512 + c], w1 = conv_w[1536 + which * 512 + c], w2 = conv_w[3072 + which * 512 + c];
            bf16_t* XT = (bf16_t*)(ws + (which == 0 ? OFF_X1T : (which == 1 ? OFF_X2T : OFF_V0T))) + (set ? XT_SET1 : 0) + ((size_t)c * NB + b) * Lg + 64 * j;
            const LAS unsigned short* tl = (const LAS unsigned short*)lds + c;
            float prev = bf2f(tl[0]), cur = bf2f(tl[RSB / 2]);
            for (int o8 = 0; o8 < 8; ++o8) {
                float r[8];
#pragma unroll
                for (int k = 0; k < 8; ++k) {
                    const int o = o8 * 8 + k; const float nxt = bf2f(tl[(o + 2) * (RSB / 2)]);
                    const int pos = posb + 1 + o;
                    r[k] = (pos >= 0 && pos < L) ? (prev * w0 + cur * w1 + nxt * w2) : 0.f;
                    prev = cur; cur = nxt;
                }
                u32x4 w; w.x = cvt_pk_bf16(r[0], r[1]); w.y = cvt_pk_bf16(r[2], r[3]); w.z = cvt_pk_bf16(r[4], r[5]); w.w = cvt_pk_bf16(r[6], r[7]);
                *(u32x4*)(XT + o8 * 8) = w;
            }
        }
        __syncthreads();
    }
}

__device__ __forceinline__ f32x16 mfma32(bf16x8 a, bf16x8 b, f32x16 c) { return __builtin_amdgcn_mfma_f32_32x32x16_bf16(a, b, c, 0, 0, 0); }

__device__ __forceinline__ void attn_phase(const Params& p, LAS unsigned char* lds) {
    const int tid = tid_l(), lane = tid & 63, wave = tid >> 6, G = gridDim.x, h = lane >> 5, l32 = lane & 31;
    unsigned char* ob = launder((unsigned char*)p.out);
    bf16_t* Q = (bf16_t*)(ob + DO_Q);
    const bf16_t* KN = (const bf16_t*)(ob + DO_KN);
    const bf16_t* KR = (const bf16_t*)(ob + DO_KR);
    const bf16_t* VT = (const bf16_t*)(ob + DO_VT);
    constexpr int KROW = 400, VROW = 136, KBYTES = 64 * KROW, BUFB = KBYTES + 128 * VROW;
    for (int u = blockIdx.x; u < 2048; u += G) {
        int seq, head, qb;
        if (u < 1024) { seq = u >> 7; head = (u >> 5) & 3; qb = u & 31; } else { const int v = u - 1024; seq = NBP + (v >> 5); head = (v >> 3) & 3; qb = v & 7; }
        const int L = seq < NBP ? LP : LS; const int row0 = seq < NBP ? seq * LP : TPR + (seq - NBP) * LS;
        const int ntiles = (L + 63) >> 6;
        const int qrow = row0 + 16 + qb * 256 + wave * 32 + l32;
        bf16x8 qf[12];
#pragma unroll
        for (int ks = 0; ks < 12; ++ks) qf[ks] = *(const bf16x8*)(Q + (size_t)qrow * 768 + head * 192 + 16 * ks + 8 * h);
        {
            const float2* RT = (const float2*)(launder(p.ws) + OFF_RT);
            const int qpos = 16 + qb * 256 + wave * 32 + l32;
#pragma unroll
            for (int ks = 8; ks < 12; ++ks) {
                const u32x4 v = __builtin_bit_cast(u32x4, qf[ks]);
                f32x4 v0 = (f32x4){bflo(v.x), bfhi(v.x), bflo(v.y), bfhi(v.y)}, v1 = (f32x4){bflo(v.z), bfhi(v.z), bflo(v.w), bfhi(v.w)};
                rope8(v0, v1, RT + qpos * 32 + 8 * (ks - 8) + 4 * h);
                qf[ks] = __builtin_bit_cast(bf16x8, pack8(v0, v1));
            }
        }
        const int kkey0 = tid >> 4, kch0 = tid & 15;
        const int rkey = tid >> 3, rch = tid & 7;
        const int vdv0 = tid >> 3, vch = tid & 7;
        const unsigned kn_off = (unsigned)(kkey0 * 512 + head * 128 + kch0 * 8) * 2u;
        const unsigned kr_off = (unsigned)(rkey * 64 + rch * 8) * 2u;
        const unsigned vt_off = (unsigned)(vdv0 * TPAD + vch * 8) * 2u;
        const unsigned char* knb = (const unsigned char*)KN + (size_t)row0 * 1024;
        const unsigned char* krb = (const unsigned char*)KR + (size_t)row0 * 128;
        const unsigned char* vtb = (const unsigned char*)VT + ((size_t)head * 128 * TPAD + row0) * 2;
        u32x4 g0, g1, g2, g3, g4;
#define ATT_LOAD(tile) do { const unsigned char* kb__ = knb + (size_t)(tile) * 65536; const unsigned char* rb__ = krb + (size_t)(tile) * 8192; const unsigned char* vb__ = vtb + (size_t)(tile) * 128; \
        g0 = *(const u32x4*)(kb__ + kn_off); g1 = *(const u32x4*)(kb__ + 32768 + kn_off); \
        g2 = *(const u32x4*)(rb__ + kr_off); (void)vb__; } while (0)
#define ATT_LOADV(tile) do { const unsigned char* vb__ = vtb + (size_t)(tile) * 128; g3 = *(const u32x4*)(vb__ + vt_off); g4 = *(const u32x4*)(vb__ + (size_t)64 * TPAD * 2 + vt_off); } while (0)
#define ATT_STOREK(buf) do { LAS unsigned char* kb_ = lds + (buf) * BUFB; \
        *(LAS u32x4*)(kb_ + kkey0 * KROW + kch0 * 16) = g0; *(LAS u32x4*)(kb_ + (kkey0 + 32) * KROW + kch0 * 16) = g1; \
        *(LAS u32x4*)(kb_ + rkey * KROW + 256 + rch * 16) = g2; } while (0)
#define ATT_STORE(buf) do { LAS unsigned char* vb_ = lds + (buf) * BUFB + KBYTES; \
        *(LAS u32x2*)(vb_ + vdv0 * VROW + vch * 16) = (u32x2){g3.x, g3.y}; *(LAS u32x2*)(vb_ + vdv0 * VROW + vch * 16 + 8) = (u32x2){g3.z, g3.w}; \
        *(LAS u32x2*)(vb_ + (vdv0 + 64) * VROW + vch * 16) = (u32x2){g4.x, g4.y}; *(LAS u32x2*)(vb_ + (vdv0 + 64) * VROW + vch * 16 + 8) = (u32x2){g4.z, g4.w}; } while (0)
        ATT_LOAD(0); ATT_LOADV(0); ATT_STOREK(0); ATT_STORE(0);
        __syncthreads();
        f32x16 o[4];
#pragma unroll
        for (int d = 0; d < 4; ++d)
#pragma unroll
            for (int r = 0; r < 16; ++r) o[d][r] = 0.f;
        float m_run = -INFINITY, l_run = 0.f;
        for (int j = 0; j < ntiles; ++j) {
            const int buf = j & 1;
            if (j + 1 < ntiles) ATT_LOAD(j + 1);
            const LAS unsigned char* kb = lds + buf * BUFB;
            f32x16 s0, s1;
#pragma unroll
            for (int r = 0; r < 16; ++r) { s0[r] = 0.f; s1[r] = 0.f; }
#pragma unroll
            for (int ks = 0; ks < 12; ++ks) {
                const bf16x8 a0 = *(const LAS bf16x8*)(kb + l32 * KROW + ks * 32 + h * 16);
                const bf16x8 a1 = *(const LAS bf16x8*)(kb + (l32 + 32) * KROW + ks * 32 + h * 16);
                s0 = mfma32(a0, qf[ks], s0); s1 = mfma32(a1, qf[ks], s1);
                if ((ks % 3) == 2) __builtin_amdgcn_sched_barrier(0);
            }
            if (j + 1 < ntiles) ATT_STOREK(buf ^ 1);
            const int vc = L - j * 64;
            if (vc < 64) {
                const int vch = vc - 4 * h;
#pragma unroll
                for (int r = 0; r < 16; ++r) {
                    if ((r & 3) + 8 * (r >> 2) >= vch) s0[r] = -INFINITY;
                    if ((r & 3) + 8 * (r >> 2) + 32 >= vch) s1[r] = -INFINITY;
                }
            }
            float mx = fmaxf(s0[0], s1[0]);
#pragma unroll
            for (int r = 1; r < 16; ++r) mx = fmaxf(mx, fmaxf(s0[r], s1[r]));
            mx = fmaxf(mx, __shfl_xor(mx, 32));
            const float m_new = fmaxf(m_run, mx);
            const float alpha = __builtin_amdgcn_exp2f(m_run - m_new);
            m_run = m_new;
            float ls = 0.f;
#pragma unroll
            for (int r = 0; r < 16; ++r) { s0[r] = __builtin_amdgcn_exp2f(s0[r] - m_new); s1[r] = __builtin_amdgcn_exp2f(s1[r] - m_new); ls += s0[r] + s1[r]; }
            l_run = l_run * alpha + ls;
#pragma unroll
            for (int d = 0; d < 4; ++d)
#pragma unroll
                for (int r = 0; r < 16; ++r) o[d][r] *= alpha;
            bf16x8 pb[4];
            {
                u32x4 w;
                w.x = cvt_pk_bf16(s0[0], s0[1]); w.y = cvt_pk_bf16(s0[2], s0[3]); w.z = cvt_pk_bf16(s0[4], s0[5]); w.w = cvt_pk_bf16(s0[6], s0[7]); pb[0] = __builtin_bit_cast(bf16x8, w);
                w.x = cvt_pk_bf16(s0[8], s0[9]); w.y = cvt_pk_bf16(s0[10], s0[11]); w.z = cvt_pk_bf16(s0[12], s0[13]); w.w = cvt_pk_bf16(s0[14], s0[15]); pb[1] = __builtin_bit_cast(bf16x8, w);
                w.x = cvt_pk_bf16(s1[0], s1[1]); w.y = cvt_pk_bf16(s1[2], s1[3]); w.z = cvt_pk_bf16(s1[4], s1[5]); w.w = cvt_pk_bf16(s1[6], s1[7]); pb[2] = __builtin_bit_cast(bf16x8, w);
                w.x = cvt_pk_bf16(s1[8], s1[9]); w.y = cvt_pk_bf16(s1[10], s1[11]); w.z = cvt_pk_bf16(s1[12], s1[13]); w.w = cvt_pk_bf16(s1[14], s1[15]); pb[3] = __builtin_bit_cast(bf16x8, w);
            }
            if (j + 1 < ntiles) ATT_LOADV(j + 1);
            const LAS unsigned char* vb = kb + KBYTES;
#pragma unroll
            for (int d = 0; d < 4; ++d)
#pragma unroll
                for (int ks = 0; ks < 4; ++ks) {
                    const LAS unsigned char* ap = vb + (d * 32 + l32) * VROW + (16 * ks + 4 * h) * 2;
                    const u32x2 lo = *(const LAS u32x2*)ap, hi = *(const LAS u32x2*)(ap + 16);
                    const u32x4 w = (u32x4){lo.x, lo.y, hi.x, hi.y};
                    o[d] = mfma32(__builtin_bit_cast(bf16x8, w), pb[ks], o[d]);
                    if (ks == 3) __builtin_amdgcn_sched_barrier(0);
                }
            if (j + 1 < ntiles) ATT_STORE(buf ^ 1);
            __syncthreads();
        }
        l_run += __shfl_xor(l_run, 32);
        const float inv = 1.0f / l_run;
#if DEBUG_CHECK == 5
        bf16_t* orow = (bf16_t*)(launder(p.ws) + OFF_ODBG) + (size_t)qrow * 512 + head * 128;
#else
        bf16_t* orow = Q + (size_t)qrow * 768 + head * 192;
#endif
#pragma unroll
        for (int d = 0; d < 4; ++d)
#pragma unroll
            for (int rq = 0; rq < 4; ++rq) {
                const u32x2 w = (u32x2){cvt_pk_bf16(o[d][4 * rq] * inv, o[d][4 * rq + 1] * inv), cvt_pk_bf16(o[d][4 * rq + 2] * inv, o[d][4 * rq + 3] * inv)};
                *(u32x2*)(orow + 32 * d + 8 * rq + 4 * h) = w;
            }
#undef ATT_LOAD
#undef ATT_LOADV
#undef ATT_STORE
#undef ATT_STOREK
    }
}

template <int SET> __device__ __forceinline__ void hyena_unit(const Params& p, LAS unsigned char* lds, int c, int bg) {
    constexpr int P = SET ? 32 : 128;
    constexpr int NBU = SET ? 16 : 4;
    constexpr int NBT = SET ? 8 : 2;
    constexpr int GP = SET ? 4 : 16;
    constexpr int LG = SET ? LGS : LGP;
    constexpr int NB = SET ? NBS : NBP;
    constexpr int RS = SET ? 4896 : 18816;
    constexpr int GBYTES = 2 * LG * 2;
    constexpr int ZOFF = 33280;
    unsigned char* ws = launder(p.ws);
    const int tid = tid_l(), lane = tid & 63, wave = tid >> 6, h = lane >> 5, l32 = lane & 31;
    const bf16_t* X1T = (const bf16_t*)(ws + OFF_X1T) + (SET ? XT_SET1 : 0);
    bf16_t* X2T = (bf16_t*)(ws + OFF_X2T) + (SET ? XT_SET1 : 0);
    const bf16_t* V0T = (const bf16_t*)(ws + OFF_V0T) + (SET ? XT_SET1 : 0);
    const bf16_t* GR = (const bf16_t*)(ws + (SET ? OFF_GR1 : OFF_GR0));
    const float* hy_bias = launder(p.in[17]);
    LAS unsigned char* gL = lds; LAS unsigned char* zL = lds + ZOFF;
    const size_t rowbase = ((size_t)c * NB + bg * NBU) * LG;
    for (int id = tid; id < NBU * (P + 1) * 8; id += 512) {
        const int bl = id / ((P + 1) * 8), rem = id % ((P + 1) * 8), blk = rem >> 3, ch = rem & 7;
        *(LAS u32x4*)(zL + bl * RS + blk * 144 + ch * 16) = *(const u32x4*)(V0T + rowbase + (size_t)bl * LG + blk * 64 + ch * 8);
    }
    for (int id = tid; id < NBU * 9; id += 512) { const int bl = id / 9, ch = id % 9; *(LAS u32x4*)(zL + bl * RS + (P + 1) * 144 + ch * 16) = (u32x4){0u, 0u, 0u, 0u}; }
    for (int id = tid; id < GBYTES / 16; id += 512) *(LAS u32x4*)(gL + id * 16) = *(const u32x4*)(GR + (size_t)c * (2 * LG) + id * 8);
    __syncthreads();
    const LAS unsigned short* g16 = (const LAS unsigned short*)gL;
    constexpr int PARTS = 512 / (NBU * 16);
    float zmeta = 0.f; int mo_bl, mo_m;
    {
        const int part = tid % PARTS, out = tid / PARTS; mo_bl = out >> 4; mo_m = out & 15;
        const LAS unsigned char* zr = zL + mo_bl * RS;
        float a = 0.f;
        for (int tt = 48 + part; tt < LG; tt += PARTS) {
            const float zv = bf2f(*(const LAS unsigned short*)(zr + (tt >> 6) * 144 + (tt & 63) * 2));
            const float gv = bf2f(g16[LG - mo_m - 48 + tt]);
            a += zv * gv;
        }
#pragma unroll
        for (int o = 1; o < PARTS; o <<= 1) a += __shfl_xor(a, o);
        const float bias0 = hy_bias[c];
        const float z0 = bf2f(*(const LAS unsigned short*)(zr + (48 + mo_m) * 2));
        const float x1 = bf2f(X1T[rowbase + (size_t)mo_bl * LG + 48 + mo_m]);
        zmeta = x1 * (a + z0 * bias0);
    }
    const int p0 = GP * wave;
    const int pp = l32 / NBT, blA = l32 % NBT, blB = NBT + blA;
#pragma unroll 1
    for (int order = 0; order < 2; ++order) {
        f32x16 acc[2][2];
#pragma unroll
        for (int a = 0; a < 2; ++a)
#pragma unroll
            for (int b = 0; b < 2; ++b)
#pragma unroll
                for (int r = 0; r < 16; ++r) acc[a][b][r] = 0.f;
#pragma unroll 1
        for (int d = p0 - (P - 1); d <= p0 + GP; ++d) {
            bf16x8 E[6];
            const int ib = LG - 64 * d - l32 + 8 * h;
#pragma unroll
            for (int e = 0; e < 6; ++e) {
                const LAS unsigned short* gp = g16 + ib - 16 * (e - 3);
#pragma unroll
                for (int j = 0; j < 8; ++j) E[e][j] = (short)gp[j];
            }
            const int q = p0 + pp - d;
            const int slot = ((unsigned)(q + 1) <= (unsigned)P) ? q + 1 : P + 1;
            const LAS unsigned char* zA = zL + blA * RS + slot * 144 + h * 16;
            const LAS unsigned char* zB = zL + blB * RS + slot * 144 + h * 16;
#pragma unroll
            for (int ks = 0; ks < 4; ++ks) {
                const bf16x8 ba = *(const LAS bf16x8*)(zA + ks * 32);
                const bf16x8 bb = *(const LAS bf16x8*)(zB + ks * 32);
#pragma unroll
                for (int m = 0; m < 2; ++m) {
                    acc[0][m] = mfma32(E[2 * m - ks + 3], ba, acc[0][m]);
                    acc[1][m] = mfma32(E[2 * m - ks + 3], bb, acc[1][m]);
                }
            }
        }
        __syncthreads();
        const float bias = hy_bias[order * 512 + c];
#pragma unroll
        for (int tl = 0; tl < 2; ++tl) {
            const int bl = tl ? blB : blA;
            const size_t grow = rowbase + (size_t)bl * LG + 64 * (p0 + pp + 1);
            LAS unsigned char* zr = zL + bl * RS + (p0 + pp + 1) * 144;
#pragma unroll
            for (int m = 0; m < 2; ++m)
#pragma unroll
                for (int rq = 0; rq < 4; ++rq) {
                    const int off = 32 * m + 8 * rq + 4 * h;
                    const u32x2 zw = *(const LAS u32x2*)(zr + off * 2);
                    const u32x2 xw = *(const u32x2*)((order ? (const bf16_t*)X2T : X1T) + grow + off);
                    const float y0 = acc[tl][m][4 * rq], y1 = acc[tl][m][4 * rq + 1], y2 = acc[tl][m][4 * rq + 2], y3 = acc[tl][m][4 * rq + 3];
                    const float r0 = bflo(xw.x) * (y0 + bflo(zw.x) * bias), r1 = bfhi(xw.x) * (y1 + bfhi(zw.x) * bias);
                    const float r2 = bflo(xw.y) * (y2 + bflo(zw.y) * bias), r3 = bfhi(xw.y) * (y3 + bfhi(zw.y) * bias);
                    const u32x2 w = (u32x2){cvt_pk_bf16(r0, r1), cvt_pk_bf16(r2, r3)};
#if DEBUG_CHECK == 5
                    if (order == 0) *(LAS u32x2*)(zr + off * 2) = w; else *(u32x2*)((bf16_t*)(ws + OFF_HDBG) + (SET ? XT_SET1 : 0) + grow + off) = w;
#else
                    if (order == 0) *(LAS u32x2*)(zr + off * 2) = w; else *(u32x2*)(X2T + grow + off) = w;
#endif
                }
        }
        if (order == 0) {
            if ((tid % PARTS) == 0) *(LAS unsigned short*)(zL + mo_bl * RS + (48 + mo_m) * 2) = (unsigned short)(cvt_pk_bf16(zmeta, 0.f) & 0xffffu);
            for (int id = tid; id < GBYTES / 16; id += 512) *(LAS u32x4*)(gL + id * 16) = *(const u32x4*)(GR + (size_t)(512 + c) * (2 * LG) + id * 8);
        }
        __syncthreads();
    }
}
__device__ __forceinline__ void hyena_phase(const Params& p, LAS unsigned char* lds) {
    for (int u = blockIdx.x; u < 2048; u += gridDim.x) {
        if (u < 1024) hyena_unit<0>(p, lds, u >> 1, u & 1); else hyena_unit<1>(p, lds, (u - 1024) >> 1, u & 1);
    }
}

__device__ __forceinline__ void mixnorm_phase(const Params& p, LAS unsigned char* lds) {
    unsigned char* ws = launder(p.ws); const int tid = tid_l(), lane = tid & 63, wave = tid >> 6, G = gridDim.x;
    const bf16_t* Q = (const bf16_t*)(launder((unsigned char*)p.out) + DO_Q);
    bf16_t* MIXN = (bf16_t*)(ws + OFF_MIXN);
    const float* ga = launder(p.in[18]); const float* gh = launder(p.in[19]);
    constexpr int RSB = 1040;
    for (int u = blockIdx.x; u < 2048; u += G) {
        const int n0 = u * 64;
        int set, b, tok0;
        if (n0 < 65536) { set = 0; b = n0 >> 13; tok0 = n0 & 8191; } else { set = 1; const int q = n0 - 65536; b = q >> 11; tok0 = q & 2047; }
        const int Lg = set ? LGS : LGP, NB = set ? NBS : NBP;
        {
            const int c = tid;
#if DEBUG_CHECK == 5
            const bf16_t* src = (const bf16_t*)(ws + OFF_HDBG) + (set ? XT_SET1 : 0) + ((size_t)c * NB + b) * Lg + tok0 + 64;
#else
            const bf16_t* src = (const bf16_t*)(ws + OFF_X2T) + (set ? XT_SET1 : 0) + ((size_t)c * NB + b) * Lg + tok0 + 64;
#endif
            LAS unsigned short* tl = (LAS unsigned short*)lds + c;
#pragma unroll
            for (int k8 = 0; k8 < 8; ++k8) {
                const u32x4 v = *(const u32x4*)(src + k8 * 8);
                tl[(k8 * 8 + 0) * (RSB / 2)] = (unsigned short)(v.x & 0xffffu); tl[(k8 * 8 + 1) * (RSB / 2)] = (unsigned short)(v.x >> 16);
                tl[(k8 * 8 + 2) * (RSB / 2)] = (unsigned short)(v.y & 0xffffu); tl[(k8 * 8 + 3) * (RSB / 2)] = (unsigned short)(v.y >> 16);
                tl[(k8 * 8 + 4) * (RSB / 2)] = (unsigned short)(v.z & 0xffffu); tl[(k8 * 8 + 5) * (RSB / 2)] = (unsigned short)(v.z >> 16);
                tl[(k8 * 8 + 6) * (RSB / 2)] = (unsigned short)(v.w & 0xffffu); tl[(k8 * 8 + 7) * (RSB / 2)] = (unsigned short)(v.w >> 16);
            }
        }
        __syncthreads();
        for (int i = 0; i < 8; ++i) {
            const int rr = wave + 8 * i; const int n = n0 + rr; const int r = full_row(n);
            const u32x4 hv = *(const LAS u32x4*)(lds + rr * RSB + lane * 16);
#if DEBUG_CHECK == 5
            const u32x4 av = *(const u32x4*)((const bf16_t*)(ws + OFF_ODBG) + (size_t)r * 512 + lane * 8);
#else
            const u32x4 av = *(const u32x4*)(Q + (size_t)r * 768 + (lane >> 4) * 192 + (lane & 15) * 8);
#endif
            float hf[8] = {bflo(hv.x), bfhi(hv.x), bflo(hv.y), bfhi(hv.y), bflo(hv.z), bfhi(hv.z), bflo(hv.w), bfhi(hv.w)};
            float af[8] = {bflo(av.x), bfhi(av.x), bflo(av.y), bfhi(av.y), bflo(av.z), bfhi(av.z), bflo(av.w), bfhi(av.w)};
            float sh = 0.f, sa = 0.f;
#pragma unroll
            for (int k = 0; k < 8; ++k) { sh += hf[k] * hf[k]; sa += af[k] * af[k]; }
            sh = wave_sum(sh); sa = wave_sum(sa);
            const float rh = rsqrtf(sh * (1.f / 512.f) + EPS), ra = rsqrtf(sa * (1.f / 512.f) + EPS);
            const f32x4 ga0 = *(const f32x4*)(ga + lane * 8), ga1 = *(const f32x4*)(ga + lane * 8 + 4);
            const f32x4 gh0 = *(const f32x4*)(gh + lane * 8), gh1 = *(const f32x4*)(gh + lane * 8 + 4);
            u32x4 wa, wh;
            wa.x = cvt_pk_bf16(af[0] * ra * ga0[0], af[1] * ra * ga0[1]); wa.y = cvt_pk_bf16(af[2] * ra * ga0[2], af[3] * ra * ga0[3]);
            wa.z = cvt_pk_bf16(af[4] * ra * ga1[0], af[5] * ra * ga1[1]); wa.w = cvt_pk_bf16(af[6] * ra * ga1[2], af[7] * ra * ga1[3]);
            wh.x = cvt_pk_bf16(hf[0] * rh * gh0[0], hf[1] * rh * gh0[1]); wh.y = cvt_pk_bf16(hf[2] * rh * gh0[2], hf[3] * rh * gh0[3]);
            wh.z = cvt_pk_bf16(hf[4] * rh * gh1[0], hf[5] * rh * gh1[1]); wh.w = cvt_pk_bf16(hf[6] * rh * gh1[2], hf[7] * rh * gh1[3]);
#if EXPT == 1
            wa = (u32x4){0u, 0u, 0u, 0u};
#endif
#if EXPT == 2
            wh = (u32x4){0u, 0u, 0u, 0u};
#endif
            *(u32x4*)(MIXN + (size_t)n * 1024 + lane * 8) = wa;
            *(u32x4*)(MIXN + (size_t)n * 1024 + 512 + lane * 8) = wh;
        }
        __syncthreads();
    }
}

__device__ __forceinline__ void h1_phase(const Params& p) {
    unsigned char* ws = launder(p.ws); const int tid = tid_l(), lane = tid & 63, wave = tid >> 6;
    const int gw = blockIdx.x * 8 + wave, NGW = gridDim.x * 8;
    const bf16_t* MIX = (const bf16_t*)(ws + OFF_MIX); bf16_t* H1B = (bf16_t*)(ws + OFF_H1B);
    const float* sqmix = (const float*)(ws + OFF_SQMIXP); float* r1 = (float*)(ws + OFF_R1); const float* g = p.in[21];
    for (int n = gw; n < TN; n += NGW) {
        const float* xrow = n < 65536 ? p.in[0] + (size_t)n * 1024 : p.in[1] + (size_t)(n - 65536) * 1024;
        const float rm = rsqrtf(wave_sum(lane < 16 ? ldco(sqmix + (size_t)n * 16 + lane) : 0.f) * (1.f / 1024.f) + EPS);
        float ss = 0.f;
#pragma unroll
        for (int hh = 0; hh < 2; ++hh) {
            const int c0 = hh * 512 + lane * 8;
            const u32x4 mv = *(const u32x4*)(MIX + (size_t)n * 1024 + c0);
            const f32x4 x0 = ld_sys(xrow + c0), x1 = ld_sys(xrow + c0 + 4);
            const f32x4 g0 = *(const f32x4*)(g + c0), g1 = *(const f32x4*)(g + c0 + 4);
            f32x4 h0, h1;
            h0[0] = x0[0] + bflo(mv.x) * rm * g0[0]; h0[1] = x0[1] + bfhi(mv.x) * rm * g0[1]; h0[2] = x0[2] + bflo(mv.y) * rm * g0[2]; h0[3] = x0[3] + bfhi(mv.y) * rm * g0[3];
            h1[0] = x1[0] + bflo(mv.z) * rm * g1[0]; h1[1] = x1[1] + bfhi(mv.z) * rm * g1[1]; h1[2] = x1[2] + bflo(mv.w) * rm * g1[2]; h1[3] = x1[3] + bfhi(mv.w) * rm * g1[3];
            ss += sq8(h0, h1);
            *(f32x4*)(p.out + (size_t)n * 1024 + c0) = h0; *(f32x4*)(p.out + (size_t)n * 1024 + c0 + 4) = h1;
            *(u32x4*)(H1B + (size_t)n * 1024 + c0) = pack8(h0, h1);
        }
        ss = wave_sum(ss);
        if (lane == 0) r1[n] = rsqrtf(ss * (1.f / 1024.f) + EPS);
    }
}
__device__ __forceinline__ void final_phase(const Params& p, int half) {
    unsigned char* ws = launder(p.ws); const int tid = tid_l(), lane = tid & 63, wave = tid >> 6;
    const int gw = blockIdx.x * 8 + wave, NGW = gridDim.x * 8;
    const bf16_t* M2 = (const bf16_t*)(ws + OFF_M2); const float* sqm2 = (const float*)(ws + OFF_SQM2P); const float* g = p.in[25];
    float dbg_off = 0.f, dbg_one = 0.f;
#if DEBUG_CHECK
    { const unsigned* dc = (const unsigned*)(ws + OFF_DBGW); dbg_off = 100.f * (float)dc[8] * (1.f / 131072.f); dbg_one = 1000.f * (float)dc[9] * (1.f / 131072.f); }
#endif
    for (int i = gw; i < 65536; i += NGW) {
        const int n = half * 65536 + i;
        const float rm = rsqrtf(wave_sum(lane < 16 ? ldco(sqm2 + (size_t)n * 16 + lane) : 0.f) * (1.f / 1024.f) + EPS);
#pragma unroll
        for (int hh = 0; hh < 2; ++hh) {
            const int c0 = hh * 512 + lane * 8;
            const u32x4 mv = *(const u32x4*)(M2 + (size_t)i * 1024 + c0);
            f32x4 h0 = *(const f32x4*)(p.out + (size_t)n * 1024 + c0), h1 = *(const f32x4*)(p.out + (size_t)n * 1024 + c0 + 4);
            const f32x4 g0 = *(const f32x4*)(g + c0), g1 = *(const f32x4*)(g + c0 + 4);
            h0 += dbg_off; h1 += dbg_off; if (n == 0 && c0 == 0) h0[0] += dbg_one;
            h0[0] += bflo(mv.x) * rm * g0[0]; h0[1] += bfhi(mv.x) * rm * g0[1]; h0[2] += bflo(mv.y) * rm * g0[2]; h0[3] += bfhi(mv.y) * rm * g0[3];
            h1[0] += bflo(mv.z) * rm * g1[0]; h1[1] += bfhi(mv.z) * rm * g1[1]; h1[2] += bflo(mv.w) * rm * g1[2]; h1[3] += bfhi(mv.w) * rm * g1[3];
            *(f32x4*)(p.out + (size_t)n * 1024 + c0) = h0; *(f32x4*)(p.out + (size_t)n * 1024 + c0 + 4) = h1;
        }
    }
}


#if DEBUG_CHECK
constexpr size_t OFF_DBG = OFF_DBGW;
__device__ __forceinline__ void check_gemm(const bf16_t* A, int lda, const bf16_t* Bt, int ldb, int K, int M, int N, int mode, const bf16_t* O, int ldc, const float* rs, unsigned* cnt, int col_lo) {
    const unsigned idx = blockIdx.x * 512u + (unsigned)tid_l();
    unsigned hsh = idx * 2654435761u + 12345u + (unsigned)mode * 977u; hsh ^= hsh >> 15; hsh *= 2246822519u; hsh ^= hsh >> 13;
    const int row = (int)(hsh % (unsigned)M); hsh = hsh * 3266489917u + 668265263u; hsh ^= hsh >> 16;
    const int col = col_lo + (int)(hsh % (unsigned)(N - col_lo));
    float d = 0.f;
    for (int k = 0; k < K; ++k) d += bf2f(A[(size_t)row * lda + k]) * bf2f(Bt[(size_t)col * ldb + k]);
    float e = d;
    if (mode == 0 || mode == 7) e = d * rs[row];
    if (mode == 5) { const float t = fmaxf(d * rs[row], 0.f); e = t * t; }
    const float st = bf2f(O[(size_t)row * ldc + col]);
    if (!(fabsf(st - e) <= 0.03f * fabsf(e) + 0.03f)) atomicAdd(cnt, 1u);
}
#endif

#if DEBUG_CHECK == 2
__device__ __forceinline__ void check_proj(const Params& p) {
    unsigned char* ws = launder(p.ws); unsigned char* ob = launder((unsigned char*)p.out);
    const bf16_t* P = (const bf16_t*)(ws + OFF_P); unsigned* cnt = (unsigned*)(ws + OFF_DBG);
    const unsigned idx = blockIdx.x * 512u + (unsigned)tid_l();
    unsigned hsh = idx * 2654435761u + 777u; hsh ^= hsh >> 15; hsh *= 2246822519u; hsh ^= hsh >> 13;
    const int row = (int)(hsh % (unsigned)T); hsh = hsh * 3266489917u + 668265263u; hsh ^= hsh >> 16;
    int pos, seq; row_info(row, pos, seq);
    {
        const int n = (int)(hsh % 768u); const int hh = n / 192, w = n % 192;
        float ss = 0.f, x1 = 0.f, x2 = 0.f; const float* W = p.in[6]; const float* g = p.in[5];
        const int j = w - 128, i = j >> 1;
        const int c1 = w < 128 ? hh * 192 + w : hh * 192 + 128 + i, c2 = hh * 192 + 160 + (w < 128 ? 0 : i);
        for (int k = 0; k < 256; ++k) { const float a = bf2f(P[(size_t)row * NPP + k]); ss += a * a; x1 += a * g[k] * W[k * 768 + c1]; x2 += a * g[k] * W[k * 768 + c2]; }
        const float rq = rsqrtf(ss * (1.f / 256.f) + EPS) * QSCALE; x1 *= rq; x2 *= rq;
        float e = x1;
        if (w >= 128) { const float inv = 1.0f / exp2f((float)i * (13.287712379549449f / 32.f)); float sn, cs; sincos_red((float)pos * inv, sn, cs); e = (j & 1) ? x2 * cs + x1 * sn : x1 * cs - x2 * sn; }
        const float st = bf2f(((const bf16_t*)(ob + DO_Q))[(size_t)row * 768 + n]);
        if (!(fabsf(st - e) <= 0.03f * fabsf(e) + 0.01f)) atomicAdd(cnt + (w < 128 ? 0 : 4), 1u);
    }
    {
        const int n = (int)((hsh >> 3) % 512u); const int hh = n >> 7, i = n & 127;
        float ss = 0.f, x1 = 0.f, x2 = 0.f; const float* W = p.in[8]; const float* g = p.in[7];
        for (int k = 0; k < 128; ++k) { const float a = bf2f(P[(size_t)row * NPP + 256 + k]); ss += a * a; x1 += a * g[k] * W[k * 1024 + hh * 256 + i]; x2 += a * g[k] * W[k * 1024 + hh * 256 + 128 + i]; }
        const float rk = rsqrtf(ss * (1.f / 128.f) + EPS); x1 *= rk; x2 *= rk;
        const float s1 = bf2f(((const bf16_t*)(ob + DO_KN))[(size_t)row * 512 + n]);
        const float s2 = bf2f(((const bf16_t*)(ob + DO_VT))[(size_t)n * TPAD + row]);
        if (!(fabsf(s1 - x1) <= 0.03f * fabsf(x1) + 0.03f)) atomicAdd(cnt + 1, 1u);
        if (!(fabsf(s2 - x2) <= 0.03f * fabsf(x2) + 0.03f)) atomicAdd(cnt + 2, 1u);
    }
    {
        const int jj = (int)((hsh >> 5) % 64u); const int i = jj >> 1;
        const float* xr = pos < 16 ? p.in[2] + (size_t)pos * 1024 : (seq < NBP ? p.in[0] + ((size_t)seq * 8192 + (pos - 16)) * 1024 : p.in[1] + ((size_t)(seq - NBP) * 2048 + (pos - 16)) * 1024);
        const float* W = p.in[4]; const float* g = p.in[3]; float x1 = 0.f, x2 = 0.f;
        for (int k = 0; k < 1024; ++k) { const float a = xr[k] * g[k]; x1 += a * W[(size_t)k * 1984 + 384 + i]; x2 += a * W[(size_t)k * 1984 + 416 + i]; }
        const float r0 = ((const float*)(ws + OFF_R0))[row]; x1 *= r0; x2 *= r0;
        const float inv = 1.0f / exp2f((float)i * (13.287712379549449f / 32.f)); float sn, cs; sincos_red((float)pos * inv, sn, cs);
        const float e = (jj & 1) ? x2 * cs + x1 * sn : x1 * cs - x2 * sn;
        const float st = bf2f(((const bf16_t*)(ob + DO_KR))[(size_t)row * 64 + jj]);
        if (!(fabsf(st - e) <= 0.03f * fabsf(e) + 0.03f)) { atomicAdd(cnt + 3, 1u); atomicAdd(cnt + 5, (unsigned)i); atomicAdd(cnt + 6, (unsigned)(pos >> 3)); }
    }
}
#endif

#if DEBUG_CHECK == 3
__device__ __forceinline__ void check_h0b(const Params& p, int slot) {
    unsigned char* ws = launder(p.ws); unsigned* cnt = (unsigned*)(ws + OFF_DBGW);
    const bf16_t* h0b = (const bf16_t*)(ws + OFF_H0B);
    const unsigned idx = blockIdx.x * 512u + (unsigned)tid_l();
    unsigned hsh = idx * 2654435761u + 4242u + (unsigned)slot * 31u; hsh ^= hsh >> 15; hsh *= 2246822519u; hsh ^= hsh >> 13;
    const int row = (int)(hsh % (unsigned)T); hsh = hsh * 3266489917u + 668265263u; hsh ^= hsh >> 16;
    const int col = (int)(hsh % 1024u);
    int pos, seq; row_info(row, pos, seq);
    const float* xr = pos < 16 ? p.in[2] + (size_t)pos * 1024 : (seq < NBP ? p.in[0] + ((size_t)seq * 8192 + (pos - 16)) * 1024 : p.in[1] + ((size_t)(seq - NBP) * 2048 + (pos - 16)) * 1024);
    const float e = xr[col]; const float st = bf2f(h0b[(size_t)row * 1024 + col]);
    if (!(fabsf(st - e) <= 0.01f * fabsf(e) + 0.001f)) atomicAdd(cnt + slot, 1u);
}
#endif

#if DEBUG_CHECK == 4
__device__ __forceinline__ void check_stale(const Params& p, const unsigned* base, unsigned ndw, int slot) {
    unsigned* cnt = (unsigned*)(launder(p.ws) + OFF_DBGW);
    const unsigned idx = blockIdx.x * 512u + (unsigned)tid_l();
    unsigned hsh = idx * 2654435761u + 999u + (unsigned)slot * 131u; hsh ^= hsh >> 15; hsh *= 2246822519u; hsh ^= hsh >> 13;
#pragma unroll 1
    for (int it = 0; it < 16; ++it) {
        hsh = hsh * 3266489917u + 668265263u; hsh ^= hsh >> 16;
        const unsigned i = hsh % ndw;
        const unsigned a = base[i];
        const unsigned b = __hip_atomic_load(base + i, __ATOMIC_RELAXED, __HIP_MEMORY_SCOPE_AGENT);
        if (a != b) atomicAdd(cnt + slot, 1u);
    }
}
#endif

#if DEBUG_CHECK == 5
__device__ __forceinline__ void check_attn(const Params& p) {
    unsigned char* ws = launder(p.ws); unsigned char* ob = launder((unsigned char*)p.out); unsigned* cnt = (unsigned*)(ws + OFF_DBGW);
    const int tid = tid_l(), lane = tid & 63, wave = tid >> 6;
    const bf16_t* Q = (const bf16_t*)(ob + DO_Q); const bf16_t* KN = (const bf16_t*)(ob + DO_KN); const bf16_t* KR = (const bf16_t*)(ob + DO_KR); const bf16_t* VT = (const bf16_t*)(ob + DO_VT);
    const bf16_t* OD = (const bf16_t*)(ws + OFF_ODBG); const float2* RT = (const float2*)(ws + OFF_RT);
    unsigned hsh = (unsigned)(blockIdx.x * 8 + wave) * 2654435761u + 31337u; hsh ^= hsh >> 15; hsh *= 2246822519u; hsh ^= hsh >> 13;
    const int n = (int)(hsh % (unsigned)TN); const int head = (int)((hsh >> 20) & 3u); const int r = full_row(n);
    int pos, seq; row_info(r, pos, seq);
    const int L = seq < NBP ? LP : LS; const int row0 = r - pos;
    const bf16_t* qp = Q + (size_t)r * 768 + head * 192;
    float mx = -INFINITY;
    for (int k = lane; k < L; k += 64) {
        float sdot = 0.f;
        for (int d = 0; d < 128; ++d) sdot += bf2f(qp[d]) * bf2f(KN[(size_t)(row0 + k) * 512 + head * 128 + d]);
        for (int i = 0; i < 32; ++i) { const float2 cs = ldco2(RT + pos * 32 + i); const float a = bf2f(qp[128 + 2 * i]), b = bf2f(qp[129 + 2 * i]);
            sdot += (a * cs.x - b * cs.y) * bf2f(KR[(size_t)(row0 + k) * 64 + 2 * i]) + (b * cs.x + a * cs.y) * bf2f(KR[(size_t)(row0 + k) * 64 + 2 * i + 1]); }
        mx = fmaxf(mx, sdot);
    }
#pragma unroll
    for (int o = 1; o < 64; o <<= 1) mx = fmaxf(mx, __shfl_xor(mx, o));
    float sw = 0.f, o0 = 0.f, o1 = 0.f; const int dv0 = (int)((hsh >> 8) & 127u), dv1 = (dv0 + 37) & 127;
    for (int k = lane; k < L; k += 64) {
        float sdot = 0.f;
        for (int d = 0; d < 128; ++d) sdot += bf2f(qp[d]) * bf2f(KN[(size_t)(row0 + k) * 512 + head * 128 + d]);
        for (int i = 0; i < 32; ++i) { const float2 cs = ldco2(RT + pos * 32 + i); const float a = bf2f(qp[128 + 2 * i]), b = bf2f(qp[129 + 2 * i]);
            sdot += (a * cs.x - b * cs.y) * bf2f(KR[(size_t)(row0 + k) * 64 + 2 * i]) + (b * cs.x + a * cs.y) * bf2f(KR[(size_t)(row0 + k) * 64 + 2 * i + 1]); }
        const float w = exp2f(sdot - mx); sw += w;
        o0 += w * bf2f(VT[(size_t)(head * 128 + dv0) * TPAD + row0 + k]); o1 += w * bf2f(VT[(size_t)(head * 128 + dv1) * TPAD + row0 + k]);
    }
    sw = wave_sum(sw); o0 = wave_sum(o0) / sw; o1 = wave_sum(o1) / sw;
    if (lane == 0) {
        const float s0 = bf2f(OD[(size_t)r * 512 + head * 128 + dv0]), s1 = bf2f(OD[(size_t)r * 512 + head * 128 + dv1]);
        atomicAdd(cnt + 10, 2u);
        if (!(fabsf(s0 - o0) <= 0.05f * fabsf(o0) + 0.002f)) atomicAdd(cnt + 8, 1u);
        if (!(fabsf(s1 - o1) <= 0.05f * fabsf(o1) + 0.002f)) atomicAdd(cnt + 8, 1u);
    }
}
__device__ __forceinline__ void check_hyena(const Params& p, LAS unsigned char* lds) {
    unsigned char* ws = launder(p.ws); unsigned* cnt = (unsigned*)(ws + OFF_DBGW);
    const int tid = tid_l();
    unsigned hsh = (unsigned)blockIdx.x * 2654435761u + 555u; hsh ^= hsh >> 15; hsh *= 2246822519u; hsh ^= hsh >> 13;
    const int set = (int)(blockIdx.x & 1u); const int c = (int)(hsh % 512u); const int NB = set ? NBS : NBP; const int b = (int)((hsh >> 12) % (unsigned)NB);
    const int LG = set ? LGS : LGP;
    const size_t base = (set ? XT_SET1 : 0) + ((size_t)c * NB + b) * LG;
    const bf16_t* X1 = (const bf16_t*)(ws + OFF_X1T) + base; const bf16_t* X2 = (const bf16_t*)(ws + OFF_X2T) + base; const bf16_t* V0 = (const bf16_t*)(ws + OFF_V0T) + base;
    const bf16_t* HD = (const bf16_t*)(ws + OFF_HDBG) + base;
    const bf16_t* G0 = (const bf16_t*)(ws + (set ? OFF_GR1 : OFF_GR0)) + (size_t)c * (2 * LG); const bf16_t* G1 = G0 + (size_t)512 * (2 * LG);
    const float bias0 = p.in[17][c], bias1 = p.in[17][512 + c];
    LAS float* z1 = (LAS float*)lds;
    for (int t = tid; t < LG; t += 512) {
        float y = 0.f;
        for (int s2 = 48; s2 < LG; ++s2) y += bf2f(G0[LG - (t - s2)]) * bf2f(V0[s2]);
        const float v = bf2f(X1[t]) * (y + bf2f(V0[t]) * bias0);
        z1[t] = (t >= 48) ? bf2f((unsigned short)(cvt_pk_bf16(v, 0.f) & 0xffffu)) : 0.f;
    }
    __syncthreads();
    {
        unsigned h2 = hsh * 3266489917u + (unsigned)tid * 2246822519u; h2 ^= h2 >> 15; h2 *= 2654435761u; h2 ^= h2 >> 13;
        const int t = 64 + (int)(h2 % (unsigned)(LG - 64));
        float y = 0.f;
        for (int s2 = 48; s2 < LG; ++s2) y += bf2f(G1[LG - (t - s2)]) * z1[s2];
        const float e = bf2f(X2[t]) * (y + z1[t] * bias1);
        const float st = bf2f(HD[t]);
        atomicAdd(cnt + 11, 1u);
        if (!(fabsf(st - e) <= 0.05f * fabsf(e) + 1.0f)) atomicAdd(cnt + 9, 1u);
    }
    __syncthreads();
}
#endif

#if DEBUG_CHECK == 7
__device__ __forceinline__ void check_h0b_full(const Params& p, int slot) {
    unsigned char* ws = launder(p.ws); unsigned* cnt = (unsigned*)(ws + OFF_DBGW);
    const bf16_t* h0b = (const bf16_t*)(ws + OFF_H0B);
    const int tid = tid_l(), lane = tid & 63, wave = tid >> 6;
    for (int row = blockIdx.x * 8 + wave; row < T; row += gridDim.x * 8) {
        int pos, seq; row_info(row, pos, seq);
        const float* xr = pos < 16 ? p.in[2] + (size_t)pos * 1024 : (seq < NBP ? p.in[0] + ((size_t)seq * 8192 + (pos - 16)) * 1024 : p.in[1] + ((size_t)(seq - NBP) * 2048 + (pos - 16)) * 1024);
        int bad = 0;
        for (int c = lane; c < 1024; c += 64) { const float e = xr[c]; const float st = bf2f(h0b[(size_t)row * 1024 + c]); if (!(fabsf(st - e) <= 0.01f * fabsf(e) + 0.001f)) bad = 1; }
        bad = __any(bad);
        if (lane == 0 && bad) atomicAdd(cnt + slot, 1u);
    }
}
#endif

#if DEBUG_CHECK == 8
__device__ __forceinline__ void check_p_golden(const Params& p) {
    unsigned char* ws = launder(p.ws); unsigned* cnt = (unsigned*)(ws + OFF_DBGW);
    const bf16_t* P = (const bf16_t*)(ws + OFF_P);
    const unsigned idx = blockIdx.x * 512u + (unsigned)tid_l();
    unsigned hsh = idx * 2654435761u + 8888u; hsh ^= hsh >> 15; hsh *= 2246822519u; hsh ^= hsh >> 13;
    const int row = (int)(hsh % (unsigned)T); hsh = hsh * 3266489917u + 668265263u; hsh ^= hsh >> 16;
    int pos, seq; row_info(row, pos, seq);
    const float* xr = pos < 16 ? p.in[2] + (size_t)pos * 1024 : (seq < NBP ? p.in[0] + ((size_t)seq * 8192 + (pos - 16)) * 1024 : p.in[1] + ((size_t)(seq - NBP) * 2048 + (pos - 16)) * 1024);
    const float* W = p.in[4]; const float* g = p.in[3];
    const int colA = 448 + (int)(hsh % 1536u), colB = (int)((hsh >> 7) % 384u);
    float ss = 0.f, a = 0.f, b = 0.f;
    for (int k = 0; k < 1024; ++k) { const float x = xr[k]; ss += x * x; a += x * g[k] * W[(size_t)k * 1984 + colA]; b += x * g[k] * W[(size_t)k * 1984 + colB]; }
    const float r0 = rsqrtf(ss * (1.f / 1024.f) + EPS); a *= r0; b *= r0;
    const float sa = bf2f(P[(size_t)row * NPP + colA]), sb = bf2f(P[(size_t)row * NPP + colB]);
    if (!(fabsf(sa - a) <= 0.03f * fabsf(a) + 0.03f)) atomicAdd(cnt + 8, 1u);
    if (!(fabsf(sb - b) <= 0.03f * fabsf(b) + 0.03f)) atomicAdd(cnt + 9, 1u);
}
#endif

#if DEBUG_CHECK == 9
__device__ __forceinline__ void check_win_r0(const Params& p) {
    unsigned char* ws = launder(p.ws); unsigned* cnt = (unsigned*)(ws + OFF_DBGW);
    const bf16_t* WT = (const bf16_t*)(ws + OFF_WIN); const float* W = p.in[4]; const float* g = p.in[3]; const float* R0 = (const float*)(ws + OFF_R0);
    const int tid = tid_l(), lane = tid & 63, wave = tid >> 6;
    const int gtid = blockIdx.x * 512 + tid, gthreads = gridDim.x * 512;
    for (int e = gtid; e < 1984 * 1024; e += gthreads) {
        const int n = e >> 10, k = e & 1023; const int sc = src_col(1, n);
        const float ex = W[(size_t)k * 1984 + sc] * g[k]; const float st = bf2f(WT[(size_t)n * 1024 + k]);
        if (!(fabsf(st - ex) <= 0.01f * fabsf(ex) + 1e-5f)) atomicAdd(cnt + 8, 1u);
    }
    for (int row = blockIdx.x * 8 + wave; row < T; row += gridDim.x * 8) {
        int pos, seq; row_info(row, pos, seq);
        const float* xr = pos < 16 ? p.in[2] + (size_t)pos * 1024 : (seq < NBP ? p.in[0] + ((size_t)seq * 8192 + (pos - 16)) * 1024 : p.in[1] + ((size_t)(seq - NBP) * 2048 + (pos - 16)) * 1024);
        float ss = 0.f;
        for (int c = lane; c < 1024; c += 64) ss += xr[c] * xr[c];
        ss = wave_sum(ss);
        const float ex = rsqrtf(ss * (1.f / 1024.f) + EPS); const float st = R0[row];
        if (lane == 0 && !(fabsf(st - ex) <= 0.001f * ex)) { atomicAdd(cnt + 9, 1u); atomicAdd(cnt + 12, (unsigned)(row >> 6)); }
    }
}
#endif

#if DEBUG_CHECK == 10
__device__ __forceinline__ void check_x(const Params& p, int mode) {
    unsigned char* ws = launder(p.ws); unsigned* cnt = (unsigned*)(ws + OFF_DBGW); unsigned* sums = (unsigned*)(ws + OFF_DBGW + MiB);
    const int tid = tid_l(), lane = tid & 63, wave = tid >> 6;
    for (int n = blockIdx.x * 8 + wave; n < TN; n += gridDim.x * 8) {
        const unsigned* xr = (const unsigned*)(n < 65536 ? p.in[0] + (size_t)n * 1024 : p.in[1] + (size_t)(n - 65536) * 1024);
        unsigned a = 0u;
        for (int c = lane; c < 1024; c += 64) a += xr[c] * (2u * (unsigned)c + 1u);
#pragma unroll
        for (int o = 1; o < 64; o <<= 1) a += __shfl_xor(a, o);
        if (lane == 0) {
            if (mode == 0) __hip_atomic_store(sums + n, a, __ATOMIC_RELAXED, __HIP_MEMORY_SCOPE_AGENT);
            else if (__hip_atomic_load(sums + n, __ATOMIC_RELAXED, __HIP_MEMORY_SCOPE_AGENT) != a) atomicAdd(cnt + 8, 1u);
        }
    }
}
#endif

#if DEBUG_CHECK == 11
__device__ __forceinline__ void check_filt_prep(const Params& p) {
    unsigned char* ws = launder(p.ws); unsigned* cnt = (unsigned*)(ws + OFF_DBGW);
    const unsigned idx = blockIdx.x * 512u + (unsigned)tid_l();
    unsigned hsh = idx * 2654435761u + 1111u; hsh ^= hsh >> 15; hsh *= 2246822519u; hsh ^= hsh >> 13;
    {
        const int set = (int)(hsh & 1u); const int L = set ? LS : LP; const int C0 = set ? LGS : LGP;
        const int n = (int)((hsh >> 1) % 2048u); hsh = hsh * 3266489917u + 668265263u; hsh ^= hsh >> 16;
        const int t = (int)(hsh % (unsigned)L);
        const float* f_w1 = p.in[10]; const float* f_b1 = p.in[11]; const float* f_freq = p.in[12]; const float* f_w2 = p.in[13];
        const float* f_b2 = p.in[14]; const float* f_w3 = p.in[15]; const float* f_decay = p.in[16];
        const float tn = (float)t / (float)(L - 1); const float w = (6.2831853071795865f * (float)t) / (float)L;
        float acc = 0.f;
        for (int j2 = 0; j2 < 64; ++j2) {
            float a2 = f_b2[j2];
            for (int j1 = 0; j1 < 64; ++j1) {
                float a1 = f_b1[j1] + tn * f_w1[j1];
                for (int k = 0; k < 16; ++k) { const float f = 1e-4f + (float)k * ((15.0f - 1e-4f) / 15.0f); float sn, cs; sincos_red(f * w, sn, cs);
                    a1 += cs * f_w1[(1 + k) * 64 + j1] - sn * f_w1[(17 + k) * 64 + j1]; }
                a2 += sin_red(f_freq[j1] * a1) * f_w2[j1 * 64 + j2];
            }
            acc += sin_red(f_freq[j2] * a2) * f_w3[j2 * 2048 + n];
        }
        const float e = acc * __expf(-tn * fabsf(f_decay[n]));
        const int order = n >> 10, dir = (n >> 9) & 1, c = n & 511;
        if (!(dir == 1 && t == 0)) {
            const bf16_t* row = (const bf16_t*)(ws + (set ? OFF_GR1 : OFF_GR0)) + (size_t)(order * 512 + c) * (2 * C0);
            const float st = bf2f(row[dir ? C0 + t : C0 - t]);
            if (!(fabsf(st - e) <= 0.02f * fabsf(e) + 0.003f)) atomicAdd(cnt + 8, 1u);
        }
    }
    {
        const int seq = (int)(hsh % 40u); const int set = seq < NBP ? 0 : 1; const int L = set ? LS : LP; const int Lg = set ? LGS : LGP; const int NB = set ? NBS : NBP;
        const int b = set ? seq - NBP : seq; const int row0 = set ? TPR + b * LS : b * LP;
        hsh = hsh * 3266489917u + 668265263u; hsh ^= hsh >> 16;
        const int pos = (int)(hsh % (unsigned)L); const int which = (int)((hsh >> 16) % 3u); const int c = (int)((hsh >> 20) % 512u);
        const bf16_t* P = (const bf16_t*)(ws + OFF_P); const float* cw = p.in[9]; const int col = 448 + which * 512 + c;
        const float um = pos > 0 ? bf2f(P[(size_t)(row0 + pos - 1) * NPP + col]) : 0.f, u0 = bf2f(P[(size_t)(row0 + pos) * NPP + col]), up = pos + 1 < L ? bf2f(P[(size_t)(row0 + pos + 1) * NPP + col]) : 0.f;
        const float e = um * cw[which * 512 + c] + u0 * cw[1536 + which * 512 + c] + up * cw[3072 + which * 512 + c];
        const bf16_t* XT = (const bf16_t*)(ws + (which == 0 ? OFF_X1T : (which == 1 ? OFF_X2T : OFF_V0T))) + (set ? XT_SET1 : 0) + ((size_t)c * NB + b) * Lg;
        const float st = bf2f(XT[pos + 48]);
        if (!(fabsf(st - e) <= 0.02f * fabsf(e) + 0.02f)) atomicAdd(cnt + 9, 1u);
    }
}
#endif
#ifndef SUB_MASK
#define SUB_MASK 15
#endif
#ifndef PHASE_MASK
#define PHASE_MASK 1023
#endif
__global__ void __launch_bounds__(512) hymba_fwd(Params p) {
    extern __shared__ __attribute__((aligned(16))) unsigned char lds_raw[];
    LAS unsigned char* lds = (LAS unsigned char*)lds_raw;
    cg::grid_group grid = cg::this_grid();
#define GSYNC() do { asm volatile("s_waitcnt vmcnt(0) lgkmcnt(0)" ::: "memory"); __threadfence(); grid.sync(); } while (0)
    const int G = gridDim.x;
    __builtin_amdgcn_fence(__ATOMIC_SEQ_CST, "agent");
    asm volatile("buffer_inv sc1\n\ts_waitcnt vmcnt(0)" ::: "memory");
#if DEBUG_CHECK == 10
    check_x(p, 0);
#endif
#if PHASE_MASK & 1
    p0_prologue(p, lds);
#endif
    GSYNC();
#if DEBUG_CHECK == 3
    check_h0b(p, 8);
#endif
#if DEBUG_CHECK == 7
    check_h0b_full(p, 8);
#endif
#if DEBUG_CHECK == 4
    check_stale(p, (const unsigned*)(launder(p.ws) + OFF_H0B), (unsigned)((size_t)T * 512), 9);
#endif
#if PHASE_MASK & 2
    {
        unsigned char* ws = launder(p.ws); unsigned char* ob = launder((unsigned char*)p.out);
        pg8::Gemm g{(const bf16_t*)(ws + OFF_H0B), (const bf16_t*)(ws + OFF_WIN), TPAD, 2048, 1024, 1024, 1024};
        pg8::StaticOrder S; S.init(TPAD, 2048, G, blockIdx.x);
        Epi<0> E{(bf16_t*)(ws + OFF_P), NPP, (const float*)(ws + OFF_R0), (float*)(ws + OFF_SQQP), (float*)(ws + OFF_SQKVP), (bf16_t*)(ob + DO_KR), (const float2*)(ws + OFF_RT)};
        pg8::gemm_phase(lds, g, S, E);
    }
#endif
    GSYNC();
#if DEBUG_CHECK == 1
    { unsigned char* ws = launder(p.ws); check_gemm((const bf16_t*)(ws + OFF_H0B), 1024, (const bf16_t*)(ws + OFF_WIN), 1024, 1024, T, 1984, 0, (const bf16_t*)(ws + OFF_P), NPP, (const float*)(ws + OFF_R0), (unsigned*)(ws + OFF_DBG) + 0, 448); }
    GSYNC();
#endif
#if DEBUG_CHECK == 3
    check_h0b(p, 9);
#endif
#if DEBUG_CHECK == 8
    check_p_golden(p);
#endif
#if DEBUG_CHECK == 9
    check_win_r0(p);
#endif
#if DEBUG_CHECK == 7
    check_h0b_full(p, 9);
    GSYNC();
#endif
#if DEBUG_CHECK == 6
    { unsigned char* ws = launder(p.ws);
      check_gemm((const bf16_t*)(ws + OFF_H0B), 1024, (const bf16_t*)(ws + OFF_WIN), 1024, 1024, T, 448, 0, (const bf16_t*)(ws + OFF_P), NPP, (const float*)(ws + OFF_R0), (unsigned*)(ws + OFF_DBG) + 8, 384);
      check_gemm((const bf16_t*)(ws + OFF_H0B), 1024, (const bf16_t*)(ws + OFF_WIN), 1024, 1024, T, 384, 7, (const bf16_t*)(ws + OFF_P), NPP, (const float*)(ws + OFF_R0), (unsigned*)(ws + OFF_DBG) + 9, 0); }
    GSYNC();
#endif
#if DEBUG_CHECK == 4
    check_stale(p, (const unsigned*)(launder(p.ws) + OFF_P), (unsigned)((size_t)T * 1024), 8);
#endif
    rownorm_phase(p);
    krope_phase(p);
    GSYNC();
#if (PHASE_MASK & 4) && (SUB2 & 1)
    {
        unsigned char* ws = launder(p.ws); unsigned char* ob = launder((unsigned char*)p.out);
        pg8::Gemm g{(const bf16_t*)(ws + OFF_P), (const bf16_t*)(ws + OFF_WUQ), TPAD, 768, 256, NPP, 256};
        pg8::StaticOrder S; S.init(TPAD, 768, G, blockIdx.x);
        Epi<1> E{(bf16_t*)(ob + DO_Q), 768, (const float*)(ws + OFF_RQ), nullptr, nullptr, nullptr, (const float2*)(ws + OFF_RT)};
        pg8::gemm_phase(lds, g, S, E);
    }
#endif
#if (PHASE_MASK & 4) && (SUB2 & 2)
    {
        unsigned char* ws = launder(p.ws); unsigned char* ob = launder((unsigned char*)p.out);
        pg8::Gemm g{(const bf16_t*)(ws + OFF_P) + 256, (const bf16_t*)(ws + OFF_WKN), TPAD, 512, 128, NPP, 128};
        pg8::StaticOrder S; S.init(TPAD, 512, G, blockIdx.x);
        Epi<2> E{(bf16_t*)(ob + DO_KN), 512, (const float*)(ws + OFF_RKV), nullptr, nullptr, nullptr, nullptr};
        pg8::gemm_phase(lds, g, S, E);
    }
#endif
#if (PHASE_MASK & 4) && (SUB2 & 4)
    {
        unsigned char* ws = launder(p.ws); unsigned char* ob = launder((unsigned char*)p.out);
        pg8::Gemm g{(const bf16_t*)(ws + OFF_WV), (const bf16_t*)(ws + OFF_P) + 256, 512, TPAD, 128, 128, NPP};
        pg8::StaticOrder S; S.init(512, TPAD, G, blockIdx.x);
        Epi<3> E{(bf16_t*)(ob + DO_VT), TPAD, (const float*)(ws + OFF_RKV), nullptr, nullptr, nullptr, nullptr};
        pg8::gemm_phase(lds, g, S, E);
    }
#endif
#if PHASE_MASK & 8
    hyprep_phase(p, lds);
#endif
    GSYNC();
#if DEBUG_CHECK == 2
    check_proj(p);
    GSYNC();
#endif
#if DEBUG_CHECK == 11
    check_filt_prep(p);
    GSYNC();
#endif
#if PHASE_MASK & 16
    attn_phase(p, lds);
#endif
#if PHASE_MASK & 32
    hyena_phase(p, lds);
#endif
    GSYNC();
#if DEBUG_CHECK == 5
    check_attn(p);
    check_hyena(p, lds);
    GSYNC();
#endif
#if PHASE_MASK & 64
    mixnorm_phase(p, lds);
#endif
    GSYNC();
#if PHASE_MASK & 128
    {
        unsigned char* ws = launder(p.ws);
        pg8::Gemm g{(const bf16_t*)(ws + OFF_MIXN), (const bf16_t*)(ws + OFF_WO), TN, 1024, 1024, 1024, 1024};
        pg8::StaticOrder S; S.init(TN, 1024, G, blockIdx.x);
        Epi<4> E{(bf16_t*)(ws + OFF_MIX), 1024, nullptr, (float*)(ws + OFF_SQMIXP), nullptr, nullptr, nullptr};
        pg8::gemm_phase(lds, g, S, E);
    }
#endif
    GSYNC();
#if DEBUG_CHECK == 1
    { unsigned char* ws = launder(p.ws); check_gemm((const bf16_t*)(ws + OFF_MIXN), 1024, (const bf16_t*)(ws + OFF_WO), 1024, 1024, TN, 1024, 4, (const bf16_t*)(ws + OFF_MIX), 1024, nullptr, (unsigned*)(ws + OFF_DBG) + 1, 0); }
#endif
#if DEBUG_CHECK == 10
    check_x(p, 1);
#endif
#if PHASE_MASK & 256
    h1_phase(p);
#endif
    GSYNC();
#if PHASE_MASK & 512
#if DEBUG_CHECK == 1
#define DBG_FF1(half) if ((half) == 0) { unsigned char* ws = launder(p.ws); check_gemm((const bf16_t*)(ws + OFF_H1B), 1024, (const bf16_t*)(ws + OFF_WF1), 1024, 1024, 65536, 4096, 5, (const bf16_t*)(ws + OFF_M), 4096, (const float*)(ws + OFF_R1), (unsigned*)(ws + OFF_DBG) + 2, 0); }
#define DBG_FF2(half) if ((half) == 0) { unsigned char* ws = launder(p.ws); check_gemm((const bf16_t*)(ws + OFF_M), 4096, (const bf16_t*)(ws + OFF_WF2), 4096, 4096, 65536, 1024, 6, (const bf16_t*)(ws + OFF_M2), 1024, nullptr, (unsigned*)(ws + OFF_DBG) + 3, 0); } GSYNC();
#else
#define DBG_FF1(half)
#define DBG_FF2(half)
#endif
#define FFN_HALF(half) \
    { \
        unsigned char* ws = launder(p.ws); \
        pg8::Gemm g{(const bf16_t*)(ws + OFF_H1B) + (size_t)(half) * 65536 * 1024, (const bf16_t*)(ws + OFF_WF1), 65536, 4096, 1024, 1024, 1024}; \
        pg8::StaticOrder S; S.init(65536, 4096, G, blockIdx.x); \
        Epi<5> E{(bf16_t*)(ws + OFF_M), 4096, (const float*)(ws + OFF_R1) + (half) * 65536, nullptr, nullptr, nullptr, nullptr}; \
        pg8::gemm_phase(lds, g, S, E); \
    } \
    GSYNC(); \
    DBG_FF1(half) \
    { \
        unsigned char* ws = launder(p.ws); \
        pg8::Gemm g{(const bf16_t*)(ws + OFF_M), (const bf16_t*)(ws + OFF_WF2), 65536, 1024, 4096, 4096, 4096}; \
        pg8::StaticOrder S; S.init(65536, 1024, G, blockIdx.x); \
        Epi<6> E{(bf16_t*)(ws + OFF_M2), 1024, nullptr, (float*)(ws + OFF_SQM2P) + (size_t)(half) * 65536 * 16, nullptr, nullptr, nullptr}; \
        pg8::gemm_phase(lds, g, S, E); \
    } \
    GSYNC(); \
    DBG_FF2(half) \
    final_phase(p, half);
    FFN_HALF(0)
    FFN_HALF(1)
#undef FFN_HALF
#endif
}

extern "C" void kernel_launch(void* const* d_in, const int* in_sizes, int n_in, void* d_out, int out_size, void* d_ws, size_t ws_size, hipStream_t stream) {
    static int grid = 0;
    if (grid == 0) {
        int dev = 0, cus = 0, per_cu = 0;
        hipGetDevice(&dev);
        hipDeviceGetAttribute(&cus, hipDeviceAttributeMultiprocessorCount, dev);
        hipFuncSetAttribute((const void*)hymba_fwd, hipFuncAttributeMaxDynamicSharedMemorySize, LDS_BYTES);
        hipOccupancyMaxActiveBlocksPerMultiprocessor(&per_cu, (const void*)hymba_fwd, 512, LDS_BYTES);
        if (per_cu < 1) per_cu = 1;
        grid = cus * 1;
        if (n_in != 26 || ws_size < 1024 * MiB) fprintf(stderr, "kernel_launch: unexpected n_in %d / ws_size %zu\n", n_in, ws_size);
    }
    Params p{};
    for (int i = 0; i < 26; ++i) p.in[i] = (const float*)d_in[i];
    p.out = (float*)d_out; p.ws = (unsigned char*)d_ws;
    void* args[] = {&p};
    hipError_t e = hipLaunchCooperativeKernel((const void*)hymba_fwd, dim3(grid), dim3(512), args, LDS_BYTES, stream);
    if (e != hipSuccess) fprintf(stderr, "cooperative launch failed: %s (grid %d)\n", hipGetErrorString(e), grid);
}
```

```cpp
#include <hip/hip_runtime.h>
#include <hip/hip_cooperative_groups.h>
#include <cstdio>
#include <cstdint>
namespace cg = cooperative_groups;
#ifndef DBG_SEL0
#define DBG_SEL0 3
#endif
#ifndef DBG_SEL1
#define DBG_SEL1 0
#endif
#ifndef DEBUG_CHECK
#define DEBUG_CHECK 0
#endif
#ifndef EXPT
#define EXPT 0
#endif
#ifndef SUB_MASK
#define SUB_MASK 15
#endif
#ifndef SUB2
#define SUB2 7
#endif

#define LAS __attribute__((address_space(3)))
typedef unsigned short bf16_t;
typedef short bf16x8 __attribute__((ext_vector_type(8)));
typedef float f32x4 __attribute__((ext_vector_type(4)));
typedef float f32x16 __attribute__((ext_vector_type(16)));
typedef unsigned u32x4 __attribute__((ext_vector_type(4)));
typedef unsigned u32x2 __attribute__((ext_vector_type(2)));

constexpr int DM = 1024, LP = 8208, LS = 2064, NBP = 8, NBS = 32;
constexpr int TPR = NBP * LP;
constexpr int TSR = NBS * LS;
constexpr int T = TPR + TSR;
constexpr int TPAD = 131840;
constexpr int TN = 131072;
constexpr int NPP = 2048;
constexpr int LGP = 8256, LGS = 2112;
constexpr float EPS = 1e-6f;
constexpr float QSCALE = 0.07216878364870322f * 1.4426950408889634f;

constexpr size_t MiB = 1ull << 20;
constexpr size_t OFF_H0B = 0;
constexpr size_t XT_SET1 = (size_t)512 * NBP * LGP;
constexpr size_t OFF_X1T = 0;
constexpr size_t OFF_X2T = 131 * MiB;
constexpr size_t OFF_P = 262 * MiB;
constexpr size_t OFF_V0T = 778 * MiB;
constexpr size_t OFF_MIXN = 262 * MiB;
constexpr size_t OFF_MIX = 518 * MiB;
constexpr size_t OFF_H1B = 0;
constexpr size_t OFF_M = 256 * MiB;
constexpr size_t OFF_M2 = 768 * MiB;
constexpr size_t OFF_SQMIXP = 896 * MiB;
constexpr size_t OFF_SQM2P = 904 * MiB;
constexpr size_t OFF_SMALL = 912 * MiB;
constexpr size_t OFF_WIN = OFF_SMALL;
constexpr size_t OFF_WUQ = OFF_SMALL + 4 * MiB;
constexpr size_t OFF_WKN = OFF_SMALL + 4 * MiB + 512 * 1024;
constexpr size_t OFF_WV = OFF_SMALL + 4 * MiB + 768 * 1024;
constexpr size_t OFF_WO = OFF_SMALL + 5 * MiB;
constexpr size_t OFF_WF1 = OFF_SMALL + 7 * MiB;
constexpr size_t OFF_WF2 = OFF_SMALL + 15 * MiB;
constexpr size_t OFF_GR0 = OFF_SMALL + 23 * MiB;
constexpr size_t OFF_GR1 = OFF_SMALL + 56 * MiB;
constexpr size_t OFF_RT = OFF_SMALL + 65 * MiB;
constexpr size_t OFF_R0 = OFF_SMALL + 68 * MiB;
constexpr size_t OFF_R1 = OFF_SMALL + 69 * MiB;
constexpr size_t OFF_RQ = OFF_SMALL + 70 * MiB;
constexpr size_t OFF_RKV = OFF_SMALL + 71 * MiB;
constexpr size_t OFF_SQQP = OFF_SMALL + 72 * MiB;
constexpr size_t OFF_SQKVP = OFF_SMALL + 75 * MiB;
constexpr size_t OFF_DBGW = OFF_SMALL + 78 * MiB;
constexpr size_t DO_Q = 0;
constexpr size_t DO_KN = 194 * MiB;
constexpr size_t DO_KR = 323 * MiB;
constexpr size_t DO_VT = 340 * MiB;

constexpr size_t OFF_ODBG = 518 * MiB;
constexpr size_t OFF_HDBG = 647 * MiB;
constexpr int LDS_BYTES = 131072;

struct Params {
    const float* in[26];
    float* out;
    unsigned char* ws;
};

__device__ __forceinline__ f32x4 ld_sys(const float* q) { f32x4 v; asm volatile("global_load_dwordx4 %0, %1, off sc0 sc1\n\ts_waitcnt vmcnt(0)" : "=v"(v) : "v"(q) : "memory"); return v; }
__device__ __forceinline__ float ldco(const float* q) { return __builtin_bit_cast(float, __hip_atomic_load((const unsigned*)q, __ATOMIC_RELAXED, __HIP_MEMORY_SCOPE_AGENT)); }
__device__ __forceinline__ float2 ldco2(const float2* q) { const unsigned long long w = __hip_atomic_load((const unsigned long long*)q, __ATOMIC_RELAXED, __HIP_MEMORY_SCOPE_AGENT); return make_float2(__builtin_bit_cast(float, (unsigned)w), __builtin_bit_cast(float, (unsigned)(w >> 32))); }
template <class Tp> __device__ __forceinline__ Tp* launder(Tp* q) { asm volatile("" : "+s"(q)); return q; }
__device__ __forceinline__ int tid_l() { int t = threadIdx.x; asm volatile("" : "+v"(t)); return t; }
__device__ __forceinline__ unsigned cvt_pk_bf16(float lo, float hi) { unsigned r; asm volatile("v_cvt_pk_bf16_f32 %0, %1, %2" : "=v"(r) : "v"(lo), "v"(hi)); return r; }
__device__ __forceinline__ float bf2f(unsigned short b) { return __builtin_bit_cast(float, (unsigned)b << 16); }
__device__ __forceinline__ float bflo(unsigned w) { return __builtin_bit_cast(float, w << 16); }
__device__ __forceinline__ float bfhi(unsigned w) { return __builtin_bit_cast(float, w & 0xffff0000u); }
__device__ __forceinline__ float wave_sum(float v) {
#pragma unroll
    for (int o = 1; o < 64; o <<= 1) v += __shfl_xor(v, o);
    return v;
}
__device__ __forceinline__ void sincos_red(float x, float& s, float& c) {
    const double xd = (double)x; const double k = rint(xd * 0.15915494309189535); const float r = (float)(xd - k * 6.283185307179586);
    s = __sinf(r); c = __cosf(r);
}
__device__ __forceinline__ float sin_red(float x) { float s, c; sincos_red(x, s, c); return s; }
__device__ __forceinline__ void row_info(int r, int& pos, int& seq) {
    if (r < TPR) { seq = r / LP; pos = r - seq * LP; }
    else { int q = r - TPR; if (q >= TSR) q = TSR - 1; const int b = q / LS; pos = q - b * LS; seq = NBP + b; }
}
__device__ __forceinline__ int full_row(int n) {
    if (n < 65536) { const int b = n >> 13; return b * LP + 16 + (n & 8191); }
    const int q = n - 65536; const int b = q >> 11; return TPR + b * LS + 16 + (q & 2047);
}

namespace pg8 {
constexpr int BM = 256, BK = 64, HALF = 128, HTB = HALF * BK * 2, STAGE_BYTES = 8 * HTB, NXCD = 8, WGM = 8;
__host__ __device__ __forceinline__ int lds_byte(int r, int c) { const int st = (r >> 4) * 2 + (c >> 5), rr = r & 15, cc = c & 31, ob = rr * 64 + cc * 2; return st * 1024 + (ob ^ (((ob >> 9) & 1) << 5)); }
__host__ __device__ __forceinline__ void stage_rc(int b, int& R, int& C) { const int st = b / 1024, sb = b % 1024, swz = sb ^ (((sb >> 9) & 1) << 5); R = (st >> 1) * 16 + swz / 64; C = (st & 1) * 32 + (swz % 64) / 2; }
__host__ __device__ __forceinline__ int perm32(int rho) { const int n = rho >> 4, i = rho & 15; return 8 * (i >> 2) + 4 * n + (i & 3); }
struct Unit { int pm, pn; };
struct Gemm { const bf16_t* A; const bf16_t* Bt; int M, N, K, lda, ldb; };
struct StaticOrder {
    int nM, nN, nwg, G, c;
    __device__ void init(int M, int N, int G_, int c_) { nM = M / BM; nN = N / BM; nwg = nM * nN; G = G_; c = c_; }
    __device__ bool next(int i, Unit& u) const {
        const long L = (long)i * G + c; if (L >= nwg) return false;
        int wgid = (int)L; { const int q = nwg / NXCD, r = nwg % NXCD, xcd = wgid % NXCD, off = wgid / NXCD; wgid = (xcd < r ? xcd * (q + 1) : r * (q + 1) + (xcd - r) * q) + off; }
        const int nig = WGM * nN, gid = wgid / nig, fm = gid * WGM, gsz = (nM - fm) < WGM ? (nM - fm) : WGM;
        u.pm = fm + ((wgid % nig) % gsz); u.pn = (wgid % nig) / gsz; return true;
    }
};
template <class Epi>
__device__ __forceinline__ void gemm_phase(LAS unsigned char* lds, const Gemm g, const StaticOrder& S, const Epi& E) {
    const int tid = tid_l(), wid = __builtin_amdgcn_readfirstlane(tid >> 6), lane = tid & 63, wr = wid >> 2, wc = wid & 3, fr = lane & 15, fq = lane >> 4;
    const int K = g.K, nt = K / BK;
    unsigned voffA[2], voffB[2];
#pragma unroll
    for (int i = 0; i < 2; ++i) { int R, C; stage_rc(tid * 16 + i * 8192, R, C); const int Rb = (R & ~31) + perm32(R & 31);
        voffA[i] = (unsigned)(R * g.lda + C) * 2u; voffB[i] = (unsigned)(Rb * g.ldb + C) * 2u; }
    const size_t kstep = (size_t)(BK * 2);
    const size_t hstepA = (size_t)HALF * g.lda * 2, hstepB = (size_t)HALF * g.ldb * 2;
    const size_t tstepA = 2 * hstepA, tstepB = 2 * hstepB;
    const unsigned ldsw = (unsigned)wid * 1024u;
    const int aoff = lds_byte(wr * 64 + fr, fq * 8), boff = lds_byte(wc * 32 + fr, fq * 8);
#define PG8_SA(b, h) (((b) * 2 + (h)) * HTB)
#define PG8_SB(b, h) ((4 + (b) * 2 + (h)) * HTB)
#define PG8_STAGE(bufoff, gbase, voff) do { _Pragma("unroll") for (int _i = 0; _i < 2; ++_i) \
        __builtin_amdgcn_global_load_lds((const unsigned*)((const char*)(gbase) + (voff)[_i]), (LAS unsigned*)(lds + (bufoff) + ldsw + _i * 8192), 16, 0, 0); } while (0)
#define PG8_LDA(dst, b, h) do { _Pragma("unroll") for (int m = 0; m < 4; ++m) _Pragma("unroll") for (int k = 0; k < 2; ++k) dst[m][k] = *(const LAS bf16x8*)(lds + PG8_SA(b, h) + aoff + m * 2048 + k * 1024); } while (0)
#define PG8_LDB(dst, b, h) do { _Pragma("unroll") for (int n = 0; n < 2; ++n) _Pragma("unroll") for (int k = 0; k < 2; ++k) dst[n][k] = *(const LAS bf16x8*)(lds + PG8_SB(b, h) + boff + n * 2048 + k * 1024); } while (0)
#define PG8_MMA(ai, bj, At, Bt) do { __builtin_amdgcn_s_setprio(1); _Pragma("unroll") for (int m = 0; m < 4; ++m) _Pragma("unroll") for (int n = 0; n < 2; ++n) _Pragma("unroll") for (int k = 0; k < 2; ++k) \
        acc[ai][bj][m][n] = __builtin_amdgcn_mfma_f32_16x16x32_bf16(Bt[n][k], At[m][k], acc[ai][bj][m][n], 0, 0, 0); __builtin_amdgcn_s_setprio(0); } while (0)
#define PG8_WAIT_V(n) asm volatile("s_waitcnt vmcnt(" #n ")" ::: "memory")
#define PG8_WAIT_L(n) asm volatile("s_waitcnt lgkmcnt(" #n ")" ::: "memory")
#define PG8_BAR __builtin_amdgcn_s_barrier()
#define PG8_SCHED __builtin_amdgcn_sched_barrier(0)
    Unit cur, nxt; int ui = 0;
    if (!S.next(0, cur)) return;
    f32x4 acc[2][2][4][2];
#pragma unroll
    for (int a = 0; a < 2; ++a)
#pragma unroll
        for (int b = 0; b < 2; ++b)
#pragma unroll
            for (int m = 0; m < 4; ++m)
#pragma unroll
                for (int n = 0; n < 2; ++n) acc[a][b][m][n] = (f32x4){0.f, 0.f, 0.f, 0.f};
    bf16x8 At[4][2], B0[2][2], B1[2][2];
    const char* cA = (const char*)g.A + (size_t)cur.pm * tstepA; const char* cB = (const char*)g.Bt + (size_t)cur.pn * tstepB;
    PG8_STAGE(PG8_SB(0, 0), cB, voffB); PG8_STAGE(PG8_SB(0, 1), cB + hstepB, voffB); PG8_STAGE(PG8_SA(0, 0), cA, voffA); PG8_STAGE(PG8_SA(0, 1), cA + hstepA, voffA);
    if (wr == 1) PG8_BAR;
    PG8_WAIT_V(2); PG8_BAR;
    PG8_STAGE(PG8_SB(1, 0), cB + kstep, voffB); PG8_STAGE(PG8_SA(1, 0), cA + kstep, voffA); PG8_STAGE(PG8_SB(1, 1), cB + hstepB + kstep, voffB);
    PG8_WAIT_V(6); PG8_BAR;
    for (;;) {
        const bool has_next = S.next(ui + 1, nxt);
        const char* nA = has_next ? (const char*)g.A + (size_t)nxt.pm * tstepA : cA; const char* nB = has_next ? (const char*)g.Bt + (size_t)nxt.pn * tstepB : cB;
        for (int t = 0; t < nt; t += 2) {
            const bool last = (t == nt - 2);
            const char* a1 = cA + (size_t)(t + 1) * kstep;
            const char* a2 = last ? nA : cA + (size_t)(t + 2) * kstep; const char* b2 = last ? nB : cB + (size_t)(t + 2) * kstep;
            const char* a3 = a2 + kstep; const char* b3 = b2 + kstep;
            PG8_LDB(B0, 0, 0); PG8_LDB(B1, 0, 1); PG8_SCHED; PG8_LDA(At, 0, 0); PG8_STAGE(PG8_SA(1, 1), a1 + hstepA, voffA);
            PG8_WAIT_V(8); PG8_WAIT_L(0); PG8_BAR; PG8_MMA(0, 0, At, B0); PG8_MMA(0, 1, At, B1); PG8_BAR; PG8_SCHED;
            PG8_LDA(At, 0, 1); PG8_STAGE(PG8_SB(0, 0), b2, voffB); PG8_STAGE(PG8_SB(0, 1), b2 + hstepB, voffB); PG8_STAGE(PG8_SA(0, 0), a2, voffA);
            PG8_WAIT_V(8); PG8_WAIT_L(0); PG8_BAR; PG8_MMA(1, 0, At, B0); PG8_MMA(1, 1, At, B1); PG8_BAR; PG8_SCHED;
            PG8_LDB(B0, 1, 0); PG8_LDB(B1, 1, 1); PG8_SCHED; PG8_LDA(At, 1, 0); PG8_STAGE(PG8_SA(0, 1), a2 + hstepA, voffA);
            PG8_WAIT_V(8); PG8_WAIT_L(0); PG8_BAR; PG8_MMA(0, 0, At, B0); PG8_MMA(0, 1, At, B1); PG8_BAR; PG8_SCHED;
            PG8_LDA(At, 1, 1); PG8_STAGE(PG8_SB(1, 0), b3, voffB); PG8_STAGE(PG8_SB(1, 1), b3 + hstepB, voffB); PG8_STAGE(PG8_SA(1, 0), a3, voffA);
            PG8_WAIT_V(8); PG8_WAIT_L(0); PG8_BAR; PG8_MMA(1, 0, At, B0); PG8_MMA(1, 1, At, B1); PG8_BAR; PG8_SCHED;
        }
        if (wr == 0) PG8_BAR;
        E(acc, cur, wr, wc, fr, fq);
        if (!has_next) break;
#pragma unroll
        for (int a = 0; a < 2; ++a)
#pragma unroll
            for (int b = 0; b < 2; ++b)
#pragma unroll
                for (int m = 0; m < 4; ++m)
#pragma unroll
                    for (int n = 0; n < 2; ++n) acc[a][b][m][n] = (f32x4){0.f, 0.f, 0.f, 0.f};
        cur = nxt; cA = nA; cB = nB; ++ui;
        if (wr == 1) PG8_BAR;
    }
    PG8_WAIT_V(0);
    PG8_BAR;
#undef PG8_SA
#undef PG8_SB
#undef PG8_STAGE
#undef PG8_LDA
#undef PG8_LDB
#undef PG8_MMA
#undef PG8_WAIT_V
#undef PG8_WAIT_L
#undef PG8_BAR
#undef PG8_SCHED
}
}

__device__ __forceinline__ void rope8(f32x4& v0, f32x4& v1, const float2* rt  ) {
    const float2 c0 = ldco2(rt), c1 = ldco2(rt + 1), c2 = ldco2(rt + 2), c3 = ldco2(rt + 3);
    float a, b;
    a = v0[0]; b = v0[1]; v0[0] = a * c0.x - b * c0.y; v0[1] = b * c0.x + a * c0.y;
    a = v0[2]; b = v0[3]; v0[2] = a * c1.x - b * c1.y; v0[3] = b * c1.x + a * c1.y;
    a = v1[0]; b = v1[1]; v1[0] = a * c2.x - b * c2.y; v1[1] = b * c2.x + a * c2.y;
    a = v1[2]; b = v1[3]; v1[2] = a * c3.x - b * c3.y; v1[3] = b * c3.x + a * c3.y;
}
__device__ __forceinline__ u32x4 pack8(const f32x4& v0, const f32x4& v1) {
    u32x4 w; w.x = cvt_pk_bf16(v0[0], v0[1]); w.y = cvt_pk_bf16(v0[2], v0[3]); w.z = cvt_pk_bf16(v1[0], v1[1]); w.w = cvt_pk_bf16(v1[2], v1[3]); return w;
}
__device__ __forceinline__ float sq8(const f32x4& a, const f32x4& b) {
    return (a[0] * a[0] + a[1] * a[1]) + (a[2] * a[2] + a[3] * a[3]) + (b[0] * b[0] + b[1] * b[1]) + (b[2] * b[2] + b[3] * b[3]);
}
template <int MODE> struct Epi {
    bf16_t* O; int ldc; const float* rs; float* sq0; float* sq1; bf16_t* KR; const float2* RT;
    __device__ __forceinline__ void operator()(const f32x4 (&acc)[2][2][4][2], const pg8::Unit& u, int wr, int wc, int fr, int fq) const {
#pragma unroll
        for (int ai = 0; ai < 2; ++ai)
#pragma unroll
            for (int m = 0; m < 4; ++m) {
                const int row = u.pm * 256 + ai * 128 + wr * 64 + m * 16 + fr;
                float sc = 1.f;
                if (MODE == 0 || MODE == 1 || MODE == 2 || MODE == 5) sc = ldco(rs + row);
                float ssum[2];
#pragma unroll
                for (int bj = 0; bj < 2; ++bj) {
                    const int col0 = u.pn * 256 + bj * 128 + wc * 32 + 8 * fq;
                    f32x4 v0 = acc[ai][bj][m][0] * sc, v1 = acc[ai][bj][m][1] * sc;
                    if (MODE == 3) {
#pragma unroll
                        for (int j = 0; j < 4; ++j) { v0[j] *= ldco(rs + col0 + j); v1[j] *= ldco(rs + col0 + 4 + j); }
                    }
                    if (MODE == 5) {
#pragma unroll
                        for (int j = 0; j < 4; ++j) { const float a = fmaxf(v0[j], 0.f), b = fmaxf(v1[j], 0.f); v0[j] = a * a; v1[j] = b * b; }
                    }
                    ssum[bj] = sq8(v0, v1);
                    *(u32x4*)(O + (size_t)row * ldc + col0) = pack8(v0, v1);
                }
                if (MODE == 0) {
                    if (u.pn == 0) { float s = ssum[0] + ssum[1]; s += __shfl_xor(s, 16); s += __shfl_xor(s, 32); if (fq == 0) sq0[row * 4 + wc] = s; }
                    else if (u.pn == 1) { float s = ssum[0]; s += __shfl_xor(s, 16); s += __shfl_xor(s, 32); if (fq == 0) sq1[row * 4 + wc] = s; }
                }
                if (MODE == 4 || MODE == 6) { float s = ssum[0] + ssum[1]; s += __shfl_xor(s, 16); s += __shfl_xor(s, 32); if (fq == 0) sq0[(size_t)row * 16 + u.pn * 4 + wc] = s; }
            }
    }
};

__device__ __forceinline__ int src_col(int mode, int n) {
    if (mode == 0) return n;
    if (mode == 1) { if (n >= 1984) return -1; if (n >= 384 && n < 448) { const int j = n - 384; return 384 + ((j & 1) ? 32 + (j >> 1) : (j >> 1)); } return n; }
    if (mode == 2) { const int h = n / 192, w = n % 192; if (w < 128) return n; const int j = w - 128; return h * 192 + 128 + ((j & 1) ? 32 + (j >> 1) : (j >> 1)); }
    if (mode == 3) return (n >> 7) * 256 + (n & 127);
    return (n >> 7) * 256 + 128 + (n & 127);
}
__device__ __forceinline__ void conv_weight(const float* W, const float* g, bf16_t* out, int K, int Nsrc, int Nout, int mode, int gtid, int gthreads) {
    const int nch = Nout * (K / 8);
    for (int e = gtid; e < nch; e += gthreads) {
        const int n = e % Nout, kc = e / Nout, k0 = kc * 8; const int sc = src_col(mode, n);
        float v[8];
#pragma unroll
        for (int j = 0; j < 8; ++j) v[j] = (sc >= 0) ? W[(size_t)(k0 + j) * Nsrc + sc] * (g ? g[k0 + j] : 1.f) : 0.f;
        u32x4 w; w.x = cvt_pk_bf16(v[0], v[1]); w.y = cvt_pk_bf16(v[2], v[3]); w.z = cvt_pk_bf16(v[4], v[5]); w.w = cvt_pk_bf16(v[6], v[7]);
        *(u32x4*)(out + (size_t)n * K + k0) = w;
    }
}

__device__ __forceinline__ void p0_prologue(const Params& p, LAS unsigned char* lds) {
    unsigned char* ws = launder(p.ws);
    const int tid = tid_l(), lane = tid & 63, wave = tid >> 6, G = gridDim.x;
    const int gtid = blockIdx.x * 512 + tid, gthreads = G * 512;
    const int gw = blockIdx.x * 8 + wave, NGW = G * 8;
#if SUB_MASK & 1
    conv_weight(p.in[4], p.in[3], (bf16_t*)(ws + OFF_WIN), 1024, 1984, 2048, 1, gtid, gthreads);
    conv_weight(p.in[6], p.in[5], (bf16_t*)(ws + OFF_WUQ), 256, 768, 768, 2, gtid, gthreads);
    conv_weight(p.in[8], p.in[7], (bf16_t*)(ws + OFF_WKN), 128, 1024, 512, 3, gtid, gthreads);
    conv_weight(p.in[8], p.in[7], (bf16_t*)(ws + OFF_WV), 128, 1024, 512, 4, gtid, gthreads);
    conv_weight(p.in[20], nullptr, (bf16_t*)(ws + OFF_WO), 1024, 1024, 1024, 0, gtid, gthreads);
    conv_weight(p.in[23], p.in[22], (bf16_t*)(ws + OFF_WF1), 1024, 4096, 4096, 0, gtid, gthreads);
    conv_weight(p.in[24], nullptr, (bf16_t*)(ws + OFF_WF2), 4096, 1024, 1024, 0, gtid, gthreads);
#endif
#if SUB_MASK & 2
#if DEBUG_CHECK
    if (blockIdx.x == 0 && tid < 64) ((unsigned*)(ws + OFF_DBGW))[tid] = 0u;
#endif
    {
        float2* RT = (float2*)(ws + OFF_RT);
        for (int e = gtid; e < LP * 32; e += gthreads) {
            const int pos = e >> 5, i = e & 31;
            const float inv = 1.0f / exp2f((float)i * (13.287712379549449f / 32.f));
            float s, c; sincos_red((float)pos * inv, s, c);
            RT[e] = make_float2(c, s);
        }
    }
#endif
#if SUB_MASK & 4
    {
        bf16_t* h0b = (bf16_t*)(ws + OFF_H0B); float* r0 = (float*)(ws + OFF_R0);
        for (int r = gw; r < TPAD; r += NGW) {
            u32x2* o = (u32x2*)(h0b + (size_t)r * 1024) + lane;
            if (r >= T) {
#pragma unroll
                for (int j = 0; j < 4; ++j) o[64 * j] = (u32x2){0u, 0u};
                if (lane == 0) __hip_atomic_store(r0 + r, 0.f, __ATOMIC_RELAXED, __HIP_MEMORY_SCOPE_AGENT);
                continue;
            }
            int pos, seq; row_info(r, pos, seq);
            const float* src = pos < 16 ? p.in[2] + (size_t)pos * 1024
                                        : (seq < NBP ? p.in[0] + ((size_t)seq * 8192 + (pos - 16)) * 1024 : p.in[1] + ((size_t)(seq - NBP) * 2048 + (pos - 16)) * 1024);
            const f32x4* xr = (const f32x4*)src + lane;
            f32x4 v[4]; float ss = 0.f;
#pragma unroll
            for (int j = 0; j < 4; ++j) { v[j] = xr[64 * j]; ss += (v[j][0] * v[j][0] + v[j][1] * v[j][1]) + (v[j][2] * v[j][2] + v[j][3] * v[j][3]); }
            ss = wave_sum(ss);
#pragma unroll
            for (int j = 0; j < 4; ++j) o[64 * j] = (u32x2){cvt_pk_bf16(v[j][0], v[j][1]), cvt_pk_bf16(v[j][2], v[j][3])};
            if (lane == 0) __hip_atomic_store(r0 + r, rsqrtf(ss * (1.f / 1024.f) + EPS), __ATOMIC_RELAXED, __HIP_MEMORY_SCOPE_AGENT);
        }
    }
#endif
#if SUB_MASK & 8
    {
        const float* f_w1 = p.in[10]; const float* f_b1 = p.in[11]; const float* f_freq = p.in[12]; const float* f_w2 = p.in[13];
        const float* f_b2 = p.in[14]; const float* f_w3 = p.in[15]; const float* f_decay = p.in[16];
        LAS float* feats = (LAS float*)lds;
        LAS float* h1 = feats + 16 * 34;
        LAS float* h2 = h1 + 16 * 64;
        for (int u = blockIdx.x; u < 513 + 129; u += G) {
            const int set = u < 513 ? 0 : 1; const int t0 = 16 * (set ? u - 513 : u); const int L = set ? LS : LP; const int C0 = set ? LGS : LGP;
            bf16_t* GR = (bf16_t*)(ws + (set ? OFF_GR1 : OFF_GR0));
            const float invLm1 = 1.0f / (float)(L - 1);
            if (tid < 256) {
                const int tt = tid >> 4, k = tid & 15; const int t = t0 + tt;
                const float w = (6.2831853071795865f * (float)t) / (float)L;
                const float f = 1e-4f + (float)k * ((15.0f - 1e-4f) / 15.0f);
                float s, c; sincos_red(f * w, s, c);
                feats[tt * 34 + 1 + k] = c; feats[tt * 34 + 17 + k] = -s;
                if (k == 0) feats[tt * 34] = (float)t * invLm1;
            }
            __syncthreads();
#pragma unroll 1
            for (int q = 0; q < 2; ++q) {
                const int o = tid + 512 * q, tt = o >> 6, j = o & 63;
                float a = f_b1[j];
#pragma unroll 3
                for (int e = 0; e < 33; ++e) a += feats[tt * 34 + e] * f_w1[e * 64 + j];
                h1[tt * 64 + j] = sin_red(f_freq[j] * a);
            }
            __syncthreads();
#pragma unroll 1
            for (int q = 0; q < 2; ++q) {
                const int o = tid + 512 * q, tt = o >> 6, j = o & 63;
                float a = f_b2[j];
#pragma unroll 4
                for (int e = 0; e < 64; ++e) a += h1[tt * 64 + e] * f_w2[e * 64 + j];
                h2[tt * 64 + j] = sin_red(f_freq[j] * a);
            }
            __syncthreads();
#pragma unroll 1
            for (int q = 0; q < 4; ++q) {
                const int n = tid + 512 * q;
                float a[16];
#pragma unroll
                for (int i = 0; i < 16; ++i) a[i] = 0.f;
#pragma unroll 2
                for (int j = 0; j < 64; ++j) {
                    const float w = f_w3[j * 2048 + n];
#pragma unroll
                    for (int i = 0; i < 16; ++i) a[i] += h2[i * 64 + j] * w;
                }
                const float dec = fabsf(f_decay[n]);
                const int order = n >> 10, dir = (n >> 9) & 1, c = n & 511;
                bf16_t* row = GR + (size_t)(order * 512 + c) * (2 * C0);
#pragma unroll
                for (int i = 0; i < 16; ++i) {
                    const int t = t0 + i;
                    const float val = a[i] * __expf(-((float)t * invLm1) * dec);
                    const unsigned short b = (unsigned short)(cvt_pk_bf16(val, 0.f) & 0xffffu);
                    if (dir == 0) row[C0 - t] = b; else if (t > 0) row[C0 + t] = b;
                }
            }
            __syncthreads();
        }
        for (int e = gtid; e < 2 * 1024 * 97; e += gthreads) {
            const int set = e / (1024 * 97), r = (e / 97) % 1024, i = e % 97; const int L = set ? LS : LP; const int C0 = set ? LGS : LGP;
            bf16_t* row = (bf16_t*)(ws + (set ? OFF_GR1 : OFF_GR0)) + (size_t)r * (2 * C0);
            const int idx = i < 49 ? i : C0 + L + (i - 49);
            row[idx] = 0;
        }
    }
#endif
}

__device__ __forceinline__ void rownorm_phase(const Params& p) {
    unsigned char* ws = launder(p.ws); const int gtid = blockIdx.x * 512 + tid_l(), gthreads = gridDim.x * 512;
    const float* sqq = (const float*)(ws + OFF_SQQP); const float* sqkv = (const float*)(ws + OFF_SQKVP);
    float* rq = (float*)(ws + OFF_RQ); float* rkv = (float*)(ws + OFF_RKV);
    for (int r = gtid; r < TPAD; r += gthreads) {
        const float a = (ldco(sqq + r * 4) + ldco(sqq + r * 4 + 1)) + (ldco(sqq + r * 4 + 2) + ldco(sqq + r * 4 + 3));
        const float b = (ldco(sqkv + r * 4) + ldco(sqkv + r * 4 + 1)) + (ldco(sqkv + r * 4 + 2) + ldco(sqkv + r * 4 + 3));
        rq[r] = rsqrtf(a * (1.f / 256.f) + EPS) * QSCALE; rkv[r] = rsqrtf(b * (1.f / 128.f) + EPS);
    }
}
__device__ __forceinline__ void krope_phase(const Params& p) {
    unsigned char* ws = launder(p.ws); unsigned char* ob = launder((unsigned char*)p.out);
    const int gtid = blockIdx.x * 512 + tid_l(), gthreads = gridDim.x * 512;
    const bf16_t* P = (const bf16_t*)(ws + OFF_P); bf16_t* KR = (bf16_t*)(ob + DO_KR); const float2* RT = (const float2*)(ws + OFF_RT);
    for (int e = gtid; e < TPAD * 8; e += gthreads) {
        const int row = e >> 3, ch = e & 7;
        int pos, seq; row_info(row, pos, seq);
        const u32x4 v = *(const u32x4*)(P + (size_t)row * NPP + 384 + ch * 8);
        f32x4 v0 = (f32x4){bflo(v.x), bfhi(v.x), bflo(v.y), bfhi(v.y)}, v1 = (f32x4){bflo(v.z), bfhi(v.z), bflo(v.w), bfhi(v.w)};
        rope8(v0, v1, RT + pos * 32 + ch * 4);
        *(u32x4*)(KR + (size_t)row * 64 + ch * 8) = pack8(v0, v1);
    }
}
__device__ __forceinline__ void hyprep_phase(const Params& p, LAS unsigned char* lds) {
    unsigned char* ws = launder(p.ws); const int tid = tid_l(), G = gridDim.x;
    const bf16_t* P = (const bf16_t*)(ws + OFF_P); const float* conv_w = p.in[9];
    constexpr int RSB = 1040;
    for (int u = blockIdx.x; u < 3096 + 3168; u += G) {
        int seq, j, which;
        if (u < 3096) { seq = u / 387; const int rem = u % 387; j = rem / 3; which = rem % 3; }
        else { const int v = u - 3096; seq = NBP + v / 99; const int rem = v % 99; j = rem / 3; which = rem % 3; }
        const int set = seq < NBP ? 0 : 1; const int L = set ? LS : LP; const int Lg = set ? LGS : LGP; const int NB = set ? NBS : NBP;
        const int b = set ? seq - NBP : seq; const int row0 = set ? TPR + b * LS : b * LP;
        const int posb = 64 * j - 49;
        for (int i = 0; i < 9; ++i) {
            const int id = tid + 512 * i; if (id >= 66 * 64) break;
            const int rr = id >> 6, ch = id & 63; const int pos = posb + rr;
            u32x4 v = (u32x4){0u, 0u, 0u, 0u};
            if (pos >= 0 && pos < L) v = *(const u32x4*)(P + (size_t)(row0 + pos) * NPP + 448 + which * 512 + ch * 8);
            *(LAS u32x4*)(lds + rr * RSB + ch * 16) = v;
        }
        __syncthreads();
        {
            const int c = tid; const float w0 = conv_w[which * 512 + c], w1 = conv_w[1536 + which * 512 + c], w2 = conv_w[3072 + which * 512 + c];
            bf16_t* XT = (bf16_t*)(ws + (which == 0 ? OFF_X1T : (which == 1 ? OFF_X2T : OFF_V0T))) + (set ? XT_SET1 : 0) + ((size_t)c * NB + b) * Lg + 64 * j;
            const LAS unsigned short* tl = (const LAS unsigned short*)lds + c;
            float prev = bf2f(tl[0]), cur = bf2f(tl[RSB / 2]);
            for (int o8 = 0; o8 < 8; ++o8) {
                float r[8];
#pragma unroll
                for (int k = 0; k < 8; ++k) {
                    const int o = o8 * 8 + k; const float nxt = bf2f(tl[(o + 2) * (RSB / 2)]);
                    const int pos = posb + 1 + o;
                    r[k] = (pos >= 0 && pos < L) ? (prev * w0 + cur * w1 + nxt * w2) : 0.f;
                    prev = cur; cur = nxt;
                }
                u32x4 w; w.x = cvt_pk_bf16(r[0], r[1]); w.y = cvt_pk_bf16(r[2], r[3]); w.z = cvt_pk_bf16(r[4], r[5]); w.w = cvt_pk_bf16(r[6], r[7]);
                *(u32x4*)(XT + o8 * 8) = w;
            }
        }
        __syncthreads();
    }
}

__device__ __forceinline__ f32x16 mfma32(bf16x8 a, bf16x8 b, f32x16 c) { return __builtin_amdgcn_mfma_f32_32x32x16_bf16(a, b, c, 0, 0, 0); }

__device__ __forceinline__ void attn_phase(const Params& p, LAS unsigned char* lds) {
    const int tid = tid_l(), lane = tid & 63, wave = tid >> 6, G = gridDim.x, h = lane >> 5, l32 = lane & 31;
    unsigned char* ob = launder((unsigned char*)p.out);
    bf16_t* Q = (bf16_t*)(ob + DO_Q);
    const bf16_t* KN = (const bf16_t*)(ob + DO_KN);
    const bf16_t* KR = (const bf16_t*)(ob + DO_KR);
    const bf16_t* VT = (const bf16_t*)(ob + DO_VT);
    constexpr int KROW = 400, VROW = 136, KBYTES = 64 * KROW, BUFB = KBYTES + 128 * VROW;
    for (int u = blockIdx.x; u < 2048; u += G) {
        int seq, head, qb;
        if (u < 1024) { seq = u >> 7; head = (u >> 5) & 3; qb = u & 31; } else { const int v = u - 1024; seq = NBP + (v >> 5); head = (v >> 3) & 3; qb = v & 7; }
        const int L = seq < NBP ? LP : LS; const int row0 = seq < NBP ? seq * LP : TPR + (seq - NBP) * LS;
        const int ntiles = (L + 63) >> 6;
        const int qrow = row0 + 16 + qb * 256 + wave * 32 + l32;
        bf16x8 qf[12];
#pragma unroll
        for (int ks = 0; ks < 12; ++ks) qf[ks] = *(const bf16x8*)(Q + (size_t)qrow * 768 + head * 192 + 16 * ks + 8 * h);
        {
            const float2* RT = (const float2*)(launder(p.ws) + OFF_RT);
            const int qpos = 16 + qb * 256 + wave * 32 + l32;
#pragma unroll
            for (int ks = 8; ks < 12; ++ks) {
                const u32x4 v = __builtin_bit_cast(u32x4, qf[ks]);
                f32x4 v0 = (f32x4){bflo(v.x), bfhi(v.x), bflo(v.y), bfhi(v.y)}, v1 = (f32x4){bflo(v.z), bfhi(v.z), bflo(v.w), bfhi(v.w)};
                rope8(v0, v1, RT + qpos * 32 + 8 * (ks - 8) + 4 * h);
                qf[ks] = __builtin_bit_cast(bf16x8, pack8(v0, v1));
            }
        }
        const int kkey0 = tid >> 4, kch0 = tid & 15;
        const int rkey = tid >> 3, rch = tid & 7;
        const int vdv0 = tid >> 3, vch = tid & 7;
        const unsigned kn_off = (unsigned)(kkey0 * 512 + head * 128 + kch0 * 8) * 2u;
        const unsigned kr_off = (unsigned)(rkey * 64 + rch * 8) * 2u;
        const unsigned vt_off = (unsigned)(vdv0 * TPAD + vch * 8) * 2u;
        const unsigned char* knb = (const unsigned char*)KN + (size_t)row0 * 1024;
        const unsigned char* krb = (const unsigned char*)KR + (size_t)row0 * 128;
        const unsigned char* vtb = (const unsigned char*)VT + ((size_t)head * 128 * TPAD + row0) * 2;
        u32x4 g0, g1, g2, g3, g4;
#define ATT_LOAD(tile) do { const unsigned char* kb__ = knb + (size_t)(tile) * 65536; const unsigned char* rb__ = krb + (size_t)(tile) * 8192; const unsigned char* vb__ = vtb + (size_t)(tile) * 128; \
        g0 = *(const u32x4*)(kb__ + kn_off); g1 = *(const u32x4*)(kb__ + 32768 + kn_off); \
        g2 = *(const u32x4*)(rb__ + kr_off); (void)vb__; } while (0)
#define ATT_LOADV(tile) do { const unsigned char* vb__ = vtb + (size_t)(tile) * 128; g3 = *(const u32x4*)(vb__ + vt_off); g4 = *(const u32x4*)(vb__ + (size_t)64 * TPAD * 2 + vt_off); } while (0)
#define ATT_STOREK(buf) do { LAS unsigned char* kb_ = lds + (buf) * BUFB; \
        *(LAS u32x4*)(kb_ + kkey0 * KROW + kch0 * 16) = g0; *(LAS u32x4*)(kb_ + (kkey0 + 32) * KROW + kch0 * 16) = g1; \
        *(LAS u32x4*)(kb_ + rkey * KROW + 256 + rch * 16) = g2; } while (0)
#define ATT_STORE(buf) do { LAS unsigned char* vb_ = lds + (buf) * BUFB + KBYTES; \
        *(LAS u32x2*)(vb_ + vdv0 * VROW + vch * 16) = (u32x2){g3.x, g3.y}; *(LAS u32x2*)(vb_ + vdv0 * VROW + vch * 16 + 8) = (u32x2){g3.z, g3.w}; \
        *(LAS u32x2*)(vb_ + (vdv0 + 64) * VROW + vch * 16) = (u32x2){g4.x, g4.y}; *(LAS u32x2*)(vb_ + (vdv0 + 64) * VROW + vch * 16 + 8) = (u32x2){g4.z, g4.w}; } while (0)
        ATT_LOAD(0); ATT_LOADV(0); ATT_STOREK(0); ATT_STORE(0);
        __syncthreads();
        f32x16 o[4];
#pragma unroll
        for (int d = 0; d < 4; ++d)
#pragma unroll
            for (int r = 0; r < 16; ++r) o[d][r] = 0.f;
        float m_run = -INFINITY, l_run = 0.f;
        for (int j = 0; j < ntiles; ++j) {
            const int buf = j & 1;
            if (j + 1 < ntiles) ATT_LOAD(j + 1);
            const LAS unsigned char* kb = lds + buf * BUFB;
            f32x16 s0, s1;
#pragma unroll
            for (int r = 0; r < 16; ++r) { s0[r] = 0.f; s1[r] = 0.f; }
#pragma unroll
            for (int ks = 0; ks < 12; ++ks) {
                const bf16x8 a0 = *(const LAS bf16x8*)(kb + l32 * KROW + ks * 32 + h * 16);
                const bf16x8 a1 = *(const LAS bf16x8*)(kb + (l32 + 32) * KROW + ks * 32 + h * 16);
                s0 = mfma32(a0, qf[ks], s0); s1 = mfma32(a1, qf[ks], s1);
                if ((ks % 3) == 2) __builtin_amdgcn_sched_barrier(0);
            }
            if (j + 1 < ntiles) ATT_STOREK(buf ^ 1);
            const int vc = L - j * 64;
            if (vc < 64) {
                const int vch = vc - 4 * h;
#pragma unroll
                for (int r = 0; r < 16; ++r) {
                    if ((r & 3) + 8 * (r >> 2) >= vch) s0[r] = -INFINITY;
                    if ((r & 3) + 8 * (r >> 2) + 32 >= vch) s1[r] = -INFINITY;
                }
            }
            float mx = fmaxf(s0[0], s1[0]);
#pragma unroll
            for (int r = 1; r < 16; ++r) mx = fmaxf(mx, fmaxf(s0[r], s1[r]));
            mx = fmaxf(mx, __shfl_xor(mx, 32));
            const float m_new = fmaxf(m_run, mx);
            const float alpha = __builtin_amdgcn_exp2f(m_run - m_new);
            m_run = m_new;
            float ls = 0.f;
#pragma unroll
            for (int r = 0; r < 16; ++r) { s0[r] = __builtin_amdgcn_exp2f(s0[r] - m_new); s1[r] = __builtin_amdgcn_exp2f(s1[r] - m_new); ls += s0[r] + s1[r]; }
            l_run = l_run * alpha + ls;
#pragma unroll
            for (int d = 0; d < 4; ++d)
#pragma unroll
                for (int r = 0; r < 16; ++r) o[d][r] *= alpha;
            bf16x8 pb[4];
            {
                u32x4 w;
                w.x = cvt_pk_bf16(s0[0], s0[1]); w.y = cvt_pk_bf16(s0[2], s0[3]); w.z = cvt_pk_bf16(s0[4], s0[5]); w.w = cvt_pk_bf16(s0[6], s0[7]); pb[0] = __builtin_bit_cast(bf16x8, w);
                w.x = cvt_pk_bf16(s0[8], s0[9]); w.y = cvt_pk_bf16(s0[10], s0[11]); w.z = cvt_pk_bf16(s0[12], s0[13]); w.w = cvt_pk_bf16(s0[14], s0[15]); pb[1] = __builtin_bit_cast(bf16x8, w);
                w.x = cvt_pk_bf16(s1[0], s1[1]); w.y = cvt_pk_bf16(s1[2], s1[3]); w.z = cvt_pk_bf16(s1[4], s1[5]); w.w = cvt_pk_bf16(s1[6], s1[7]); pb[2] = __builtin_bit_cast(bf16x8, w);
                w.x = cvt_pk_bf16(s1[8], s1[9]); w.y = cvt_pk_bf16(s1[10], s1[11]); w.z = cvt_pk_bf16(s1[12], s1[13]); w.w = cvt_pk_bf16(s1[14], s1[15]); pb[3] = __builtin_bit_cast(bf16x8, w);
            }
            if (j + 1 < ntiles) ATT_LOADV(j + 1);
            const LAS unsigned char* vb = kb + KBYTES;
#pragma unroll
            for (int d = 0; d < 4; ++d)
#pragma unroll
                for (int ks = 0; ks < 4; ++ks) {
                    const LAS unsigned char* ap = vb + (d * 32 + l32) * VROW + (16 * ks + 4 * h) * 2;
                    const u32x2 lo = *(const LAS u32x2*)ap, hi = *(const LAS u32x2*)(ap + 16);
                    const u32x4 w = (u32x4){lo.x, lo.y, hi.x, hi.y};
                    o[d] = mfma32(__builtin_bit_cast(bf16x8, w), pb[ks], o[d]);
                    if (ks == 3) __builtin_amdgcn_sched_barrier(0);
                }
            if (j + 1 < ntiles) ATT_STORE(buf ^ 1);
            __syncthreads();
        }
        l_run += __shfl_xor(l_run, 32);
        const float inv = 1.0f / l_run;
#if DEBUG_CHECK == 5
        bf16_t* orow = (bf16_t*)(launder(p.ws) + OFF_ODBG) + (size_t)qrow * 512 + head * 128;
#else
        bf16_t* orow = Q + (size_t)qrow * 768 + head * 192;
#endif
#pragma unroll
        for (int d = 0; d < 4; ++d)
#pragma unroll
            for (int rq = 0; rq < 4; ++rq) {
                const u32x2 w = (u32x2){cvt_pk_bf16(o[d][4 * rq] * inv, o[d][4 * rq + 1] * inv), cvt_pk_bf16(o[d][4 * rq + 2] * inv, o[d][4 * rq + 3] * inv)};
                *(u32x2*)(orow + 32 * d + 8 * rq + 4 * h) = w;
            }
#undef ATT_LOAD
#undef ATT_LOADV
#undef ATT_STORE
#undef ATT_STOREK
    }
}

template <int SET> __device__ __forceinline__ void hyena_unit(const Params& p, LAS unsigned char* lds, int c, int bg) {
    constexpr int P = SET ? 32 : 128;
    constexpr int NBU = SET ? 16 : 4;
    constexpr int NBT = SET ? 8 : 2;
    constexpr int GP = SET ? 4 : 16;
    constexpr int LG = SET ? LGS : LGP;
    constexpr int NB = SET ? NBS : NBP;
    constexpr int RS = SET ? 4896 : 18816;
    constexpr int GBYTES = 2 * LG * 2;
    constexpr int ZOFF = 33280;
    unsigned char* ws = launder(p.ws);
    const int tid = tid_l(), lane = tid & 63, wave = tid >> 6, h = lane >> 5, l32 = lane & 31;
    const bf16_t* X1T = (const bf16_t*)(ws + OFF_X1T) + (SET ? XT_SET1 : 0);
    bf16_t* X2T = (bf16_t*)(ws + OFF_X2T) + (SET ? XT_SET1 : 0);
    const bf16_t* V0T = (const bf16_t*)(ws + OFF_V0T) + (SET ? XT_SET1 : 0);
    const bf16_t* GR = (const bf16_t*)(ws + (SET ? OFF_GR1 : OFF_GR0));
    const float* hy_bias = launder(p.in[17]);
    LAS unsigned char* gL = lds; LAS unsigned char* zL = lds + ZOFF;
    const size_t rowbase = ((size_t)c * NB + bg * NBU) * LG;
    for (int id = tid; id < NBU * (P + 1) * 8; id += 512) {
        const int bl = id / ((P + 1) * 8), rem = id % ((P + 1) * 8), blk = rem >> 3, ch = rem & 7;
        *(LAS u32x4*)(zL + bl * RS + blk * 144 + ch * 16) = *(const u32x4*)(V0T + rowbase + (size_t)bl * LG + blk * 64 + ch * 8);
    }
    for (int id = tid; id < NBU * 9; id += 512) { const int bl = id / 9, ch = id % 9; *(LAS u32x4*)(zL + bl * RS + (P + 1) * 144 + ch * 16) = (u32x4){0u, 0u, 0u, 0u}; }
    for (int id = tid; id < GBYTES / 16; id += 512) *(LAS u32x4*)(gL + id * 16) = *(const u32x4*)(GR + (size_t)c * (2 * LG) + id * 8);
    __syncthreads();
    const LAS unsigned short* g16 = (const LAS unsigned short*)gL;
    constexpr int PARTS = 512 / (NBU * 16);
    float zmeta = 0.f; int mo_bl, mo_m;
    {
        const int part = tid % PARTS, out = tid / PARTS; mo_bl = out >> 4; mo_m = out & 15;
        const LAS unsigned char* zr = zL + mo_bl * RS;
        float a = 0.f;
        for (int tt = 48 + part; tt < LG; tt += PARTS) {
            const float zv = bf2f(*(const LAS unsigned short*)(zr + (tt >> 6) * 144 + (tt & 63) * 2));
            const float gv = bf2f(g16[LG - mo_m - 48 + tt]);
            a += zv * gv;
        }
#pragma unroll
        for (int o = 1; o < PARTS; o <<= 1) a += __shfl_xor(a, o);
        const float bias0 = hy_bias[c];
        const float z0 = bf2f(*(const LAS unsigned short*)(zr + (48 + mo_m) * 2));
        const float x1 = bf2f(X1T[rowbase + (size_t)mo_bl * LG + 48 + mo_m]);
        zmeta = x1 * (a + z0 * bias0);
    }
    const int p0 = GP * wave;
    const int pp = l32 / NBT, blA = l32 % NBT, blB = NBT + blA;
#pragma unroll 1
    for (int order = 0; order < 2; ++order) {
        f32x16 acc[2][2];
#pragma unroll
        for (int a = 0; a < 2; ++a)
#pragma unroll
            for (int b = 0; b < 2; ++b)
#pragma unroll
                for (int r = 0; r < 16; ++r) acc[a][b][r] = 0.f;
#pragma unroll 1
        for (int d = p0 - (P - 1); d <= p0 + GP; ++d) {
            bf16x8 E[6];
            const int ib = LG - 64 * d - l32 + 8 * h;
#pragma unroll
            for (int e = 0; e < 6; ++e) {
                const LAS unsigned short* gp = g16 + ib - 16 * (e - 3);
#pragma unroll
                for (int j = 0; j < 8; ++j) E[e][j] = (short)gp[j];
            }
            const int q = p0 + pp - d;
            const int slot = ((unsigned)(q + 1) <= (unsigned)P) ? q + 1 : P + 1;
            const LAS unsigned char* zA = zL + blA * RS + slot * 144 + h * 16;
            const LAS unsigned char* zB = zL + blB * RS + slot * 144 + h * 16;
#pragma unroll
            for (int ks = 0; ks < 4; ++ks) {
                const bf16x8 ba = *(const LAS bf16x8*)(zA + ks * 32);
                const bf16x8 bb = *(const LAS bf16x8*)(zB + ks * 32);
#pragma unroll
                for (int m = 0; m < 2; ++m) {
                    acc[0][m] = mfma32(E[2 * m - ks + 3], ba, acc[0][m]);
                    acc[1][m] = mfma32(E[2 * m - ks + 3], bb, acc[1][m]);
                }
            }
        }
        __syncthreads();
        const float bias = hy_bias[order * 512 + c];
#pragma unroll
        for (int tl = 0; tl < 2; ++tl) {
            const int bl = tl ? blB : blA;
            const size_t grow = rowbase + (size_t)bl * LG + 64 * (p0 + pp + 1);
            LAS unsigned char* zr = zL + bl * RS + (p0 + pp + 1) * 144;
#pragma unroll
            for (int m = 0; m < 2; ++m)
#pragma unroll
                for (int rq = 0; rq < 4; ++rq) {
                    const int off = 32 * m + 8 * rq + 4 * h;
                    const u32x2 zw = *(const LAS u32x2*)(zr + off * 2);
                    const u32x2 xw = *(const u32x2*)((order ? (const bf16_t*)X2T : X1T) + grow + off);
                    const float y0 = acc[tl][m][4 * rq], y1 = acc[tl][m][4 * rq + 1], y2 = acc[tl][m][4 * rq + 2], y3 = acc[tl][m][4 * rq + 3];
                    const float r0 = bflo(xw.x) * (y0 + bflo(zw.x) * bias), r1 = bfhi(xw.x) * (y1 + bfhi(zw.x) * bias);
                    const float r2 = bflo(xw.y) * (y2 + bflo(zw.y) * bias), r3 = bfhi(xw.y) * (y3 + bfhi(zw.y) * bias);
                    const u32x2 w = (u32x2){cvt_pk_bf16(r0, r1), cvt_pk_bf16(r2, r3)};
#if DEBUG_CHECK == 5
                    if (order == 0) *(LAS u32x2*)(zr + off * 2) = w; else *(u32x2*)((bf16_t*)(ws + OFF_HDBG) + (SET ? XT_SET1 : 0) + grow + off) = w;
#else
                    if (order == 0) *(LAS u32x2*)(zr + off * 2) = w; else *(u32x2*)(X2T + grow + off) = w;
#endif
                }
        }
        if (order == 0) {
            if ((tid % PARTS) == 0) *(LAS unsigned short*)(zL + mo_bl * RS + (48 + mo_m) * 2) = (unsigned short)(cvt_pk_bf16(zmeta, 0.f) & 0xffffu);
            for (int id = tid; id < GBYTES / 16; id += 512) *(LAS u32x4*)(gL + id * 16) = *(const u32x4*)(GR + (size_t)(512 + c) * (2 * LG) + id * 8);
        }
        __syncthreads();
    }
}
__device__ __forceinline__ void hyena_phase(const Params& p, LAS unsigned char* lds) {
    for (int u = blockIdx.x; u < 2048; u += gridDim.x) {
        if (u < 1024) hyena_unit<0>(p, lds, u >> 1, u & 1); else hyena_unit<1>(p, lds, (u - 1024) >> 1, u & 1);
    }
}

__device__ __forceinline__ void mixnorm_phase(const Params& p, LAS unsigned char* lds) {
    unsigned char* ws = launder(p.ws); const int tid = tid_l(), lane = tid & 63, wave = tid >> 6, G = gridDim.x;
    const bf16_t* Q = (const bf16_t*)(launder((unsigned char*)p.out) + DO_Q);
    bf16_t* MIXN = (bf16_t*)(ws + OFF_MIXN);
    const float* ga = launder(p.in[18]); const float* gh = launder(p.in[19]);
    constexpr int RSB = 1040;
    for (int u = blockIdx.x; u < 2048; u += G) {
        const int n0 = u * 64;
        int set, b, tok0;
        if (n0 < 65536) { set = 0; b = n0 >> 13; tok0 = n0 & 8191; } else { set = 1; const int q = n0 - 65536; b = q >> 11; tok0 = q & 2047; }
        const int Lg = set ? LGS : LGP, NB = set ? NBS : NBP;
        {
            const int c = tid;
#if DEBUG_CHECK == 5
            const bf16_t* src = (const bf16_t*)(ws + OFF_HDBG) + (set ? XT_SET1 : 0) + ((size_t)c * NB + b) * Lg + tok0 + 64;
#else
            const bf16_t* src = (const bf16_t*)(ws + OFF_X2T) + (set ? XT_SET1 : 0) + ((size_t)c * NB + b) * Lg + tok0 + 64;
#endif
            LAS unsigned short* tl = (LAS unsigned short*)lds + c;
#pragma unroll
            for (int k8 = 0; k8 < 8; ++k8) {
                const u32x4 v = *(const u32x4*)(src + k8 * 8);
                tl[(k8 * 8 + 0) * (RSB / 2)] = (unsigned short)(v.x & 0xffffu); tl[(k8 * 8 + 1) * (RSB / 2)] = (unsigned short)(v.x >> 16);
                tl[(k8 * 8 + 2) * (RSB / 2)] = (unsigned short)(v.y & 0xffffu); tl[(k8 * 8 + 3) * (RSB / 2)] = (unsigned short)(v.y >> 16);
                tl[(k8 * 8 + 4) * (RSB / 2)] = (unsigned short)(v.z & 0xffffu); tl[(k8 * 8 + 5) * (RSB / 2)] = (unsigned short)(v.z >> 16);
                tl[(k8 * 8 + 6) * (RSB / 2)] = (unsigned short)(v.w & 0xffffu); tl[(k8 * 8 + 7) * (RSB / 2)] = (unsigned short)(v.w >> 16);
            }
        }
        __syncthreads();
        for (int i = 0; i < 8; ++i) {
            const int rr = wave + 8 * i; const int n = n0 + rr; const int r = full_row(n);
            const u32x4 hv = *(const LAS u32x4*)(lds + rr * RSB + lane * 16);
#if DEBUG_CHECK == 5
            const u32x4 av = *(const u32x4*)((const bf16_t*)(ws + OFF_ODBG) + (size_t)r * 512 + lane * 8);
#else
            const u32x4 av = *(const u32x4*)(Q + (size_t)r * 768 + (lane >> 4) * 192 + (lane & 15) * 8);
#endif
            float hf[8] = {bflo(hv.x), bfhi(hv.x), bflo(hv.y), bfhi(hv.y), bflo(hv.z), bfhi(hv.z), bflo(hv.w), bfhi(hv.w)};
            float af[8] = {bflo(av.x), bfhi(av.x), bflo(av.y), bfhi(av.y), bflo(av.z), bfhi(av.z), bflo(av.w), bfhi(av.w)};
            float sh = 0.f, sa = 0.f;
#pragma unroll
            for (int k = 0; k < 8; ++k) { sh += hf[k] * hf[k]; sa += af[k] * af[k]; }
            sh = wave_sum(sh); sa = wave_sum(sa);
            const float rh = rsqrtf(sh * (1.f / 512.f) + EPS), ra = rsqrtf(sa * (1.f / 512.f) + EPS);
            const f32x4 ga0 = *(const f32x4*)(ga + lane * 8), ga1 = *(const f32x4*)(ga + lane * 8 + 4);
            const f32x4 gh0 = *(const f32x4*)(gh + lane * 8), gh1 = *(const f32x4*)(gh + lane * 8 + 4);
            u32x4 wa, wh;
            wa.x = cvt_pk_bf16(af[0] * ra * ga0[0], af[1] * ra * ga0[1]); wa.y = cvt_pk_bf16(af[2] * ra * ga0[2], af[3] * ra * ga0[3]);
            wa.z = cvt_pk_bf16(af[4] * ra * ga1[0], af[5] * ra * ga1[1]); wa.w = cvt_pk_bf16(af[6] * ra * ga1[2], af[7] * ra * ga1[3]);
            wh.x = cvt_pk_bf16(hf[0] * rh * gh0[0], hf[1] * rh * gh0[1]); wh.y = cvt_pk_bf16(hf[2] * rh * gh0[2], hf[3] * rh * gh0[3]);
            wh.z = cvt_pk_bf16(hf[4] * rh * gh1[0], hf[5] * rh * gh1[1]); wh.w = cvt_pk_bf16(hf[6] * rh * gh1[2], hf[7] * rh * gh1[3]);
#if EXPT == 1
            wa = (u32x4){0u, 0u, 0u, 0u};
#endif
#if EXPT == 2
            wh = (u32x4){0u, 0u, 0u, 0u};
#endif
            *(u32x4*)(MIXN + (size_t)n * 1024 + lane * 8) = wa;
            *(u32x4*)(MIXN + (size_t)n * 1024 + 512 + lane * 8) = wh;
        }
        __syncthreads();
    }
}

__device__ __forceinline__ void h1_phase(const Params& p) {
    unsigned char* ws = launder(p.ws); const int tid = tid_l(), lane = tid & 63, wave = tid >> 6;
    const int gw = blockIdx.x * 8 + wave, NGW = gridDim.x * 8;
    const bf16_t* MIX = (const bf16_t*)(ws + OFF_MIX); bf16_t* H1B = (bf16_t*)(ws + OFF_H1B);
    const float* sqmix = (const float*)(ws + OFF_SQMIXP); float* r1 = (float*)(ws + OFF_R1); const float* g = p.in[21];
    for (int n = gw; n < TN; n += NGW) {
        const float* xrow = n < 65536 ? p.in[0] + (size_t)n * 1024 : p.in[1] + (size_t)(n - 65536) * 1024;
        const float rm = rsqrtf(wave_sum(lane < 16 ? ldco(sqmix + (size_t)n * 16 + lane) : 0.f) * (1.f / 1024.f) + EPS);
        float ss = 0.f;
#pragma unroll
        for (int hh = 0; hh < 2; ++hh) {
            const int c0 = hh * 512 + lane * 8;
            const u32x4 mv = *(const u32x4*)(MIX + (size_t)n * 1024 + c0);
            const f32x4 x0 = *(const f32x4*)(xrow + c0), x1 = *(const f32x4*)(xrow + c0 + 4);
            const f32x4 g0 = *(const f32x4*)(g + c0), g1 = *(const f32x4*)(g + c0 + 4);
            f32x4 h0, h1;
            h0[0] = x0[0] + bflo(mv.x) * rm * g0[0]; h0[1] = x0[1] + bfhi(mv.x) * rm * g0[1]; h0[2] = x0[2] + bflo(mv.y) * rm * g0[2]; h0[3] = x0[3] + bfhi(mv.y) * rm * g0[3];
            h1[0] = x1[0] + bflo(mv.z) * rm * g1[0]; h1[1] = x1[1] + bfhi(mv.z) * rm * g1[1]; h1[2] = x1[2] + bflo(mv.w) * rm * g1[2]; h1[3] = x1[3] + bfhi(mv.w) * rm * g1[3];
            ss += sq8(h0, h1);
            *(f32x4*)(p.out + (size_t)n * 1024 + c0) = h0; *(f32x4*)(p.out + (size_t)n * 1024 + c0 + 4) = h1;
            *(u32x4*)(H1B + (size_t)n * 1024 + c0) = pack8(h0, h1);
        }
        ss = wave_sum(ss);
        if (lane == 0) r1[n] = rsqrtf(ss * (1.f / 1024.f) + EPS);
    }
}
__device__ __forceinline__ void final_phase(const Params& p, int half) {
    unsigned char* ws = launder(p.ws); const int tid = tid_l(), lane = tid & 63, wave = tid >> 6;
    const int gw = blockIdx.x * 8 + wave, NGW = gridDim.x * 8;
    const bf16_t* M2 = (const bf16_t*)(ws + OFF_M2); const float* sqm2 = (const float*)(ws + OFF_SQM2P); const float* g = p.in[25];
    float dbg_off = 0.f, dbg_one = 0.f;
#if DEBUG_CHECK
    { const unsigned* dc = (const unsigned*)(ws + OFF_DBGW); dbg_off = 100.f * (float)dc[8] * (1.f / 131072.f); dbg_one = 1000.f * (float)dc[9] * (1.f / 131072.f); }
#endif
    for (int i = gw; i < 65536; i += NGW) {
        const int n = half * 65536 + i;
        const float rm = rsqrtf(wave_sum(lane < 16 ? ldco(sqm2 + (size_t)n * 16 + lane) : 0.f) * (1.f / 1024.f) + EPS);
#pragma unroll
        for (int hh = 0; hh < 2; ++hh) {
            const int c0 = hh * 512 + lane * 8;
            const u32x4 mv = *(const u32x4*)(M2 + (size_t)i * 1024 + c0);
            f32x4 h0 = *(const f32x4*)(p.out + (size_t)n * 1024 + c0), h1 = *(const f32x4*)(p.out + (size_t)n * 1024 + c0 + 4);
            const f32x4 g0 = *(const f32x4*)(g + c0), g1 = *(const f32x4*)(g + c0 + 4);
            h0 += dbg_off; h1 += dbg_off; if (n == 0 && c0 == 0) h0[0] += dbg_one;
            h0[0] += bflo(mv.x) * rm * g0[0]; h0[1] += bfhi(mv.x) * rm * g0[1]; h0[2] += bflo(mv.y) * rm * g0[2]; h0[3] += bfhi(mv.y) * rm * g0[3];
            h1[0] += bflo(mv.z) * rm * g1[0]; h1[1] += bfhi(mv.z) * rm * g1[1]; h1[2] += bflo(mv.w) * rm * g1[2]; h1[3] += bfhi(mv.w) * rm * g1[3];
            *(f32x4*)(p.out + (size_t)n * 1024 + c0) = h0; *(f32x4*)(p.out + (size_t)n * 1024 + c0 + 4) = h1;
        }
    }
}


#if DEBUG_CHECK
constexpr size_t OFF_DBG = OFF_DBGW;
__device__ __forceinline__ void check_gemm(const bf16_t* A, int lda, const bf16_t* Bt, int ldb, int K, int M, int N, int mode, const bf16_t* O, int ldc, const float* rs, unsigned* cnt, int col_lo) {
    const unsigned idx = blockIdx.x * 512u + (unsigned)tid_l();
    unsigned hsh = idx * 2654435761u + 12345u + (unsigned)mode * 977u; hsh ^= hsh >> 15; hsh *= 2246822519u; hsh ^= hsh >> 13;
    const int row = (int)(hsh % (unsigned)M); hsh = hsh * 3266489917u + 668265263u; hsh ^= hsh >> 16;
    const int col = col_lo + (int)(hsh % (unsigned)(N - col_lo));
    float d = 0.f;
    for (int k = 0; k < K; ++k) d += bf2f(A[(size_t)row * lda + k]) * bf2f(Bt[(size_t)col * ldb + k]);
    float e = d;
    if (mode == 0 || mode == 7) e = d * rs[row];
    if (mode == 5) { const float t = fmaxf(d * rs[row], 0.f); e = t * t; }
    const float st = bf2f(O[(size_t)row * ldc + col]);
    if (!(fabsf(st - e) <= 0.03f * fabsf(e) + 0.03f)) atomicAdd(cnt, 1u);
}
#endif

#if DEBUG_CHECK == 2
__device__ __forceinline__ void check_proj(const Params& p) {
    unsigned char* ws = launder(p.ws); unsigned char* ob = launder((unsigned char*)p.out);
    const bf16_t* P = (const bf16_t*)(ws + OFF_P); unsigned* cnt = (unsigned*)(ws + OFF_DBG);
    const unsigned idx = blockIdx.x * 512u + (unsigned)tid_l();
    unsigned hsh = idx * 2654435761u + 777u; hsh ^= hsh >> 15; hsh *= 2246822519u; hsh ^= hsh >> 13;
    const int row = (int)(hsh % (unsigned)T); hsh = hsh * 3266489917u + 668265263u; hsh ^= hsh >> 16;
    int pos, seq; row_info(row, pos, seq);
    {
        const int n = (int)(hsh % 768u); const int hh = n / 192, w = n % 192;
        float ss = 0.f, x1 = 0.f, x2 = 0.f; const float* W = p.in[6]; const float* g = p.in[5];
        const int j = w - 128, i = j >> 1;
        const int c1 = w < 128 ? hh * 192 + w : hh * 192 + 128 + i, c2 = hh * 192 + 160 + (w < 128 ? 0 : i);
        for (int k = 0; k < 256; ++k) { const float a = bf2f(P[(size_t)row * NPP + k]); ss += a * a; x1 += a * g[k] * W[k * 768 + c1]; x2 += a * g[k] * W[k * 768 + c2]; }
        const float rq = rsqrtf(ss * (1.f / 256.f) + EPS) * QSCALE; x1 *= rq; x2 *= rq;
        float e = x1;
        if (w >= 128) { const float inv = 1.0f / exp2f((float)i * (13.287712379549449f / 32.f)); float sn, cs; sincos_red((float)pos * inv, sn, cs); e = (j & 1) ? x2 * cs + x1 * sn : x1 * cs - x2 * sn; }
        const float st = bf2f(((const bf16_t*)(ob + DO_Q))[(size_t)row * 768 + n]);
        if (!(fabsf(st - e) <= 0.03f * fabsf(e) + 0.01f)) atomicAdd(cnt + (w < 128 ? 0 : 4), 1u);
    }
    {
        const int n = (int)((hsh >> 3) % 512u); const int hh = n >> 7, i = n & 127;
        float ss = 0.f, x1 = 0.f, x2 = 0.f; const float* W = p.in[8]; const float* g = p.in[7];
        for (int k = 0; k < 128; ++k) { const float a = bf2f(P[(size_t)row * NPP + 256 + k]); ss += a * a; x1 += a * g[k] * W[k * 1024 + hh * 256 + i]; x2 += a * g[k] * W[k * 1024 + hh * 256 + 128 + i]; }
        const float rk = rsqrtf(ss * (1.f / 128.f) + EPS); x1 *= rk; x2 *= rk;
        const float s1 = bf2f(((const bf16_t*)(ob + DO_KN))[(size_t)row * 512 + n]);
        const float s2 = bf2f(((const bf16_t*)(ob + DO_VT))[(size_t)n * TPAD + row]);
        if (!(fabsf(s1 - x1) <= 0.03f * fabsf(x1) + 0.03f)) atomicAdd(cnt + 1, 1u);
        if (!(fabsf(s2 - x2) <= 0.03f * fabsf(x2) + 0.03f)) atomicAdd(cnt + 2, 1u);
    }
    {
        const int jj = (int)((hsh >> 5) % 64u); const int i = jj >> 1;
        const float* xr = pos < 16 ? p.in[2] + (size_t)pos * 1024 : (seq < NBP ? p.in[0] + ((size_t)seq * 8192 + (pos - 16)) * 1024 : p.in[1] + ((size_t)(seq - NBP) * 2048 + (pos - 16)) * 1024);
        const float* W = p.in[4]; const float* g = p.in[3]; float x1 = 0.f, x2 = 0.f;
        for (int k = 0; k < 1024; ++k) { const float a = xr[k] * g[k]; x1 += a * W[(size_t)k * 1984 + 384 + i]; x2 += a * W[(size_t)k * 1984 + 416 + i]; }
        const float r0 = ((const float*)(ws + OFF_R0))[row]; x1 *= r0; x2 *= r0;
        const float inv = 1.0f / exp2f((float)i * (13.287712379549449f / 32.f)); float sn, cs; sincos_red((float)pos * inv, sn, cs);
        const float e = (jj & 1) ? x2 * cs + x1 * sn : x1 * cs - x2 * sn;
        const float st = bf2f(((const bf16_t*)(ob + DO_KR))[(size_t)row * 64 + jj]);
        if (!(fabsf(st - e) <= 0.03f * fabsf(e) + 0.03f)) { atomicAdd(cnt + 3, 1u); atomicAdd(cnt + 5, (unsigned)i); atomicAdd(cnt + 6, (unsigned)(pos >> 3)); }
    }
}
#endif

#if DEBUG_CHECK == 3
__device__ __forceinline__ void check_h0b(const Params& p, int slot) {
    unsigned char* ws = launder(p.ws); unsigned* cnt = (unsigned*)(ws + OFF_DBGW);
    const bf16_t* h0b = (const bf16_t*)(ws + OFF_H0B);
    const unsigned idx = blockIdx.x * 512u + (unsigned)tid_l();
    unsigned hsh = idx * 2654435761u + 4242u + (unsigned)slot * 31u; hsh ^= hsh >> 15; hsh *= 2246822519u; hsh ^= hsh >> 13;
    const int row = (int)(hsh % (unsigned)T); hsh = hsh * 3266489917u + 668265263u; hsh ^= hsh >> 16;
    const int col = (int)(hsh % 1024u);
    int pos, seq; row_info(row, pos, seq);
    const float* xr = pos < 16 ? p.in[2] + (size_t)pos * 1024 : (seq < NBP ? p.in[0] + ((size_t)seq * 8192 + (pos - 16)) * 1024 : p.in[1] + ((size_t)(seq - NBP) * 2048 + (pos - 16)) * 1024);
    const float e = xr[col]; const float st = bf2f(h0b[(size_t)row * 1024 + col]);
    if (!(fabsf(st - e) <= 0.01f * fabsf(e) + 0.001f)) atomicAdd(cnt + slot, 1u);
}
#endif

#if DEBUG_CHECK == 4
__device__ __forceinline__ void check_stale(const Params& p, const unsigned* base, unsigned ndw, int slot) {
    unsigned* cnt = (unsigned*)(launder(p.ws) + OFF_DBGW);
    const unsigned idx = blockIdx.x * 512u + (unsigned)tid_l();
    unsigned hsh = idx * 2654435761u + 999u + (unsigned)slot * 131u; hsh ^= hsh >> 15; hsh *= 2246822519u; hsh ^= hsh >> 13;
#pragma unroll 1
    for (int it = 0; it < 16; ++it) {
        hsh = hsh * 3266489917u + 668265263u; hsh ^= hsh >> 16;
        const unsigned i = hsh % ndw;
        const unsigned a = base[i];
        const unsigned b = __hip_atomic_load(base + i, __ATOMIC_RELAXED, __HIP_MEMORY_SCOPE_AGENT);
        if (a != b) atomicAdd(cnt + slot, 1u);
    }
}
#endif

#if DEBUG_CHECK == 5
__device__ __forceinline__ void check_attn(const Params& p) {
    unsigned char* ws = launder(p.ws); unsigned char* ob = launder((unsigned char*)p.out); unsigned* cnt = (unsigned*)(ws + OFF_DBGW);
    const int tid = tid_l(), lane = tid & 63, wave = tid >> 6;
    const bf16_t* Q = (const bf16_t*)(ob + DO_Q); const bf16_t* KN = (const bf16_t*)(ob + DO_KN); const bf16_t* KR = (const bf16_t*)(ob + DO_KR); const bf16_t* VT = (const bf16_t*)(ob + DO_VT);
    const bf16_t* OD = (const bf16_t*)(ws + OFF_ODBG); const float2* RT = (const float2*)(ws + OFF_RT);
    unsigned hsh = (unsigned)(blockIdx.x * 8 + wave) * 2654435761u + 31337u; hsh ^= hsh >> 15; hsh *= 2246822519u; hsh ^= hsh >> 13;
    const int n = (int)(hsh % (unsigned)TN); const int head = (int)((hsh >> 20) & 3u); const int r = full_row(n);
    int pos, seq; row_info(r, pos, seq);
    const int L = seq < NBP ? LP : LS; const int row0 = r - pos;
    const bf16_t* qp = Q + (size_t)r * 768 + head * 192;
    float mx = -INFINITY;
    for (int k = lane; k < L; k += 64) {
        float sdot = 0.f;
        for (int d = 0; d < 128; ++d) sdot += bf2f(qp[d]) * bf2f(KN[(size_t)(row0 + k) * 512 + head * 128 + d]);
        for (int i = 0; i < 32; ++i) { const float2 cs = ldco2(RT + pos * 32 + i); const float a = bf2f(qp[128 + 2 * i]), b = bf2f(qp[129 + 2 * i]);
            sdot += (a * cs.x - b * cs.y) * bf2f(KR[(size_t)(row0 + k) * 64 + 2 * i]) + (b * cs.x + a * cs.y) * bf2f(KR[(size_t)(row0 + k) * 64 + 2 * i + 1]); }
        mx = fmaxf(mx, sdot);
    }
#pragma unroll
    for (int o = 1; o < 64; o <<= 1) mx = fmaxf(mx, __shfl_xor(mx, o));
    float sw = 0.f, o0 = 0.f, o1 = 0.f; const int dv0 = (int)((hsh >> 8) & 127u), dv1 = (dv0 + 37) & 127;
    for (int k = lane; k < L; k += 64) {
        float sdot = 0.f;
        for (int d = 0; d < 128; ++d) sdot += bf2f(qp[d]) * bf2f(KN[(size_t)(row0 + k) * 512 + head * 128 + d]);
        for (int i = 0; i < 32; ++i) { const float2 cs = ldco2(RT + pos * 32 + i); const float a = bf2f(qp[128 + 2 * i]), b = bf2f(qp[129 + 2 * i]);
            sdot += (a * cs.x - b * cs.y) * bf2f(KR[(size_t)(row0 + k) * 64 + 2 * i]) + (b * cs.x + a * cs.y) * bf2f(KR[(size_t)(row0 + k) * 64 + 2 * i + 1]); }
        const float w = exp2f(sdot - mx); sw += w;
        o0 += w * bf2f(VT[(size_t)(head * 128 + dv0) * TPAD + row0 + k]); o1 += w * bf2f(VT[(size_t)(head * 128 + dv1) * TPAD + row0 + k]);
    }
    sw = wave_sum(sw); o0 = wave_sum(o0) / sw; o1 = wave_sum(o1) / sw;
    if (lane == 0) {
        const float s0 = bf2f(OD[(size_t)r * 512 + head * 128 + dv0]), s1 = bf2f(OD[(size_t)r * 512 + head * 128 + dv1]);
        atomicAdd(cnt + 10, 2u);
        if (!(fabsf(s0 - o0) <= 0.05f * fabsf(o0) + 0.002f)) atomicAdd(cnt + 8, 1u);
        if (!(fabsf(s1 - o1) <= 0.05f * fabsf(o1) + 0.002f)) atomicAdd(cnt + 8, 1u);
    }
}
__device__ __forceinline__ void check_hyena(const Params& p, LAS unsigned char* lds) {
    unsigned char* ws = launder(p.ws); unsigned* cnt = (unsigned*)(ws + OFF_DBGW);
    const int tid = tid_l();
    unsigned hsh = (unsigned)blockIdx.x * 2654435761u + 555u; hsh ^= hsh >> 15; hsh *= 2246822519u; hsh ^= hsh >> 13;
    const int set = (int)(blockIdx.x & 1u); const int c = (int)(hsh % 512u); const int NB = set ? NBS : NBP; const int b = (int)((hsh >> 12) % (unsigned)NB);
    const int LG = set ? LGS : LGP;
    const size_t base = (set ? XT_SET1 : 0) + ((size_t)c * NB + b) * LG;
    const bf16_t* X1 = (const bf16_t*)(ws + OFF_X1T) + base; const bf16_t* X2 = (const bf16_t*)(ws + OFF_X2T) + base; const bf16_t* V0 = (const bf16_t*)(ws + OFF_V0T) + base;
    const bf16_t* HD = (const bf16_t*)(ws + OFF_HDBG) + base;
    const bf16_t* G0 = (const bf16_t*)(ws + (set ? OFF_GR1 : OFF_GR0)) + (size_t)c * (2 * LG); const bf16_t* G1 = G0 + (size_t)512 * (2 * LG);
    const float bias0 = p.in[17][c], bias1 = p.in[17][512 + c];
    LAS float* z1 = (LAS float*)lds;
    for (int t = tid; t < LG; t += 512) {
        float y = 0.f;
        for (int s2 = 48; s2 < LG; ++s2) y += bf2f(G0[LG - (t - s2)]) * bf2f(V0[s2]);
        const float v = bf2f(X1[t]) * (y + bf2f(V0[t]) * bias0);
        z1[t] = (t >= 48) ? bf2f((unsigned short)(cvt_pk_bf16(v, 0.f) & 0xffffu)) : 0.f;
    }
    __syncthreads();
    {
        unsigned h2 = hsh * 3266489917u + (unsigned)tid * 2246822519u; h2 ^= h2 >> 15; h2 *= 2654435761u; h2 ^= h2 >> 13;
        const int t = 64 + (int)(h2 % (unsigned)(LG - 64));
        float y = 0.f;
        for (int s2 = 48; s2 < LG; ++s2) y += bf2f(G1[LG - (t - s2)]) * z1[s2];
        const float e = bf2f(X2[t]) * (y + z1[t] * bias1);
        const float st = bf2f(HD[t]);
        atomicAdd(cnt + 11, 1u);
        if (!(fabsf(st - e) <= 0.05f * fabsf(e) + 1.0f)) atomicAdd(cnt + 9, 1u);
    }
    __syncthreads();
}
#endif

#if DEBUG_CHECK == 7
__device__ __forceinline__ void check_h0b_full(const Params& p, int slot) {
    unsigned char* ws = launder(p.ws); unsigned* cnt = (unsigned*)(ws + OFF_DBGW);
    const bf16_t* h0b = (const bf16_t*)(ws + OFF_H0B);
    const int tid = tid_l(), lane = tid & 63, wave = tid >> 6;
    for (int row = blockIdx.x * 8 + wave; row < T; row += gridDim.x * 8) {
        int pos, seq; row_info(row, pos, seq);
        const float* xr = pos < 16 ? p.in[2] + (size_t)pos * 1024 : (seq < NBP ? p.in[0] + ((size_t)seq * 8192 + (pos - 16)) * 1024 : p.in[1] + ((size_t)(seq - NBP) * 2048 + (pos - 16)) * 1024);
        int bad = 0;
        for (int c = lane; c < 1024; c += 64) { const float e = xr[c]; const float st = bf2f(h0b[(size_t)row * 1024 + c]); if (!(fabsf(st - e) <= 0.01f * fabsf(e) + 0.001f)) bad = 1; }
        bad = __any(bad);
        if (lane == 0 && bad) atomicAdd(cnt + slot, 1u);
    }
}
#endif

#if DEBUG_CHECK == 8
__device__ __forceinline__ void check_p_golden(const Params& p) {
    unsigned char* ws = launder(p.ws); unsigned* cnt = (unsigned*)(ws + OFF_DBGW);
    const bf16_t* P = (const bf16_t*)(ws + OFF_P);
    const unsigned idx = blockIdx.x * 512u + (unsigned)tid_l();
    unsigned hsh = idx * 2654435761u + 8888u; hsh ^= hsh >> 15; hsh *= 2246822519u; hsh ^= hsh >> 13;
    const int row = (int)(hsh % (unsigned)T); hsh = hsh * 3266489917u + 668265263u; hsh ^= hsh >> 16;
    int pos, seq; row_info(row, pos, seq);
    const float* xr = pos < 16 ? p.in[2] + (size_t)pos * 1024 : (seq < NBP ? p.in[0] + ((size_t)seq * 8192 + (pos - 16)) * 1024 : p.in[1] + ((size_t)(seq - NBP) * 2048 + (pos - 16)) * 1024);
    const float* W = p.in[4]; const float* g = p.in[3];
    const int colA = 448 + (int)(hsh % 1536u), colB = (int)((hsh >> 7) % 384u);
    float ss = 0.f, a = 0.f, b = 0.f;
    for (int k = 0; k < 1024; ++k) { const float x = xr[k]; ss += x * x; a += x * g[k] * W[(size_t)k * 1984 + colA]; b += x * g[k] * W[(size_t)k * 1984 + colB]; }
    const float r0 = rsqrtf(ss * (1.f / 1024.f) + EPS); a *= r0; b *= r0;
    const float sa = bf2f(P[(size_t)row * NPP + colA]), sb = bf2f(P[(size_t)row * NPP + colB]);
    if (!(fabsf(sa - a) <= 0.03f * fabsf(a) + 0.03f)) atomicAdd(cnt + 8, 1u);
    if (!(fabsf(sb - b) <= 0.03f * fabsf(b) + 0.03f)) atomicAdd(cnt + 9, 1u);
}
#endif

#if DEBUG_CHECK == 9
__device__ __forceinline__ void check_win_r0(const Params& p) {
    unsigned char* ws = launder(p.ws); unsigned* cnt = (unsigned*)(ws + OFF_DBGW);
    const bf16_t* WT = (const bf16_t*)(ws + OFF_WIN); const float* W = p.in[4]; const float* g = p.in[3]; const float* R0 = (const float*)(ws + OFF_R0);
    const int tid = tid_l(), lane = tid & 63, wave = tid >> 6;
    const int gtid = blockIdx.x * 512 + tid, gthreads = gridDim.x * 512;
    for (int e = gtid; e < 1984 * 1024; e += gthreads) {
        const int n = e >> 10, k = e & 1023; const int sc = src_col(1, n);
        const float ex = W[(size_t)k * 1984 + sc] * g[k]; const float st = bf2f(WT[(size_t)n * 1024 + k]);
        if (!(fabsf(st - ex) <= 0.01f * fabsf(ex) + 1e-5f)) atomicAdd(cnt + 8, 1u);
    }
    for (int row = blockIdx.x * 8 + wave; row < T; row += gridDim.x * 8) {
        int pos, seq; row_info(row, pos, seq);
        const float* xr = pos < 16 ? p.in[2] + (size_t)pos * 1024 : (seq < NBP ? p.in[0] + ((size_t)seq * 8192 + (pos - 16)) * 1024 : p.in[1] + ((size_t)(seq - NBP) * 2048 + (pos - 16)) * 1024);
        float ss = 0.f;
        for (int c = lane; c < 1024; c += 64) ss += xr[c] * xr[c];
        ss = wave_sum(ss);
        const float ex = rsqrtf(ss * (1.f / 1024.f) + EPS); const float st = R0[row];
        if (lane == 0 && !(fabsf(st - ex) <= 0.001f * ex)) { atomicAdd(cnt + 9, 1u); atomicAdd(cnt + 12, (unsigned)(row >> 6)); }
    }
}
#endif

#if DEBUG_CHECK == 10
__device__ __forceinline__ void check_x(const Params& p, int mode) {
    unsigned char* ws = launder(p.ws); unsigned* cnt = (unsigned*)(ws + OFF_DBGW); unsigned* sums = (unsigned*)(ws + OFF_DBGW + MiB);
    const int tid = tid_l(), lane = tid & 63, wave = tid >> 6;
    for (int n = blockIdx.x * 8 + wave; n < TN; n += gridDim.x * 8) {
        const unsigned* xr = (const unsigned*)(n < 65536 ? p.in[0] + (size_t)n * 1024 : p.in[1] + (size_t)(n - 65536) * 1024);
        unsigned a = 0u;
        for (int c = lane; c < 1024; c += 64) a += xr[c] * (2u * (unsigned)c + 1u);
#pragma unroll
        for (int o = 1; o < 64; o <<= 1) a += __shfl_xor(a, o);
        if (lane == 0) {
            if (mode == 0) __hip_atomic_store(sums + n, a, __ATOMIC_RELAXED, __HIP_MEMORY_SCOPE_AGENT);
            else if (__hip_atomic_load(sums + n, __ATOMIC_RELAXED, __HIP_MEMORY_SCOPE_AGENT) != a) atomicAdd(cnt + 8, 1u);
        }
    }
}
#endif

#if DEBUG_CHECK == 11
__device__ __forceinline__ void check_filt_prep(const Params& p) {
    unsigned char* ws = launder(p.ws); unsigned* cnt = (unsigned*)(ws + OFF_DBGW);
    const unsigned idx = blockIdx.x * 512u + (unsigned)tid_l();
    unsigned hsh = idx * 2654435761u + 1111u; hsh ^= hsh >> 15; hsh *= 2246822519u; hsh ^= hsh >> 13;
    {
        const int set = (int)(hsh & 1u); const int L = set ? LS : LP; const int C0 = set ? LGS : LGP;
        const int n = (int)((hsh >> 1) % 2048u); hsh = hsh * 3266489917u + 668265263u; hsh ^= hsh >> 16;
        const int t = (int)(hsh % (unsigned)L);
        const float* f_w1 = p.in[10]; const float* f_b1 = p.in[11]; const float* f_freq = p.in[12]; const float* f_w2 = p.in[13];
        const float* f_b2 = p.in[14]; const float* f_w3 = p.in[15]; const float* f_decay = p.in[16];
        const float tn = (float)t / (float)(L - 1); const float w = (6.2831853071795865f * (float)t) / (float)L;
        float acc = 0.f;
        for (int j2 = 0; j2 < 64; ++j2) {
            float a2 = f_b2[j2];
            for (int j1 = 0; j1 < 64; ++j1) {
                float a1 = f_b1[j1] + tn * f_w1[j1];
                for (int k = 0; k < 16; ++k) { const float f = 1e-4f + (float)k * ((15.0f - 1e-4f) / 15.0f); float sn, cs; sincos_red(f * w, sn, cs);
                    a1 += cs * f_w1[(1 + k) * 64 + j1] - sn * f_w1[(17 + k) * 64 + j1]; }
                a2 += sin_red(f_freq[j1] * a1) * f_w2[j1 * 64 + j2];
            }
            acc += sin_red(f_freq[j2] * a2) * f_w3[j2 * 2048 + n];
        }
        const float e = acc * __expf(-tn * fabsf(f_decay[n]));
        const int order = n >> 10, dir = (n >> 9) & 1, c = n & 511;
        if (!(dir == 1 && t == 0)) {
            const bf16_t* row = (const bf16_t*)(ws + (set ? OFF_GR1 : OFF_GR0)) + (size_t)(order * 512 + c) * (2 * C0);
            const float st = bf2f(row[dir ? C0 + t : C0 - t]);
            if (!(fabsf(st - e) <= 0.02f * fabsf(e) + 0.003f)) atomicAdd(cnt + 8, 1u);
        }
    }
    {
        const int seq = (int)(hsh % 40u); const int set = seq < NBP ? 0 : 1; const int L = set ? LS : LP; const int Lg = set ? LGS : LGP; const int NB = set ? NBS : NBP;
        const int b = set ? seq - NBP : seq; const int row0 = set ? TPR + b * LS : b * LP;
        hsh = hsh * 3266489917u + 668265263u; hsh ^= hsh >> 16;
        const int pos = (int)(hsh % (unsigned)L); const int which = (int)((hsh >> 16) % 3u); const int c = (int)((hsh >> 20) % 512u);
        const bf16_t* P = (const bf16_t*)(ws + OFF_P); const float* cw = p.in[9]; const int col = 448 + which * 512 + c;
        const float um = pos > 0 ? bf2f(P[(size_t)(row0 + pos - 1) * NPP + col]) : 0.f, u0 = bf2f(P[(size_t)(row0 + pos) * NPP + col]), up = pos + 1 < L ? bf2f(P[(size_t)(row0 + pos + 1) * NPP + col]) : 0.f;
        const float e = um * cw[which * 512 + c] + u0 * cw[1536 + which * 512 + c] + up * cw[3072 + which * 512 + c];
        const bf16_t* XT = (const bf16_t*)(ws + (which == 0 ? OFF_X1T : (which == 1 ? OFF_X2T : OFF_V0T))) + (set ? XT_SET1 : 0) + ((size_t)c * NB + b) * Lg;
        const float st = bf2f(XT[pos + 48]);
        if (!(fabsf(st - e) <= 0.02f * fabsf(e) + 0.02f)) atomicAdd(cnt + 9, 1u);
    }
}
#endif
#ifndef SUB_MASK
#define SUB_MASK 15
#endif
#ifndef PHASE_MASK
#define PHASE_MASK 1023
#endif
__global__ void __launch_bounds__(512) hymba_fwd(Params p) {
    extern __shared__ __attribute__((aligned(16))) unsigned char lds_raw[];
    LAS unsigned char* lds = (LAS unsigned char*)lds_raw;
    cg::grid_group grid = cg::this_grid();
#define GSYNC() do { asm volatile("s_waitcnt vmcnt(0) lgkmcnt(0)" ::: "memory"); __threadfence(); grid.sync(); } while (0)
    const int G = gridDim.x;
    __builtin_amdgcn_fence(__ATOMIC_SEQ_CST, "agent");
    asm volatile("buffer_inv sc1\n\ts_waitcnt vmcnt(0)" ::: "memory");
#if DEBUG_CHECK == 10
    check_x(p, 0);
#endif
#if PHASE_MASK & 1
    p0_prologue(p, lds);
#endif
    GSYNC();
#if DEBUG_CHECK == 3
    check_h0b(p, 8);
#endif
#if DEBUG_CHECK == 7
    check_h0b_full(p, 8);
#endif
#if DEBUG_CHECK == 4
    check_stale(p, (const unsigned*)(launder(p.ws) + OFF_H0B), (unsigned)((size_t)T * 512), 9);
#endif
#if PHASE_MASK & 2
    {
        unsigned char* ws = launder(p.ws); unsigned char* ob = launder((unsigned char*)p.out);
        pg8::Gemm g{(const bf16_t*)(ws + OFF_H0B), (const bf16_t*)(ws + OFF_WIN), TPAD, 2048, 1024, 1024, 1024};
        pg8::StaticOrder S; S.init(TPAD, 2048, G, blockIdx.x);
        Epi<0> E{(bf16_t*)(ws + OFF_P), NPP, (const float*)(ws + OFF_R0), (float*)(ws + OFF_SQQP), (float*)(ws + OFF_SQKVP), (bf16_t*)(ob + DO_KR), (const float2*)(ws + OFF_RT)};
        pg8::gemm_phase(lds, g, S, E);
    }
#endif
    GSYNC();
#if DEBUG_CHECK == 1
    { unsigned char* ws = launder(p.ws); check_gemm((const bf16_t*)(ws + OFF_H0B), 1024, (const bf16_t*)(ws + OFF_WIN), 1024, 1024, T, 1984, 0, (const bf16_t*)(ws + OFF_P), NPP, (const float*)(ws + OFF_R0), (unsigned*)(ws + OFF_DBG) + 0, 448); }
    GSYNC();
#endif
#if DEBUG_CHECK == 3
    check_h0b(p, 9);
#endif
#if DEBUG_CHECK == 8
    check_p_golden(p);
#endif
#if DEBUG_CHECK == 9
    check_win_r0(p);
#endif
#if DEBUG_CHECK == 7
    check_h0b_full(p, 9);
    GSYNC();
#endif
#if DEBUG_CHECK == 6
    { unsigned char* ws = launder(p.ws);
      check_gemm((const bf16_t*)(ws + OFF_H0B), 1024, (const bf16_t*)(ws + OFF_WIN), 1024, 1024, T, 448, 0, (const bf16_t*)(ws + OFF_P), NPP, (const float*)(ws + OFF_R0), (unsigned*)(ws + OFF_DBG) + 8, 384);
      check_gemm((const bf16_t*)(ws + OFF_H0B), 1024, (const bf16_t*)(ws + OFF_WIN), 1024, 1024, T, 384, 7, (const bf16_t*)(ws + OFF_P), NPP, (const float*)(ws + OFF_R0), (unsigned*)(ws + OFF_DBG) + 9, 0); }
    GSYNC();
#endif
#if DEBUG_CHECK == 4
    check_stale(p, (const unsigned*)(launder(p.ws) + OFF_P), (unsigned)((size_t)T * 1024), 8);
#endif
    rownorm_phase(p);
    krope_phase(p);
    GSYNC();
#if (PHASE_MASK & 4) && (SUB2 & 1)
    {
        unsigned char* ws = launder(p.ws); unsigned char* ob = launder((unsigned char*)p.out);
        pg8::Gemm g{(const bf16_t*)(ws + OFF_P), (const bf16_t*)(ws + OFF_WUQ), TPAD, 768, 256, NPP, 256};
        pg8::StaticOrder S; S.init(TPAD, 768, G, blockIdx.x);
        Epi<1> E{(bf16_t*)(ob + DO_Q), 768, (const float*)(ws + OFF_RQ), nullptr, nullptr, nullptr, (const float2*)(ws + OFF_RT)};
        pg8::gemm_phase(lds, g, S, E);
    }
#endif
#if (PHASE_MASK & 4) && (SUB2 & 2)
    {
        unsigned char* ws = launder(p.ws); unsigned char* ob = launder((unsigned char*)p.out);
        pg8::Gemm g{(const bf16_t*)(ws + OFF_P) + 256, (const bf16_t*)(ws + OFF_WKN), TPAD, 512, 128, NPP, 128};
        pg8::StaticOrder S; S.init(TPAD, 512, G, blockIdx.x);
        Epi<2> E{(bf16_t*)(ob + DO_KN), 512, (const float*)(ws + OFF_RKV), nullptr, nullptr, nullptr, nullptr};
        pg8::gemm_phase(lds, g, S, E);
    }
#endif
#if (PHASE_MASK & 4) && (SUB2 & 4)
    {
        unsigned char* ws = launder(p.ws); unsigned char* ob = launder((unsigned char*)p.out);
        pg8::Gemm g{(const bf16_t*)(ws + OFF_WV), (const bf16_t*)(ws + OFF_P) + 256, 512, TPAD, 128, 128, NPP};
        pg8::StaticOrder S; S.init(512, TPAD, G, blockIdx.x);
        Epi<3> E{(bf16_t*)(ob + DO_VT), TPAD, (const float*)(ws + OFF_RKV), nullptr, nullptr, nullptr, nullptr};
        pg8::gemm_phase(lds, g, S, E);
    }
#endif
#if PHASE_MASK & 8
    hyprep_phase(p, lds);
#endif
    GSYNC();
#if DEBUG_CHECK == 2
    check_proj(p);
    GSYNC();
#endif
#if DEBUG_CHECK == 11
    check_filt_prep(p);
    GSYNC();
#endif
#if PHASE_MASK & 16
    attn_phase(p, lds);
#endif
#if PHASE_MASK & 32
    hyena_phase(p, lds);
#endif
    GSYNC();
#if DEBUG_CHECK == 5
    check_attn(p);
    check_hyena(p, lds);
    GSYNC();
#endif
#if PHASE_MASK & 64
    mixnorm_phase(p, lds);
#endif
    GSYNC();
#if PHASE_MASK & 128
    {
        unsigned char* ws = launder(p.ws);
        pg8::Gemm g{(const bf16_t*)(ws + OFF_MIXN), (const bf16_t*)(ws + OFF_WO), TN, 1024, 1024, 1024, 1024};
        pg8::StaticOrder S; S.init(TN, 1024, G, blockIdx.x);
        Epi<4> E{(bf16_t*)(ws + OFF_MIX), 1024, nullptr, (float*)(ws + OFF_SQMIXP), nullptr, nullptr, nullptr};
        pg8::gemm_phase(lds, g, S, E);
    }
#endif
    GSYNC();
#if DEBUG_CHECK == 1
    { unsigned char* ws = launder(p.ws); check_gemm((const bf16_t*)(ws + OFF_MIXN), 1024, (const bf16_t*)(ws + OFF_WO), 1024, 1024, TN, 1024, 4, (const bf16_t*)(ws + OFF_MIX), 1024, nullptr, (unsigned*)(ws + OFF_DBG) + 1, 0); }
#endif
#if DEBUG_CHECK == 10
    check_x(p, 1);
#endif
#if PHASE_MASK & 256
    h1_phase(p);
#endif
    GSYNC();
#if PHASE_MASK & 512
#if DEBUG_CHECK == 1
#define DBG_FF1(half) if ((half) == 0) { unsigned char* ws = launder(p.ws); check_gemm((const bf16_t*)(ws + OFF_H1B), 1024, (const bf16_t*)(ws + OFF_WF1), 1024, 1024, 65536, 4096, 5, (const bf16_t*)(ws + OFF_M), 4096, (const float*)(ws + OFF_R1), (unsigned*)(ws + OFF_DBG) + 2, 0); }
#define DBG_FF2(half) if ((half) == 0) { unsigned char* ws = launder(p.ws); check_gemm((const bf16_t*)(ws + OFF_M), 4096, (const bf16_t*)(ws + OFF_WF2), 4096, 4096, 65536, 1024, 6, (const bf16_t*)(ws + OFF_M2), 1024, nullptr, (unsigned*)(ws + OFF_DBG) + 3, 0); } GSYNC();
#else
#define DBG_FF1(half)
#define DBG_FF2(half)
#endif
#define FFN_HALF(half) \
    { \
        unsigned char* ws = launder(p.ws); \
        pg8::Gemm g{(const bf16_t*)(ws + OFF_H1B) + (size_t)(half) * 65536 * 1024, (const bf16_t*)(ws + OFF_WF1), 65536, 4096, 1024, 1024, 1024}; \
        pg8::StaticOrder S; S.init(65536, 4096, G, blockIdx.x); \
        Epi<5> E{(bf16_t*)(ws + OFF_M), 4096, (const float*)(ws + OFF_R1) + (half) * 65536, nullptr, nullptr, nullptr, nullptr}; \
        pg8::gemm_phase(lds, g, S, E); \
    } \
    GSYNC(); \
    DBG_FF1(half) \
    { \
        unsigned char* ws = launder(p.ws); \
        pg8::Gemm g{(const bf16_t*)(ws + OFF_M), (const bf16_t*)(ws + OFF_WF2), 65536, 1024, 4096, 4096, 4096}; \
        pg8::StaticOrder S; S.init(65536, 1024, G, blockIdx.x); \
        Epi<6> E{(bf16_t*)(ws + OFF_M2), 1024, nullptr, (float*)(ws + OFF_SQM2P) + (size_t)(half) * 65536 * 16, nullptr, nullptr, nullptr}; \
        pg8::gemm_phase(lds, g, S, E); \
    } \
    GSYNC(); \
    DBG_FF2(half) \
    final_phase(p, half);
    FFN_HALF(0)
    FFN_HALF(1)
#undef FFN_HALF
#endif
}

extern "C" void kernel_launch(void* const* d_in, const int* in_sizes, int n_in, void* d_out, int out_size, void* d_ws, size_t ws_size, hipStream_t stream) {
    static int grid = 0;
    if (grid == 0) {
        int dev = 0, cus = 0, per_cu = 0;
        hipGetDevice(&dev);
        hipDeviceGetAttribute(&cus, hipDeviceAttributeMultiprocessorCount, dev);
        hipFuncSetAttribute((const void*)hymba_fwd, hipFuncAttributeMaxDynamicSharedMemorySize, LDS_BYTES);
        hipOccupancyMaxActiveBlocksPerMultiprocessor(&per_cu, (const void*)hymba_fwd, 512, LDS_BYTES);
        if (per_cu < 1) per_cu = 1;
        grid = cus * 1;
        if (n_in != 26 || ws_size < 1024 * MiB) fprintf(stderr, "kernel_launch: unexpected n_in %d / ws_size %zu\n", n_in, ws_size);
    }
    Params p{};
    for (int i = 0; i < 26; ++i) p.in[i] = (const float*)d_in[i];
    p.out = (float*)d_out; p.ws = (unsigned char*)d_ws;
    void* args[] = {&p};
    hipError_t e = hipLaunchCooperativeKernel((const void*)hymba_fwd, dim3(grid), dim3(512), args, LDS_BYTES, stream);
    if (e != hipSuccess) fprintf(stderr, "cooperative launch failed: %s (grid %d)\n", hipGetErrorString(e), grid);
}
```

```cpp
#include <hip/hip_runtime.h>
#include <hip/hip_cooperative_groups.h>
#include <cstdio>
#include <cstdint>
namespace cg = cooperative_groups;
#ifndef DBG_SEL0
#define DBG_SEL0 3
#endif
#ifndef DBG_SEL1
#define DBG_SEL1 0
#endif
#ifndef DEBUG_CHECK
#define DEBUG_CHECK 0
#endif
#ifndef EXPT
#define EXPT 0
#endif
#ifndef SUB_MASK
#define SUB_MASK 15
#endif
#ifndef SUB2
#define SUB2 7
#endif

#define LAS __attribute__((address_space(3)))
typedef unsigned short bf16_t;
typedef short bf16x8 __attribute__((ext_vector_type(8)));
typedef float f32x4 __attribute__((ext_vector_type(4)));
typedef float f32x16 __attribute__((ext_vector_type(16)));
typedef unsigned u32x4 __attribute__((ext_vector_type(4)));
typedef unsigned u32x2 __attribute__((ext_vector_type(2)));

constexpr int DM = 1024, LP = 8208, LS = 2064, NBP = 8, NBS = 32;
constexpr int TPR = NBP * LP;
constexpr int TSR = NBS * LS;
constexpr int T = TPR + TSR;
constexpr int TPAD = 131840;
constexpr int TN = 131072;
constexpr int NPP = 2048;
constexpr int LGP = 8256, LGS = 2112;
constexpr float EPS = 1e-6f;
constexpr float QSCALE = 0.07216878364870322f * 1.4426950408889634f;

constexpr size_t MiB = 1ull << 20;
constexpr size_t OFF_H0B = 0;
constexpr size_t XT_SET1 = (size_t)512 * NBP * LGP;
constexpr size_t OFF_X1T = 0;
constexpr size_t OFF_X2T = 131 * MiB;
constexpr size_t OFF_P = 262 * MiB;
constexpr size_t OFF_V0T = 778 * MiB;
constexpr size_t OFF_MIXN = 262 * MiB;
constexpr size_t OFF_MIX = 518 * MiB;
constexpr size_t OFF_H1B = 0;
constexpr size_t OFF_M = 256 * MiB;
constexpr size_t OFF_M2 = 768 * MiB;
constexpr size_t OFF_SQMIXP = 896 * MiB;
constexpr size_t OFF_SQM2P = 904 * MiB;
constexpr size_t OFF_SMALL = 912 * MiB;
constexpr size_t OFF_WIN = OFF_SMALL;
constexpr size_t OFF_WUQ = OFF_SMALL + 4 * MiB;
constexpr size_t OFF_WKN = OFF_SMALL + 4 * MiB + 512 * 1024;
constexpr size_t OFF_WV = OFF_SMALL + 4 * MiB + 768 * 1024;
constexpr size_t OFF_WO = OFF_SMALL + 5 * MiB;
constexpr size_t OFF_WF1 = OFF_SMALL + 7 * MiB;
constexpr size_t OFF_WF2 = OFF_SMALL + 15 * MiB;
constexpr size_t OFF_GR0 = OFF_SMALL + 23 * MiB;
constexpr size_t OFF_GR1 = OFF_SMALL + 56 * MiB;
constexpr size_t OFF_RT = OFF_SMALL + 65 * MiB;
constexpr size_t OFF_R0 = OFF_SMALL + 68 * MiB;
constexpr size_t OFF_R1 = OFF_SMALL + 69 * MiB;
constexpr size_t OFF_RQ = OFF_SMALL + 70 * MiB;
constexpr size_t OFF_RKV = OFF_SMALL + 71 * MiB;
constexpr size_t OFF_SQQP = OFF_SMALL + 72 * MiB;
constexpr size_t OFF_SQKVP = OFF_SMALL + 75 * MiB;
constexpr size_t OFF_DBGW = OFF_SMALL + 78 * MiB;
constexpr size_t DO_Q = 0;
constexpr size_t DO_KN = 194 * MiB;
constexpr size_t DO_KR = 323 * MiB;
constexpr size_t DO_VT = 340 * MiB;

constexpr size_t OFF_ODBG = 518 * MiB;
constexpr size_t OFF_HDBG = 647 * MiB;
constexpr int LDS_BYTES = 147456;

struct Params {
    const float* in[26];
    float* out;
    unsigned char* ws;
};

__device__ __forceinline__ f32x4 ld_sys(const float* q) { f32x4 v; asm volatile("global_load_dwordx4 %0, %1, off sc0 sc1\n\ts_waitcnt vmcnt(0)" : "=v"(v) : "v"(q) : "memory"); return v; }
__device__ __forceinline__ float ldco(const float* q) { return __builtin_bit_cast(float, __hip_atomic_load((const unsigned*)q, __ATOMIC_RELAXED, __HIP_MEMORY_SCOPE_AGENT)); }
__device__ __forceinline__ float2 ldco2(const float2* q) { const unsigned long long w = __hip_atomic_load((const unsigned long long*)q, __ATOMIC_RELAXED, __HIP_MEMORY_SCOPE_AGENT); return make_float2(__builtin_bit_cast(float, (unsigned)w), __builtin_bit_cast(float, (unsigned)(w >> 32))); }
template <class Tp> __device__ __forceinline__ Tp* launder(Tp* q) { asm volatile("" : "+s"(q)); return q; }
__device__ __forceinline__ int tid_l() { int t = threadIdx.x; asm volatile("" : "+v"(t)); return t; }
__device__ __forceinline__ unsigned cvt_pk_bf16(float lo, float hi) { unsigned r; asm volatile("v_cvt_pk_bf16_f32 %0, %1, %2" : "=v"(r) : "v"(lo), "v"(hi)); return r; }
__device__ __forceinline__ float bf2f(unsigned short b) { return __builtin_bit_cast(float, (unsigned)b << 16); }
__device__ __forceinline__ float bflo(unsigned w) { return __builtin_bit_cast(float, w << 16); }
__device__ __forceinline__ float bfhi(unsigned w) { return __builtin_bit_cast(float, w & 0xffff0000u); }
__device__ __forceinline__ float wave_sum(float v) {
#pragma unroll
    for (int o = 1; o < 64; o <<= 1) v += __shfl_xor(v, o);
    return v;
}
__device__ __forceinline__ void sincos_red(float x, float& s, float& c) {
    const double xd = (double)x; const double k = rint(xd * 0.15915494309189535); const float r = (float)(xd - k * 6.283185307179586);
    s = __sinf(r); c = __cosf(r);
}
__device__ __forceinline__ float sin_red(float x) { float s, c; sincos_red(x, s, c); return s; }
__device__ __forceinline__ void row_info(int r, int& pos, int& seq) {
    if (r < TPR) { seq = r / LP; pos = r - seq * LP; }
    else { int q = r - TPR; if (q >= TSR) q = TSR - 1; const int b = q / LS; pos = q - b * LS; seq = NBP + b; }
}
__device__ __forceinline__ int full_row(int n) {
    if (n < 65536) { const int b = n >> 13; return b * LP + 16 + (n & 8191); }
    const int q = n - 65536; const int b = q >> 11; return TPR + b * LS + 16 + (q & 2047);
}

namespace pg8 {
constexpr int BM = 256, BK = 64, HALF = 128, HTB = HALF * BK * 2, STAGE_BYTES = 8 * HTB, NXCD = 8, WGM = 8;
__host__ __device__ __forceinline__ int lds_byte(int r, int c) { const int st = (r >> 4) * 2 + (c >> 5), rr = r & 15, cc = c & 31, ob = rr * 64 + cc * 2; return st * 1024 + (ob ^ (((ob >> 9) & 1) << 5)); }
__host__ __device__ __forceinline__ void stage_rc(int b, int& R, int& C) { const int st = b / 1024, sb = b % 1024, swz = sb ^ (((sb >> 9) & 1) << 5); R = (st >> 1) * 16 + swz / 64; C = (st & 1) * 32 + (swz % 64) / 2; }
__host__ __device__ __forceinline__ int perm32(int rho) { const int n = rho >> 4, i = rho & 15; return 8 * (i >> 2) + 4 * n + (i & 3); }
struct Unit { int pm, pn; };
struct Gemm { const bf16_t* A; const bf16_t* Bt; int M, N, K, lda, ldb; };
struct StaticOrder {
    int nM, nN, nwg, G, c;
    __device__ void init(int M, int N, int G_, int c_) { nM = M / BM; nN = N / BM; nwg = nM * nN; G = G_; c = c_; }
    __device__ bool next(int i, Unit& u) const {
        const long L = (long)i * G + c; if (L >= nwg) return false;
        int wgid = (int)L; { const int q = nwg / NXCD, r = nwg % NXCD, xcd = wgid % NXCD, off = wgid / NXCD; wgid = (xcd < r ? xcd * (q + 1) : r * (q + 1) + (xcd - r) * q) + off; }
        const int nig = WGM * nN, gid = wgid / nig, fm = gid * WGM, gsz = (nM - fm) < WGM ? (nM - fm) : WGM;
        u.pm = fm + ((wgid % nig) % gsz); u.pn = (wgid % nig) / gsz; return true;
    }
};
template <class Epi>
__device__ __forceinline__ void gemm_phase(LAS unsigned char* lds, const Gemm g, const StaticOrder& S, const Epi& E) {
    const int tid = tid_l(), wid = __builtin_amdgcn_readfirstlane(tid >> 6), lane = tid & 63, wr = wid >> 2, wc = wid & 3, fr = lane & 15, fq = lane >> 4;
    const int K = g.K, nt = K / BK;
    unsigned voffA[2], voffB[2];
#pragma unroll
    for (int i = 0; i < 2; ++i) { int R, C; stage_rc(tid * 16 + i * 8192, R, C); const int Rb = (R & ~31) + perm32(R & 31);
        voffA[i] = (unsigned)(R * g.lda + C) * 2u; voffB[i] = (unsigned)(Rb * g.ldb + C) * 2u; }
    const size_t kstep = (size_t)(BK * 2);
    const size_t hstepA = (size_t)HALF * g.lda * 2, hstepB = (size_t)HALF * g.ldb * 2;
    const size_t tstepA = 2 * hstepA, tstepB = 2 * hstepB;
    const unsigned ldsw = (unsigned)wid * 1024u;
    const int aoff = lds_byte(wr * 64 + fr, fq * 8), boff = lds_byte(wc * 32 + fr, fq * 8);
#define PG8_SA(b, h) (((b) * 2 + (h)) * HTB)
#define PG8_SB(b, h) ((4 + (b) * 2 + (h)) * HTB)
#define PG8_STAGE(bufoff, gbase, voff) do { _Pragma("unroll") for (int _i = 0; _i < 2; ++_i) \
        __builtin_amdgcn_global_load_lds((const unsigned*)((const char*)(gbase) + (voff)[_i]), (LAS unsigned*)(lds + (bufoff) + ldsw + _i * 8192), 16, 0, 0); } while (0)
#define PG8_LDA(dst, b, h) do { _Pragma("unroll") for (int m = 0; m < 4; ++m) _Pragma("unroll") for (int k = 0; k < 2; ++k) dst[m][k] = *(const LAS bf16x8*)(lds + PG8_SA(b, h) + aoff + m * 2048 + k * 1024); } while (0)
#define PG8_LDB(dst, b, h) do { _Pragma("unroll") for (int n = 0; n < 2; ++n) _Pragma("unroll") for (int k = 0; k < 2; ++k) dst[n][k] = *(const LAS bf16x8*)(lds + PG8_SB(b, h) + boff + n * 2048 + k * 1024); } while (0)
#define PG8_MMA(ai, bj, At, Bt) do { __builtin_amdgcn_s_setprio(1); _Pragma("unroll") for (int m = 0; m < 4; ++m) _Pragma("unroll") for (int n = 0; n < 2; ++n) _Pragma("unroll") for (int k = 0; k < 2; ++k) \
        acc[ai][bj][m][n] = __builtin_amdgcn_mfma_f32_16x16x32_bf16(Bt[n][k], At[m][k], acc[ai][bj][m][n], 0, 0, 0); __builtin_amdgcn_s_setprio(0); } while (0)
#define PG8_WAIT_V(n) asm volatile("s_waitcnt vmcnt(" #n ")" ::: "memory")
#define PG8_WAIT_L(n) asm volatile("s_waitcnt lgkmcnt(" #n ")" ::: "memory")
#define PG8_BAR __builtin_amdgcn_s_barrier()
#define PG8_SCHED __builtin_amdgcn_sched_barrier(0)
    Unit cur, nxt; int ui = 0;
    if (!S.next(0, cur)) return;
    f32x4 acc[2][2][4][2];
#pragma unroll
    for (int a = 0; a < 2; ++a)
#pragma unroll
        for (int b = 0; b < 2; ++b)
#pragma unroll
            for (int m = 0; m < 4; ++m)
#pragma unroll
                for (int n = 0; n < 2; ++n) acc[a][b][m][n] = (f32x4){0.f, 0.f, 0.f, 0.f};
    bf16x8 At[4][2], B0[2][2], B1[2][2];
    const char* cA = (const char*)g.A + (size_t)cur.pm * tstepA; const char* cB = (const char*)g.Bt + (size_t)cur.pn * tstepB;
    PG8_STAGE(PG8_SB(0, 0), cB, voffB); PG8_STAGE(PG8_SB(0, 1), cB + hstepB, voffB); PG8_STAGE(PG8_SA(0, 0), cA, voffA); PG8_STAGE(PG8_SA(0, 1), cA + hstepA, voffA);
    if (wr == 1) PG8_BAR;
    PG8_WAIT_V(2); PG8_BAR;
    PG8_STAGE(PG8_SB(1, 0), cB + kstep, voffB); PG8_STAGE(PG8_SA(1, 0), cA + kstep, voffA); PG8_STAGE(PG8_SB(1, 1), cB + hstepB + kstep, voffB);
    PG8_WAIT_V(6); PG8_BAR;
    for (;;) {
        const bool has_next = S.next(ui + 1, nxt);
        const char* nA = has_next ? (const char*)g.A + (size_t)nxt.pm * tstepA : cA; const char* nB = has_next ? (const char*)g.Bt + (size_t)nxt.pn * tstepB : cB;
        for (int t = 0; t < nt; t += 2) {
            const bool last = (t == nt - 2);
            const char* a1 = cA + (size_t)(t + 1) * kstep;
            const char* a2 = last ? nA : cA + (size_t)(t + 2) * kstep; const char* b2 = last ? nB : cB + (size_t)(t + 2) * kstep;
            const char* a3 = a2 + kstep; const char* b3 = b2 + kstep;
            PG8_LDB(B0, 0, 0); PG8_LDB(B1, 0, 1); PG8_SCHED; PG8_LDA(At, 0, 0); PG8_STAGE(PG8_SA(1, 1), a1 + hstepA, voffA);
            PG8_WAIT_V(8); PG8_WAIT_L(0); PG8_BAR; PG8_MMA(0, 0, At, B0); PG8_MMA(0, 1, At, B1); PG8_BAR; PG8_SCHED;
            PG8_LDA(At, 0, 1); PG8_STAGE(PG8_SB(0, 0), b2, voffB); PG8_STAGE(PG8_SB(0, 1), b2 + hstepB, voffB); PG8_STAGE(PG8_SA(0, 0), a2, voffA);
            PG8_WAIT_V(8); PG8_WAIT_L(0); PG8_BAR; PG8_MMA(1, 0, At, B0); PG8_MMA(1, 1, At, B1); PG8_BAR; PG8_SCHED;
            PG8_LDB(B0, 1, 0); PG8_LDB(B1, 1, 1); PG8_SCHED; PG8_LDA(At, 1, 0); PG8_STAGE(PG8_SA(0, 1), a2 + hstepA, voffA);
            PG8_WAIT_V(8); PG8_WAIT_L(0); PG8_BAR; PG8_MMA(0, 0, At, B0); PG8_MMA(0, 1, At, B1); PG8_BAR; PG8_SCHED;
            PG8_LDA(At, 1, 1); PG8_STAGE(PG8_SB(1, 0), b3, voffB); PG8_STAGE(PG8_SB(1, 1), b3 + hstepB, voffB); PG8_STAGE(PG8_SA(1, 0), a3, voffA);
            PG8_WAIT_V(8); PG8_WAIT_L(0); PG8_BAR; PG8_MMA(1, 0, At, B0); PG8_MMA(1, 1, At, B1); PG8_BAR; PG8_SCHED;
        }
        if (wr == 0) PG8_BAR;
        E(acc, cur, wr, wc, fr, fq);
        if (!has_next) break;
#pragma unroll
        for (int a = 0; a < 2; ++a)
#pragma unroll
            for (int b = 0; b < 2; ++b)
#pragma unroll
                for (int m = 0; m < 4; ++m)
#pragma unroll
                    for (int n = 0; n < 2; ++n) acc[a][b][m][n] = (f32x4){0.f, 0.f, 0.f, 0.f};
        cur = nxt; cA = nA; cB = nB; ++ui;
        if (wr == 1) PG8_BAR;
    }
    PG8_WAIT_V(0);
    PG8_BAR;
#undef PG8_SA
#undef PG8_SB
#undef PG8_STAGE
#undef PG8_LDA
#undef PG8_LDB
#undef PG8_MMA
#undef PG8_WAIT_V
#undef PG8_WAIT_L
#undef PG8_BAR
#undef PG8_SCHED
}
}

__device__ __forceinline__ void rope8(f32x4& v0, f32x4& v1, const float2* rt  ) {
    const float2 c0 = ldco2(rt), c1 = ldco2(rt + 1), c2 = ldco2(rt + 2), c3 = ldco2(rt + 3);
    float a, b;
    a = v0[0]; b = v0[1]; v0[0] = a * c0.x - b * c0.y; v0[1] = b * c0.x + a * c0.y;
    a = v0[2]; b = v0[3]; v0[2] = a * c1.x - b * c1.y; v0[3] = b * c1.x + a * c1.y;
    a = v1[0]; b = v1[1]; v1[0] = a * c2.x - b * c2.y; v1[1] = b * c2.x + a * c2.y;
    a = v1[2]; b = v1[3]; v1[2] = a * c3.x - b * c3.y; v1[3] = b * c3.x + a * c3.y;
}
__device__ __forceinline__ u32x4 pack8(const f32x4& v0, const f32x4& v1) {
    u32x4 w; w.x = cvt_pk_bf16(v0[0], v0[1]); w.y = cvt_pk_bf16(v0[2], v0[3]); w.z = cvt_pk_bf16(v1[0], v1[1]); w.w = cvt_pk_bf16(v1[2], v1[3]); return w;
}
__device__ __forceinline__ float sq8(const f32x4& a, const f32x4& b) {
    return (a[0] * a[0] + a[1] * a[1]) + (a[2] * a[2] + a[3] * a[3]) + (b[0] * b[0] + b[1] * b[1]) + (b[2] * b[2] + b[3] * b[3]);
}
template <int MODE> struct Epi {
    bf16_t* O; int ldc; const float* rs; float* sq0; float* sq1; bf16_t* KR; const float2* RT;
    __device__ __forceinline__ void operator()(const f32x4 (&acc)[2][2][4][2], const pg8::Unit& u, int wr, int wc, int fr, int fq) const {
#pragma unroll
        for (int ai = 0; ai < 2; ++ai)
#pragma unroll
            for (int m = 0; m < 4; ++m) {
                const int row = u.pm * 256 + ai * 128 + wr * 64 + m * 16 + fr;
                float sc = 1.f;
                if (MODE == 0 || MODE == 1 || MODE == 2 || MODE == 5) sc = ldco(rs + row);
                float ssum[2];
#pragma unroll
                for (int bj = 0; bj < 2; ++bj) {
                    const int col0 = u.pn * 256 + bj * 128 + wc * 32 + 8 * fq;
                    f32x4 v0 = acc[ai][bj][m][0] * sc, v1 = acc[ai][bj][m][1] * sc;
                    if (MODE == 3) {
#pragma unroll
                        for (int j = 0; j < 4; ++j) { v0[j] *= ldco(rs + col0 + j); v1[j] *= ldco(rs + col0 + 4 + j); }
                    }
                    if (MODE == 5) {
#pragma unroll
                        for (int j = 0; j < 4; ++j) { const float a = fmaxf(v0[j], 0.f), b = fmaxf(v1[j], 0.f); v0[j] = a * a; v1[j] = b * b; }
                    }
                    ssum[bj] = sq8(v0, v1);
                    *(u32x4*)(O + (size_t)row * ldc + col0) = pack8(v0, v1);
                }
                if (MODE == 0) {
                    if (u.pn == 0) { float s = ssum[0] + ssum[1]; s += __shfl_xor(s, 16); s += __shfl_xor(s, 32); if (fq == 0) sq0[row * 4 + wc] = s; }
                    else if (u.pn == 1) { float s = ssum[0]; s += __shfl_xor(s, 16); s += __shfl_xor(s, 32); if (fq == 0) sq1[row * 4 + wc] = s; }
                }
                if (MODE == 4 || MODE == 6) { float s = ssum[0] + ssum[1]; s += __shfl_xor(s, 16); s += __shfl_xor(s, 32); if (fq == 0) sq0[(size_t)row * 16 + u.pn * 4 + wc] = s; }
            }
    }
};

__device__ __forceinline__ int src_col(int mode, int n) {
    if (mode == 0) return n;
    if (mode == 1) { if (n >= 1984) return -1; if (n >= 384 && n < 448) { const int j = n - 384; return 384 + ((j & 1) ? 32 + (j >> 1) : (j >> 1)); } return n; }
    if (mode == 2) { const int h = n / 192, w = n % 192; if (w < 128) return n; const int j = w - 128; return h * 192 + 128 + ((j & 1) ? 32 + (j >> 1) : (j >> 1)); }
    if (mode == 3) return (n >> 7) * 256 + (n & 127);
    return (n >> 7) * 256 + 128 + (n & 127);
}
__device__ __forceinline__ void conv_weight(const float* W, const float* g, bf16_t* out, int K, int Nsrc, int Nout, int mode, int gtid, int gthreads) {
    const int nch = Nout * (K / 8);
    for (int e = gtid; e < nch; e += gthreads) {
        const int n = e % Nout, kc = e / Nout, k0 = kc * 8; const int sc = src_col(mode, n);
        float v[8];
#pragma unroll
        for (int j = 0; j < 8; ++j) v[j] = (sc >= 0) ? W[(size_t)(k0 + j) * Nsrc + sc] * (g ? g[k0 + j] : 1.f) : 0.f;
        u32x4 w; w.x = cvt_pk_bf16(v[0], v[1]); w.y = cvt_pk_bf16(v[2], v[3]); w.z = cvt_pk_bf16(v[4], v[5]); w.w = cvt_pk_bf16(v[6], v[7]);
        *(u32x4*)(out + (size_t)n * K + k0) = w;
    }
}

__device__ __forceinline__ void p0_prologue(const Params& p, LAS unsigned char* lds) {
    unsigned char* ws = launder(p.ws);
    const int tid = tid_l(), lane = tid & 63, wave = tid >> 6, G = gridDim.x;
    const int gtid = blockIdx.x * 512 + tid, gthreads = G * 512;
    const int gw = blockIdx.x * 8 + wave, NGW = G * 8;
#if SUB_MASK & 1
    conv_weight(p.in[4], p.in[3], (bf16_t*)(ws + OFF_WIN), 1024, 1984, 2048, 1, gtid, gthreads);
    conv_weight(p.in[6], p.in[5], (bf16_t*)(ws + OFF_WUQ), 256, 768, 768, 2, gtid, gthreads);
    conv_weight(p.in[8], p.in[7], (bf16_t*)(ws + OFF_WKN), 128, 1024, 512, 3, gtid, gthreads);
    conv_weight(p.in[8], p.in[7], (bf16_t*)(ws + OFF_WV), 128, 1024, 512, 4, gtid, gthreads);
    conv_weight(p.in[20], nullptr, (bf16_t*)(ws + OFF_WO), 1024, 1024, 1024, 0, gtid, gthreads);
    conv_weight(p.in[23], p.in[22], (bf16_t*)(ws + OFF_WF1), 1024, 4096, 4096, 0, gtid, gthreads);
    conv_weight(p.in[24], nullptr, (bf16_t*)(ws + OFF_WF2), 4096, 1024, 1024, 0, gtid, gthreads);
#endif
#if SUB_MASK & 2
#if DEBUG_CHECK
    if (blockIdx.x == 0 && tid < 64) ((unsigned*)(ws + OFF_DBGW))[tid] = 0u;
#endif
    {
        float2* RT = (float2*)(ws + OFF_RT);
        for (int e = gtid; e < LP * 32; e += gthreads) {
            const int pos = e >> 5, i = e & 31;
            const float inv = 1.0f / exp2f((float)i * (13.287712379549449f / 32.f));
            float s, c; sincos_red((float)pos * inv, s, c);
            RT[e] = make_float2(c, s);
        }
    }
#endif
#if SUB_MASK & 4
    {
        bf16_t* h0b = (bf16_t*)(ws + OFF_H0B); float* r0 = (float*)(ws + OFF_R0);
        for (int r = gw; r < TPAD; r += NGW) {
            u32x2* o = (u32x2*)(h0b + (size_t)r * 1024) + lane;
            if (r >= T) {
#pragma unroll
                for (int j = 0; j < 4; ++j) o[64 * j] = (u32x2){0u, 0u};
                if (lane == 0) __hip_atomic_store(r0 + r, 0.f, __ATOMIC_RELAXED, __HIP_MEMORY_SCOPE_AGENT);
                continue;
            }
            int pos, seq; row_info(r, pos, seq);
            const float* src = pos < 16 ? p.in[2] + (size_t)pos * 1024
                                        : (seq < NBP ? p.in[0] + ((size_t)seq * 8192 + (pos - 16)) * 1024 : p.in[1] + ((size_t)(seq - NBP) * 2048 + (pos - 16)) * 1024);
            const f32x4* xr = (const f32x4*)src + lane;
            f32x4 v[4]; float ss = 0.f;
#pragma unroll
            for (int j = 0; j < 4; ++j) { v[j] = xr[64 * j]; ss += (v[j][0] * v[j][0] + v[j][1] * v[j][1]) + (v[j][2] * v[j][2] + v[j][3] * v[j][3]); }
            ss = wave_sum(ss);
#pragma unroll
            for (int j = 0; j < 4; ++j) o[64 * j] = (u32x2){cvt_pk_bf16(v[j][0], v[j][1]), cvt_pk_bf16(v[j][2], v[j][3])};
            if (lane == 0) __hip_atomic_store(r0 + r, rsqrtf(ss * (1.f / 1024.f) + EPS), __ATOMIC_RELAXED, __HIP_MEMORY_SCOPE_AGENT);
        }
    }
#endif
#if SUB_MASK & 8
    {
        const float* f_w1 = p.in[10]; const float* f_b1 = p.in[11]; const float* f_freq = p.in[12]; const float* f_w2 = p.in[13];
        const float* f_b2 = p.in[14]; const float* f_w3 = p.in[15]; const float* f_decay = p.in[16];
        LAS float* feats = (LAS float*)lds;
        LAS float* h1 = feats + 16 * 34;
        LAS float* h2 = h1 + 16 * 64;
        for (int u = blockIdx.x; u < 513 + 129; u += G) {
            const int set = u < 513 ? 0 : 1; const int t0 = 16 * (set ? u - 513 : u); const int L = set ? LS : LP; const int C0 = set ? LGS : LGP;
            bf16_t* GR = (bf16_t*)(ws + (set ? OFF_GR1 : OFF_GR0));
            const float invLm1 = 1.0f / (float)(L - 1);
            if (tid < 256) {
                const int tt = tid >> 4, k = tid & 15; const int t = t0 + tt;
                const float w = (6.2831853071795865f * (float)t) / (float)L;
                const float f = 1e-4f + (float)k * ((15.0f - 1e-4f) / 15.0f);
                float s, c; sincos_red(f * w, s, c);
                feats[tt * 34 + 1 + k] = c; feats[tt * 34 + 17 + k] = -s;
                if (k == 0) feats[tt * 34] = (float)t * invLm1;
            }
            __syncthreads();
#pragma unroll 1
            for (int q = 0; q < 2; ++q) {
                const int o = tid + 512 * q, tt = o >> 6, j = o & 63;
                float a = f_b1[j];
#pragma unroll 3
                for (int e = 0; e < 33; ++e) a += feats[tt * 34 + e] * f_w1[e * 64 + j];
                h1[tt * 64 + j] = sin_red(f_freq[j] * a);
            }
            __syncthreads();
#pragma unroll 1
            for (int q = 0; q < 2; ++q) {
                const int o = tid + 512 * q, tt = o >> 6, j = o & 63;
                float a = f_b2[j];
#pragma unroll 4
                for (int e = 0; e < 64; ++e) a += h1[tt * 64 + e] * f_w2[e * 64 + j];
                h2[tt * 64 + j] = sin_red(f_freq[j] * a);
            }
            __syncthreads();
#pragma unroll 1
            for (int q = 0; q < 4; ++q) {
                const int n = tid + 512 * q;
                float a[16];
#pragma unroll
                for (int i = 0; i < 16; ++i) a[i] = 0.f;
#pragma unroll 2
                for (int j = 0; j < 64; ++j) {
                    const float w = f_w3[j * 2048 + n];
#pragma unroll
                    for (int i = 0; i < 16; ++i) a[i] += h2[i * 64 + j] * w;
                }
                const float dec = fabsf(f_decay[n]);
                const int order = n >> 10, dir = (n >> 9) & 1, c = n & 511;
                bf16_t* row = GR + (size_t)(order * 512 + c) * (2 * C0);
#pragma unroll
                for (int i = 0; i < 16; ++i) {
                    const int t = t0 + i;
                    const float val = a[i] * __expf(-((float)t * invLm1) * dec);
                    const unsigned short b = (unsigned short)(cvt_pk_bf16(val, 0.f) & 0xffffu);
                    if (dir == 0) row[C0 - t] = b; else if (t > 0) row[C0 + t] = b;
                }
            }
            __syncthreads();
        }
        for (int e = gtid; e < 2 * 1024 * 97; e += gthreads) {
            const int set = e / (1024 * 97), r = (e / 97) % 1024, i = e % 97; const int L = set ? LS : LP; const int C0 = set ? LGS : LGP;
            bf16_t* row = (bf16_t*)(ws + (set ? OFF_GR1 : OFF_GR0)) + (size_t)r * (2 * C0);
            const int idx = i < 49 ? i : C0 + L + (i - 49);
            row[idx] = 0;
        }
    }
#endif
}

__device__ __forceinline__ void rownorm_phase(const Params& p) {
    unsigned char* ws = launder(p.ws); const int gtid = blockIdx.x * 512 + tid_l(), gthreads = gridDim.x * 512;
    const float* sqq = (const float*)(ws + OFF_SQQP); const float* sqkv = (const float*)(ws + OFF_SQKVP);
    float* rq = (float*)(ws + OFF_RQ); float* rkv = (float*)(ws + OFF_RKV);
    for (int r = gtid; r < TPAD; r += gthreads) {
        const float a = (ldco(sqq + r * 4) + ldco(sqq + r * 4 + 1)) + (ldco(sqq + r * 4 + 2) + ldco(sqq + r * 4 + 3));
        const float b = (ldco(sqkv + r * 4) + ldco(sqkv + r * 4 + 1)) + (ldco(sqkv + r * 4 + 2) + ldco(sqkv + r * 4 + 3));
        rq[r] = rsqrtf(a * (1.f / 256.f) + EPS) * QSCALE; rkv[r] = rsqrtf(b * (1.f / 128.f) + EPS);
    }
}
__device__ __forceinline__ void krope_phase(const Params& p) {
    unsigned char* ws = launder(p.ws); unsigned char* ob = launder((unsigned char*)p.out);
    const int gtid = blockIdx.x * 512 + tid_l(), gthreads = gridDim.x * 512;
    const bf16_t* P = (const bf16_t*)(ws + OFF_P); bf16_t* KR = (bf16_t*)(ob + DO_KR); const float2* RT = (const float2*)(ws + OFF_RT);
    for (int e = gtid; e < TPAD * 8; e += gthreads) {
        const int row = e >> 3, ch = e & 7;
        int pos, seq; row_info(row, pos, seq);
        const u32x4 v = *(const u32x4*)(P + (size_t)row * NPP + 384 + ch * 8);
        f32x4 v0 = (f32x4){bflo(v.x), bfhi(v.x), bflo(v.y), bfhi(v.y)}, v1 = (f32x4){bflo(v.z), bfhi(v.z), bflo(v.w), bfhi(v.w)};
        rope8(v0, v1, RT + pos * 32 + ch * 4);
        *(u32x4*)(KR + (size_t)row * 64 + ch * 8) = pack8(v0, v1);
    }
}
__device__ __forceinline__ void hyprep_phase(const Params& p, LAS unsigned char* lds) {
    unsigned char* ws = launder(p.ws); const int tid = tid_l(), G = gridDim.x;
    const bf16_t* P = (const bf16_t*)(ws + OFF_P); const float* conv_w = p.in[9];
    constexpr int RSB = 1040;
    for (int u = blockIdx.x; u < 3096 + 3168; u += G) {
        int seq, j, which;
        if (u < 3096) { seq = u / 387; const int rem = u % 387; j = rem / 3; which = rem % 3; }
        else { const int v = u - 3096; seq = NBP + v / 99; const int rem = v % 99; j = rem / 3; which = rem % 3; }
        const int set = seq < NBP ? 0 : 1; const int L = set ? LS : LP; const int Lg = set ? LGS : LGP; const int NB = set ? NBS : NBP;
        const int b = set ? seq - NBP : seq; const int row0 = set ? TPR + b * LS : b * LP;
        const int posb = 64 * j - 49;
        for (int i = 0; i < 9; ++i) {
            const int id = tid + 512 * i; if (id >= 66 * 64) break;
            const int rr = id >> 6, ch = id & 63; const int pos = posb + rr;
            u32x4 v = (u32x4){0u, 0u, 0u, 0u};
            if (pos >= 0 && pos < L) v = *(const u32x4*)(P + (size_t)(row0 + pos) * NPP + 448 + which * 512 + ch * 8);
            *(LAS u32x4*)(lds + rr * RSB + ch * 16) = v;
        }
        __syncthreads();
        {
            const int c = tid; const float w0 = conv_w[which * 512 + c], w1 = conv_w[1536 + which * 512 + c], w2 = conv_w[3072 + which * 512 + c];
            bf16_t* XT = (bf16_t*)(ws + (which == 0 ? OFF_X1T : (which == 1 ? OFF_X2T : OFF_V0T))) + (set ? XT_SET1 : 0) + ((size_t)c * NB + b) * Lg + 64 * j;
            const LAS unsigned short* tl = (const LAS unsigned short*)lds + c;
            float prev = bf2f(tl[0]), cur = bf2f(tl[RSB / 2]);
            for (int o8 = 0; o8 < 8; ++o8) {
                float r[8];
#pragma unroll
                for (int k = 0; k < 8; ++k) {
                    const int o = o8 * 8 + k; const float nxt = bf2f(tl[(o + 2) * (RSB / 2)]);
                    const int pos = posb + 1 + o;
                    r[k] = (pos >= 0 && pos < L) ? (prev * w0 + cur * w1 + nxt * w2) : 0.f;
                    prev = cur; cur = nxt;
                }
                u32x4 w; w.x = cvt_pk_bf16(r[0], r[1]); w.y = cvt_pk_bf16(r[2], r[3]); w.z = cvt_pk_bf16(r[4], r[5]); w.w = cvt_pk_bf16(r[6], r[7]);
                *(u32x4*)(XT + o8 * 8) = w;
            }
        }
        __syncthreads();
    }
}

__device__ __forceinline__ f32x16 mfma32(bf16x8 a, bf16x8 b, f32x16 c) { return __builtin_amdgcn_mfma_f32_32x32x16_bf16(a, b, c, 0, 0, 0); }

__device__ __forceinline__ void attn_phase(const Params& p, LAS unsigned char* lds) {
    const int tid = tid_l(), lane = tid & 63, wave = tid >> 6, G = gridDim.x, h = lane >> 5, l32 = lane & 31;
    unsigned char* ob = launder((unsigned char*)p.out);
    bf16_t* Q = (bf16_t*)(ob + DO_Q);
    const bf16_t* KN = (const bf16_t*)(ob + DO_KN);
    const bf16_t* KR = (const bf16_t*)(ob + DO_KR);
    const bf16_t* VT = (const bf16_t*)(ob + DO_VT);
    constexpr int KROW = 400, VROW = 136, KBYTES = 64 * KROW, BUFB = KBYTES + 128 * VROW;
    for (int u = blockIdx.x; u < 2048; u += G) {
        int seq, head, qb;
        if (u < 1024) { seq = u >> 7; head = (u >> 5) & 3; qb = u & 31; } else { const int v = u - 1024; seq = NBP + (v >> 5); head = (v >> 3) & 3; qb = v & 7; }
        const int L = seq < NBP ? LP : LS; const int row0 = seq < NBP ? seq * LP : TPR + (seq - NBP) * LS;
        const int ntiles = (L + 63) >> 6;
        const int qrow = row0 + 16 + qb * 256 + wave * 32 + l32;
        bf16x8 qf[12];
#pragma unroll
        for (int ks = 0; ks < 12; ++ks) qf[ks] = *(const bf16x8*)(Q + (size_t)qrow * 768 + head * 192 + 16 * ks + 8 * h);
        {
            const float2* RT = (const float2*)(launder(p.ws) + OFF_RT);
            const int qpos = 16 + qb * 256 + wave * 32 + l32;
#pragma unroll
            for (int ks = 8; ks < 12; ++ks) {
                const u32x4 v = __builtin_bit_cast(u32x4, qf[ks]);
                f32x4 v0 = (f32x4){bflo(v.x), bfhi(v.x), bflo(v.y), bfhi(v.y)}, v1 = (f32x4){bflo(v.z), bfhi(v.z), bflo(v.w), bfhi(v.w)};
                rope8(v0, v1, RT + qpos * 32 + 8 * (ks - 8) + 4 * h);
                qf[ks] = __builtin_bit_cast(bf16x8, pack8(v0, v1));
            }
        }
        const int kkey0 = tid >> 4, kch0 = tid & 15;
        const int rkey = tid >> 3, rch = tid & 7;
        const int vdv0 = tid >> 3, vch = tid & 7;
        const unsigned kn_off = (unsigned)(kkey0 * 512 + head * 128 + kch0 * 8) * 2u;
        const unsigned kr_off = (unsigned)(rkey * 64 + rch * 8) * 2u;
        const unsigned vt_off = (unsigned)(vdv0 * TPAD + vch * 8) * 2u;
        const unsigned char* knb = (const unsigned char*)KN + (size_t)row0 * 1024;
        const unsigned char* krb = (const unsigned char*)KR + (size_t)row0 * 128;
        const unsigned char* vtb = (const unsigned char*)VT + ((size_t)head * 128 * TPAD + row0) * 2;
        u32x4 g0, g1, g2, g3, g4;
#define ATT_LOAD(tile) do { const unsigned char* kb__ = knb + (size_t)(tile) * 65536; const unsigned char* rb__ = krb + (size_t)(tile) * 8192; const unsigned char* vb__ = vtb + (size_t)(tile) * 128; \
        g0 = *(const u32x4*)(kb__ + kn_off); g1 = *(const u32x4*)(kb__ + 32768 + kn_off); \
        g2 = *(const u32x4*)(rb__ + kr_off); (void)vb__; } while (0)
#define ATT_LOADV(tile) do { const unsigned char* vb__ = vtb + (size_t)(tile) * 128; g3 = *(const u32x4*)(vb__ + vt_off); g4 = *(const u32x4*)(vb__ + (size_t)64 * TPAD * 2 + vt_off); } while (0)
#define ATT_STOREK(buf) do { LAS unsigned char* kb_ = lds + (buf) * BUFB; \
        *(LAS u32x4*)(kb_ + kkey0 * KROW + kch0 * 16) = g0; *(LAS u32x4*)(kb_ + (kkey0 + 32) * KROW + kch0 * 16) = g1; \
        *(LAS u32x4*)(kb_ + rkey * KROW + 256 + rch * 16) = g2; } while (0)
#define ATT_STORE(buf) do { LAS unsigned char* vb_ = lds + (buf) * BUFB + KBYTES; \
        *(LAS u32x2*)(vb_ + vdv0 * VROW + vch * 16) = (u32x2){g3.x, g3.y}; *(LAS u32x2*)(vb_ + vdv0 * VROW + vch * 16 + 8) = (u32x2){g3.z, g3.w}; \
        *(LAS u32x2*)(vb_ + (vdv0 + 64) * VROW + vch * 16) = (u32x2){g4.x, g4.y}; *(LAS u32x2*)(vb_ + (vdv0 + 64) * VROW + vch * 16 + 8) = (u32x2){g4.z, g4.w}; } while (0)
        ATT_LOAD(0); ATT_LOADV(0); ATT_STOREK(0); ATT_STORE(0);
        __syncthreads();
        f32x16 o[4];
#pragma unroll
        for (int d = 0; d < 4; ++d)
#pragma unroll
            for (int r = 0; r < 16; ++r) o[d][r] = 0.f;
        float m_run = -INFINITY, l_run = 0.f;
        for (int j = 0; j < ntiles; ++j) {
            const int buf = j & 1;
            if (j + 1 < ntiles) ATT_LOAD(j + 1);
            const LAS unsigned char* kb = lds + buf * BUFB;
            f32x16 s0, s1;
#pragma unroll
            for (int r = 0; r < 16; ++r) { s0[r] = 0.f; s1[r] = 0.f; }
#pragma unroll
            for (int ks = 0; ks < 12; ++ks) {
                const bf16x8 a0 = *(const LAS bf16x8*)(kb + l32 * KROW + ks * 32 + h * 16);
                const bf16x8 a1 = *(const LAS bf16x8*)(kb + (l32 + 32) * KROW + ks * 32 + h * 16);
                s0 = mfma32(a0, qf[ks], s0); s1 = mfma32(a1, qf[ks], s1);
                if ((ks % 3) == 2) __builtin_amdgcn_sched_barrier(0);
            }
            if (j + 1 < ntiles) ATT_STOREK(buf ^ 1);
            const int vc = L - j * 64;
            if (vc < 64) {
                const int vch = vc - 4 * h;
#pragma unroll
                for (int r = 0; r < 16; ++r) {
                    if ((r & 3) + 8 * (r >> 2) >= vch) s0[r] = -INFINITY;
                    if ((r & 3) + 8 * (r >> 2) + 32 >= vch) s1[r] = -INFINITY;
                }
            }
            float mx = fmaxf(s0[0], s1[0]);
#pragma unroll
            for (int r = 1; r < 16; ++r) mx = fmaxf(mx, fmaxf(s0[r], s1[r]));
            mx = fmaxf(mx, __shfl_xor(mx, 32));
            const float m_new = fmaxf(m_run, mx);
            const float alpha = __builtin_amdgcn_exp2f(m_run - m_new);
            m_run = m_new;
            float ls = 0.f;
#pragma unroll
            for (int r = 0; r < 16; ++r) { s0[r] = __builtin_amdgcn_exp2f(s0[r] - m_new); s1[r] = __builtin_amdgcn_exp2f(s1[r] - m_new); ls += s0[r] + s1[r]; }
            l_run = l_run * alpha + ls;
#pragma unroll
            for (int d = 0; d < 4; ++d)
#pragma unroll
                for (int r = 0; r < 16; ++r) o[d][r] *= alpha;
            bf16x8 pb[4];
            {
                u32x4 w;
                w.x = cvt_pk_bf16(s0[0], s0[1]); w.y = cvt_pk_bf16(s0[2], s0[3]); w.z = cvt_pk_bf16(s0[4], s0[5]); w.w = cvt_pk_bf16(s0[6], s0[7]); pb[0] = __builtin_bit_cast(bf16x8, w);
                w.x = cvt_pk_bf16(s0[8], s0[9]); w.y = cvt_pk_bf16(s0[10], s0[11]); w.z = cvt_pk_bf16(s0[12], s0[13]); w.w = cvt_pk_bf16(s0[14], s0[15]); pb[1] = __builtin_bit_cast(bf16x8, w);
                w.x = cvt_pk_bf16(s1[0], s1[1]); w.y = cvt_pk_bf16(s1[2], s1[3]); w.z = cvt_pk_bf16(s1[4], s1[5]); w.w = cvt_pk_bf16(s1[6], s1[7]); pb[2] = __builtin_bit_cast(bf16x8, w);
                w.x = cvt_pk_bf16(s1[8], s1[9]); w.y = cvt_pk_bf16(s1[10], s1[11]); w.z = cvt_pk_bf16(s1[12], s1[13]); w.w = cvt_pk_bf16(s1[14], s1[15]); pb[3] = __builtin_bit_cast(bf16x8, w);
            }
            if (j + 1 < ntiles) ATT_LOADV(j + 1);
            const LAS unsigned char* vb = kb + KBYTES;
#pragma unroll
            for (int d = 0; d < 4; ++d)
#pragma unroll
                for (int ks = 0; ks < 4; ++ks) {
                    const LAS unsigned char* ap = vb + (d * 32 + l32) * VROW + (16 * ks + 4 * h) * 2;
                    const u32x2 lo = *(const LAS u32x2*)ap, hi = *(const LAS u32x2*)(ap + 16);
                    const u32x4 w = (u32x4){lo.x, lo.y, hi.x, hi.y};
                    o[d] = mfma32(__builtin_bit_cast(bf16x8, w), pb[ks], o[d]);
                    if (ks == 3) __builtin_amdgcn_sched_barrier(0);
                }
            if (j + 1 < ntiles) ATT_STORE(buf ^ 1);
            __syncthreads();
        }
        l_run += __shfl_xor(l_run, 32);
        const float inv = 1.0f / l_run;
#if DEBUG_CHECK == 5
        bf16_t* orow = (bf16_t*)(launder(p.ws) + OFF_ODBG) + (size_t)qrow * 512 + head * 128;
#else
        bf16_t* orow = Q + (size_t)qrow * 768 + head * 192;
#endif
#pragma unroll
        for (int d = 0; d < 4; ++d)
#pragma unroll
            for (int rq = 0; rq < 4; ++rq) {
                const u32x2 w = (u32x2){cvt_pk_bf16(o[d][4 * rq] * inv, o[d][4 * rq + 1] * inv), cvt_pk_bf16(o[d][4 * rq + 2] * inv, o[d][4 * rq + 3] * inv)};
                *(u32x2*)(orow + 32 * d + 8 * rq + 4 * h) = w;
            }
#undef ATT_LOAD
#undef ATT_LOADV
#undef ATT_STORE
#undef ATT_STOREK
    }
}

template <int SET> __device__ __forceinline__ void hyena_unit(const Params& p, LAS unsigned char* lds, int c, int bg) {
    constexpr int P = SET ? 32 : 128;
    constexpr int NBU = SET ? 16 : 4;
    constexpr int NBT = SET ? 8 : 2;
    constexpr int GP = SET ? 4 : 16;
    constexpr int LG = SET ? LGS : LGP;
    constexpr int NB = SET ? NBS : NBP;
    constexpr int RS = SET ? 4896 : 18816;
    constexpr int GBYTES = 2 * LG * 2;
    constexpr int G1OFF = 33220;
    constexpr int ZOFF = 66560;
    unsigned char* ws = launder(p.ws);
    const int tid = tid_l(), lane = tid & 63, wave = tid >> 6, h = lane >> 5, l32 = lane & 31;
    const bf16_t* X1T = (const bf16_t*)(ws + OFF_X1T) + (SET ? XT_SET1 : 0);
    bf16_t* X2T = (bf16_t*)(ws + OFF_X2T) + (SET ? XT_SET1 : 0);
    const bf16_t* V0T = (const bf16_t*)(ws + OFF_V0T) + (SET ? XT_SET1 : 0);
    const bf16_t* GR = (const bf16_t*)(ws + (SET ? OFF_GR1 : OFF_GR0));
    const float* hy_bias = launder(p.in[17]);
    LAS unsigned char* gL = lds; LAS unsigned char* zL = lds + ZOFF;
    const size_t rowbase = ((size_t)c * NB + bg * NBU) * LG;
    for (int id = tid; id < NBU * (P + 1) * 8; id += 512) {
        const int bl = id / ((P + 1) * 8), rem = id % ((P + 1) * 8), blk = rem >> 3, ch = rem & 7;
        *(LAS u32x4*)(zL + bl * RS + blk * 144 + ch * 16) = *(const u32x4*)(V0T + rowbase + (size_t)bl * LG + blk * 64 + ch * 8);
    }
    for (int id = tid; id < NBU * 9; id += 512) { const int bl = id / 9, ch = id % 9; *(LAS u32x4*)(zL + bl * RS + (P + 1) * 144 + ch * 16) = (u32x4){0u, 0u, 0u, 0u}; }
#define HY_LOADG(rowidx) do { const unsigned* g32_ = (const unsigned*)(GR + (size_t)(rowidx) * (2 * LG)); \
        for (int id = tid; id < GBYTES / 4; id += 512) { const unsigned a_ = g32_[id], b_ = (id + 1 < GBYTES / 4) ? g32_[id + 1] : 0u; \
            *(LAS unsigned*)(gL + id * 4) = a_; *(LAS unsigned*)(gL + G1OFF + id * 4) = (a_ >> 16) | (b_ << 16); } } while (0)
    HY_LOADG(c);
    __syncthreads();
    const LAS unsigned short* g16 = (const LAS unsigned short*)gL;
    constexpr int PARTS = 512 / (NBU * 16);
    float zmeta = 0.f; int mo_bl, mo_m;
    {
        const int part = tid % PARTS, out = tid / PARTS; mo_bl = out >> 4; mo_m = out & 15;
        const LAS unsigned char* zr = zL + mo_bl * RS;
        float a = 0.f;
        for (int tt = 48 + part; tt < LG; tt += PARTS) {
            const float zv = bf2f(*(const LAS unsigned short*)(zr + (tt >> 6) * 144 + (tt & 63) * 2));
            const float gv = bf2f(g16[LG - mo_m - 48 + tt]);
            a += zv * gv;
        }
#pragma unroll
        for (int o = 1; o < PARTS; o <<= 1) a += __shfl_xor(a, o);
        const float bias0 = hy_bias[c];
        const float z0 = bf2f(*(const LAS unsigned short*)(zr + (48 + mo_m) * 2));
        const float x1 = bf2f(X1T[rowbase + (size_t)mo_bl * LG + 48 + mo_m]);
        zmeta = x1 * (a + z0 * bias0);
    }
    const int p0 = GP * wave;
    const int pp = l32 / NBT, blA = l32 % NBT, blB = NBT + blA;
#pragma unroll 1
    for (int order = 0; order < 2; ++order) {
        f32x16 acc[2][2];
#pragma unroll
        for (int a = 0; a < 2; ++a)
#pragma unroll
            for (int b = 0; b < 2; ++b)
#pragma unroll
                for (int r = 0; r < 16; ++r) acc[a][b][r] = 0.f;
#pragma unroll 1
        for (int d = p0 - (P - 1); d <= p0 + GP; ++d) {
            bf16x8 E[6];
            const int ib = LG - 64 * d - l32 + 8 * h;
            const LAS unsigned char* gpl = gL + (l32 & 1) * G1OFF + (ib >> 1) * 4;
#pragma unroll
            for (int e = 0; e < 6; ++e) {
                const LAS unsigned* gp = (const LAS unsigned*)(gpl - 32 * (e - 3));
                const u32x4 w = (u32x4){gp[0], gp[1], gp[2], gp[3]};
                E[e] = __builtin_bit_cast(bf16x8, w);
            }
            const int q = p0 + pp - d;
            const int slot = ((unsigned)(q + 1) <= (unsigned)P) ? q + 1 : P + 1;
            const LAS unsigned char* zA = zL + blA * RS + slot * 144 + h * 16;
            const LAS unsigned char* zB = zL + blB * RS + slot * 144 + h * 16;
#pragma unroll
            for (int ks = 0; ks < 4; ++ks) {
                const bf16x8 ba = *(const LAS bf16x8*)(zA + ks * 32);
                const bf16x8 bb = *(const LAS bf16x8*)(zB + ks * 32);
#pragma unroll
                for (int m = 0; m < 2; ++m) {
                    acc[0][m] = mfma32(E[2 * m - ks + 3], ba, acc[0][m]);
                    acc[1][m] = mfma32(E[2 * m - ks + 3], bb, acc[1][m]);
                }
            }
        }
        __syncthreads();
        const float bias = hy_bias[order * 512 + c];
#pragma unroll
        for (int tl = 0; tl < 2; ++tl) {
            const int bl = tl ? blB : blA;
            const size_t grow = rowbase + (size_t)bl * LG + 64 * (p0 + pp + 1);
            LAS unsigned char* zr = zL + bl * RS + (p0 + pp + 1) * 144;
#pragma unroll
            for (int m = 0; m < 2; ++m)
#pragma unroll
                for (int rq = 0; rq < 4; ++rq) {
                    const int off = 32 * m + 8 * rq + 4 * h;
                    const u32x2 zw = *(const LAS u32x2*)(zr + off * 2);
                    const u32x2 xw = *(const u32x2*)((order ? (const bf16_t*)X2T : X1T) + grow + off);
                    const float y0 = acc[tl][m][4 * rq], y1 = acc[tl][m][4 * rq + 1], y2 = acc[tl][m][4 * rq + 2], y3 = acc[tl][m][4 * rq + 3];
                    const float r0 = bflo(xw.x) * (y0 + bflo(zw.x) * bias), r1 = bfhi(xw.x) * (y1 + bfhi(zw.x) * bias);
                    const float r2 = bflo(xw.y) * (y2 + bflo(zw.y) * bias), r3 = bfhi(xw.y) * (y3 + bfhi(zw.y) * bias);
                    const u32x2 w = (u32x2){cvt_pk_bf16(r0, r1), cvt_pk_bf16(r2, r3)};
#if DEBUG_CHECK == 5
                    if (order == 0) *(LAS u32x2*)(zr + off * 2) = w; else *(u32x2*)((bf16_t*)(ws + OFF_HDBG) + (SET ? XT_SET1 : 0) + grow + off) = w;
#else
                    if (order == 0) *(LAS u32x2*)(zr + off * 2) = w; else *(u32x2*)(X2T + grow + off) = w;
#endif
                }
        }
        if (order == 0) {
            if ((tid % PARTS) == 0) *(LAS unsigned short*)(zL + mo_bl * RS + (48 + mo_m) * 2) = (unsigned short)(cvt_pk_bf16(zmeta, 0.f) & 0xffffu);
            HY_LOADG(512 + c);
        }
        __syncthreads();
    }
}
#undef HY_LOADG
__device__ __forceinline__ void hyena_phase(const Params& p, LAS unsigned char* lds) {
    for (int u = blockIdx.x; u < 2048; u += gridDim.x) {
        if (u < 1024) hyena_unit<0>(p, lds, u >> 1, u & 1); else hyena_unit<1>(p, lds, (u - 1024) >> 1, u & 1);
    }
}

__device__ __forceinline__ void mixnorm_phase(const Params& p, LAS unsigned char* lds) {
    unsigned char* ws = launder(p.ws); const int tid = tid_l(), lane = tid & 63, wave = tid >> 6, G = gridDim.x;
    const bf16_t* Q = (const bf16_t*)(launder((unsigned char*)p.out) + DO_Q);
    bf16_t* MIXN = (bf16_t*)(ws + OFF_MIXN);
    const float* ga = launder(p.in[18]); const float* gh = launder(p.in[19]);
    constexpr int RSB = 1040;
    for (int u = blockIdx.x; u < 2048; u += G) {
        const int n0 = u * 64;
        int set, b, tok0;
        if (n0 < 65536) { set = 0; b = n0 >> 13; tok0 = n0 & 8191; } else { set = 1; const int q = n0 - 65536; b = q >> 11; tok0 = q & 2047; }
        const int Lg = set ? LGS : LGP, NB = set ? NBS : NBP;
        {
            const int c = tid;
#if DEBUG_CHECK == 5
            const bf16_t* src = (const bf16_t*)(ws + OFF_HDBG) + (set ? XT_SET1 : 0) + ((size_t)c * NB + b) * Lg + tok0 + 64;
#else
            const bf16_t* src = (const bf16_t*)(ws + OFF_X2T) + (set ? XT_SET1 : 0) + ((size_t)c * NB + b) * Lg + tok0 + 64;
#endif
            LAS unsigned short* tl = (LAS unsigned short*)lds + c;
#pragma unroll
            for (int k8 = 0; k8 < 8; ++k8) {
                const u32x4 v = *(const u32x4*)(src + k8 * 8);
                tl[(k8 * 8 + 0) * (RSB / 2)] = (unsigned short)(v.x & 0xffffu); tl[(k8 * 8 + 1) * (RSB / 2)] = (unsigned short)(v.x >> 16);
                tl[(k8 * 8 + 2) * (RSB / 2)] = (unsigned short)(v.y & 0xffffu); tl[(k8 * 8 + 3) * (RSB / 2)] = (unsigned short)(v.y >> 16);
                tl[(k8 * 8 + 4) * (RSB / 2)] = (unsigned short)(v.z & 0xffffu); tl[(k8 * 8 + 5) * (RSB / 2)] = (unsigned short)(v.z >> 16);
                tl[(k8 * 8 + 6) * (RSB / 2)] = (unsigned short)(v.w & 0xffffu); tl[(k8 * 8 + 7) * (RSB / 2)] = (unsigned short)(v.w >> 16);
            }
        }
        __syncthreads();
        for (int i = 0; i < 8; ++i) {
            const int rr = wave + 8 * i; const int n = n0 + rr; const int r = full_row(n);
            const u32x4 hv = *(const LAS u32x4*)(lds + rr * RSB + lane * 16);
#if DEBUG_CHECK == 5
            const u32x4 av = *(const u32x4*)((const bf16_t*)(ws + OFF_ODBG) + (size_t)r * 512 + lane * 8);
#else
            const u32x4 av = *(const u32x4*)(Q + (size_t)r * 768 + (lane >> 4) * 192 + (lane & 15) * 8);
#endif
            float hf[8] = {bflo(hv.x), bfhi(hv.x), bflo(hv.y), bfhi(hv.y), bflo(hv.z), bfhi(hv.z), bflo(hv.w), bfhi(hv.w)};
            float af[8] = {bflo(av.x), bfhi(av.x), bflo(av.y), bfhi(av.y), bflo(av.z), bfhi(av.z), bflo(av.w), bfhi(av.w)};
            float sh = 0.f, sa = 0.f;
#pragma unroll
            for (int k = 0; k < 8; ++k) { sh += hf[k] * hf[k]; sa += af[k] * af[k]; }
            sh = wave_sum(sh); sa = wave_sum(sa);
            const float rh = rsqrtf(sh * (1.f / 512.f) + EPS), ra = rsqrtf(sa * (1.f / 512.f) + EPS);
            const f32x4 ga0 = *(const f32x4*)(ga + lane * 8), ga1 = *(const f32x4*)(ga + lane * 8 + 4);
            const f32x4 gh0 = *(const f32x4*)(gh + lane * 8), gh1 = *(const f32x4*)(gh + lane * 8 + 4);
            u32x4 wa, wh;
            wa.x = cvt_pk_bf16(af[0] * ra * ga0[0], af[1] * ra * ga0[1]); wa.y = cvt_pk_bf16(af[2] * ra * ga0[2], af[3] * ra * ga0[3]);
            wa.z = cvt_pk_bf16(af[4] * ra * ga1[0], af[5] * ra * ga1[1]); wa.w = cvt_pk_bf16(af[6] * ra * ga1[2], af[7] * ra * ga1[3]);
            wh.x = cvt_pk_bf16(hf[0] * rh * gh0[0], hf[1] * rh * gh0[1]); wh.y = cvt_pk_bf16(hf[2] * rh * gh0[2], hf[3] * rh * gh0[3]);
            wh.z = cvt_pk_bf16(hf[4] * rh * gh1[0], hf[5] * rh * gh1[1]); wh.w = cvt_pk_bf16(hf[6] * rh * gh1[2], hf[7] * rh * gh1[3]);
#if EXPT == 1
            wa = (u32x4){0u, 0u, 0u, 0u};
#endif
#if EXPT == 2
            wh = (u32x4){0u, 0u, 0u, 0u};
#endif
            *(u32x4*)(MIXN + (size_t)n * 1024 + lane * 8) = wa;
            *(u32x4*)(MIXN + (size_t)n * 1024 + 512 + lane * 8) = wh;
        }
        __syncthreads();
    }
}

__device__ __forceinline__ void h1_phase(const Params& p) {
    unsigned char* ws = launder(p.ws); const int tid = tid_l(), lane = tid & 63, wave = tid >> 6;
    const int gw = blockIdx.x * 8 + wave, NGW = gridDim.x * 8;
    const bf16_t* MIX = (const bf16_t*)(ws + OFF_MIX); bf16_t* H1B = (bf16_t*)(ws + OFF_H1B);
    const float* sqmix = (const float*)(ws + OFF_SQMIXP); float* r1 = (float*)(ws + OFF_R1); const float* g = p.in[21];
    for (int n = gw; n < TN; n += NGW) {
        const float* xrow = n < 65536 ? p.in[0] + (size_t)n * 1024 : p.in[1] + (size_t)(n - 65536) * 1024;
        const float rm = rsqrtf(wave_sum(lane < 16 ? ldco(sqmix + (size_t)n * 16 + lane) : 0.f) * (1.f / 1024.f) + EPS);
        float ss = 0.f;
#pragma unroll
        for (int hh = 0; hh < 2; ++hh) {
            const int c0 = hh * 512 + lane * 8;
            const u32x4 mv = *(const u32x4*)(MIX + (size_t)n * 1024 + c0);
            const f32x4 x0 = *(const f32x4*)(xrow + c0), x1 = *(const f32x4*)(xrow + c0 + 4);
            const f32x4 g0 = *(const f32x4*)(g + c0), g1 = *(const f32x4*)(g + c0 + 4);
            f32x4 h0, h1;
            h0[0] = x0[0] + bflo(mv.x) * rm * g0[0]; h0[1] = x0[1] + bfhi(mv.x) * rm * g0[1]; h0[2] = x0[2] + bflo(mv.y) * rm * g0[2]; h0[3] = x0[3] + bfhi(mv.y) * rm * g0[3];
            h1[0] = x1[0] + bflo(mv.z) * rm * g1[0]; h1[1] = x1[1] + bfhi(mv.z) * rm * g1[1]; h1[2] = x1[2] + bflo(mv.w) * rm * g1[2]; h1[3] = x1[3] + bfhi(mv.w) * rm * g1[3];
            ss += sq8(h0, h1);
            *(f32x4*)(p.out + (size_t)n * 1024 + c0) = h0; *(f32x4*)(p.out + (size_t)n * 1024 + c0 + 4) = h1;
            *(u32x4*)(H1B + (size_t)n * 1024 + c0) = pack8(h0, h1);
        }
        ss = wave_sum(ss);
        if (lane == 0) r1[n] = rsqrtf(ss * (1.f / 1024.f) + EPS);
    }
}
__device__ __forceinline__ void final_phase(const Params& p, int half) {
    unsigned char* ws = launder(p.ws); const int tid = tid_l(), lane = tid & 63, wave = tid >> 6;
    const int gw = blockIdx.x * 8 + wave, NGW = gridDim.x * 8;
    const bf16_t* M2 = (const bf16_t*)(ws + OFF_M2); const float* sqm2 = (const float*)(ws + OFF_SQM2P); const float* g = p.in[25];
    float dbg_off = 0.f, dbg_one = 0.f;
#if DEBUG_CHECK
    { const unsigned* dc = (const unsigned*)(ws + OFF_DBGW); dbg_off = 100.f * (float)dc[8] * (1.f / 131072.f); dbg_one = 1000.f * (float)dc[9] * (1.f / 131072.f); }
#endif
    for (int i = gw; i < 65536; i += NGW) {
        const int n = half * 65536 + i;
        const float rm = rsqrtf(wave_sum(lane < 16 ? ldco(sqm2 + (size_t)n * 16 + lane) : 0.f) * (1.f / 1024.f) + EPS);
#pragma unroll
        for (int hh = 0; hh < 2; ++hh) {
            const int c0 = hh * 512 + lane * 8;
            const u32x4 mv = *(const u32x4*)(M2 + (size_t)i * 1024 + c0);
            f32x4 h0 = *(const f32x4*)(p.out + (size_t)n * 1024 + c0), h1 = *(const f32x4*)(p.out + (size_t)n * 1024 + c0 + 4);
            const f32x4 g0 = *(const f32x4*)(g + c0), g1 = *(const f32x4*)(g + c0 + 4);
            h0 += dbg_off; h1 += dbg_off; if (n == 0 && c0 == 0) h0[0] += dbg_one;
            h0[0] += bflo(mv.x) * rm * g0[0]; h0[1] += bfhi(mv.x) * rm * g0[1]; h0[2] += bflo(mv.y) * rm * g0[2]; h0[3] += bfhi(mv.y) * rm * g0[3];
            h1[0] += bflo(mv.z) * rm * g1[0]; h1[1] += bfhi(mv.z) * rm * g1[1]; h1[2] += bflo(mv.w) * rm * g1[2]; h1[3] += bfhi(mv.w) * rm * g1[3];
            *(f32x4*)(p.out + (size_t)n * 1024 + c0) = h0; *(f32x4*)(p.out + (size_t)n * 1024 + c0 + 4) = h1;
        }
    }
}


#if DEBUG_CHECK
constexpr size_t OFF_DBG = OFF_DBGW;
__device__ __forceinline__ void check_gemm(const bf16_t* A, int lda, const bf16_t* Bt, int ldb, int K, int M, int N, int mode, const bf16_t* O, int ldc, const float* rs, unsigned* cnt, int col_lo) {
    const unsigned idx = blockIdx.x * 512u + (unsigned)tid_l();
    unsigned hsh = idx * 2654435761u + 12345u + (unsigned)mode * 977u; hsh ^= hsh >> 15; hsh *= 2246822519u; hsh ^= hsh >> 13;
    const int row = (int)(hsh % (unsigned)M); hsh = hsh * 3266489917u + 668265263u; hsh ^= hsh >> 16;
    const int col = col_lo + (int)(hsh % (unsigned)(N - col_lo));
    float d = 0.f;
    for (int k = 0; k < K; ++k) d += bf2f(A[(size_t)row * lda + k]) * bf2f(Bt[(size_t)col * ldb + k]);
    float e = d;
    if (mode == 0 || mode == 7) e = d * rs[row];
    if (mode == 5) { const float t = fmaxf(d * rs[row], 0.f); e = t * t; }
    const float st = bf2f(O[(size_t)row * ldc + col]);
    if (!(fabsf(st - e) <= 0.03f * fabsf(e) + 0.03f)) atomicAdd(cnt, 1u);
}
#endif

#if DEBUG_CHECK == 2
__device__ __forceinline__ void check_proj(const Params& p) {
    unsigned char* ws = launder(p.ws); unsigned char* ob = launder((unsigned char*)p.out);
    const bf16_t* P = (const bf16_t*)(ws + OFF_P); unsigned* cnt = (unsigned*)(ws + OFF_DBG);
    const unsigned idx = blockIdx.x * 512u + (unsigned)tid_l();
    unsigned hsh = idx * 2654435761u + 777u; hsh ^= hsh >> 15; hsh *= 2246822519u; hsh ^= hsh >> 13;
    const int row = (int)(hsh % (unsigned)T); hsh = hsh * 3266489917u + 668265263u; hsh ^= hsh >> 16;
    int pos, seq; row_info(row, pos, seq);
    {
        const int n = (int)(hsh % 768u); const int hh = n / 192, w = n % 192;
        float ss = 0.f, x1 = 0.f, x2 = 0.f; const float* W = p.in[6]; const float* g = p.in[5];
        const int j = w - 128, i = j >> 1;
        const int c1 = w < 128 ? hh * 192 + w : hh * 192 + 128 + i, c2 = hh * 192 + 160 + (w < 128 ? 0 : i);
        for (int k = 0; k < 256; ++k) { const float a = bf2f(P[(size_t)row * NPP + k]); ss += a * a; x1 += a * g[k] * W[k * 768 + c1]; x2 += a * g[k] * W[k * 768 + c2]; }
        const float rq = rsqrtf(ss * (1.f / 256.f) + EPS) * QSCALE; x1 *= rq; x2 *= rq;
        float e = x1;
        if (w >= 128) { const float inv = 1.0f / exp2f((float)i * (13.287712379549449f / 32.f)); float sn, cs; sincos_red((float)pos * inv, sn, cs); e = (j & 1) ? x2 * cs + x1 * sn : x1 * cs - x2 * sn; }
        const float st = bf2f(((const bf16_t*)(ob + DO_Q))[(size_t)row * 768 + n]);
        if (!(fabsf(st - e) <= 0.03f * fabsf(e) + 0.01f)) atomicAdd(cnt + (w < 128 ? 0 : 4), 1u);
    }
    {
        const int n = (int)((hsh >> 3) % 512u); const int hh = n >> 7, i = n & 127;
        float ss = 0.f, x1 = 0.f, x2 = 0.f; const float* W = p.in[8]; const float* g = p.in[7];
        for (int k = 0; k < 128; ++k) { const float a = bf2f(P[(size_t)row * NPP + 256 + k]); ss += a * a; x1 += a * g[k] * W[k * 1024 + hh * 256 + i]; x2 += a * g[k] * W[k * 1024 + hh * 256 + 128 + i]; }
        const float rk = rsqrtf(ss * (1.f / 128.f) + EPS); x1 *= rk; x2 *= rk;
        const float s1 = bf2f(((const bf16_t*)(ob + DO_KN))[(size_t)row * 512 + n]);
        const float s2 = bf2f(((const bf16_t*)(ob + DO_VT))[(size_t)n * TPAD + row]);
        if (!(fabsf(s1 - x1) <= 0.03f * fabsf(x1) + 0.03f)) atomicAdd(cnt + 1, 1u);
        if (!(fabsf(s2 - x2) <= 0.03f * fabsf(x2) + 0.03f)) atomicAdd(cnt + 2, 1u);
    }
    {
        const int jj = (int)((hsh >> 5) % 64u); const int i = jj >> 1;
        const float* xr = pos < 16 ? p.in[2] + (size_t)pos * 1024 : (seq < NBP ? p.in[0] + ((size_t)seq * 8192 + (pos - 16)) * 1024 : p.in[1] + ((size_t)(seq - NBP) * 2048 + (pos - 16)) * 1024);
        const float* W = p.in[4]; const float* g = p.in[3]; float x1 = 0.f, x2 = 0.f;
        for (int k = 0; k < 1024; ++k) { const float a = xr[k] * g[k]; x1 += a * W[(size_t)k * 1984 + 384 + i]; x2 += a * W[(size_t)k * 1984 + 416 + i]; }
        const float r0 = ((const float*)(ws + OFF_R0))[row]; x1 *= r0; x2 *= r0;
        const float inv = 1.0f / exp2f((float)i * (13.287712379549449f / 32.f)); float sn, cs; sincos_red((float)pos * inv, sn, cs);
        const float e = (jj & 1) ? x2 * cs + x1 * sn : x1 * cs - x2 * sn;
        const float st = bf2f(((const bf16_t*)(ob + DO_KR))[(size_t)row * 64 + jj]);
        if (!(fabsf(st - e) <= 0.03f * fabsf(e) + 0.03f)) { atomicAdd(cnt + 3, 1u); atomicAdd(cnt + 5, (unsigned)i); atomicAdd(cnt + 6, (unsigned)(pos >> 3)); }
    }
}
#endif

#if DEBUG_CHECK == 3
__device__ __forceinline__ void check_h0b(const Params& p, int slot) {
    unsigned char* ws = launder(p.ws); unsigned* cnt = (unsigned*)(ws + OFF_DBGW);
    const bf16_t* h0b = (const bf16_t*)(ws + OFF_H0B);
    const unsigned idx = blockIdx.x * 512u + (unsigned)tid_l();
    unsigned hsh = idx * 2654435761u + 4242u + (unsigned)slot * 31u; hsh ^= hsh >> 15; hsh *= 2246822519u; hsh ^= hsh >> 13;
    const int row = (int)(hsh % (unsigned)T); hsh = hsh * 3266489917u + 668265263u; hsh ^= hsh >> 16;
    const int col = (int)(hsh % 1024u);
    int pos, seq; row_info(row, pos, seq);
    const float* xr = pos < 16 ? p.in[2] + (size_t)pos * 1024 : (seq < NBP ? p.in[0] + ((size_t)seq * 8192 + (pos - 16)) * 1024 : p.in[1] + ((size_t)(seq - NBP) * 2048 + (pos - 16)) * 1024);
    const float e = xr[col]; const float st = bf2f(h0b[(size_t)row * 1024 + col]);
    if (!(fabsf(st - e) <= 0.01f * fabsf(e) + 0.001f)) atomicAdd(cnt + slot, 1u);
}
#endif

#if DEBUG_CHECK == 4
__device__ __forceinline__ void check_stale(const Params& p, const unsigned* base, unsigned ndw, int slot) {
    unsigned* cnt = (unsigned*)(launder(p.ws) + OFF_DBGW);
    const unsigned idx = blockIdx.x * 512u + (unsigned)tid_l();
    unsigned hsh = idx * 2654435761u + 999u + (unsigned)slot * 131u; hsh ^= hsh >> 15; hsh *= 2246822519u; hsh ^= hsh >> 13;
#pragma unroll 1
    for (int it = 0; it < 16; ++it) {
        hsh = hsh * 3266489917u + 668265263u; hsh ^= hsh >> 16;
        const unsigned i = hsh % ndw;
        const unsigned a = base[i];
        const unsigned b = __hip_atomic_load(base + i, __ATOMIC_RELAXED, __HIP_MEMORY_SCOPE_AGENT);
        if (a != b) atomicAdd(cnt + slot, 1u);
    }
}
#endif

#if DEBUG_CHECK == 5
__device__ __forceinline__ void check_attn(const Params& p) {
    unsigned char* ws = launder(p.ws); unsigned char* ob = launder((unsigned char*)p.out); unsigned* cnt = (unsigned*)(ws + OFF_DBGW);
    const int tid = tid_l(), lane = tid & 63, wave = tid >> 6;
    const bf16_t* Q = (const bf16_t*)(ob + DO_Q); const bf16_t* KN = (const bf16_t*)(ob + DO_KN); const bf16_t* KR = (const bf16_t*)(ob + DO_KR); const bf16_t* VT = (const bf16_t*)(ob + DO_VT);
    const bf16_t* OD = (const bf16_t*)(ws + OFF_ODBG); const float2* RT = (const float2*)(ws + OFF_RT);
    unsigned hsh = (unsigned)(blockIdx.x * 8 + wave) * 2654435761u + 31337u; hsh ^= hsh >> 15; hsh *= 2246822519u; hsh ^= hsh >> 13;
    const int n = (int)(hsh % (unsigned)TN); const int head = (int)((hsh >> 20) & 3u); const int r = full_row(n);
    int pos, seq; row_info(r, pos, seq);
    const int L = seq < NBP ? LP : LS; const int row0 = r - pos;
    const bf16_t* qp = Q + (size_t)r * 768 + head * 192;
    float mx = -INFINITY;
    for (int k = lane; k < L; k += 64) {
        float sdot = 0.f;
        for (int d = 0; d < 128; ++d) sdot += bf2f(qp[d]) * bf2f(KN[(size_t)(row0 + k) * 512 + head * 128 + d]);
        for (int i = 0; i < 32; ++i) { const float2 cs = ldco2(RT + pos * 32 + i); const float a = bf2f(qp[128 + 2 * i]), b = bf2f(qp[129 + 2 * i]);
            sdot += (a * cs.x - b * cs.y) * bf2f(KR[(size_t)(row0 + k) * 64 + 2 * i]) + (b * cs.x + a * cs.y) * bf2f(KR[(size_t)(row0 + k) * 64 + 2 * i + 1]); }
        mx = fmaxf(mx, sdot);
    }
#pragma unroll
    for (int o = 1; o < 64; o <<= 1) mx = fmaxf(mx, __shfl_xor(mx, o));
    float sw = 0.f, o0 = 0.f, o1 = 0.f; const int dv0 = (int)((hsh >> 8) & 127u), dv1 = (dv0 + 37) & 127;
    for (int k = lane; k < L; k += 64) {
        float sdot = 0.f;
        for (int d = 0; d < 128; ++d) sdot += bf2f(qp[d]) * bf2f(KN[(size_t)(row0 + k) * 512 + head * 128 + d]);
        for (int i = 0; i < 32; ++i) { const float2 cs = ldco2(RT + pos * 32 + i); const float a = bf2f(qp[128 + 2 * i]), b = bf2f(qp[129 + 2 * i]);
            sdot += (a * cs.x - b * cs.y) * bf2f(KR[(size_t)(row0 + k) * 64 + 2 * i]) + (b * cs.x + a * cs.y) * bf2f(KR[(size_t)(row0 + k) * 64 + 2 * i + 1]); }
        const float w = exp2f(sdot - mx); sw += w;
        o0 += w * bf2f(VT[(size_t)(head * 128 + dv0) * TPAD + row0 + k]); o1 += w * bf2f(VT[(size_t)(head * 128 + dv1) * TPAD + row0 + k]);
    }
    sw = wave_sum(sw); o0 = wave_sum(o0) / sw; o1 = wave_sum(o1) / sw;
    if (lane == 0) {
        const float s0 = bf2f(OD[(size_t)r * 512 + head * 128 + dv0]), s1 = bf2f(OD[(size_t)r * 512 + head * 128 + dv1]);
        atomicAdd(cnt + 10, 2u);
        if (!(fabsf(s0 - o0) <= 0.05f * fabsf(o0) + 0.002f)) atomicAdd(cnt + 8, 1u);
        if (!(fabsf(s1 - o1) <= 0.05f * fabsf(o1) + 0.002f)) atomicAdd(cnt + 8, 1u);
    }
}
__device__ __forceinline__ void check_hyena(const Params& p, LAS unsigned char* lds) {
    unsigned char* ws = launder(p.ws); unsigned* cnt = (unsigned*)(ws + OFF_DBGW);
    const int tid = tid_l();
    unsigned hsh = (unsigned)blockIdx.x * 2654435761u + 555u; hsh ^= hsh >> 15; hsh *= 2246822519u; hsh ^= hsh >> 13;
    const int set = (int)(blockIdx.x & 1u); const int c = (int)(hsh % 512u); const int NB = set ? NBS : NBP; const int b = (int)((hsh >> 12) % (unsigned)NB);
    const int LG = set ? LGS : LGP;
    const size_t base = (set ? XT_SET1 : 0) + ((size_t)c * NB + b) * LG;
    const bf16_t* X1 = (const bf16_t*)(ws + OFF_X1T) + base; const bf16_t* X2 = (const bf16_t*)(ws + OFF_X2T) + base; const bf16_t* V0 = (const bf16_t*)(ws + OFF_V0T) + base;
    const bf16_t* HD = (const bf16_t*)(ws + OFF_HDBG) + base;
    const bf16_t* G0 = (const bf16_t*)(ws + (set ? OFF_GR1 : OFF_GR0)) + (size_t)c * (2 * LG); const bf16_t* G1 = G0 + (size_t)512 * (2 * LG);
    const float bias0 = p.in[17][c], bias1 = p.in[17][512 + c];
    LAS float* z1 = (LAS float*)lds;
    for (int t = tid; t < LG; t += 512) {
        float y = 0.f;
        for (int s2 = 48; s2 < LG; ++s2) y += bf2f(G0[LG - (t - s2)]) * bf2f(V0[s2]);
        const float v = bf2f(X1[t]) * (y + bf2f(V0[t]) * bias0);
        z1[t] = (t >= 48) ? bf2f((unsigned short)(cvt_pk_bf16(v, 0.f) & 0xffffu)) : 0.f;
    }
    __syncthreads();
    {
        unsigned h2 = hsh * 3266489917u + (unsigned)tid * 2246822519u; h2 ^= h2 >> 15; h2 *= 2654435761u; h2 ^= h2 >> 13;
        const int t = 64 + (int)(h2 % (unsigned)(LG - 64));
        float y = 0.f;
        for (int s2 = 48; s2 < LG; ++s2) y += bf2f(G1[LG - (t - s2)]) * z1[s2];
        const float e = bf2f(X2[t]) * (y + z1[t] * bias1);
        const float st = bf2f(HD[t]);
        atomicAdd(cnt + 11, 1u);
        if (!(fabsf(st - e) <= 0.05f * fabsf(e) + 1.0f)) atomicAdd(cnt + 9, 1u);
    }
    __syncthreads();
}
#endif

#if DEBUG_CHECK == 7
__device__ __forceinline__ void check_h0b_full(const Params& p, int slot) {
    unsigned char* ws = launder(p.ws); unsigned* cnt = (unsigned*)(ws + OFF_DBGW);
    const bf16_t* h0b = (const bf16_t*)(ws + OFF_H0B);
    const int tid = tid_l(), lane = tid & 63, wave = tid >> 6;
    for (int row = blockIdx.x * 8 + wave; row < T; row += gridDim.x * 8) {
        int pos, seq; row_info(row, pos, seq);
        const float* xr = pos < 16 ? p.in[2] + (size_t)pos * 1024 : (seq < NBP ? p.in[0] + ((size_t)seq * 8192 + (pos - 16)) * 1024 : p.in[1] + ((size_t)(seq - NBP) * 2048 + (pos - 16)) * 1024);
        int bad = 0;
        for (int c = lane; c < 1024; c += 64) { const float e = xr[c]; const float st = bf2f(h0b[(size_t)row * 1024 + c]); if (!(fabsf(st - e) <= 0.01f * fabsf(e) + 0.001f)) bad = 1; }
        bad = __any(bad);
        if (lane == 0 && bad) atomicAdd(cnt + slot, 1u);
    }
}
#endif

#if DEBUG_CHECK == 8
__device__ __forceinline__ void check_p_golden(const Params& p) {
    unsigned char* ws = launder(p.ws); unsigned* cnt = (unsigned*)(ws + OFF_DBGW);
    const bf16_t* P = (const bf16_t*)(ws + OFF_P);
    const unsigned idx = blockIdx.x * 512u + (unsigned)tid_l();
    unsigned hsh = idx * 2654435761u + 8888u; hsh ^= hsh >> 15; hsh *= 2246822519u; hsh ^= hsh >> 13;
    const int row = (int)(hsh % (unsigned)T); hsh = hsh * 3266489917u + 668265263u; hsh ^= hsh >> 16;
    int pos, seq; row_info(row, pos, seq);
    const float* xr = pos < 16 ? p.in[2] + (size_t)pos * 1024 : (seq < NBP ? p.in[0] + ((size_t)seq * 8192 + (pos - 16)) * 1024 : p.in[1] + ((size_t)(seq - NBP) * 2048 + (pos - 16)) * 1024);
    const float* W = p.in[4]; const float* g = p.in[3];
    const int colA = 448 + (int)(hsh % 1536u), colB = (int)((hsh >> 7) % 384u);
    float ss = 0.f, a = 0.f, b = 0.f;
    for (int k = 0; k < 1024; ++k) { const float x = xr[k]; ss += x * x; a += x * g[k] * W[(size_t)k * 1984 + colA]; b += x * g[k] * W[(size_t)k * 1984 + colB]; }
    const float r0 = rsqrtf(ss * (1.f / 1024.f) + EPS); a *= r0; b *= r0;
    const float sa = bf2f(P[(size_t)row * NPP + colA]), sb = bf2f(P[(size_t)row * NPP + colB]);
    if (!(fabsf(sa - a) <= 0.03f * fabsf(a) + 0.03f)) atomicAdd(cnt + 8, 1u);
    if (!(fabsf(sb - b) <= 0.03f * fabsf(b) + 0.03f)) atomicAdd(cnt + 9, 1u);
}
#endif

#if DEBUG_CHECK == 9
__device__ __forceinline__ void check_win_r0(const Params& p) {
    unsigned char* ws = launder(p.ws); unsigned* cnt = (unsigned*)(ws + OFF_DBGW);
    const bf16_t* WT = (const bf16_t*)(ws + OFF_WIN); const float* W = p.in[4]; const float* g = p.in[3]; const float* R0 = (const float*)(ws + OFF_R0);
    const int tid = tid_l(), lane = tid & 63, wave = tid >> 6;
    const int gtid = blockIdx.x * 512 + tid, gthreads = gridDim.x * 512;
    for (int e = gtid; e < 1984 * 1024; e += gthreads) {
        const int n = e >> 10, k = e & 1023; const int sc = src_col(1, n);
        const float ex = W[(size_t)k * 1984 + sc] * g[k]; const float st = bf2f(WT[(size_t)n * 1024 + k]);
        if (!(fabsf(st - ex) <= 0.01f * fabsf(ex) + 1e-5f)) atomicAdd(cnt + 8, 1u);
    }
    for (int row = blockIdx.x * 8 + wave; row < T; row += gridDim.x * 8) {
        int pos, seq; row_info(row, pos, seq);
        const float* xr = pos < 16 ? p.in[2] + (size_t)pos * 1024 : (seq < NBP ? p.in[0] + ((size_t)seq * 8192 + (pos - 16)) * 1024 : p.in[1] + ((size_t)(seq - NBP) * 2048 + (pos - 16)) * 1024);
        float ss = 0.f;
        for (int c = lane; c < 1024; c += 64) ss += xr[c] * xr[c];
        ss = wave_sum(ss);
        const float ex = rsqrtf(ss * (1.f / 1024.f) + EPS); const float st = R0[row];
        if (lane == 0 && !(fabsf(st - ex) <= 0.001f * ex)) { atomicAdd(cnt + 9, 1u); atomicAdd(cnt + 12, (unsigned)(row >> 6)); }
    }
}
#endif

#if DEBUG_CHECK == 10
__device__ __forceinline__ void check_x(const Params& p, int mode) {
    unsigned char* ws = launder(p.ws); unsigned* cnt = (unsigned*)(ws + OFF_DBGW); unsigned* sums = (unsigned*)(ws + OFF_DBGW + MiB);
    const int tid = tid_l(), lane = tid & 63, wave = tid >> 6;
    for (int n = blockIdx.x * 8 + wave; n < TN; n += gridDim.x * 8) {
        const unsigned* xr = (const unsigned*)(n < 65536 ? p.in[0] + (size_t)n * 1024 : p.in[1] + (size_t)(n - 65536) * 1024);
        unsigned a = 0u;
        for (int c = lane; c < 1024; c += 64) a += xr[c] * (2u * (unsigned)c + 1u);
#pragma unroll
        for (int o = 1; o < 64; o <<= 1) a += __shfl_xor(a, o);
        if (lane == 0) {
            if (mode == 0) __hip_atomic_store(sums + n, a, __ATOMIC_RELAXED, __HIP_MEMORY_SCOPE_AGENT);
            else if (__hip_atomic_load(sums + n, __ATOMIC_RELAXED, __HIP_MEMORY_SCOPE_AGENT) != a) atomicAdd(cnt + 8, 1u);
        }
    }
}
#endif

#if DEBUG_CHECK == 11
__device__ __forceinline__ void check_filt_prep(const Params& p) {
    unsigned char* ws = launder(p.ws); unsigned* cnt = (unsigned*)(ws + OFF_DBGW);
    const unsigned idx = blockIdx.x * 512u + (unsigned)tid_l();
    unsigned hsh = idx * 2654435761u + 1111u; hsh ^= hsh >> 15; hsh *= 2246822519u; hsh ^= hsh >> 13;
    {
        const int set = (int)(hsh & 1u); const int L = set ? LS : LP; const int C0 = set ? LGS : LGP;
        const int n = (int)((hsh >> 1) % 2048u); hsh = hsh * 3266489917u + 668265263u; hsh ^= hsh >> 16;
        const int t = (int)(hsh % (unsigned)L);
        const float* f_w1 = p.in[10]; const float* f_b1 = p.in[11]; const float* f_freq = p.in[12]; const float* f_w2 = p.in[13];
        const float* f_b2 = p.in[14]; const float* f_w3 = p.in[15]; const float* f_decay = p.in[16];
        const float tn = (float)t / (float)(L - 1); const float w = (6.2831853071795865f * (float)t) / (float)L;
        float acc = 0.f;
        for (int j2 = 0; j2 < 64; ++j2) {
            float a2 = f_b2[j2];
            for (int j1 = 0; j1 < 64; ++j1) {
                float a1 = f_b1[j1] + tn * f_w1[j1];
                for (int k = 0; k < 16; ++k) { const float f = 1e-4f + (float)k * ((15.0f - 1e-4f) / 15.0f); float sn, cs; sincos_red(f * w, sn, cs);
                    a1 += cs * f_w1[(1 + k) * 64 + j1] - sn * f_w1[(17 + k) * 64 + j1]; }
                a2 += sin_red(f_freq[j1] * a1) * f_w2[j1 * 64 + j2];
            }
            acc += sin_red(f_freq[j2] * a2) * f_w3[j2 * 2048 + n];
        }
        const float e = acc * __expf(-tn * fabsf(f_decay[n]));
        const int order = n >> 10, dir = (n >> 9) & 1, c = n & 511;
        if (!(dir == 1 && t == 0)) {
            const bf16_t* row = (const bf16_t*)(ws + (set ? OFF_GR1 : OFF_GR0)) + (size_t)(order * 512 + c) * (2 * C0);
            const float st = bf2f(row[dir ? C0 + t : C0 - t]);
            if (!(fabsf(st - e) <= 0.02f * fabsf(e) + 0.003f)) atomicAdd(cnt + 8, 1u);
        }
    }
    {
        const int seq = (int)(hsh % 40u); const int set = seq < NBP ? 0 : 1; const int L = set ? LS : LP; const int Lg = set ? LGS : LGP; const int NB = set ? NBS : NBP;
        const int b = set ? seq - NBP : seq; const int row0 = set ? TPR + b * LS : b * LP;
        hsh = hsh * 3266489917u + 668265263u; hsh ^= hsh >> 16;
        const int pos = (int)(hsh % (unsigned)L); const int which = (int)((hsh >> 16) % 3u); const int c = (int)((hsh >> 20) % 512u);
        const bf16_t* P = (const bf16_t*)(ws + OFF_P); const float* cw = p.in[9]; const int col = 448 + which * 512 + c;
        const float um = pos > 0 ? bf2f(P[(size_t)(row0 + pos - 1) * NPP + col]) : 0.f, u0 = bf2f(P[(size_t)(row0 + pos) * NPP + col]), up = pos + 1 < L ? bf2f(P[(size_t)(row0 + pos + 1) * NPP + col]) : 0.f;
        const float e = um * cw[which * 512 + c] + u0 * cw[1536 + which * 512 + c] + up * cw[3072 + which * 512 + c];
        const bf16_t* XT = (const bf16_t*)(ws + (which == 0 ? OFF_X1T : (which == 1 ? OFF_X2T : OFF_V0T))) + (set ? XT_SET1 : 0) + ((size_t)c * NB + b) * Lg;
        const float st = bf2f(XT[pos + 48]);
        if (!(fabsf(st - e) <= 0.02f * fabsf(e) + 0.02f)) atomicAdd(cnt + 9, 1u);
    }
}
#endif
#ifndef SUB_MASK
#define SUB_MASK 15
#endif
#ifndef PHASE_MASK
#define PHASE_MASK 1023
#endif
__global__ void __launch_bounds__(512) hymba_fwd(Params p) {
    extern __shared__ __attribute__((aligned(16))) unsigned char lds_raw[];
    LAS unsigned char* lds = (LAS unsigned char*)lds_raw;
    cg::grid_group grid = cg::this_grid();
#define GSYNC() do { asm volatile("s_waitcnt vmcnt(0) lgkmcnt(0)" ::: "memory"); __threadfence(); grid.sync(); } while (0)
    const int G = gridDim.x;
    __builtin_amdgcn_fence(__ATOMIC_SEQ_CST, "agent");
    asm volatile("buffer_inv sc1\n\ts_waitcnt vmcnt(0)" ::: "memory");
#if DEBUG_CHECK == 10
    check_x(p, 0);
#endif
#if PHASE_MASK & 1
    p0_prologue(p, lds);
#endif
    GSYNC();
#if DEBUG_CHECK == 3
    check_h0b(p, 8);
#endif
#if DEBUG_CHECK == 7
    check_h0b_full(p, 8);
#endif
#if DEBUG_CHECK == 4
    check_stale(p, (const unsigned*)(launder(p.ws) + OFF_H0B), (unsigned)((size_t)T * 512), 9);
#endif
#if PHASE_MASK & 2
    {
        unsigned char* ws = launder(p.ws); unsigned char* ob = launder((unsigned char*)p.out);
        pg8::Gemm g{(const bf16_t*)(ws + OFF_H0B), (const bf16_t*)(ws + OFF_WIN), TPAD, 2048, 1024, 1024, 1024};
        pg8::StaticOrder S; S.init(TPAD, 2048, G, blockIdx.x);
        Epi<0> E{(bf16_t*)(ws + OFF_P), NPP, (const float*)(ws + OFF_R0), (float*)(ws + OFF_SQQP), (float*)(ws + OFF_SQKVP), (bf16_t*)(ob + DO_KR), (const float2*)(ws + OFF_RT)};
        pg8::gemm_phase(lds, g, S, E);
    }
#endif
    GSYNC();
#if DEBUG_CHECK == 1
    { unsigned char* ws = launder(p.ws); check_gemm((const bf16_t*)(ws + OFF_H0B), 1024, (const bf16_t*)(ws + OFF_WIN), 1024, 1024, T, 1984, 0, (const bf16_t*)(ws + OFF_P), NPP, (const float*)(ws + OFF_R0), (unsigned*)(ws + OFF_DBG) + 0, 448); }
    GSYNC();
#endif
#if DEBUG_CHECK == 3
    check_h0b(p, 9);
#endif
#if DEBUG_CHECK == 8
    check_p_golden(p);
#endif
#if DEBUG_CHECK == 9
    check_win_r0(p);
#endif
#if DEBUG_CHECK == 7
    check_h0b_full(p, 9);
    GSYNC();
#endif
#if DEBUG_CHECK == 6
    { unsigned char* ws = launder(p.ws);
      check_gemm((const bf16_t*)(ws + OFF_H0B), 1024, (const bf16_t*)(ws + OFF_WIN), 1024, 1024, T, 448, 0, (const bf16_t*)(ws + OFF_P), NPP, (const float*)(ws + OFF_R0), (unsigned*)(ws + OFF_DBG) + 8, 384);
      check_gemm((const bf16_t*)(ws + OFF_H0B), 1024, (const bf16_t*)(ws + OFF_WIN), 1024, 1024, T, 384, 7, (const bf16_t*)(ws + OFF_P), NPP, (const float*)(ws + OFF_R0), (unsigned*)(ws + OFF_DBG) + 9, 0); }
    GSYNC();
#endif
#if DEBUG_CHECK == 4
    check_stale(p, (const unsigned*)(launder(p.ws) + OFF_P), (unsigned)((size_t)T * 1024), 8);
#endif
    rownorm_phase(p);
    krope_phase(p);
    GSYNC();
#if (PHASE_MASK & 4) && (SUB2 & 1)
    {
        unsigned char* ws = launder(p.ws); unsigned char* ob = launder((unsigned char*)p.out);
        pg8::Gemm g{(const bf16_t*)(ws + OFF_P), (const bf16_t*)(ws + OFF_WUQ), TPAD, 768, 256, NPP, 256};
        pg8::StaticOrder S; S.init(TPAD, 768, G, blockIdx.x);
        Epi<1> E{(bf16_t*)(ob + DO_Q), 768, (const float*)(ws + OFF_RQ), nullptr, nullptr, nullptr, (const float2*)(ws + OFF_RT)};
        pg8::gemm_phase(lds, g, S, E);
    }
#endif
#if (PHASE_MASK & 4) && (SUB2 & 2)
    {
        unsigned char* ws = launder(p.ws); unsigned char* ob = launder((unsigned char*)p.out);
        pg8::Gemm g{(const bf16_t*)(ws + OFF_P) + 256, (const bf16_t*)(ws + OFF_WKN), TPAD, 512, 128, NPP, 128};
        pg8::StaticOrder S; S.init(TPAD, 512, G, blockIdx.x);
        Epi<2> E{(bf16_t*)(ob + DO_KN), 512, (const float*)(ws + OFF_RKV), nullptr, nullptr, nullptr, nullptr};
        pg8::gemm_phase(lds, g, S, E);
    }
#endif
#if (PHASE_MASK & 4) && (SUB2 & 4)
    {
        unsigned char* ws = launder(p.ws); unsigned char* ob = launder((unsigned char*)p.out);
        pg8::Gemm g{(const bf16_t*)(ws + OFF_WV), (const bf16_t*)(ws + OFF_P) + 256, 512, TPAD, 128, 128, NPP};
        pg8::StaticOrder S; S.init(512, TPAD, G, blockIdx.x);
        Epi<3> E{(bf16_t*)(ob + DO_VT), TPAD, (const float*)(ws + OFF_RKV), nullptr, nullptr, nullptr, nullptr};
        pg8::gemm_phase(lds, g, S, E);
    }
#endif
#if PHASE_MASK & 8
    hyprep_phase(p, lds);
#endif
    GSYNC();
#if DEBUG_CHECK == 2
    check_proj(p);
    GSYNC();
#endif
#if DEBUG_CHECK == 11
    check_filt_prep(p);
    GSYNC();
#endif
#if PHASE_MASK & 16
    attn_phase(p, lds);
#endif
#if PHASE_MASK & 32
    hyena_phase(p, lds);
#endif
    GSYNC();
#if DEBUG_CHECK == 5
    check_attn(p);
    check_hyena(p, lds);
    GSYNC();
#endif
#if PHASE_MASK & 64
    mixnorm_phase(p, lds);
#endif
    GSYNC();
#if PHASE_MASK & 128
    {
        unsigned char* ws = launder(p.ws);
        pg8::Gemm g{(const bf16_t*)(ws + OFF_MIXN), (const bf16_t*)(ws + OFF_WO), TN, 1024, 1024, 1024, 1024};
        pg8::StaticOrder S; S.init(TN, 1024, G, blockIdx.x);
        Epi<4> E{(bf16_t*)(ws + OFF_MIX), 1024, nullptr, (float*)(ws + OFF_SQMIXP), nullptr, nullptr, nullptr};
        pg8::gemm_phase(lds, g, S, E);
    }
#endif
    GSYNC();
#if DEBUG_CHECK == 1
    { unsigned char* ws = launder(p.ws); check_gemm((const bf16_t*)(ws + OFF_MIXN), 1024, (const bf16_t*)(ws + OFF_WO), 1024, 1024, TN, 1024, 4, (const bf16_t*)(ws + OFF_MIX), 1024, nullptr, (unsigned*)(ws + OFF_DBG) + 1, 0); }
#endif
#if DEBUG_CHECK == 10
    check_x(p, 1);
#endif
#if PHASE_MASK & 256
    h1_phase(p);
#endif
    GSYNC();
#if PHASE_MASK & 512
#if DEBUG_CHECK == 1
#define DBG_FF1(half) if ((half) == 0) { unsigned char* ws = launder(p.ws); check_gemm((const bf16_t*)(ws + OFF_H1B), 1024, (const bf16_t*)(ws + OFF_WF1), 1024, 1024, 65536, 4096, 5, (const bf16_t*)(ws + OFF_M), 4096, (const float*)(ws + OFF_R1), (unsigned*)(ws + OFF_DBG) + 2, 0); }
#define DBG_FF2(half) if ((half) == 0) { unsigned char* ws = launder(p.ws); check_gemm((const bf16_t*)(ws + OFF_M), 4096, (const bf16_t*)(ws + OFF_WF2), 4096, 4096, 65536, 1024, 6, (const bf16_t*)(ws + OFF_M2), 1024, nullptr, (unsigned*)(ws + OFF_DBG) + 3, 0); } GSYNC();
#else
#define DBG_FF1(half)
#define DBG_FF2(half)
#endif
#define FFN_HALF(half) \
    { \
        unsigned char* ws = launder(p.ws); \
        pg8::Gemm g{(const bf16_t*)(ws + OFF_H1B) + (size_t)(half) * 65536 * 1024, (const bf16_t*)(ws + OFF_WF1), 65536, 4096, 1024, 1024, 1024}; \
        pg8::StaticOrder S; S.init(65536, 4096, G, blockIdx.x); \
        Epi<5> E{(bf16_t*)(ws + OFF_M), 4096, (const float*)(ws + OFF_R1) + (half) * 65536, nullptr, nullptr, nullptr, nullptr}; \
        pg8::gemm_phase(lds, g, S, E); \
    } \
    GSYNC(); \
    DBG_FF1(half) \
    { \
        unsigned char* ws = launder(p.ws); \
        pg8::Gemm g{(const bf16_t*)(ws + OFF_M), (const bf16_t*)(ws + OFF_WF2), 65536, 1024, 4096, 4096, 4096}; \
        pg8::StaticOrder S; S.init(65536, 1024, G, blockIdx.x); \
        Epi<6> E{(bf16_t*)(ws + OFF_M2), 1024, nullptr, (float*)(ws + OFF_SQM2P) + (size_t)(half) * 65536 * 16, nullptr, nullptr, nullptr}; \
        pg8::gemm_phase(lds, g, S, E); \
    } \
    GSYNC(); \
    DBG_FF2(half) \
    final_phase(p, half);
    FFN_HALF(0)
    FFN_HALF(1)
#undef FFN_HALF
#endif
}

extern "C" void kernel_launch(void* const* d_in, const int* in_sizes, int n_in, void* d_out, int out_size, void* d_ws, size_t ws_size, hipStream_t stream) {
    static int grid = 0;
    if (grid == 0) {
        int dev = 0, cus = 0, per_cu = 0;
        hipGetDevice(&dev);
        hipDeviceGetAttribute(&cus, hipDeviceAttributeMultiprocessorCount, dev);
        hipFuncSetAttribute((const void*)hymba_fwd, hipFuncAttributeMaxDynamicSharedMemorySize, LDS_BYTES);
        hipOccupancyMaxActiveBlocksPerMultiprocessor(&per_cu, (const void*)hymba_fwd, 512, LDS_BYTES);
        if (per_cu < 1) per_cu = 1;
        grid = cus * 1;
        if (n_in != 26 || ws_size < 1024 * MiB) fprintf(stderr, "kernel_launch: unexpected n_in %d / ws_size %zu\n", n_in, ws_size);
    }
    Params p{};
    for (int i = 0; i < 26; ++i) p.in[i] = (const float*)d_in[i];
    p.out = (float*)d_out; p.ws = (unsigned char*)d_ws;
    void* args[] = {&p};
    hipError_t e = hipLaunchCooperativeKernel((const void*)hymba_fwd, dim3(grid), dim3(512), args, LDS_BYTES, stream);
    if (e != hipSuccess) fprintf(stderr, "cooperative launch failed: %s (grid %d)\n", hipGetErrorString(e), grid);
}
```

```cpp
#include <hip/hip_runtime.h>
#include <hip/hip_cooperative_groups.h>
#include <cstdio>
#include <cstdint>
namespace cg = cooperative_groups;
#ifndef DBG_SEL0
#define DBG_SEL0 3
#endif
#ifndef DBG_SEL1
#define DBG_SEL1 0
#endif
#ifndef DEBUG_CHECK
#define DEBUG_CHECK 0
#endif
#ifndef EXPT
#define EXPT 0
#endif
#ifndef SUB_MASK
#define SUB_MASK 15
#endif
#ifndef SUB2
#define SUB2 7
#endif

#define LAS __attribute__((address_space(3)))
typedef unsigned short bf16_t;
typedef short bf16x8 __attribute__((ext_vector_type(8)));
typedef float f32x4 __attribute__((ext_vector_type(4)));
typedef float f32x16 __attribute__((ext_vector_type(16)));
typedef unsigned u32x4 __attribute__((ext_vector_type(4)));
typedef unsigned u32x2 __attribute__((ext_vector_type(2)));

constexpr int DM = 1024, LP = 8208, LS = 2064, NBP = 8, NBS = 32;
constexpr int TPR = NBP * LP;
constexpr int TSR = NBS * LS;
constexpr int T = TPR + TSR;
constexpr int TPAD = 131840;
constexpr int TN = 131072;
constexpr int NPP = 2048;
constexpr int LGP = 8256, LGS = 2112;
constexpr float EPS = 1e-6f;
constexpr float QSCALE = 0.07216878364870322f * 1.4426950408889634f;

constexpr size_t MiB = 1ull << 20;
constexpr size_t OFF_H0B = 0;
constexpr size_t XT_SET1 = (size_t)512 * NBP * LGP;
constexpr size_t OFF_X1T = 0;
constexpr size_t OFF_X2T = 131 * MiB;
constexpr size_t OFF_P = 262 * MiB;
constexpr size_t OFF_V0T = 778 * MiB;
constexpr size_t OFF_MIXN = 262 * MiB;
constexpr size_t OFF_MIX = 518 * MiB;
constexpr size_t OFF_H1B = 0;
constexpr size_t OFF_M = 256 * MiB;
constexpr size_t OFF_M2 = 768 * MiB;
constexpr size_t OFF_SQMIXP = 896 * MiB;
constexpr size_t OFF_SQM2P = 904 * MiB;
constexpr size_t OFF_SMALL = 912 * MiB;
constexpr size_t OFF_WIN = OFF_SMALL;
constexpr size_t OFF_WUQ = OFF_SMALL + 4 * MiB;
constexpr size_t OFF_WKN = OFF_SMALL + 4 * MiB + 512 * 1024;
constexpr size_t OFF_WV = OFF_SMALL + 4 * MiB + 768 * 1024;
constexpr size_t OFF_WO = OFF_SMALL + 5 * MiB;
constexpr size_t OFF_WF1 = OFF_SMALL + 7 * MiB;
constexpr size_t OFF_WF2 = OFF_SMALL + 15 * MiB;
constexpr size_t OFF_GR0 = OFF_SMALL + 23 * MiB;
constexpr size_t OFF_GR1 = OFF_SMALL + 56 * MiB;
constexpr size_t OFF_RT = OFF_SMALL + 65 * MiB;
constexpr size_t OFF_R0 = OFF_SMALL + 68 * MiB;
constexpr size_t OFF_R1 = OFF_SMALL + 69 * MiB;
constexpr size_t OFF_RQ = OFF_SMALL + 70 * MiB;
constexpr size_t OFF_RKV = OFF_SMALL + 71 * MiB;
constexpr size_t OFF_SQQP = OFF_SMALL + 72 * MiB;
constexpr size_t OFF_SQKVP = OFF_SMALL + 75 * MiB;
constexpr size_t OFF_DBGW = OFF_SMALL + 78 * MiB;
constexpr size_t DO_Q = 0;
constexpr size_t DO_KN = 194 * MiB;
constexpr size_t DO_KR = 323 * MiB;
constexpr size_t DO_VT = 340 * MiB;

constexpr size_t OFF_ODBG = 518 * MiB;
constexpr size_t OFF_HDBG = 647 * MiB;
constexpr int LDS_BYTES = 147456;

struct Params {
    const float* in[26];
    float* out;
    unsigned char* ws;
};

__device__ __forceinline__ f32x4 ld_sys(const float* q) { f32x4 v; asm volatile("global_load_dwordx4 %0, %1, off sc0 sc1\n\ts_waitcnt vmcnt(0)" : "=v"(v) : "v"(q) : "memory"); return v; }
__device__ __forceinline__ float ldco(const float* q) { return __builtin_bit_cast(float, __hip_atomic_load((const unsigned*)q, __ATOMIC_RELAXED, __HIP_MEMORY_SCOPE_AGENT)); }
__device__ __forceinline__ float2 ldco2(const float2* q) { const unsigned long long w = __hip_atomic_load((const unsigned long long*)q, __ATOMIC_RELAXED, __HIP_MEMORY_SCOPE_AGENT); return make_float2(__builtin_bit_cast(float, (unsigned)w), __builtin_bit_cast(float, (unsigned)(w >> 32))); }
template <class Tp> __device__ __forceinline__ Tp* launder(Tp* q) { asm volatile("" : "+s"(q)); return q; }
__device__ __forceinline__ int tid_l() { int t = threadIdx.x; asm volatile("" : "+v"(t)); return t; }
__device__ __forceinline__ unsigned cvt_pk_bf16(float lo, float hi) { unsigned r; asm volatile("v_cvt_pk_bf16_f32 %0, %1, %2" : "=v"(r) : "v"(lo), "v"(hi)); return r; }
__device__ __forceinline__ float bf2f(unsigned short b) { return __builtin_bit_cast(float, (unsigned)b << 16); }
__device__ __forceinline__ float bflo(unsigned w) { return __builtin_bit_cast(float, w << 16); }
__device__ __forceinline__ float bfhi(unsigned w) { return __builtin_bit_cast(float, w & 0xffff0000u); }
__device__ __forceinline__ float wave_sum(float v) {
#pragma unroll
    for (int o = 1; o < 64; o <<= 1) v += __shfl_xor(v, o);
    return v;
}
__device__ __forceinline__ void sincos_red(float x, float& s, float& c) {
    const double xd = (double)x; const double k = rint(xd * 0.15915494309189535); const float r = (float)(xd - k * 6.283185307179586);
    s = __sinf(r); c = __cosf(r);
}
__device__ __forceinline__ float sin_red(float x) { float s, c; sincos_red(x, s, c); return s; }
__device__ __forceinline__ void row_info(int r, int& pos, int& seq) {
    if (r < TPR) { seq = r / LP; pos = r - seq * LP; }
    else { int q = r - TPR; if (q >= TSR) q = TSR - 1; const int b = q / LS; pos = q - b * LS; seq = NBP + b; }
}
__device__ __forceinline__ int full_row(int n) {
    if (n < 65536) { const int b = n >> 13; return b * LP + 16 + (n & 8191); }
    const int q = n - 65536; const int b = q >> 11; return TPR + b * LS + 16 + (q & 2047);
}

namespace pg8 {
constexpr int BM = 256, BK = 64, HALF = 128, HTB = HALF * BK * 2, STAGE_BYTES = 8 * HTB, NXCD = 8, WGM = 8;
__host__ __device__ __forceinline__ int lds_byte(int r, int c) { const int st = (r >> 4) * 2 + (c >> 5), rr = r & 15, cc = c & 31, ob = rr * 64 + cc * 2; return st * 1024 + (ob ^ (((ob >> 9) & 1) << 5)); }
__host__ __device__ __forceinline__ void stage_rc(int b, int& R, int& C) { const int st = b / 1024, sb = b % 1024, swz = sb ^ (((sb >> 9) & 1) << 5); R = (st >> 1) * 16 + swz / 64; C = (st & 1) * 32 + (swz % 64) / 2; }
__host__ __device__ __forceinline__ int perm32(int rho) { const int n = rho >> 4, i = rho & 15; return 8 * (i >> 2) + 4 * n + (i & 3); }
struct Unit { int pm, pn; };
struct Gemm { const bf16_t* A; const bf16_t* Bt; int M, N, K, lda, ldb; };
struct StaticOrder {
    int nM, nN, nwg, G, c;
    __device__ void init(int M, int N, int G_, int c_) { nM = M / BM; nN = N / BM; nwg = nM * nN; G = G_; c = c_; }
    __device__ bool next(int i, Unit& u) const {
        const long L = (long)i * G + c; if (L >= nwg) return false;
        int wgid = (int)L; { const int q = nwg / NXCD, r = nwg % NXCD, xcd = wgid % NXCD, off = wgid / NXCD; wgid = (xcd < r ? xcd * (q + 1) : r * (q + 1) + (xcd - r) * q) + off; }
        const int nig = WGM * nN, gid = wgid / nig, fm = gid * WGM, gsz = (nM - fm) < WGM ? (nM - fm) : WGM;
        u.pm = fm + ((wgid % nig) % gsz); u.pn = (wgid % nig) / gsz; return true;
    }
};
template <class Epi>
__device__ __forceinline__ void gemm_phase(LAS unsigned char* lds, const Gemm g, const StaticOrder& S, const Epi& E) {
    const int tid = tid_l(), wid = __builtin_amdgcn_readfirstlane(tid >> 6), lane = tid & 63, wr = wid >> 2, wc = wid & 3, fr = lane & 15, fq = lane >> 4;
    const int K = g.K, nt = K / BK;
    unsigned voffA[2], voffB[2];
#pragma unroll
    for (int i = 0; i < 2; ++i) { int R, C; stage_rc(tid * 16 + i * 8192, R, C); const int Rb = (R & ~31) + perm32(R & 31);
        voffA[i] = (unsigned)(R * g.lda + C) * 2u; voffB[i] = (unsigned)(Rb * g.ldb + C) * 2u; }
    const size_t kstep = (size_t)(BK * 2);
    const size_t hstepA = (size_t)HALF * g.lda * 2, hstepB = (size_t)HALF * g.ldb * 2;
    const size_t tstepA = 2 * hstepA, tstepB = 2 * hstepB;
    const unsigned ldsw = (unsigned)wid * 1024u;
    const int aoff = lds_byte(wr * 64 + fr, fq * 8), boff = lds_byte(wc * 32 + fr, fq * 8);
#define PG8_SA(b, h) (((b) * 2 + (h)) * HTB)
#define PG8_SB(b, h) ((4 + (b) * 2 + (h)) * HTB)
#define PG8_STAGE(bufoff, gbase, voff) do { _Pragma("unroll") for (int _i = 0; _i < 2; ++_i) \
        __builtin_amdgcn_global_load_lds((const unsigned*)((const char*)(gbase) + (voff)[_i]), (LAS unsigned*)(lds + (bufoff) + ldsw + _i * 8192), 16, 0, 0); } while (0)
#define PG8_LDA(dst, b, h) do { _Pragma("unroll") for (int m = 0; m < 4; ++m) _Pragma("unroll") for (int k = 0; k < 2; ++k) dst[m][k] = *(const LAS bf16x8*)(lds + PG8_SA(b, h) + aoff + m * 2048 + k * 1024); } while (0)
#define PG8_LDB(dst, b, h) do { _Pragma("unroll") for (int n = 0; n < 2; ++n) _Pragma("unroll") for (int k = 0; k < 2; ++k) dst[n][k] = *(const LAS bf16x8*)(lds + PG8_SB(b, h) + boff + n * 2048 + k * 1024); } while (0)
#define PG8_MMA(ai, bj, At, Bt) do { __builtin_amdgcn_s_setprio(1); _Pragma("unroll") for (int m = 0; m < 4; ++m) _Pragma("unroll") for (int n = 0; n < 2; ++n) _Pragma("unroll") for (int k = 0; k < 2; ++k) \
        acc[ai][bj][m][n] = __builtin_amdgcn_mfma_f32_16x16x32_bf16(Bt[n][k], At[m][k], acc[ai][bj][m][n], 0, 0, 0); __builtin_amdgcn_s_setprio(0); } while (0)
#define PG8_WAIT_V(n) asm volatile("s_waitcnt vmcnt(" #n ")" ::: "memory")
#define PG8_WAIT_L(n) asm volatile("s_waitcnt lgkmcnt(" #n ")" ::: "memory")
#define PG8_BAR __builtin_amdgcn_s_barrier()
#define PG8_SCHED __builtin_amdgcn_sched_barrier(0)
    Unit cur, nxt; int ui = 0;
    if (!S.next(0, cur)) return;
    f32x4 acc[2][2][4][2];
#pragma unroll
    for (int a = 0; a < 2; ++a)
#pragma unroll
        for (int b = 0; b < 2; ++b)
#pragma unroll
            for (int m = 0; m < 4; ++m)
#pragma unroll
                for (int n = 0; n < 2; ++n) acc[a][b][m][n] = (f32x4){0.f, 0.f, 0.f, 0.f};
    bf16x8 At[4][2], B0[2][2], B1[2][2];
    const char* cA = (const char*)g.A + (size_t)cur.pm * tstepA; const char* cB = (const char*)g.Bt + (size_t)cur.pn * tstepB;
    PG8_STAGE(PG8_SB(0, 0), cB, voffB); PG8_STAGE(PG8_SB(0, 1), cB + hstepB, voffB); PG8_STAGE(PG8_SA(0, 0), cA, voffA); PG8_STAGE(PG8_SA(0, 1), cA + hstepA, voffA);
    if (wr == 1) PG8_BAR;
    PG8_WAIT_V(2); PG8_BAR;
    PG8_STAGE(PG8_SB(1, 0), cB + kstep, voffB); PG8_STAGE(PG8_SA(1, 0), cA + kstep, voffA); PG8_STAGE(PG8_SB(1, 1), cB + hstepB + kstep, voffB);
    PG8_WAIT_V(6); PG8_BAR;
    for (;;) {
        const bool has_next = S.next(ui + 1, nxt);
        const char* nA = has_next ? (const char*)g.A + (size_t)nxt.pm * tstepA : cA; const char* nB = has_next ? (const char*)g.Bt + (size_t)nxt.pn * tstepB : cB;
        for (int t = 0; t < nt; t += 2) {
            const bool last = (t == nt - 2);
            const char* a1 = cA + (size_t)(t + 1) * kstep;
            const char* a2 = last ? nA : cA + (size_t)(t + 2) * kstep; const char* b2 = last ? nB : cB + (size_t)(t + 2) * kstep;
            const char* a3 = a2 + kstep; const char* b3 = b2 + kstep;
            PG8_LDB(B0, 0, 0); PG8_LDB(B1, 0, 1); PG8_SCHED; PG8_LDA(At, 0, 0); PG8_STAGE(PG8_SA(1, 1), a1 + hstepA, voffA);
            PG8_WAIT_V(8); PG8_WAIT_L(0); PG8_BAR; PG8_MMA(0, 0, At, B0); PG8_MMA(0, 1, At, B1); PG8_BAR; PG8_SCHED;
            PG8_LDA(At, 0, 1); PG8_STAGE(PG8_SB(0, 0), b2, voffB); PG8_STAGE(PG8_SB(0, 1), b2 + hstepB, voffB); PG8_STAGE(PG8_SA(0, 0), a2, voffA);
            PG8_WAIT_V(8); PG8_WAIT_L(0); PG8_BAR; PG8_MMA(1, 0, At, B0); PG8_MMA(1, 1, At, B1); PG8_BAR; PG8_SCHED;
            PG8_LDB(B0, 1, 0); PG8_LDB(B1, 1, 1); PG8_SCHED; PG8_LDA(At, 1, 0); PG8_STAGE(PG8_SA(0, 1), a2 + hstepA, voffA);
            PG8_WAIT_V(8); PG8_WAIT_L(0); PG8_BAR; PG8_MMA(0, 0, At, B0); PG8_MMA(0, 1, At, B1); PG8_BAR; PG8_SCHED;
            PG8_LDA(At, 1, 1); PG8_STAGE(PG8_SB(1, 0), b3, voffB); PG8_STAGE(PG8_SB(1, 1), b3 + hstepB, voffB); PG8_STAGE(PG8_SA(1, 0), a3, voffA);
            PG8_WAIT_V(8); PG8_WAIT_L(0); PG8_BAR; PG8_MMA(1, 0, At, B0); PG8_MMA(1, 1, At, B1); PG8_BAR; PG8_SCHED;
        }
        if (wr == 0) PG8_BAR;
        E(acc, cur, wr, wc, fr, fq);
        if (!has_next) break;
#pragma unroll
        for (int a = 0; a < 2; ++a)
#pragma unroll
            for (int b = 0; b < 2; ++b)
#pragma unroll
                for (int m = 0; m < 4; ++m)
#pragma unroll
                    for (int n = 0; n < 2; ++n) acc[a][b][m][n] = (f32x4){0.f, 0.f, 0.f, 0.f};
        cur = nxt; cA = nA; cB = nB; ++ui;
        if (wr == 1) PG8_BAR;
    }
    PG8_WAIT_V(0);
    PG8_BAR;
#undef PG8_SA
#undef PG8_SB
#undef PG8_STAGE
#undef PG8_LDA
#undef PG8_LDB
#undef PG8_MMA
#undef PG8_WAIT_V
#undef PG8_WAIT_L
#undef PG8_BAR
#undef PG8_SCHED
}
}

__device__ __forceinline__ void rope8(f32x4& v0, f32x4& v1, const float2* rt  ) {
    const float2 c0 = ldco2(rt), c1 = ldco2(rt + 1), c2 = ldco2(rt + 2), c3 = ldco2(rt + 3);
    float a, b;
    a = v0[0]; b = v0[1]; v0[0] = a * c0.x - b * c0.y; v0[1] = b * c0.x + a * c0.y;
    a = v0[2]; b = v0[3]; v0[2] = a * c1.x - b * c1.y; v0[3] = b * c1.x + a * c1.y;
    a = v1[0]; b = v1[1]; v1[0] = a * c2.x - b * c2.y; v1[1] = b * c2.x + a * c2.y;
    a = v1[2]; b = v1[3]; v1[2] = a * c3.x - b * c3.y; v1[3] = b * c3.x + a * c3.y;
}
__device__ __forceinline__ u32x4 pack8(const f32x4& v0, const f32x4& v1) {
    u32x4 w; w.x = cvt_pk_bf16(v0[0], v0[1]); w.y = cvt_pk_bf16(v0[2], v0[3]); w.z = cvt_pk_bf16(v1[0], v1[1]); w.w = cvt_pk_bf16(v1[2], v1[3]); return w;
}
__device__ __forceinline__ float sq8(const f32x4& a, const f32x4& b) {
    return (a[0] * a[0] + a[1] * a[1]) + (a[2] * a[2] + a[3] * a[3]) + (b[0] * b[0] + b[1] * b[1]) + (b[2] * b[2] + b[3] * b[3]);
}
template <int MODE> struct Epi {
    bf16_t* O; int ldc; const float* rs; float* sq0; float* sq1; bf16_t* KR; const float2* RT;
    __device__ __forceinline__ void operator()(const f32x4 (&acc)[2][2][4][2], const pg8::Unit& u, int wr, int wc, int fr, int fq) const {
#pragma unroll
        for (int ai = 0; ai < 2; ++ai)
#pragma unroll
            for (int m = 0; m < 4; ++m) {
                const int row = u.pm * 256 + ai * 128 + wr * 64 + m * 16 + fr;
                float sc = 1.f;
                if (MODE == 0 || MODE == 1 || MODE == 2 || MODE == 5) sc = ldco(rs + row);
                float ssum[2];
#pragma unroll
                for (int bj = 0; bj < 2; ++bj) {
                    const int col0 = u.pn * 256 + bj * 128 + wc * 32 + 8 * fq;
                    f32x4 v0 = acc[ai][bj][m][0] * sc, v1 = acc[ai][bj][m][1] * sc;
                    if (MODE == 3) {
#pragma unroll
                        for (int j = 0; j < 4; ++j) { v0[j] *= ldco(rs + col0 + j); v1[j] *= ldco(rs + col0 + 4 + j); }
                    }
                    if (MODE == 5) {
#pragma unroll
                        for (int j = 0; j < 4; ++j) { const float a = fmaxf(v0[j], 0.f), b = fmaxf(v1[j], 0.f); v0[j] = a * a; v1[j] = b * b; }
                    }
                    ssum[bj] = sq8(v0, v1);
                    *(u32x4*)(O + (size_t)row * ldc + col0) = pack8(v0, v1);
                }
                if (MODE == 0) {
                    if (u.pn == 0) { float s = ssum[0] + ssum[1]; s += __shfl_xor(s, 16); s += __shfl_xor(s, 32); if (fq == 0) sq0[row * 4 + wc] = s; }
                    else if (u.pn == 1) { float s = ssum[0]; s += __shfl_xor(s, 16); s += __shfl_xor(s, 32); if (fq == 0) sq1[row * 4 + wc] = s; }
                }
                if (MODE == 4 || MODE == 6) { float s = ssum[0] + ssum[1]; s += __shfl_xor(s, 16); s += __shfl_xor(s, 32); if (fq == 0) sq0[(size_t)row * 16 + u.pn * 4 + wc] = s; }
            }
    }
};

__device__ __forceinline__ int src_col(int mode, int n) {
    if (mode == 0) return n;
    if (mode == 1) { if (n >= 1984) return -1; if (n >= 384 && n < 448) { const int j = n - 384; return 384 + ((j & 1) ? 32 + (j >> 1) : (j >> 1)); } return n; }
    if (mode == 2) { const int h = n / 192, w = n % 192; if (w < 128) return n; const int j = w - 128; return h * 192 + 128 + ((j & 1) ? 32 + (j >> 1) : (j >> 1)); }
    if (mode == 3) return (n >> 7) * 256 + (n & 127);
    return (n >> 7) * 256 + 128 + (n & 127);
}
__device__ __forceinline__ void conv_weight(const float* W, const float* g, bf16_t* out, int K, int Nsrc, int Nout, int mode, int gtid, int gthreads) {
    const int nch = Nout * (K / 8);
    for (int e = gtid; e < nch; e += gthreads) {
        const int n = e % Nout, kc = e / Nout, k0 = kc * 8; const int sc = src_col(mode, n);
        float v[8];
#pragma unroll
        for (int j = 0; j < 8; ++j) v[j] = (sc >= 0) ? W[(size_t)(k0 + j) * Nsrc + sc] * (g ? g[k0 + j] : 1.f) : 0.f;
        u32x4 w; w.x = cvt_pk_bf16(v[0], v[1]); w.y = cvt_pk_bf16(v[2], v[3]); w.z = cvt_pk_bf16(v[4], v[5]); w.w = cvt_pk_bf16(v[6], v[7]);
        *(u32x4*)(out + (size_t)n * K + k0) = w;
    }
}

__device__ __forceinline__ void p0_prologue(const Params& p, LAS unsigned char* lds) {
    unsigned char* ws = launder(p.ws);
    const int tid = tid_l(), lane = tid & 63, wave = tid >> 6, G = gridDim.x;
    const int gtid = blockIdx.x * 512 + tid, gthreads = G * 512;
    const int gw = blockIdx.x * 8 + wave, NGW = G * 8;
#if SUB_MASK & 1
    conv_weight(p.in[4], p.in[3], (bf16_t*)(ws + OFF_WIN), 1024, 1984, 2048, 1, gtid, gthreads);
    conv_weight(p.in[6], p.in[5], (bf16_t*)(ws + OFF_WUQ), 256, 768, 768, 2, gtid, gthreads);
    conv_weight(p.in[8], p.in[7], (bf16_t*)(ws + OFF_WKN), 128, 1024, 512, 3, gtid, gthreads);
    conv_weight(p.in[8], p.in[7], (bf16_t*)(ws + OFF_WV), 128, 1024, 512, 4, gtid, gthreads);
    conv_weight(p.in[20], nullptr, (bf16_t*)(ws + OFF_WO), 1024, 1024, 1024, 0, gtid, gthreads);
    conv_weight(p.in[23], p.in[22], (bf16_t*)(ws + OFF_WF1), 1024, 4096, 4096, 0, gtid, gthreads);
    conv_weight(p.in[24], nullptr, (bf16_t*)(ws + OFF_WF2), 4096, 1024, 1024, 0, gtid, gthreads);
#endif
#if SUB_MASK & 2
#if DEBUG_CHECK
    if (blockIdx.x == 0 && tid < 64) ((unsigned*)(ws + OFF_DBGW))[tid] = 0u;
#endif
    {
        float2* RT = (float2*)(ws + OFF_RT);
        for (int e = gtid; e < LP * 32; e += gthreads) {
            const int pos = e >> 5, i = e & 31;
            const float inv = 1.0f / exp2f((float)i * (13.287712379549449f / 32.f));
            float s, c; sincos_red((float)pos * inv, s, c);
            RT[e] = make_float2(c, s);
        }
    }
#endif
#if SUB_MASK & 4
    {
        bf16_t* h0b = (bf16_t*)(ws + OFF_H0B); float* r0 = (float*)(ws + OFF_R0);
        for (int r = gw; r < TPAD; r += NGW) {
            u32x2* o = (u32x2*)(h0b + (size_t)r * 1024) + lane;
            if (r >= T) {
#pragma unroll
                for (int j = 0; j < 4; ++j) o[64 * j] = (u32x2){0u, 0u};
                if (lane == 0) __hip_atomic_store(r0 + r, 0.f, __ATOMIC_RELAXED, __HIP_MEMORY_SCOPE_AGENT);
                continue;
            }
            int pos, seq; row_info(r, pos, seq);
            const float* src = pos < 16 ? p.in[2] + (size_t)pos * 1024
                                        : (seq < NBP ? p.in[0] + ((size_t)seq * 8192 + (pos - 16)) * 1024 : p.in[1] + ((size_t)(seq - NBP) * 2048 + (pos - 16)) * 1024);
            const f32x4* xr = (const f32x4*)src + lane;
            f32x4 v[4]; float ss = 0.f;
#pragma unroll
            for (int j = 0; j < 4; ++j) { v[j] = xr[64 * j]; ss += (v[j][0] * v[j][0] + v[j][1] * v[j][1]) + (v[j][2] * v[j][2] + v[j][3] * v[j][3]); }
            ss = wave_sum(ss);
#pragma unroll
            for (int j = 0; j < 4; ++j) o[64 * j] = (u32x2){cvt_pk_bf16(v[j][0], v[j][1]), cvt_pk_bf16(v[j][2], v[j][3])};
            if (lane == 0) __hip_atomic_store(r0 + r, rsqrtf(ss * (1.f / 1024.f) + EPS), __ATOMIC_RELAXED, __HIP_MEMORY_SCOPE_AGENT);
        }
    }
#endif
#if SUB_MASK & 8
    {
        const float* f_w1 = p.in[10]; const float* f_b1 = p.in[11]; const float* f_freq = p.in[12]; const float* f_w2 = p.in[13];
        const float* f_b2 = p.in[14]; const float* f_w3 = p.in[15]; const float* f_decay = p.in[16];
        LAS float* feats = (LAS float*)lds;
        LAS float* h1 = feats + 16 * 34;
        LAS float* h2 = h1 + 16 * 64;
        for (int u = blockIdx.x; u < 513 + 129; u += G) {
            const int set = u < 513 ? 0 : 1; const int t0 = 16 * (set ? u - 513 : u); const int L = set ? LS : LP; const int C0 = set ? LGS : LGP;
            bf16_t* GR = (bf16_t*)(ws + (set ? OFF_GR1 : OFF_GR0));
            const float invLm1 = 1.0f / (float)(L - 1);
            if (tid < 256) {
                const int tt = tid >> 4, k = tid & 15; const int t = t0 + tt;
                const float w = (6.2831853071795865f * (float)t) / (float)L;
                const float f = 1e-4f + (float)k * ((15.0f - 1e-4f) / 15.0f);
                float s, c; sincos_red(f * w, s, c);
                feats[tt * 34 + 1 + k] = c; feats[tt * 34 + 17 + k] = -s;
                if (k == 0) feats[tt * 34] = (float)t * invLm1;
            }
            __syncthreads();
#pragma unroll 1
            for (int q = 0; q < 2; ++q) {
                const int o = tid + 512 * q, tt = o >> 6, j = o & 63;
                float a = f_b1[j];
#pragma unroll 3
                for (int e = 0; e < 33; ++e) a += feats[tt * 34 + e] * f_w1[e * 64 + j];
                h1[tt * 64 + j] = sin_red(f_freq[j] * a);
            }
            __syncthreads();
#pragma unroll 1
            for (int q = 0; q < 2; ++q) {
                const int o = tid + 512 * q, tt = o >> 6, j = o & 63;
                float a = f_b2[j];
#pragma unroll 4
                for (int e = 0; e < 64; ++e) a += h1[tt * 64 + e] * f_w2[e * 64 + j];
                h2[tt * 64 + j] = sin_red(f_freq[j] * a);
            }
            __syncthreads();
#pragma unroll 1
            for (int q = 0; q < 4; ++q) {
                const int n = tid + 512 * q;
                float a[16];
#pragma unroll
                for (int i = 0; i < 16; ++i) a[i] = 0.f;
#pragma unroll 2
                for (int j = 0; j < 64; ++j) {
                    const float w = f_w3[j * 2048 + n];
#pragma unroll
                    for (int i = 0; i < 16; ++i) a[i] += h2[i * 64 + j] * w;
                }
                const float dec = fabsf(f_decay[n]);
                const int order = n >> 10, dir = (n >> 9) & 1, c = n & 511;
                bf16_t* row = GR + (size_t)(order * 512 + c) * (2 * C0);
#pragma unroll
                for (int i = 0; i < 16; ++i) {
                    const int t = t0 + i;
                    const float val = a[i] * __expf(-((float)t * invLm1) * dec);
                    const unsigned short b = (unsigned short)(cvt_pk_bf16(val, 0.f) & 0xffffu);
                    if (dir == 0) row[C0 - t] = b; else if (t > 0) row[C0 + t] = b;
                }
            }
            __syncthreads();
        }
        for (int e = gtid; e < 2 * 1024 * 97; e += gthreads) {
            const int set = e / (1024 * 97), r = (e / 97) % 1024, i = e % 97; const int L = set ? LS : LP; const int C0 = set ? LGS : LGP;
            bf16_t* row = (bf16_t*)(ws + (set ? OFF_GR1 : OFF_GR0)) + (size_t)r * (2 * C0);
            const int idx = i < 49 ? i : C0 + L + (i - 49);
            row[idx] = 0;
        }
    }
#endif
}

__device__ __forceinline__ void rownorm_phase(const Params& p) {
    unsigned char* ws = launder(p.ws); const int gtid = blockIdx.x * 512 + tid_l(), gthreads = gridDim.x * 512;
    const float* sqq = (const float*)(ws + OFF_SQQP); const float* sqkv = (const float*)(ws + OFF_SQKVP);
    float* rq = (float*)(ws + OFF_RQ); float* rkv = (float*)(ws + OFF_RKV);
    for (int r = gtid; r < TPAD; r += gthreads) {
        const float a = (ldco(sqq + r * 4) + ldco(sqq + r * 4 + 1)) + (ldco(sqq + r * 4 + 2) + ldco(sqq + r * 4 + 3));
        const float b = (ldco(sqkv + r * 4) + ldco(sqkv + r * 4 + 1)) + (ldco(sqkv + r * 4 + 2) + ldco(sqkv + r * 4 + 3));
        rq[r] = rsqrtf(a * (1.f / 256.f) + EPS) * QSCALE; rkv[r] = rsqrtf(b * (1.f / 128.f) + EPS);
    }
}
__device__ __forceinline__ void krope_phase(const Params& p) {
    unsigned char* ws = launder(p.ws); unsigned char* ob = launder((unsigned char*)p.out);
    const int gtid = blockIdx.x * 512 + tid_l(), gthreads = gridDim.x * 512;
    const bf16_t* P = (const bf16_t*)(ws + OFF_P); bf16_t* KR = (bf16_t*)(ob + DO_KR); const float2* RT = (const float2*)(ws + OFF_RT);
    for (int e = gtid; e < TPAD * 8; e += gthreads) {
        const int row = e >> 3, ch = e & 7;
        int pos, seq; row_info(row, pos, seq);
        const u32x4 v = *(const u32x4*)(P + (size_t)row * NPP + 384 + ch * 8);
        f32x4 v0 = (f32x4){bflo(v.x), bfhi(v.x), bflo(v.y), bfhi(v.y)}, v1 = (f32x4){bflo(v.z), bfhi(v.z), bflo(v.w), bfhi(v.w)};
        rope8(v0, v1, RT + pos * 32 + ch * 4);
        *(u32x4*)(KR + (size_t)row * 64 + ch * 8) = pack8(v0, v1);
    }
}
__device__ __forceinline__ void hyprep_phase(const Params& p, LAS unsigned char* lds) {
    unsigned char* ws = launder(p.ws); const int tid = tid_l(), G = gridDim.x;
    const bf16_t* P = (const bf16_t*)(ws + OFF_P); const float* conv_w = p.in[9];
    constexpr int RSB = 1040;
    for (int u = blockIdx.x; u < 3096 + 3168; u += G) {
        int seq, j, which;
        if (u < 3096) { seq = u / 387; const int rem = u % 387; j = rem / 3; which = rem % 3; }
        else { const int v = u - 3096; seq = NBP + v / 99; const int rem = v % 99; j = rem / 3; which = rem % 3; }
        const int set = seq < NBP ? 0 : 1; const int L = set ? LS : LP; const int Lg = set ? LGS : LGP; const int NB = set ? NBS : NBP;
        const int b = set ? seq - NBP : seq; const int row0 = set ? TPR + b * LS : b * LP;
        const int posb = 64 * j - 49;
        for (int i = 0; i < 9; ++i) {
            const int id = tid + 512 * i; if (id >= 66 * 64) break;
            const int rr = id >> 6, ch = id & 63; const int pos = posb + rr;
            u32x4 v = (u32x4){0u, 0u, 0u, 0u};
            if (pos >= 0 && pos < L) v = *(const u32x4*)(P + (size_t)(row0 + pos) * NPP + 448 + which * 512 + ch * 8);
            *(LAS u32x4*)(lds + rr * RSB + ch * 16) = v;
        }
        __syncthreads();
        {
            const int c = tid; const float w0 = conv_w[which * 512 + c], w1 = conv_w[1536 + which * 512 + c], w2 = conv_w[3072 + which * 512 + c];
            bf16_t* XT = (bf16_t*)(ws + (which == 0 ? OFF_X1T : (which == 1 ? OFF_X2T : OFF_V0T))) + (set ? XT_SET1 : 0) + ((size_t)c * NB + b) * Lg + 64 * j;
            const LAS unsigned short* tl = (const LAS unsigned short*)lds + c;
            float prev = bf2f(tl[0]), cur = bf2f(tl[RSB / 2]);
            for (int o8 = 0; o8 < 8; ++o8) {
                float r[8];
#pragma unroll
                for (int k = 0; k < 8; ++k) {
                    const int o = o8 * 8 + k; const float nxt = bf2f(tl[(o + 2) * (RSB / 2)]);
                    const int pos = posb + 1 + o;
                    r[k] = (pos >= 0 && pos < L) ? (prev * w0 + cur * w1 + nxt * w2) : 0.f;
                    prev = cur; cur = nxt;
                }
                u32x4 w; w.x = cvt_pk_bf16(r[0], r[1]); w.y = cvt_pk_bf16(r[2], r[3]); w.z = cvt_pk_bf16(r[4], r[5]); w.w = cvt_pk_bf16(r[6], r[7]);
                *(u32x4*)(XT + o8 * 8) = w;
            }
        }
        __syncthreads();
    }
}

__device__ __forceinline__ f32x16 mfma32(bf16x8 a, bf16x8 b, f32x16 c) { return __builtin_amdgcn_mfma_f32_32x32x16_bf16(a, b, c, 0, 0, 0); }

__device__ __forceinline__ void attn_phase(const Params& p, LAS unsigned char* lds) {
    const int tid = tid_l(), lane = tid & 63, wave = tid >> 6, G = gridDim.x, h = lane >> 5, l32 = lane & 31;
    unsigned char* ob = launder((unsigned char*)p.out);
    bf16_t* Q = (bf16_t*)(ob + DO_Q);
    const bf16_t* KN = (const bf16_t*)(ob + DO_KN);
    const bf16_t* KR = (const bf16_t*)(ob + DO_KR);
    const bf16_t* VT = (const bf16_t*)(ob + DO_VT);
    constexpr int KROW = 400, VROW = 136, KBYTES = 64 * KROW, BUFB = KBYTES + 128 * VROW;
    for (int u = blockIdx.x; u < 2048; u += G) {
        int seq, head, qb;
        if (u < 1024) { seq = u >> 7; head = (u >> 5) & 3; qb = u & 31; } else { const int v = u - 1024; seq = NBP + (v >> 5); head = (v >> 3) & 3; qb = v & 7; }
        const int L = seq < NBP ? LP : LS; const int row0 = seq < NBP ? seq * LP : TPR + (seq - NBP) * LS;
        const int ntiles = (L + 63) >> 6;
        const int qrow = row0 + 16 + qb * 256 + wave * 32 + l32;
        bf16x8 qf[12];
#pragma unroll
        for (int ks = 0; ks < 12; ++ks) qf[ks] = *(const bf16x8*)(Q + (size_t)qrow * 768 + head * 192 + 16 * ks + 8 * h);
        {
            const float2* RT = (const float2*)(launder(p.ws) + OFF_RT);
            const int qpos = 16 + qb * 256 + wave * 32 + l32;
#pragma unroll
            for (int ks = 8; ks < 12; ++ks) {
                const u32x4 v = __builtin_bit_cast(u32x4, qf[ks]);
                f32x4 v0 = (f32x4){bflo(v.x), bfhi(v.x), bflo(v.y), bfhi(v.y)}, v1 = (f32x4){bflo(v.z), bfhi(v.z), bflo(v.w), bfhi(v.w)};
                rope8(v0, v1, RT + qpos * 32 + 8 * (ks - 8) + 4 * h);
                qf[ks] = __builtin_bit_cast(bf16x8, pack8(v0, v1));
            }
        }
        const int kkey0 = tid >> 4, kch0 = tid & 15;
        const int rkey = tid >> 3, rch = tid & 7;
        const int vdv0 = tid >> 3, vch = tid & 7;
        const unsigned kn_off = (unsigned)(kkey0 * 512 + head * 128 + kch0 * 8) * 2u;
        const unsigned kr_off = (unsigned)(rkey * 64 + rch * 8) * 2u;
        const unsigned vt_off = (unsigned)(vdv0 * TPAD + vch * 8) * 2u;
        const unsigned char* knb = (const unsigned char*)KN + (size_t)row0 * 1024;
        const unsigned char* krb = (const unsigned char*)KR + (size_t)row0 * 128;
        const unsigned char* vtb = (const unsigned char*)VT + ((size_t)head * 128 * TPAD + row0) * 2;
        u32x4 g0, g1, g2, g3, g4;
#define ATT_LOAD(tile) do { const unsigned char* kb__ = knb + (size_t)(tile) * 65536; const unsigned char* rb__ = krb + (size_t)(tile) * 8192; const unsigned char* vb__ = vtb + (size_t)(tile) * 128; \
        g0 = *(const u32x4*)(kb__ + kn_off); g1 = *(const u32x4*)(kb__ + 32768 + kn_off); \
        g2 = *(const u32x4*)(rb__ + kr_off); (void)vb__; } while (0)
#define ATT_LOADV(tile) do { const unsigned char* vb__ = vtb + (size_t)(tile) * 128; g3 = *(const u32x4*)(vb__ + vt_off); g4 = *(const u32x4*)(vb__ + (size_t)64 * TPAD * 2 + vt_off); } while (0)
#define ATT_STOREK(buf) do { LAS unsigned char* kb_ = lds + (buf) * BUFB; \
        *(LAS u32x4*)(kb_ + kkey0 * KROW + kch0 * 16) = g0; *(LAS u32x4*)(kb_ + (kkey0 + 32) * KROW + kch0 * 16) = g1; \
        *(LAS u32x4*)(kb_ + rkey * KROW + 256 + rch * 16) = g2; } while (0)
#define ATT_STORE(buf) do { LAS unsigned char* vb_ = lds + (buf) * BUFB + KBYTES; \
        *(LAS u32x2*)(vb_ + vdv0 * VROW + vch * 16) = (u32x2){g3.x, g3.y}; *(LAS u32x2*)(vb_ + vdv0 * VROW + vch * 16 + 8) = (u32x2){g3.z, g3.w}; \
        *(LAS u32x2*)(vb_ + (vdv0 + 64) * VROW + vch * 16) = (u32x2){g4.x, g4.y}; *(LAS u32x2*)(vb_ + (vdv0 + 64) * VROW + vch * 16 + 8) = (u32x2){g4.z, g4.w}; } while (0)
        ATT_LOAD(0); ATT_LOADV(0); ATT_STOREK(0); ATT_STORE(0);
        __syncthreads();
        f32x16 o[4];
#pragma unroll
        for (int d = 0; d < 4; ++d)
#pragma unroll
            for (int r = 0; r < 16; ++r) o[d][r] = 0.f;
        float m_run = -INFINITY, l_run = 0.f;
        for (int j = 0; j < ntiles; ++j) {
            const int buf = j & 1;
            if (j + 1 < ntiles) ATT_LOAD(j + 1);
            const LAS unsigned char* kb = lds + buf * BUFB;
            f32x16 s0, s1;
#pragma unroll
            for (int r = 0; r < 16; ++r) { s0[r] = 0.f; s1[r] = 0.f; }
#pragma unroll
            for (int ks = 0; ks < 12; ++ks) {
                const bf16x8 a0 = *(const LAS bf16x8*)(kb + l32 * KROW + ks * 32 + h * 16);
                const bf16x8 a1 = *(const LAS bf16x8*)(kb + (l32 + 32) * KROW + ks * 32 + h * 16);
                s0 = mfma32(a0, qf[ks], s0); s1 = mfma32(a1, qf[ks], s1);
                if ((ks % 3) == 2) __builtin_amdgcn_sched_barrier(0);
            }
            if (j + 1 < ntiles) ATT_STOREK(buf ^ 1);
            const int vc = L - j * 64;
            if (vc < 64) {
                const int vch = vc - 4 * h;
#pragma unroll
                for (int r = 0; r < 16; ++r) {
                    if ((r & 3) + 8 * (r >> 2) >= vch) s0[r] = -INFINITY;
                    if ((r & 3) + 8 * (r >> 2) + 32 >= vch) s1[r] = -INFINITY;
                }
            }
            float mx = fmaxf(s0[0], s1[0]);
#pragma unroll
            for (int r = 1; r < 16; ++r) mx = fmaxf(mx, fmaxf(s0[r], s1[r]));
            mx = fmaxf(mx, __shfl_xor(mx, 32));
            const float m_new = fmaxf(m_run, mx);
            const float alpha = __builtin_amdgcn_exp2f(m_run - m_new);
            m_run = m_new;
            float ls = 0.f;
#pragma unroll
            for (int r = 0; r < 16; ++r) { s0[r] = __builtin_amdgcn_exp2f(s0[r] - m_new); s1[r] = __builtin_amdgcn_exp2f(s1[r] - m_new); ls += s0[r] + s1[r]; }
            l_run = l_run * alpha + ls;
            if (__any(alpha != 1.0f)) {
#pragma unroll
                for (int d = 0; d < 4; ++d)
#pragma unroll
                    for (int r = 0; r < 16; ++r) o[d][r] *= alpha;
            }
            bf16x8 pb[4];
            {
                u32x4 w;
                w.x = cvt_pk_bf16(s0[0], s0[1]); w.y = cvt_pk_bf16(s0[2], s0[3]); w.z = cvt_pk_bf16(s0[4], s0[5]); w.w = cvt_pk_bf16(s0[6], s0[7]); pb[0] = __builtin_bit_cast(bf16x8, w);
                w.x = cvt_pk_bf16(s0[8], s0[9]); w.y = cvt_pk_bf16(s0[10], s0[11]); w.z = cvt_pk_bf16(s0[12], s0[13]); w.w = cvt_pk_bf16(s0[14], s0[15]); pb[1] = __builtin_bit_cast(bf16x8, w);
                w.x = cvt_pk_bf16(s1[0], s1[1]); w.y = cvt_pk_bf16(s1[2], s1[3]); w.z = cvt_pk_bf16(s1[4], s1[5]); w.w = cvt_pk_bf16(s1[6], s1[7]); pb[2] = __builtin_bit_cast(bf16x8, w);
                w.x = cvt_pk_bf16(s1[8], s1[9]); w.y = cvt_pk_bf16(s1[10], s1[11]); w.z = cvt_pk_bf16(s1[12], s1[13]); w.w = cvt_pk_bf16(s1[14], s1[15]); pb[3] = __builtin_bit_cast(bf16x8, w);
            }
            if (j + 1 < ntiles) ATT_LOADV(j + 1);
            const LAS unsigned char* vb = kb + KBYTES;
#pragma unroll
            for (int d = 0; d < 4; ++d)
#pragma unroll
                for (int ks = 0; ks < 4; ++ks) {
                    const LAS unsigned char* ap = vb + (d * 32 + l32) * VROW + (16 * ks + 4 * h) * 2;
                    const u32x2 lo = *(const LAS u32x2*)ap, hi = *(const LAS u32x2*)(ap + 16);
                    const u32x4 w = (u32x4){lo.x, lo.y, hi.x, hi.y};
                    o[d] = mfma32(__builtin_bit_cast(bf16x8, w), pb[ks], o[d]);
                    if (ks == 3) __builtin_amdgcn_sched_barrier(0);
                }
            if (j + 1 < ntiles) ATT_STORE(buf ^ 1);
            __syncthreads();
        }
        l_run += __shfl_xor(l_run, 32);
        const float inv = 1.0f / l_run;
#if DEBUG_CHECK == 5
        bf16_t* orow = (bf16_t*)(launder(p.ws) + OFF_ODBG) + (size_t)qrow * 512 + head * 128;
#else
        bf16_t* orow = Q + (size_t)qrow * 768 + head * 192;
#endif
#pragma unroll
        for (int d = 0; d < 4; ++d)
#pragma unroll
            for (int rq = 0; rq < 4; ++rq) {
                const u32x2 w = (u32x2){cvt_pk_bf16(o[d][4 * rq] * inv, o[d][4 * rq + 1] * inv), cvt_pk_bf16(o[d][4 * rq + 2] * inv, o[d][4 * rq + 3] * inv)};
                *(u32x2*)(orow + 32 * d + 8 * rq + 4 * h) = w;
            }
#undef ATT_LOAD
#undef ATT_LOADV
#undef ATT_STORE
#undef ATT_STOREK
    }
}

template <int SET> __device__ __forceinline__ void hyena_unit(const Params& p, LAS unsigned char* lds, int c, int bg) {
    constexpr int P = SET ? 32 : 128;
    constexpr int NBU = SET ? 16 : 4;
    constexpr int NBT = SET ? 8 : 2;
    constexpr int GP = SET ? 4 : 16;
    constexpr int LG = SET ? LGS : LGP;
    constexpr int NB = SET ? NBS : NBP;
    constexpr int RS = SET ? 4896 : 18816;
    constexpr int GBYTES = 2 * LG * 2;
    constexpr int G1OFF = 33220;
    constexpr int ZOFF = 66560;
    unsigned char* ws = launder(p.ws);
    const int tid = tid_l(), lane = tid & 63, wave = tid >> 6, h = lane >> 5, l32 = lane & 31;
    const bf16_t* X1T = (const bf16_t*)(ws + OFF_X1T) + (SET ? XT_SET1 : 0);
    bf16_t* X2T = (bf16_t*)(ws + OFF_X2T) + (SET ? XT_SET1 : 0);
    const bf16_t* V0T = (const bf16_t*)(ws + OFF_V0T) + (SET ? XT_SET1 : 0);
    const bf16_t* GR = (const bf16_t*)(ws + (SET ? OFF_GR1 : OFF_GR0));
    const float* hy_bias = launder(p.in[17]);
    LAS unsigned char* gL = lds; LAS unsigned char* zL = lds + ZOFF;
    const size_t rowbase = ((size_t)c * NB + bg * NBU) * LG;
    for (int id = tid; id < NBU * (P + 1) * 8; id += 512) {
        const int bl = id / ((P + 1) * 8), rem = id % ((P + 1) * 8), blk = rem >> 3, ch = rem & 7;
        *(LAS u32x4*)(zL + bl * RS + blk * 144 + ch * 16) = *(const u32x4*)(V0T + rowbase + (size_t)bl * LG + blk * 64 + ch * 8);
    }
    for (int id = tid; id < NBU * 9; id += 512) { const int bl = id / 9, ch = id % 9; *(LAS u32x4*)(zL + bl * RS + (P + 1) * 144 + ch * 16) = (u32x4){0u, 0u, 0u, 0u}; }
#define HY_LOADG(rowidx) do { const unsigned* g32_ = (const unsigned*)(GR + (size_t)(rowidx) * (2 * LG)); \
        for (int id = tid; id < GBYTES / 4; id += 512) { const unsigned a_ = g32_[id], b_ = (id + 1 < GBYTES / 4) ? g32_[id + 1] : 0u; \
            *(LAS unsigned*)(gL + id * 4) = a_; *(LAS unsigned*)(gL + G1OFF + id * 4) = (a_ >> 16) | (b_ << 16); } } while (0)
    HY_LOADG(c);
    __syncthreads();
    const LAS unsigned short* g16 = (const LAS unsigned short*)gL;
    constexpr int PARTS = 512 / (NBU * 16);
    float zmeta = 0.f; int mo_bl, mo_m;
    {
        const int part = tid % PARTS, out = tid / PARTS; mo_bl = out >> 4; mo_m = out & 15;
        const LAS unsigned char* zr = zL + mo_bl * RS;
        float a = 0.f;
        for (int tt = 48 + part; tt < LG; tt += PARTS) {
            const float zv = bf2f(*(const LAS unsigned short*)(zr + (tt >> 6) * 144 + (tt & 63) * 2));
            const float gv = bf2f(g16[LG - mo_m - 48 + tt]);
            a += zv * gv;
        }
#pragma unroll
        for (int o = 1; o < PARTS; o <<= 1) a += __shfl_xor(a, o);
        const float bias0 = hy_bias[c];
        const float z0 = bf2f(*(const LAS unsigned short*)(zr + (48 + mo_m) * 2));
        const float x1 = bf2f(X1T[rowbase + (size_t)mo_bl * LG + 48 + mo_m]);
        zmeta = x1 * (a + z0 * bias0);
    }
    const int p0 = GP * wave;
    const int pp = l32 / NBT, blA = l32 % NBT, blB = NBT + blA;
#pragma unroll 1
    for (int order = 0; order < 2; ++order) {
        f32x16 acc[2][2];
#pragma unroll
        for (int a = 0; a < 2; ++a)
#pragma unroll
            for (int b = 0; b < 2; ++b)
#pragma unroll
                for (int r = 0; r < 16; ++r) acc[a][b][r] = 0.f;
        bf16x8 Ep4, Ep5;
        {
            const int d0 = p0 - (P - 1); const int ib0 = LG - 64 * d0 - l32 + 8 * h;
            const LAS unsigned char* g0 = gL + (l32 & 1) * G1OFF + (ib0 >> 1) * 4;
            const LAS unsigned* ga = (const LAS unsigned*)(g0 + 96); const LAS unsigned* gb = (const LAS unsigned*)(g0 + 64);
            Ep4 = __builtin_bit_cast(bf16x8, (u32x4){ga[0], ga[1], ga[2], ga[3]}); Ep5 = __builtin_bit_cast(bf16x8, (u32x4){gb[0], gb[1], gb[2], gb[3]});
        }
#pragma unroll 1
        for (int d = p0 - (P - 1); d <= p0 + GP; ++d) {
            bf16x8 E[6];
            const int ib = LG - 64 * d - l32 + 8 * h;
            const LAS unsigned char* gpl = gL + (l32 & 1) * G1OFF + (ib >> 1) * 4;
            E[0] = Ep4; E[1] = Ep5;
#pragma unroll
            for (int e = 2; e < 6; ++e) {
                const LAS unsigned* gp = (const LAS unsigned*)(gpl - 32 * (e - 3));
                const u32x4 w = (u32x4){gp[0], gp[1], gp[2], gp[3]};
                E[e] = __builtin_bit_cast(bf16x8, w);
            }
            Ep4 = E[4]; Ep5 = E[5];
            const int q = p0 + pp - d;
            const int slot = ((unsigned)(q + 1) <= (unsigned)P) ? q + 1 : P + 1;
            const LAS unsigned char* zA = zL + blA * RS + slot * 144 + h * 16;
            const LAS unsigned char* zB = zL + blB * RS + slot * 144 + h * 16;
#pragma unroll
            for (int ks = 0; ks < 4; ++ks) {
                const bf16x8 ba = *(const LAS bf16x8*)(zA + ks * 32);
                const bf16x8 bb = *(const LAS bf16x8*)(zB + ks * 32);
#pragma unroll
                for (int m = 0; m < 2; ++m) {
                    acc[0][m] = mfma32(E[2 * m - ks + 3], ba, acc[0][m]);
                    acc[1][m] = mfma32(E[2 * m - ks + 3], bb, acc[1][m]);
                }
            }
        }
        __syncthreads();
        const float bias = hy_bias[order * 512 + c];
#pragma unroll
        for (int tl = 0; tl < 2; ++tl) {
            const int bl = tl ? blB : blA;
            const size_t grow = rowbase + (size_t)bl * LG + 64 * (p0 + pp + 1);
            LAS unsigned char* zr = zL + bl * RS + (p0 + pp + 1) * 144;
#pragma unroll
            for (int m = 0; m < 2; ++m)
#pragma unroll
                for (int rq = 0; rq < 4; ++rq) {
                    const int off = 32 * m + 8 * rq + 4 * h;
                    const u32x2 zw = *(const LAS u32x2*)(zr + off * 2);
                    const u32x2 xw = *(const u32x2*)((order ? (const bf16_t*)X2T : X1T) + grow + off);
                    const float y0 = acc[tl][m][4 * rq], y1 = acc[tl][m][4 * rq + 1], y2 = acc[tl][m][4 * rq + 2], y3 = acc[tl][m][4 * rq + 3];
                    const float r0 = bflo(xw.x) * (y0 + bflo(zw.x) * bias), r1 = bfhi(xw.x) * (y1 + bfhi(zw.x) * bias);
                    const float r2 = bflo(xw.y) * (y2 + bflo(zw.y) * bias), r3 = bfhi(xw.y) * (y3 + bfhi(zw.y) * bias);
                    const u32x2 w = (u32x2){cvt_pk_bf16(r0, r1), cvt_pk_bf16(r2, r3)};
#if DEBUG_CHECK == 5
                    if (order == 0) *(LAS u32x2*)(zr + off * 2) = w; else *(u32x2*)((bf16_t*)(ws + OFF_HDBG) + (SET ? XT_SET1 : 0) + grow + off) = w;
#else
                    if (order == 0) *(LAS u32x2*)(zr + off * 2) = w; else *(u32x2*)(X2T + grow + off) = w;
#endif
                }
        }
        if (order == 0) {
            if ((tid % PARTS) == 0) *(LAS unsigned short*)(zL + mo_bl * RS + (48 + mo_m) * 2) = (unsigned short)(cvt_pk_bf16(zmeta, 0.f) & 0xffffu);
            HY_LOADG(512 + c);
        }
        __syncthreads();
    }
}
#undef HY_LOADG
__device__ __forceinline__ void hyena_phase(const Params& p, LAS unsigned char* lds) {
    for (int u = blockIdx.x; u < 2048; u += gridDim.x) {
        if (u < 1024) hyena_unit<0>(p, lds, u >> 1, u & 1); else hyena_unit<1>(p, lds, (u - 1024) >> 1, u & 1);
    }
}

__device__ __forceinline__ void mixnorm_phase(const Params& p, LAS unsigned char* lds) {
    unsigned char* ws = launder(p.ws); const int tid = tid_l(), lane = tid & 63, wave = tid >> 6, G = gridDim.x;
    const bf16_t* Q = (const bf16_t*)(launder((unsigned char*)p.out) + DO_Q);
    bf16_t* MIXN = (bf16_t*)(ws + OFF_MIXN);
    const float* ga = launder(p.in[18]); const float* gh = launder(p.in[19]);
    constexpr int RSB = 1040;
    for (int u = blockIdx.x; u < 2048; u += G) {
        const int n0 = u * 64;
        int set, b, tok0;
        if (n0 < 65536) { set = 0; b = n0 >> 13; tok0 = n0 & 8191; } else { set = 1; const int q = n0 - 65536; b = q >> 11; tok0 = q & 2047; }
        const int Lg = set ? LGS : LGP, NB = set ? NBS : NBP;
        {
            const int c = tid;
#if DEBUG_CHECK == 5
            const bf16_t* src = (const bf16_t*)(ws + OFF_HDBG) + (set ? XT_SET1 : 0) + ((size_t)c * NB + b) * Lg + tok0 + 64;
#else
            const bf16_t* src = (const bf16_t*)(ws + OFF_X2T) + (set ? XT_SET1 : 0) + ((size_t)c * NB + b) * Lg + tok0 + 64;
#endif
            LAS unsigned short* tl = (LAS unsigned short*)lds + c;
#pragma unroll
            for (int k8 = 0; k8 < 8; ++k8) {
                const u32x4 v = *(const u32x4*)(src + k8 * 8);
                tl[(k8 * 8 + 0) * (RSB / 2)] = (unsigned short)(v.x & 0xffffu); tl[(k8 * 8 + 1) * (RSB / 2)] = (unsigned short)(v.x >> 16);
                tl[(k8 * 8 + 2) * (RSB / 2)] = (unsigned short)(v.y & 0xffffu); tl[(k8 * 8 + 3) * (RSB / 2)] = (unsigned short)(v.y >> 16);
                tl[(k8 * 8 + 4) * (RSB / 2)] = (unsigned short)(v.z & 0xffffu); tl[(k8 * 8 + 5) * (RSB / 2)] = (unsigned short)(v.z >> 16);
                tl[(k8 * 8 + 6) * (RSB / 2)] = (unsigned short)(v.w & 0xffffu); tl[(k8 * 8 + 7) * (RSB / 2)] = (unsigned short)(v.w >> 16);
            }
        }
        __syncthreads();
        for (int i = 0; i < 8; ++i) {
            const int rr = wave + 8 * i; const int n = n0 + rr; const int r = full_row(n);
            const u32x4 hv = *(const LAS u32x4*)(lds + rr * RSB + lane * 16);
#if DEBUG_CHECK == 5
            const u32x4 av = *(const u32x4*)((const bf16_t*)(ws + OFF_ODBG) + (size_t)r * 512 + lane * 8);
#else
            const u32x4 av = *(const u32x4*)(Q + (size_t)r * 768 + (lane >> 4) * 192 + (lane & 15) * 8);
#endif
            float hf[8] = {bflo(hv.x), bfhi(hv.x), bflo(hv.y), bfhi(hv.y), bflo(hv.z), bfhi(hv.z), bflo(hv.w), bfhi(hv.w)};
            float af[8] = {bflo(av.x), bfhi(av.x), bflo(av.y), bfhi(av.y), bflo(av.z), bfhi(av.z), bflo(av.w), bfhi(av.w)};
            float sh = 0.f, sa = 0.f;
#pragma unroll
            for (int k = 0; k < 8; ++k) { sh += hf[k] * hf[k]; sa += af[k] * af[k]; }
            sh = wave_sum(sh); sa = wave_sum(sa);
            const float rh = rsqrtf(sh * (1.f / 512.f) + EPS), ra = rsqrtf(sa * (1.f / 512.f) + EPS);
            const f32x4 ga0 = *(const f32x4*)(ga + lane * 8), ga1 = *(const f32x4*)(ga + lane * 8 + 4);
            const f32x4 gh0 = *(const f32x4*)(gh + lane * 8), gh1 = *(const f32x4*)(gh + lane * 8 + 4);
            u32x4 wa, wh;
            wa.x = cvt_pk_bf16(af[0] * ra * ga0[0], af[1] * ra * ga0[1]); wa.y = cvt_pk_bf16(af[2] * ra * ga0[2], af[3] * ra * ga0[3]);
            wa.z = cvt_pk_bf16(af[4] * ra * ga1[0], af[5] * ra * ga1[1]); wa.w = cvt_pk_bf16(af[6] * ra * ga1[2], af[7] * ra * ga1[3]);
            wh.x = cvt_pk_bf16(hf[0] * rh * gh0[0], hf[1] * rh * gh0[1]); wh.y = cvt_pk_bf16(hf[2] * rh * gh0[2], hf[3] * rh * gh0[3]);
            wh.z = cvt_pk_bf16(hf[4] * rh * gh1[0], hf[5] * rh * gh1[1]); wh.w = cvt_pk_bf16(hf[6] * rh * gh1[2], hf[7] * rh * gh1[3]);
#if EXPT == 1
            wa = (u32x4){0u, 0u, 0u, 0u};
#endif
#if EXPT == 2
            wh = (u32x4){0u, 0u, 0u, 0u};
#endif
            *(u32x4*)(MIXN + (size_t)n * 1024 + lane * 8) = wa;
            *(u32x4*)(MIXN + (size_t)n * 1024 + 512 + lane * 8) = wh;
        }
        __syncthreads();
    }
}

__device__ __forceinline__ void h1_phase(const Params& p) {
    unsigned char* ws = launder(p.ws); const int tid = tid_l(), lane = tid & 63, wave = tid >> 6;
    const int gw = blockIdx.x * 8 + wave, NGW = gridDim.x * 8;
    const bf16_t* MIX = (const bf16_t*)(ws + OFF_MIX); bf16_t* H1B = (bf16_t*)(ws + OFF_H1B);
    const float* sqmix = (const float*)(ws + OFF_SQMIXP); float* r1 = (float*)(ws + OFF_R1); const float* g = p.in[21];
    for (int n = gw; n < TN; n += NGW) {
        const float* xrow = n < 65536 ? p.in[0] + (size_t)n * 1024 : p.in[1] + (size_t)(n - 65536) * 1024;
        const float rm = rsqrtf(wave_sum(lane < 16 ? ldco(sqmix + (size_t)n * 16 + lane) : 0.f) * (1.f / 1024.f) + EPS);
        float ss = 0.f;
#pragma unroll
        for (int hh = 0; hh < 2; ++hh) {
            const int c0 = hh * 512 + lane * 8;
            const u32x4 mv = *(const u32x4*)(MIX + (size_t)n * 1024 + c0);
            const f32x4 x0 = *(const f32x4*)(xrow + c0), x1 = *(const f32x4*)(xrow + c0 + 4);
            const f32x4 g0 = *(const f32x4*)(g + c0), g1 = *(const f32x4*)(g + c0 + 4);
            f32x4 h0, h1;
            h0[0] = x0[0] + bflo(mv.x) * rm * g0[0]; h0[1] = x0[1] + bfhi(mv.x) * rm * g0[1]; h0[2] = x0[2] + bflo(mv.y) * rm * g0[2]; h0[3] = x0[3] + bfhi(mv.y) * rm * g0[3];
            h1[0] = x1[0] + bflo(mv.z) * rm * g1[0]; h1[1] = x1[1] + bfhi(mv.z) * rm * g1[1]; h1[2] = x1[2] + bflo(mv.w) * rm * g1[2]; h1[3] = x1[3] + bfhi(mv.w) * rm * g1[3];
            ss += sq8(h0, h1);
            *(f32x4*)(p.out + (size_t)n * 1024 + c0) = h0; *(f32x4*)(p.out + (size_t)n * 1024 + c0 + 4) = h1;
            *(u32x4*)(H1B + (size_t)n * 1024 + c0) = pack8(h0, h1);
        }
        ss = wave_sum(ss);
        if (lane == 0) r1[n] = rsqrtf(ss * (1.f / 1024.f) + EPS);
    }
}
__device__ __forceinline__ void final_phase(const Params& p, int half) {
    unsigned char* ws = launder(p.ws); const int tid = tid_l(), lane = tid & 63, wave = tid >> 6;
    const int gw = blockIdx.x * 8 + wave, NGW = gridDim.x * 8;
    const bf16_t* M2 = (const bf16_t*)(ws + OFF_M2); const float* sqm2 = (const float*)(ws + OFF_SQM2P); const float* g = p.in[25];
    float dbg_off = 0.f, dbg_one = 0.f;
#if DEBUG_CHECK
    { const unsigned* dc = (const unsigned*)(ws + OFF_DBGW); dbg_off = 100.f * (float)dc[8] * (1.f / 131072.f); dbg_one = 1000.f * (float)dc[9] * (1.f / 131072.f); }
#endif
    for (int i = gw; i < 65536; i += NGW) {
        const int n = half * 65536 + i;
        const float rm = rsqrtf(wave_sum(lane < 16 ? ldco(sqm2 + (size_t)n * 16 + lane) : 0.f) * (1.f / 1024.f) + EPS);
#pragma unroll
        for (int hh = 0; hh < 2; ++hh) {
            const int c0 = hh * 512 + lane * 8;
            const u32x4 mv = *(const u32x4*)(M2 + (size_t)i * 1024 + c0);
            f32x4 h0 = *(const f32x4*)(p.out + (size_t)n * 1024 + c0), h1 = *(const f32x4*)(p.out + (size_t)n * 1024 + c0 + 4);
            const f32x4 g0 = *(const f32x4*)(g + c0), g1 = *(const f32x4*)(g + c0 + 4);
            h0 += dbg_off; h1 += dbg_off; if (n == 0 && c0 == 0) h0[0] += dbg_one;
            h0[0] += bflo(mv.x) * rm * g0[0]; h0[1] += bfhi(mv.x) * rm * g0[1]; h0[2] += bflo(mv.y) * rm * g0[2]; h0[3] += bfhi(mv.y) * rm * g0[3];
            h1[0] += bflo(mv.z) * rm * g1[0]; h1[1] += bfhi(mv.z) * rm * g1[1]; h1[2] += bflo(mv.w) * rm * g1[2]; h1[3] += bfhi(mv.w) * rm * g1[3];
            *(f32x4*)(p.out + (size_t)n * 1024 + c0) = h0; *(f32x4*)(p.out + (size_t)n * 1024 + c0 + 4) = h1;
        }
    }
}


#if DEBUG_CHECK
constexpr size_t OFF_DBG = OFF_DBGW;
__device__ __forceinline__ void check_gemm(const bf16_t* A, int lda, const bf16_t* Bt, int ldb, int K, int M, int N, int mode, const bf16_t* O, int ldc, const float* rs, unsigned* cnt, int col_lo) {
    const unsigned idx = blockIdx.x * 512u + (unsigned)tid_l();
    unsigned hsh = idx * 2654435761u + 12345u + (unsigned)mode * 977u; hsh ^= hsh >> 15; hsh *= 2246822519u; hsh ^= hsh >> 13;
    const int row = (int)(hsh % (unsigned)M); hsh = hsh * 3266489917u + 668265263u; hsh ^= hsh >> 16;
    const int col = col_lo + (int)(hsh % (unsigned)(N - col_lo));
    float d = 0.f;
    for (int k = 0; k < K; ++k) d += bf2f(A[(size_t)row * lda + k]) * bf2f(Bt[(size_t)col * ldb + k]);
    float e = d;
    if (mode == 0 || mode == 7) e = d * rs[row];
    if (mode == 5) { const float t = fmaxf(d * rs[row], 0.f); e = t * t; }
    const float st = bf2f(O[(size_t)row * ldc + col]);
    if (!(fabsf(st - e) <= 0.03f * fabsf(e) + 0.03f)) atomicAdd(cnt, 1u);
}
#endif

#if DEBUG_CHECK == 2
__device__ __forceinline__ void check_proj(const Params& p) {
    unsigned char* ws = launder(p.ws); unsigned char* ob = launder((unsigned char*)p.out);
    const bf16_t* P = (const bf16_t*)(ws + OFF_P); unsigned* cnt = (unsigned*)(ws + OFF_DBG);
    const unsigned idx = blockIdx.x * 512u + (unsigned)tid_l();
    unsigned hsh = idx * 2654435761u + 777u; hsh ^= hsh >> 15; hsh *= 2246822519u; hsh ^= hsh >> 13;
    const int row = (int)(hsh % (unsigned)T); hsh = hsh * 3266489917u + 668265263u; hsh ^= hsh >> 16;
    int pos, seq; row_info(row, pos, seq);
    {
        const int n = (int)(hsh % 768u); const int hh = n / 192, w = n % 192;
        float ss = 0.f, x1 = 0.f, x2 = 0.f; const float* W = p.in[6]; const float* g = p.in[5];
        const int j = w - 128, i = j >> 1;
        const int c1 = w < 128 ? hh * 192 + w : hh * 192 + 128 + i, c2 = hh * 192 + 160 + (w < 128 ? 0 : i);
        for (int k = 0; k < 256; ++k) { const float a = bf2f(P[(size_t)row * NPP + k]); ss += a * a; x1 += a * g[k] * W[k * 768 + c1]; x2 += a * g[k] * W[k * 768 + c2]; }
        const float rq = rsqrtf(ss * (1.f / 256.f) + EPS) * QSCALE; x1 *= rq; x2 *= rq;
        float e = x1;
        if (w >= 128) { const float inv = 1.0f / exp2f((float)i * (13.287712379549449f / 32.f)); float sn, cs; sincos_red((float)pos * inv, sn, cs); e = (j & 1) ? x2 * cs + x1 * sn : x1 * cs - x2 * sn; }
        const float st = bf2f(((const bf16_t*)(ob + DO_Q))[(size_t)row * 768 + n]);
        if (!(fabsf(st - e) <= 0.03f * fabsf(e) + 0.01f)) atomicAdd(cnt + (w < 128 ? 0 : 4), 1u);
    }
    {
        const int n = (int)((hsh >> 3) % 512u); const int hh = n >> 7, i = n & 127;
        float ss = 0.f, x1 = 0.f, x2 = 0.f; const float* W = p.in[8]; const float* g = p.in[7];
        for (int k = 0; k < 128; ++k) { const float a = bf2f(P[(size_t)row * NPP + 256 + k]); ss += a * a; x1 += a * g[k] * W[k * 1024 + hh * 256 + i]; x2 += a * g[k] * W[k * 1024 + hh * 256 + 128 + i]; }
        const float rk = rsqrtf(ss * (1.f / 128.f) + EPS); x1 *= rk; x2 *= rk;
        const float s1 = bf2f(((const bf16_t*)(ob + DO_KN))[(size_t)row * 512 + n]);
        const float s2 = bf2f(((const bf16_t*)(ob + DO_VT))[(size_t)n * TPAD + row]);
        if (!(fabsf(s1 - x1) <= 0.03f * fabsf(x1) + 0.03f)) atomicAdd(cnt + 1, 1u);
        if (!(fabsf(s2 - x2) <= 0.03f * fabsf(x2) + 0.03f)) atomicAdd(cnt + 2, 1u);
    }
    {
        const int jj = (int)((hsh >> 5) % 64u); const int i = jj >> 1;
        const float* xr = pos < 16 ? p.in[2] + (size_t)pos * 1024 : (seq < NBP ? p.in[0] + ((size_t)seq * 8192 + (pos - 16)) * 1024 : p.in[1] + ((size_t)(seq - NBP) * 2048 + (pos - 16)) * 1024);
        const float* W = p.in[4]; const float* g = p.in[3]; float x1 = 0.f, x2 = 0.f;
        for (int k = 0; k < 1024; ++k) { const float a = xr[k] * g[k]; x1 += a * W[(size_t)k * 1984 + 384 + i]; x2 += a * W[(size_t)k * 1984 + 416 + i]; }
        const float r0 = ((const float*)(ws + OFF_R0))[row]; x1 *= r0; x2 *= r0;
        const float inv = 1.0f / exp2f((float)i * (13.287712379549449f / 32.f)); float sn, cs; sincos_red((float)pos * inv, sn, cs);
        const float e = (jj & 1) ? x2 * cs + x1 * sn : x1 * cs - x2 * sn;
        const float st = bf2f(((const bf16_t*)(ob + DO_KR))[(size_t)row * 64 + jj]);
        if (!(fabsf(st - e) <= 0.03f * fabsf(e) + 0.03f)) { atomicAdd(cnt + 3, 1u); atomicAdd(cnt + 5, (unsigned)i); atomicAdd(cnt + 6, (unsigned)(pos >> 3)); }
    }
}
#endif

#if DEBUG_CHECK == 3
__device__ __forceinline__ void check_h0b(const Params& p, int slot) {
    unsigned char* ws = launder(p.ws); unsigned* cnt = (unsigned*)(ws + OFF_DBGW);
    const bf16_t* h0b = (const bf16_t*)(ws + OFF_H0B);
    const unsigned idx = blockIdx.x * 512u + (unsigned)tid_l();
    unsigned hsh = idx * 2654435761u + 4242u + (unsigned)slot * 31u; hsh ^= hsh >> 15; hsh *= 2246822519u; hsh ^= hsh >> 13;
    const int row = (int)(hsh % (unsigned)T); hsh = hsh * 3266489917u + 668265263u; hsh ^= hsh >> 16;
    const int col = (int)(hsh % 1024u);
    int pos, seq; row_info(row, pos, seq);
    const float* xr = pos < 16 ? p.in[2] + (size_t)pos * 1024 : (seq < NBP ? p.in[0] + ((size_t)seq * 8192 + (pos - 16)) * 1024 : p.in[1] + ((size_t)(seq - NBP) * 2048 + (pos - 16)) * 1024);
    const float e = xr[col]; const float st = bf2f(h0b[(size_t)row * 1024 + col]);
    if (!(fabsf(st - e) <= 0.01f * fabsf(e) + 0.001f)) atomicAdd(cnt + slot, 1u);
}
#endif

#if DEBUG_CHECK == 4
__device__ __forceinline__ void check_stale(const Params& p, const unsigned* base, unsigned ndw, int slot) {
    unsigned* cnt = (unsigned*)(launder(p.ws) + OFF_DBGW);
    const unsigned idx = blockIdx.x * 512u + (unsigned)tid_l();
    unsigned hsh = idx * 2654435761u + 999u + (unsigned)slot * 131u; hsh ^= hsh >> 15; hsh *= 2246822519u; hsh ^= hsh >> 13;
#pragma unroll 1
    for (int it = 0; it < 16; ++it) {
        hsh = hsh * 3266489917u + 668265263u; hsh ^= hsh >> 16;
        const unsigned i = hsh % ndw;
        const unsigned a = base[i];
        const unsigned b = __hip_atomic_load(base + i, __ATOMIC_RELAXED, __HIP_MEMORY_SCOPE_AGENT);
        if (a != b) atomicAdd(cnt + slot, 1u);
    }
}
#endif

#if DEBUG_CHECK == 5
__device__ __forceinline__ void check_attn(const Params& p) {
    unsigned char* ws = launder(p.ws); unsigned char* ob = launder((unsigned char*)p.out); unsigned* cnt = (unsigned*)(ws + OFF_DBGW);
    const int tid = tid_l(), lane = tid & 63, wave = tid >> 6;
    const bf16_t* Q = (const bf16_t*)(ob + DO_Q); const bf16_t* KN = (const bf16_t*)(ob + DO_KN); const bf16_t* KR = (const bf16_t*)(ob + DO_KR); const bf16_t* VT = (const bf16_t*)(ob + DO_VT);
    const bf16_t* OD = (const bf16_t*)(ws + OFF_ODBG); const float2* RT = (const float2*)(ws + OFF_RT);
    unsigned hsh = (unsigned)(blockIdx.x * 8 + wave) * 2654435761u + 31337u; hsh ^= hsh >> 15; hsh *= 2246822519u; hsh ^= hsh >> 13;
    const int n = (int)(hsh % (unsigned)TN); const int head = (int)((hsh >> 20) & 3u); const int r = full_row(n);
    int pos, seq; row_info(r, pos, seq);
    const int L = seq < NBP ? LP : LS; const int row0 = r - pos;
    const bf16_t* qp = Q + (size_t)r * 768 + head * 192;
    float mx = -INFINITY;
    for (int k = lane; k < L; k += 64) {
        float sdot = 0.f;
        for (int d = 0; d < 128; ++d) sdot += bf2f(qp[d]) * bf2f(KN[(size_t)(row0 + k) * 512 + head * 128 + d]);
        for (int i = 0; i < 32; ++i) { const float2 cs = ldco2(RT + pos * 32 + i); const float a = bf2f(qp[128 + 2 * i]), b = bf2f(qp[129 + 2 * i]);
            sdot += (a * cs.x - b * cs.y) * bf2f(KR[(size_t)(row0 + k) * 64 + 2 * i]) + (b * cs.x + a * cs.y) * bf2f(KR[(size_t)(row0 + k) * 64 + 2 * i + 1]); }
        mx = fmaxf(mx, sdot);
    }
#pragma unroll
    for (int o = 1; o < 64; o <<= 1) mx = fmaxf(mx, __shfl_xor(mx, o));
    float sw = 0.f, o0 = 0.f, o1 = 0.f; const int dv0 = (int)((hsh >> 8) & 127u), dv1 = (dv0 + 37) & 127;
    for (int k = lane; k < L; k += 64) {
        float sdot = 0.f;
        for (int d = 0; d < 128; ++d) sdot += bf2f(qp[d]) * bf2f(KN[(size_t)(row0 + k) * 512 + head * 128 + d]);
        for (int i = 0; i < 32; ++i) { const float2 cs = ldco2(RT + pos * 32 + i); const float a = bf2f(qp[128 + 2 * i]), b = bf2f(qp[129 + 2 * i]);
            sdot += (a * cs.x - b * cs.y) * bf2f(KR[(size_t)(row0 + k) * 64 + 2 * i]) + (b * cs.x + a * cs.y) * bf2f(KR[(size_t)(row0 + k) * 64 + 2 * i + 1]); }
        const float w = exp2f(sdot - mx); sw += w;
        o0 += w * bf2f(VT[(size_t)(head * 128 + dv0) * TPAD + row0 + k]); o1 += w * bf2f(VT[(size_t)(head * 128 + dv1) * TPAD + row0 + k]);
    }
    sw = wave_sum(sw); o0 = wave_sum(o0) / sw; o1 = wave_sum(o1) / sw;
    if (lane == 0) {
        const float s0 = bf2f(OD[(size_t)r * 512 + head * 128 + dv0]), s1 = bf2f(OD[(size_t)r * 512 + head * 128 + dv1]);
        atomicAdd(cnt + 10, 2u);
        if (!(fabsf(s0 - o0) <= 0.05f * fabsf(o0) + 0.002f)) atomicAdd(cnt + 8, 1u);
        if (!(fabsf(s1 - o1) <= 0.05f * fabsf(o1) + 0.002f)) atomicAdd(cnt + 8, 1u);
    }
}
__device__ __forceinline__ void check_hyena(const Params& p, LAS unsigned char* lds) {
    unsigned char* ws = launder(p.ws); unsigned* cnt = (unsigned*)(ws + OFF_DBGW);
    const int tid = tid_l();
    unsigned hsh = (unsigned)blockIdx.x * 2654435761u + 555u; hsh ^= hsh >> 15; hsh *= 2246822519u; hsh ^= hsh >> 13;
    const int set = (int)(blockIdx.x & 1u); const int c = (int)(hsh % 512u); const int NB = set ? NBS : NBP; const int b = (int)((hsh >> 12) % (unsigned)NB);
    const int LG = set ? LGS : LGP;
    const size_t base = (set ? XT_SET1 : 0) + ((size_t)c * NB + b) * LG;
    const bf16_t* X1 = (const bf16_t*)(ws + OFF_X1T) + base; const bf16_t* X2 = (const bf16_t*)(ws + OFF_X2T) + base; const bf16_t* V0 = (const bf16_t*)(ws + OFF_V0T) + base;
    const bf16_t* HD = (const bf16_t*)(ws + OFF_HDBG) + base;
    const bf16_t* G0 = (const bf16_t*)(ws + (set ? OFF_GR1 : OFF_GR0)) + (size_t)c * (2 * LG); const bf16_t* G1 = G0 + (size_t)512 * (2 * LG);
    const float bias0 = p.in[17][c], bias1 = p.in[17][512 + c];
    LAS float* z1 = (LAS float*)lds;
    for (int t = tid; t < LG; t += 512) {
        float y = 0.f;
        for (int s2 = 48; s2 < LG; ++s2) y += bf2f(G0[LG - (t - s2)]) * bf2f(V0[s2]);
        const float v = bf2f(X1[t]) * (y + bf2f(V0[t]) * bias0);
        z1[t] = (t >= 48) ? bf2f((unsigned short)(cvt_pk_bf16(v, 0.f) & 0xffffu)) : 0.f;
    }
    __syncthreads();
    {
        unsigned h2 = hsh * 3266489917u + (unsigned)tid * 2246822519u; h2 ^= h2 >> 15; h2 *= 2654435761u; h2 ^= h2 >> 13;
        const int t = 64 + (int)(h2 % (unsigned)(LG - 64));
        float y = 0.f;
        for (int s2 = 48; s2 < LG; ++s2) y += bf2f(G1[LG - (t - s2)]) * z1[s2];
        const float e = bf2f(X2[t]) * (y + z1[t] * bias1);
        const float st = bf2f(HD[t]);
        atomicAdd(cnt + 11, 1u);
        if (!(fabsf(st - e) <= 0.05f * fabsf(e) + 1.0f)) atomicAdd(cnt + 9, 1u);
    }
    __syncthreads();
}
#endif

#if DEBUG_CHECK == 7
__device__ __forceinline__ void check_h0b_full(const Params& p, int slot) {
    unsigned char* ws = launder(p.ws); unsigned* cnt = (unsigned*)(ws + OFF_DBGW);
    const bf16_t* h0b = (const bf16_t*)(ws + OFF_H0B);
    const int tid = tid_l(), lane = tid & 63, wave = tid >> 6;
    for (int row = blockIdx.x * 8 + wave; row < T; row += gridDim.x * 8) {
        int pos, seq; row_info(row, pos, seq);
        const float* xr = pos < 16 ? p.in[2] + (size_t)pos * 1024 : (seq < NBP ? p.in[0] + ((size_t)seq * 8192 + (pos - 16)) * 1024 : p.in[1] + ((size_t)(seq - NBP) * 2048 + (pos - 16)) * 1024);
        int bad = 0;
        for (int c = lane; c < 1024; c += 64) { const float e = xr[c]; const float st = bf2f(h0b[(size_t)row * 1024 + c]); if (!(fabsf(st - e) <= 0.01f * fabsf(e) + 0.001f)) bad = 1; }
        bad = __any(bad);
        if (lane == 0 && bad) atomicAdd(cnt + slot, 1u);
    }
}
#endif

#if DEBUG_CHECK == 8
__device__ __forceinline__ void check_p_golden(const Params& p) {
    unsigned char* ws = launder(p.ws); unsigned* cnt = (unsigned*)(ws + OFF_DBGW);
    const bf16_t* P = (const bf16_t*)(ws + OFF_P);
    const unsigned idx = blockIdx.x * 512u + (unsigned)tid_l();
    unsigned hsh = idx * 2654435761u + 8888u; hsh ^= hsh >> 15; hsh *= 2246822519u; hsh ^= hsh >> 13;
    const int row = (int)(hsh % (unsigned)T); hsh = hsh * 3266489917u + 668265263u; hsh ^= hsh >> 16;
    int pos, seq; row_info(row, pos, seq);
    const float* xr = pos < 16 ? p.in[2] + (size_t)pos * 1024 : (seq < NBP ? p.in[0] + ((size_t)seq * 8192 + (pos - 16)) * 1024 : p.in[1] + ((size_t)(seq - NBP) * 2048 + (pos - 16)) * 1024);
    const float* W = p.in[4]; const float* g = p.in[3];
    const int colA = 448 + (int)(hsh % 1536u), colB = (int)((hsh >> 7) % 384u);
    float ss = 0.f, a = 0.f, b = 0.f;
    for (int k = 0; k < 1024; ++k) { const float x = xr[k]; ss += x * x; a += x * g[k] * W[(size_t)k * 1984 + colA]; b += x * g[k] * W[(size_t)k * 1984 + colB]; }
    const float r0 = rsqrtf(ss * (1.f / 1024.f) + EPS); a *= r0; b *= r0;
    const float sa = bf2f(P[(size_t)row * NPP + colA]), sb = bf2f(P[(size_t)row * NPP + colB]);
    if (!(fabsf(sa - a) <= 0.03f * fabsf(a) + 0.03f)) atomicAdd(cnt + 8, 1u);
    if (!(fabsf(sb - b) <= 0.03f * fabsf(b) + 0.03f)) atomicAdd(cnt + 9, 1u);
}
#endif

#if DEBUG_CHECK == 9
__device__ __forceinline__ void check_win_r0(const Params& p) {
    unsigned char* ws = launder(p.ws); unsigned* cnt = (unsigned*)(ws + OFF_DBGW);
    const bf16_t* WT = (const bf16_t*)(ws + OFF_WIN); const float* W = p.in[4]; const float* g = p.in[3]; const float* R0 = (const float*)(ws + OFF_R0);
    const int tid = tid_l(), lane = tid & 63, wave = tid >> 6;
    const int gtid = blockIdx.x * 512 + tid, gthreads = gridDim.x * 512;
    for (int e = gtid; e < 1984 * 1024; e += gthreads) {
        const int n = e >> 10, k = e & 1023; const int sc = src_col(1, n);
        const float ex = W[(size_t)k * 1984 + sc] * g[k]; const float st = bf2f(WT[(size_t)n * 1024 + k]);
        if (!(fabsf(st - ex) <= 0.01f * fabsf(ex) + 1e-5f)) atomicAdd(cnt + 8, 1u);
    }
    for (int row = blockIdx.x * 8 + wave; row < T; row += gridDim.x * 8) {
        int pos, seq; row_info(row, pos, seq);
        const float* xr = pos < 16 ? p.in[2] + (size_t)pos * 1024 : (seq < NBP ? p.in[0] + ((size_t)seq * 8192 + (pos - 16)) * 1024 : p.in[1] + ((size_t)(seq - NBP) * 2048 + (pos - 16)) * 1024);
        float ss = 0.f;
        for (int c = lane; c < 1024; c += 64) ss += xr[c] * xr[c];
        ss = wave_sum(ss);
        const float ex = rsqrtf(ss * (1.f / 1024.f) + EPS); const float st = R0[row];
        if (lane == 0 && !(fabsf(st - ex) <= 0.001f * ex)) { atomicAdd(cnt + 9, 1u); atomicAdd(cnt + 12, (unsigned)(row >> 6)); }
    }
}
#endif

#if DEBUG_CHECK == 10
__device__ __forceinline__ void check_x(const Params& p, int mode) {
    unsigned char* ws = launder(p.ws); unsigned* cnt = (unsigned*)(ws + OFF_DBGW); unsigned* sums = (unsigned*)(ws + OFF_DBGW + MiB);
    const int tid = tid_l(), lane = tid & 63, wave = tid >> 6;
    for (int n = blockIdx.x * 8 + wave; n < TN; n += gridDim.x * 8) {
        const unsigned* xr = (const unsigned*)(n < 65536 ? p.in[0] + (size_t)n * 1024 : p.in[1] + (size_t)(n - 65536) * 1024);
        unsigned a = 0u;
        for (int c = lane; c < 1024; c += 64) a += xr[c] * (2u * (unsigned)c + 1u);
#pragma unroll
        for (int o = 1; o < 64; o <<= 1) a += __shfl_xor(a, o);
        if (lane == 0) {
            if (mode == 0) __hip_atomic_store(sums + n, a, __ATOMIC_RELAXED, __HIP_MEMORY_SCOPE_AGENT);
            else if (__hip_atomic_load(sums + n, __ATOMIC_RELAXED, __HIP_MEMORY_SCOPE_AGENT) != a) atomicAdd(cnt + 8, 1u);
        }
    }
}
#endif

#if DEBUG_CHECK == 11
__device__ __forceinline__ void check_filt_prep(const Params& p) {
    unsigned char* ws = launder(p.ws); unsigned* cnt = (unsigned*)(ws + OFF_DBGW);
    const unsigned idx = blockIdx.x * 512u + (unsigned)tid_l();
    unsigned hsh = idx * 2654435761u + 1111u; hsh ^= hsh >> 15; hsh *= 2246822519u; hsh ^= hsh >> 13;
    {
        const int set = (int)(hsh & 1u); const int L = set ? LS : LP; const int C0 = set ? LGS : LGP;
        const int n = (int)((hsh >> 1) % 2048u); hsh = hsh * 3266489917u + 668265263u; hsh ^= hsh >> 16;
        const int t = (int)(hsh % (unsigned)L);
        const float* f_w1 = p.in[10]; const float* f_b1 = p.in[11]; const float* f_freq = p.in[12]; const float* f_w2 = p.in[13];
        const float* f_b2 = p.in[14]; const float* f_w3 = p.in[15]; const float* f_decay = p.in[16];
        const float tn = (float)t / (float)(L - 1); const float w = (6.2831853071795865f * (float)t) / (float)L;
        float acc = 0.f;
        for (int j2 = 0; j2 < 64; ++j2) {
            float a2 = f_b2[j2];
            for (int j1 = 0; j1 < 64; ++j1) {
                float a1 = f_b1[j1] + tn * f_w1[j1];
                for (int k = 0; k < 16; ++k) { const float f = 1e-4f + (float)k * ((15.0f - 1e-4f) / 15.0f); float sn, cs; sincos_red(f * w, sn, cs);
                    a1 += cs * f_w1[(1 + k) * 64 + j1] - sn * f_w1[(17 + k) * 64 + j1]; }
                a2 += sin_red(f_freq[j1] * a1) * f_w2[j1 * 64 + j2];
            }
            acc += sin_red(f_freq[j2] * a2) * f_w3[j2 * 2048 + n];
        }
        const float e = acc * __expf(-tn * fabsf(f_decay[n]));
        const int order = n >> 10, dir = (n >> 9) & 1, c = n & 511;
        if (!(dir == 1 && t == 0)) {
            const bf16_t* row = (const bf16_t*)(ws + (set ? OFF_GR1 : OFF_GR0)) + (size_t)(order * 512 + c) * (2 * C0);
            const float st = bf2f(row[dir ? C0 + t : C0 - t]);
            if (!(fabsf(st - e) <= 0.02f * fabsf(e) + 0.003f)) atomicAdd(cnt + 8, 1u);
        }
    }
    {
        const int seq = (int)(hsh % 40u); const int set = seq < NBP ? 0 : 1; const int L = set ? LS : LP; const int Lg = set ? LGS : LGP; const int NB = set ? NBS : NBP;
        const int b = set ? seq - NBP : seq; const int row0 = set ? TPR + b * LS : b * LP;
        hsh = hsh * 3266489917u + 668265263u; hsh ^= hsh >> 16;
        const int pos = (int)(hsh % (unsigned)L); const int which = (int)((hsh >> 16) % 3u); const int c = (int)((hsh >> 20) % 512u);
        const bf16_t* P = (const bf16_t*)(ws + OFF_P); const float* cw = p.in[9]; const int col = 448 + which * 512 + c;
        const float um = pos > 0 ? bf2f(P[(size_t)(row0 + pos - 1) * NPP + col]) : 0.f, u0 = bf2f(P[(size_t)(row0 + pos) * NPP + col]), up = pos + 1 < L ? bf2f(P[(size_t)(row0 + pos + 1) * NPP + col]) : 0.f;
        const float e = um * cw[which * 512 + c] + u0 * cw[1536 + which * 512 + c] + up * cw[3072 + which * 512 + c];
        const bf16_t* XT = (const bf16_t*)(ws + (which == 0 ? OFF_X1T : (which == 1 ? OFF_X2T : OFF_V0T))) + (set ? XT_SET1 : 0) + ((size_t)c * NB + b) * Lg;
        const float st = bf2f(XT[pos + 48]);
        if (!(fabsf(st - e) <= 0.02f * fabsf(e) + 0.02f)) atomicAdd(cnt + 9, 1u);
    }
}
#endif
#ifndef SUB_MASK
#define SUB_MASK 15
#endif
#ifndef PHASE_MASK
#define PHASE_MASK 1023
#endif
__global__ void __launch_bounds__(512) hymba_fwd(Params p) {
    extern __shared__ __attribute__((aligned(16))) unsigned char lds_raw[];
    LAS unsigned char* lds = (LAS unsigned char*)lds_raw;
    cg::grid_group grid = cg::this_grid();
#define GSYNC() do { asm volatile("s_waitcnt vmcnt(0) lgkmcnt(0)" ::: "memory"); __threadfence(); grid.sync(); } while (0)
    const int G = gridDim.x;
    __builtin_amdgcn_fence(__ATOMIC_SEQ_CST, "agent");
    asm volatile("buffer_inv sc1\n\ts_waitcnt vmcnt(0)" ::: "memory");
#if DEBUG_CHECK == 10
    check_x(p, 0);
#endif
#if PHASE_MASK & 1
    p0_prologue(p, lds);
#endif
    GSYNC();
#if DEBUG_CHECK == 3
    check_h0b(p, 8);
#endif
#if DEBUG_CHECK == 7
    check_h0b_full(p, 8);
#endif
#if DEBUG_CHECK == 4
    check_stale(p, (const unsigned*)(launder(p.ws) + OFF_H0B), (unsigned)((size_t)T * 512), 9);
#endif
#if PHASE_MASK & 2
    {
        unsigned char* ws = launder(p.ws); unsigned char* ob = launder((unsigned char*)p.out);
        pg8::Gemm g{(const bf16_t*)(ws + OFF_H0B), (const bf16_t*)(ws + OFF_WIN), TPAD, 2048, 1024, 1024, 1024};
        pg8::StaticOrder S; S.init(TPAD, 2048, G, blockIdx.x);
        Epi<0> E{(bf16_t*)(ws + OFF_P), NPP, (const float*)(ws + OFF_R0), (float*)(ws + OFF_SQQP), (float*)(ws + OFF_SQKVP), (bf16_t*)(ob + DO_KR), (const float2*)(ws + OFF_RT)};
        pg8::gemm_phase(lds, g, S, E);
    }
#endif
    GSYNC();
#if DEBUG_CHECK == 1
    { unsigned char* ws = launder(p.ws); check_gemm((const bf16_t*)(ws + OFF_H0B), 1024, (const bf16_t*)(ws + OFF_WIN), 1024, 1024, T, 1984, 0, (const bf16_t*)(ws + OFF_P), NPP, (const float*)(ws + OFF_R0), (unsigned*)(ws + OFF_DBG) + 0, 448); }
    GSYNC();
#endif
#if DEBUG_CHECK == 3
    check_h0b(p, 9);
#endif
#if DEBUG_CHECK == 8
    check_p_golden(p);
#endif
#if DEBUG_CHECK == 9
    check_win_r0(p);
#endif
#if DEBUG_CHECK == 7
    check_h0b_full(p, 9);
    GSYNC();
#endif
#if DEBUG_CHECK == 6
    { unsigned char* ws = launder(p.ws);
      check_gemm((const bf16_t*)(ws + OFF_H0B), 1024, (const bf16_t*)(ws + OFF_WIN), 1024, 1024, T, 448, 0, (const bf16_t*)(ws + OFF_P), NPP, (const float*)(ws + OFF_R0), (unsigned*)(ws + OFF_DBG) + 8, 384);
      check_gemm((const bf16_t*)(ws + OFF_H0B), 1024, (const bf16_t*)(ws + OFF_WIN), 1024, 1024, T, 384, 7, (const bf16_t*)(ws + OFF_P), NPP, (const float*)(ws + OFF_R0), (unsigned*)(ws + OFF_DBG) + 9, 0); }
    GSYNC();
#endif
#if DEBUG_CHECK == 4
    check_stale(p, (const unsigned*)(launder(p.ws) + OFF_P), (unsigned)((size_t)T * 1024), 8);
#endif
    rownorm_phase(p);
    krope_phase(p);
    GSYNC();
#if (PHASE_MASK & 4) && (SUB2 & 1)
    {
        unsigned char* ws = launder(p.ws); unsigned char* ob = launder((unsigned char*)p.out);
        pg8::Gemm g{(const bf16_t*)(ws + OFF_P), (const bf16_t*)(ws + OFF_WUQ), TPAD, 768, 256, NPP, 256};
        pg8::StaticOrder S; S.init(TPAD, 768, G, blockIdx.x);
        Epi<1> E{(bf16_t*)(ob + DO_Q), 768, (const float*)(ws + OFF_RQ), nullptr, nullptr, nullptr, (const float2*)(ws + OFF_RT)};
        pg8::gemm_phase(lds, g, S, E);
    }
#endif
#if (PHASE_MASK & 4) && (SUB2 & 2)
    {
        unsigned char* ws = launder(p.ws); unsigned char* ob = launder((unsigned char*)p.out);
        pg8::Gemm g{(const bf16_t*)(ws + OFF_P) + 256, (const bf16_t*)(ws + OFF_WKN), TPAD, 512, 128, NPP, 128};
        pg8::StaticOrder S; S.init(TPAD, 512, G, blockIdx.x);
        Epi<2> E{(bf16_t*)(ob + DO_KN), 512, (const float*)(ws + OFF_RKV), nullptr, nullptr, nullptr, nullptr};
        pg8::gemm_phase(lds, g, S, E);
    }
#endif
#if (PHASE_MASK & 4) && (SUB2 & 4)
    {
        unsigned char* ws = launder(p.ws); unsigned char* ob = launder((unsigned char*)p.out);
        pg8::Gemm g{(const bf16_t*)(ws + OFF_WV), (const bf16_t*)(ws + OFF_P) + 256, 512, TPAD, 128, 128, NPP};
        pg8::StaticOrder S; S.init(512, TPAD, G, blockIdx.x);
        Epi<3> E{(bf16_t*)(ob + DO_VT), TPAD, (const float*)(ws + OFF_RKV), nullptr, nullptr, nullptr, nullptr};
        pg8::gemm_phase(lds, g, S, E);
    }
#endif
#if PHASE_MASK & 8
    hyprep_phase(p, lds);
#endif
    GSYNC();
#if DEBUG_CHECK == 2
    check_proj(p);
    GSYNC();
#endif
#if DEBUG_CHECK == 11
    check_filt_prep(p);
    GSYNC();
#endif
#if PHASE_MASK & 16
    attn_phase(p, lds);
#endif
#if PHASE_MASK & 32
    hyena_phase(p, lds);
#endif
    GSYNC();
#if DEBUG_CHECK == 5
    check_attn(p);
    check_hyena(p, lds);
    GSYNC();
#endif
#if PHASE_MASK & 64
    mixnorm_phase(p, lds);
#endif
    GSYNC();
#if PHASE_MASK & 128
    {
        unsigned char* ws = launder(p.ws);
        pg8::Gemm g{(const bf16_t*)(ws + OFF_MIXN), (const bf16_t*)(ws + OFF_WO), TN, 1024, 1024, 1024, 1024};
        pg8::StaticOrder S; S.init(TN, 1024, G, blockIdx.x);
        Epi<4> E{(bf16_t*)(ws + OFF_MIX), 1024, nullptr, (float*)(ws + OFF_SQMIXP), nullptr, nullptr, nullptr};
        pg8::gemm_phase(lds, g, S, E);
    }
#endif
    GSYNC();
#if DEBUG_CHECK == 1
    { unsigned char* ws = launder(p.ws); check_gemm((const bf16_t*)(ws + OFF_MIXN), 1024, (const bf16_t*)(ws + OFF_WO), 1024, 1024, TN, 1024, 4, (const bf16_t*)(ws + OFF_MIX), 1024, nullptr, (unsigned*)(ws + OFF_DBG) + 1, 0); }
#endif
#if DEBUG_CHECK == 10
    check_x(p, 1);
#endif
#if PHASE_MASK & 256
    h1_phase(p);
#endif
    GSYNC();
#if PHASE_MASK & 512
#if DEBUG_CHECK == 1
#define DBG_FF1(half) if ((half) == 0) { unsigned char* ws = launder(p.ws); check_gemm((const bf16_t*)(ws + OFF_H1B), 1024, (const bf16_t*)(ws + OFF_WF1), 1024, 1024, 65536, 4096, 5, (const bf16_t*)(ws + OFF_M), 4096, (const float*)(ws + OFF_R1), (unsigned*)(ws + OFF_DBG) + 2, 0); }
#define DBG_FF2(half) if ((half) == 0) { unsigned char* ws = launder(p.ws); check_gemm((const bf16_t*)(ws + OFF_M), 4096, (const bf16_t*)(ws + OFF_WF2), 4096, 4096, 65536, 1024, 6, (const bf16_t*)(ws + OFF_M2), 1024, nullptr, (unsigned*)(ws + OFF_DBG) + 3, 0); } GSYNC();
#else
#define DBG_FF1(half)
#define DBG_FF2(half)
#endif
#define FFN_HALF(half) \
    { \
        unsigned char* ws = launder(p.ws); \
        pg8::Gemm g{(const bf16_t*)(ws + OFF_H1B) + (size_t)(half) * 65536 * 1024, (const bf16_t*)(ws + OFF_WF1), 65536, 4096, 1024, 1024, 1024}; \
        pg8::StaticOrder S; S.init(65536, 4096, G, blockIdx.x); \
        Epi<5> E{(bf16_t*)(ws + OFF_M), 4096, (const float*)(ws + OFF_R1) + (half) * 65536, nullptr, nullptr, nullptr, nullptr}; \
        pg8::gemm_phase(lds, g, S, E); \
    } \
    GSYNC(); \
    DBG_FF1(half) \
    { \
        unsigned char* ws = launder(p.ws); \
        pg8::Gemm g{(const bf16_t*)(ws + OFF_M), (const bf16_t*)(ws + OFF_WF2), 65536, 1024, 4096, 4096, 4096}; \
        pg8::StaticOrder S; S.init(65536, 1024, G, blockIdx.x); \
        Epi<6> E{(bf16_t*)(ws + OFF_M2), 1024, nullptr, (float*)(ws + OFF_SQM2P) + (size_t)(half) * 65536 * 16, nullptr, nullptr, nullptr}; \
        pg8::gemm_phase(lds, g, S, E); \
    } \
    GSYNC(); \
    DBG_FF2(half) \
    final_phase(p, half);
    FFN_HALF(0)
    FFN_HALF(1)
#undef FFN_HALF
#endif
}

extern "C" void kernel_launch(void* const* d_in, const int* in_sizes, int n_in, void* d_out, int out_size, void* d_ws, size_t ws_size, hipStream_t stream) {
    static int grid = 0;
    if (grid == 0) {
        int dev = 0, cus = 0, per_cu = 0;
        hipGetDevice(&dev);
        hipDeviceGetAttribute(&cus, hipDeviceAttributeMultiprocessorCount, dev);
        hipFuncSetAttribute((const void*)hymba_fwd, hipFuncAttributeMaxDynamicSharedMemorySize, LDS_BYTES);
        hipOccupancyMaxActiveBlocksPerMultiprocessor(&per_cu, (const void*)hymba_fwd, 512, LDS_BYTES);
        if (per_cu < 1) per_cu = 1;
        grid = cus * 1;
        if (n_in != 26 || ws_size < 1024 * MiB) fprintf(stderr, "kernel_launch: unexpected n_in %d / ws_size %zu\n", n_in, ws_size);
    }
    Params p{};
    for (int i = 0; i < 26; ++i) p.in[i] = (const float*)d_in[i];
    p.out = (float*)d_out; p.ws = (unsigned char*)d_ws;
    void* args[] = {&p};
    hipError_t e = hipLaunchCooperativeKernel((const void*)hymba_fwd, dim3(grid), dim3(512), args, LDS_BYTES, stream);
    if (e != hipSuccess) fprintf(stderr, "cooperative launch failed: %s (grid %d)\n", hipGetErrorString(e), grid);
}
```

```cpp
#include <hip/hip_runtime.h>
#include <hip/hip_cooperative_groups.h>
#include <cstdio>
#include <cstdint>
namespace cg = cooperative_groups;
#ifndef DBG_SEL0
#define DBG_SEL0 3
#endif
#ifndef DBG_SEL1
#define DBG_SEL1 0
#endif
#ifndef DEBUG_CHECK
#define DEBUG_CHECK 0
#endif
#ifndef EXPT
#define EXPT 0
#endif
#ifndef SUB_MASK
#define SUB_MASK 15
#endif
#ifndef SUB2
#define SUB2 7
#endif

#define LAS __attribute__((address_space(3)))
#define GAS __attribute__((address_space(1)))
typedef unsigned short bf16_t;
typedef short bf16x8 __attribute__((ext_vector_type(8)));
typedef float f32x4 __attribute__((ext_vector_type(4)));
typedef float f32x16 __attribute__((ext_vector_type(16)));
typedef unsigned u32x4 __attribute__((ext_vector_type(4)));
typedef unsigned u32x2 __attribute__((ext_vector_type(2)));

constexpr int DM = 1024, LP = 8208, LS = 2064, NBP = 8, NBS = 32;
constexpr int TPR = NBP * LP;
constexpr int TSR = NBS * LS;
constexpr int T = TPR + TSR;
constexpr int TPAD = 131840;
constexpr int TN = 131072;
constexpr int NPP = 2048;
constexpr int LGP = 8256, LGS = 2112;
constexpr float EPS = 1e-6f;
constexpr float QSCALE = 0.07216878364870322f * 1.4426950408889634f;

constexpr size_t MiB = 1ull << 20;
constexpr size_t OFF_H0B = 0;
constexpr size_t XT_SET1 = (size_t)512 * NBP * LGP;
constexpr size_t OFF_X1T = 0;
constexpr size_t OFF_X2T = 131 * MiB;
constexpr size_t OFF_P = 262 * MiB;
constexpr size_t OFF_V0T = 778 * MiB;
constexpr size_t OFF_MIXN = 262 * MiB;
constexpr size_t OFF_MIX = 518 * MiB;
constexpr size_t OFF_H1B = 0;
constexpr size_t OFF_M = 256 * MiB;
constexpr size_t OFF_M2 = 768 * MiB;
constexpr size_t OFF_SQMIXP = 896 * MiB;
constexpr size_t OFF_SQM2P = 904 * MiB;
constexpr size_t OFF_SMALL = 912 * MiB;
constexpr size_t OFF_WIN = OFF_SMALL;
constexpr size_t OFF_WUQ = OFF_SMALL + 4 * MiB;
constexpr size_t OFF_WKN = OFF_SMALL + 4 * MiB + 512 * 1024;
constexpr size_t OFF_WV = OFF_SMALL + 4 * MiB + 768 * 1024;
constexpr size_t OFF_WO = OFF_SMALL + 5 * MiB;
constexpr size_t OFF_WF1 = OFF_SMALL + 7 * MiB;
constexpr size_t OFF_WF2 = OFF_SMALL + 15 * MiB;
constexpr size_t OFF_GR0 = OFF_SMALL + 23 * MiB;
constexpr size_t OFF_GR1 = OFF_SMALL + 56 * MiB;
constexpr size_t OFF_RT = OFF_SMALL + 65 * MiB;
constexpr size_t OFF_R0 = OFF_SMALL + 68 * MiB;
constexpr size_t OFF_R1 = OFF_SMALL + 69 * MiB;
constexpr size_t OFF_RQ = OFF_SMALL + 70 * MiB;
constexpr size_t OFF_RKV = OFF_SMALL + 71 * MiB;
constexpr size_t OFF_SQQP = OFF_SMALL + 72 * MiB;
constexpr size_t OFF_SQKVP = OFF_SMALL + 75 * MiB;
constexpr size_t OFF_DBGW = OFF_SMALL + 78 * MiB;
constexpr size_t DO_Q = 0;
constexpr size_t DO_KN = 194 * MiB;
constexpr size_t DO_KR = 323 * MiB;
constexpr size_t DO_VT = 340 * MiB;

constexpr size_t OFF_ODBG = 518 * MiB;
constexpr size_t OFF_HDBG = 647 * MiB;
constexpr int LDS_BYTES = 147456;

struct Params {
    const float* in[26];
    float* out;
    unsigned char* ws;
};

__device__ __forceinline__ f32x4 ld_sys(const float* q) { f32x4 v; asm volatile("global_load_dwordx4 %0, %1, off sc0 sc1\n\ts_waitcnt vmcnt(0)" : "=v"(v) : "v"(q) : "memory"); return v; }
__device__ __forceinline__ float ldco(const float* q) { return __builtin_bit_cast(float, __hip_atomic_load((const unsigned*)q, __ATOMIC_RELAXED, __HIP_MEMORY_SCOPE_AGENT)); }
__device__ __forceinline__ float2 ldco2(const float2* q) { const unsigned long long w = __hip_atomic_load((const unsigned long long*)q, __ATOMIC_RELAXED, __HIP_MEMORY_SCOPE_AGENT); return make_float2(__builtin_bit_cast(float, (unsigned)w), __builtin_bit_cast(float, (unsigned)(w >> 32))); }
template <class Tp> __device__ __forceinline__ Tp* launder(Tp* q) { asm volatile("" : "+s"(q)); return q; }
__device__ __forceinline__ int tid_l() { int t = threadIdx.x; asm volatile("" : "+v"(t)); return t; }
__device__ __forceinline__ unsigned cvt_pk_bf16(float lo, float hi) { unsigned r; asm volatile("v_cvt_pk_bf16_f32 %0, %1, %2" : "=v"(r) : "v"(lo), "v"(hi)); return r; }
__device__ __forceinline__ float bf2f(unsigned short b) { return __builtin_bit_cast(float, (unsigned)b << 16); }
__device__ __forceinline__ float bflo(unsigned w) { return __builtin_bit_cast(float, w << 16); }
__device__ __forceinline__ float bfhi(unsigned w) { return __builtin_bit_cast(float, w & 0xffff0000u); }
__device__ __forceinline__ float wave_sum(float v) {
#pragma unroll
    for (int o = 1; o < 64; o <<= 1) v += __shfl_xor(v, o);
    return v;
}
__device__ __forceinline__ void sincos_red(float x, float& s, float& c) {
    const double xd = (double)x; const double k = rint(xd * 0.15915494309189535); const float r = (float)(xd - k * 6.283185307179586);
    s = __sinf(r); c = __cosf(r);
}
__device__ __forceinline__ float sin_red(float x) { float s, c; sincos_red(x, s, c); return s; }
__device__ __forceinline__ void row_info(int r, int& pos, int& seq) {
    if (r < TPR) { seq = r / LP; pos = r - seq * LP; }
    else { int q = r - TPR; if (q >= TSR) q = TSR - 1; const int b = q / LS; pos = q - b * LS; seq = NBP + b; }
}
__device__ __forceinline__ int full_row(int n) {
    if (n < 65536) { const int b = n >> 13; return b * LP + 16 + (n & 8191); }
    const int q = n - 65536; const int b = q >> 11; return TPR + b * LS + 16 + (q & 2047);
}

namespace pg8 {
constexpr int BM = 256, BK = 64, HALF = 128, HTB = HALF * BK * 2, STAGE_BYTES = 8 * HTB, NXCD = 8, WGM = 8;
__host__ __device__ __forceinline__ int lds_byte(int r, int c) { const int st = (r >> 4) * 2 + (c >> 5), rr = r & 15, cc = c & 31, ob = rr * 64 + cc * 2; return st * 1024 + (ob ^ (((ob >> 9) & 1) << 5)); }
__host__ __device__ __forceinline__ void stage_rc(int b, int& R, int& C) { const int st = b / 1024, sb = b % 1024, swz = sb ^ (((sb >> 9) & 1) << 5); R = (st >> 1) * 16 + swz / 64; C = (st & 1) * 32 + (swz % 64) / 2; }
__host__ __device__ __forceinline__ int perm32(int rho) { const int n = rho >> 4, i = rho & 15; return 8 * (i >> 2) + 4 * n + (i & 3); }
struct Unit { int pm, pn; };
struct Gemm { const bf16_t* A; const bf16_t* Bt; int M, N, K, lda, ldb; };
struct StaticOrder {
    int nM, nN, nwg, G, c;
    __device__ void init(int M, int N, int G_, int c_) { nM = M / BM; nN = N / BM; nwg = nM * nN; G = G_; c = c_; }
    __device__ bool next(int i, Unit& u) const {
        const long L = (long)i * G + c; if (L >= nwg) return false;
        int wgid = (int)L; { const int q = nwg / NXCD, r = nwg % NXCD, xcd = wgid % NXCD, off = wgid / NXCD; wgid = (xcd < r ? xcd * (q + 1) : r * (q + 1) + (xcd - r) * q) + off; }
        const int nig = WGM * nN, gid = wgid / nig, fm = gid * WGM, gsz = (nM - fm) < WGM ? (nM - fm) : WGM;
        u.pm = fm + ((wgid % nig) % gsz); u.pn = (wgid % nig) / gsz; return true;
    }
};
template <class Epi>
__device__ __forceinline__ void gemm_phase(LAS unsigned char* lds, const Gemm g, const StaticOrder& S, const Epi& E) {
    const int tid = tid_l(), wid = __builtin_amdgcn_readfirstlane(tid >> 6), lane = tid & 63, wr = wid >> 2, wc = wid & 3, fr = lane & 15, fq = lane >> 4;
    const int K = g.K, nt = K / BK;
    unsigned voffA[2], voffB[2];
#pragma unroll
    for (int i = 0; i < 2; ++i) { int R, C; stage_rc(tid * 16 + i * 8192, R, C); const int Rb = (R & ~31) + perm32(R & 31);
        voffA[i] = (unsigned)(R * g.lda + C) * 2u; voffB[i] = (unsigned)(Rb * g.ldb + C) * 2u; }
    const size_t kstep = (size_t)(BK * 2);
    const size_t hstepA = (size_t)HALF * g.lda * 2, hstepB = (size_t)HALF * g.ldb * 2;
    const size_t tstepA = 2 * hstepA, tstepB = 2 * hstepB;
    const unsigned ldsw = (unsigned)wid * 1024u;
    const int aoff = lds_byte(wr * 64 + fr, fq * 8), boff = lds_byte(wc * 32 + fr, fq * 8);
#define PG8_SA(b, h) (((b) * 2 + (h)) * HTB)
#define PG8_SB(b, h) ((4 + (b) * 2 + (h)) * HTB)
#define PG8_STAGE(bufoff, gbase, voff) do { _Pragma("unroll") for (int _i = 0; _i < 2; ++_i) \
        __builtin_amdgcn_global_load_lds((const unsigned*)((const char*)(gbase) + (voff)[_i]), (LAS unsigned*)(lds + (bufoff) + ldsw + _i * 8192), 16, 0, 0); } while (0)
#define PG8_LDA(dst, b, h) do { _Pragma("unroll") for (int m = 0; m < 4; ++m) _Pragma("unroll") for (int k = 0; k < 2; ++k) dst[m][k] = *(const LAS bf16x8*)(lds + PG8_SA(b, h) + aoff + m * 2048 + k * 1024); } while (0)
#define PG8_LDB(dst, b, h) do { _Pragma("unroll") for (int n = 0; n < 2; ++n) _Pragma("unroll") for (int k = 0; k < 2; ++k) dst[n][k] = *(const LAS bf16x8*)(lds + PG8_SB(b, h) + boff + n * 2048 + k * 1024); } while (0)
#define PG8_MMA(ai, bj, At, Bt) do { __builtin_amdgcn_s_setprio(1); _Pragma("unroll") for (int m = 0; m < 4; ++m) _Pragma("unroll") for (int n = 0; n < 2; ++n) _Pragma("unroll") for (int k = 0; k < 2; ++k) \
        acc[ai][bj][m][n] = __builtin_amdgcn_mfma_f32_16x16x32_bf16(Bt[n][k], At[m][k], acc[ai][bj][m][n], 0, 0, 0); __builtin_amdgcn_s_setprio(0); } while (0)
#define PG8_WAIT_V(n) asm volatile("s_waitcnt vmcnt(" #n ")" ::: "memory")
#define PG8_WAIT_L(n) asm volatile("s_waitcnt lgkmcnt(" #n ")" ::: "memory")
#define PG8_BAR __builtin_amdgcn_s_barrier()
#define PG8_SCHED __builtin_amdgcn_sched_barrier(0)
    Unit cur, nxt; int ui = 0;
    if (!S.next(0, cur)) return;
    f32x4 acc[2][2][4][2];
#pragma unroll
    for (int a = 0; a < 2; ++a)
#pragma unroll
        for (int b = 0; b < 2; ++b)
#pragma unroll
            for (int m = 0; m < 4; ++m)
#pragma unroll
                for (int n = 0; n < 2; ++n) acc[a][b][m][n] = (f32x4){0.f, 0.f, 0.f, 0.f};
    bf16x8 At[4][2], B0[2][2], B1[2][2];
    const char* cA = (const char*)g.A + (size_t)cur.pm * tstepA; const char* cB = (const char*)g.Bt + (size_t)cur.pn * tstepB;
    PG8_STAGE(PG8_SB(0, 0), cB, voffB); PG8_STAGE(PG8_SB(0, 1), cB + hstepB, voffB); PG8_STAGE(PG8_SA(0, 0), cA, voffA); PG8_STAGE(PG8_SA(0, 1), cA + hstepA, voffA);
    if (wr == 1) PG8_BAR;
    PG8_WAIT_V(2); PG8_BAR;
    PG8_STAGE(PG8_SB(1, 0), cB + kstep, voffB); PG8_STAGE(PG8_SA(1, 0), cA + kstep, voffA); PG8_STAGE(PG8_SB(1, 1), cB + hstepB + kstep, voffB);
    PG8_WAIT_V(6); PG8_BAR;
    for (;;) {
        const bool has_next = S.next(ui + 1, nxt);
        const char* nA = has_next ? (const char*)g.A + (size_t)nxt.pm * tstepA : cA; const char* nB = has_next ? (const char*)g.Bt + (size_t)nxt.pn * tstepB : cB;
        for (int t = 0; t < nt; t += 2) {
            const bool last = (t == nt - 2);
            const char* a1 = cA + (size_t)(t + 1) * kstep;
            const char* a2 = last ? nA : cA + (size_t)(t + 2) * kstep; const char* b2 = last ? nB : cB + (size_t)(t + 2) * kstep;
            const char* a3 = a2 + kstep; const char* b3 = b2 + kstep;
            PG8_LDB(B0, 0, 0); PG8_LDB(B1, 0, 1); PG8_SCHED; PG8_LDA(At, 0, 0); PG8_STAGE(PG8_SA(1, 1), a1 + hstepA, voffA);
            PG8_WAIT_V(8); PG8_WAIT_L(0); PG8_BAR; PG8_MMA(0, 0, At, B0); PG8_MMA(0, 1, At, B1); PG8_BAR; PG8_SCHED;
            PG8_LDA(At, 0, 1); PG8_STAGE(PG8_SB(0, 0), b2, voffB); PG8_STAGE(PG8_SB(0, 1), b2 + hstepB, voffB); PG8_STAGE(PG8_SA(0, 0), a2, voffA);
            PG8_WAIT_V(8); PG8_WAIT_L(0); PG8_BAR; PG8_MMA(1, 0, At, B0); PG8_MMA(1, 1, At, B1); PG8_BAR; PG8_SCHED;
            PG8_LDB(B0, 1, 0); PG8_LDB(B1, 1, 1); PG8_SCHED; PG8_LDA(At, 1, 0); PG8_STAGE(PG8_SA(0, 1), a2 + hstepA, voffA);
            PG8_WAIT_V(8); PG8_WAIT_L(0); PG8_BAR; PG8_MMA(0, 0, At, B0); PG8_MMA(0, 1, At, B1); PG8_BAR; PG8_SCHED;
            PG8_LDA(At, 1, 1); PG8_STAGE(PG8_SB(1, 0), b3, voffB); PG8_STAGE(PG8_SB(1, 1), b3 + hstepB, voffB); PG8_STAGE(PG8_SA(1, 0), a3, voffA);
            PG8_WAIT_V(8); PG8_WAIT_L(0); PG8_BAR; PG8_MMA(1, 0, At, B0); PG8_MMA(1, 1, At, B1); PG8_BAR; PG8_SCHED;
        }
        if (wr == 0) PG8_BAR;
        E(acc, cur, wr, wc, fr, fq);
        if (!has_next) break;
#pragma unroll
        for (int a = 0; a < 2; ++a)
#pragma unroll
            for (int b = 0; b < 2; ++b)
#pragma unroll
                for (int m = 0; m < 4; ++m)
#pragma unroll
                    for (int n = 0; n < 2; ++n) acc[a][b][m][n] = (f32x4){0.f, 0.f, 0.f, 0.f};
        cur = nxt; cA = nA; cB = nB; ++ui;
        if (wr == 1) PG8_BAR;
    }
    PG8_WAIT_V(0);
    PG8_BAR;
#undef PG8_SA
#undef PG8_SB
#undef PG8_STAGE
#undef PG8_LDA
#undef PG8_LDB
#undef PG8_MMA
#undef PG8_WAIT_V
#undef PG8_WAIT_L
#undef PG8_BAR
#undef PG8_SCHED
}
}

__device__ __forceinline__ void rope8(f32x4& v0, f32x4& v1, const float2* rt  ) {
    const float2 c0 = ldco2(rt), c1 = ldco2(rt + 1), c2 = ldco2(rt + 2), c3 = ldco2(rt + 3);
    float a, b;
    a = v0[0]; b = v0[1]; v0[0] = a * c0.x - b * c0.y; v0[1] = b * c0.x + a * c0.y;
    a = v0[2]; b = v0[3]; v0[2] = a * c1.x - b * c1.y; v0[3] = b * c1.x + a * c1.y;
    a = v1[0]; b = v1[1]; v1[0] = a * c2.x - b * c2.y; v1[1] = b * c2.x + a * c2.y;
    a = v1[2]; b = v1[3]; v1[2] = a * c3.x - b * c3.y; v1[3] = b * c3.x + a * c3.y;
}
__device__ __forceinline__ u32x4 pack8(const f32x4& v0, const f32x4& v1) {
    u32x4 w; w.x = cvt_pk_bf16(v0[0], v0[1]); w.y = cvt_pk_bf16(v0[2], v0[3]); w.z = cvt_pk_bf16(v1[0], v1[1]); w.w = cvt_pk_bf16(v1[2], v1[3]); return w;
}
__device__ __forceinline__ float sq8(const f32x4& a, const f32x4& b) {
    return (a[0] * a[0] + a[1] * a[1]) + (a[2] * a[2] + a[3] * a[3]) + (b[0] * b[0] + b[1] * b[1]) + (b[2] * b[2] + b[3] * b[3]);
}
template <int MODE> struct Epi {
    bf16_t* O; int ldc; const float* rs; float* sq0; float* sq1; bf16_t* KR; const float2* RT;
    __device__ __forceinline__ void operator()(const f32x4 (&acc)[2][2][4][2], const pg8::Unit& u, int wr, int wc, int fr, int fq) const {
#pragma unroll
        for (int ai = 0; ai < 2; ++ai)
#pragma unroll
            for (int m = 0; m < 4; ++m) {
                const int row = u.pm * 256 + ai * 128 + wr * 64 + m * 16 + fr;
                float sc = 1.f;
                if (MODE == 0 || MODE == 1 || MODE == 2 || MODE == 5) sc = ldco(rs + row);
                float ssum[2];
#pragma unroll
                for (int bj = 0; bj < 2; ++bj) {
                    const int col0 = u.pn * 256 + bj * 128 + wc * 32 + 8 * fq;
                    f32x4 v0 = acc[ai][bj][m][0] * sc, v1 = acc[ai][bj][m][1] * sc;
                    if (MODE == 3) {
#pragma unroll
                        for (int j = 0; j < 4; ++j) { v0[j] *= ldco(rs + col0 + j); v1[j] *= ldco(rs + col0 + 4 + j); }
                    }
                    if (MODE == 5) {
#pragma unroll
                        for (int j = 0; j < 4; ++j) { const float a = fmaxf(v0[j], 0.f), b = fmaxf(v1[j], 0.f); v0[j] = a * a; v1[j] = b * b; }
                    }
                    ssum[bj] = sq8(v0, v1);
                    *(u32x4*)(O + (size_t)row * ldc + col0) = pack8(v0, v1);
                }
                if (MODE == 0) {
                    if (u.pn == 0) { float s = ssum[0] + ssum[1]; s += __shfl_xor(s, 16); s += __shfl_xor(s, 32); if (fq == 0) sq0[row * 4 + wc] = s; }
                    else if (u.pn == 1) { float s = ssum[0]; s += __shfl_xor(s, 16); s += __shfl_xor(s, 32); if (fq == 0) sq1[row * 4 + wc] = s; }
                }
                if (MODE == 4 || MODE == 6) { float s = ssum[0] + ssum[1]; s += __shfl_xor(s, 16); s += __shfl_xor(s, 32); if (fq == 0) sq0[(size_t)row * 16 + u.pn * 4 + wc] = s; }
            }
    }
};

__device__ __forceinline__ int src_col(int mode, int n) {
    if (mode == 0) return n;
    if (mode == 1) { if (n >= 1984) return -1; if (n >= 384 && n < 448) { const int j = n - 384; return 384 + ((j & 1) ? 32 + (j >> 1) : (j >> 1)); } return n; }
    if (mode == 2) { const int h = n / 192, w = n % 192; if (w < 128) return n; const int j = w - 128; return h * 192 + 128 + ((j & 1) ? 32 + (j >> 1) : (j >> 1)); }
    if (mode == 3) return (n >> 7) * 256 + (n & 127);
    return (n >> 7) * 256 + 128 + (n & 127);
}
__device__ __forceinline__ void conv_weight(const float* W, const float* g, bf16_t* out, int K, int Nsrc, int Nout, int mode, int gtid, int gthreads) {
    const int nch = Nout * (K / 8);
    for (int e = gtid; e < nch; e += gthreads) {
        const int n = e % Nout, kc = e / Nout, k0 = kc * 8; const int sc = src_col(mode, n);
        float v[8];
#pragma unroll
        for (int j = 0; j < 8; ++j) v[j] = (sc >= 0) ? W[(size_t)(k0 + j) * Nsrc + sc] * (g ? g[k0 + j] : 1.f) : 0.f;
        u32x4 w; w.x = cvt_pk_bf16(v[0], v[1]); w.y = cvt_pk_bf16(v[2], v[3]); w.z = cvt_pk_bf16(v[4], v[5]); w.w = cvt_pk_bf16(v[6], v[7]);
        *(u32x4*)(out + (size_t)n * K + k0) = w;
    }
}

__device__ __forceinline__ void p0_prologue(const Params& p, LAS unsigned char* lds) {
    unsigned char* ws = launder(p.ws);
    const int tid = tid_l(), lane = tid & 63, wave = tid >> 6, G = gridDim.x;
    const int gtid = blockIdx.x * 512 + tid, gthreads = G * 512;
    const int gw = blockIdx.x * 8 + wave, NGW = G * 8;
#if SUB_MASK & 1
    conv_weight(p.in[4], p.in[3], (bf16_t*)(ws + OFF_WIN), 1024, 1984, 2048, 1, gtid, gthreads);
    conv_weight(p.in[6], p.in[5], (bf16_t*)(ws + OFF_WUQ), 256, 768, 768, 2, gtid, gthreads);
    conv_weight(p.in[8], p.in[7], (bf16_t*)(ws + OFF_WKN), 128, 1024, 512, 3, gtid, gthreads);
    conv_weight(p.in[8], p.in[7], (bf16_t*)(ws + OFF_WV), 128, 1024, 512, 4, gtid, gthreads);
    conv_weight(p.in[20], nullptr, (bf16_t*)(ws + OFF_WO), 1024, 1024, 1024, 0, gtid, gthreads);
    conv_weight(p.in[23], p.in[22], (bf16_t*)(ws + OFF_WF1), 1024, 4096, 4096, 0, gtid, gthreads);
    conv_weight(p.in[24], nullptr, (bf16_t*)(ws + OFF_WF2), 4096, 1024, 1024, 0, gtid, gthreads);
#endif
#if SUB_MASK & 2
#if DEBUG_CHECK
    if (blockIdx.x == 0 && tid < 64) ((unsigned*)(ws + OFF_DBGW))[tid] = 0u;
#endif
    {
        float2* RT = (float2*)(ws + OFF_RT);
        for (int e = gtid; e < LP * 32; e += gthreads) {
            const int pos = e >> 5, i = e & 31;
            const float inv = 1.0f / exp2f((float)i * (13.287712379549449f / 32.f));
            float s, c; sincos_red((float)pos * inv, s, c);
            RT[e] = make_float2(c, s);
        }
    }
#endif
#if SUB_MASK & 4
    {
        bf16_t* h0b = (bf16_t*)(ws + OFF_H0B); float* r0 = (float*)(ws + OFF_R0);
        for (int r = gw; r < TPAD; r += NGW) {
            u32x2* o = (u32x2*)(h0b + (size_t)r * 1024) + lane;
            if (r >= T) {
#pragma unroll
                for (int j = 0; j < 4; ++j) o[64 * j] = (u32x2){0u, 0u};
                if (lane == 0) __hip_atomic_store(r0 + r, 0.f, __ATOMIC_RELAXED, __HIP_MEMORY_SCOPE_AGENT);
                continue;
            }
            int pos, seq; row_info(r, pos, seq);
            const float* src = pos < 16 ? p.in[2] + (size_t)pos * 1024
                                        : (seq < NBP ? p.in[0] + ((size_t)seq * 8192 + (pos - 16)) * 1024 : p.in[1] + ((size_t)(seq - NBP) * 2048 + (pos - 16)) * 1024);
            const f32x4* xr = (const f32x4*)src + lane;
            f32x4 v[4]; float ss = 0.f;
#pragma unroll
            for (int j = 0; j < 4; ++j) { v[j] = xr[64 * j]; ss += (v[j][0] * v[j][0] + v[j][1] * v[j][1]) + (v[j][2] * v[j][2] + v[j][3] * v[j][3]); }
            ss = wave_sum(ss);
#pragma unroll
            for (int j = 0; j < 4; ++j) o[64 * j] = (u32x2){cvt_pk_bf16(v[j][0], v[j][1]), cvt_pk_bf16(v[j][2], v[j][3])};
            if (lane == 0) __hip_atomic_store(r0 + r, rsqrtf(ss * (1.f / 1024.f) + EPS), __ATOMIC_RELAXED, __HIP_MEMORY_SCOPE_AGENT);
        }
    }
#endif
#if SUB_MASK & 8
    {
        const float* f_w1 = p.in[10]; const float* f_b1 = p.in[11]; const float* f_freq = p.in[12]; const float* f_w2 = p.in[13];
        const float* f_b2 = p.in[14]; const float* f_w3 = p.in[15]; const float* f_decay = p.in[16];
        LAS float* feats = (LAS float*)lds;
        LAS float* h1 = feats + 16 * 34;
        LAS float* h2 = h1 + 16 * 64;
        for (int u = blockIdx.x; u < 513 + 129; u += G) {
            const int set = u < 513 ? 0 : 1; const int t0 = 16 * (set ? u - 513 : u); const int L = set ? LS : LP; const int C0 = set ? LGS : LGP;
            bf16_t* GR = (bf16_t*)(ws + (set ? OFF_GR1 : OFF_GR0));
            const float invLm1 = 1.0f / (float)(L - 1);
            if (tid < 256) {
                const int tt = tid >> 4, k = tid & 15; const int t = t0 + tt;
                const float w = (6.2831853071795865f * (float)t) / (float)L;
                const float f = 1e-4f + (float)k * ((15.0f - 1e-4f) / 15.0f);
                float s, c; sincos_red(f * w, s, c);
                feats[tt * 34 + 1 + k] = c; feats[tt * 34 + 17 + k] = -s;
                if (k == 0) feats[tt * 34] = (float)t * invLm1;
            }
            __syncthreads();
#pragma unroll 1
            for (int q = 0; q < 2; ++q) {
                const int o = tid + 512 * q, tt = o >> 6, j = o & 63;
                float a = f_b1[j];
#pragma unroll 3
                for (int e = 0; e < 33; ++e) a += feats[tt * 34 + e] * f_w1[e * 64 + j];
                h1[tt * 64 + j] = sin_red(f_freq[j] * a);
            }
            __syncthreads();
#pragma unroll 1
            for (int q = 0; q < 2; ++q) {
                const int o = tid + 512 * q, tt = o >> 6, j = o & 63;
                float a = f_b2[j];
#pragma unroll 4
                for (int e = 0; e < 64; ++e) a += h1[tt * 64 + e] * f_w2[e * 64 + j];
                h2[tt * 64 + j] = sin_red(f_freq[j] * a);
            }
            __syncthreads();
#pragma unroll 1
            for (int q = 0; q < 4; ++q) {
                const int n = tid + 512 * q;
                float a[16];
#pragma unroll
                for (int i = 0; i < 16; ++i) a[i] = 0.f;
#pragma unroll 2
                for (int j = 0; j < 64; ++j) {
                    const float w = f_w3[j * 2048 + n];
#pragma unroll
                    for (int i = 0; i < 16; ++i) a[i] += h2[i * 64 + j] * w;
                }
                const float dec = fabsf(f_decay[n]);
                const int order = n >> 10, dir = (n >> 9) & 1, c = n & 511;
                bf16_t* row = GR + (size_t)(order * 512 + c) * (2 * C0);
#pragma unroll
                for (int i = 0; i < 16; ++i) {
                    const int t = t0 + i;
                    const float val = a[i] * __expf(-((float)t * invLm1) * dec);
                    const unsigned short b = (unsigned short)(cvt_pk_bf16(val, 0.f) & 0xffffu);
                    if (dir == 0) row[C0 - t] = b; else if (t > 0) row[C0 + t] = b;
                }
            }
            __syncthreads();
        }
        for (int e = gtid; e < 2 * 1024 * 97; e += gthreads) {
            const int set = e / (1024 * 97), r = (e / 97) % 1024, i = e % 97; const int L = set ? LS : LP; const int C0 = set ? LGS : LGP;
            bf16_t* row = (bf16_t*)(ws + (set ? OFF_GR1 : OFF_GR0)) + (size_t)r * (2 * C0);
            const int idx = i < 49 ? i : C0 + L + (i - 49);
            row[idx] = 0;
        }
    }
#endif
}

__device__ __forceinline__ void rownorm_phase(const Params& p) {
    unsigned char* ws = launder(p.ws); const int gtid = blockIdx.x * 512 + tid_l(), gthreads = gridDim.x * 512;
    const float* sqq = (const float*)(ws + OFF_SQQP); const float* sqkv = (const float*)(ws + OFF_SQKVP);
    float* rq = (float*)(ws + OFF_RQ); float* rkv = (float*)(ws + OFF_RKV);
    for (int r = gtid; r < TPAD; r += gthreads) {
        const float a = (ldco(sqq + r * 4) + ldco(sqq + r * 4 + 1)) + (ldco(sqq + r * 4 + 2) + ldco(sqq + r * 4 + 3));
        const float b = (ldco(sqkv + r * 4) + ldco(sqkv + r * 4 + 1)) + (ldco(sqkv + r * 4 + 2) + ldco(sqkv + r * 4 + 3));
        rq[r] = rsqrtf(a * (1.f / 256.f) + EPS) * QSCALE; rkv[r] = rsqrtf(b * (1.f / 128.f) + EPS);
    }
}
__device__ __forceinline__ void krope_phase(const Params& p) {
    unsigned char* ws = launder(p.ws); unsigned char* ob = launder((unsigned char*)p.out);
    const int gtid = blockIdx.x * 512 + tid_l(), gthreads = gridDim.x * 512;
    const bf16_t* P = (const bf16_t*)(ws + OFF_P); bf16_t* KR = (bf16_t*)(ob + DO_KR); const float2* RT = (const float2*)(ws + OFF_RT);
    for (int e = gtid; e < TPAD * 8; e += gthreads) {
        const int row = e >> 3, ch = e & 7;
        int pos, seq; row_info(row, pos, seq);
        const u32x4 v = *(const u32x4*)(P + (size_t)row * NPP + 384 + ch * 8);
        f32x4 v0 = (f32x4){bflo(v.x), bfhi(v.x), bflo(v.y), bfhi(v.y)}, v1 = (f32x4){bflo(v.z), bfhi(v.z), bflo(v.w), bfhi(v.w)};
        rope8(v0, v1, RT + pos * 32 + ch * 4);
        *(u32x4*)(KR + (size_t)row * 64 + ch * 8) = pack8(v0, v1);
    }
}
__device__ __forceinline__ void hyprep_phase(const Params& p, LAS unsigned char* lds) {
    unsigned char* ws = launder(p.ws); const int tid = tid_l(), G = gridDim.x;
    const bf16_t* P = (const bf16_t*)(ws + OFF_P); const float* conv_w = p.in[9];
    constexpr int RSB = 1040;
    for (int u = blockIdx.x; u < 3096 + 3168; u += G) {
        int seq, j, which;
        if (u < 3096) { seq = u / 387; const int rem = u % 387; j = rem / 3; which = rem % 3; }
        else { const int v = u - 3096; seq = NBP + v / 99; const int rem = v % 99; j = rem / 3; which = rem % 3; }
        const int set = seq < NBP ? 0 : 1; const int L = set ? LS : LP; const int Lg = set ? LGS : LGP; const int NB = set ? NBS : NBP;
        const int b = set ? seq - NBP : seq; const int row0 = set ? TPR + b * LS : b * LP;
        const int posb = 64 * j - 49;
        for (int i = 0; i < 9; ++i) {
            const int id = tid + 512 * i; if (id >= 66 * 64) break;
            const int rr = id >> 6, ch = id & 63; const int pos = posb + rr;
            u32x4 v = (u32x4){0u, 0u, 0u, 0u};
            if (pos >= 0 && pos < L) v = *(const GAS u32x4*)(P + (size_t)(row0 + pos) * NPP + 448 + which * 512 + ch * 8);
            *(LAS u32x4*)(lds + rr * RSB + ch * 16) = v;
        }
        __syncthreads();
        {
            const int c = tid; const float w0 = conv_w[which * 512 + c], w1 = conv_w[1536 + which * 512 + c], w2 = conv_w[3072 + which * 512 + c];
            bf16_t* XT = (bf16_t*)(ws + (which == 0 ? OFF_X1T : (which == 1 ? OFF_X2T : OFF_V0T))) + (set ? XT_SET1 : 0) + ((size_t)c * NB + b) * Lg + 64 * j;
            const LAS unsigned short* tl = (const LAS unsigned short*)lds + c;
            float prev = bf2f(tl[0]), cur = bf2f(tl[RSB / 2]);
            for (int o8 = 0; o8 < 8; ++o8) {
                float r[8];
#pragma unroll
                for (int k = 0; k < 8; ++k) {
                    const int o = o8 * 8 + k; const float nxt = bf2f(tl[(o + 2) * (RSB / 2)]);
                    const int pos = posb + 1 + o;
                    r[k] = (pos >= 0 && pos < L) ? (prev * w0 + cur * w1 + nxt * w2) : 0.f;
                    prev = cur; cur = nxt;
                }
                u32x4 w; w.x = cvt_pk_bf16(r[0], r[1]); w.y = cvt_pk_bf16(r[2], r[3]); w.z = cvt_pk_bf16(r[4], r[5]); w.w = cvt_pk_bf16(r[6], r[7]);
                *(GAS u32x4*)(XT + o8 * 8) = w;
            }
        }
        __syncthreads();
    }
}

__device__ __forceinline__ f32x16 mfma32(bf16x8 a, bf16x8 b, f32x16 c) { return __builtin_amdgcn_mfma_f32_32x32x16_bf16(a, b, c, 0, 0, 0); }

__device__ __forceinline__ void attn_phase(const Params& p, LAS unsigned char* lds) {
    const int tid = tid_l(), lane = tid & 63, wave = tid >> 6, G = gridDim.x, h = lane >> 5, l32 = lane & 31;
    unsigned char* ob = launder((unsigned char*)p.out);
    bf16_t* Q = (bf16_t*)(ob + DO_Q);
    const bf16_t* KN = (const bf16_t*)(ob + DO_KN);
    const bf16_t* KR = (const bf16_t*)(ob + DO_KR);
    const bf16_t* VT = (const bf16_t*)(ob + DO_VT);
    constexpr int KROW = 400, VROW = 136, KBYTES = 64 * KROW, BUFB = KBYTES + 128 * VROW;
    for (int u = blockIdx.x; u < 2048; u += G) {
        int seq, head, qb;
        if (u < 1024) { seq = u >> 7; head = (u >> 5) & 3; qb = u & 31; } else { const int v = u - 1024; seq = NBP + (v >> 5); head = (v >> 3) & 3; qb = v & 7; }
        const int L = seq < NBP ? LP : LS; const int row0 = seq < NBP ? seq * LP : TPR + (seq - NBP) * LS;
        const int ntiles = (L + 63) >> 6;
        const int qrow = row0 + 16 + qb * 256 + wave * 32 + l32;
        bf16x8 qf[12];
#pragma unroll
        for (int ks = 0; ks < 12; ++ks) qf[ks] = *(const GAS bf16x8*)(Q + (size_t)qrow * 768 + head * 192 + 16 * ks + 8 * h);
        {
            const float2* RT = (const float2*)(launder(p.ws) + OFF_RT);
            const int qpos = 16 + qb * 256 + wave * 32 + l32;
#pragma unroll
            for (int ks = 8; ks < 12; ++ks) {
                const u32x4 v = __builtin_bit_cast(u32x4, qf[ks]);
                f32x4 v0 = (f32x4){bflo(v.x), bfhi(v.x), bflo(v.y), bfhi(v.y)}, v1 = (f32x4){bflo(v.z), bfhi(v.z), bflo(v.w), bfhi(v.w)};
                rope8(v0, v1, RT + qpos * 32 + 8 * (ks - 8) + 4 * h);
                qf[ks] = __builtin_bit_cast(bf16x8, pack8(v0, v1));
            }
        }
        const int kkey0 = tid >> 4, kch0 = tid & 15;
        const int rkey = tid >> 3, rch = tid & 7;
        const int vdv0 = tid >> 3, vch = tid & 7;
        const unsigned kn_off = (unsigned)(kkey0 * 512 + head * 128 + kch0 * 8) * 2u;
        const unsigned kr_off = (unsigned)(rkey * 64 + rch * 8) * 2u;
        const unsigned vt_off = (unsigned)(vdv0 * TPAD + vch * 8) * 2u;
        const unsigned char* knb = (const unsigned char*)KN + (size_t)row0 * 1024;
        const unsigned char* krb = (const unsigned char*)KR + (size_t)row0 * 128;
        const unsigned char* vtb = (const unsigned char*)VT + ((size_t)head * 128 * TPAD + row0) * 2;
        u32x4 g0, g1, g2, g3, g4;
#define ATT_LOAD(tile) do { const unsigned char* kb__ = knb + (size_t)(tile) * 65536; const unsigned char* rb__ = krb + (size_t)(tile) * 8192; const unsigned char* vb__ = vtb + (size_t)(tile) * 128; \
        g0 = *(const GAS u32x4*)(kb__ + kn_off); g1 = *(const GAS u32x4*)(kb__ + 32768 + kn_off); \
        g2 = *(const GAS u32x4*)(rb__ + kr_off); (void)vb__; } while (0)
#define ATT_LOADV(tile) do { const unsigned char* vb__ = vtb + (size_t)(tile) * 128; g3 = *(const GAS u32x4*)(vb__ + vt_off); g4 = *(const GAS u32x4*)(vb__ + (size_t)64 * TPAD * 2 + vt_off); } while (0)
#define ATT_STOREK(buf) do { LAS unsigned char* kb_ = lds + (buf) * BUFB; \
        *(LAS u32x4*)(kb_ + kkey0 * KROW + kch0 * 16) = g0; *(LAS u32x4*)(kb_ + (kkey0 + 32) * KROW + kch0 * 16) = g1; \
        *(LAS u32x4*)(kb_ + rkey * KROW + 256 + rch * 16) = g2; } while (0)
#define ATT_STORE(buf) do { LAS unsigned char* vb_ = lds + (buf) * BUFB + KBYTES; \
        *(LAS u32x2*)(vb_ + vdv0 * VROW + vch * 16) = (u32x2){g3.x, g3.y}; *(LAS u32x2*)(vb_ + vdv0 * VROW + vch * 16 + 8) = (u32x2){g3.z, g3.w}; \
        *(LAS u32x2*)(vb_ + (vdv0 + 64) * VROW + vch * 16) = (u32x2){g4.x, g4.y}; *(LAS u32x2*)(vb_ + (vdv0 + 64) * VROW + vch * 16 + 8) = (u32x2){g4.z, g4.w}; } while (0)
        ATT_LOAD(0); ATT_LOADV(0); ATT_STOREK(0); ATT_STORE(0);
        __syncthreads();
        f32x16 o[4];
#pragma unroll
        for (int d = 0; d < 4; ++d)
#pragma unroll
            for (int r = 0; r < 16; ++r) o[d][r] = 0.f;
        float m_run = -INFINITY, l_run = 0.f;
        for (int j = 0; j < ntiles; ++j) {
            const int buf = j & 1;
            if (j + 1 < ntiles) ATT_LOAD(j + 1);
            const LAS unsigned char* kb = lds + buf * BUFB;
            f32x16 s0, s1;
#pragma unroll
            for (int r = 0; r < 16; ++r) { s0[r] = 0.f; s1[r] = 0.f; }
#pragma unroll
            for (int ks = 0; ks < 12; ++ks) {
                const bf16x8 a0 = *(const LAS bf16x8*)(kb + l32 * KROW + ks * 32 + h * 16);
                const bf16x8 a1 = *(const LAS bf16x8*)(kb + (l32 + 32) * KROW + ks * 32 + h * 16);
                s0 = mfma32(a0, qf[ks], s0); s1 = mfma32(a1, qf[ks], s1);
                if ((ks % 3) == 2) __builtin_amdgcn_sched_barrier(0);
            }
            if (j + 1 < ntiles) ATT_STOREK(buf ^ 1);
            const int vc = L - j * 64;
            if (vc < 64) {
                const int vch = vc - 4 * h;
#pragma unroll
                for (int r = 0; r < 16; ++r) {
                    if ((r & 3) + 8 * (r >> 2) >= vch) s0[r] = -INFINITY;
                    if ((r & 3) + 8 * (r >> 2) + 32 >= vch) s1[r] = -INFINITY;
                }
            }
            float mx = fmaxf(s0[0], s1[0]);
#pragma unroll
            for (int r = 1; r < 16; ++r) mx = fmaxf(mx, fmaxf(s0[r], s1[r]));
            mx = fmaxf(mx, __shfl_xor(mx, 32));
            const float m_new = fmaxf(m_run, mx);
            const float alpha = __builtin_amdgcn_exp2f(m_run - m_new);
            m_run = m_new;
            float ls = 0.f;
#pragma unroll
            for (int r = 0; r < 16; ++r) { s0[r] = __builtin_amdgcn_exp2f(s0[r] - m_new); s1[r] = __builtin_amdgcn_exp2f(s1[r] - m_new); ls += s0[r] + s1[r]; }
            l_run = l_run * alpha + ls;
            if (__any(alpha != 1.0f)) {
#pragma unroll
                for (int d = 0; d < 4; ++d)
#pragma unroll
                    for (int r = 0; r < 16; ++r) o[d][r] *= alpha;
            }
            bf16x8 pb[4];
            {
                u32x4 w;
                w.x = cvt_pk_bf16(s0[0], s0[1]); w.y = cvt_pk_bf16(s0[2], s0[3]); w.z = cvt_pk_bf16(s0[4], s0[5]); w.w = cvt_pk_bf16(s0[6], s0[7]); pb[0] = __builtin_bit_cast(bf16x8, w);
                w.x = cvt_pk_bf16(s0[8], s0[9]); w.y = cvt_pk_bf16(s0[10], s0[11]); w.z = cvt_pk_bf16(s0[12], s0[13]); w.w = cvt_pk_bf16(s0[14], s0[15]); pb[1] = __builtin_bit_cast(bf16x8, w);
                w.x = cvt_pk_bf16(s1[0], s1[1]); w.y = cvt_pk_bf16(s1[2], s1[3]); w.z = cvt_pk_bf16(s1[4], s1[5]); w.w = cvt_pk_bf16(s1[6], s1[7]); pb[2] = __builtin_bit_cast(bf16x8, w);
                w.x = cvt_pk_bf16(s1[8], s1[9]); w.y = cvt_pk_bf16(s1[10], s1[11]); w.z = cvt_pk_bf16(s1[12], s1[13]); w.w = cvt_pk_bf16(s1[14], s1[15]); pb[3] = __builtin_bit_cast(bf16x8, w);
            }
            if (j + 1 < ntiles) ATT_LOADV(j + 1);
            const LAS unsigned char* vb = kb + KBYTES;
#pragma unroll
            for (int d = 0; d < 4; ++d)
#pragma unroll
                for (int ks = 0; ks < 4; ++ks) {
                    const LAS unsigned char* ap = vb + (d * 32 + l32) * VROW + (16 * ks + 4 * h) * 2;
                    const u32x2 lo = *(const LAS u32x2*)ap, hi = *(const LAS u32x2*)(ap + 16);
                    const u32x4 w = (u32x4){lo.x, lo.y, hi.x, hi.y};
                    o[d] = mfma32(__builtin_bit_cast(bf16x8, w), pb[ks], o[d]);
                    if (ks == 3) __builtin_amdgcn_sched_barrier(0);
                }
            if (j + 1 < ntiles) ATT_STORE(buf ^ 1);
            __syncthreads();
        }
        l_run += __shfl_xor(l_run, 32);
        const float inv = 1.0f / l_run;
#if DEBUG_CHECK == 5
        bf16_t* orow = (bf16_t*)(launder(p.ws) + OFF_ODBG) + (size_t)qrow * 512 + head * 128;
#else
        bf16_t* orow = Q + (size_t)qrow * 768 + head * 192;
#endif
#pragma unroll
        for (int d = 0; d < 4; ++d)
#pragma unroll
            for (int rq = 0; rq < 4; ++rq) {
                const u32x2 w = (u32x2){cvt_pk_bf16(o[d][4 * rq] * inv, o[d][4 * rq + 1] * inv), cvt_pk_bf16(o[d][4 * rq + 2] * inv, o[d][4 * rq + 3] * inv)};
                *(GAS u32x2*)(orow + 32 * d + 8 * rq + 4 * h) = w;
            }
#undef ATT_LOAD
#undef ATT_LOADV
#undef ATT_STORE
#undef ATT_STOREK
    }
}

template <int SET> __device__ __forceinline__ void hyena_unit(const Params& p, LAS unsigned char* lds, int c, int bg) {
    constexpr int P = SET ? 32 : 128;
    constexpr int NBU = SET ? 16 : 4;
    constexpr int NBT = SET ? 8 : 2;
    constexpr int GP = SET ? 4 : 16;
    constexpr int LG = SET ? LGS : LGP;
    constexpr int NB = SET ? NBS : NBP;
    constexpr int RS = SET ? 4896 : 18816;
    constexpr int GBYTES = 2 * LG * 2;
    constexpr int G1OFF = 33220;
    constexpr int ZOFF = 66560;
    unsigned char* ws = launder(p.ws);
    const int tid = tid_l(), lane = tid & 63, wave = tid >> 6, h = lane >> 5, l32 = lane & 31;
    const bf16_t* X1T = (const bf16_t*)(ws + OFF_X1T) + (SET ? XT_SET1 : 0);
    bf16_t* X2T = (bf16_t*)(ws + OFF_X2T) + (SET ? XT_SET1 : 0);
    const bf16_t* V0T = (const bf16_t*)(ws + OFF_V0T) + (SET ? XT_SET1 : 0);
    const bf16_t* GR = (const bf16_t*)(ws + (SET ? OFF_GR1 : OFF_GR0));
    const float* hy_bias = launder(p.in[17]);
    LAS unsigned char* gL = lds; LAS unsigned char* zL = lds + ZOFF;
    const size_t rowbase = ((size_t)c * NB + bg * NBU) * LG;
    for (int id = tid; id < NBU * (P + 1) * 8; id += 512) {
        const int bl = id / ((P + 1) * 8), rem = id % ((P + 1) * 8), blk = rem >> 3, ch = rem & 7;
        *(LAS u32x4*)(zL + bl * RS + blk * 144 + ch * 16) = *(const GAS u32x4*)(V0T + rowbase + (size_t)bl * LG + blk * 64 + ch * 8);
    }
    for (int id = tid; id < NBU * 9; id += 512) { const int bl = id / 9, ch = id % 9; *(LAS u32x4*)(zL + bl * RS + (P + 1) * 144 + ch * 16) = (u32x4){0u, 0u, 0u, 0u}; }
#define HY_LOADG(rowidx) do { const unsigned* g32_ = (const unsigned*)(GR + (size_t)(rowidx) * (2 * LG)); \
        for (int id = tid; id < GBYTES / 4; id += 512) { const unsigned a_ = g32_[id], b_ = (id + 1 < GBYTES / 4) ? g32_[id + 1] : 0u; \
            *(LAS unsigned*)(gL + id * 4) = a_; *(LAS unsigned*)(gL + G1OFF + id * 4) = (a_ >> 16) | (b_ << 16); } } while (0)
    HY_LOADG(c);
    __syncthreads();
    const LAS unsigned short* g16 = (const LAS unsigned short*)gL;
    constexpr int PARTS = 512 / (NBU * 16);
    float zmeta = 0.f; int mo_bl, mo_m;
    {
        const int part = tid % PARTS, out = tid / PARTS; mo_bl = out >> 4; mo_m = out & 15;
        const LAS unsigned char* zr = zL + mo_bl * RS;
        float a = 0.f;
        for (int tt = 48 + part; tt < LG; tt += PARTS) {
            const float zv = bf2f(*(const LAS unsigned short*)(zr + (tt >> 6) * 144 + (tt & 63) * 2));
            const float gv = bf2f(g16[LG - mo_m - 48 + tt]);
            a += zv * gv;
        }
#pragma unroll
        for (int o = 1; o < PARTS; o <<= 1) a += __shfl_xor(a, o);
        const float bias0 = hy_bias[c];
        const float z0 = bf2f(*(const LAS unsigned short*)(zr + (48 + mo_m) * 2));
        const float x1 = bf2f(X1T[rowbase + (size_t)mo_bl * LG + 48 + mo_m]);
        zmeta = x1 * (a + z0 * bias0);
    }
    const int p0 = GP * wave;
    const int pp = l32 / NBT, blA = l32 % NBT, blB = NBT + blA;
#pragma unroll 1
    for (int order = 0; order < 2; ++order) {
        f32x16 acc[2][2];
#pragma unroll
        for (int a = 0; a < 2; ++a)
#pragma unroll
            for (int b = 0; b < 2; ++b)
#pragma unroll
                for (int r = 0; r < 16; ++r) acc[a][b][r] = 0.f;
        bf16x8 Ep4, Ep5;
        {
            const int d0 = p0 - (P - 1); const int ib0 = LG - 64 * d0 - l32 + 8 * h;
            const LAS unsigned char* g0 = gL + (l32 & 1) * G1OFF + (ib0 >> 1) * 4;
            const LAS unsigned* ga = (const LAS unsigned*)(g0 + 96); const LAS unsigned* gb = (const LAS unsigned*)(g0 + 64);
            Ep4 = __builtin_bit_cast(bf16x8, (u32x4){ga[0], ga[1], ga[2], ga[3]}); Ep5 = __builtin_bit_cast(bf16x8, (u32x4){gb[0], gb[1], gb[2], gb[3]});
        }
#pragma unroll 1
        for (int d = p0 - (P - 1); d <= p0 + GP; ++d) {
            bf16x8 E[6];
            const int ib = LG - 64 * d - l32 + 8 * h;
            const LAS unsigned char* gpl = gL + (l32 & 1) * G1OFF + (ib >> 1) * 4;
            E[0] = Ep4; E[1] = Ep5;
#pragma unroll
            for (int e = 2; e < 6; ++e) {
                const LAS unsigned* gp = (const LAS unsigned*)(gpl - 32 * (e - 3));
                const u32x4 w = (u32x4){gp[0], gp[1], gp[2], gp[3]};
                E[e] = __builtin_bit_cast(bf16x8, w);
            }
            Ep4 = E[4]; Ep5 = E[5];
            const int q = p0 + pp - d;
            const int slot = ((unsigned)(q + 1) <= (unsigned)P) ? q + 1 : P + 1;
            const LAS unsigned char* zA = zL + blA * RS + slot * 144 + h * 16;
            const LAS unsigned char* zB = zL + blB * RS + slot * 144 + h * 16;
#pragma unroll
            for (int ks = 0; ks < 4; ++ks) {
                const bf16x8 ba = *(const LAS bf16x8*)(zA + ks * 32);
                const bf16x8 bb = *(const LAS bf16x8*)(zB + ks * 32);
#pragma unroll
                for (int m = 0; m < 2; ++m) {
                    acc[0][m] = mfma32(E[2 * m - ks + 3], ba, acc[0][m]);
                    acc[1][m] = mfma32(E[2 * m - ks + 3], bb, acc[1][m]);
                }
            }
        }
        __syncthreads();
        const float bias = hy_bias[order * 512 + c];
#pragma unroll
        for (int tl = 0; tl < 2; ++tl) {
            const int bl = tl ? blB : blA;
            const size_t grow = rowbase + (size_t)bl * LG + 64 * (p0 + pp + 1);
            LAS unsigned char* zr = zL + bl * RS + (p0 + pp + 1) * 144;
#pragma unroll
            for (int m = 0; m < 2; ++m)
#pragma unroll
                for (int rq = 0; rq < 4; ++rq) {
                    const int off = 32 * m + 8 * rq + 4 * h;
                    const u32x2 zw = *(const LAS u32x2*)(zr + off * 2);
                    const u32x2 xw = *(const GAS u32x2*)((order ? (const bf16_t*)X2T : X1T) + grow + off);
                    const float y0 = acc[tl][m][4 * rq], y1 = acc[tl][m][4 * rq + 1], y2 = acc[tl][m][4 * rq + 2], y3 = acc[tl][m][4 * rq + 3];
                    const float r0 = bflo(xw.x) * (y0 + bflo(zw.x) * bias), r1 = bfhi(xw.x) * (y1 + bfhi(zw.x) * bias);
                    const float r2 = bflo(xw.y) * (y2 + bflo(zw.y) * bias), r3 = bfhi(xw.y) * (y3 + bfhi(zw.y) * bias);
                    const u32x2 w = (u32x2){cvt_pk_bf16(r0, r1), cvt_pk_bf16(r2, r3)};
#if DEBUG_CHECK == 5
                    if (order == 0) *(LAS u32x2*)(zr + off * 2) = w; else *(GAS u32x2*)((bf16_t*)(ws + OFF_HDBG) + (SET ? XT_SET1 : 0) + grow + off) = w;
#else
                    if (order == 0) *(LAS u32x2*)(zr + off * 2) = w; else *(GAS u32x2*)(X2T + grow + off) = w;
#endif
                }
        }
        if (order == 0) {
            if ((tid % PARTS) == 0) *(LAS unsigned short*)(zL + mo_bl * RS + (48 + mo_m) * 2) = (unsigned short)(cvt_pk_bf16(zmeta, 0.f) & 0xffffu);
            HY_LOADG(512 + c);
        }
        __syncthreads();
    }
}
#undef HY_LOADG
__device__ __forceinline__ void hyena_phase(const Params& p, LAS unsigned char* lds) {
    for (int u = blockIdx.x; u < 2048; u += gridDim.x) {
        if (u < 1024) hyena_unit<0>(p, lds, u >> 1, u & 1); else hyena_unit<1>(p, lds, (u - 1024) >> 1, u & 1);
    }
}

__device__ __forceinline__ void mixnorm_phase(const Params& p, LAS unsigned char* lds) {
    unsigned char* ws = launder(p.ws); const int tid = tid_l(), lane = tid & 63, wave = tid >> 6, G = gridDim.x;
    const bf16_t* Q = (const bf16_t*)(launder((unsigned char*)p.out) + DO_Q);
    bf16_t* MIXN = (bf16_t*)(ws + OFF_MIXN);
    const float* ga = launder(p.in[18]); const float* gh = launder(p.in[19]);
    constexpr int RSB = 1040;
    for (int u = blockIdx.x; u < 2048; u += G) {
        const int n0 = u * 64;
        int set, b, tok0;
        if (n0 < 65536) { set = 0; b = n0 >> 13; tok0 = n0 & 8191; } else { set = 1; const int q = n0 - 65536; b = q >> 11; tok0 = q & 2047; }
        const int Lg = set ? LGS : LGP, NB = set ? NBS : NBP;
        {
            const int c = tid;
#if DEBUG_CHECK == 5
            const bf16_t* src = (const bf16_t*)(ws + OFF_HDBG) + (set ? XT_SET1 : 0) + ((size_t)c * NB + b) * Lg + tok0 + 64;
#else
            const bf16_t* src = (const bf16_t*)(ws + OFF_X2T) + (set ? XT_SET1 : 0) + ((size_t)c * NB + b) * Lg + tok0 + 64;
#endif
            LAS unsigned short* tl = (LAS unsigned short*)lds + c;
#pragma unroll
            for (int k8 = 0; k8 < 8; ++k8) {
                const u32x4 v = *(const GAS u32x4*)(src + k8 * 8);
                tl[(k8 * 8 + 0) * (RSB / 2)] = (unsigned short)(v.x & 0xffffu); tl[(k8 * 8 + 1) * (RSB / 2)] = (unsigned short)(v.x >> 16);
                tl[(k8 * 8 + 2) * (RSB / 2)] = (unsigned short)(v.y & 0xffffu); tl[(k8 * 8 + 3) * (RSB / 2)] = (unsigned short)(v.y >> 16);
                tl[(k8 * 8 + 4) * (RSB / 2)] = (unsigned short)(v.z & 0xffffu); tl[(k8 * 8 + 5) * (RSB / 2)] = (unsigned short)(v.z >> 16);
                tl[(k8 * 8 + 6) * (RSB / 2)] = (unsigned short)(v.w & 0xffffu); tl[(k8 * 8 + 7) * (RSB / 2)] = (unsigned short)(v.w >> 16);
            }
        }
        __syncthreads();
        for (int i = 0; i < 8; ++i) {
            const int rr = wave + 8 * i; const int n = n0 + rr; const int r = full_row(n);
            const u32x4 hv = *(const LAS u32x4*)(lds + rr * RSB + lane * 16);
#if DEBUG_CHECK == 5
            const u32x4 av = *(const GAS u32x4*)((const bf16_t*)(ws + OFF_ODBG) + (size_t)r * 512 + lane * 8);
#else
            const u32x4 av = *(const GAS u32x4*)(Q + (size_t)r * 768 + (lane >> 4) * 192 + (lane & 15) * 8);
#endif
            float hf[8] = {bflo(hv.x), bfhi(hv.x), bflo(hv.y), bfhi(hv.y), bflo(hv.z), bfhi(hv.z), bflo(hv.w), bfhi(hv.w)};
            float af[8] = {bflo(av.x), bfhi(av.x), bflo(av.y), bfhi(av.y), bflo(av.z), bfhi(av.z), bflo(av.w), bfhi(av.w)};
            float sh = 0.f, sa = 0.f;
#pragma unroll
            for (int k = 0; k < 8; ++k) { sh += hf[k] * hf[k]; sa += af[k] * af[k]; }
            sh = wave_sum(sh); sa = wave_sum(sa);
            const float rh = rsqrtf(sh * (1.f / 512.f) + EPS), ra = rsqrtf(sa * (1.f / 512.f) + EPS);
            const f32x4 ga0 = *(const GAS f32x4*)(ga + lane * 8), ga1 = *(const GAS f32x4*)(ga + lane * 8 + 4);
            const f32x4 gh0 = *(const GAS f32x4*)(gh + lane * 8), gh1 = *(const GAS f32x4*)(gh + lane * 8 + 4);
            u32x4 wa, wh;
            wa.x = cvt_pk_bf16(af[0] * ra * ga0[0], af[1] * ra * ga0[1]); wa.y = cvt_pk_bf16(af[2] * ra * ga0[2], af[3] * ra * ga0[3]);
            wa.z = cvt_pk_bf16(af[4] * ra * ga1[0], af[5] * ra * ga1[1]); wa.w = cvt_pk_bf16(af[6] * ra * ga1[2], af[7] * ra * ga1[3]);
            wh.x = cvt_pk_bf16(hf[0] * rh * gh0[0], hf[1] * rh * gh0[1]); wh.y = cvt_pk_bf16(hf[2] * rh * gh0[2], hf[3] * rh * gh0[3]);
            wh.z = cvt_pk_bf16(hf[4] * rh * gh1[0], hf[5] * rh * gh1[1]); wh.w = cvt_pk_bf16(hf[6] * rh * gh1[2], hf[7] * rh * gh1[3]);
#if EXPT == 1
            wa = (u32x4){0u, 0u, 0u, 0u};
#endif
#if EXPT == 2
            wh = (u32x4){0u, 0u, 0u, 0u};
#endif
            *(GAS u32x4*)(MIXN + (size_t)n * 1024 + lane * 8) = wa;
            *(GAS u32x4*)(MIXN + (size_t)n * 1024 + 512 + lane * 8) = wh;
        }
        __syncthreads();
    }
}

__device__ __forceinline__ void h1_phase(const Params& p) {
    unsigned char* ws = launder(p.ws); const int tid = tid_l(), lane = tid & 63, wave = tid >> 6;
    const int gw = blockIdx.x * 8 + wave, NGW = gridDim.x * 8;
    const bf16_t* MIX = (const bf16_t*)(ws + OFF_MIX); bf16_t* H1B = (bf16_t*)(ws + OFF_H1B);
    const float* sqmix = (const float*)(ws + OFF_SQMIXP); float* r1 = (float*)(ws + OFF_R1); const float* g = p.in[21];
    for (int n = gw; n < TN; n += NGW) {
        const float* xrow = n < 65536 ? p.in[0] + (size_t)n * 1024 : p.in[1] + (size_t)(n - 65536) * 1024;
        const float rm = rsqrtf(wave_sum(lane < 16 ? ldco(sqmix + (size_t)n * 16 + lane) : 0.f) * (1.f / 1024.f) + EPS);
        float ss = 0.f;
#pragma unroll
        for (int hh = 0; hh < 2; ++hh) {
            const int c0 = hh * 512 + lane * 8;
            const u32x4 mv = *(const u32x4*)(MIX + (size_t)n * 1024 + c0);
            const f32x4 x0 = *(const f32x4*)(xrow + c0), x1 = *(const f32x4*)(xrow + c0 + 4);
            const f32x4 g0 = *(const f32x4*)(g + c0), g1 = *(const f32x4*)(g + c0 + 4);
            f32x4 h0, h1;
            h0[0] = x0[0] + bflo(mv.x) * rm * g0[0]; h0[1] = x0[1] + bfhi(mv.x) * rm * g0[1]; h0[2] = x0[2] + bflo(mv.y) * rm * g0[2]; h0[3] = x0[3] + bfhi(mv.y) * rm * g0[3];
            h1[0] = x1[0] + bflo(mv.z) * rm * g1[0]; h1[1] = x1[1] + bfhi(mv.z) * rm * g1[1]; h1[2] = x1[2] + bflo(mv.w) * rm * g1[2]; h1[3] = x1[3] + bfhi(mv.w) * rm * g1[3];
            ss += sq8(h0, h1);
            *(f32x4*)(p.out + (size_t)n * 1024 + c0) = h0; *(f32x4*)(p.out + (size_t)n * 1024 + c0 + 4) = h1;
            *(u32x4*)(H1B + (size_t)n * 1024 + c0) = pack8(h0, h1);
        }
        ss = wave_sum(ss);
        if (lane == 0) r1[n] = rsqrtf(ss * (1.f / 1024.f) + EPS);
    }
}
__device__ __forceinline__ void final_phase(const Params& p, int half) {
    unsigned char* ws = launder(p.ws); const int tid = tid_l(), lane = tid & 63, wave = tid >> 6;
    const int gw = blockIdx.x * 8 + wave, NGW = gridDim.x * 8;
    const bf16_t* M2 = (const bf16_t*)(ws + OFF_M2); const float* sqm2 = (const float*)(ws + OFF_SQM2P); const float* g = p.in[25];
    float dbg_off = 0.f, dbg_one = 0.f;
#if DEBUG_CHECK
    { const unsigned* dc = (const unsigned*)(ws + OFF_DBGW); dbg_off = 100.f * (float)dc[8] * (1.f / 131072.f); dbg_one = 1000.f * (float)dc[9] * (1.f / 131072.f); }
#endif
    for (int i = gw; i < 65536; i += NGW) {
        const int n = half * 65536 + i;
        const float rm = rsqrtf(wave_sum(lane < 16 ? ldco(sqm2 + (size_t)n * 16 + lane) : 0.f) * (1.f / 1024.f) + EPS);
#pragma unroll
        for (int hh = 0; hh < 2; ++hh) {
            const int c0 = hh * 512 + lane * 8;
            const u32x4 mv = *(const u32x4*)(M2 + (size_t)i * 1024 + c0);
            f32x4 h0 = *(const f32x4*)(p.out + (size_t)n * 1024 + c0), h1 = *(const f32x4*)(p.out + (size_t)n * 1024 + c0 + 4);
            const f32x4 g0 = *(const f32x4*)(g + c0), g1 = *(const f32x4*)(g + c0 + 4);
            h0 += dbg_off; h1 += dbg_off; if (n == 0 && c0 == 0) h0[0] += dbg_one;
            h0[0] += bflo(mv.x) * rm * g0[0]; h0[1] += bfhi(mv.x) * rm * g0[1]; h0[2] += bflo(mv.y) * rm * g0[2]; h0[3] += bfhi(mv.y) * rm * g0[3];
            h1[0] += bflo(mv.z) * rm * g1[0]; h1[1] += bfhi(mv.z) * rm * g1[1]; h1[2] += bflo(mv.w) * rm * g1[2]; h1[3] += bfhi(mv.w) * rm * g1[3];
            *(f32x4*)(p.out + (size_t)n * 1024 + c0) = h0; *(f32x4*)(p.out + (size_t)n * 1024 + c0 + 4) = h1;
        }
    }
}


#if DEBUG_CHECK
constexpr size_t OFF_DBG = OFF_DBGW;
__device__ __forceinline__ void check_gemm(const bf16_t* A, int lda, const bf16_t* Bt, int ldb, int K, int M, int N, int mode, const bf16_t* O, int ldc, const float* rs, unsigned* cnt, int col_lo) {
    const unsigned idx = blockIdx.x * 512u + (unsigned)tid_l();
    unsigned hsh = idx * 2654435761u + 12345u + (unsigned)mode * 977u; hsh ^= hsh >> 15; hsh *= 2246822519u; hsh ^= hsh >> 13;
    const int row = (int)(hsh % (unsigned)M); hsh = hsh * 3266489917u + 668265263u; hsh ^= hsh >> 16;
    const int col = col_lo + (int)(hsh % (unsigned)(N - col_lo));
    float d = 0.f;
    for (int k = 0; k < K; ++k) d += bf2f(A[(size_t)row * lda + k]) * bf2f(Bt[(size_t)col * ldb + k]);
    float e = d;
    if (mode == 0 || mode == 7) e = d * rs[row];
    if (mode == 5) { const float t = fmaxf(d * rs[row], 0.f); e = t * t; }
    const float st = bf2f(O[(size_t)row * ldc + col]);
    if (!(fabsf(st - e) <= 0.03f * fabsf(e) + 0.03f)) atomicAdd(cnt, 1u);
}
#endif

#if DEBUG_CHECK == 2
__device__ __forceinline__ void check_proj(const Params& p) {
    unsigned char* ws = launder(p.ws); unsigned char* ob = launder((unsigned char*)p.out);
    const bf16_t* P = (const bf16_t*)(ws + OFF_P); unsigned* cnt = (unsigned*)(ws + OFF_DBG);
    const unsigned idx = blockIdx.x * 512u + (unsigned)tid_l();
    unsigned hsh = idx * 2654435761u + 777u; hsh ^= hsh >> 15; hsh *= 2246822519u; hsh ^= hsh >> 13;
    const int row = (int)(hsh % (unsigned)T); hsh = hsh * 3266489917u + 668265263u; hsh ^= hsh >> 16;
    int pos, seq; row_info(row, pos, seq);
    {
        const int n = (int)(hsh % 768u); const int hh = n / 192, w = n % 192;
        float ss = 0.f, x1 = 0.f, x2 = 0.f; const float* W = p.in[6]; const float* g = p.in[5];
        const int j = w - 128, i = j >> 1;
        const int c1 = w < 128 ? hh * 192 + w : hh * 192 + 128 + i, c2 = hh * 192 + 160 + (w < 128 ? 0 : i);
        for (int k = 0; k < 256; ++k) { const float a = bf2f(P[(size_t)row * NPP + k]); ss += a * a; x1 += a * g[k] * W[k * 768 + c1]; x2 += a * g[k] * W[k * 768 + c2]; }
        const float rq = rsqrtf(ss * (1.f / 256.f) + EPS) * QSCALE; x1 *= rq; x2 *= rq;
        float e = x1;
        if (w >= 128) { const float inv = 1.0f / exp2f((float)i * (13.287712379549449f / 32.f)); float sn, cs; sincos_red((float)pos * inv, sn, cs); e = (j & 1) ? x2 * cs + x1 * sn : x1 * cs - x2 * sn; }
        const float st = bf2f(((const bf16_t*)(ob + DO_Q))[(size_t)row * 768 + n]);
        if (!(fabsf(st - e) <= 0.03f * fabsf(e) + 0.01f)) atomicAdd(cnt + (w < 128 ? 0 : 4), 1u);
    }
    {
        const int n = (int)((hsh >> 3) % 512u); const int hh = n >> 7, i = n & 127;
        float ss = 0.f, x1 = 0.f, x2 = 0.f; const float* W = p.in[8]; const float* g = p.in[7];
        for (int k = 0; k < 128; ++k) { const float a = bf2f(P[(size_t)row * NPP + 256 + k]); ss += a * a; x1 += a * g[k] * W[k * 1024 + hh * 256 + i]; x2 += a * g[k] * W[k * 1024 + hh * 256 + 128 + i]; }
        const float rk = rsqrtf(ss * (1.f / 128.f) + EPS); x1 *= rk; x2 *= rk;
        const float s1 = bf2f(((const bf16_t*)(ob + DO_KN))[(size_t)row * 512 + n]);
        const float s2 = bf2f(((const bf16_t*)(ob + DO_VT))[(size_t)n * TPAD + row]);
        if (!(fabsf(s1 - x1) <= 0.03f * fabsf(x1) + 0.03f)) atomicAdd(cnt + 1, 1u);
        if (!(fabsf(s2 - x2) <= 0.03f * fabsf(x2) + 0.03f)) atomicAdd(cnt + 2, 1u);
    }
    {
        const int jj = (int)((hsh >> 5) % 64u); const int i = jj >> 1;
        const float* xr = pos < 16 ? p.in[2] + (size_t)pos * 1024 : (seq < NBP ? p.in[0] + ((size_t)seq * 8192 + (pos - 16)) * 1024 : p.in[1] + ((size_t)(seq - NBP) * 2048 + (pos - 16)) * 1024);
        const float* W = p.in[4]; const float* g = p.in[3]; float x1 = 0.f, x2 = 0.f;
        for (int k = 0; k < 1024; ++k) { const float a = xr[k] * g[k]; x1 += a * W[(size_t)k * 1984 + 384 + i]; x2 += a * W[(size_t)k * 1984 + 416 + i]; }
        const float r0 = ((const float*)(ws + OFF_R0))[row]; x1 *= r0; x2 *= r0;
        const float inv = 1.0f / exp2f((float)i * (13.287712379549449f / 32.f)); float sn, cs; sincos_red((float)pos * inv, sn, cs);
        const float e = (jj & 1) ? x2 * cs + x1 * sn : x1 * cs - x2 * sn;
        const float st = bf2f(((const bf16_t*)(ob + DO_KR))[(size_t)row * 64 + jj]);
        if (!(fabsf(st - e) <= 0.03f * fabsf(e) + 0.03f)) { atomicAdd(cnt + 3, 1u); atomicAdd(cnt + 5, (unsigned)i); atomicAdd(cnt + 6, (unsigned)(pos >> 3)); }
    }
}
#endif

#if DEBUG_CHECK == 3
__device__ __forceinline__ void check_h0b(const Params& p, int slot) {
    unsigned char* ws = launder(p.ws); unsigned* cnt = (unsigned*)(ws + OFF_DBGW);
    const bf16_t* h0b = (const bf16_t*)(ws + OFF_H0B);
    const unsigned idx = blockIdx.x * 512u + (unsigned)tid_l();
    unsigned hsh = idx * 2654435761u + 4242u + (unsigned)slot * 31u; hsh ^= hsh >> 15; hsh *= 2246822519u; hsh ^= hsh >> 13;
    const int row = (int)(hsh % (unsigned)T); hsh = hsh * 3266489917u + 668265263u; hsh ^= hsh >> 16;
    const int col = (int)(hsh % 1024u);
    int pos, seq; row_info(row, pos, seq);
    const float* xr = pos < 16 ? p.in[2] + (size_t)pos * 1024 : (seq < NBP ? p.in[0] + ((size_t)seq * 8192 + (pos - 16)) * 1024 : p.in[1] + ((size_t)(seq - NBP) * 2048 + (pos - 16)) * 1024);
    const float e = xr[col]; const float st = bf2f(h0b[(size_t)row * 1024 + col]);
    if (!(fabsf(st - e) <= 0.01f * fabsf(e) + 0.001f)) atomicAdd(cnt + slot, 1u);
}
#endif

#if DEBUG_CHECK == 4
__device__ __forceinline__ void check_stale(const Params& p, const unsigned* base, unsigned ndw, int slot) {
    unsigned* cnt = (unsigned*)(launder(p.ws) + OFF_DBGW);
    const unsigned idx = blockIdx.x * 512u + (unsigned)tid_l();
    unsigned hsh = idx * 2654435761u + 999u + (unsigned)slot * 131u; hsh ^= hsh >> 15; hsh *= 2246822519u; hsh ^= hsh >> 13;
#pragma unroll 1
    for (int it = 0; it < 16; ++it) {
        hsh = hsh * 3266489917u + 668265263u; hsh ^= hsh >> 16;
        const unsigned i = hsh % ndw;
        const unsigned a = base[i];
        const unsigned b = __hip_atomic_load(base + i, __ATOMIC_RELAXED, __HIP_MEMORY_SCOPE_AGENT);
        if (a != b) atomicAdd(cnt + slot, 1u);
    }
}
#endif

#if DEBUG_CHECK == 5
__device__ __forceinline__ void check_attn(const Params& p) {
    unsigned char* ws = launder(p.ws); unsigned char* ob = launder((unsigned char*)p.out); unsigned* cnt = (unsigned*)(ws + OFF_DBGW);
    const int tid = tid_l(), lane = tid & 63, wave = tid >> 6;
    const bf16_t* Q = (const bf16_t*)(ob + DO_Q); const bf16_t* KN = (const bf16_t*)(ob + DO_KN); const bf16_t* KR = (const bf16_t*)(ob + DO_KR); const bf16_t* VT = (const bf16_t*)(ob + DO_VT);
    const bf16_t* OD = (const bf16_t*)(ws + OFF_ODBG); const float2* RT = (const float2*)(ws + OFF_RT);
    unsigned hsh = (unsigned)(blockIdx.x * 8 + wave) * 2654435761u + 31337u; hsh ^= hsh >> 15; hsh *= 2246822519u; hsh ^= hsh >> 13;
    const int n = (int)(hsh % (unsigned)TN); const int head = (int)((hsh >> 20) & 3u); const int r = full_row(n);
    int pos, seq; row_info(r, pos, seq);
    const int L = seq < NBP ? LP : LS; const int row0 = r - pos;
    const bf16_t* qp = Q + (size_t)r * 768 + head * 192;
    float mx = -INFINITY;
    for (int k = lane; k < L; k += 64) {
        float sdot = 0.f;
        for (int d = 0; d < 128; ++d) sdot += bf2f(qp[d]) * bf2f(KN[(size_t)(row0 + k) * 512 + head * 128 + d]);
        for (int i = 0; i < 32; ++i) { const float2 cs = ldco2(RT + pos * 32 + i); const float a = bf2f(qp[128 + 2 * i]), b = bf2f(qp[129 + 2 * i]);
            sdot += (a * cs.x - b * cs.y) * bf2f(KR[(size_t)(row0 + k) * 64 + 2 * i]) + (b * cs.x + a * cs.y) * bf2f(KR[(size_t)(row0 + k) * 64 + 2 * i + 1]); }
        mx = fmaxf(mx, sdot);
    }
#pragma unroll
    for (int o = 1; o < 64; o <<= 1) mx = fmaxf(mx, __shfl_xor(mx, o));
    float sw = 0.f, o0 = 0.f, o1 = 0.f; const int dv0 = (int)((hsh >> 8) & 127u), dv1 = (dv0 + 37) & 127;
    for (int k = lane; k < L; k += 64) {
        float sdot = 0.f;
        for (int d = 0; d < 128; ++d) sdot += bf2f(qp[d]) * bf2f(KN[(size_t)(row0 + k) * 512 + head * 128 + d]);
        for (int i = 0; i < 32; ++i) { const float2 cs = ldco2(RT + pos * 32 + i); const float a = bf2f(qp[128 + 2 * i]), b = bf2f(qp[129 + 2 * i]);
            sdot += (a * cs.x - b * cs.y) * bf2f(KR[(size_t)(row0 + k) * 64 + 2 * i]) + (b * cs.x + a * cs.y) * bf2f(KR[(size_t)(row0 + k) * 64 + 2 * i + 1]); }
        const float w = exp2f(sdot - mx); sw += w;
        o0 += w * bf2f(VT[(size_t)(head * 128 + dv0) * TPAD + row0 + k]); o1 += w * bf2f(VT[(size_t)(head * 128 + dv1) * TPAD + row0 + k]);
    }
    sw = wave_sum(sw); o0 = wave_sum(o0) / sw; o1 = wave_sum(o1) / sw;
    if (lane == 0) {
        const float s0 = bf2f(OD[(size_t)r * 512 + head * 128 + dv0]), s1 = bf2f(OD[(size_t)r * 512 + head * 128 + dv1]);
        atomicAdd(cnt + 10, 2u);
        if (!(fabsf(s0 - o0) <= 0.05f * fabsf(o0) + 0.002f)) atomicAdd(cnt + 8, 1u);
        if (!(fabsf(s1 - o1) <= 0.05f * fabsf(o1) + 0.002f)) atomicAdd(cnt + 8, 1u);
    }
}
__device__ __forceinline__ void check_hyena(const Params& p, LAS unsigned char* lds) {
    unsigned char* ws = launder(p.ws); unsigned* cnt = (unsigned*)(ws + OFF_DBGW);
    const int tid = tid_l();
    unsigned hsh = (unsigned)blockIdx.x * 2654435761u + 555u; hsh ^= hsh >> 15; hsh *= 2246822519u; hsh ^= hsh >> 13;
    const int set = (int)(blockIdx.x & 1u); const int c = (int)(hsh % 512u); const int NB = set ? NBS : NBP; const int b = (int)((hsh >> 12) % (unsigned)NB);
    const int LG = set ? LGS : LGP;
    const size_t base = (set ? XT_SET1 : 0) + ((size_t)c * NB + b) * LG;
    const bf16_t* X1 = (const bf16_t*)(ws + OFF_X1T) + base; const bf16_t* X2 = (const bf16_t*)(ws + OFF_X2T) + base; const bf16_t* V0 = (const bf16_t*)(ws + OFF_V0T) + base;
    const bf16_t* HD = (const bf16_t*)(ws + OFF_HDBG) + base;
    const bf16_t* G0 = (const bf16_t*)(ws + (set ? OFF_GR1 : OFF_GR0)) + (size_t)c * (2 * LG); const bf16_t* G1 = G0 + (size_t)512 * (2 * LG);
    const float bias0 = p.in[17][c], bias1 = p.in[17][512 + c];
    LAS float* z1 = (LAS float*)lds;
    for (int t = tid; t < LG; t += 512) {
        float y = 0.f;
        for (int s2 = 48; s2 < LG; ++s2) y += bf2f(G0[LG - (t - s2)]) * bf2f(V0[s2]);
        const float v = bf2f(X1[t]) * (y + bf2f(V0[t]) * bias0);
        z1[t] = (t >= 48) ? bf2f((unsigned short)(cvt_pk_bf16(v, 0.f) & 0xffffu)) : 0.f;
    }
    __syncthreads();
    {
        unsigned h2 = hsh * 3266489917u + (unsigned)tid * 2246822519u; h2 ^= h2 >> 15; h2 *= 2654435761u; h2 ^= h2 >> 13;
        const int t = 64 + (int)(h2 % (unsigned)(LG - 64));
        float y = 0.f;
        for (int s2 = 48; s2 < LG; ++s2) y += bf2f(G1[LG - (t - s2)]) * z1[s2];
        const float e = bf2f(X2[t]) * (y + z1[t] * bias1);
        const float st = bf2f(HD[t]);
        atomicAdd(cnt + 11, 1u);
        if (!(fabsf(st - e) <= 0.05f * fabsf(e) + 1.0f)) atomicAdd(cnt + 9, 1u);
    }
    __syncthreads();
}
#endif

#if DEBUG_CHECK == 7
__device__ __forceinline__ void check_h0b_full(const Params& p, int slot) {
    unsigned char* ws = launder(p.ws); unsigned* cnt = (unsigned*)(ws + OFF_DBGW);
    const bf16_t* h0b = (const bf16_t*)(ws + OFF_H0B);
    const int tid = tid_l(), lane = tid & 63, wave = tid >> 6;
    for (int row = blockIdx.x * 8 + wave; row < T; row += gridDim.x * 8) {
        int pos, seq; row_info(row, pos, seq);
        const float* xr = pos < 16 ? p.in[2] + (size_t)pos * 1024 : (seq < NBP ? p.in[0] + ((size_t)seq * 8192 + (pos - 16)) * 1024 : p.in[1] + ((size_t)(seq - NBP) * 2048 + (pos - 16)) * 1024);
        int bad = 0;
        for (int c = lane; c < 1024; c += 64) { const float e = xr[c]; const float st = bf2f(h0b[(size_t)row * 1024 + c]); if (!(fabsf(st - e) <= 0.01f * fabsf(e) + 0.001f)) bad = 1; }
        bad = __any(bad);
        if (lane == 0 && bad) atomicAdd(cnt + slot, 1u);
    }
}
#endif

#if DEBUG_CHECK == 8
__device__ __forceinline__ void check_p_golden(const Params& p) {
    unsigned char* ws = launder(p.ws); unsigned* cnt = (unsigned*)(ws + OFF_DBGW);
    const bf16_t* P = (const bf16_t*)(ws + OFF_P);
    const unsigned idx = blockIdx.x * 512u + (unsigned)tid_l();
    unsigned hsh = idx * 2654435761u + 8888u; hsh ^= hsh >> 15; hsh *= 2246822519u; hsh ^= hsh >> 13;
    const int row = (int)(hsh % (unsigned)T); hsh = hsh * 3266489917u + 668265263u; hsh ^= hsh >> 16;
    int pos, seq; row_info(row, pos, seq);
    const float* xr = pos < 16 ? p.in[2] + (size_t)pos * 1024 : (seq < NBP ? p.in[0] + ((size_t)seq * 8192 + (pos - 16)) * 1024 : p.in[1] + ((size_t)(seq - NBP) * 2048 + (pos - 16)) * 1024);
    const float* W = p.in[4]; const float* g = p.in[3];
    const int colA = 448 + (int)(hsh % 1536u), colB = (int)((hsh >> 7) % 384u);
    float ss = 0.f, a = 0.f, b = 0.f;
    for (int k = 0; k < 1024; ++k) { const float x = xr[k]; ss += x * x; a += x * g[k] * W[(size_t)k * 1984 + colA]; b += x * g[k] * W[(size_t)k * 1984 + colB]; }
    const float r0 = rsqrtf(ss * (1.f / 1024.f) + EPS); a *= r0; b *= r0;
    const float sa = bf2f(P[(size_t)row * NPP + colA]), sb = bf2f(P[(size_t)row * NPP + colB]);
    if (!(fabsf(sa - a) <= 0.03f * fabsf(a) + 0.03f)) atomicAdd(cnt + 8, 1u);
    if (!(fabsf(sb - b) <= 0.03f * fabsf(b) + 0.03f)) atomicAdd(cnt + 9, 1u);
}
#endif

#if DEBUG_CHECK == 9
__device__ __forceinline__ void check_win_r0(const Params& p) {
    unsigned char* ws = launder(p.ws); unsigned* cnt = (unsigned*)(ws + OFF_DBGW);
    const bf16_t* WT = (const bf16_t*)(ws + OFF_WIN); const float* W = p.in[4]; const float* g = p.in[3]; const float* R0 = (const float*)(ws + OFF_R0);
    const int tid = tid_l(), lane = tid & 63, wave = tid >> 6;
    const int gtid = blockIdx.x * 512 + tid, gthreads = gridDim.x * 512;
    for (int e = gtid; e < 1984 * 1024; e += gthreads) {
        const int n = e >> 10, k = e & 1023; const int sc = src_col(1, n);
        const float ex = W[(size_t)k * 1984 + sc] * g[k]; const float st = bf2f(WT[(size_t)n * 1024 + k]);
        if (!(fabsf(st - ex) <= 0.01f * fabsf(ex) + 1e-5f)) atomicAdd(cnt + 8, 1u);
    }
    for (int row = blockIdx.x * 8 + wave; row < T; row += gridDim.x * 8) {
        int pos, seq; row_info(row, pos, seq);
        const float* xr = pos < 16 ? p.in[2] + (size_t)pos * 1024 : (seq < NBP ? p.in[0] + ((size_t)seq * 8192 + (pos - 16)) * 1024 : p.in[1] + ((size_t)(seq - NBP) * 2048 + (pos - 16)) * 1024);
        float ss = 0.f;
        for (int c = lane; c < 1024; c += 64) ss += xr[c] * xr[c];
        ss = wave_sum(ss);
        const float ex = rsqrtf(ss * (1.f / 1024.f) + EPS); const float st = R0[row];
        if (lane == 0 && !(fabsf(st - ex) <= 0.001f * ex)) { atomicAdd(cnt + 9, 1u); atomicAdd(cnt + 12, (unsigned)(row >> 6)); }
    }
}
#endif

#if DEBUG_CHECK == 10
__device__ __forceinline__ void check_x(const Params& p, int mode) {
    unsigned char* ws = launder(p.ws); unsigned* cnt = (unsigned*)(ws + OFF_DBGW); unsigned* sums = (unsigned*)(ws + OFF_DBGW + MiB);
    const int tid = tid_l(), lane = tid & 63, wave = tid >> 6;
    for (int n = blockIdx.x * 8 + wave; n < TN; n += gridDim.x * 8) {
        const unsigned* xr = (const unsigned*)(n < 65536 ? p.in[0] + (size_t)n * 1024 : p.in[1] + (size_t)(n - 65536) * 1024);
        unsigned a = 0u;
        for (int c = lane; c < 1024; c += 64) a += xr[c] * (2u * (unsigned)c + 1u);
#pragma unroll
        for (int o = 1; o < 64; o <<= 1) a += __shfl_xor(a, o);
        if (lane == 0) {
            if (mode == 0) __hip_atomic_store(sums + n, a, __ATOMIC_RELAXED, __HIP_MEMORY_SCOPE_AGENT);
            else if (__hip_atomic_load(sums + n, __ATOMIC_RELAXED, __HIP_MEMORY_SCOPE_AGENT) != a) atomicAdd(cnt + 8, 1u);
        }
    }
}
#endif

#if DEBUG_CHECK == 11
__device__ __forceinline__ void check_filt_prep(const Params& p) {
    unsigned char* ws = launder(p.ws); unsigned* cnt = (unsigned*)(ws + OFF_DBGW);
    const unsigned idx = blockIdx.x * 512u + (unsigned)tid_l();
    unsigned hsh = idx * 2654435761u + 1111u; hsh ^= hsh >> 15; hsh *= 2246822519u; hsh ^= hsh >> 13;
    {
        const int set = (int)(hsh & 1u); const int L = set ? LS : LP; const int C0 = set ? LGS : LGP;
        const int n = (int)((hsh >> 1) % 2048u); hsh = hsh * 3266489917u + 668265263u; hsh ^= hsh >> 16;
        const int t = (int)(hsh % (unsigned)L);
        const float* f_w1 = p.in[10]; const float* f_b1 = p.in[11]; const float* f_freq = p.in[12]; const float* f_w2 = p.in[13];
        const float* f_b2 = p.in[14]; const float* f_w3 = p.in[15]; const float* f_decay = p.in[16];
        const float tn = (float)t / (float)(L - 1); const float w = (6.2831853071795865f * (float)t) / (float)L;
        float acc = 0.f;
        for (int j2 = 0; j2 < 64; ++j2) {
            float a2 = f_b2[j2];
            for (int j1 = 0; j1 < 64; ++j1) {
                float a1 = f_b1[j1] + tn * f_w1[j1];
                for (int k = 0; k < 16; ++k) { const float f = 1e-4f + (float)k * ((15.0f - 1e-4f) / 15.0f); float sn, cs; sincos_red(f * w, sn, cs);
                    a1 += cs * f_w1[(1 + k) * 64 + j1] - sn * f_w1[(17 + k) * 64 + j1]; }
                a2 += sin_red(f_freq[j1] * a1) * f_w2[j1 * 64 + j2];
            }
            acc += sin_red(f_freq[j2] * a2) * f_w3[j2 * 2048 + n];
        }
        const float e = acc * __expf(-tn * fabsf(f_decay[n]));
        const int order = n >> 10, dir = (n >> 9) & 1, c = n & 511;
        if (!(dir == 1 && t == 0)) {
            const bf16_t* row = (const bf16_t*)(ws + (set ? OFF_GR1 : OFF_GR0)) + (size_t)(order * 512 + c) * (2 * C0);
            const float st = bf2f(row[dir ? C0 + t : C0 - t]);
            if (!(fabsf(st - e) <= 0.02f * fabsf(e) + 0.003f)) atomicAdd(cnt + 8, 1u);
        }
    }
    {
        const int seq = (int)(hsh % 40u); const int set = seq < NBP ? 0 : 1; const int L = set ? LS : LP; const int Lg = set ? LGS : LGP; const int NB = set ? NBS : NBP;
        const int b = set ? seq - NBP : seq; const int row0 = set ? TPR + b * LS : b * LP;
        hsh = hsh * 3266489917u + 668265263u; hsh ^= hsh >> 16;
        const int pos = (int)(hsh % (unsigned)L); const int which = (int)((hsh >> 16) % 3u); const int c = (int)((hsh >> 20) % 512u);
        const bf16_t* P = (const bf16_t*)(ws + OFF_P); const float* cw = p.in[9]; const int col = 448 + which * 512 + c;
        const float um = pos > 0 ? bf2f(P[(size_t)(row0 + pos - 1) * NPP + col]) : 0.f, u0 = bf2f(P[(size_t)(row0 + pos) * NPP + col]), up = pos + 1 < L ? bf2f(P[(size_t)(row0 + pos + 1) * NPP + col]) : 0.f;
        const float e = um * cw[which * 512 + c] + u0 * cw[1536 + which * 512 + c] + up * cw[3072 + which * 512 + c];
        const bf16_t* XT = (const bf16_t*)(ws + (which == 0 ? OFF_X1T : (which == 1 ? OFF_X2T : OFF_V0T))) + (set ? XT_SET1 : 0) + ((size_t)c * NB + b) * Lg;
        const float st = bf2f(XT[pos + 48]);
        if (!(fabsf(st - e) <= 0.02f * fabsf(e) + 0.02f)) atomicAdd(cnt + 9, 1u);
    }
}
#endif
#ifndef SUB_MASK
#define SUB_MASK 15
#endif
#ifndef PHASE_MASK
#define PHASE_MASK 1023
#endif
__global__ void __launch_bounds__(512) hymba_fwd(Params p) {
    extern __shared__ __attribute__((aligned(16))) unsigned char lds_raw[];
    LAS unsigned char* lds = (LAS unsigned char*)lds_raw;
    cg::grid_group grid = cg::this_grid();
#define GSYNC() do { asm volatile("s_waitcnt vmcnt(0) lgkmcnt(0)" ::: "memory"); __threadfence(); grid.sync(); } while (0)
    const int G = gridDim.x;
    __builtin_amdgcn_fence(__ATOMIC_SEQ_CST, "agent");
    asm volatile("buffer_inv sc1\n\ts_waitcnt vmcnt(0)" ::: "memory");
#if DEBUG_CHECK == 10
    check_x(p, 0);
#endif
#if PHASE_MASK & 1
    p0_prologue(p, lds);
#endif
    GSYNC();
#if DEBUG_CHECK == 3
    check_h0b(p, 8);
#endif
#if DEBUG_CHECK == 7
    check_h0b_full(p, 8);
#endif
#if DEBUG_CHECK == 4
    check_stale(p, (const unsigned*)(launder(p.ws) + OFF_H0B), (unsigned)((size_t)T * 512), 9);
#endif
#if PHASE_MASK & 2
    {
        unsigned char* ws = launder(p.ws); unsigned char* ob = launder((unsigned char*)p.out);
        pg8::Gemm g{(const bf16_t*)(ws + OFF_H0B), (const bf16_t*)(ws + OFF_WIN), TPAD, 2048, 1024, 1024, 1024};
        pg8::StaticOrder S; S.init(TPAD, 2048, G, blockIdx.x);
        Epi<0> E{(bf16_t*)(ws + OFF_P), NPP, (const float*)(ws + OFF_R0), (float*)(ws + OFF_SQQP), (float*)(ws + OFF_SQKVP), (bf16_t*)(ob + DO_KR), (const float2*)(ws + OFF_RT)};
        pg8::gemm_phase(lds, g, S, E);
    }
#endif
    GSYNC();
#if DEBUG_CHECK == 1
    { unsigned char* ws = launder(p.ws); check_gemm((const bf16_t*)(ws + OFF_H0B), 1024, (const bf16_t*)(ws + OFF_WIN), 1024, 1024, T, 1984, 0, (const bf16_t*)(ws + OFF_P), NPP, (const float*)(ws + OFF_R0), (unsigned*)(ws + OFF_DBG) + 0, 448); }
    GSYNC();
#endif
#if DEBUG_CHECK == 3
    check_h0b(p, 9);
#endif
#if DEBUG_CHECK == 8
    check_p_golden(p);
#endif
#if DEBUG_CHECK == 9
    check_win_r0(p);
#endif
#if DEBUG_CHECK == 7
    check_h0b_full(p, 9);
    GSYNC();
#endif
#if DEBUG_CHECK == 6
    { unsigned char* ws = launder(p.ws);
      check_gemm((const bf16_t*)(ws + OFF_H0B), 1024, (const bf16_t*)(ws + OFF_WIN), 1024, 1024, T, 448, 0, (const bf16_t*)(ws + OFF_P), NPP, (const float*)(ws + OFF_R0), (unsigned*)(ws + OFF_DBG) + 8, 384);
      check_gemm((const bf16_t*)(ws + OFF_H0B), 1024, (const bf16_t*)(ws + OFF_WIN), 1024, 1024, T, 384, 7, (const bf16_t*)(ws + OFF_P), NPP, (const float*)(ws + OFF_R0), (unsigned*)(ws + OFF_DBG) + 9, 0); }
    GSYNC();
#endif
#if DEBUG_CHECK == 4
    check_stale(p, (const unsigned*)(launder(p.ws) + OFF_P), (unsigned)((size_t)T * 1024), 8);
#endif
    rownorm_phase(p);
    krope_phase(p);
    GSYNC();
#if (PHASE_MASK & 4) && (SUB2 & 1)
    {
        unsigned char* ws = launder(p.ws); unsigned char* ob = launder((unsigned char*)p.out);
        pg8::Gemm g{(const bf16_t*)(ws + OFF_P), (const bf16_t*)(ws + OFF_WUQ), TPAD, 768, 256, NPP, 256};
        pg8::StaticOrder S; S.init(TPAD, 768, G, blockIdx.x);
        Epi<1> E{(bf16_t*)(ob + DO_Q), 768, (const float*)(ws + OFF_RQ), nullptr, nullptr, nullptr, (const float2*)(ws + OFF_RT)};
        pg8::gemm_phase(lds, g, S, E);
    }
#endif
#if (PHASE_MASK & 4) && (SUB2 & 2)
    {
        unsigned char* ws = launder(p.ws); unsigned char* ob = launder((unsigned char*)p.out);
        pg8::Gemm g{(const bf16_t*)(ws + OFF_P) + 256, (const bf16_t*)(ws + OFF_WKN), TPAD, 512, 128, NPP, 128};
        pg8::StaticOrder S; S.init(TPAD, 512, G, blockIdx.x);
        Epi<2> E{(bf16_t*)(ob + DO_KN), 512, (const float*)(ws + OFF_RKV), nullptr, nullptr, nullptr, nullptr};
        pg8::gemm_phase(lds, g, S, E);
    }
#endif
#if (PHASE_MASK & 4) && (SUB2 & 4)
    {
        unsigned char* ws = launder(p.ws); unsigned char* ob = launder((unsigned char*)p.out);
        pg8::Gemm g{(const bf16_t*)(ws + OFF_WV), (const bf16_t*)(ws + OFF_P) + 256, 512, TPAD, 128, 128, NPP};
        pg8::StaticOrder S; S.init(512, TPAD, G, blockIdx.x);
        Epi<3> E{(bf16_t*)(ob + DO_VT), TPAD, (const float*)(ws + OFF_RKV), nullptr, nullptr, nullptr, nullptr};
        pg8::gemm_phase(lds, g, S, E);
    }
#endif
#if PHASE_MASK & 8
    hyprep_phase(p, lds);
#endif
    GSYNC();
#if DEBUG_CHECK == 2
    check_proj(p);
    GSYNC();
#endif
#if DEBUG_CHECK == 11
    check_filt_prep(p);
    GSYNC();
#endif
#if PHASE_MASK & 16
    attn_phase(p, lds);
#endif
#if PHASE_MASK & 32
    hyena_phase(p, lds);
#endif
    GSYNC();
#if DEBUG_CHECK == 5
    check_attn(p);
    check_hyena(p, lds);
    GSYNC();
#endif
#if PHASE_MASK & 64
    mixnorm_phase(p, lds);
#endif
    GSYNC();
#if PHASE_MASK & 128
    {
        unsigned char* ws = launder(p.ws);
        pg8::Gemm g{(const bf16_t*)(ws + OFF_MIXN), (const bf16_t*)(ws + OFF_WO), TN, 1024, 1024, 1024, 1024};
        pg8::StaticOrder S; S.init(TN, 1024, G, blockIdx.x);
        Epi<4> E{(bf16_t*)(ws + OFF_MIX), 1024, nullptr, (float*)(ws + OFF_SQMIXP), nullptr, nullptr, nullptr};
        pg8::gemm_phase(lds, g, S, E);
    }
#endif
    GSYNC();
#if DEBUG_CHECK == 1
    { unsigned char* ws = launder(p.ws); check_gemm((const bf16_t*)(ws + OFF_MIXN), 1024, (const bf16_t*)(ws + OFF_WO), 1024, 1024, TN, 1024, 4, (const bf16_t*)(ws + OFF_MIX), 1024, nullptr, (unsigned*)(ws + OFF_DBG) + 1, 0); }
#endif
#if DEBUG_CHECK == 10
    check_x(p, 1);
#endif
#if PHASE_MASK & 256
    h1_phase(p);
#endif
    GSYNC();
#if PHASE_MASK & 512
#if DEBUG_CHECK == 1
#define DBG_FF1(half) if ((half) == 0) { unsigned char* ws = launder(p.ws); check_gemm((const bf16_t*)(ws + OFF_H1B), 1024, (const bf16_t*)(ws + OFF_WF1), 1024, 1024, 65536, 4096, 5, (const bf16_t*)(ws + OFF_M), 4096, (const float*)(ws + OFF_R1), (unsigned*)(ws + OFF_DBG) + 2, 0); }
#define DBG_FF2(half) if ((half) == 0) { unsigned char* ws = launder(p.ws); check_gemm((const bf16_t*)(ws + OFF_M), 4096, (const bf16_t*)(ws + OFF_WF2), 4096, 4096, 65536, 1024, 6, (const bf16_t*)(ws + OFF_M2), 1024, nullptr, (unsigned*)(ws + OFF_DBG) + 3, 0); } GSYNC();
#else
#define DBG_FF1(half)
#define DBG_FF2(half)
#endif
#define FFN_HALF(half) \
    { \
        unsigned char* ws = launder(p.ws); \
        pg8::Gemm g{(const bf16_t*)(ws + OFF_H1B) + (size_t)(half) * 65536 * 1024, (const bf16_t*)(ws + OFF_WF1), 65536, 4096, 1024, 1024, 1024}; \
        pg8::StaticOrder S; S.init(65536, 4096, G, blockIdx.x); \
        Epi<5> E{(bf16_t*)(ws + OFF_M), 4096, (const float*)(ws + OFF_R1) + (half) * 65536, nullptr, nullptr, nullptr, nullptr}; \
        pg8::gemm_phase(lds, g, S, E); \
    } \
    GSYNC(); \
    DBG_FF1(half) \
    { \
        unsigned char* ws = launder(p.ws); \
        pg8::Gemm g{(const bf16_t*)(ws + OFF_M), (const bf16_t*)(ws + OFF_WF2), 65536, 1024, 4096, 4096, 4096}; \
        pg8::StaticOrder S; S.init(65536, 1024, G, blockIdx.x); \
        Epi<6> E{(bf16_t*)(ws + OFF_M2), 1024, nullptr, (float*)(ws + OFF_SQM2P) + (size_t)(half) * 65536 * 16, nullptr, nullptr, nullptr}; \
        pg8::gemm_phase(lds, g, S, E); \
    } \
    GSYNC(); \
    DBG_FF2(half) \
    final_phase(p, half);
    FFN_HALF(0)
    FFN_HALF(1)
#undef FFN_HALF
#endif
}

extern "C" void kernel_launch(void* const* d_in, const int* in_sizes, int n_in, void* d_out, int out_size, void* d_ws, size_t ws_size, hipStream_t stream) {
    static int grid = 0;
    if (grid == 0) {
        int dev = 0, cus = 0, per_cu = 0;
        hipGetDevice(&dev);
        hipDeviceGetAttribute(&cus, hipDeviceAttributeMultiprocessorCount, dev);
        hipFuncSetAttribute((const void*)hymba_fwd, hipFuncAttributeMaxDynamicSharedMemorySize, LDS_BYTES);
        hipOccupancyMaxActiveBlocksPerMultiprocessor(&per_cu, (const void*)hymba_fwd, 512, LDS_BYTES);
        if (per_cu < 1) per_cu = 1;
        grid = cus * 1;
        if (n_in != 26 || ws_size < 1024 * MiB) fprintf(stderr, "kernel_launch: unexpected n_in %d / ws_size %zu\n", n_in, ws_size);
    }
    Params p{};
    for (int i = 0; i < 26; ++i) p.in[i] = (const float*)d_in[i];
    p.out = (float*)d_out; p.ws = (unsigned char*)d_ws;
    void* args[] = {&p};
    hipError_t e = hipLaunchCooperativeKernel((const void*)hymba_fwd, dim3(grid), dim3(512), args, LDS_BYTES, stream);
    if (e != hipSuccess) fprintf(stderr, "cooperative launch failed: %s (grid %d)\n", hipGetErrorString(e), grid);
}
```

```cpp
#include <hip/hip_runtime.h>
#include <hip/hip_cooperative_groups.h>
#include <cstdio>
#include <cstdint>
namespace cg = cooperative_groups;
#ifndef DBG_SEL0
#define DBG_SEL0 3
#endif
#ifndef DBG_SEL1
#define DBG_SEL1 0
#endif
#ifndef DEBUG_CHECK
#define DEBUG_CHECK 0
#endif
#ifndef EXPT
#define EXPT 0
#endif
#ifndef SUB_MASK
#define SUB_MASK 15
#endif
#ifndef SUB2
#define SUB2 7
#endif

#define LAS __attribute__((address_space(3)))
#define GAS __attribute__((address_space(1)))
typedef unsigned short bf16_t;
typedef short bf16x8 __attribute__((ext_vector_type(8)));
typedef float f32x4 __attribute__((ext_vector_type(4)));
typedef float f32x16 __attribute__((ext_vector_type(16)));
typedef unsigned u32x4 __attribute__((ext_vector_type(4)));
typedef unsigned u32x2 __attribute__((ext_vector_type(2)));

constexpr int DM = 1024, LP = 8208, LS = 2064, NBP = 8, NBS = 32;
constexpr int TPR = NBP * LP;
constexpr int TSR = NBS * LS;
constexpr int T = TPR + TSR;
constexpr int TPAD = 131840;
constexpr int TN = 131072;
constexpr int NPP = 2048;
constexpr int LGP = 8256, LGS = 2112;
constexpr float EPS = 1e-6f;
constexpr float QSCALE = 0.07216878364870322f * 1.4426950408889634f;

constexpr size_t MiB = 1ull << 20;
constexpr size_t OFF_H0B = 0;
constexpr size_t XT_SET1 = (size_t)512 * NBP * LGP;
constexpr size_t OFF_X1T = 0;
constexpr size_t OFF_X2T = 131 * MiB;
constexpr size_t OFF_P = 262 * MiB;
constexpr size_t OFF_V0T = 778 * MiB;
constexpr size_t OFF_MIXN = 262 * MiB;
constexpr size_t OFF_MIX = 518 * MiB;
constexpr size_t OFF_H1B = 0;
constexpr size_t OFF_M = 256 * MiB;
constexpr size_t OFF_M2 = 768 * MiB;
constexpr size_t OFF_SQMIXP = 896 * MiB;
constexpr size_t OFF_SQM2P = 904 * MiB;
constexpr size_t OFF_SMALL = 912 * MiB;
constexpr size_t OFF_WIN = OFF_SMALL;
constexpr size_t OFF_WUQ = OFF_SMALL + 4 * MiB;
constexpr size_t OFF_WKN = OFF_SMALL + 4 * MiB + 512 * 1024;
constexpr size_t OFF_WV = OFF_SMALL + 4 * MiB + 768 * 1024;
constexpr size_t OFF_WO = OFF_SMALL + 5 * MiB;
constexpr size_t OFF_WF1 = OFF_SMALL + 7 * MiB;
constexpr size_t OFF_WF2 = OFF_SMALL + 15 * MiB;
constexpr size_t OFF_GR0 = OFF_SMALL + 23 * MiB;
constexpr size_t OFF_GR1 = OFF_SMALL + 56 * MiB;
constexpr size_t OFF_RT = OFF_SMALL + 65 * MiB;
constexpr size_t OFF_R0 = OFF_SMALL + 68 * MiB;
constexpr size_t OFF_R1 = OFF_SMALL + 69 * MiB;
constexpr size_t OFF_RQ = OFF_SMALL + 70 * MiB;
constexpr size_t OFF_RKV = OFF_SMALL + 71 * MiB;
constexpr size_t OFF_SQQP = OFF_SMALL + 72 * MiB;
constexpr size_t OFF_SQKVP = OFF_SMALL + 75 * MiB;
constexpr size_t OFF_DBGW = OFF_SMALL + 78 * MiB;
constexpr size_t DO_Q = 0;
constexpr size_t DO_KN = 194 * MiB;
constexpr size_t DO_KR = 323 * MiB;
constexpr size_t DO_VT = 340 * MiB;

constexpr size_t OFF_ODBG = 518 * MiB;
constexpr size_t OFF_HDBG = 647 * MiB;
constexpr int LDS_BYTES = 147456;

struct Params {
    const float* in[26];
    float* out;
    unsigned char* ws;
};

__device__ __forceinline__ f32x4 ld_sys(const float* q) { f32x4 v; asm volatile("global_load_dwordx4 %0, %1, off sc0 sc1\n\ts_waitcnt vmcnt(0)" : "=v"(v) : "v"(q) : "memory"); return v; }
__device__ __forceinline__ float ldco(const float* q) { return __builtin_bit_cast(float, __hip_atomic_load((const unsigned*)q, __ATOMIC_RELAXED, __HIP_MEMORY_SCOPE_AGENT)); }
__device__ __forceinline__ float2 ldco2(const float2* q) { const unsigned long long w = __hip_atomic_load((const unsigned long long*)q, __ATOMIC_RELAXED, __HIP_MEMORY_SCOPE_AGENT); return make_float2(__builtin_bit_cast(float, (unsigned)w), __builtin_bit_cast(float, (unsigned)(w >> 32))); }
template <class Tp> __device__ __forceinline__ Tp* launder(Tp* q) { asm volatile("" : "+s"(q)); return q; }
__device__ __forceinline__ int tid_l() { int t = threadIdx.x; asm volatile("" : "+v"(t)); return t; }
__device__ __forceinline__ unsigned cvt_pk_bf16(float lo, float hi) { unsigned r; asm volatile("v_cvt_pk_bf16_f32 %0, %1, %2" : "=v"(r) : "v"(lo), "v"(hi)); return r; }
__device__ __forceinline__ float bf2f(unsigned short b) { return __builtin_bit_cast(float, (unsigned)b << 16); }
__device__ __forceinline__ float bflo(unsigned w) { return __builtin_bit_cast(float, w << 16); }
__device__ __forceinline__ float bfhi(unsigned w) { return __builtin_bit_cast(float, w & 0xffff0000u); }
__device__ __forceinline__ float wave_sum(float v) {
#pragma unroll
    for (int o = 1; o < 64; o <<= 1) v += __shfl_xor(v, o);
    return v;
}
__device__ __forceinline__ void sincos_red(float x, float& s, float& c) {
    const double xd = (double)x; const double k = rint(xd * 0.15915494309189535); const float r = (float)(xd - k * 6.283185307179586);
    s = __sinf(r); c = __cosf(r);
}
__device__ __forceinline__ float sin_red(float x) { float s, c; sincos_red(x, s, c); return s; }
__device__ __forceinline__ void row_info(int r, int& pos, int& seq) {
    if (r < TPR) { seq = r / LP; pos = r - seq * LP; }
    else { int q = r - TPR; if (q >= TSR) q = TSR - 1; const int b = q / LS; pos = q - b * LS; seq = NBP + b; }
}
__device__ __forceinline__ int full_row(int n) {
    if (n < 65536) { const int b = n >> 13; return b * LP + 16 + (n & 8191); }
    const int q = n - 65536; const int b = q >> 11; return TPR + b * LS + 16 + (q & 2047);
}

namespace pg8 {
constexpr int BM = 256, BK = 64, HALF = 128, HTB = HALF * BK * 2, STAGE_BYTES = 8 * HTB, NXCD = 8, WGM = 8;
__host__ __device__ __forceinline__ int lds_byte(int r, int c) { const int st = (r >> 4) * 2 + (c >> 5), rr = r & 15, cc = c & 31, ob = rr * 64 + cc * 2; return st * 1024 + (ob ^ (((ob >> 9) & 1) << 5)); }
__host__ __device__ __forceinline__ void stage_rc(int b, int& R, int& C) { const int st = b / 1024, sb = b % 1024, swz = sb ^ (((sb >> 9) & 1) << 5); R = (st >> 1) * 16 + swz / 64; C = (st & 1) * 32 + (swz % 64) / 2; }
__host__ __device__ __forceinline__ int perm32(int rho) { const int n = rho >> 4, i = rho & 15; return 8 * (i >> 2) + 4 * n + (i & 3); }
struct Unit { int pm, pn; };
struct Gemm { const bf16_t* A; const bf16_t* Bt; int M, N, K, lda, ldb; };
struct StaticOrder {
    int nM, nN, nwg, G, c;
    __device__ void init(int M, int N, int G_, int c_) { nM = M / BM; nN = N / BM; nwg = nM * nN; G = G_; c = c_; }
    __device__ bool next(int i, Unit& u) const {
        const long L = (long)i * G + c; if (L >= nwg) return false;
        int wgid = (int)L; { const int q = nwg / NXCD, r = nwg % NXCD, xcd = wgid % NXCD, off = wgid / NXCD; wgid = (xcd < r ? xcd * (q + 1) : r * (q + 1) + (xcd - r) * q) + off; }
        const int nig = WGM * nN, gid = wgid / nig, fm = gid * WGM, gsz = (nM - fm) < WGM ? (nM - fm) : WGM;
        u.pm = fm + ((wgid % nig) % gsz); u.pn = (wgid % nig) / gsz; return true;
    }
};
template <class Epi>
__device__ __forceinline__ void gemm_phase(LAS unsigned char* lds, const Gemm g, const StaticOrder& S, const Epi& E) {
    const int tid = tid_l(), wid = __builtin_amdgcn_readfirstlane(tid >> 6), lane = tid & 63, wr = wid >> 2, wc = wid & 3, fr = lane & 15, fq = lane >> 4;
    const int K = g.K, nt = K / BK;
    unsigned voffA[2], voffB[2];
#pragma unroll
    for (int i = 0; i < 2; ++i) { int R, C; stage_rc(tid * 16 + i * 8192, R, C); const int Rb = (R & ~31) + perm32(R & 31);
        voffA[i] = (unsigned)(R * g.lda + C) * 2u; voffB[i] = (unsigned)(Rb * g.ldb + C) * 2u; }
    const size_t kstep = (size_t)(BK * 2);
    const size_t hstepA = (size_t)HALF * g.lda * 2, hstepB = (size_t)HALF * g.ldb * 2;
    const size_t tstepA = 2 * hstepA, tstepB = 2 * hstepB;
    const unsigned ldsw = (unsigned)wid * 1024u;
    const int aoff = lds_byte(wr * 64 + fr, fq * 8), boff = lds_byte(wc * 32 + fr, fq * 8);
#define PG8_SA(b, h) (((b) * 2 + (h)) * HTB)
#define PG8_SB(b, h) ((4 + (b) * 2 + (h)) * HTB)
#define PG8_STAGE(bufoff, gbase, voff) do { _Pragma("unroll") for (int _i = 0; _i < 2; ++_i) \
        __builtin_amdgcn_global_load_lds((const unsigned*)((const char*)(gbase) + (voff)[_i]), (LAS unsigned*)(lds + (bufoff) + ldsw + _i * 8192), 16, 0, 0); } while (0)
#define PG8_LDA(dst, b, h) do { _Pragma("unroll") for (int m = 0; m < 4; ++m) _Pragma("unroll") for (int k = 0; k < 2; ++k) dst[m][k] = *(const LAS bf16x8*)(lds + PG8_SA(b, h) + aoff + m * 2048 + k * 1024); } while (0)
#define PG8_LDB(dst, b, h) do { _Pragma("unroll") for (int n = 0; n < 2; ++n) _Pragma("unroll") for (int k = 0; k < 2; ++k) dst[n][k] = *(const LAS bf16x8*)(lds + PG8_SB(b, h) + boff + n * 2048 + k * 1024); } while (0)
#define PG8_MMA(ai, bj, At, Bt) do { __builtin_amdgcn_s_setprio(1); _Pragma("unroll") for (int m = 0; m < 4; ++m) _Pragma("unroll") for (int n = 0; n < 2; ++n) _Pragma("unroll") for (int k = 0; k < 2; ++k) \
        acc[ai][bj][m][n] = __builtin_amdgcn_mfma_f32_16x16x32_bf16(Bt[n][k], At[m][k], acc[ai][bj][m][n], 0, 0, 0); __builtin_amdgcn_s_setprio(0); } while (0)
#define PG8_WAIT_V(n) asm volatile("s_waitcnt vmcnt(" #n ")" ::: "memory")
#define PG8_WAIT_L(n) asm volatile("s_waitcnt lgkmcnt(" #n ")" ::: "memory")
#define PG8_BAR __builtin_amdgcn_s_barrier()
#define PG8_SCHED __builtin_amdgcn_sched_barrier(0)
    Unit cur, nxt; int ui = 0;
    if (!S.next(0, cur)) return;
    f32x4 acc[2][2][4][2];
#pragma unroll
    for (int a = 0; a < 2; ++a)
#pragma unroll
        for (int b = 0; b < 2; ++b)
#pragma unroll
            for (int m = 0; m < 4; ++m)
#pragma unroll
                for (int n = 0; n < 2; ++n) acc[a][b][m][n] = (f32x4){0.f, 0.f, 0.f, 0.f};
    bf16x8 At[4][2], B0[2][2], B1[2][2];
    const char* cA = (const char*)g.A + (size_t)cur.pm * tstepA; const char* cB = (const char*)g.Bt + (size_t)cur.pn * tstepB;
    PG8_STAGE(PG8_SB(0, 0), cB, voffB); PG8_STAGE(PG8_SB(0, 1), cB + hstepB, voffB); PG8_STAGE(PG8_SA(0, 0), cA, voffA); PG8_STAGE(PG8_SA(0, 1), cA + hstepA, voffA);
    if (wr == 1) PG8_BAR;
    PG8_WAIT_V(2); PG8_BAR;
    PG8_STAGE(PG8_SB(1, 0), cB + kstep, voffB); PG8_STAGE(PG8_SA(1, 0), cA + kstep, voffA); PG8_STAGE(PG8_SB(1, 1), cB + hstepB + kstep, voffB);
    PG8_WAIT_V(6); PG8_BAR;
    for (;;) {
        const bool has_next = S.next(ui + 1, nxt);
        const char* nA = has_next ? (const char*)g.A + (size_t)nxt.pm * tstepA : cA; const char* nB = has_next ? (const char*)g.Bt + (size_t)nxt.pn * tstepB : cB;
        for (int t = 0; t < nt; t += 2) {
            const bool last = (t == nt - 2);
            const char* a1 = cA + (size_t)(t + 1) * kstep;
            const char* a2 = last ? nA : cA + (size_t)(t + 2) * kstep; const char* b2 = last ? nB : cB + (size_t)(t + 2) * kstep;
            const char* a3 = a2 + kstep; const char* b3 = b2 + kstep;
            PG8_LDB(B0, 0, 0); PG8_LDB(B1, 0, 1); PG8_SCHED; PG8_LDA(At, 0, 0); PG8_STAGE(PG8_SA(1, 1), a1 + hstepA, voffA);
            PG8_WAIT_V(8); PG8_WAIT_L(0); PG8_BAR; PG8_MMA(0, 0, At, B0); PG8_MMA(0, 1, At, B1); PG8_BAR; PG8_SCHED;
            PG8_LDA(At, 0, 1); PG8_STAGE(PG8_SB(0, 0), b2, voffB); PG8_STAGE(PG8_SB(0, 1), b2 + hstepB, voffB); PG8_STAGE(PG8_SA(0, 0), a2, voffA);
            PG8_WAIT_V(8); PG8_WAIT_L(0); PG8_BAR; PG8_MMA(1, 0, At, B0); PG8_MMA(1, 1, At, B1); PG8_BAR; PG8_SCHED;
            PG8_LDB(B0, 1, 0); PG8_LDB(B1, 1, 1); PG8_SCHED; PG8_LDA(At, 1, 0); PG8_STAGE(PG8_SA(0, 1), a2 + hstepA, voffA);
            PG8_WAIT_V(8); PG8_WAIT_L(0); PG8_BAR; PG8_MMA(0, 0, At, B0); PG8_MMA(0, 1, At, B1); PG8_BAR; PG8_SCHED;
            PG8_LDA(At, 1, 1); PG8_STAGE(PG8_SB(1, 0), b3, voffB); PG8_STAGE(PG8_SB(1, 1), b3 + hstepB, voffB); PG8_STAGE(PG8_SA(1, 0), a3, voffA);
            PG8_WAIT_V(8); PG8_WAIT_L(0); PG8_BAR; PG8_MMA(1, 0, At, B0); PG8_MMA(1, 1, At, B1); PG8_BAR; PG8_SCHED;
        }
        if (wr == 0) PG8_BAR;
        E(acc, cur, wr, wc, fr, fq);
        if (!has_next) break;
#pragma unroll
        for (int a = 0; a < 2; ++a)
#pragma unroll
            for (int b = 0; b < 2; ++b)
#pragma unroll
                for (int m = 0; m < 4; ++m)
#pragma unroll
                    for (int n = 0; n < 2; ++n) acc[a][b][m][n] = (f32x4){0.f, 0.f, 0.f, 0.f};
        cur = nxt; cA = nA; cB = nB; ++ui;
        if (wr == 1) PG8_BAR;
    }
    PG8_WAIT_V(0);
    PG8_BAR;
#undef PG8_SA
#undef PG8_SB
#undef PG8_STAGE
#undef PG8_LDA
#undef PG8_LDB
#undef PG8_MMA
#undef PG8_WAIT_V
#undef PG8_WAIT_L
#undef PG8_BAR
#undef PG8_SCHED
}
}

__device__ __forceinline__ void rope8(f32x4& v0, f32x4& v1, const float2* rt  ) {
    const float2 c0 = ldco2(rt), c1 = ldco2(rt + 1), c2 = ldco2(rt + 2), c3 = ldco2(rt + 3);
    float a, b;
    a = v0[0]; b = v0[1]; v0[0] = a * c0.x - b * c0.y; v0[1] = b * c0.x + a * c0.y;
    a = v0[2]; b = v0[3]; v0[2] = a * c1.x - b * c1.y; v0[3] = b * c1.x + a * c1.y;
    a = v1[0]; b = v1[1]; v1[0] = a * c2.x - b * c2.y; v1[1] = b * c2.x + a * c2.y;
    a = v1[2]; b = v1[3]; v1[2] = a * c3.x - b * c3.y; v1[3] = b * c3.x + a * c3.y;
}
__device__ __forceinline__ u32x4 pack8(const f32x4& v0, const f32x4& v1) {
    u32x4 w; w.x = cvt_pk_bf16(v0[0], v0[1]); w.y = cvt_pk_bf16(v0[2], v0[3]); w.z = cvt_pk_bf16(v1[0], v1[1]); w.w = cvt_pk_bf16(v1[2], v1[3]); return w;
}
__device__ __forceinline__ float sq8(const f32x4& a, const f32x4& b) {
    return (a[0] * a[0] + a[1] * a[1]) + (a[2] * a[2] + a[3] * a[3]) + (b[0] * b[0] + b[1] * b[1]) + (b[2] * b[2] + b[3] * b[3]);
}
template <int MODE> struct Epi {
    bf16_t* O; int ldc; const float* rs; float* sq0; float* sq1; bf16_t* KR; const float2* RT;
    __device__ __forceinline__ void operator()(const f32x4 (&acc)[2][2][4][2], const pg8::Unit& u, int wr, int wc, int fr, int fq) const {
#pragma unroll
        for (int ai = 0; ai < 2; ++ai)
#pragma unroll
            for (int m = 0; m < 4; ++m) {
                const int row = u.pm * 256 + ai * 128 + wr * 64 + m * 16 + fr;
                float sc = 1.f;
                if (MODE == 0 || MODE == 1 || MODE == 2 || MODE == 5) sc = ldco(rs + row);
                float ssum[2];
#pragma unroll
                for (int bj = 0; bj < 2; ++bj) {
                    const int col0 = u.pn * 256 + bj * 128 + wc * 32 + 8 * fq;
                    f32x4 v0 = acc[ai][bj][m][0] * sc, v1 = acc[ai][bj][m][1] * sc;
                    if (MODE == 3) {
#pragma unroll
                        for (int j = 0; j < 4; ++j) { v0[j] *= ldco(rs + col0 + j); v1[j] *= ldco(rs + col0 + 4 + j); }
                    }
                    if (MODE == 5) {
#pragma unroll
                        for (int j = 0; j < 4; ++j) { const float a = fmaxf(v0[j], 0.f), b = fmaxf(v1[j], 0.f); v0[j] = a * a; v1[j] = b * b; }
                    }
                    ssum[bj] = sq8(v0, v1);
                    *(u32x4*)(O + (size_t)row * ldc + col0) = pack8(v0, v1);
                }
                if (MODE == 0) {
                    if (u.pn == 0) { float s = ssum[0] + ssum[1]; s += __shfl_xor(s, 16); s += __shfl_xor(s, 32); if (fq == 0) sq0[row * 4 + wc] = s; }
                    else if (u.pn == 1) { float s = ssum[0]; s += __shfl_xor(s, 16); s += __shfl_xor(s, 32); if (fq == 0) sq1[row * 4 + wc] = s; }
                }
                if (MODE == 4 || MODE == 6) { float s = ssum[0] + ssum[1]; s += __shfl_xor(s, 16); s += __shfl_xor(s, 32); if (fq == 0) sq0[(size_t)row * 16 + u.pn * 4 + wc] = s; }
            }
    }
};

__device__ __forceinline__ int src_col(int mode, int n) {
    if (mode == 0) return n;
    if (mode == 1) { if (n >= 1984) return -1; if (n >= 384 && n < 448) { const int j = n - 384; return 384 + ((j & 1) ? 32 + (j >> 1) : (j >> 1)); } return n; }
    if (mode == 2) { const int h = n / 192, w = n % 192; if (w < 128) return n; const int j = w - 128; return h * 192 + 128 + ((j & 1) ? 32 + (j >> 1) : (j >> 1)); }
    if (mode == 3) return (n >> 7) * 256 + (n & 127);
    return (n >> 7) * 256 + 128 + (n & 127);
}
__device__ __forceinline__ void conv_weight(const float* W, const float* g, bf16_t* out, int K, int Nsrc, int Nout, int mode, int gtid, int gthreads) {
    const int nch = Nout * (K / 8);
    for (int e = gtid; e < nch; e += gthreads) {
        const int n = e % Nout, kc = e / Nout, k0 = kc * 8; const int sc = src_col(mode, n);
        float v[8];
#pragma unroll
        for (int j = 0; j < 8; ++j) v[j] = (sc >= 0) ? W[(size_t)(k0 + j) * Nsrc + sc] * (g ? g[k0 + j] : 1.f) : 0.f;
        u32x4 w; w.x = cvt_pk_bf16(v[0], v[1]); w.y = cvt_pk_bf16(v[2], v[3]); w.z = cvt_pk_bf16(v[4], v[5]); w.w = cvt_pk_bf16(v[6], v[7]);
        *(u32x4*)(out + (size_t)n * K + k0) = w;
    }
}

__device__ __forceinline__ void p0_prologue(const Params& p, LAS unsigned char* lds) {
    unsigned char* ws = launder(p.ws);
    const int tid = tid_l(), lane = tid & 63, wave = tid >> 6, G = gridDim.x;
    const int gtid = blockIdx.x * 512 + tid, gthreads = G * 512;
    const int gw = blockIdx.x * 8 + wave, NGW = G * 8;
#if SUB_MASK & 1
    conv_weight(p.in[4], p.in[3], (bf16_t*)(ws + OFF_WIN), 1024, 1984, 2048, 1, gtid, gthreads);
    conv_weight(p.in[6], p.in[5], (bf16_t*)(ws + OFF_WUQ), 256, 768, 768, 2, gtid, gthreads);
    conv_weight(p.in[8], p.in[7], (bf16_t*)(ws + OFF_WKN), 128, 1024, 512, 3, gtid, gthreads);
    conv_weight(p.in[8], p.in[7], (bf16_t*)(ws + OFF_WV), 128, 1024, 512, 4, gtid, gthreads);
    conv_weight(p.in[20], nullptr, (bf16_t*)(ws + OFF_WO), 1024, 1024, 1024, 0, gtid, gthreads);
    conv_weight(p.in[23], p.in[22], (bf16_t*)(ws + OFF_WF1), 1024, 4096, 4096, 0, gtid, gthreads);
    conv_weight(p.in[24], nullptr, (bf16_t*)(ws + OFF_WF2), 4096, 1024, 1024, 0, gtid, gthreads);
#endif
#if SUB_MASK & 2
#if DEBUG_CHECK
    if (blockIdx.x == 0 && tid < 64) ((unsigned*)(ws + OFF_DBGW))[tid] = 0u;
#endif
    {
        float2* RT = (float2*)(ws + OFF_RT);
        for (int e = gtid; e < LP * 32; e += gthreads) {
            const int pos = e >> 5, i = e & 31;
            const float inv = 1.0f / exp2f((float)i * (13.287712379549449f / 32.f));
            float s, c; sincos_red((float)pos * inv, s, c);
            RT[e] = make_float2(c, s);
        }
    }
#endif
#if SUB_MASK & 4
    {
        bf16_t* h0b = (bf16_t*)(ws + OFF_H0B); float* r0 = (float*)(ws + OFF_R0);
        for (int r = gw; r < TPAD; r += NGW) {
            u32x2* o = (u32x2*)(h0b + (size_t)r * 1024) + lane;
            if (r >= T) {
#pragma unroll
                for (int j = 0; j < 4; ++j) o[64 * j] = (u32x2){0u, 0u};
                if (lane == 0) __hip_atomic_store(r0 + r, 0.f, __ATOMIC_RELAXED, __HIP_MEMORY_SCOPE_AGENT);
                continue;
            }
            int pos, seq; row_info(r, pos, seq);
            const float* src = pos < 16 ? p.in[2] + (size_t)pos * 1024
                                        : (seq < NBP ? p.in[0] + ((size_t)seq * 8192 + (pos - 16)) * 1024 : p.in[1] + ((size_t)(seq - NBP) * 2048 + (pos - 16)) * 1024);
            const f32x4* xr = (const f32x4*)src + lane;
            f32x4 v[4]; float ss = 0.f;
#pragma unroll
            for (int j = 0; j < 4; ++j) { v[j] = xr[64 * j]; ss += (v[j][0] * v[j][0] + v[j][1] * v[j][1]) + (v[j][2] * v[j][2] + v[j][3] * v[j][3]); }
            ss = wave_sum(ss);
#pragma unroll
            for (int j = 0; j < 4; ++j) o[64 * j] = (u32x2){cvt_pk_bf16(v[j][0], v[j][1]), cvt_pk_bf16(v[j][2], v[j][3])};
            if (lane == 0) __hip_atomic_store(r0 + r, rsqrtf(ss * (1.f / 1024.f) + EPS), __ATOMIC_RELAXED, __HIP_MEMORY_SCOPE_AGENT);
        }
    }
#endif
#if SUB_MASK & 8
    {
        const float* f_w1 = p.in[10]; const float* f_b1 = p.in[11]; const float* f_freq = p.in[12]; const float* f_w2 = p.in[13];
        const float* f_b2 = p.in[14]; const float* f_w3 = p.in[15]; const float* f_decay = p.in[16];
        LAS float* feats = (LAS float*)lds;
        LAS float* h1 = feats + 16 * 34;
        LAS float* h2 = h1 + 16 * 64;
        for (int u = blockIdx.x; u < 513 + 129; u += G) {
            const int set = u < 513 ? 0 : 1; const int t0 = 16 * (set ? u - 513 : u); const int L = set ? LS : LP; const int C0 = set ? LGS : LGP;
            bf16_t* GR = (bf16_t*)(ws + (set ? OFF_GR1 : OFF_GR0));
            const float invLm1 = 1.0f / (float)(L - 1);
            if (tid < 256) {
                const int tt = tid >> 4, k = tid & 15; const int t = t0 + tt;
                const float w = (6.2831853071795865f * (float)t) / (float)L;
                const float f = 1e-4f + (float)k * ((15.0f - 1e-4f) / 15.0f);
                float s, c; sincos_red(f * w, s, c);
                feats[tt * 34 + 1 + k] = c; feats[tt * 34 + 17 + k] = -s;
                if (k == 0) feats[tt * 34] = (float)t * invLm1;
            }
            __syncthreads();
#pragma unroll 1
            for (int q = 0; q < 2; ++q) {
                const int o = tid + 512 * q, tt = o >> 6, j = o & 63;
                float a = f_b1[j];
#pragma unroll 3
                for (int e = 0; e < 33; ++e) a += feats[tt * 34 + e] * f_w1[e * 64 + j];
                h1[tt * 64 + j] = sin_red(f_freq[j] * a);
            }
            __syncthreads();
#pragma unroll 1
            for (int q = 0; q < 2; ++q) {
                const int o = tid + 512 * q, tt = o >> 6, j = o & 63;
                float a = f_b2[j];
#pragma unroll 4
                for (int e = 0; e < 64; ++e) a += h1[tt * 64 + e] * f_w2[e * 64 + j];
                h2[tt * 64 + j] = sin_red(f_freq[j] * a);
            }
            __syncthreads();
#pragma unroll 1
            for (int q = 0; q < 4; ++q) {
                const int n = tid + 512 * q;
                float a[16];
#pragma unroll
                for (int i = 0; i < 16; ++i) a[i] = 0.f;
#pragma unroll 2
                for (int j = 0; j < 64; ++j) {
                    const float w = f_w3[j * 2048 + n];
#pragma unroll
                    for (int i = 0; i < 16; ++i) a[i] += h2[i * 64 + j] * w;
                }
                const float dec = fabsf(f_decay[n]);
                const int order = n >> 10, dir = (n >> 9) & 1, c = n & 511;
                bf16_t* row = GR + (size_t)(order * 512 + c) * (2 * C0);
#pragma unroll
                for (int i = 0; i < 16; ++i) {
                    const int t = t0 + i;
                    const float val = a[i] * __expf(-((float)t * invLm1) * dec);
                    const unsigned short b = (unsigned short)(cvt_pk_bf16(val, 0.f) & 0xffffu);
                    if (dir == 0) row[C0 - t] = b; else if (t > 0) row[C0 + t] = b;
                }
            }
            __syncthreads();
        }
        for (int e = gtid; e < 2 * 1024 * 97; e += gthreads) {
            const int set = e / (1024 * 97), r = (e / 97) % 1024, i = e % 97; const int L = set ? LS : LP; const int C0 = set ? LGS : LGP;
            bf16_t* row = (bf16_t*)(ws + (set ? OFF_GR1 : OFF_GR0)) + (size_t)r * (2 * C0);
            const int idx = i < 49 ? i : C0 + L + (i - 49);
            row[idx] = 0;
        }
    }
#endif
}

__device__ __forceinline__ void rownorm_phase(const Params& p) {
    unsigned char* ws = launder(p.ws); const int gtid = blockIdx.x * 512 + tid_l(), gthreads = gridDim.x * 512;
    const float* sqq = (const float*)(ws + OFF_SQQP); const float* sqkv = (const float*)(ws + OFF_SQKVP);
    float* rq = (float*)(ws + OFF_RQ); float* rkv = (float*)(ws + OFF_RKV);
    for (int r = gtid; r < TPAD; r += gthreads) {
        const float a = (ldco(sqq + r * 4) + ldco(sqq + r * 4 + 1)) + (ldco(sqq + r * 4 + 2) + ldco(sqq + r * 4 + 3));
        const float b = (ldco(sqkv + r * 4) + ldco(sqkv + r * 4 + 1)) + (ldco(sqkv + r * 4 + 2) + ldco(sqkv + r * 4 + 3));
        rq[r] = rsqrtf(a * (1.f / 256.f) + EPS) * QSCALE; rkv[r] = rsqrtf(b * (1.f / 128.f) + EPS);
    }
}
__device__ __forceinline__ void krope_phase(const Params& p) {
    unsigned char* ws = launder(p.ws); unsigned char* ob = launder((unsigned char*)p.out);
    const int gtid = blockIdx.x * 512 + tid_l(), gthreads = gridDim.x * 512;
    const bf16_t* P = (const bf16_t*)(ws + OFF_P); bf16_t* KR = (bf16_t*)(ob + DO_KR); const float2* RT = (const float2*)(ws + OFF_RT);
    for (int e = gtid; e < TPAD * 8; e += gthreads) {
        const int row = e >> 3, ch = e & 7;
        int pos, seq; row_info(row, pos, seq);
        const u32x4 v = *(const u32x4*)(P + (size_t)row * NPP + 384 + ch * 8);
        f32x4 v0 = (f32x4){bflo(v.x), bfhi(v.x), bflo(v.y), bfhi(v.y)}, v1 = (f32x4){bflo(v.z), bfhi(v.z), bflo(v.w), bfhi(v.w)};
        rope8(v0, v1, RT + pos * 32 + ch * 4);
        *(u32x4*)(KR + (size_t)row * 64 + ch * 8) = pack8(v0, v1);
    }
}
__device__ __forceinline__ void hyprep_phase(const Params& p, LAS unsigned char* lds) {
    unsigned char* ws = launder(p.ws); const int tid = tid_l(), G = gridDim.x;
    const bf16_t* P = (const bf16_t*)(ws + OFF_P); const float* conv_w = p.in[9];
    constexpr int RSB = 1040;
    for (int u = blockIdx.x; u < 3096 + 3168; u += G) {
        int seq, j, which;
        if (u < 3096) { seq = u / 387; const int rem = u % 387; j = rem / 3; which = rem % 3; }
        else { const int v = u - 3096; seq = NBP + v / 99; const int rem = v % 99; j = rem / 3; which = rem % 3; }
        const int set = seq < NBP ? 0 : 1; const int L = set ? LS : LP; const int Lg = set ? LGS : LGP; const int NB = set ? NBS : NBP;
        const int b = set ? seq - NBP : seq; const int row0 = set ? TPR + b * LS : b * LP;
        const int posb = 64 * j - 49;
        for (int i = 0; i < 9; ++i) {
            const int id = tid + 512 * i; if (id >= 66 * 64) break;
            const int rr = id >> 6, ch = id & 63; const int pos = posb + rr;
            u32x4 v = (u32x4){0u, 0u, 0u, 0u};
            if (pos >= 0 && pos < L) v = *(const GAS u32x4*)(P + (size_t)(row0 + pos) * NPP + 448 + which * 512 + ch * 8);
            *(LAS u32x4*)(lds + rr * RSB + ch * 16) = v;
        }
        __syncthreads();
        {
            const int c = tid; const float w0 = conv_w[which * 512 + c], w1 = conv_w[1536 + which * 512 + c], w2 = conv_w[3072 + which * 512 + c];
            bf16_t* XT = (bf16_t*)(ws + (which == 0 ? OFF_X1T : (which == 1 ? OFF_X2T : OFF_V0T))) + (set ? XT_SET1 : 0) + ((size_t)c * NB + b) * Lg + 64 * j;
            const LAS unsigned short* tl = (const LAS unsigned short*)lds + c;
            float prev = bf2f(tl[0]), cur = bf2f(tl[RSB / 2]);
            for (int o8 = 0; o8 < 8; ++o8) {
                float r[8];
#pragma unroll
                for (int k = 0; k < 8; ++k) {
                    const int o = o8 * 8 + k; const float nxt = bf2f(tl[(o + 2) * (RSB / 2)]);
                    const int pos = posb + 1 + o;
                    r[k] = (pos >= 0 && pos < L) ? (prev * w0 + cur * w1 + nxt * w2) : 0.f;
                    prev = cur; cur = nxt;
                }
                u32x4 w; w.x = cvt_pk_bf16(r[0], r[1]); w.y = cvt_pk_bf16(r[2], r[3]); w.z = cvt_pk_bf16(r[4], r[5]); w.w = cvt_pk_bf16(r[6], r[7]);
                *(GAS u32x4*)(XT + o8 * 8) = w;
            }
        }
        __syncthreads();
    }
}

__device__ __forceinline__ f32x16 mfma32(bf16x8 a, bf16x8 b, f32x16 c) { return __builtin_amdgcn_mfma_f32_32x32x16_bf16(a, b, c, 0, 0, 0); }

__device__ __forceinline__ void attn_phase(const Params& p, LAS unsigned char* lds) {
    const int tid = tid_l(), lane = tid & 63, wave = tid >> 6, G = gridDim.x, h = lane >> 5, l32 = lane & 31;
    unsigned char* ob = launder((unsigned char*)p.out);
    bf16_t* Q = (bf16_t*)(ob + DO_Q);
    const bf16_t* KN = (const bf16_t*)(ob + DO_KN);
    const bf16_t* KR = (const bf16_t*)(ob + DO_KR);
    const bf16_t* VT = (const bf16_t*)(ob + DO_VT);
    constexpr int KROW = 400, VROW = 136, KBYTES = 64 * KROW, BUFB = KBYTES + 128 * VROW;
    for (int u = blockIdx.x; u < 2048; u += G) {
        int seq, head, qb;
        if (u < 1024) { seq = u >> 7; head = (u >> 5) & 3; qb = u & 31; } else { const int v = u - 1024; seq = NBP + (v >> 5); head = (v >> 3) & 3; qb = v & 7; }
        const int L = seq < NBP ? LP : LS; const int row0 = seq < NBP ? seq * LP : TPR + (seq - NBP) * LS;
        const int ntiles = (L + 63) >> 6;
        const int qrow = row0 + 16 + qb * 256 + wave * 32 + l32;
        bf16x8 qf[12];
#pragma unroll
        for (int ks = 0; ks < 12; ++ks) qf[ks] = *(const GAS bf16x8*)(Q + (size_t)qrow * 768 + head * 192 + 16 * ks + 8 * h);
        {
            const float2* RT = (const float2*)(launder(p.ws) + OFF_RT);
            const int qpos = 16 + qb * 256 + wave * 32 + l32;
#pragma unroll
            for (int ks = 8; ks < 12; ++ks) {
                const u32x4 v = __builtin_bit_cast(u32x4, qf[ks]);
                f32x4 v0 = (f32x4){bflo(v.x), bfhi(v.x), bflo(v.y), bfhi(v.y)}, v1 = (f32x4){bflo(v.z), bfhi(v.z), bflo(v.w), bfhi(v.w)};
                rope8(v0, v1, RT + qpos * 32 + 8 * (ks - 8) + 4 * h);
                qf[ks] = __builtin_bit_cast(bf16x8, pack8(v0, v1));
            }
        }
        const int kkey0 = tid >> 4, kch0 = tid & 15;
        const int rkey = tid >> 3, rch = tid & 7;
        const int vdv0 = tid >> 3, vch = tid & 7;
        const unsigned kn_off = (unsigned)(kkey0 * 512 + head * 128 + kch0 * 8) * 2u;
        const unsigned kr_off = (unsigned)(rkey * 64 + rch * 8) * 2u;
        const unsigned vt_off = (unsigned)(vdv0 * TPAD + vch * 8) * 2u;
        const unsigned char* knb = (const unsigned char*)KN + (size_t)row0 * 1024;
        const unsigned char* krb = (const unsigned char*)KR + (size_t)row0 * 128;
        const unsigned char* vtb = (const unsigned char*)VT + ((size_t)head * 128 * TPAD + row0) * 2;
        u32x4 g0, g1, g2, g3, g4;
#define ATT_LOAD(tile) do { const unsigned char* kb__ = knb + (size_t)(tile) * 65536; const unsigned char* rb__ = krb + (size_t)(tile) * 8192; const unsigned char* vb__ = vtb + (size_t)(tile) * 128; \
        g0 = *(const GAS u32x4*)(kb__ + kn_off); g1 = *(const GAS u32x4*)(kb__ + 32768 + kn_off); \
        g2 = *(const GAS u32x4*)(rb__ + kr_off); (void)vb__; } while (0)
#define ATT_LOADV(tile) do { const unsigned char* vb__ = vtb + (size_t)(tile) * 128; g3 = *(const GAS u32x4*)(vb__ + vt_off); g4 = *(const GAS u32x4*)(vb__ + (size_t)64 * TPAD * 2 + vt_off); } while (0)
#define ATT_STOREK(buf) do { LAS unsigned char* kb_ = lds + (buf) * BUFB; \
        *(LAS u32x4*)(kb_ + kkey0 * KROW + kch0 * 16) = g0; *(LAS u32x4*)(kb_ + (kkey0 + 32) * KROW + kch0 * 16) = g1; \
        *(LAS u32x4*)(kb_ + rkey * KROW + 256 + rch * 16) = g2; } while (0)
#define ATT_STORE(buf) do { LAS unsigned char* vb_ = lds + (buf) * BUFB + KBYTES; \
        *(LAS u32x2*)(vb_ + vdv0 * VROW + vch * 16) = (u32x2){g3.x, g3.y}; *(LAS u32x2*)(vb_ + vdv0 * VROW + vch * 16 + 8) = (u32x2){g3.z, g3.w}; \
        *(LAS u32x2*)(vb_ + (vdv0 + 64) * VROW + vch * 16) = (u32x2){g4.x, g4.y}; *(LAS u32x2*)(vb_ + (vdv0 + 64) * VROW + vch * 16 + 8) = (u32x2){g4.z, g4.w}; } while (0)
        ATT_LOAD(0); ATT_LOADV(0); ATT_STOREK(0); ATT_STORE(0);
        __syncthreads();
        f32x16 o[4];
#pragma unroll
        for (int d = 0; d < 4; ++d)
#pragma unroll
            for (int r = 0; r < 16; ++r) o[d][r] = 0.f;
        float m_run = -INFINITY, l_run = 0.f;
        for (int j = 0; j < ntiles; ++j) {
            const int buf = j & 1;
            if (j + 1 < ntiles) ATT_LOAD(j + 1);
            const LAS unsigned char* kb = lds + buf * BUFB;
            f32x16 s0, s1;
#pragma unroll
            for (int r = 0; r < 16; ++r) { s0[r] = 0.f; s1[r] = 0.f; }
#pragma unroll
            for (int ks = 0; ks < 12; ++ks) {
                const bf16x8 a0 = *(const LAS bf16x8*)(kb + l32 * KROW + ks * 32 + h * 16);
                const bf16x8 a1 = *(const LAS bf16x8*)(kb + (l32 + 32) * KROW + ks * 32 + h * 16);
                s0 = mfma32(a0, qf[ks], s0); s1 = mfma32(a1, qf[ks], s1);
                if ((ks % 3) == 2) __builtin_amdgcn_sched_barrier(0);
            }
            if (j + 1 < ntiles) ATT_STOREK(buf ^ 1);
            const int vc = L - j * 64;
            if (vc < 64) {
                const int vch = vc - 4 * h;
#pragma unroll
                for (int r = 0; r < 16; ++r) {
                    if ((r & 3) + 8 * (r >> 2) >= vch) s0[r] = -INFINITY;
                    if ((r & 3) + 8 * (r >> 2) + 32 >= vch) s1[r] = -INFINITY;
                }
            }
            float mx = fmaxf(s0[0], s1[0]);
#pragma unroll
            for (int r = 1; r < 16; ++r) mx = fmaxf(mx, fmaxf(s0[r], s1[r]));
            mx = fmaxf(mx, __shfl_xor(mx, 32));
            const float m_new = fmaxf(m_run, mx);
            const float alpha = __builtin_amdgcn_exp2f(m_run - m_new);
            m_run = m_new;
            float ls = 0.f;
#pragma unroll
            for (int r = 0; r < 16; ++r) { s0[r] = __builtin_amdgcn_exp2f(s0[r] - m_new); s1[r] = __builtin_amdgcn_exp2f(s1[r] - m_new); ls += s0[r] + s1[r]; }
            l_run = l_run * alpha + ls;
            if (__any(alpha != 1.0f)) {
#pragma unroll
                for (int d = 0; d < 4; ++d)
#pragma unroll
                    for (int r = 0; r < 16; ++r) o[d][r] *= alpha;
            }
            bf16x8 pb[4];
            {
                u32x4 w;
                w.x = cvt_pk_bf16(s0[0], s0[1]); w.y = cvt_pk_bf16(s0[2], s0[3]); w.z = cvt_pk_bf16(s0[4], s0[5]); w.w = cvt_pk_bf16(s0[6], s0[7]); pb[0] = __builtin_bit_cast(bf16x8, w);
                w.x = cvt_pk_bf16(s0[8], s0[9]); w.y = cvt_pk_bf16(s0[10], s0[11]); w.z = cvt_pk_bf16(s0[12], s0[13]); w.w = cvt_pk_bf16(s0[14], s0[15]); pb[1] = __builtin_bit_cast(bf16x8, w);
                w.x = cvt_pk_bf16(s1[0], s1[1]); w.y = cvt_pk_bf16(s1[2], s1[3]); w.z = cvt_pk_bf16(s1[4], s1[5]); w.w = cvt_pk_bf16(s1[6], s1[7]); pb[2] = __builtin_bit_cast(bf16x8, w);
                w.x = cvt_pk_bf16(s1[8], s1[9]); w.y = cvt_pk_bf16(s1[10], s1[11]); w.z = cvt_pk_bf16(s1[12], s1[13]); w.w = cvt_pk_bf16(s1[14], s1[15]); pb[3] = __builtin_bit_cast(bf16x8, w);
            }
            if (j + 1 < ntiles) ATT_LOADV(j + 1);
            const LAS unsigned char* vb = kb + KBYTES;
#pragma unroll
            for (int d = 0; d < 4; ++d)
#pragma unroll
                for (int ks = 0; ks < 4; ++ks) {
                    const LAS unsigned char* ap = vb + (d * 32 + l32) * VROW + (16 * ks + 4 * h) * 2;
                    const u32x2 lo = *(const LAS u32x2*)ap, hi = *(const LAS u32x2*)(ap + 16);
                    const u32x4 w = (u32x4){lo.x, lo.y, hi.x, hi.y};
                    o[d] = mfma32(__builtin_bit_cast(bf16x8, w), pb[ks], o[d]);
                    if (ks == 3) __builtin_amdgcn_sched_barrier(0);
                }
            if (j + 1 < ntiles) ATT_STORE(buf ^ 1);
            __syncthreads();
        }
        l_run += __shfl_xor(l_run, 32);
        const float inv = 1.0f / l_run;
#if DEBUG_CHECK == 5
        bf16_t* orow = (bf16_t*)(launder(p.ws) + OFF_ODBG) + (size_t)qrow * 512 + head * 128;
#else
        bf16_t* orow = Q + (size_t)qrow * 768 + head * 192;
#endif
#pragma unroll
        for (int d = 0; d < 4; ++d)
#pragma unroll
            for (int rq = 0; rq < 4; ++rq) {
                const u32x2 w = (u32x2){cvt_pk_bf16(o[d][4 * rq] * inv, o[d][4 * rq + 1] * inv), cvt_pk_bf16(o[d][4 * rq + 2] * inv, o[d][4 * rq + 3] * inv)};
                *(GAS u32x2*)(orow + 32 * d + 8 * rq + 4 * h) = w;
            }
#undef ATT_LOAD
#undef ATT_LOADV
#undef ATT_STORE
#undef ATT_STOREK
    }
}

template <int SET> __device__ __forceinline__ void hyena_unit(const Params& p, LAS unsigned char* lds, int c, int bg) {
    constexpr int P = SET ? 32 : 128;
    constexpr int NBU = SET ? 16 : 4;
    constexpr int NBT = SET ? 8 : 2;
    constexpr int GP = SET ? 4 : 16;
    constexpr int LG = SET ? LGS : LGP;
    constexpr int NB = SET ? NBS : NBP;
    constexpr int RS = SET ? 4896 : 18816;
    constexpr int GBYTES = 2 * LG * 2;
    constexpr int G1OFF = 33220;
    constexpr int ZOFF = 66560;
    unsigned char* ws = launder(p.ws);
    const int tid = tid_l(), lane = tid & 63, wave = tid >> 6, h = lane >> 5, l32 = lane & 31;
    const bf16_t* X1T = (const bf16_t*)(ws + OFF_X1T) + (SET ? XT_SET1 : 0);
    bf16_t* X2T = (bf16_t*)(ws + OFF_X2T) + (SET ? XT_SET1 : 0);
    const bf16_t* V0T = (const bf16_t*)(ws + OFF_V0T) + (SET ? XT_SET1 : 0);
    const bf16_t* GR = (const bf16_t*)(ws + (SET ? OFF_GR1 : OFF_GR0));
    const float* hy_bias = launder(p.in[17]);
    LAS unsigned char* gL = lds; LAS unsigned char* zL = lds + ZOFF;
    const size_t rowbase = ((size_t)c * NB + bg * NBU) * LG;
    for (int id = tid; id < NBU * (P + 1) * 8; id += 512) {
        const int bl = id / ((P + 1) * 8), rem = id % ((P + 1) * 8), blk = rem >> 3, ch = rem & 7;
        *(LAS u32x4*)(zL + bl * RS + blk * 144 + ch * 16) = *(const GAS u32x4*)(V0T + rowbase + (size_t)bl * LG + blk * 64 + ch * 8);
    }
    for (int id = tid; id < NBU * 9; id += 512) { const int bl = id / 9, ch = id % 9; *(LAS u32x4*)(zL + bl * RS + (P + 1) * 144 + ch * 16) = (u32x4){0u, 0u, 0u, 0u}; }
#define HY_LOADG(rowidx) do { const unsigned* g32_ = (const unsigned*)(GR + (size_t)(rowidx) * (2 * LG)); \
        for (int id = tid; id < GBYTES / 4; id += 512) { const unsigned a_ = g32_[id], b_ = (id + 1 < GBYTES / 4) ? g32_[id + 1] : 0u; \
            *(LAS unsigned*)(gL + id * 4) = a_; *(LAS unsigned*)(gL + G1OFF + id * 4) = (a_ >> 16) | (b_ << 16); } } while (0)
    HY_LOADG(c);
    __syncthreads();
    const LAS unsigned short* g16 = (const LAS unsigned short*)gL;
    constexpr int PARTS = 512 / (NBU * 16);
    float zmeta = 0.f; int mo_bl, mo_m;
    {
        const int part = tid % PARTS, out = tid / PARTS; mo_bl = out >> 4; mo_m = out & 15;
        const LAS unsigned char* zr = zL + mo_bl * RS;
        float a = 0.f;
        for (int tt = 48 + part; tt < LG; tt += PARTS) {
            const float zv = bf2f(*(const LAS unsigned short*)(zr + (tt >> 6) * 144 + (tt & 63) * 2));
            const float gv = bf2f(g16[LG - mo_m - 48 + tt]);
            a += zv * gv;
        }
#pragma unroll
        for (int o = 1; o < PARTS; o <<= 1) a += __shfl_xor(a, o);
        const float bias0 = hy_bias[c];
        const float z0 = bf2f(*(const LAS unsigned short*)(zr + (48 + mo_m) * 2));
        const float x1 = bf2f(X1T[rowbase + (size_t)mo_bl * LG + 48 + mo_m]);
        zmeta = x1 * (a + z0 * bias0);
    }
    const int p0 = GP * wave;
    const int pp = l32 / NBT, blA = l32 % NBT, blB = NBT + blA;
#pragma unroll 1
    for (int order = 0; order < 2; ++order) {
        f32x16 acc[2][2];
#pragma unroll
        for (int a = 0; a < 2; ++a)
#pragma unroll
            for (int b = 0; b < 2; ++b)
#pragma unroll
                for (int r = 0; r < 16; ++r) acc[a][b][r] = 0.f;
        bf16x8 Ep4, Ep5;
        {
            const int d0 = p0 - (P - 1); const int ib0 = LG - 64 * d0 - l32 + 8 * h;
            const LAS unsigned char* g0 = gL + (l32 & 1) * G1OFF + (ib0 >> 1) * 4;
            const LAS unsigned* ga = (const LAS unsigned*)(g0 + 96); const LAS unsigned* gb = (const LAS unsigned*)(g0 + 64);
            Ep4 = __builtin_bit_cast(bf16x8, (u32x4){ga[0], ga[1], ga[2], ga[3]}); Ep5 = __builtin_bit_cast(bf16x8, (u32x4){gb[0], gb[1], gb[2], gb[3]});
        }
#pragma unroll 1
        for (int d = p0 - (P - 1); d <= p0 + GP; ++d) {
            bf16x8 E[6];
            const int ib = LG - 64 * d - l32 + 8 * h;
            const LAS unsigned char* gpl = gL + (l32 & 1) * G1OFF + (ib >> 1) * 4;
            E[0] = Ep4; E[1] = Ep5;
#pragma unroll
            for (int e = 2; e < 6; ++e) {
                const LAS unsigned* gp = (const LAS unsigned*)(gpl - 32 * (e - 3));
                const u32x4 w = (u32x4){gp[0], gp[1], gp[2], gp[3]};
                E[e] = __builtin_bit_cast(bf16x8, w);
            }
            Ep4 = E[4]; Ep5 = E[5];
            const int q = p0 + pp - d;
            const int slot = ((unsigned)(q + 1) <= (unsigned)P) ? q + 1 : P + 1;
            const LAS unsigned char* zA = zL + blA * RS + slot * 144 + h * 16;
            const LAS unsigned char* zB = zL + blB * RS + slot * 144 + h * 16;
#pragma unroll
            for (int ks = 0; ks < 4; ++ks) {
                const bf16x8 ba = *(const LAS bf16x8*)(zA + ks * 32);
                const bf16x8 bb = *(const LAS bf16x8*)(zB + ks * 32);
#pragma unroll
                for (int m = 0; m < 2; ++m) {
                    acc[0][m] = mfma32(E[2 * m - ks + 3], ba, acc[0][m]);
                    acc[1][m] = mfma32(E[2 * m - ks + 3], bb, acc[1][m]);
                }
            }
        }
        __syncthreads();
        const float bias = hy_bias[order * 512 + c];
#pragma unroll
        for (int tl = 0; tl < 2; ++tl) {
            const int bl = tl ? blB : blA;
            const size_t grow = rowbase + (size_t)bl * LG + 64 * (p0 + pp + 1);
            LAS unsigned char* zr = zL + bl * RS + (p0 + pp + 1) * 144;
#pragma unroll
            for (int m = 0; m < 2; ++m)
#pragma unroll
                for (int rq = 0; rq < 4; ++rq) {
                    const int off = 32 * m + 8 * rq + 4 * h;
                    const u32x2 zw = *(const LAS u32x2*)(zr + off * 2);
                    const u32x2 xw = *(const GAS u32x2*)((order ? (const bf16_t*)X2T : X1T) + grow + off);
                    const float y0 = acc[tl][m][4 * rq], y1 = acc[tl][m][4 * rq + 1], y2 = acc[tl][m][4 * rq + 2], y3 = acc[tl][m][4 * rq + 3];
                    const float r0 = bflo(xw.x) * (y0 + bflo(zw.x) * bias), r1 = bfhi(xw.x) * (y1 + bfhi(zw.x) * bias);
                    const float r2 = bflo(xw.y) * (y2 + bflo(zw.y) * bias), r3 = bfhi(xw.y) * (y3 + bfhi(zw.y) * bias);
                    const u32x2 w = (u32x2){cvt_pk_bf16(r0, r1), cvt_pk_bf16(r2, r3)};
#if DEBUG_CHECK == 5
                    if (order == 0) *(LAS u32x2*)(zr + off * 2) = w; else *(GAS u32x2*)((bf16_t*)(ws + OFF_HDBG) + (SET ? XT_SET1 : 0) + grow + off) = w;
#else
                    if (order == 0) *(LAS u32x2*)(zr + off * 2) = w; else *(GAS u32x2*)(X2T + grow + off) = w;
#endif
                }
        }
        if (order == 0) {
            if ((tid % PARTS) == 0) *(LAS unsigned short*)(zL + mo_bl * RS + (48 + mo_m) * 2) = (unsigned short)(cvt_pk_bf16(zmeta, 0.f) & 0xffffu);
            HY_LOADG(512 + c);
        }
        __syncthreads();
    }
}
#undef HY_LOADG
__device__ __forceinline__ void hyena_phase(const Params& p, LAS unsigned char* lds) {
    for (int u = blockIdx.x; u < 2048; u += gridDim.x) {
        if (u < 1024) hyena_unit<0>(p, lds, u >> 1, u & 1); else hyena_unit<1>(p, lds, (u - 1024) >> 1, u & 1);
    }
}

__device__ __forceinline__ void mixnorm_phase(const Params& p, LAS unsigned char* lds) {
    unsigned char* ws = launder(p.ws); const int tid = tid_l(), lane = tid & 63, wave = tid >> 6, G = gridDim.x;
    const bf16_t* Q = (const bf16_t*)(launder((unsigned char*)p.out) + DO_Q);
    bf16_t* MIXN = (bf16_t*)(ws + OFF_MIXN);
    const float* ga = launder(p.in[18]); const float* gh = launder(p.in[19]);
    constexpr int RSB = 1040;
    for (int u = blockIdx.x; u < 2048; u += G) {
        const int n0 = u * 64;
        int set, b, tok0;
        if (n0 < 65536) { set = 0; b = n0 >> 13; tok0 = n0 & 8191; } else { set = 1; const int q = n0 - 65536; b = q >> 11; tok0 = q & 2047; }
        const int Lg = set ? LGS : LGP, NB = set ? NBS : NBP;
        {
            const int c = tid;
#if DEBUG_CHECK == 5
            const bf16_t* src = (const bf16_t*)(ws + OFF_HDBG) + (set ? XT_SET1 : 0) + ((size_t)c * NB + b) * Lg + tok0 + 64;
#else
            const bf16_t* src = (const bf16_t*)(ws + OFF_X2T) + (set ? XT_SET1 : 0) + ((size_t)c * NB + b) * Lg + tok0 + 64;
#endif
            LAS unsigned short* tl = (LAS unsigned short*)lds + c;
#pragma unroll
            for (int k8 = 0; k8 < 8; ++k8) {
                const u32x4 v = *(const GAS u32x4*)(src + k8 * 8);
                tl[(k8 * 8 + 0) * (RSB / 2)] = (unsigned short)(v.x & 0xffffu); tl[(k8 * 8 + 1) * (RSB / 2)] = (unsigned short)(v.x >> 16);
                tl[(k8 * 8 + 2) * (RSB / 2)] = (unsigned short)(v.y & 0xffffu); tl[(k8 * 8 + 3) * (RSB / 2)] = (unsigned short)(v.y >> 16);
                tl[(k8 * 8 + 4) * (RSB / 2)] = (unsigned short)(v.z & 0xffffu); tl[(k8 * 8 + 5) * (RSB / 2)] = (unsigned short)(v.z >> 16);
                tl[(k8 * 8 + 6) * (RSB / 2)] = (unsigned short)(v.w & 0xffffu); tl[(k8 * 8 + 7) * (RSB / 2)] = (unsigned short)(v.w >> 16);
            }
        }
        __syncthreads();
        for (int i = 0; i < 8; ++i) {
            const int rr = wave + 8 * i; const int n = n0 + rr; const int r = full_row(n);
            const u32x4 hv = *(const LAS u32x4*)(lds + rr * RSB + lane * 16);
#if DEBUG_CHECK == 5
            const u32x4 av = *(const GAS u32x4*)((const bf16_t*)(ws + OFF_ODBG) + (size_t)r * 512 + lane * 8);
#else
            const u32x4 av = *(const GAS u32x4*)(Q + (size_t)r * 768 + (lane >> 4) * 192 + (lane & 15) * 8);
#endif
            float hf[8] = {bflo(hv.x), bfhi(hv.x), bflo(hv.y), bfhi(hv.y), bflo(hv.z), bfhi(hv.z), bflo(hv.w), bfhi(hv.w)};
            float af[8] = {bflo(av.x), bfhi(av.x), bflo(av.y), bfhi(av.y), bflo(av.z), bfhi(av.z), bflo(av.w), bfhi(av.w)};
            float sh = 0.f, sa = 0.f;
#pragma unroll
            for (int k = 0; k < 8; ++k) { sh += hf[k] * hf[k]; sa += af[k] * af[k]; }
            sh = wave_sum(sh); sa = wave_sum(sa);
            const float rh = rsqrtf(sh * (1.f / 512.f) + EPS), ra = rsqrtf(sa * (1.f / 512.f) + EPS);
            const f32x4 ga0 = *(const GAS f32x4*)(ga + lane * 8), ga1 = *(const GAS f32x4*)(ga + lane * 8 + 4);
            const f32x4 gh0 = *(const GAS f32x4*)(gh + lane * 8), gh1 = *(const GAS f32x4*)(gh + lane * 8 + 4);
            u32x4 wa, wh;
            wa.x = cvt_pk_bf16(af[0] * ra * ga0[0], af[1] * ra * ga0[1]); wa.y = cvt_pk_bf16(af[2] * ra * ga0[2], af[3] * ra * ga0[3]);
            wa.z = cvt_pk_bf16(af[4] * ra * ga1[0], af[5] * ra * ga1[1]); wa.w = cvt_pk_bf16(af[6] * ra * ga1[2], af[7] * ra * ga1[3]);
            wh.x = cvt_pk_bf16(hf[0] * rh * gh0[0], hf[1] * rh * gh0[1]); wh.y = cvt_pk_bf16(hf[2] * rh * gh0[2], hf[3] * rh * gh0[3]);
            wh.z = cvt_pk_bf16(hf[4] * rh * gh1[0], hf[5] * rh * gh1[1]); wh.w = cvt_pk_bf16(hf[6] * rh * gh1[2], hf[7] * rh * gh1[3]);
#if EXPT == 1
            wa = (u32x4){0u, 0u, 0u, 0u};
#endif
#if EXPT == 2
            wh = (u32x4){0u, 0u, 0u, 0u};
#endif
            *(GAS u32x4*)(MIXN + (size_t)n * 1024 + lane * 8) = wa;
            *(GAS u32x4*)(MIXN + (size_t)n * 1024 + 512 + lane * 8) = wh;
        }
        __syncthreads();
    }
}

__device__ __forceinline__ void h1_phase(const Params& p) {
    unsigned char* ws = launder(p.ws); const int tid = tid_l(), lane = tid & 63, wave = tid >> 6;
    const int gw = blockIdx.x * 8 + wave, NGW = gridDim.x * 8;
    const bf16_t* MIX = (const bf16_t*)(ws + OFF_MIX); bf16_t* H1B = (bf16_t*)(ws + OFF_H1B);
    const float* sqmix = (const float*)(ws + OFF_SQMIXP); float* r1 = (float*)(ws + OFF_R1); const float* g = p.in[21];
    for (int n = gw; n < TN; n += NGW) {
        const float* xrow = n < 65536 ? p.in[0] + (size_t)n * 1024 : p.in[1] + (size_t)(n - 65536) * 1024;
        const float rm = rsqrtf(wave_sum(lane < 16 ? ldco(sqmix + (size_t)n * 16 + lane) : 0.f) * (1.f / 1024.f) + EPS);
        float ss = 0.f;
#pragma unroll
        for (int hh = 0; hh < 2; ++hh) {
            const int c0 = hh * 512 + lane * 8;
            const u32x4 mv = *(const u32x4*)(MIX + (size_t)n * 1024 + c0);
            const f32x4 x0 = *(const f32x4*)(xrow + c0), x1 = *(const f32x4*)(xrow + c0 + 4);
            const f32x4 g0 = *(const f32x4*)(g + c0), g1 = *(const f32x4*)(g + c0 + 4);
            f32x4 h0, h1;
            h0[0] = x0[0] + bflo(mv.x) * rm * g0[0]; h0[1] = x0[1] + bfhi(mv.x) * rm * g0[1]; h0[2] = x0[2] + bflo(mv.y) * rm * g0[2]; h0[3] = x0[3] + bfhi(mv.y) * rm * g0[3];
            h1[0] = x1[0] + bflo(mv.z) * rm * g1[0]; h1[1] = x1[1] + bfhi(mv.z) * rm * g1[1]; h1[2] = x1[2] + bflo(mv.w) * rm * g1[2]; h1[3] = x1[3] + bfhi(mv.w) * rm * g1[3];
            ss += sq8(h0, h1);
            *(f32x4*)(p.out + (size_t)n * 1024 + c0) = h0; *(f32x4*)(p.out + (size_t)n * 1024 + c0 + 4) = h1;
            *(u32x4*)(H1B + (size_t)n * 1024 + c0) = pack8(h0, h1);
        }
        ss = wave_sum(ss);
        if (lane == 0) r1[n] = rsqrtf(ss * (1.f / 1024.f) + EPS);
    }
}
__device__ __forceinline__ void final_phase(const Params& p, int half) {
    unsigned char* ws = launder(p.ws); const int tid = tid_l(), lane = tid & 63, wave = tid >> 6;
    const int gw = blockIdx.x * 8 + wave, NGW = gridDim.x * 8;
    const bf16_t* M2 = (const bf16_t*)(ws + OFF_M2); const float* sqm2 = (const float*)(ws + OFF_SQM2P); const float* g = p.in[25];
    float dbg_off = 0.f, dbg_one = 0.f;
#if DEBUG_CHECK
    { const unsigned* dc = (const unsigned*)(ws + OFF_DBGW); dbg_off = 100.f * (float)dc[8] * (1.f / 131072.f); dbg_one = 1000.f * (float)dc[9] * (1.f / 131072.f); }
#endif
    for (int i = gw; i < 65536; i += NGW) {
        const int n = half * 65536 + i;
        const float rm = rsqrtf(wave_sum(lane < 16 ? ldco(sqm2 + (size_t)n * 16 + lane) : 0.f) * (1.f / 1024.f) + EPS);
#pragma unroll
        for (int hh = 0; hh < 2; ++hh) {
            const int c0 = hh * 512 + lane * 8;
            const u32x4 mv = *(const u32x4*)(M2 + (size_t)i * 1024 + c0);
            f32x4 h0 = *(const f32x4*)(p.out + (size_t)n * 1024 + c0), h1 = *(const f32x4*)(p.out + (size_t)n * 1024 + c0 + 4);
            const f32x4 g0 = *(const f32x4*)(g + c0), g1 = *(const f32x4*)(g + c0 + 4);
            h0 += dbg_off; h1 += dbg_off; if (n == 0 && c0 == 0) h0[0] += dbg_one;
            h0[0] += bflo(mv.x) * rm * g0[0]; h0[1] += bfhi(mv.x) * rm * g0[1]; h0[2] += bflo(mv.y) * rm * g0[2]; h0[3] += bfhi(mv.y) * rm * g0[3];
            h1[0] += bflo(mv.z) * rm * g1[0]; h1[1] += bfhi(mv.z) * rm * g1[1]; h1[2] += bflo(mv.w) * rm * g1[2]; h1[3] += bfhi(mv.w) * rm * g1[3];
            *(f32x4*)(p.out + (size_t)n * 1024 + c0) = h0; *(f32x4*)(p.out + (size_t)n * 1024 + c0 + 4) = h1;
        }
    }
}


#if DEBUG_CHECK
constexpr size_t OFF_DBG = OFF_DBGW;
__device__ __forceinline__ void check_gemm(const bf16_t* A, int lda, const bf16_t* Bt, int ldb, int K, int M, int N, int mode, const bf16_t* O, int ldc, const float* rs, unsigned* cnt, int col_lo) {
    const unsigned idx = blockIdx.x * 512u + (unsigned)tid_l();
    unsigned hsh = idx * 2654435761u + 12345u + (unsigned)mode * 977u; hsh ^= hsh >> 15; hsh *= 2246822519u; hsh ^= hsh >> 13;
    const int row = (int)(hsh % (unsigned)M); hsh = hsh * 3266489917u + 668265263u; hsh ^= hsh >> 16;
    const int col = col_lo + (int)(hsh % (unsigned)(N - col_lo));
    float d = 0.f;
    for (int k = 0; k < K; ++k) d += bf2f(A[(size_t)row * lda + k]) * bf2f(Bt[(size_t)col * ldb + k]);
    float e = d;
    if (mode == 0 || mode == 7) e = d * rs[row];
    if (mode == 5) { const float t = fmaxf(d * rs[row], 0.f); e = t * t; }
    const float st = bf2f(O[(size_t)row * ldc + col]);
    if (!(fabsf(st - e) <= 0.03f * fabsf(e) + 0.03f)) atomicAdd(cnt, 1u);
}
#endif

#if DEBUG_CHECK == 2
__device__ __forceinline__ void check_proj(const Params& p) {
    unsigned char* ws = launder(p.ws); unsigned char* ob = launder((unsigned char*)p.out);
    const bf16_t* P = (const bf16_t*)(ws + OFF_P); unsigned* cnt = (unsigned*)(ws + OFF_DBG);
    const unsigned idx = blockIdx.x * 512u + (unsigned)tid_l();
    unsigned hsh = idx * 2654435761u + 777u; hsh ^= hsh >> 15; hsh *= 2246822519u; hsh ^= hsh >> 13;
    const int row = (int)(hsh % (unsigned)T); hsh = hsh * 3266489917u + 668265263u; hsh ^= hsh >> 16;
    int pos, seq; row_info(row, pos, seq);
    {
        const int n = (int)(hsh % 768u); const int hh = n / 192, w = n % 192;
        float ss = 0.f, x1 = 0.f, x2 = 0.f; const float* W = p.in[6]; const float* g = p.in[5];
        const int j = w - 128, i = j >> 1;
        const int c1 = w < 128 ? hh * 192 + w : hh * 192 + 128 + i, c2 = hh * 192 + 160 + (w < 128 ? 0 : i);
        for (int k = 0; k < 256; ++k) { const float a = bf2f(P[(size_t)row * NPP + k]); ss += a * a; x1 += a * g[k] * W[k * 768 + c1]; x2 += a * g[k] * W[k * 768 + c2]; }
        const float rq = rsqrtf(ss * (1.f / 256.f) + EPS) * QSCALE; x1 *= rq; x2 *= rq;
        float e = x1;
        if (w >= 128) { const float inv = 1.0f / exp2f((float)i * (13.287712379549449f / 32.f)); float sn, cs; sincos_red((float)pos * inv, sn, cs); e = (j & 1) ? x2 * cs + x1 * sn : x1 * cs - x2 * sn; }
        const float st = bf2f(((const bf16_t*)(ob + DO_Q))[(size_t)row * 768 + n]);
        if (!(fabsf(st - e) <= 0.03f * fabsf(e) + 0.01f)) atomicAdd(cnt + (w < 128 ? 0 : 4), 1u);
    }
    {
        const int n = (int)((hsh >> 3) % 512u); const int hh = n >> 7, i = n & 127;
        float ss = 0.f, x1 = 0.f, x2 = 0.f; const float* W = p.in[8]; const float* g = p.in[7];
        for (int k = 0; k < 128; ++k) { const float a = bf2f(P[(size_t)row * NPP + 256 + k]); ss += a * a; x1 += a * g[k] * W[k * 1024 + hh * 256 + i]; x2 += a * g[k] * W[k * 1024 + hh * 256 + 128 + i]; }
        const float rk = rsqrtf(ss * (1.f / 128.f) + EPS); x1 *= rk; x2 *= rk;
        const float s1 = bf2f(((const bf16_t*)(ob + DO_KN))[(size_t)row * 512 + n]);
        const float s2 = bf2f(((const bf16_t*)(ob + DO_VT))[(size_t)n * TPAD + row]);
        if (!(fabsf(s1 - x1) <= 0.03f * fabsf(x1) + 0.03f)) atomicAdd(cnt + 1, 1u);
        if (!(fabsf(s2 - x2) <= 0.03f * fabsf(x2) + 0.03f)) atomicAdd(cnt + 2, 1u);
    }
    {
        const int jj = (int)((hsh >> 5) % 64u); const int i = jj >> 1;
        const float* xr = pos < 16 ? p.in[2] + (size_t)pos * 1024 : (seq < NBP ? p.in[0] + ((size_t)seq * 8192 + (pos - 16)) * 1024 : p.in[1] + ((size_t)(seq - NBP) * 2048 + (pos - 16)) * 1024);
        const float* W = p.in[4]; const float* g = p.in[3]; float x1 = 0.f, x2 = 0.f;
        for (int k = 0; k < 1024; ++k) { const float a = xr[k] * g[k]; x1 += a * W[(size_t)k * 1984 + 384 + i]; x2 += a * W[(size_t)k * 1984 + 416 + i]; }
        const float r0 = ((const float*)(ws + OFF_R0))[row]; x1 *= r0; x2 *= r0;
        const float inv = 1.0f / exp2f((float)i * (13.287712379549449f / 32.f)); float sn, cs; sincos_red((float)pos * inv, sn, cs);
        const float e = (jj & 1) ? x2 * cs + x1 * sn : x1 * cs - x2 * sn;
        const float st = bf2f(((const bf16_t*)(ob + DO_KR))[(size_t)row * 64 + jj]);
        if (!(fabsf(st - e) <= 0.03f * fabsf(e) + 0.03f)) { atomicAdd(cnt + 3, 1u); atomicAdd(cnt + 5, (unsigned)i); atomicAdd(cnt + 6, (unsigned)(pos >> 3)); }
    }
}
#endif

#if DEBUG_CHECK == 3
__device__ __forceinline__ void check_h0b(const Params& p, int slot) {
    unsigned char* ws = launder(p.ws); unsigned* cnt = (unsigned*)(ws + OFF_DBGW);
    const bf16_t* h0b = (const bf16_t*)(ws + OFF_H0B);
    const unsigned idx = blockIdx.x * 512u + (unsigned)tid_l();
    unsigned hsh = idx * 2654435761u + 4242u + (unsigned)slot * 31u; hsh ^= hsh >> 15; hsh *= 2246822519u; hsh ^= hsh >> 13;
    const int row = (int)(hsh % (unsigned)T); hsh = hsh * 3266489917u + 668265263u; hsh ^= hsh >> 16;
    const int col = (int)(hsh % 1024u);
    int pos, seq; row_info(row, pos, seq);
    const float* xr = pos < 16 ? p.in[2] + (size_t)pos * 1024 : (seq < NBP ? p.in[0] + ((size_t)seq * 8192 + (pos - 16)) * 1024 : p.in[1] + ((size_t)(seq - NBP) * 2048 + (pos - 16)) * 1024);
    const float e = xr[col]; const float st = bf2f(h0b[(size_t)row * 1024 + col]);
    if (!(fabsf(st - e) <= 0.01f * fabsf(e) + 0.001f)) atomicAdd(cnt + slot, 1u);
}
#endif

#if DEBUG_CHECK == 4
__device__ __forceinline__ void check_stale(const Params& p, const unsigned* base, unsigned ndw, int slot) {
    unsigned* cnt = (unsigned*)(launder(p.ws) + OFF_DBGW);
    const unsigned idx = blockIdx.x * 512u + (unsigned)tid_l();
    unsigned hsh = idx * 2654435761u + 999u + (unsigned)slot * 131u; hsh ^= hsh >> 15; hsh *= 2246822519u; hsh ^= hsh >> 13;
#pragma unroll 1
    for (int it = 0; it < 16; ++it) {
        hsh = hsh * 3266489917u + 668265263u; hsh ^= hsh >> 16;
        const unsigned i = hsh % ndw;
        const unsigned a = base[i];
        const unsigned b = __hip_atomic_load(base + i, __ATOMIC_RELAXED, __HIP_MEMORY_SCOPE_AGENT);
        if (a != b) atomicAdd(cnt + slot, 1u);
    }
}
#endif

#if DEBUG_CHECK == 5
__device__ __forceinline__ void check_attn(const Params& p) {
    unsigned char* ws = launder(p.ws); unsigned char* ob = launder((unsigned char*)p.out); unsigned* cnt = (unsigned*)(ws + OFF_DBGW);
    const int tid = tid_l(), lane = tid & 63, wave = tid >> 6;
    const bf16_t* Q = (const bf16_t*)(ob + DO_Q); const bf16_t* KN = (const bf16_t*)(ob + DO_KN); const bf16_t* KR = (const bf16_t*)(ob + DO_KR); const bf16_t* VT = (const bf16_t*)(ob + DO_VT);
    const bf16_t* OD = (const bf16_t*)(ws + OFF_ODBG); const float2* RT = (const float2*)(ws + OFF_RT);
    unsigned hsh = (unsigned)(blockIdx.x * 8 + wave) * 2654435761u + 31337u; hsh ^= hsh >> 15; hsh *= 2246822519u; hsh ^= hsh >> 13;
    const int n = (int)(hsh % (unsigned)TN); const int head = (int)((hsh >> 20) & 3u); const int r = full_row(n);
    int pos, seq; row_info(r, pos, seq);
    const int L = seq < NBP ? LP : LS; const int row0 = r - pos;
    const bf16_t* qp = Q + (size_t)r * 768 + head * 192;
    float mx = -INFINITY;
    for (int k = lane; k < L; k += 64) {
        float sdot = 0.f;
        for (int d = 0; d < 128; ++d) sdot += bf2f(qp[d]) * bf2f(KN[(size_t)(row0 + k) * 512 + head * 128 + d]);
        for (int i = 0; i < 32; ++i) { const float2 cs = ldco2(RT + pos * 32 + i); const float a = bf2f(qp[128 + 2 * i]), b = bf2f(qp[129 + 2 * i]);
            sdot += (a * cs.x - b * cs.y) * bf2f(KR[(size_t)(row0 + k) * 64 + 2 * i]) + (b * cs.x + a * cs.y) * bf2f(KR[(size_t)(row0 + k) * 64 + 2 * i + 1]); }
        mx = fmaxf(mx, sdot);
    }
#pragma unroll
    for (int o = 1; o < 64; o <<= 1) mx = fmaxf(mx, __shfl_xor(mx, o));
    float sw = 0.f, o0 = 0.f, o1 = 0.f; const int dv0 = (int)((hsh >> 8) & 127u), dv1 = (dv0 + 37) & 127;
    for (int k = lane; k < L; k += 64) {
        float sdot = 0.f;
        for (int d = 0; d < 128; ++d) sdot += bf2f(qp[d]) * bf2f(KN[(size_t)(row0 + k) * 512 + head * 128 + d]);
        for (int i = 0; i < 32; ++i) { const float2 cs = ldco2(RT + pos * 32 + i); const float a = bf2f(qp[128 + 2 * i]), b = bf2f(qp[129 + 2 * i]);
            sdot += (a * cs.x - b * cs.y) * bf2f(KR[(size_t)(row0 + k) * 64 + 2 * i]) + (b * cs.x + a * cs.y) * bf2f(KR[(size_t)(row0 + k) * 64 + 2 * i + 1]); }
        const float w = exp2f(sdot - mx); sw += w;
        o0 += w * bf2f(VT[(size_t)(head * 128 + dv0) * TPAD + row0 + k]); o1 += w * bf2f(VT[(size_t)(head * 128 + dv1) * TPAD + row0 + k]);
    }
    sw = wave_sum(sw); o0 = wave_sum(o0) / sw; o1 = wave_sum(o1) / sw;
    if (lane == 0) {
        const float s0 = bf2f(OD[(size_t)r * 512 + head * 128 + dv0]), s1 = bf2f(OD[(size_t)r * 512 + head * 128 + dv1]);
        atomicAdd(cnt + 10, 2u);
        if (!(fabsf(s0 - o0) <= 0.05f * fabsf(o0) + 0.002f)) atomicAdd(cnt + 8, 1u);
        if (!(fabsf(s1 - o1) <= 0.05f * fabsf(o1) + 0.002f)) atomicAdd(cnt + 8, 1u);
    }
}
__device__ __forceinline__ void check_hyena(const Params& p, LAS unsigned char* lds) {
    unsigned char* ws = launder(p.ws); unsigned* cnt = (unsigned*)(ws + OFF_DBGW);
    const int tid = tid_l();
    unsigned hsh = (unsigned)blockIdx.x * 2654435761u + 555u; hsh ^= hsh >> 15; hsh *= 2246822519u; hsh ^= hsh >> 13;
    const int set = (int)(blockIdx.x & 1u); const int c = (int)(hsh % 512u); const int NB = set ? NBS : NBP; const int b = (int)((hsh >> 12) % (unsigned)NB);
    const int LG = set ? LGS : LGP;
    const size_t base = (set ? XT_SET1 : 0) + ((size_t)c * NB + b) * LG;
    const bf16_t* X1 = (const bf16_t*)(ws + OFF_X1T) + base; const bf16_t* X2 = (const bf16_t*)(ws + OFF_X2T) + base; const bf16_t* V0 = (const bf16_t*)(ws + OFF_V0T) + base;
    const bf16_t* HD = (const bf16_t*)(ws + OFF_HDBG) + base;
    const bf16_t* G0 = (const bf16_t*)(ws + (set ? OFF_GR1 : OFF_GR0)) + (size_t)c * (2 * LG); const bf16_t* G1 = G0 + (size_t)512 * (2 * LG);
    const float bias0 = p.in[17][c], bias1 = p.in[17][512 + c];
    LAS float* z1 = (LAS float*)lds;
    for (int t = tid; t < LG; t += 512) {
        float y = 0.f;
        for (int s2 = 48; s2 < LG; ++s2) y += bf2f(G0[LG - (t - s2)]) * bf2f(V0[s2]);
        const float v = bf2f(X1[t]) * (y + bf2f(V0[t]) * bias0);
        z1[t] = (t >= 48) ? bf2f((unsigned short)(cvt_pk_bf16(v, 0.f) & 0xffffu)) : 0.f;
    }
    __syncthreads();
    {
        unsigned h2 = hsh * 3266489917u + (unsigned)tid * 2246822519u; h2 ^= h2 >> 15; h2 *= 2654435761u; h2 ^= h2 >> 13;
        const int t = 64 + (int)(h2 % (unsigned)(LG - 64));
        float y = 0.f;
        for (int s2 = 48; s2 < LG; ++s2) y += bf2f(G1[LG - (t - s2)]) * z1[s2];
        const float e = bf2f(X2[t]) * (y + z1[t] * bias1);
        const float st = bf2f(HD[t]);
        atomicAdd(cnt + 11, 1u);
        if (!(fabsf(st - e) <= 0.05f * fabsf(e) + 1.0f)) atomicAdd(cnt + 9, 1u);
    }
    __syncthreads();
}
#endif

#if DEBUG_CHECK == 7
__device__ __forceinline__ void check_h0b_full(const Params& p, int slot) {
    unsigned char* ws = launder(p.ws); unsigned* cnt = (unsigned*)(ws + OFF_DBGW);
    const bf16_t* h0b = (const bf16_t*)(ws + OFF_H0B);
    const int tid = tid_l(), lane = tid & 63, wave = tid >> 6;
    for (int row = blockIdx.x * 8 + wave; row < T; row += gridDim.x * 8) {
        int pos, seq; row_info(row, pos, seq);
        const float* xr = pos < 16 ? p.in[2] + (size_t)pos * 1024 : (seq < NBP ? p.in[0] + ((size_t)seq * 8192 + (pos - 16)) * 1024 : p.in[1] + ((size_t)(seq - NBP) * 2048 + (pos - 16)) * 1024);
        int bad = 0;
        for (int c = lane; c < 1024; c += 64) { const float e = xr[c]; const float st = bf2f(h0b[(size_t)row * 1024 + c]); if (!(fabsf(st - e) <= 0.01f * fabsf(e) + 0.001f)) bad = 1; }
        bad = __any(bad);
        if (lane == 0 && bad) atomicAdd(cnt + slot, 1u);
    }
}
#endif

#if DEBUG_CHECK == 8
__device__ __forceinline__ void check_p_golden(const Params& p) {
    unsigned char* ws = launder(p.ws); unsigned* cnt = (unsigned*)(ws + OFF_DBGW);
    const bf16_t* P = (const bf16_t*)(ws + OFF_P);
    const unsigned idx = blockIdx.x * 512u + (unsigned)tid_l();
    unsigned hsh = idx * 2654435761u + 8888u; hsh ^= hsh >> 15; hsh *= 2246822519u; hsh ^= hsh >> 13;
    const int row = (int)(hsh % (unsigned)T); hsh = hsh * 3266489917u + 668265263u; hsh ^= hsh >> 16;
    int pos, seq; row_info(row, pos, seq);
    const float* xr = pos < 16 ? p.in[2] + (size_t)pos * 1024 : (seq < NBP ? p.in[0] + ((size_t)seq * 8192 + (pos - 16)) * 1024 : p.in[1] + ((size_t)(seq - NBP) * 2048 + (pos - 16)) * 1024);
    const float* W = p.in[4]; const float* g = p.in[3];
    const int colA = 448 + (int)(hsh % 1536u), colB = (int)((hsh >> 7) % 384u);
    float ss = 0.f, a = 0.f, b = 0.f;
    for (int k = 0; k < 1024; ++k) { const float x = xr[k]; ss += x * x; a += x * g[k] * W[(size_t)k * 1984 + colA]; b += x * g[k] * W[(size_t)k * 1984 + colB]; }
    const float r0 = rsqrtf(ss * (1.f / 1024.f) + EPS); a *= r0; b *= r0;
    const float sa = bf2f(P[(size_t)row * NPP + colA]), sb = bf2f(P[(size_t)row * NPP + colB]);
    if (!(fabsf(sa - a) <= 0.03f * fabsf(a) + 0.03f)) atomicAdd(cnt + 8, 1u);
    if (!(fabsf(sb - b) <= 0.03f * fabsf(b) + 0.03f)) atomicAdd(cnt + 9, 1u);
}
#endif

#if DEBUG_CHECK == 9
__device__ __forceinline__ void check_win_r0(const Params& p) {
    unsigned char* ws = launder(p.ws); unsigned* cnt = (unsigned*)(ws + OFF_DBGW);
    const bf16_t* WT = (const bf16_t*)(ws + OFF_WIN); const float* W = p.in[4]; const float* g = p.in[3]; const float* R0 = (const float*)(ws + OFF_R0);
    const int tid = tid_l(), lane = tid & 63, wave = tid >> 6;
    const int gtid = blockIdx.x * 512 + tid, gthreads = gridDim.x * 512;
    for (int e = gtid; e < 1984 * 1024; e += gthreads) {
        const int n = e >> 10, k = e & 1023; const int sc = src_col(1, n);
        const float ex = W[(size_t)k * 1984 + sc] * g[k]; const float st = bf2f(WT[(size_t)n * 1024 + k]);
        if (!(fabsf(st - ex) <= 0.01f * fabsf(ex) + 1e-5f)) atomicAdd(cnt + 8, 1u);
    }
    for (int row = blockIdx.x * 8 + wave; row < T; row += gridDim.x * 8) {
        int pos, seq; row_info(row, pos, seq);
        const float* xr = pos < 16 ? p.in[2] + (size_t)pos * 1024 : (seq < NBP ? p.in[0] + ((size_t)seq * 8192 + (pos - 16)) * 1024 : p.in[1] + ((size_t)(seq - NBP) * 2048 + (pos - 16)) * 1024);
        float ss = 0.f;
        for (int c = lane; c < 1024; c += 64) ss += xr[c] * xr[c];
        ss = wave_sum(ss);
        const float ex = rsqrtf(ss * (1.f / 1024.f) + EPS); const float st = R0[row];
        if (lane == 0 && !(fabsf(st - ex) <= 0.001f * ex)) { atomicAdd(cnt + 9, 1u); atomicAdd(cnt + 12, (unsigned)(row >> 6)); }
    }
}
#endif

#if DEBUG_CHECK == 10
__device__ __forceinline__ void check_x(const Params& p, int mode) {
    unsigned char* ws = launder(p.ws); unsigned* cnt = (unsigned*)(ws + OFF_DBGW); unsigned* sums = (unsigned*)(ws + OFF_DBGW + MiB);
    const int tid = tid_l(), lane = tid & 63, wave = tid >> 6;
    for (int n = blockIdx.x * 8 + wave; n < TN; n += gridDim.x * 8) {
        const unsigned* xr = (const unsigned*)(n < 65536 ? p.in[0] + (size_t)n * 1024 : p.in[1] + (size_t)(n - 65536) * 1024);
        unsigned a = 0u;
        for (int c = lane; c < 1024; c += 64) a += xr[c] * (2u * (unsigned)c + 1u);
#pragma unroll
        for (int o = 1; o < 64; o <<= 1) a += __shfl_xor(a, o);
        if (lane == 0) {
            if (mode == 0) __hip_atomic_store(sums + n, a, __ATOMIC_RELAXED, __HIP_MEMORY_SCOPE_AGENT);
            else if (__hip_atomic_load(sums + n, __ATOMIC_RELAXED, __HIP_MEMORY_SCOPE_AGENT) != a) atomicAdd(cnt + 8, 1u);
        }
    }
}
#endif

#if DEBUG_CHECK == 11
__device__ __forceinline__ void check_filt_prep(const Params& p) {
    unsigned char* ws = launder(p.ws); unsigned* cnt = (unsigned*)(ws + OFF_DBGW);
    const unsigned idx = blockIdx.x * 512u + (unsigned)tid_l();
    unsigned hsh = idx * 2654435761u + 1111u; hsh ^= hsh >> 15; hsh *= 2246822519u; hsh ^= hsh >> 13;
    {
        const int set = (int)(hsh & 1u); const int L = set ? LS : LP; const int C0 = set ? LGS : LGP;
        const int n = (int)((hsh >> 1) % 2048u); hsh = hsh * 3266489917u + 668265263u; hsh ^= hsh >> 16;
        const int t = (int)(hsh % (unsigned)L);
        const float* f_w1 = p.in[10]; const float* f_b1 = p.in[11]; const float* f_freq = p.in[12]; const float* f_w2 = p.in[13];
        const float* f_b2 = p.in[14]; const float* f_w3 = p.in[15]; const float* f_decay = p.in[16];
        const float tn = (float)t / (float)(L - 1); const float w = (6.2831853071795865f * (float)t) / (float)L;
        float acc = 0.f;
        for (int j2 = 0; j2 < 64; ++j2) {
            float a2 = f_b2[j2];
            for (int j1 = 0; j1 < 64; ++j1) {
                float a1 = f_b1[j1] + tn * f_w1[j1];
                for (int k = 0; k < 16; ++k) { const float f = 1e-4f + (float)k * ((15.0f - 1e-4f) / 15.0f); float sn, cs; sincos_red(f * w, sn, cs);
                    a1 += cs * f_w1[(1 + k) * 64 + j1] - sn * f_w1[(17 + k) * 64 + j1]; }
                a2 += sin_red(f_freq[j1] * a1) * f_w2[j1 * 64 + j2];
            }
            acc += sin_red(f_freq[j2] * a2) * f_w3[j2 * 2048 + n];
        }
        const float e = acc * __expf(-tn * fabsf(f_decay[n]));
        const int order = n >> 10, dir = (n >> 9) & 1, c = n & 511;
        if (!(dir == 1 && t == 0)) {
            const bf16_t* row = (const bf16_t*)(ws + (set ? OFF_GR1 : OFF_GR0)) + (size_t)(order * 512 + c) * (2 * C0);
            const float st = bf2f(row[dir ? C0 + t : C0 - t]);
            if (!(fabsf(st - e) <= 0.02f * fabsf(e) + 0.003f)) atomicAdd(cnt + 8, 1u);
        }
    }
    {
        const int seq = (int)(hsh % 40u); const int set = seq < NBP ? 0 : 1; const int L = set ? LS : LP; const int Lg = set ? LGS : LGP; const int NB = set ? NBS : NBP;
        const int b = set ? seq - NBP : seq; const int row0 = set ? TPR + b * LS : b * LP;
        hsh = hsh * 3266489917u + 668265263u; hsh ^= hsh >> 16;
        const int pos = (int)(hsh % (unsigned)L); const int which = (int)((hsh >> 16) % 3u); const int c = (int)((hsh >> 20) % 512u);
        const bf16_t* P = (const bf16_t*)(ws + OFF_P); const float* cw = p.in[9]; const int col = 448 + which * 512 + c;
        const float um = pos > 0 ? bf2f(P[(size_t)(row0 + pos - 1) * NPP + col]) : 0.f, u0 = bf2f(P[(size_t)(row0 + pos) * NPP + col]), up = pos + 1 < L ? bf2f(P[(size_t)(row0 + pos + 1) * NPP + col]) : 0.f;
        const float e = um * cw[which * 512 + c] + u0 * cw[1536 + which * 512 + c] + up * cw[3072 + which * 512 + c];
        const bf16_t* XT = (const bf16_t*)(ws + (which == 0 ? OFF_X1T : (which == 1 ? OFF_X2T : OFF_V0T))) + (set ? XT_SET1 : 0) + ((size_t)c * NB + b) * Lg;
        const float st = bf2f(XT[pos + 48]);
        if (!(fabsf(st - e) <= 0.02f * fabsf(e) + 0.02f)) atomicAdd(cnt + 9, 1u);
    }
}
#endif
#ifndef SUB_MASK
#define SUB_MASK 15
#endif
#ifndef PHASE_MASK
#define PHASE_MASK 1023
#endif
__global__ void __launch_bounds__(512) hymba_fwd(Params p) {
    extern __shared__ __attribute__((aligned(16))) unsigned char lds_raw[];
    LAS unsigned char* lds = (LAS unsigned char*)lds_raw;
    cg::grid_group grid = cg::this_grid();
#define GSYNC() do { asm volatile("s_waitcnt vmcnt(0) lgkmcnt(0)" ::: "memory"); grid.sync(); } while (0)
    const int G = gridDim.x;
    __builtin_amdgcn_fence(__ATOMIC_SEQ_CST, "agent");
    asm volatile("buffer_inv sc1\n\ts_waitcnt vmcnt(0)" ::: "memory");
#if DEBUG_CHECK == 10
    check_x(p, 0);
#endif
#if PHASE_MASK & 1
    p0_prologue(p, lds);
#endif
    GSYNC();
#if DEBUG_CHECK == 3
    check_h0b(p, 8);
#endif
#if DEBUG_CHECK == 7
    check_h0b_full(p, 8);
#endif
#if DEBUG_CHECK == 4
    check_stale(p, (const unsigned*)(launder(p.ws) + OFF_H0B), (unsigned)((size_t)T * 512), 9);
#endif
#if PHASE_MASK & 2
    {
        unsigned char* ws = launder(p.ws); unsigned char* ob = launder((unsigned char*)p.out);
        pg8::Gemm g{(const bf16_t*)(ws + OFF_H0B), (const bf16_t*)(ws + OFF_WIN), TPAD, 2048, 1024, 1024, 1024};
        pg8::StaticOrder S; S.init(TPAD, 2048, G, blockIdx.x);
        Epi<0> E{(bf16_t*)(ws + OFF_P), NPP, (const float*)(ws + OFF_R0), (float*)(ws + OFF_SQQP), (float*)(ws + OFF_SQKVP), (bf16_t*)(ob + DO_KR), (const float2*)(ws + OFF_RT)};
        pg8::gemm_phase(lds, g, S, E);
    }
#endif
    GSYNC();
#if DEBUG_CHECK == 1
    { unsigned char* ws = launder(p.ws); check_gemm((const bf16_t*)(ws + OFF_H0B), 1024, (const bf16_t*)(ws + OFF_WIN), 1024, 1024, T, 1984, 0, (const bf16_t*)(ws + OFF_P), NPP, (const float*)(ws + OFF_R0), (unsigned*)(ws + OFF_DBG) + 0, 448); }
    GSYNC();
#endif
#if DEBUG_CHECK == 3
    check_h0b(p, 9);
#endif
#if DEBUG_CHECK == 8
    check_p_golden(p);
#endif
#if DEBUG_CHECK == 9
    check_win_r0(p);
#endif
#if DEBUG_CHECK == 7
    check_h0b_full(p, 9);
    GSYNC();
#endif
#if DEBUG_CHECK == 6
    { unsigned char* ws = launder(p.ws);
      check_gemm((const bf16_t*)(ws + OFF_H0B), 1024, (const bf16_t*)(ws + OFF_WIN), 1024, 1024, T, 448, 0, (const bf16_t*)(ws + OFF_P), NPP, (const float*)(ws + OFF_R0), (unsigned*)(ws + OFF_DBG) + 8, 384);
      check_gemm((const bf16_t*)(ws + OFF_H0B), 1024, (const bf16_t*)(ws + OFF_WIN), 1024, 1024, T, 384, 7, (const bf16_t*)(ws + OFF_P), NPP, (const float*)(ws + OFF_R0), (unsigned*)(ws + OFF_DBG) + 9, 0); }
    GSYNC();
#endif
#if DEBUG_CHECK == 4
    check_stale(p, (const unsigned*)(launder(p.ws) + OFF_P), (unsigned)((size_t)T * 1024), 8);
#endif
    rownorm_phase(p);
    krope_phase(p);
    GSYNC();
#if (PHASE_MASK & 4) && (SUB2 & 1)
    {
        unsigned char* ws = launder(p.ws); unsigned char* ob = launder((unsigned char*)p.out);
        pg8::Gemm g{(const bf16_t*)(ws + OFF_P), (const bf16_t*)(ws + OFF_WUQ), TPAD, 768, 256, NPP, 256};
        pg8::StaticOrder S; S.init(TPAD, 768, G, blockIdx.x);
        Epi<1> E{(bf16_t*)(ob + DO_Q), 768, (const float*)(ws + OFF_RQ), nullptr, nullptr, nullptr, (const float2*)(ws + OFF_RT)};
        pg8::gemm_phase(lds, g, S, E);
    }
#endif
#if (PHASE_MASK & 4) && (SUB2 & 2)
    {
        unsigned char* ws = launder(p.ws); unsigned char* ob = launder((unsigned char*)p.out);
        pg8::Gemm g{(const bf16_t*)(ws + OFF_P) + 256, (const bf16_t*)(ws + OFF_WKN), TPAD, 512, 128, NPP, 128};
        pg8::StaticOrder S; S.init(TPAD, 512, G, blockIdx.x);
        Epi<2> E{(bf16_t*)(ob + DO_KN), 512, (const float*)(ws + OFF_RKV), nullptr, nullptr, nullptr, nullptr};
        pg8::gemm_phase(lds, g, S, E);
    }
#endif
#if (PHASE_MASK & 4) && (SUB2 & 4)
    {
        unsigned char* ws = launder(p.ws); unsigned char* ob = launder((unsigned char*)p.out);
        pg8::Gemm g{(const bf16_t*)(ws + OFF_WV), (const bf16_t*)(ws + OFF_P) + 256, 512, TPAD, 128, 128, NPP};
        pg8::StaticOrder S; S.init(512, TPAD, G, blockIdx.x);
        Epi<3> E{(bf16_t*)(ob + DO_VT), TPAD, (const float*)(ws + OFF_RKV), nullptr, nullptr, nullptr, nullptr};
        pg8::gemm_phase(lds, g, S, E);
    }
#endif
#if PHASE_MASK & 8
    hyprep_phase(p, lds);
#endif
    GSYNC();
#if DEBUG_CHECK == 2
    check_proj(p);
    GSYNC();
#endif
#if DEBUG_CHECK == 11
    check_filt_prep(p);
    GSYNC();
#endif
#if PHASE_MASK & 16
    attn_phase(p, lds);
#endif
#if PHASE_MASK & 32
    hyena_phase(p, lds);
#endif
    GSYNC();
#if DEBUG_CHECK == 5
    check_attn(p);
    check_hyena(p, lds);
    GSYNC();
#endif
#if PHASE_MASK & 64
    mixnorm_phase(p, lds);
#endif
    GSYNC();
#if PHASE_MASK & 128
    {
        unsigned char* ws = launder(p.ws);
        pg8::Gemm g{(const bf16_t*)(ws + OFF_MIXN), (const bf16_t*)(ws + OFF_WO), TN, 1024, 1024, 1024, 1024};
        pg8::StaticOrder S; S.init(TN, 1024, G, blockIdx.x);
        Epi<4> E{(bf16_t*)(ws + OFF_MIX), 1024, nullptr, (float*)(ws + OFF_SQMIXP), nullptr, nullptr, nullptr};
        pg8::gemm_phase(lds, g, S, E);
    }
#endif
    GSYNC();
#if DEBUG_CHECK == 1
    { unsigned char* ws = launder(p.ws); check_gemm((const bf16_t*)(ws + OFF_MIXN), 1024, (const bf16_t*)(ws + OFF_WO), 1024, 1024, TN, 1024, 4, (const bf16_t*)(ws + OFF_MIX), 1024, nullptr, (unsigned*)(ws + OFF_DBG) + 1, 0); }
#endif
#if DEBUG_CHECK == 10
    check_x(p, 1);
#endif
#if PHASE_MASK & 256
    h1_phase(p);
#endif
    GSYNC();
#if PHASE_MASK & 512
#if DEBUG_CHECK == 1
#define DBG_FF1(half) if ((half) == 0) { unsigned char* ws = launder(p.ws); check_gemm((const bf16_t*)(ws + OFF_H1B), 1024, (const bf16_t*)(ws + OFF_WF1), 1024, 1024, 65536, 4096, 5, (const bf16_t*)(ws + OFF_M), 4096, (const float*)(ws + OFF_R1), (unsigned*)(ws + OFF_DBG) + 2, 0); }
#define DBG_FF2(half) if ((half) == 0) { unsigned char* ws = launder(p.ws); check_gemm((const bf16_t*)(ws + OFF_M), 4096, (const bf16_t*)(ws + OFF_WF2), 4096, 4096, 65536, 1024, 6, (const bf16_t*)(ws + OFF_M2), 1024, nullptr, (unsigned*)(ws + OFF_DBG) + 3, 0); } GSYNC();
#else
#define DBG_FF1(half)
#define DBG_FF2(half)
#endif
#define FFN_HALF(half) \
    { \
        unsigned char* ws = launder(p.ws); \
        pg8::Gemm g{(const bf16_t*)(ws + OFF_H1B) + (size_t)(half) * 65536 * 1024, (const bf16_t*)(ws + OFF_WF1), 65536, 4096, 1024, 1024, 1024}; \
        pg8::StaticOrder S; S.init(65536, 4096, G, blockIdx.x); \
        Epi<5> E{(bf16_t*)(ws + OFF_M), 4096, (const float*)(ws + OFF_R1) + (half) * 65536, nullptr, nullptr, nullptr, nullptr}; \
        pg8::gemm_phase(lds, g, S, E); \
    } \
    GSYNC(); \
    DBG_FF1(half) \
    { \
        unsigned char* ws = launder(p.ws); \
        pg8::Gemm g{(const bf16_t*)(ws + OFF_M), (const bf16_t*)(ws + OFF_WF2), 65536, 1024, 4096, 4096, 4096}; \
        pg8::StaticOrder S; S.init(65536, 1024, G, blockIdx.x); \
        Epi<6> E{(bf16_t*)(ws + OFF_M2), 1024, nullptr, (float*)(ws + OFF_SQM2P) + (size_t)(half) * 65536 * 16, nullptr, nullptr, nullptr}; \
        pg8::gemm_phase(lds, g, S, E); \
    } \
    GSYNC(); \
    DBG_FF2(half) \
    final_phase(p, half);
    FFN_HALF(0)
    FFN_HALF(1)
#undef FFN_HALF
#endif
}

extern "C" void kernel_launch(void* const* d_in, const int* in_sizes, int n_in, void* d_out, int out_size, void* d_ws, size_t ws_size, hipStream_t stream) {
    static int grid = 0;
    if (grid == 0) {
        int dev = 0, cus = 0, per_cu = 0;
        hipGetDevice(&dev);
        hipDeviceGetAttribute(&cus, hipDeviceAttributeMultiprocessorCount, dev);
        hipFuncSetAttribute((const void*)hymba_fwd, hipFuncAttributeMaxDynamicSharedMemorySize, LDS_BYTES);
        hipOccupancyMaxActiveBlocksPerMultiprocessor(&per_cu, (const void*)hymba_fwd, 512, LDS_BYTES);
        if (per_cu < 1) per_cu = 1;
        grid = cus * 1;
        if (n_in != 26 || ws_size < 1024 * MiB) fprintf(stderr, "kernel_launch: unexpected n_in %d / ws_size %zu\n", n_in, ws_size);
    }
    Params p{};
    for (int i = 0; i < 26; ++i) p.in[i] = (const float*)d_in[i];
    p.out = (float*)d_out; p.ws = (unsigned char*)d_ws;
    void* args[] = {&p};
    hipError_t e = hipLaunchCooperativeKernel((const void*)hymba_fwd, dim3(grid), dim3(512), args, LDS_BYTES, stream);
    if (e != hipSuccess) fprintf(stderr, "cooperative launch failed: %s (grid %d)\n", hipGetErrorString(e), grid);
}
```

```cpp
#include <hip/hip_runtime.h>
#include <hip/hip_cooperative_groups.h>
#include <cstdio>
#include <cstdint>
namespace cg = cooperative_groups;
#ifndef DBG_SEL0
#define DBG_SEL0 3
#endif
#ifndef DBG_SEL1
#define DBG_SEL1 0
#endif
#ifndef DEBUG_CHECK
#define DEBUG_CHECK 0
#endif
#ifndef EXPT
#define EXPT 0
#endif
#ifndef SUB_MASK
#define SUB_MASK 15
#endif
#ifndef SUB2
#define SUB2 7
#endif

#define LAS __attribute__((address_space(3)))
#define GAS __attribute__((address_space(1)))
typedef unsigned short bf16_t;
typedef short bf16x8 __attribute__((ext_vector_type(8)));
typedef float f32x4 __attribute__((ext_vector_type(4)));
typedef float f32x16 __attribute__((ext_vector_type(16)));
typedef unsigned u32x4 __attribute__((ext_vector_type(4)));
typedef unsigned u32x2 __attribute__((ext_vector_type(2)));

constexpr int DM = 1024, LP = 8208, LS = 2064, NBP = 8, NBS = 32;
constexpr int TPR = NBP * LP;
constexpr int TSR = NBS * LS;
constexpr int T = TPR + TSR;
constexpr int TPAD = 131840;
constexpr int TN = 131072;
constexpr int NPP = 2048;
constexpr int LGP = 8256, LGS = 2112;
constexpr float EPS = 1e-6f;
constexpr float QSCALE = 0.07216878364870322f * 1.4426950408889634f;

constexpr size_t MiB = 1ull << 20;
constexpr size_t OFF_H0B = 0;
constexpr size_t XT_SET1 = (size_t)512 * NBP * LGP;
constexpr size_t OFF_X1T = 0;
constexpr size_t OFF_X2T = 131 * MiB;
constexpr size_t OFF_P = 262 * MiB;
constexpr size_t OFF_V0T = 778 * MiB;
constexpr size_t OFF_MIXN = 262 * MiB;
constexpr size_t OFF_MIX = 518 * MiB;
constexpr size_t OFF_H1B = 0;
constexpr size_t OFF_M = 256 * MiB;
constexpr size_t OFF_M2 = 768 * MiB;
constexpr size_t OFF_SQMIXP = 896 * MiB;
constexpr size_t OFF_SQM2P = 904 * MiB;
constexpr size_t OFF_SMALL = 912 * MiB;
constexpr size_t OFF_WIN = OFF_SMALL;
constexpr size_t OFF_WUQ = OFF_SMALL + 4 * MiB;
constexpr size_t OFF_WKN = OFF_SMALL + 4 * MiB + 512 * 1024;
constexpr size_t OFF_WV = OFF_SMALL + 4 * MiB + 768 * 1024;
constexpr size_t OFF_WO = OFF_SMALL + 5 * MiB;
constexpr size_t OFF_WF1 = OFF_SMALL + 7 * MiB;
constexpr size_t OFF_WF2 = OFF_SMALL + 15 * MiB;
constexpr size_t OFF_GR0 = OFF_SMALL + 23 * MiB;
constexpr size_t OFF_GR1 = OFF_SMALL + 56 * MiB;
constexpr size_t OFF_RT = OFF_SMALL + 65 * MiB;
constexpr size_t OFF_R0 = OFF_SMALL + 68 * MiB;
constexpr size_t OFF_R1 = OFF_SMALL + 69 * MiB;
constexpr size_t OFF_RQ = OFF_SMALL + 70 * MiB;
constexpr size_t OFF_RKV = OFF_SMALL + 71 * MiB;
constexpr size_t OFF_SQQP = OFF_SMALL + 72 * MiB;
constexpr size_t OFF_SQKVP = OFF_SMALL + 75 * MiB;
constexpr size_t OFF_DBGW = OFF_SMALL + 78 * MiB;
constexpr size_t DO_Q = 0;
constexpr size_t DO_KN = 194 * MiB;
constexpr size_t DO_KR = 323 * MiB;
constexpr size_t DO_VT = 340 * MiB;

constexpr size_t OFF_ODBG = 518 * MiB;
constexpr size_t OFF_HDBG = 647 * MiB;
constexpr int LDS_BYTES = 147456;

struct Params {
    const float* in[26];
    float* out;
    unsigned char* ws;
};

__device__ __forceinline__ f32x4 ld_sys(const float* q) { f32x4 v; asm volatile("global_load_dwordx4 %0, %1, off sc0 sc1\n\ts_waitcnt vmcnt(0)" : "=v"(v) : "v"(q) : "memory"); return v; }
__device__ __forceinline__ float ldco(const float* q) { return __builtin_bit_cast(float, __hip_atomic_load((const unsigned*)q, __ATOMIC_RELAXED, __HIP_MEMORY_SCOPE_AGENT)); }
__device__ __forceinline__ float2 ldco2(const float2* q) { const unsigned long long w = __hip_atomic_load((const unsigned long long*)q, __ATOMIC_RELAXED, __HIP_MEMORY_SCOPE_AGENT); return make_float2(__builtin_bit_cast(float, (unsigned)w), __builtin_bit_cast(float, (unsigned)(w >> 32))); }
template <class Tp> __device__ __forceinline__ Tp* launder(Tp* q) { asm volatile("" : "+s"(q)); return q; }
__device__ __forceinline__ int tid_l() { int t = threadIdx.x; asm volatile("" : "+v"(t)); return t; }
__device__ __forceinline__ unsigned cvt_pk_bf16(float lo, float hi) { unsigned r; asm volatile("v_cvt_pk_bf16_f32 %0, %1, %2" : "=v"(r) : "v"(lo), "v"(hi)); return r; }
__device__ __forceinline__ float bf2f(unsigned short b) { return __builtin_bit_cast(float, (unsigned)b << 16); }
__device__ __forceinline__ float bflo(unsigned w) { return __builtin_bit_cast(float, w << 16); }
__device__ __forceinline__ float bfhi(unsigned w) { return __builtin_bit_cast(float, w & 0xffff0000u); }
__device__ __forceinline__ float wave_sum(float v) {
#pragma unroll
    for (int o = 1; o < 64; o <<= 1) v += __shfl_xor(v, o);
    return v;
}
__device__ __forceinline__ void sincos_red(float x, float& s, float& c) {
    const double xd = (double)x; const double k = rint(xd * 0.15915494309189535); const float r = (float)(xd - k * 6.283185307179586);
    s = __sinf(r); c = __cosf(r);
}
__device__ __forceinline__ float sin_red(float x) { float s, c; sincos_red(x, s, c); return s; }
__device__ __forceinline__ void row_info(int r, int& pos, int& seq) {
    if (r < TPR) { seq = r / LP; pos = r - seq * LP; }
    else { int q = r - TPR; if (q >= TSR) q = TSR - 1; const int b = q / LS; pos = q - b * LS; seq = NBP + b; }
}
__device__ __forceinline__ int full_row(int n) {
    if (n < 65536) { const int b = n >> 13; return b * LP + 16 + (n & 8191); }
    const int q = n - 65536; const int b = q >> 11; return TPR + b * LS + 16 + (q & 2047);
}

namespace pg8 {
constexpr int BM = 256, BK = 64, HALF = 128, HTB = HALF * BK * 2, STAGE_BYTES = 8 * HTB, NXCD = 8, WGM = 8;
__host__ __device__ __forceinline__ int lds_byte(int r, int c) { const int st = (r >> 4) * 2 + (c >> 5), rr = r & 15, cc = c & 31, ob = rr * 64 + cc * 2; return st * 1024 + (ob ^ (((ob >> 9) & 1) << 5)); }
__host__ __device__ __forceinline__ void stage_rc(int b, int& R, int& C) { const int st = b / 1024, sb = b % 1024, swz = sb ^ (((sb >> 9) & 1) << 5); R = (st >> 1) * 16 + swz / 64; C = (st & 1) * 32 + (swz % 64) / 2; }
__host__ __device__ __forceinline__ int perm32(int rho) { const int n = rho >> 4, i = rho & 15; return 8 * (i >> 2) + 4 * n + (i & 3); }
struct Unit { int pm, pn; };
struct Gemm { const bf16_t* A; const bf16_t* Bt; int M, N, K, lda, ldb; };
struct StaticOrder {
    int nM, nN, nwg, G, c;
    __device__ void init(int M, int N, int G_, int c_) { nM = M / BM; nN = N / BM; nwg = nM * nN; G = G_; c = c_; }
    __device__ bool next(int i, Unit& u) const {
        const long L = (long)i * G + c; if (L >= nwg) return false;
        int wgid = (int)L; { const int q = nwg / NXCD, r = nwg % NXCD, xcd = wgid % NXCD, off = wgid / NXCD; wgid = (xcd < r ? xcd * (q + 1) : r * (q + 1) + (xcd - r) * q) + off; }
        const int nig = WGM * nN, gid = wgid / nig, fm = gid * WGM, gsz = (nM - fm) < WGM ? (nM - fm) : WGM;
        u.pm = fm + ((wgid % nig) % gsz); u.pn = (wgid % nig) / gsz; return true;
    }
};
template <class Epi>
__device__ __forceinline__ void gemm_phase(LAS unsigned char* lds, const Gemm g, const StaticOrder& S, const Epi& E) {
    const int tid = tid_l(), wid = __builtin_amdgcn_readfirstlane(tid >> 6), lane = tid & 63, wr = wid >> 2, wc = wid & 3, fr = lane & 15, fq = lane >> 4;
    const int K = g.K, nt = K / BK;
    unsigned voffA[2], voffB[2];
#pragma unroll
    for (int i = 0; i < 2; ++i) { int R, C; stage_rc(tid * 16 + i * 8192, R, C); const int Rb = (R & ~31) + perm32(R & 31);
        voffA[i] = (unsigned)(R * g.lda + C) * 2u; voffB[i] = (unsigned)(Rb * g.ldb + C) * 2u; }
    const size_t kstep = (size_t)(BK * 2);
    const size_t hstepA = (size_t)HALF * g.lda * 2, hstepB = (size_t)HALF * g.ldb * 2;
    const size_t tstepA = 2 * hstepA, tstepB = 2 * hstepB;
    const unsigned ldsw = (unsigned)wid * 1024u;
    const int aoff = lds_byte(wr * 64 + fr, fq * 8), boff = lds_byte(wc * 32 + fr, fq * 8);
#define PG8_SA(b, h) (((b) * 2 + (h)) * HTB)
#define PG8_SB(b, h) ((4 + (b) * 2 + (h)) * HTB)
#define PG8_STAGE(bufoff, gbase, voff) do { _Pragma("unroll") for (int _i = 0; _i < 2; ++_i) \
        __builtin_amdgcn_global_load_lds((const unsigned*)((const char*)(gbase) + (voff)[_i]), (LAS unsigned*)(lds + (bufoff) + ldsw + _i * 8192), 16, 0, 0); } while (0)
#define PG8_LDA(dst, b, h) do { _Pragma("unroll") for (int m = 0; m < 4; ++m) _Pragma("unroll") for (int k = 0; k < 2; ++k) dst[m][k] = *(const LAS bf16x8*)(lds + PG8_SA(b, h) + aoff + m * 2048 + k * 1024); } while (0)
#define PG8_LDB(dst, b, h) do { _Pragma("unroll") for (int n = 0; n < 2; ++n) _Pragma("unroll") for (int k = 0; k < 2; ++k) dst[n][k] = *(const LAS bf16x8*)(lds + PG8_SB(b, h) + boff + n * 2048 + k * 1024); } while (0)
#define PG8_MMA(ai, bj, At, Bt) do { __builtin_amdgcn_s_setprio(1); _Pragma("unroll") for (int m = 0; m < 4; ++m) _Pragma("unroll") for (int n = 0; n < 2; ++n) _Pragma("unroll") for (int k = 0; k < 2; ++k) \
        acc[ai][bj][m][n] = __builtin_amdgcn_mfma_f32_16x16x32_bf16(Bt[n][k], At[m][k], acc[ai][bj][m][n], 0, 0, 0); __builtin_amdgcn_s_setprio(0); } while (0)
#define PG8_WAIT_V(n) asm volatile("s_waitcnt vmcnt(" #n ")" ::: "memory")
#define PG8_WAIT_L(n) asm volatile("s_waitcnt lgkmcnt(" #n ")" ::: "memory")
#define PG8_BAR __builtin_amdgcn_s_barrier()
#define PG8_SCHED __builtin_amdgcn_sched_barrier(0)
    Unit cur, nxt; int ui = 0;
    if (!S.next(0, cur)) return;
    f32x4 acc[2][2][4][2];
#pragma unroll
    for (int a = 0; a < 2; ++a)
#pragma unroll
        for (int b = 0; b < 2; ++b)
#pragma unroll
            for (int m = 0; m < 4; ++m)
#pragma unroll
                for (int n = 0; n < 2; ++n) acc[a][b][m][n] = (f32x4){0.f, 0.f, 0.f, 0.f};
    bf16x8 At[4][2], B0[2][2], B1[2][2];
    const char* cA = (const char*)g.A + (size_t)cur.pm * tstepA; const char* cB = (const char*)g.Bt + (size_t)cur.pn * tstepB;
    PG8_STAGE(PG8_SB(0, 0), cB, voffB); PG8_STAGE(PG8_SB(0, 1), cB + hstepB, voffB); PG8_STAGE(PG8_SA(0, 0), cA, voffA); PG8_STAGE(PG8_SA(0, 1), cA + hstepA, voffA);
    if (wr == 1) PG8_BAR;
    PG8_WAIT_V(2); PG8_BAR;
    PG8_STAGE(PG8_SB(1, 0), cB + kstep, voffB); PG8_STAGE(PG8_SA(1, 0), cA + kstep, voffA); PG8_STAGE(PG8_SB(1, 1), cB + hstepB + kstep, voffB);
    PG8_WAIT_V(6); PG8_BAR;
    for (;;) {
        const bool has_next = S.next(ui + 1, nxt);
        const char* nA = has_next ? (const char*)g.A + (size_t)nxt.pm * tstepA : cA; const char* nB = has_next ? (const char*)g.Bt + (size_t)nxt.pn * tstepB : cB;
        for (int t = 0; t < nt; t += 2) {
            const bool last = (t == nt - 2);
            const char* a1 = cA + (size_t)(t + 1) * kstep;
            const char* a2 = last ? nA : cA + (size_t)(t + 2) * kstep; const char* b2 = last ? nB : cB + (size_t)(t + 2) * kstep;
            const char* a3 = a2 + kstep; const char* b3 = b2 + kstep;
            PG8_LDB(B0, 0, 0); PG8_LDB(B1, 0, 1); PG8_SCHED; PG8_LDA(At, 0, 0); PG8_STAGE(PG8_SA(1, 1), a1 + hstepA, voffA);
            PG8_WAIT_V(8); PG8_WAIT_L(0); PG8_BAR; PG8_MMA(0, 0, At, B0); PG8_MMA(0, 1, At, B1); PG8_BAR; PG8_SCHED;
            PG8_LDA(At, 0, 1); PG8_STAGE(PG8_SB(0, 0), b2, voffB); PG8_STAGE(PG8_SB(0, 1), b2 + hstepB, voffB); PG8_STAGE(PG8_SA(0, 0), a2, voffA);
            PG8_WAIT_V(8); PG8_WAIT_L(0); PG8_BAR; PG8_MMA(1, 0, At, B0); PG8_MMA(1, 1, At, B1); PG8_BAR; PG8_SCHED;
            PG8_LDB(B0, 1, 0); PG8_LDB(B1, 1, 1); PG8_SCHED; PG8_LDA(At, 1, 0); PG8_STAGE(PG8_SA(0, 1), a2 + hstepA, voffA);
            PG8_WAIT_V(8); PG8_WAIT_L(0); PG8_BAR; PG8_MMA(0, 0, At, B0); PG8_MMA(0, 1, At, B1); PG8_BAR; PG8_SCHED;
            PG8_LDA(At, 1, 1); PG8_STAGE(PG8_SB(1, 0), b3, voffB); PG8_STAGE(PG8_SB(1, 1), b3 + hstepB, voffB); PG8_STAGE(PG8_SA(1, 0), a3, voffA);
            PG8_WAIT_V(8); PG8_WAIT_L(0); PG8_BAR; PG8_MMA(1, 0, At, B0); PG8_MMA(1, 1, At, B1); PG8_BAR; PG8_SCHED;
        }
        if (wr == 0) PG8_BAR;
        E(acc, cur, wr, wc, fr, fq);
        if (!has_next) break;
#pragma unroll
        for (int a = 0; a < 2; ++a)
#pragma unroll
            for (int b = 0; b < 2; ++b)
#pragma unroll
                for (int m = 0; m < 4; ++m)
#pragma unroll
                    for (int n = 0; n < 2; ++n) acc[a][b][m][n] = (f32x4){0.f, 0.f, 0.f, 0.f};
        cur = nxt; cA = nA; cB = nB; ++ui;
        if (wr == 1) PG8_BAR;
    }
    PG8_WAIT_V(0);
    PG8_BAR;
#undef PG8_SA
#undef PG8_SB
#undef PG8_STAGE
#undef PG8_LDA
#undef PG8_LDB
#undef PG8_MMA
#undef PG8_WAIT_V
#undef PG8_WAIT_L
#undef PG8_BAR
#undef PG8_SCHED
}
}

__device__ __forceinline__ void rope8(f32x4& v0, f32x4& v1, const float2* rt  ) {
    const float2 c0 = ldco2(rt), c1 = ldco2(rt + 1), c2 = ldco2(rt + 2), c3 = ldco2(rt + 3);
    float a, b;
    a = v0[0]; b = v0[1]; v0[0] = a * c0.x - b * c0.y; v0[1] = b * c0.x + a * c0.y;
    a = v0[2]; b = v0[3]; v0[2] = a * c1.x - b * c1.y; v0[3] = b * c1.x + a * c1.y;
    a = v1[0]; b = v1[1]; v1[0] = a * c2.x - b * c2.y; v1[1] = b * c2.x + a * c2.y;
    a = v1[2]; b = v1[3]; v1[2] = a * c3.x - b * c3.y; v1[3] = b * c3.x + a * c3.y;
}
__device__ __forceinline__ u32x4 pack8(const f32x4& v0, const f32x4& v1) {
    u32x4 w; w.x = cvt_pk_bf16(v0[0], v0[1]); w.y = cvt_pk_bf16(v0[2], v0[3]); w.z = cvt_pk_bf16(v1[0], v1[1]); w.w = cvt_pk_bf16(v1[2], v1[3]); return w;
}
__device__ __forceinline__ float sq8(const f32x4& a, const f32x4& b) {
    return (a[0] * a[0] + a[1] * a[1]) + (a[2] * a[2] + a[3] * a[3]) + (b[0] * b[0] + b[1] * b[1]) + (b[2] * b[2] + b[3] * b[3]);
}
template <int MODE> struct Epi {
    bf16_t* O; int ldc; const float* rs; float* sq0; float* sq1; bf16_t* KR; const float2* RT;
    __device__ __forceinline__ void operator()(const f32x4 (&acc)[2][2][4][2], const pg8::Unit& u, int wr, int wc, int fr, int fq) const {
#pragma unroll
        for (int ai = 0; ai < 2; ++ai)
#pragma unroll
            for (int m = 0; m < 4; ++m) {
                const int row = u.pm * 256 + ai * 128 + wr * 64 + m * 16 + fr;
                float sc = 1.f;
                if (MODE == 0 || MODE == 1 || MODE == 2 || MODE == 5) sc = ldco(rs + row);
                float ssum[2];
#pragma unroll
                for (int bj = 0; bj < 2; ++bj) {
                    const int col0 = u.pn * 256 + bj * 128 + wc * 32 + 8 * fq;
                    f32x4 v0 = acc[ai][bj][m][0] * sc, v1 = acc[ai][bj][m][1] * sc;
                    if (MODE == 3) {
#pragma unroll
                        for (int j = 0; j < 4; ++j) { v0[j] *= ldco(rs + col0 + j); v1[j] *= ldco(rs + col0 + 4 + j); }
                    }
                    if (MODE == 5) {
#pragma unroll
                        for (int j = 0; j < 4; ++j) { const float a = fmaxf(v0[j], 0.f), b = fmaxf(v1[j], 0.f); v0[j] = a * a; v1[j] = b * b; }
                    }
                    ssum[bj] = sq8(v0, v1);
                    *(u32x4*)(O + (size_t)row * ldc + col0) = pack8(v0, v1);
                }
                if (MODE == 0) {
                    if (u.pn == 0) { float s = ssum[0] + ssum[1]; s += __shfl_xor(s, 16); s += __shfl_xor(s, 32); if (fq == 0) sq0[row * 4 + wc] = s; }
                    else if (u.pn == 1) { float s = ssum[0]; s += __shfl_xor(s, 16); s += __shfl_xor(s, 32); if (fq == 0) sq1[row * 4 + wc] = s; }
                }
                if (MODE == 4 || MODE == 6) { float s = ssum[0] + ssum[1]; s += __shfl_xor(s, 16); s += __shfl_xor(s, 32); if (fq == 0) sq0[(size_t)row * 16 + u.pn * 4 + wc] = s; }
            }
    }
};

__device__ __forceinline__ int src_col(int mode, int n) {
    if (mode == 0) return n;
    if (mode == 1) { if (n >= 1984) return -1; if (n >= 384 && n < 448) { const int j = n - 384; return 384 + ((j & 1) ? 32 + (j >> 1) : (j >> 1)); } return n; }
    if (mode == 2) { const int h = n / 192, w = n % 192; if (w < 128) return n; const int j = w - 128; return h * 192 + 128 + ((j & 1) ? 32 + (j >> 1) : (j >> 1)); }
    if (mode == 3) return (n >> 7) * 256 + (n & 127);
    return (n >> 7) * 256 + 128 + (n & 127);
}
__device__ __forceinline__ void conv_weight(const float* W, const float* g, bf16_t* out, int K, int Nsrc, int Nout, int mode, int gtid, int gthreads) {
    const int nch = Nout * (K / 8);
    for (int e = gtid; e < nch; e += gthreads) {
        const int n = e % Nout, kc = e / Nout, k0 = kc * 8; const int sc = src_col(mode, n);
        float v[8];
#pragma unroll
        for (int j = 0; j < 8; ++j) v[j] = (sc >= 0) ? W[(size_t)(k0 + j) * Nsrc + sc] * (g ? g[k0 + j] : 1.f) : 0.f;
        u32x4 w; w.x = cvt_pk_bf16(v[0], v[1]); w.y = cvt_pk_bf16(v[2], v[3]); w.z = cvt_pk_bf16(v[4], v[5]); w.w = cvt_pk_bf16(v[6], v[7]);
        *(u32x4*)(out + (size_t)n * K + k0) = w;
    }
}

__device__ __forceinline__ void p0_prologue(const Params& p, LAS unsigned char* lds) {
    unsigned char* ws = launder(p.ws);
    const int tid = tid_l(), lane = tid & 63, wave = tid >> 6, G = gridDim.x;
    const int gtid = blockIdx.x * 512 + tid, gthreads = G * 512;
    const int gw = blockIdx.x * 8 + wave, NGW = G * 8;
#if SUB_MASK & 1
    conv_weight(p.in[4], p.in[3], (bf16_t*)(ws + OFF_WIN), 1024, 1984, 2048, 1, gtid, gthreads);
    conv_weight(p.in[6], p.in[5], (bf16_t*)(ws + OFF_WUQ), 256, 768, 768, 2, gtid, gthreads);
    conv_weight(p.in[8], p.in[7], (bf16_t*)(ws + OFF_WKN), 128, 1024, 512, 3, gtid, gthreads);
    conv_weight(p.in[8], p.in[7], (bf16_t*)(ws + OFF_WV), 128, 1024, 512, 4, gtid, gthreads);
    conv_weight(p.in[20], nullptr, (bf16_t*)(ws + OFF_WO), 1024, 1024, 1024, 0, gtid, gthreads);
    conv_weight(p.in[23], p.in[22], (bf16_t*)(ws + OFF_WF1), 1024, 4096, 4096, 0, gtid, gthreads);
    conv_weight(p.in[24], nullptr, (bf16_t*)(ws + OFF_WF2), 4096, 1024, 1024, 0, gtid, gthreads);
#endif
#if SUB_MASK & 2
#if DEBUG_CHECK
    if (blockIdx.x == 0 && tid < 64) ((unsigned*)(ws + OFF_DBGW))[tid] = 0u;
#endif
    {
        float2* RT = (float2*)(ws + OFF_RT);
        for (int e = gtid; e < LP * 32; e += gthreads) {
            const int pos = e >> 5, i = e & 31;
            const float inv = 1.0f / exp2f((float)i * (13.287712379549449f / 32.f));
            float s, c; sincos_red((float)pos * inv, s, c);
            RT[e] = make_float2(c, s);
        }
    }
#endif
#if SUB_MASK & 4
    {
        bf16_t* h0b = (bf16_t*)(ws + OFF_H0B); float* r0 = (float*)(ws + OFF_R0);
        for (int r = gw; r < TPAD; r += NGW) {
            u32x2* o = (u32x2*)(h0b + (size_t)r * 1024) + lane;
            if (r >= T) {
#pragma unroll
                for (int j = 0; j < 4; ++j) o[64 * j] = (u32x2){0u, 0u};
                if (lane == 0) __hip_atomic_store(r0 + r, 0.f, __ATOMIC_RELAXED, __HIP_MEMORY_SCOPE_AGENT);
                continue;
            }
            int pos, seq; row_info(r, pos, seq);
            const float* src = pos < 16 ? p.in[2] + (size_t)pos * 1024
                                        : (seq < NBP ? p.in[0] + ((size_t)seq * 8192 + (pos - 16)) * 1024 : p.in[1] + ((size_t)(seq - NBP) * 2048 + (pos - 16)) * 1024);
            const f32x4* xr = (const f32x4*)src + lane;
            f32x4 v[4]; float ss = 0.f;
#pragma unroll
            for (int j = 0; j < 4; ++j) { v[j] = xr[64 * j]; ss += (v[j][0] * v[j][0] + v[j][1] * v[j][1]) + (v[j][2] * v[j][2] + v[j][3] * v[j][3]); }
            ss = wave_sum(ss);
#pragma unroll
            for (int j = 0; j < 4; ++j) o[64 * j] = (u32x2){cvt_pk_bf16(v[j][0], v[j][1]), cvt_pk_bf16(v[j][2], v[j][3])};
            if (lane == 0) __hip_atomic_store(r0 + r, rsqrtf(ss * (1.f / 1024.f) + EPS), __ATOMIC_RELAXED, __HIP_MEMORY_SCOPE_AGENT);
        }
    }
#endif
#if SUB_MASK & 8
    {
        const float* f_w1 = p.in[10]; const float* f_b1 = p.in[11]; const float* f_freq = p.in[12]; const float* f_w2 = p.in[13];
        const float* f_b2 = p.in[14]; const float* f_w3 = p.in[15]; const float* f_decay = p.in[16];
        LAS float* feats = (LAS float*)lds;
        LAS float* h1 = feats + 16 * 34;
        LAS float* h2 = h1 + 16 * 64;
        for (int u = blockIdx.x; u < 513 + 129; u += G) {
            const int set = u < 513 ? 0 : 1; const int t0 = 16 * (set ? u - 513 : u); const int L = set ? LS : LP; const int C0 = set ? LGS : LGP;
            bf16_t* GR = (bf16_t*)(ws + (set ? OFF_GR1 : OFF_GR0));
            const float invLm1 = 1.0f / (float)(L - 1);
            if (tid < 256) {
                const int tt = tid >> 4, k = tid & 15; const int t = t0 + tt;
                const float w = (6.2831853071795865f * (float)t) / (float)L;
                const float f = 1e-4f + (float)k * ((15.0f - 1e-4f) / 15.0f);
                float s, c; sincos_red(f * w, s, c);
                feats[tt * 34 + 1 + k] = c; feats[tt * 34 + 17 + k] = -s;
                if (k == 0) feats[tt * 34] = (float)t * invLm1;
            }
            __syncthreads();
#pragma unroll 1
            for (int q = 0; q < 2; ++q) {
                const int o = tid + 512 * q, tt = o >> 6, j = o & 63;
                float a = f_b1[j];
#pragma unroll 3
                for (int e = 0; e < 33; ++e) a += feats[tt * 34 + e] * f_w1[e * 64 + j];
                h1[tt * 64 + j] = sin_red(f_freq[j] * a);
            }
            __syncthreads();
#pragma unroll 1
            for (int q = 0; q < 2; ++q) {
                const int o = tid + 512 * q, tt = o >> 6, j = o & 63;
                float a = f_b2[j];
#pragma unroll 4
                for (int e = 0; e < 64; ++e) a += h1[tt * 64 + e] * f_w2[e * 64 + j];
                h2[tt * 64 + j] = sin_red(f_freq[j] * a);
            }
            __syncthreads();
#pragma unroll 1
            for (int q = 0; q < 4; ++q) {
                const int n = tid + 512 * q;
                float a[16];
#pragma unroll
                for (int i = 0; i < 16; ++i) a[i] = 0.f;
#pragma unroll 2
                for (int j = 0; j < 64; ++j) {
                    const float w = f_w3[j * 2048 + n];
#pragma unroll
                    for (int i = 0; i < 16; ++i) a[i] += h2[i * 64 + j] * w;
                }
                const float dec = fabsf(f_decay[n]);
                const int order = n >> 10, dir = (n >> 9) & 1, c = n & 511;
                bf16_t* row = GR + (size_t)(order * 512 + c) * (2 * C0);
#pragma unroll
                for (int i = 0; i < 16; ++i) {
                    const int t = t0 + i;
                    const float val = a[i] * __expf(-((float)t * invLm1) * dec);
                    const unsigned short b = (unsigned short)(cvt_pk_bf16(val, 0.f) & 0xffffu);
                    if (dir == 0) row[C0 - t] = b; else if (t > 0) row[C0 + t] = b;
                }
            }
            __syncthreads();
        }
        for (int e = gtid; e < 2 * 1024 * 97; e += gthreads) {
            const int set = e / (1024 * 97), r = (e / 97) % 1024, i = e % 97; const int L = set ? LS : LP; const int C0 = set ? LGS : LGP;
            bf16_t* row = (bf16_t*)(ws + (set ? OFF_GR1 : OFF_GR0)) + (size_t)r * (2 * C0);
            const int idx = i < 49 ? i : C0 + L + (i - 49);
            row[idx] = 0;
        }
    }
#endif
}

__device__ __forceinline__ void rownorm_phase(const Params& p) {
    unsigned char* ws = launder(p.ws); const int gtid = blockIdx.x * 512 + tid_l(), gthreads = gridDim.x * 512;
    const float* sqq = (const float*)(ws + OFF_SQQP); const float* sqkv = (const float*)(ws + OFF_SQKVP);
    float* rq = (float*)(ws + OFF_RQ); float* rkv = (float*)(ws + OFF_RKV);
    for (int r = gtid; r < TPAD; r += gthreads) {
        const float a = (ldco(sqq + r * 4) + ldco(sqq + r * 4 + 1)) + (ldco(sqq + r * 4 + 2) + ldco(sqq + r * 4 + 3));
        const float b = (ldco(sqkv + r * 4) + ldco(sqkv + r * 4 + 1)) + (ldco(sqkv + r * 4 + 2) + ldco(sqkv + r * 4 + 3));
        rq[r] = rsqrtf(a * (1.f / 256.f) + EPS) * QSCALE; rkv[r] = rsqrtf(b * (1.f / 128.f) + EPS);
    }
}
__device__ __forceinline__ void krope_phase(const Params& p) {
    unsigned char* ws = launder(p.ws); unsigned char* ob = launder((unsigned char*)p.out);
    const int gtid = blockIdx.x * 512 + tid_l(), gthreads = gridDim.x * 512;
    const bf16_t* P = (const bf16_t*)(ws + OFF_P); bf16_t* KR = (bf16_t*)(ob + DO_KR); const float2* RT = (const float2*)(ws + OFF_RT);
    for (int e = gtid; e < TPAD * 8; e += gthreads) {
        const int row = e >> 3, ch = e & 7;
        int pos, seq; row_info(row, pos, seq);
        const u32x4 v = *(const u32x4*)(P + (size_t)row * NPP + 384 + ch * 8);
        f32x4 v0 = (f32x4){bflo(v.x), bfhi(v.x), bflo(v.y), bfhi(v.y)}, v1 = (f32x4){bflo(v.z), bfhi(v.z), bflo(v.w), bfhi(v.w)};
        rope8(v0, v1, RT + pos * 32 + ch * 4);
        *(u32x4*)(KR + (size_t)row * 64 + ch * 8) = pack8(v0, v1);
    }
}
__device__ __forceinline__ void hyprep_phase(const Params& p, LAS unsigned char* lds) {
    unsigned char* ws = launder(p.ws); const int tid = tid_l(), G = gridDim.x;
    const bf16_t* P = (const bf16_t*)(ws + OFF_P); const float* conv_w = p.in[9];
    constexpr int RSB = 1040;
    for (int u = blockIdx.x; u < 3096 + 3168; u += G) {
        int seq, j, which;
        if (u < 3096) { seq = u / 387; const int rem = u % 387; j = rem / 3; which = rem % 3; }
        else { const int v = u - 3096; seq = NBP + v / 99; const int rem = v % 99; j = rem / 3; which = rem % 3; }
        const int set = seq < NBP ? 0 : 1; const int L = set ? LS : LP; const int Lg = set ? LGS : LGP; const int NB = set ? NBS : NBP;
        const int b = set ? seq - NBP : seq; const int row0 = set ? TPR + b * LS : b * LP;
        const int posb = 64 * j - 49;
        for (int i = 0; i < 9; ++i) {
            const int id = tid + 512 * i; if (id >= 66 * 64) break;
            const int rr = id >> 6, ch = id & 63; const int pos = posb + rr;
            u32x4 v = (u32x4){0u, 0u, 0u, 0u};
            if (pos >= 0 && pos < L) v = *(const GAS u32x4*)(P + (size_t)(row0 + pos) * NPP + 448 + which * 512 + ch * 8);
            *(LAS u32x4*)(lds + rr * RSB + ch * 16) = v;
        }
        __syncthreads();
        {
            const int c = tid; const float w0 = conv_w[which * 512 + c], w1 = conv_w[1536 + which * 512 + c], w2 = conv_w[3072 + which * 512 + c];
            bf16_t* XT = (bf16_t*)(ws + (which == 0 ? OFF_X1T : (which == 1 ? OFF_X2T : OFF_V0T))) + (set ? XT_SET1 : 0) + ((size_t)c * NB + b) * Lg + 64 * j;
            const LAS unsigned short* tl = (const LAS unsigned short*)lds + c;
            float prev = bf2f(tl[0]), cur = bf2f(tl[RSB / 2]);
            for (int o8 = 0; o8 < 8; ++o8) {
                float r[8];
#pragma unroll
                for (int k = 0; k < 8; ++k) {
                    const int o = o8 * 8 + k; const float nxt = bf2f(tl[(o + 2) * (RSB / 2)]);
                    const int pos = posb + 1 + o;
                    r[k] = (pos >= 0 && pos < L) ? (prev * w0 + cur * w1 + nxt * w2) : 0.f;
                    prev = cur; cur = nxt;
                }
                u32x4 w; w.x = cvt_pk_bf16(r[0], r[1]); w.y = cvt_pk_bf16(r[2], r[3]); w.z = cvt_pk_bf16(r[4], r[5]); w.w = cvt_pk_bf16(r[6], r[7]);
                *(GAS u32x4*)(XT + o8 * 8) = w;
            }
        }
        __syncthreads();
    }
}

__device__ __forceinline__ f32x16 mfma32(bf16x8 a, bf16x8 b, f32x16 c) { return __builtin_amdgcn_mfma_f32_32x32x16_bf16(a, b, c, 0, 0, 0); }

__device__ __forceinline__ void attn_phase(const Params& p, LAS unsigned char* lds) {
    const int tid = tid_l(), lane = tid & 63, wave = tid >> 6, G = gridDim.x, h = lane >> 5, l32 = lane & 31;
    unsigned char* ob = launder((unsigned char*)p.out);
    bf16_t* Q = (bf16_t*)(ob + DO_Q);
    const bf16_t* KN = (const bf16_t*)(ob + DO_KN);
    const bf16_t* KR = (const bf16_t*)(ob + DO_KR);
    const bf16_t* VT = (const bf16_t*)(ob + DO_VT);
    constexpr int KROW = 400, VROW = 136, KBYTES = 64 * KROW, BUFB = KBYTES + 128 * VROW;
    for (int u = blockIdx.x; u < 2048; u += G) {
        int seq, head, qb;
        if (u < 1024) { seq = u >> 7; head = (u >> 5) & 3; qb = u & 31; } else { const int v = u - 1024; seq = NBP + (v >> 5); head = (v >> 3) & 3; qb = v & 7; }
        const int L = seq < NBP ? LP : LS; const int row0 = seq < NBP ? seq * LP : TPR + (seq - NBP) * LS;
        const int ntiles = (L + 63) >> 6;
        const int qrow = row0 + 16 + qb * 256 + wave * 32 + l32;
        bf16x8 qf[12];
#pragma unroll
        for (int ks = 0; ks < 12; ++ks) qf[ks] = *(const GAS bf16x8*)(Q + (size_t)qrow * 768 + head * 192 + 16 * ks + 8 * h);
        {
            const float2* RT = (const float2*)(launder(p.ws) + OFF_RT);
            const int qpos = 16 + qb * 256 + wave * 32 + l32;
#pragma unroll
            for (int ks = 8; ks < 12; ++ks) {
                const u32x4 v = __builtin_bit_cast(u32x4, qf[ks]);
                f32x4 v0 = (f32x4){bflo(v.x), bfhi(v.x), bflo(v.y), bfhi(v.y)}, v1 = (f32x4){bflo(v.z), bfhi(v.z), bflo(v.w), bfhi(v.w)};
                rope8(v0, v1, RT + qpos * 32 + 8 * (ks - 8) + 4 * h);
                qf[ks] = __builtin_bit_cast(bf16x8, pack8(v0, v1));
            }
        }
        const int kkey0 = tid >> 4, kch0 = tid & 15;
        const int rkey = tid >> 3, rch = tid & 7;
        const int vdv0 = tid >> 3, vch = tid & 7;
        const unsigned kn_off = (unsigned)(kkey0 * 512 + head * 128 + kch0 * 8) * 2u;
        const unsigned kr_off = (unsigned)(rkey * 64 + rch * 8) * 2u;
        const unsigned vt_off = (unsigned)(vdv0 * TPAD + vch * 8) * 2u;
        const unsigned char* knb = (const unsigned char*)KN + (size_t)row0 * 1024;
        const unsigned char* krb = (const unsigned char*)KR + (size_t)row0 * 128;
        const unsigned char* vtb = (const unsigned char*)VT + ((size_t)head * 128 * TPAD + row0) * 2;
        u32x4 g0, g1, g2, g3, g4;
#define ATT_LOAD(tile) do { const unsigned char* kb__ = knb + (size_t)(tile) * 65536; const unsigned char* rb__ = krb + (size_t)(tile) * 8192; const unsigned char* vb__ = vtb + (size_t)(tile) * 128; \
        g0 = *(const GAS u32x4*)(kb__ + kn_off); g1 = *(const GAS u32x4*)(kb__ + 32768 + kn_off); \
        g2 = *(const GAS u32x4*)(rb__ + kr_off); (void)vb__; } while (0)
#define ATT_LOADV(tile) do { const unsigned char* vb__ = vtb + (size_t)(tile) * 128; g3 = *(const GAS u32x4*)(vb__ + vt_off); g4 = *(const GAS u32x4*)(vb__ + (size_t)64 * TPAD * 2 + vt_off); } while (0)
#define ATT_STOREK(buf) do { LAS unsigned char* kb_ = lds + (buf) * BUFB; \
        *(LAS u32x4*)(kb_ + kkey0 * KROW + kch0 * 16) = g0; *(LAS u32x4*)(kb_ + (kkey0 + 32) * KROW + kch0 * 16) = g1; \
        *(LAS u32x4*)(kb_ + rkey * KROW + 256 + rch * 16) = g2; } while (0)
#define ATT_STORE(buf) do { LAS unsigned char* vb_ = lds + (buf) * BUFB + KBYTES; \
        *(LAS u32x2*)(vb_ + vdv0 * VROW + vch * 16) = (u32x2){g3.x, g3.y}; *(LAS u32x2*)(vb_ + vdv0 * VROW + vch * 16 + 8) = (u32x2){g3.z, g3.w}; \
        *(LAS u32x2*)(vb_ + (vdv0 + 64) * VROW + vch * 16) = (u32x2){g4.x, g4.y}; *(LAS u32x2*)(vb_ + (vdv0 + 64) * VROW + vch * 16 + 8) = (u32x2){g4.z, g4.w}; } while (0)
        ATT_LOAD(0); ATT_LOADV(0); ATT_STOREK(0); ATT_STORE(0);
        __syncthreads();
        f32x16 o[4];
#pragma unroll
        for (int d = 0; d < 4; ++d)
#pragma unroll
            for (int r = 0; r < 16; ++r) o[d][r] = 0.f;
        float m_run = -INFINITY, l_run = 0.f;
        for (int j = 0; j < ntiles; ++j) {
            const int buf = j & 1;
            if (j + 1 < ntiles) ATT_LOAD(j + 1);
            const LAS unsigned char* kb = lds + buf * BUFB;
            f32x16 s0, s1;
#pragma unroll
            for (int r = 0; r < 16; ++r) { s0[r] = 0.f; s1[r] = 0.f; }
#pragma unroll
            for (int ks = 0; ks < 12; ++ks) {
                const bf16x8 a0 = *(const LAS bf16x8*)(kb + l32 * KROW + ks * 32 + h * 16);
                const bf16x8 a1 = *(const LAS bf16x8*)(kb + (l32 + 32) * KROW + ks * 32 + h * 16);
                s0 = mfma32(a0, qf[ks], s0); s1 = mfma32(a1, qf[ks], s1);
                if ((ks % 3) == 2) __builtin_amdgcn_sched_barrier(0);
            }
            if (j + 1 < ntiles) ATT_STOREK(buf ^ 1);
            const int vc = L - j * 64;
            if (vc < 64) {
                const int vch = vc - 4 * h;
#pragma unroll
                for (int r = 0; r < 16; ++r) {
                    if ((r & 3) + 8 * (r >> 2) >= vch) s0[r] = -INFINITY;
                    if ((r & 3) + 8 * (r >> 2) + 32 >= vch) s1[r] = -INFINITY;
                }
            }
            float mx = fmaxf(s0[0], s1[0]);
#pragma unroll
            for (int r = 1; r < 16; ++r) mx = fmaxf(mx, fmaxf(s0[r], s1[r]));
            mx = fmaxf(mx, __shfl_xor(mx, 32));
            const float m_new = fmaxf(m_run, mx);
            const float alpha = __builtin_amdgcn_exp2f(m_run - m_new);
            m_run = m_new;
            float ls = 0.f;
#pragma unroll
            for (int r = 0; r < 16; ++r) { s0[r] = __builtin_amdgcn_exp2f(s0[r] - m_new); s1[r] = __builtin_amdgcn_exp2f(s1[r] - m_new); ls += s0[r] + s1[r]; }
            l_run = l_run * alpha + ls;
            if (__any(alpha != 1.0f)) {
#pragma unroll
                for (int d = 0; d < 4; ++d)
#pragma unroll
                    for (int r = 0; r < 16; ++r) o[d][r] *= alpha;
            }
            bf16x8 pb[4];
            {
                u32x4 w;
                w.x = cvt_pk_bf16(s0[0], s0[1]); w.y = cvt_pk_bf16(s0[2], s0[3]); w.z = cvt_pk_bf16(s0[4], s0[5]); w.w = cvt_pk_bf16(s0[6], s0[7]); pb[0] = __builtin_bit_cast(bf16x8, w);
                w.x = cvt_pk_bf16(s0[8], s0[9]); w.y = cvt_pk_bf16(s0[10], s0[11]); w.z = cvt_pk_bf16(s0[12], s0[13]); w.w = cvt_pk_bf16(s0[14], s0[15]); pb[1] = __builtin_bit_cast(bf16x8, w);
                w.x = cvt_pk_bf16(s1[0], s1[1]); w.y = cvt_pk_bf16(s1[2], s1[3]); w.z = cvt_pk_bf16(s1[4], s1[5]); w.w = cvt_pk_bf16(s1[6], s1[7]); pb[2] = __builtin_bit_cast(bf16x8, w);
                w.x = cvt_pk_bf16(s1[8], s1[9]); w.y = cvt_pk_bf16(s1[10], s1[11]); w.z = cvt_pk_bf16(s1[12], s1[13]); w.w = cvt_pk_bf16(s1[14], s1[15]); pb[3] = __builtin_bit_cast(bf16x8, w);
            }
            if (j + 1 < ntiles) ATT_LOADV(j + 1);
            const LAS unsigned char* vb = kb + KBYTES;
#pragma unroll
            for (int d = 0; d < 4; ++d)
#pragma unroll
                for (int ks = 0; ks < 4; ++ks) {
                    const LAS unsigned char* ap = vb + (d * 32 + l32) * VROW + (16 * ks + 4 * h) * 2;
                    const u32x2 lo = *(const LAS u32x2*)ap, hi = *(const LAS u32x2*)(ap + 16);
                    const u32x4 w = (u32x4){lo.x, lo.y, hi.x, hi.y};
                    o[d] = mfma32(__builtin_bit_cast(bf16x8, w), pb[ks], o[d]);
                    if (ks == 3) __builtin_amdgcn_sched_barrier(0);
                }
            if (j + 1 < ntiles) ATT_STORE(buf ^ 1);
            __syncthreads();
        }
        l_run += __shfl_xor(l_run, 32);
        const float inv = 1.0f / l_run;
#if DEBUG_CHECK == 5
        bf16_t* orow = (bf16_t*)(launder(p.ws) + OFF_ODBG) + (size_t)qrow * 512 + head * 128;
#else
        bf16_t* orow = Q + (size_t)qrow * 768 + head * 192;
#endif
#pragma unroll
        for (int d = 0; d < 4; ++d)
#pragma unroll
            for (int rq = 0; rq < 4; ++rq) {
                const u32x2 w = (u32x2){cvt_pk_bf16(o[d][4 * rq] * inv, o[d][4 * rq + 1] * inv), cvt_pk_bf16(o[d][4 * rq + 2] * inv, o[d][4 * rq + 3] * inv)};
                *(GAS u32x2*)(orow + 32 * d + 8 * rq + 4 * h) = w;
            }
#undef ATT_LOAD
#undef ATT_LOADV
#undef ATT_STORE
#undef ATT_STOREK
    }
}

template <int SET> __device__ __forceinline__ void hyena_unit(const Params& p, LAS unsigned char* lds, int c, int bg) {
    constexpr int P = SET ? 32 : 128;
    constexpr int NBU = SET ? 16 : 4;
    constexpr int NBT = SET ? 8 : 2;
    constexpr int GP = SET ? 4 : 16;
    constexpr int LG = SET ? LGS : LGP;
    constexpr int NB = SET ? NBS : NBP;
    constexpr int RS = SET ? 4896 : 18816;
    constexpr int GBYTES = 2 * LG * 2;
    constexpr int G1OFF = 33220;
    constexpr int ZOFF = 66560;
    unsigned char* ws = launder(p.ws);
    const int tid = tid_l(), lane = tid & 63, wave = tid >> 6, h = lane >> 5, l32 = lane & 31;
    const bf16_t* X1T = (const bf16_t*)(ws + OFF_X1T) + (SET ? XT_SET1 : 0);
    bf16_t* X2T = (bf16_t*)(ws + OFF_X2T) + (SET ? XT_SET1 : 0);
    const bf16_t* V0T = (const bf16_t*)(ws + OFF_V0T) + (SET ? XT_SET1 : 0);
    const bf16_t* GR = (const bf16_t*)(ws + (SET ? OFF_GR1 : OFF_GR0));
    const float* hy_bias = launder(p.in[17]);
    LAS unsigned char* gL = lds; LAS unsigned char* zL = lds + ZOFF;
    const size_t rowbase = ((size_t)c * NB + bg * NBU) * LG;
    for (int id = tid; id < NBU * (P + 1) * 8; id += 512) {
        const int bl = id / ((P + 1) * 8), rem = id % ((P + 1) * 8), blk = rem >> 3, ch = rem & 7;
        *(LAS u32x4*)(zL + bl * RS + blk * 144 + ch * 16) = *(const GAS u32x4*)(V0T + rowbase + (size_t)bl * LG + blk * 64 + ch * 8);
    }
    for (int id = tid; id < NBU * 9; id += 512) { const int bl = id / 9, ch = id % 9; *(LAS u32x4*)(zL + bl * RS + (P + 1) * 144 + ch * 16) = (u32x4){0u, 0u, 0u, 0u}; }
#define HY_LOADG(rowidx) do { const unsigned* g32_ = (const unsigned*)(GR + (size_t)(rowidx) * (2 * LG)); \
        for (int id = tid; id < GBYTES / 4; id += 512) { const unsigned a_ = g32_[id], b_ = (id + 1 < GBYTES / 4) ? g32_[id + 1] : 0u; \
            *(LAS unsigned*)(gL + id * 4) = a_; *(LAS unsigned*)(gL + G1OFF + id * 4) = (a_ >> 16) | (b_ << 16); } } while (0)
    HY_LOADG(c);
    __syncthreads();
    const LAS unsigned short* g16 = (const LAS unsigned short*)gL;
    constexpr int PARTS = 512 / (NBU * 16);
    float zmeta = 0.f; int mo_bl, mo_m;
    {
        const int part = tid % PARTS, out = tid / PARTS; mo_bl = out >> 4; mo_m = out & 15;
        const LAS unsigned char* zr = zL + mo_bl * RS;
        float a = 0.f;
        const LAS unsigned char* gm = gL + (mo_m & 1) * G1OFF;
        for (int ci = part; ci < (LG - 48) / 8; ci += PARTS) {
            const int tt0 = 48 + 8 * ci;
            const u32x4 zv = *(const LAS u32x4*)(zr + (tt0 >> 6) * 144 + (tt0 & 63) * 2);
            const LAS unsigned* gp = (const LAS unsigned*)(gm + ((LG - mo_m - 48 + tt0) >> 1) * 4);
            const unsigned g0 = gp[0], g1 = gp[1], g2 = gp[2], g3 = gp[3];
            a += (bflo(zv.x) * bflo(g0) + bfhi(zv.x) * bfhi(g0)) + (bflo(zv.y) * bflo(g1) + bfhi(zv.y) * bfhi(g1))
               + (bflo(zv.z) * bflo(g2) + bfhi(zv.z) * bfhi(g2)) + (bflo(zv.w) * bflo(g3) + bfhi(zv.w) * bfhi(g3));
        }
#pragma unroll
        for (int o = 1; o < PARTS; o <<= 1) a += __shfl_xor(a, o);
        const float bias0 = hy_bias[c];
        const float z0 = bf2f(*(const LAS unsigned short*)(zr + (48 + mo_m) * 2));
        const float x1 = bf2f(X1T[rowbase + (size_t)mo_bl * LG + 48 + mo_m]);
        zmeta = x1 * (a + z0 * bias0);
    }
    const int p0 = GP * wave;
    const int pp = l32 / NBT, blA = l32 % NBT, blB = NBT + blA;
#pragma unroll 1
    for (int order = 0; order < 2; ++order) {
        f32x16 acc[2][2];
#pragma unroll
        for (int a = 0; a < 2; ++a)
#pragma unroll
            for (int b = 0; b < 2; ++b)
#pragma unroll
                for (int r = 0; r < 16; ++r) acc[a][b][r] = 0.f;
        bf16x8 Ep4, Ep5;
        {
            const int d0 = p0 - (P - 1); const int ib0 = LG - 64 * d0 - l32 + 8 * h;
            const LAS unsigned char* g0 = gL + (l32 & 1) * G1OFF + (ib0 >> 1) * 4;
            const LAS unsigned* ga = (const LAS unsigned*)(g0 + 96); const LAS unsigned* gb = (const LAS unsigned*)(g0 + 64);
            Ep4 = __builtin_bit_cast(bf16x8, (u32x4){ga[0], ga[1], ga[2], ga[3]}); Ep5 = __builtin_bit_cast(bf16x8, (u32x4){gb[0], gb[1], gb[2], gb[3]});
        }
#define HY_LOAD(dd, Bv, Ev) do { \
            const int ib_ = LG - 64 * (dd) - l32 + 8 * h; \
            const LAS unsigned char* gpl_ = gL + (l32 & 1) * G1OFF + (ib_ >> 1) * 4; \
            _Pragma("unroll") for (int e = 2; e < 6; ++e) { const LAS unsigned* gp_ = (const LAS unsigned*)(gpl_ - 32 * (e - 3)); \
                Ev[e - 2] = __builtin_bit_cast(bf16x8, (u32x4){gp_[0], gp_[1], gp_[2], gp_[3]}); } \
            const int q_ = p0 + pp - (dd); const int slot_ = ((unsigned)(q_ + 1) <= (unsigned)P) ? q_ + 1 : P + 1; \
            const LAS unsigned char* zA_ = zL + blA * RS + slot_ * 144 + h * 16; const LAS unsigned char* zB_ = zL + blB * RS + slot_ * 144 + h * 16; \
            _Pragma("unroll") for (int ks = 0; ks < 4; ++ks) { Bv[0][ks] = *(const LAS bf16x8*)(zA_ + ks * 32); Bv[1][ks] = *(const LAS bf16x8*)(zB_ + ks * 32); } } while (0)
#define HY_MMA(Bv, Ev) do { \
            _Pragma("unroll") for (int ks = 0; ks < 4; ++ks) { \
                const bf16x8 a0_ = (ks == 0) ? Ev[1] : (ks == 1) ? Ev[0] : (ks == 2) ? Ep5 : Ep4; \
                const bf16x8 a1_ = (ks == 0) ? Ev[3] : (ks == 1) ? Ev[2] : (ks == 2) ? Ev[1] : Ev[0]; \
                acc[0][0] = mfma32(a0_, Bv[0][ks], acc[0][0]); acc[1][0] = mfma32(a0_, Bv[1][ks], acc[1][0]); \
                acc[0][1] = mfma32(a1_, Bv[0][ks], acc[0][1]); acc[1][1] = mfma32(a1_, Bv[1][ks], acc[1][1]); } \
            Ep4 = Ev[2]; Ep5 = Ev[3]; } while (0)
        {
            bf16x8 BA[2][4], BB[2][4], EA[4], EB[4];
            const int dlo = p0 - (P - 1), dhi = p0 + GP;
            HY_LOAD(dlo, BA, EA);
#pragma unroll 1
            for (int d = dlo; d <= dhi; d += 2) {
                HY_LOAD(d + 1, BB, EB);
                HY_MMA(BA, EA);
                if (d + 2 <= dhi) HY_LOAD(d + 2, BA, EA);
                HY_MMA(BB, EB);
            }
        }
#undef HY_LOAD
#undef HY_MMA
        __syncthreads();
        const float bias = hy_bias[order * 512 + c];
#pragma unroll
        for (int tl = 0; tl < 2; ++tl) {
            const int bl = tl ? blB : blA;
            const size_t grow = rowbase + (size_t)bl * LG + 64 * (p0 + pp + 1);
            LAS unsigned char* zr = zL + bl * RS + (p0 + pp + 1) * 144;
#pragma unroll
            for (int m = 0; m < 2; ++m)
#pragma unroll
                for (int rq = 0; rq < 4; ++rq) {
                    const int off = 32 * m + 8 * rq + 4 * h;
                    const u32x2 zw = *(const LAS u32x2*)(zr + off * 2);
                    const u32x2 xw = *(const GAS u32x2*)((order ? (const bf16_t*)X2T : X1T) + grow + off);
                    const float y0 = acc[tl][m][4 * rq], y1 = acc[tl][m][4 * rq + 1], y2 = acc[tl][m][4 * rq + 2], y3 = acc[tl][m][4 * rq + 3];
                    const float r0 = bflo(xw.x) * (y0 + bflo(zw.x) * bias), r1 = bfhi(xw.x) * (y1 + bfhi(zw.x) * bias);
                    const float r2 = bflo(xw.y) * (y2 + bflo(zw.y) * bias), r3 = bfhi(xw.y) * (y3 + bfhi(zw.y) * bias);
                    const u32x2 w = (u32x2){cvt_pk_bf16(r0, r1), cvt_pk_bf16(r2, r3)};
#if DEBUG_CHECK == 5
                    if (order == 0) *(LAS u32x2*)(zr + off * 2) = w; else *(GAS u32x2*)((bf16_t*)(ws + OFF_HDBG) + (SET ? XT_SET1 : 0) + grow + off) = w;
#else
                    if (order == 0) *(LAS u32x2*)(zr + off * 2) = w; else *(GAS u32x2*)(X2T + grow + off) = w;
#endif
                }
        }
        if (order == 0) {
            if ((tid % PARTS) == 0) *(LAS unsigned short*)(zL + mo_bl * RS + (48 + mo_m) * 2) = (unsigned short)(cvt_pk_bf16(zmeta, 0.f) & 0xffffu);
            HY_LOADG(512 + c);
        }
        __syncthreads();
    }
}
#undef HY_LOADG
__device__ __forceinline__ void hyena_phase(const Params& p, LAS unsigned char* lds) {
    for (int u = blockIdx.x; u < 2048; u += gridDim.x) {
        if (u < 1024) hyena_unit<0>(p, lds, u >> 1, u & 1); else hyena_unit<1>(p, lds, (u - 1024) >> 1, u & 1);
    }
}

__device__ __forceinline__ void mixnorm_phase(const Params& p, LAS unsigned char* lds) {
    unsigned char* ws = launder(p.ws); const int tid = tid_l(), lane = tid & 63, wave = tid >> 6, G = gridDim.x;
    const bf16_t* Q = (const bf16_t*)(launder((unsigned char*)p.out) + DO_Q);
    bf16_t* MIXN = (bf16_t*)(ws + OFF_MIXN);
    const float* ga = launder(p.in[18]); const float* gh = launder(p.in[19]);
    constexpr int RSB = 1040;
    for (int u = blockIdx.x; u < 2048; u += G) {
        const int n0 = u * 64;
        int set, b, tok0;
        if (n0 < 65536) { set = 0; b = n0 >> 13; tok0 = n0 & 8191; } else { set = 1; const int q = n0 - 65536; b = q >> 11; tok0 = q & 2047; }
        const int Lg = set ? LGS : LGP, NB = set ? NBS : NBP;
        {
            const int c = tid;
#if DEBUG_CHECK == 5
            const bf16_t* src = (const bf16_t*)(ws + OFF_HDBG) + (set ? XT_SET1 : 0) + ((size_t)c * NB + b) * Lg + tok0 + 64;
#else
            const bf16_t* src = (const bf16_t*)(ws + OFF_X2T) + (set ? XT_SET1 : 0) + ((size_t)c * NB + b) * Lg + tok0 + 64;
#endif
            LAS unsigned short* tl = (LAS unsigned short*)lds + c;
#pragma unroll
            for (int k8 = 0; k8 < 8; ++k8) {
                const u32x4 v = *(const GAS u32x4*)(src + k8 * 8);
                tl[(k8 * 8 + 0) * (RSB / 2)] = (unsigned short)(v.x & 0xffffu); tl[(k8 * 8 + 1) * (RSB / 2)] = (unsigned short)(v.x >> 16);
                tl[(k8 * 8 + 2) * (RSB / 2)] = (unsigned short)(v.y & 0xffffu); tl[(k8 * 8 + 3) * (RSB / 2)] = (unsigned short)(v.y >> 16);
                tl[(k8 * 8 + 4) * (RSB / 2)] = (unsigned short)(v.z & 0xffffu); tl[(k8 * 8 + 5) * (RSB / 2)] = (unsigned short)(v.z >> 16);
                tl[(k8 * 8 + 6) * (RSB / 2)] = (unsigned short)(v.w & 0xffffu); tl[(k8 * 8 + 7) * (RSB / 2)] = (unsigned short)(v.w >> 16);
            }
        }
        __syncthreads();
        for (int i = 0; i < 8; ++i) {
            const int rr = wave + 8 * i; const int n = n0 + rr; const int r = full_row(n);
            const u32x4 hv = *(const LAS u32x4*)(lds + rr * RSB + lane * 16);
#if DEBUG_CHECK == 5
            const u32x4 av = *(const GAS u32x4*)((const bf16_t*)(ws + OFF_ODBG) + (size_t)r * 512 + lane * 8);
#else
            const u32x4 av = *(const GAS u32x4*)(Q + (size_t)r * 768 + (lane >> 4) * 192 + (lane & 15) * 8);
#endif
            float hf[8] = {bflo(hv.x), bfhi(hv.x), bflo(hv.y), bfhi(hv.y), bflo(hv.z), bfhi(hv.z), bflo(hv.w), bfhi(hv.w)};
            float af[8] = {bflo(av.x), bfhi(av.x), bflo(av.y), bfhi(av.y), bflo(av.z), bfhi(av.z), bflo(av.w), bfhi(av.w)};
            float sh = 0.f, sa = 0.f;
#pragma unroll
            for (int k = 0; k < 8; ++k) { sh += hf[k] * hf[k]; sa += af[k] * af[k]; }
            sh = wave_sum(sh); sa = wave_sum(sa);
            const float rh = rsqrtf(sh * (1.f / 512.f) + EPS), ra = rsqrtf(sa * (1.f / 512.f) + EPS);
            const f32x4 ga0 = *(const GAS f32x4*)(ga + lane * 8), ga1 = *(const GAS f32x4*)(ga + lane * 8 + 4);
            const f32x4 gh0 = *(const GAS f32x4*)(gh + lane * 8), gh1 = *(const GAS f32x4*)(gh + lane * 8 + 4);
            u32x4 wa, wh;
            wa.x = cvt_pk_bf16(af[0] * ra * ga0[0], af[1] * ra * ga0[1]); wa.y = cvt_pk_bf16(af[2] * ra * ga0[2], af[3] * ra * ga0[3]);
            wa.z = cvt_pk_bf16(af[4] * ra * ga1[0], af[5] * ra * ga1[1]); wa.w = cvt_pk_bf16(af[6] * ra * ga1[2], af[7] * ra * ga1[3]);
            wh.x = cvt_pk_bf16(hf[0] * rh * gh0[0], hf[1] * rh * gh0[1]); wh.y = cvt_pk_bf16(hf[2] * rh * gh0[2], hf[3] * rh * gh0[3]);
            wh.z = cvt_pk_bf16(hf[4] * rh * gh1[0], hf[5] * rh * gh1[1]); wh.w = cvt_pk_bf16(hf[6] * rh * gh1[2], hf[7] * rh * gh1[3]);
#if EXPT == 1
            wa = (u32x4){0u, 0u, 0u, 0u};
#endif
#if EXPT == 2
            wh = (u32x4){0u, 0u, 0u, 0u};
#endif
            *(GAS u32x4*)(MIXN + (size_t)n * 1024 + lane * 8) = wa;
            *(GAS u32x4*)(MIXN + (size_t)n * 1024 + 512 + lane * 8) = wh;
        }
        __syncthreads();
    }
}

__device__ __forceinline__ void h1_phase(const Params& p) {
    unsigned char* ws = launder(p.ws); const int tid = tid_l(), lane = tid & 63, wave = tid >> 6;
    const int gw = blockIdx.x * 8 + wave, NGW = gridDim.x * 8;
    const bf16_t* MIX = (const bf16_t*)(ws + OFF_MIX); bf16_t* H1B = (bf16_t*)(ws + OFF_H1B);
    const float* sqmix = (const float*)(ws + OFF_SQMIXP); float* r1 = (float*)(ws + OFF_R1); const float* g = p.in[21];
    for (int n = gw; n < TN; n += NGW) {
        const float* xrow = n < 65536 ? p.in[0] + (size_t)n * 1024 : p.in[1] + (size_t)(n - 65536) * 1024;
        const float rm = rsqrtf(wave_sum(lane < 16 ? ldco(sqmix + (size_t)n * 16 + lane) : 0.f) * (1.f / 1024.f) + EPS);
        float ss = 0.f;
#pragma unroll
        for (int hh = 0; hh < 2; ++hh) {
            const int c0 = hh * 512 + lane * 8;
            const u32x4 mv = *(const u32x4*)(MIX + (size_t)n * 1024 + c0);
            const f32x4 x0 = *(const f32x4*)(xrow + c0), x1 = *(const f32x4*)(xrow + c0 + 4);
            const f32x4 g0 = *(const f32x4*)(g + c0), g1 = *(const f32x4*)(g + c0 + 4);
            f32x4 h0, h1;
            h0[0] = x0[0] + bflo(mv.x) * rm * g0[0]; h0[1] = x0[1] + bfhi(mv.x) * rm * g0[1]; h0[2] = x0[2] + bflo(mv.y) * rm * g0[2]; h0[3] = x0[3] + bfhi(mv.y) * rm * g0[3];
            h1[0] = x1[0] + bflo(mv.z) * rm * g1[0]; h1[1] = x1[1] + bfhi(mv.z) * rm * g1[1]; h1[2] = x1[2] + bflo(mv.w) * rm * g1[2]; h1[3] = x1[3] + bfhi(mv.w) * rm * g1[3];
            ss += sq8(h0, h1);
            *(f32x4*)(p.out + (size_t)n * 1024 + c0) = h0; *(f32x4*)(p.out + (size_t)n * 1024 + c0 + 4) = h1;
            *(u32x4*)(H1B + (size_t)n * 1024 + c0) = pack8(h0, h1);
        }
        ss = wave_sum(ss);
        if (lane == 0) r1[n] = rsqrtf(ss * (1.f / 1024.f) + EPS);
    }
}
__device__ __forceinline__ void final_phase(const Params& p, int half) {
    unsigned char* ws = launder(p.ws); const int tid = tid_l(), lane = tid & 63, wave = tid >> 6;
    const int gw = blockIdx.x * 8 + wave, NGW = gridDim.x * 8;
    const bf16_t* M2 = (const bf16_t*)(ws + OFF_M2); const float* sqm2 = (const float*)(ws + OFF_SQM2P); const float* g = p.in[25];
    float dbg_off = 0.f, dbg_one = 0.f;
#if DEBUG_CHECK
    { const unsigned* dc = (const unsigned*)(ws + OFF_DBGW); dbg_off = 100.f * (float)dc[8] * (1.f / 131072.f); dbg_one = 1000.f * (float)dc[9] * (1.f / 131072.f); }
#endif
    for (int i = gw; i < 65536; i += NGW) {
        const int n = half * 65536 + i;
        const float rm = rsqrtf(wave_sum(lane < 16 ? ldco(sqm2 + (size_t)n * 16 + lane) : 0.f) * (1.f / 1024.f) + EPS);
#pragma unroll
        for (int hh = 0; hh < 2; ++hh) {
            const int c0 = hh * 512 + lane * 8;
            const u32x4 mv = *(const u32x4*)(M2 + (size_t)i * 1024 + c0);
            f32x4 h0 = *(const f32x4*)(p.out + (size_t)n * 1024 + c0), h1 = *(const f32x4*)(p.out + (size_t)n * 1024 + c0 + 4);
            const f32x4 g0 = *(const f32x4*)(g + c0), g1 = *(const f32x4*)(g + c0 + 4);
            h0 += dbg_off; h1 += dbg_off; if (n == 0 && c0 == 0) h0[0] += dbg_one;
            h0[0] += bflo(mv.x) * rm * g0[0]; h0[1] += bfhi(mv.x) * rm * g0[1]; h0[2] += bflo(mv.y) * rm * g0[2]; h0[3] += bfhi(mv.y) * rm * g0[3];
            h1[0] += bflo(mv.z) * rm * g1[0]; h1[1] += bfhi(mv.z) * rm * g1[1]; h1[2] += bflo(mv.w) * rm * g1[2]; h1[3] += bfhi(mv.w) * rm * g1[3];
            *(f32x4*)(p.out + (size_t)n * 1024 + c0) = h0; *(f32x4*)(p.out + (size_t)n * 1024 + c0 + 4) = h1;
        }
    }
}


#if DEBUG_CHECK
constexpr size_t OFF_DBG = OFF_DBGW;
__device__ __forceinline__ void check_gemm(const bf16_t* A, int lda, const bf16_t* Bt, int ldb, int K, int M, int N, int mode, const bf16_t* O, int ldc, const float* rs, unsigned* cnt, int col_lo) {
    const unsigned idx = blockIdx.x * 512u + (unsigned)tid_l();
    unsigned hsh = idx * 2654435761u + 12345u + (unsigned)mode * 977u; hsh ^= hsh >> 15; hsh *= 2246822519u; hsh ^= hsh >> 13;
    const int row = (int)(hsh % (unsigned)M); hsh = hsh * 3266489917u + 668265263u; hsh ^= hsh >> 16;
    const int col = col_lo + (int)(hsh % (unsigned)(N - col_lo));
    float d = 0.f;
    for (int k = 0; k < K; ++k) d += bf2f(A[(size_t)row * lda + k]) * bf2f(Bt[(size_t)col * ldb + k]);
    float e = d;
    if (mode == 0 || mode == 7) e = d * rs[row];
    if (mode == 5) { const float t = fmaxf(d * rs[row], 0.f); e = t * t; }
    const float st = bf2f(O[(size_t)row * ldc + col]);
    if (!(fabsf(st - e) <= 0.03f * fabsf(e) + 0.03f)) atomicAdd(cnt, 1u);
}
#endif

#if DEBUG_CHECK == 2
__device__ __forceinline__ void check_proj(const Params& p) {
    unsigned char* ws = launder(p.ws); unsigned char* ob = launder((unsigned char*)p.out);
    const bf16_t* P = (const bf16_t*)(ws + OFF_P); unsigned* cnt = (unsigned*)(ws + OFF_DBG);
    const unsigned idx = blockIdx.x * 512u + (unsigned)tid_l();
    unsigned hsh = idx * 2654435761u + 777u; hsh ^= hsh >> 15; hsh *= 2246822519u; hsh ^= hsh >> 13;
    const int row = (int)(hsh % (unsigned)T); hsh = hsh * 3266489917u + 668265263u; hsh ^= hsh >> 16;
    int pos, seq; row_info(row, pos, seq);
    {
        const int n = (int)(hsh % 768u); const int hh = n / 192, w = n % 192;
        float ss = 0.f, x1 = 0.f, x2 = 0.f; const float* W = p.in[6]; const float* g = p.in[5];
        const int j = w - 128, i = j >> 1;
        const int c1 = w < 128 ? hh * 192 + w : hh * 192 + 128 + i, c2 = hh * 192 + 160 + (w < 128 ? 0 : i);
        for (int k = 0; k < 256; ++k) { const float a = bf2f(P[(size_t)row * NPP + k]); ss += a * a; x1 += a * g[k] * W[k * 768 + c1]; x2 += a * g[k] * W[k * 768 + c2]; }
        const float rq = rsqrtf(ss * (1.f / 256.f) + EPS) * QSCALE; x1 *= rq; x2 *= rq;
        float e = x1;
        if (w >= 128) { const float inv = 1.0f / exp2f((float)i * (13.287712379549449f / 32.f)); float sn, cs; sincos_red((float)pos * inv, sn, cs); e = (j & 1) ? x2 * cs + x1 * sn : x1 * cs - x2 * sn; }
        const float st = bf2f(((const bf16_t*)(ob + DO_Q))[(size_t)row * 768 + n]);
        if (!(fabsf(st - e) <= 0.03f * fabsf(e) + 0.01f)) atomicAdd(cnt + (w < 128 ? 0 : 4), 1u);
    }
    {
        const int n = (int)((hsh >> 3) % 512u); const int hh = n >> 7, i = n & 127;
        float ss = 0.f, x1 = 0.f, x2 = 0.f; const float* W = p.in[8]; const float* g = p.in[7];
        for (int k = 0; k < 128; ++k) { const float a = bf2f(P[(size_t)row * NPP + 256 + k]); ss += a * a; x1 += a * g[k] * W[k * 1024 + hh * 256 + i]; x2 += a * g[k] * W[k * 1024 + hh * 256 + 128 + i]; }
        const float rk = rsqrtf(ss * (1.f / 128.f) + EPS); x1 *= rk; x2 *= rk;
        const float s1 = bf2f(((const bf16_t*)(ob + DO_KN))[(size_t)row * 512 + n]);
        const float s2 = bf2f(((const bf16_t*)(ob + DO_VT))[(size_t)n * TPAD + row]);
        if (!(fabsf(s1 - x1) <= 0.03f * fabsf(x1) + 0.03f)) atomicAdd(cnt + 1, 1u);
        if (!(fabsf(s2 - x2) <= 0.03f * fabsf(x2) + 0.03f)) atomicAdd(cnt + 2, 1u);
    }
    {
        const int jj = (int)((hsh >> 5) % 64u); const int i = jj >> 1;
        const float* xr = pos < 16 ? p.in[2] + (size_t)pos * 1024 : (seq < NBP ? p.in[0] + ((size_t)seq * 8192 + (pos - 16)) * 1024 : p.in[1] + ((size_t)(seq - NBP) * 2048 + (pos - 16)) * 1024);
        const float* W = p.in[4]; const float* g = p.in[3]; float x1 = 0.f, x2 = 0.f;
        for (int k = 0; k < 1024; ++k) { const float a = xr[k] * g[k]; x1 += a * W[(size_t)k * 1984 + 384 + i]; x2 += a * W[(size_t)k * 1984 + 416 + i]; }
        const float r0 = ((const float*)(ws + OFF_R0))[row]; x1 *= r0; x2 *= r0;
        const float inv = 1.0f / exp2f((float)i * (13.287712379549449f / 32.f)); float sn, cs; sincos_red((float)pos * inv, sn, cs);
        const float e = (jj & 1) ? x2 * cs + x1 * sn : x1 * cs - x2 * sn;
        const float st = bf2f(((const bf16_t*)(ob + DO_KR))[(size_t)row * 64 + jj]);
        if (!(fabsf(st - e) <= 0.03f * fabsf(e) + 0.03f)) { atomicAdd(cnt + 3, 1u); atomicAdd(cnt + 5, (unsigned)i); atomicAdd(cnt + 6, (unsigned)(pos >> 3)); }
    }
}
#endif

#if DEBUG_CHECK == 3
__device__ __forceinline__ void check_h0b(const Params& p, int slot) {
    unsigned char* ws = launder(p.ws); unsigned* cnt = (unsigned*)(ws + OFF_DBGW);
    const bf16_t* h0b = (const bf16_t*)(ws + OFF_H0B);
    const unsigned idx = blockIdx.x * 512u + (unsigned)tid_l();
    unsigned hsh = idx * 2654435761u + 4242u + (unsigned)slot * 31u; hsh ^= hsh >> 15; hsh *= 2246822519u; hsh ^= hsh >> 13;
    const int row = (int)(hsh % (unsigned)T); hsh = hsh * 3266489917u + 668265263u; hsh ^= hsh >> 16;
    const int col = (int)(hsh % 1024u);
    int pos, seq; row_info(row, pos, seq);
    const float* xr = pos < 16 ? p.in[2] + (size_t)pos * 1024 : (seq < NBP ? p.in[0] + ((size_t)seq * 8192 + (pos - 16)) * 1024 : p.in[1] + ((size_t)(seq - NBP) * 2048 + (pos - 16)) * 1024);
    const float e = xr[col]; const float st = bf2f(h0b[(size_t)row * 1024 + col]);
    if (!(fabsf(st - e) <= 0.01f * fabsf(e) + 0.001f)) atomicAdd(cnt + slot, 1u);
}
#endif

#if DEBUG_CHECK == 4
__device__ __forceinline__ void check_stale(const Params& p, const unsigned* base, unsigned ndw, int slot) {
    unsigned* cnt = (unsigned*)(launder(p.ws) + OFF_DBGW);
    const unsigned idx = blockIdx.x * 512u + (unsigned)tid_l();
    unsigned hsh = idx * 2654435761u + 999u + (unsigned)slot * 131u; hsh ^= hsh >> 15; hsh *= 2246822519u; hsh ^= hsh >> 13;
#pragma unroll 1
    for (int it = 0; it < 16; ++it) {
        hsh = hsh * 3266489917u + 668265263u; hsh ^= hsh >> 16;
        const unsigned i = hsh % ndw;
        const unsigned a = base[i];
        const unsigned b = __hip_atomic_load(base + i, __ATOMIC_RELAXED, __HIP_MEMORY_SCOPE_AGENT);
        if (a != b) atomicAdd(cnt + slot, 1u);
    }
}
#endif

#if DEBUG_CHECK == 5
__device__ __forceinline__ void check_attn(const Params& p) {
    unsigned char* ws = launder(p.ws); unsigned char* ob = launder((unsigned char*)p.out); unsigned* cnt = (unsigned*)(ws + OFF_DBGW);
    const int tid = tid_l(), lane = tid & 63, wave = tid >> 6;
    const bf16_t* Q = (const bf16_t*)(ob + DO_Q); const bf16_t* KN = (const bf16_t*)(ob + DO_KN); const bf16_t* KR = (const bf16_t*)(ob + DO_KR); const bf16_t* VT = (const bf16_t*)(ob + DO_VT);
    const bf16_t* OD = (const bf16_t*)(ws + OFF_ODBG); const float2* RT = (const float2*)(ws + OFF_RT);
    unsigned hsh = (unsigned)(blockIdx.x * 8 + wave) * 2654435761u + 31337u; hsh ^= hsh >> 15; hsh *= 2246822519u; hsh ^= hsh >> 13;
    const int n = (int)(hsh % (unsigned)TN); const int head = (int)((hsh >> 20) & 3u); const int r = full_row(n);
    int pos, seq; row_info(r, pos, seq);
    const int L = seq < NBP ? LP : LS; const int row0 = r - pos;
    const bf16_t* qp = Q + (size_t)r * 768 + head * 192;
    float mx = -INFINITY;
    for (int k = lane; k < L; k += 64) {
        float sdot = 0.f;
        for (int d = 0; d < 128; ++d) sdot += bf2f(qp[d]) * bf2f(KN[(size_t)(row0 + k) * 512 + head * 128 + d]);
        for (int i = 0; i < 32; ++i) { const float2 cs = ldco2(RT + pos * 32 + i); const float a = bf2f(qp[128 + 2 * i]), b = bf2f(qp[129 + 2 * i]);
            sdot += (a * cs.x - b * cs.y) * bf2f(KR[(size_t)(row0 + k) * 64 + 2 * i]) + (b * cs.x + a * cs.y) * bf2f(KR[(size_t)(row0 + k) * 64 + 2 * i + 1]); }
        mx = fmaxf(mx, sdot);
    }
#pragma unroll
    for (int o = 1; o < 64; o <<= 1) mx = fmaxf(mx, __shfl_xor(mx, o));
    float sw = 0.f, o0 = 0.f, o1 = 0.f; const int dv0 = (int)((hsh >> 8) & 127u), dv1 = (dv0 + 37) & 127;
    for (int k = lane; k < L; k += 64) {
        float sdot = 0.f;
        for (int d = 0; d < 128; ++d) sdot += bf2f(qp[d]) * bf2f(KN[(size_t)(row0 + k) * 512 + head * 128 + d]);
        for (int i = 0; i < 32; ++i) { const float2 cs = ldco2(RT + pos * 32 + i); const float a = bf2f(qp[128 + 2 * i]), b = bf2f(qp[129 + 2 * i]);
            sdot += (a * cs.x - b * cs.y) * bf2f(KR[(size_t)(row0 + k) * 64 + 2 * i]) + (b * cs.x + a * cs.y) * bf2f(KR[(size_t)(row0 + k) * 64 + 2 * i + 1]); }
        const float w = exp2f(sdot - mx); sw += w;
        o0 += w * bf2f(VT[(size_t)(head * 128 + dv0) * TPAD + row0 + k]); o1 += w * bf2f(VT[(size_t)(head * 128 + dv1) * TPAD + row0 + k]);
    }
    sw = wave_sum(sw); o0 = wave_sum(o0) / sw; o1 = wave_sum(o1) / sw;
    if (lane == 0) {
        const float s0 = bf2f(OD[(size_t)r * 512 + head * 128 + dv0]), s1 = bf2f(OD[(size_t)r * 512 + head * 128 + dv1]);
        atomicAdd(cnt + 10, 2u);
        if (!(fabsf(s0 - o0) <= 0.05f * fabsf(o0) + 0.002f)) atomicAdd(cnt + 8, 1u);
        if (!(fabsf(s1 - o1) <= 0.05f * fabsf(o1) + 0.002f)) atomicAdd(cnt + 8, 1u);
    }
}
__device__ __forceinline__ void check_hyena(const Params& p, LAS unsigned char* lds) {
    unsigned char* ws = launder(p.ws); unsigned* cnt = (unsigned*)(ws + OFF_DBGW);
    const int tid = tid_l();
    unsigned hsh = (unsigned)blockIdx.x * 2654435761u + 555u; hsh ^= hsh >> 15; hsh *= 2246822519u; hsh ^= hsh >> 13;
    const int set = (int)(blockIdx.x & 1u); const int c = (int)(hsh % 512u); const int NB = set ? NBS : NBP; const int b = (int)((hsh >> 12) % (unsigned)NB);
    const int LG = set ? LGS : LGP;
    const size_t base = (set ? XT_SET1 : 0) + ((size_t)c * NB + b) * LG;
    const bf16_t* X1 = (const bf16_t*)(ws + OFF_X1T) + base; const bf16_t* X2 = (const bf16_t*)(ws + OFF_X2T) + base; const bf16_t* V0 = (const bf16_t*)(ws + OFF_V0T) + base;
    const bf16_t* HD = (const bf16_t*)(ws + OFF_HDBG) + base;
    const bf16_t* G0 = (const bf16_t*)(ws + (set ? OFF_GR1 : OFF_GR0)) + (size_t)c * (2 * LG); const bf16_t* G1 = G0 + (size_t)512 * (2 * LG);
    const float bias0 = p.in[17][c], bias1 = p.in[17][512 + c];
    LAS float* z1 = (LAS float*)lds;
    for (int t = tid; t < LG; t += 512) {
        float y = 0.f;
        for (int s2 = 48; s2 < LG; ++s2) y += bf2f(G0[LG - (t - s2)]) * bf2f(V0[s2]);
        const float v = bf2f(X1[t]) * (y + bf2f(V0[t]) * bias0);
        z1[t] = (t >= 48) ? bf2f((unsigned short)(cvt_pk_bf16(v, 0.f) & 0xffffu)) : 0.f;
    }
    __syncthreads();
    {
        unsigned h2 = hsh * 3266489917u + (unsigned)tid * 2246822519u; h2 ^= h2 >> 15; h2 *= 2654435761u; h2 ^= h2 >> 13;
        const int t = 64 + (int)(h2 % (unsigned)(LG - 64));
        float y = 0.f;
        for (int s2 = 48; s2 < LG; ++s2) y += bf2f(G1[LG - (t - s2)]) * z1[s2];
        const float e = bf2f(X2[t]) * (y + z1[t] * bias1);
        const float st = bf2f(HD[t]);
        atomicAdd(cnt + 11, 1u);
        if (!(fabsf(st - e) <= 0.05f * fabsf(e) + 1.0f)) atomicAdd(cnt + 9, 1u);
    }
    __syncthreads();
}
#endif

#if DEBUG_CHECK == 7
__device__ __forceinline__ void check_h0b_full(const Params& p, int slot) {
    unsigned char* ws = launder(p.ws); unsigned* cnt = (unsigned*)(ws + OFF_DBGW);
    const bf16_t* h0b = (const bf16_t*)(ws + OFF_H0B);
    const int tid = tid_l(), lane = tid & 63, wave = tid >> 6;
    for (int row = blockIdx.x * 8 + wave; row < T; row += gridDim.x * 8) {
        int pos, seq; row_info(row, pos, seq);
        const float* xr = pos < 16 ? p.in[2] + (size_t)pos * 1024 : (seq < NBP ? p.in[0] + ((size_t)seq * 8192 + (pos - 16)) * 1024 : p.in[1] + ((size_t)(seq - NBP) * 2048 + (pos - 16)) * 1024);
        int bad = 0;
        for (int c = lane; c < 1024; c += 64) { const float e = xr[c]; const float st = bf2f(h0b[(size_t)row * 1024 + c]); if (!(fabsf(st - e) <= 0.01f * fabsf(e) + 0.001f)) bad = 1; }
        bad = __any(bad);
        if (lane == 0 && bad) atomicAdd(cnt + slot, 1u);
    }
}
#endif

#if DEBUG_CHECK == 8
__device__ __forceinline__ void check_p_golden(const Params& p) {
    unsigned char* ws = launder(p.ws); unsigned* cnt = (unsigned*)(ws + OFF_DBGW);
    const bf16_t* P = (const bf16_t*)(ws + OFF_P);
    const unsigned idx = blockIdx.x * 512u + (unsigned)tid_l();
    unsigned hsh = idx * 2654435761u + 8888u; hsh ^= hsh >> 15; hsh *= 2246822519u; hsh ^= hsh >> 13;
    const int row = (int)(hsh % (unsigned)T); hsh = hsh * 3266489917u + 668265263u; hsh ^= hsh >> 16;
    int pos, seq; row_info(row, pos, seq);
    const float* xr = pos < 16 ? p.in[2] + (size_t)pos * 1024 : (seq < NBP ? p.in[0] + ((size_t)seq * 8192 + (pos - 16)) * 1024 : p.in[1] + ((size_t)(seq - NBP) * 2048 + (pos - 16)) * 1024);
    const float* W = p.in[4]; const float* g = p.in[3];
    const int colA = 448 + (int)(hsh % 1536u), colB = (int)((hsh >> 7) % 384u);
    float ss = 0.f, a = 0.f, b = 0.f;
    for (int k = 0; k < 1024; ++k) { const float x = xr[k]; ss += x * x; a += x * g[k] * W[(size_t)k * 1984 + colA]; b += x * g[k] * W[(size_t)k * 1984 + colB]; }
    const float r0 = rsqrtf(ss * (1.f / 1024.f) + EPS); a *= r0; b *= r0;
    const float sa = bf2f(P[(size_t)row * NPP + colA]), sb = bf2f(P[(size_t)row * NPP + colB]);
    if (!(fabsf(sa - a) <= 0.03f * fabsf(a) + 0.03f)) atomicAdd(cnt + 8, 1u);
    if (!(fabsf(sb - b) <= 0.03f * fabsf(b) + 0.03f)) atomicAdd(cnt + 9, 1u);
}
#endif

#if DEBUG_CHECK == 9
__device__ __forceinline__ void check_win_r0(const Params& p) {
    unsigned char* ws = launder(p.ws); unsigned* cnt = (unsigned*)(ws + OFF_DBGW);
    const bf16_t* WT = (const bf16_t*)(ws + OFF_WIN); const float* W = p.in[4]; const float* g = p.in[3]; const float* R0 = (const float*)(ws + OFF_R0);
    const int tid = tid_l(), lane = tid & 63, wave = tid >> 6;
    const int gtid = blockIdx.x * 512 + tid, gthreads = gridDim.x * 512;
    for (int e = gtid; e < 1984 * 1024; e += gthreads) {
        const int n = e >> 10, k = e & 1023; const int sc = src_col(1, n);
        const float ex = W[(size_t)k * 1984 + sc] * g[k]; const float st = bf2f(WT[(size_t)n * 1024 + k]);
        if (!(fabsf(st - ex) <= 0.01f * fabsf(ex) + 1e-5f)) atomicAdd(cnt + 8, 1u);
    }
    for (int row = blockIdx.x * 8 + wave; row < T; row += gridDim.x * 8) {
        int pos, seq; row_info(row, pos, seq);
        const float* xr = pos < 16 ? p.in[2] + (size_t)pos * 1024 : (seq < NBP ? p.in[0] + ((size_t)seq * 8192 + (pos - 16)) * 1024 : p.in[1] + ((size_t)(seq - NBP) * 2048 + (pos - 16)) * 1024);
        float ss = 0.f;
        for (int c = lane; c < 1024; c += 64) ss += xr[c] * xr[c];
        ss = wave_sum(ss);
        const float ex = rsqrtf(ss * (1.f / 1024.f) + EPS); const float st = R0[row];
        if (lane == 0 && !(fabsf(st - ex) <= 0.001f * ex)) { atomicAdd(cnt + 9, 1u); atomicAdd(cnt + 12, (unsigned)(row >> 6)); }
    }
}
#endif

#if DEBUG_CHECK == 10
__device__ __forceinline__ void check_x(const Params& p, int mode) {
    unsigned char* ws = launder(p.ws); unsigned* cnt = (unsigned*)(ws + OFF_DBGW); unsigned* sums = (unsigned*)(ws + OFF_DBGW + MiB);
    const int tid = tid_l(), lane = tid & 63, wave = tid >> 6;
    for (int n = blockIdx.x * 8 + wave; n < TN; n += gridDim.x * 8) {
        const unsigned* xr = (const unsigned*)(n < 65536 ? p.in[0] + (size_t)n * 1024 : p.in[1] + (size_t)(n - 65536) * 1024);
        unsigned a = 0u;
        for (int c = lane; c < 1024; c += 64) a += xr[c] * (2u * (unsigned)c + 1u);
#pragma unroll
        for (int o = 1; o < 64; o <<= 1) a += __shfl_xor(a, o);
        if (lane == 0) {
            if (mode == 0) __hip_atomic_store(sums + n, a, __ATOMIC_RELAXED, __HIP_MEMORY_SCOPE_AGENT);
            else if (__hip_atomic_load(sums + n, __ATOMIC_RELAXED, __HIP_MEMORY_SCOPE_AGENT) != a) atomicAdd(cnt + 8, 1u);
        }
    }
}
#endif

#if DEBUG_CHECK == 11
__device__ __forceinline__ void check_filt_prep(const Params& p) {
    unsigned char* ws = launder(p.ws); unsigned* cnt = (unsigned*)(ws + OFF_DBGW);
    const unsigned idx = blockIdx.x * 512u + (unsigned)tid_l();
    unsigned hsh = idx * 2654435761u + 1111u; hsh ^= hsh >> 15; hsh *= 2246822519u; hsh ^= hsh >> 13;
    {
        const int set = (int)(hsh & 1u); const int L = set ? LS : LP; const int C0 = set ? LGS : LGP;
        const int n = (int)((hsh >> 1) % 2048u); hsh = hsh * 3266489917u + 668265263u; hsh ^= hsh >> 16;
        const int t = (int)(hsh % (unsigned)L);
        const float* f_w1 = p.in[10]; const float* f_b1 = p.in[11]; const float* f_freq = p.in[12]; const float* f_w2 = p.in[13];
        const float* f_b2 = p.in[14]; const float* f_w3 = p.in[15]; const float* f_decay = p.in[16];
        const float tn = (float)t / (float)(L - 1); const float w = (6.2831853071795865f * (float)t) / (float)L;
        float acc = 0.f;
        for (int j2 = 0; j2 < 64; ++j2) {
            float a2 = f_b2[j2];
            for (int j1 = 0; j1 < 64; ++j1) {
                float a1 = f_b1[j1] + tn * f_w1[j1];
                for (int k = 0; k < 16; ++k) { const float f = 1e-4f + (float)k * ((15.0f - 1e-4f) / 15.0f); float sn, cs; sincos_red(f * w, sn, cs);
                    a1 += cs * f_w1[(1 + k) * 64 + j1] - sn * f_w1[(17 + k) * 64 + j1]; }
                a2 += sin_red(f_freq[j1] * a1) * f_w2[j1 * 64 + j2];
            }
            acc += sin_red(f_freq[j2] * a2) * f_w3[j2 * 2048 + n];
        }
        const float e = acc * __expf(-tn * fabsf(f_decay[n]));
        const int order = n >> 10, dir = (n >> 9) & 1, c = n & 511;
        if (!(dir == 1 && t == 0)) {
            const bf16_t* row = (const bf16_t*)(ws + (set ? OFF_GR1 : OFF_GR0)) + (size_t)(order * 512 + c) * (2 * C0);
            const float st = bf2f(row[dir ? C0 + t : C0 - t]);
            if (!(fabsf(st - e) <= 0.02f * fabsf(e) + 0.003f)) atomicAdd(cnt + 8, 1u);
        }
    }
    {
        const int seq = (int)(hsh % 40u); const int set = seq < NBP ? 0 : 1; const int L = set ? LS : LP; const int Lg = set ? LGS : LGP; const int NB = set ? NBS : NBP;
        const int b = set ? seq - NBP : seq; const int row0 = set ? TPR + b * LS : b * LP;
        hsh = hsh * 3266489917u + 668265263u; hsh ^= hsh >> 16;
        const int pos = (int)(hsh % (unsigned)L); const int which = (int)((hsh >> 16) % 3u); const int c = (int)((hsh >> 20) % 512u);
        const bf16_t* P = (const bf16_t*)(ws + OFF_P); const float* cw = p.in[9]; const int col = 448 + which * 512 + c;
        const float um = pos > 0 ? bf2f(P[(size_t)(row0 + pos - 1) * NPP + col]) : 0.f, u0 = bf2f(P[(size_t)(row0 + pos) * NPP + col]), up = pos + 1 < L ? bf2f(P[(size_t)(row0 + pos + 1) * NPP + col]) : 0.f;
        const float e = um * cw[which * 512 + c] + u0 * cw[1536 + which * 512 + c] + up * cw[3072 + which * 512 + c];
        const bf16_t* XT = (const bf16_t*)(ws + (which == 0 ? OFF_X1T : (which == 1 ? OFF_X2T : OFF_V0T))) + (set ? XT_SET1 : 0) + ((size_t)c * NB + b) * Lg;
        const float st = bf2f(XT[pos + 48]);
        if (!(fabsf(st - e) <= 0.02f * fabsf(e) + 0.02f)) atomicAdd(cnt + 9, 1u);
    }
}
#endif
#ifndef SUB_MASK
#define SUB_MASK 15
#endif
#ifndef PHASE_MASK
#define PHASE_MASK 1023
#endif
__global__ void __launch_bounds__(512) hymba_fwd(Params p) {
    extern __shared__ __attribute__((aligned(16))) unsigned char lds_raw[];
    LAS unsigned char* lds = (LAS unsigned char*)lds_raw;
    cg::grid_group grid = cg::this_grid();
#define GSYNC() do { asm volatile("s_waitcnt vmcnt(0) lgkmcnt(0)" ::: "memory"); grid.sync(); } while (0)
    const int G = gridDim.x;
    __builtin_amdgcn_fence(__ATOMIC_SEQ_CST, "agent");
    asm volatile("buffer_inv sc1\n\ts_waitcnt vmcnt(0)" ::: "memory");
#if DEBUG_CHECK == 10
    check_x(p, 0);
#endif
#if PHASE_MASK & 1
    p0_prologue(p, lds);
#endif
    GSYNC();
#if DEBUG_CHECK == 3
    check_h0b(p, 8);
#endif
#if DEBUG_CHECK == 7
    check_h0b_full(p, 8);
#endif
#if DEBUG_CHECK == 4
    check_stale(p, (const unsigned*)(launder(p.ws) + OFF_H0B), (unsigned)((size_t)T * 512), 9);
#endif
#if PHASE_MASK & 2
    {
        unsigned char* ws = launder(p.ws); unsigned char* ob = launder((unsigned char*)p.out);
        pg8::Gemm g{(const bf16_t*)(ws + OFF_H0B), (const bf16_t*)(ws + OFF_WIN), TPAD, 2048, 1024, 1024, 1024};
        pg8::StaticOrder S; S.init(TPAD, 2048, G, blockIdx.x);
        Epi<0> E{(bf16_t*)(ws + OFF_P), NPP, (const float*)(ws + OFF_R0), (float*)(ws + OFF_SQQP), (float*)(ws + OFF_SQKVP), (bf16_t*)(ob + DO_KR), (const float2*)(ws + OFF_RT)};
        pg8::gemm_phase(lds, g, S, E);
    }
#endif
    GSYNC();
#if DEBUG_CHECK == 1
    { unsigned char* ws = launder(p.ws); check_gemm((const bf16_t*)(ws + OFF_H0B), 1024, (const bf16_t*)(ws + OFF_WIN), 1024, 1024, T, 1984, 0, (const bf16_t*)(ws + OFF_P), NPP, (const float*)(ws + OFF_R0), (unsigned*)(ws + OFF_DBG) + 0, 448); }
    GSYNC();
#endif
#if DEBUG_CHECK == 3
    check_h0b(p, 9);
#endif
#if DEBUG_CHECK == 8
    check_p_golden(p);
#endif
#if DEBUG_CHECK == 9
    check_win_r0(p);
#endif
#if DEBUG_CHECK == 7
    check_h0b_full(p, 9);
    GSYNC();
#endif
#if DEBUG_CHECK == 6
    { unsigned char* ws = launder(p.ws);
      check_gemm((const bf16_t*)(ws + OFF_H0B), 1024, (const bf16_t*)(ws + OFF_WIN), 1024, 1024, T, 448, 0, (const bf16_t*)(ws + OFF_P), NPP, (const float*)(ws + OFF_R0), (unsigned*)(ws + OFF_DBG) + 8, 384);
      check_gemm((const bf16_t*)(ws + OFF_H0B), 1024, (const bf16_t*)(ws + OFF_WIN), 1024, 1024, T, 384, 7, (const bf16_t*)(ws + OFF_P), NPP, (const float*)(ws + OFF_R0), (unsigned*)(ws + OFF_DBG) + 9, 0); }
    GSYNC();
#endif
#if DEBUG_CHECK == 4
    check_stale(p, (const unsigned*)(launder(p.ws) + OFF_P), (unsigned)((size_t)T * 1024), 8);
#endif
    rownorm_phase(p);
    krope_phase(p);
    GSYNC();
#if (PHASE_MASK & 4) && (SUB2 & 1)
    {
        unsigned char* ws = launder(p.ws); unsigned char* ob = launder((unsigned char*)p.out);
        pg8::Gemm g{(const bf16_t*)(ws + OFF_P), (const bf16_t*)(ws + OFF_WUQ), TPAD, 768, 256, NPP, 256};
        pg8::StaticOrder S; S.init(TPAD, 768, G, blockIdx.x);
        Epi<1> E{(bf16_t*)(ob + DO_Q), 768, (const float*)(ws + OFF_RQ), nullptr, nullptr, nullptr, (const float2*)(ws + OFF_RT)};
        pg8::gemm_phase(lds, g, S, E);
    }
#endif
#if (PHASE_MASK & 4) && (SUB2 & 2)
    {
        unsigned char* ws = launder(p.ws); unsigned char* ob = launder((unsigned char*)p.out);
        pg8::Gemm g{(const bf16_t*)(ws + OFF_P) + 256, (const bf16_t*)(ws + OFF_WKN), TPAD, 512, 128, NPP, 128};
        pg8::StaticOrder S; S.init(TPAD, 512, G, blockIdx.x);
        Epi<2> E{(bf16_t*)(ob + DO_KN), 512, (const float*)(ws + OFF_RKV), nullptr, nullptr, nullptr, nullptr};
        pg8::gemm_phase(lds, g, S, E);
    }
#endif
#if (PHASE_MASK & 4) && (SUB2 & 4)
    {
        unsigned char* ws = launder(p.ws); unsigned char* ob = launder((unsigned char*)p.out);
        pg8::Gemm g{(const bf16_t*)(ws + OFF_WV), (const bf16_t*)(ws + OFF_P) + 256, 512, TPAD, 128, 128, NPP};
        pg8::StaticOrder S; S.init(512, TPAD, G, blockIdx.x);
        Epi<3> E{(bf16_t*)(ob + DO_VT), TPAD, (const float*)(ws + OFF_RKV), nullptr, nullptr, nullptr, nullptr};
        pg8::gemm_phase(lds, g, S, E);
    }
#endif
#if PHASE_MASK & 8
    hyprep_phase(p, lds);
#endif
    GSYNC();
#if DEBUG_CHECK == 2
    check_proj(p);
    GSYNC();
#endif
#if DEBUG_CHECK == 11
    check_filt_prep(p);
    GSYNC();
#endif
#if PHASE_MASK & 16
    attn_phase(p, lds);
#endif
#if PHASE_MASK & 32
    hyena_phase(p, lds);
#endif
    GSYNC();
#if DEBUG_CHECK == 5
    check_attn(p);
    check_hyena(p, lds);
    GSYNC();
#endif
#if PHASE_MASK & 64
    mixnorm_phase(p, lds);
#endif
    GSYNC();
#if PHASE_MASK & 128
    {
        unsigned char* ws = launder(p.ws);
        pg8::Gemm g{(const bf16_t*)(ws + OFF_MIXN), (const bf16_t*)(ws + OFF_WO), TN, 1024, 1024, 1024, 1024};
        pg8::StaticOrder S; S.init(TN, 1024, G, blockIdx.x);
        Epi<4> E{(bf16_t*)(ws + OFF_MIX), 1024, nullptr, (float*)(ws + OFF_SQMIXP), nullptr, nullptr, nullptr};
        pg8::gemm_phase(lds, g, S, E);
    }
#endif
    GSYNC();
#if DEBUG_CHECK == 1
    { unsigned char* ws = launder(p.ws); check_gemm((const bf16_t*)(ws + OFF_MIXN), 1024, (const bf16_t*)(ws + OFF_WO), 1024, 1024, TN, 1024, 4, (const bf16_t*)(ws + OFF_MIX), 1024, nullptr, (unsigned*)(ws + OFF_DBG) + 1, 0); }
#endif
#if DEBUG_CHECK == 10
    check_x(p, 1);
#endif
#if PHASE_MASK & 256
    h1_phase(p);
#endif
    GSYNC();
#if PHASE_MASK & 512
#if DEBUG_CHECK == 1
#define DBG_FF1(half) if ((half) == 0) { unsigned char* ws = launder(p.ws); check_gemm((const bf16_t*)(ws + OFF_H1B), 1024, (const bf16_t*)(ws + OFF_WF1), 1024, 1024, 65536, 4096, 5, (const bf16_t*)(ws + OFF_M), 4096, (const float*)(ws + OFF_R1), (unsigned*)(ws + OFF_DBG) + 2, 0); }
#define DBG_FF2(half) if ((half) == 0) { unsigned char* ws = launder(p.ws); check_gemm((const bf16_t*)(ws + OFF_M), 4096, (const bf16_t*)(ws + OFF_WF2), 4096, 4096, 65536, 1024, 6, (const bf16_t*)(ws + OFF_M2), 1024, nullptr, (unsigned*)(ws + OFF_DBG) + 3, 0); } GSYNC();
#else
#define DBG_FF1(half)
#define DBG_FF2(half)
#endif
#define FFN_HALF(half) \
    { \
        unsigned char* ws = launder(p.ws); \
        pg8::Gemm g{(const bf16_t*)(ws + OFF_H1B) + (size_t)(half) * 65536 * 1024, (const bf16_t*)(ws + OFF_WF1), 65536, 4096, 1024, 1024, 1024}; \
        pg8::StaticOrder S; S.init(65536, 4096, G, blockIdx.x); \
        Epi<5> E{(bf16_t*)(ws + OFF_M), 4096, (const float*)(ws + OFF_R1) + (half) * 65536, nullptr, nullptr, nullptr, nullptr}; \
        pg8::gemm_phase(lds, g, S, E); \
    } \
    GSYNC(); \
    DBG_FF1(half) \
    { \
        unsigned char* ws = launder(p.ws); \
        pg8::Gemm g{(const bf16_t*)(ws + OFF_M), (const bf16_t*)(ws + OFF_WF2), 65536, 1024, 4096, 4096, 4096}; \
        pg8::StaticOrder S; S.init(65536, 1024, G, blockIdx.x); \
        Epi<6> E{(bf16_t*)(ws + OFF_M2), 1024, nullptr, (float*)(ws + OFF_SQM2P) + (size_t)(half) * 65536 * 16, nullptr, nullptr, nullptr}; \
        pg8::gemm_phase(lds, g, S, E); \
    } \
    GSYNC(); \
    DBG_FF2(half) \
    final_phase(p, half);
    FFN_HALF(0)
    FFN_HALF(1)
#undef FFN_HALF
#endif
}

extern "C" void kernel_launch(void* const* d_in, const int* in_sizes, int n_in, void* d_out, int out_size, void* d_ws, size_t ws_size, hipStream_t stream) {
    static int grid = 0;
    if (grid == 0) {
        int dev = 0, cus = 0, per_cu = 0;
        hipGetDevice(&dev);
        hipDeviceGetAttribute(&cus, hipDeviceAttributeMultiprocessorCount, dev);
        hipFuncSetAttribute((const void*)hymba_fwd, hipFuncAttributeMaxDynamicSharedMemorySize, LDS_BYTES);
        hipOccupancyMaxActiveBlocksPerMultiprocessor(&per_cu, (const void*)hymba_fwd, 512, LDS_BYTES);
        if (per_cu < 1) per_cu = 1;
        grid = cus * 1;
        if (n_in != 26 || ws_size < 1024 * MiB) fprintf(stderr, "kernel_launch: unexpected n_in %d / ws_size %zu\n", n_in, ws_size);
    }
    Params p{};
    for (int i = 0; i < 26; ++i) p.in[i] = (const float*)d_in[i];
    p.out = (float*)d_out; p.ws = (unsigned char*)d_ws;
    void* args[] = {&p};
    hipError_t e = hipLaunchCooperativeKernel((const void*)hymba_fwd, dim3(grid), dim3(512), args, LDS_BYTES, stream);
    if (e != hipSuccess) fprintf(stderr, "cooperative launch failed: %s (grid %d)\n", hipGetErrorString(e), grid);
}
```

```cpp
#include <hip/hip_runtime.h>
#include <hip/hip_cooperative_groups.h>
#include <cstdio>
#include <cstdint>
namespace cg = cooperative_groups;
#ifndef DBG_SEL0
#define DBG_SEL0 3
#endif
#ifndef DBG_SEL1
#define DBG_SEL1 0
#endif
#ifndef DEBUG_CHECK
#define DEBUG_CHECK 0
#endif
#ifndef EXPT
#define EXPT 0
#endif
#ifndef SUB_MASK
#define SUB_MASK 15
#endif
#ifndef SUB2
#define SUB2 7
#endif

#define LAS __attribute__((address_space(3)))
#define GAS __attribute__((address_space(1)))
typedef unsigned short bf16_t;
typedef short bf16x8 __attribute__((ext_vector_type(8)));
typedef float f32x4 __attribute__((ext_vector_type(4)));
typedef float f32x16 __attribute__((ext_vector_type(16)));
typedef unsigned u32x4 __attribute__((ext_vector_type(4)));
typedef unsigned u32x2 __attribute__((ext_vector_type(2)));

constexpr int DM = 1024, LP = 8208, LS = 2064, NBP = 8, NBS = 32;
constexpr int TPR = NBP * LP;
constexpr int TSR = NBS * LS;
constexpr int T = TPR + TSR;
constexpr int TPAD = 131840;
constexpr int TN = 131072;
constexpr int NPP = 2048;
constexpr int LGP = 8256, LGS = 2112;
constexpr float EPS = 1e-6f;
constexpr float QSCALE = 0.07216878364870322f * 1.4426950408889634f;

constexpr size_t MiB = 1ull << 20;
constexpr size_t OFF_H0B = 0;
constexpr size_t XT_SET1 = (size_t)512 * NBP * LGP;
constexpr size_t OFF_X1T = 0;
constexpr size_t OFF_X2T = 131 * MiB;
constexpr size_t OFF_P = 262 * MiB;
constexpr size_t OFF_V0T = 778 * MiB;
constexpr size_t OFF_MIXN = 262 * MiB;
constexpr size_t OFF_MIX = 518 * MiB;
constexpr size_t OFF_H1B = 0;
constexpr size_t OFF_M = 256 * MiB;
constexpr size_t OFF_M2 = 768 * MiB;
constexpr size_t OFF_SQMIXP = 896 * MiB;
constexpr size_t OFF_SQM2P = 904 * MiB;
constexpr size_t OFF_SMALL = 912 * MiB;
constexpr size_t OFF_WIN = OFF_SMALL;
constexpr size_t OFF_WUQ = OFF_SMALL + 4 * MiB;
constexpr size_t OFF_WKN = OFF_SMALL + 4 * MiB + 512 * 1024;
constexpr size_t OFF_WV = OFF_SMALL + 4 * MiB + 768 * 1024;
constexpr size_t OFF_WO = OFF_SMALL + 5 * MiB;
constexpr size_t OFF_WF1 = OFF_SMALL + 7 * MiB;
constexpr size_t OFF_WF2 = OFF_SMALL + 15 * MiB;
constexpr size_t OFF_GR0 = OFF_SMALL + 23 * MiB;
constexpr size_t OFF_GR1 = OFF_SMALL + 56 * MiB;
constexpr size_t OFF_RT = OFF_SMALL + 65 * MiB;
constexpr size_t OFF_R0 = OFF_SMALL + 68 * MiB;
constexpr size_t OFF_R1 = OFF_SMALL + 69 * MiB;
constexpr size_t OFF_RQ = OFF_SMALL + 70 * MiB;
constexpr size_t OFF_RKV = OFF_SMALL + 71 * MiB;
constexpr size_t OFF_SQQP = OFF_SMALL + 72 * MiB;
constexpr size_t OFF_SQKVP = OFF_SMALL + 75 * MiB;
constexpr size_t OFF_DBGW = OFF_SMALL + 78 * MiB;
constexpr size_t DO_Q = 0;
constexpr size_t DO_KN = 194 * MiB;
constexpr size_t DO_KR = 323 * MiB;
constexpr size_t DO_VT = 340 * MiB;

constexpr size_t OFF_ODBG = 518 * MiB;
constexpr size_t OFF_HDBG = 647 * MiB;
constexpr int LDS_BYTES = 147456;

struct Params {
    const float* in[26];
    float* out;
    unsigned char* ws;
};

__device__ __forceinline__ f32x4 ld_sys(const float* q) { f32x4 v; asm volatile("global_load_dwordx4 %0, %1, off sc0 sc1\n\ts_waitcnt vmcnt(0)" : "=v"(v) : "v"(q) : "memory"); return v; }
__device__ __forceinline__ float ldco(const float* q) { return __builtin_bit_cast(float, __hip_atomic_load((const unsigned*)q, __ATOMIC_RELAXED, __HIP_MEMORY_SCOPE_AGENT)); }
__device__ __forceinline__ float2 ldco2(const float2* q) { const unsigned long long w = __hip_atomic_load((const unsigned long long*)q, __ATOMIC_RELAXED, __HIP_MEMORY_SCOPE_AGENT); return make_float2(__builtin_bit_cast(float, (unsigned)w), __builtin_bit_cast(float, (unsigned)(w >> 32))); }
template <class Tp> __device__ __forceinline__ Tp* launder(Tp* q) { asm volatile("" : "+s"(q)); return q; }
__device__ __forceinline__ int tid_l() { int t = threadIdx.x; asm volatile("" : "+v"(t)); return t; }
__device__ __forceinline__ unsigned cvt_pk_bf16(float lo, float hi) { unsigned r; asm volatile("v_cvt_pk_bf16_f32 %0, %1, %2" : "=v"(r) : "v"(lo), "v"(hi)); return r; }
__device__ __forceinline__ float bf2f(unsigned short b) { return __builtin_bit_cast(float, (unsigned)b << 16); }
__device__ __forceinline__ float bflo(unsigned w) { return __builtin_bit_cast(float, w << 16); }
__device__ __forceinline__ float bfhi(unsigned w) { return __builtin_bit_cast(float, w & 0xffff0000u); }
__device__ __forceinline__ float wave_sum(float v) {
#pragma unroll
    for (int o = 1; o < 64; o <<= 1) v += __shfl_xor(v, o);
    return v;
}
__device__ __forceinline__ void sincos_red(float x, float& s, float& c) {
    const double xd = (double)x; const double k = rint(xd * 0.15915494309189535); const float r = (float)(xd - k * 6.283185307179586);
    s = __sinf(r); c = __cosf(r);
}
__device__ __forceinline__ float sin_red(float x) { float s, c; sincos_red(x, s, c); return s; }
__device__ __forceinline__ void row_info(int r, int& pos, int& seq) {
    if (r < TPR) { seq = r / LP; pos = r - seq * LP; }
    else { int q = r - TPR; if (q >= TSR) q = TSR - 1; const int b = q / LS; pos = q - b * LS; seq = NBP + b; }
}
__device__ __forceinline__ int full_row(int n) {
    if (n < 65536) { const int b = n >> 13; return b * LP + 16 + (n & 8191); }
    const int q = n - 65536; const int b = q >> 11; return TPR + b * LS + 16 + (q & 2047);
}

namespace pg8 {
constexpr int BM = 256, BK = 64, HALF = 128, HTB = HALF * BK * 2, STAGE_BYTES = 8 * HTB, NXCD = 8, WGM = 8;
__host__ __device__ __forceinline__ int lds_byte(int r, int c) { const int st = (r >> 4) * 2 + (c >> 5), rr = r & 15, cc = c & 31, ob = rr * 64 + cc * 2; return st * 1024 + (ob ^ (((ob >> 9) & 1) << 5)); }
__host__ __device__ __forceinline__ void stage_rc(int b, int& R, int& C) { const int st = b / 1024, sb = b % 1024, swz = sb ^ (((sb >> 9) & 1) << 5); R = (st >> 1) * 16 + swz / 64; C = (st & 1) * 32 + (swz % 64) / 2; }
__host__ __device__ __forceinline__ int perm32(int rho) { const int n = rho >> 4, i = rho & 15; return 8 * (i >> 2) + 4 * n + (i & 3); }
struct Unit { int pm, pn; };
struct Gemm { const bf16_t* A; const bf16_t* Bt; int M, N, K, lda, ldb; };
struct StaticOrder {
    int nM, nN, nwg, G, c;
    __device__ void init(int M, int N, int G_, int c_) { nM = M / BM; nN = N / BM; nwg = nM * nN; G = G_; c = c_; }
    __device__ bool next(int i, Unit& u) const {
        const long L = (long)i * G + c; if (L >= nwg) return false;
        int wgid = (int)L; { const int q = nwg / NXCD, r = nwg % NXCD, xcd = wgid % NXCD, off = wgid / NXCD; wgid = (xcd < r ? xcd * (q + 1) : r * (q + 1) + (xcd - r) * q) + off; }
        const int nig = WGM * nN, gid = wgid / nig, fm = gid * WGM, gsz = (nM - fm) < WGM ? (nM - fm) : WGM;
        u.pm = fm + ((wgid % nig) % gsz); u.pn = (wgid % nig) / gsz; return true;
    }
};
template <class Epi>
__device__ __forceinline__ void gemm_phase(LAS unsigned char* lds, const Gemm g, const StaticOrder& S, const Epi& E) {
    const int tid = tid_l(), wid = __builtin_amdgcn_readfirstlane(tid >> 6), lane = tid & 63, wr = wid >> 2, wc = wid & 3, fr = lane & 15, fq = lane >> 4;
    const int K = g.K, nt = K / BK;
    unsigned voffA[2], voffB[2];
#pragma unroll
    for (int i = 0; i < 2; ++i) { int R, C; stage_rc(tid * 16 + i * 8192, R, C); const int Rb = (R & ~31) + perm32(R & 31);
        voffA[i] = (unsigned)(R * g.lda + C) * 2u; voffB[i] = (unsigned)(Rb * g.ldb + C) * 2u; }
    const size_t kstep = (size_t)(BK * 2);
    const size_t hstepA = (size_t)HALF * g.lda * 2, hstepB = (size_t)HALF * g.ldb * 2;
    const size_t tstepA = 2 * hstepA, tstepB = 2 * hstepB;
    const unsigned ldsw = (unsigned)wid * 1024u;
    const int aoff = lds_byte(wr * 64 + fr, fq * 8), boff = lds_byte(wc * 32 + fr, fq * 8);
#define PG8_SA(b, h) (((b) * 2 + (h)) * HTB)
#define PG8_SB(b, h) ((4 + (b) * 2 + (h)) * HTB)
#define PG8_STAGE(bufoff, gbase, voff) do { _Pragma("unroll") for (int _i = 0; _i < 2; ++_i) \
        __builtin_amdgcn_global_load_lds((const unsigned*)((const char*)(gbase) + (voff)[_i]), (LAS unsigned*)(lds + (bufoff) + ldsw + _i * 8192), 16, 0, 0); } while (0)
#define PG8_LDA(dst, b, h) do { _Pragma("unroll") for (int m = 0; m < 4; ++m) _Pragma("unroll") for (int k = 0; k < 2; ++k) dst[m][k] = *(const LAS bf16x8*)(lds + PG8_SA(b, h) + aoff + m * 2048 + k * 1024); } while (0)
#define PG8_LDB(dst, b, h) do { _Pragma("unroll") for (int n = 0; n < 2; ++n) _Pragma("unroll") for (int k = 0; k < 2; ++k) dst[n][k] = *(const LAS bf16x8*)(lds + PG8_SB(b, h) + boff + n * 2048 + k * 1024); } while (0)
#define PG8_MMA(ai, bj, At, Bt) do { __builtin_amdgcn_s_setprio(1); _Pragma("unroll") for (int m = 0; m < 4; ++m) _Pragma("unroll") for (int n = 0; n < 2; ++n) _Pragma("unroll") for (int k = 0; k < 2; ++k) \
        acc[ai][bj][m][n] = __builtin_amdgcn_mfma_f32_16x16x32_bf16(Bt[n][k], At[m][k], acc[ai][bj][m][n], 0, 0, 0); __builtin_amdgcn_s_setprio(0); } while (0)
#define PG8_WAIT_V(n) asm volatile("s_waitcnt vmcnt(" #n ")" ::: "memory")
#define PG8_WAIT_L(n) asm volatile("s_waitcnt lgkmcnt(" #n ")" ::: "memory")
#define PG8_BAR __builtin_amdgcn_s_barrier()
#define PG8_SCHED __builtin_amdgcn_sched_barrier(0)
    Unit cur, nxt; int ui = 0;
    if (!S.next(0, cur)) return;
    f32x4 acc[2][2][4][2];
#pragma unroll
    for (int a = 0; a < 2; ++a)
#pragma unroll
        for (int b = 0; b < 2; ++b)
#pragma unroll
            for (int m = 0; m < 4; ++m)
#pragma unroll
                for (int n = 0; n < 2; ++n) acc[a][b][m][n] = (f32x4){0.f, 0.f, 0.f, 0.f};
    bf16x8 At[4][2], B0[2][2], B1[2][2];
    const char* cA = (const char*)g.A + (size_t)cur.pm * tstepA; const char* cB = (const char*)g.Bt + (size_t)cur.pn * tstepB;
    PG8_STAGE(PG8_SB(0, 0), cB, voffB); PG8_STAGE(PG8_SB(0, 1), cB + hstepB, voffB); PG8_STAGE(PG8_SA(0, 0), cA, voffA); PG8_STAGE(PG8_SA(0, 1), cA + hstepA, voffA);
    if (wr == 1) PG8_BAR;
    PG8_WAIT_V(2); PG8_BAR;
    PG8_STAGE(PG8_SB(1, 0), cB + kstep, voffB); PG8_STAGE(PG8_SA(1, 0), cA + kstep, voffA); PG8_STAGE(PG8_SB(1, 1), cB + hstepB + kstep, voffB);
    PG8_WAIT_V(6); PG8_BAR;
    for (;;) {
        const bool has_next = S.next(ui + 1, nxt);
        const char* nA = has_next ? (const char*)g.A + (size_t)nxt.pm * tstepA : cA; const char* nB = has_next ? (const char*)g.Bt + (size_t)nxt.pn * tstepB : cB;
        for (int t = 0; t < nt; t += 2) {
            const bool last = (t == nt - 2);
            const char* a1 = cA + (size_t)(t + 1) * kstep;
            const char* a2 = last ? nA : cA + (size_t)(t + 2) * kstep; const char* b2 = last ? nB : cB + (size_t)(t + 2) * kstep;
            const char* a3 = a2 + kstep; const char* b3 = b2 + kstep;
            PG8_LDB(B0, 0, 0); PG8_LDB(B1, 0, 1); PG8_SCHED; PG8_LDA(At, 0, 0); PG8_STAGE(PG8_SA(1, 1), a1 + hstepA, voffA);
            PG8_WAIT_V(8); PG8_WAIT_L(0); PG8_BAR; PG8_MMA(0, 0, At, B0); PG8_MMA(0, 1, At, B1); PG8_BAR; PG8_SCHED;
            PG8_LDA(At, 0, 1); PG8_STAGE(PG8_SB(0, 0), b2, voffB); PG8_STAGE(PG8_SB(0, 1), b2 + hstepB, voffB); PG8_STAGE(PG8_SA(0, 0), a2, voffA);
            PG8_WAIT_V(8); PG8_WAIT_L(0); PG8_BAR; PG8_MMA(1, 0, At, B0); PG8_MMA(1, 1, At, B1); PG8_BAR; PG8_SCHED;
            PG8_LDB(B0, 1, 0); PG8_LDB(B1, 1, 1); PG8_SCHED; PG8_LDA(At, 1, 0); PG8_STAGE(PG8_SA(0, 1), a2 + hstepA, voffA);
            PG8_WAIT_V(8); PG8_WAIT_L(0); PG8_BAR; PG8_MMA(0, 0, At, B0); PG8_MMA(0, 1, At, B1); PG8_BAR; PG8_SCHED;
            PG8_LDA(At, 1, 1); PG8_STAGE(PG8_SB(1, 0), b3, voffB); PG8_STAGE(PG8_SB(1, 1), b3 + hstepB, voffB); PG8_STAGE(PG8_SA(1, 0), a3, voffA);
            PG8_WAIT_V(8); PG8_WAIT_L(0); PG8_BAR; PG8_MMA(1, 0, At, B0); PG8_MMA(1, 1, At, B1); PG8_BAR; PG8_SCHED;
        }
        if (wr == 0) PG8_BAR;
        E(acc, cur, wr, wc, fr, fq);
        if (!has_next) break;
#pragma unroll
        for (int a = 0; a < 2; ++a)
#pragma unroll
            for (int b = 0; b < 2; ++b)
#pragma unroll
                for (int m = 0; m < 4; ++m)
#pragma unroll
                    for (int n = 0; n < 2; ++n) acc[a][b][m][n] = (f32x4){0.f, 0.f, 0.f, 0.f};
        cur = nxt; cA = nA; cB = nB; ++ui;
        if (wr == 1) PG8_BAR;
    }
    PG8_WAIT_V(0);
    PG8_BAR;
#undef PG8_SA
#undef PG8_SB
#undef PG8_STAGE
#undef PG8_LDA
#undef PG8_LDB
#undef PG8_MMA
#undef PG8_WAIT_V
#undef PG8_WAIT_L
#undef PG8_BAR
#undef PG8_SCHED
}
}

__device__ __forceinline__ void rope8(f32x4& v0, f32x4& v1, const float2* rt  ) {
    const float2 c0 = ldco2(rt), c1 = ldco2(rt + 1), c2 = ldco2(rt + 2), c3 = ldco2(rt + 3);
    float a, b;
    a = v0[0]; b = v0[1]; v0[0] = a * c0.x - b * c0.y; v0[1] = b * c0.x + a * c0.y;
    a = v0[2]; b = v0[3]; v0[2] = a * c1.x - b * c1.y; v0[3] = b * c1.x + a * c1.y;
    a = v1[0]; b = v1[1]; v1[0] = a * c2.x - b * c2.y; v1[1] = b * c2.x + a * c2.y;
    a = v1[2]; b = v1[3]; v1[2] = a * c3.x - b * c3.y; v1[3] = b * c3.x + a * c3.y;
}
__device__ __forceinline__ u32x4 pack8(const f32x4& v0, const f32x4& v1) {
    u32x4 w; w.x = cvt_pk_bf16(v0[0], v0[1]); w.y = cvt_pk_bf16(v0[2], v0[3]); w.z = cvt_pk_bf16(v1[0], v1[1]); w.w = cvt_pk_bf16(v1[2], v1[3]); return w;
}
__device__ __forceinline__ float sq8(const f32x4& a, const f32x4& b) {
    return (a[0] * a[0] + a[1] * a[1]) + (a[2] * a[2] + a[3] * a[3]) + (b[0] * b[0] + b[1] * b[1]) + (b[2] * b[2] + b[3] * b[3]);
}
template <int MODE> struct Epi {
    bf16_t* O; int ldc; const float* rs; float* sq0; float* sq1; bf16_t* KR; const float2* RT;
    __device__ __forceinline__ void operator()(const f32x4 (&acc)[2][2][4][2], const pg8::Unit& u, int wr, int wc, int fr, int fq) const {
#pragma unroll
        for (int ai = 0; ai < 2; ++ai)
#pragma unroll
            for (int m = 0; m < 4; ++m) {
                const int row = u.pm * 256 + ai * 128 + wr * 64 + m * 16 + fr;
                float sc = 1.f;
                if (MODE == 0 || MODE == 1 || MODE == 2 || MODE == 5) sc = ldco(rs + row);
                float ssum[2];
#pragma unroll
                for (int bj = 0; bj < 2; ++bj) {
                    const int col0 = u.pn * 256 + bj * 128 + wc * 32 + 8 * fq;
                    f32x4 v0 = acc[ai][bj][m][0] * sc, v1 = acc[ai][bj][m][1] * sc;
                    if (MODE == 3) {
#pragma unroll
                        for (int j = 0; j < 4; ++j) { v0[j] *= ldco(rs + col0 + j); v1[j] *= ldco(rs + col0 + 4 + j); }
                    }
                    if (MODE == 5) {
#pragma unroll
                        for (int j = 0; j < 4; ++j) { const float a = fmaxf(v0[j], 0.f), b = fmaxf(v1[j], 0.f); v0[j] = a * a; v1[j] = b * b; }
                    }
                    ssum[bj] = sq8(v0, v1);
                    *(u32x4*)(O + (size_t)row * ldc + col0) = pack8(v0, v1);
                }
                if (MODE == 0) {
                    if (u.pn == 0) { float s = ssum[0] + ssum[1]; s += __shfl_xor(s, 16); s += __shfl_xor(s, 32); if (fq == 0) sq0[row * 4 + wc] = s; }
                    else if (u.pn == 1) { float s = ssum[0]; s += __shfl_xor(s, 16); s += __shfl_xor(s, 32); if (fq == 0) sq1[row * 4 + wc] = s; }
                }
                if (MODE == 4 || MODE == 6) { float s = ssum[0] + ssum[1]; s += __shfl_xor(s, 16); s += __shfl_xor(s, 32); if (fq == 0) sq0[(size_t)row * 16 + u.pn * 4 + wc] = s; }
            }
    }
};

__device__ __forceinline__ int src_col(int mode, int n) {
    if (mode == 0) return n;
    if (mode == 1) { if (n >= 1984) return -1; if (n >= 384 && n < 448) { const int j = n - 384; return 384 + ((j & 1) ? 32 + (j >> 1) : (j >> 1)); } return n; }
    if (mode == 2) { const int h = n / 192, w = n % 192; if (w < 128) return n; const int j = w - 128; return h * 192 + 128 + ((j & 1) ? 32 + (j >> 1) : (j >> 1)); }
    if (mode == 3) return (n >> 7) * 256 + (n & 127);
    return (n >> 7) * 256 + 128 + (n & 127);
}
__device__ __forceinline__ void conv_weight(const float* W, const float* g, bf16_t* out, int K, int Nsrc, int Nout, int mode, int gtid, int gthreads) {
    const int nch = Nout * (K / 8);
    for (int e = gtid; e < nch; e += gthreads) {
        const int n = e % Nout, kc = e / Nout, k0 = kc * 8; const int sc = src_col(mode, n);
        float v[8];
#pragma unroll
        for (int j = 0; j < 8; ++j) v[j] = (sc >= 0) ? W[(size_t)(k0 + j) * Nsrc + sc] * (g ? g[k0 + j] : 1.f) : 0.f;
        u32x4 w; w.x = cvt_pk_bf16(v[0], v[1]); w.y = cvt_pk_bf16(v[2], v[3]); w.z = cvt_pk_bf16(v[4], v[5]); w.w = cvt_pk_bf16(v[6], v[7]);
        *(u32x4*)(out + (size_t)n * K + k0) = w;
    }
}

__device__ __forceinline__ void p0_prologue(const Params& p, LAS unsigned char* lds) {
    unsigned char* ws = launder(p.ws);
    const int tid = tid_l(), lane = tid & 63, wave = tid >> 6, G = gridDim.x;
    const int gtid = blockIdx.x * 512 + tid, gthreads = G * 512;
    const int gw = blockIdx.x * 8 + wave, NGW = G * 8;
#if SUB_MASK & 1
    conv_weight(p.in[4], p.in[3], (bf16_t*)(ws + OFF_WIN), 1024, 1984, 2048, 1, gtid, gthreads);
    conv_weight(p.in[6], p.in[5], (bf16_t*)(ws + OFF_WUQ), 256, 768, 768, 2, gtid, gthreads);
    conv_weight(p.in[8], p.in[7], (bf16_t*)(ws + OFF_WKN), 128, 1024, 512, 3, gtid, gthreads);
    conv_weight(p.in[8], p.in[7], (bf16_t*)(ws + OFF_WV), 128, 1024, 512, 4, gtid, gthreads);
    conv_weight(p.in[20], nullptr, (bf16_t*)(ws + OFF_WO), 1024, 1024, 1024, 0, gtid, gthreads);
    conv_weight(p.in[23], p.in[22], (bf16_t*)(ws + OFF_WF1), 1024, 4096, 4096, 0, gtid, gthreads);
    conv_weight(p.in[24], nullptr, (bf16_t*)(ws + OFF_WF2), 4096, 1024, 1024, 0, gtid, gthreads);
#endif
#if SUB_MASK & 2
#if DEBUG_CHECK
    if (blockIdx.x == 0 && tid < 64) ((unsigned*)(ws + OFF_DBGW))[tid] = 0u;
#endif
    {
        float2* RT = (float2*)(ws + OFF_RT);
        for (int e = gtid; e < LP * 32; e += gthreads) {
            const int pos = e >> 5, i = e & 31;
            const float inv = 1.0f / exp2f((float)i * (13.287712379549449f / 32.f));
            float s, c; sincos_red((float)pos * inv, s, c);
            RT[e] = make_float2(c, s);
        }
    }
#endif
#if SUB_MASK & 4
    {
        bf16_t* h0b = (bf16_t*)(ws + OFF_H0B); float* r0 = (float*)(ws + OFF_R0);
        for (int r = gw; r < TPAD; r += NGW) {
            u32x2* o = (u32x2*)(h0b + (size_t)r * 1024) + lane;
            if (r >= T) {
#pragma unroll
                for (int j = 0; j < 4; ++j) o[64 * j] = (u32x2){0u, 0u};
                if (lane == 0) __hip_atomic_store(r0 + r, 0.f, __ATOMIC_RELAXED, __HIP_MEMORY_SCOPE_AGENT);
                continue;
            }
            int pos, seq; row_info(r, pos, seq);
            const float* src = pos < 16 ? p.in[2] + (size_t)pos * 1024
                                        : (seq < NBP ? p.in[0] + ((size_t)seq * 8192 + (pos - 16)) * 1024 : p.in[1] + ((size_t)(seq - NBP) * 2048 + (pos - 16)) * 1024);
            const f32x4* xr = (const f32x4*)src + lane;
            f32x4 v[4]; float ss = 0.f;
#pragma unroll
            for (int j = 0; j < 4; ++j) { v[j] = xr[64 * j]; ss += (v[j][0] * v[j][0] + v[j][1] * v[j][1]) + (v[j][2] * v[j][2] + v[j][3] * v[j][3]); }
            ss = wave_sum(ss);
#pragma unroll
            for (int j = 0; j < 4; ++j) o[64 * j] = (u32x2){cvt_pk_bf16(v[j][0], v[j][1]), cvt_pk_bf16(v[j][2], v[j][3])};
            if (lane == 0) __hip_atomic_store(r0 + r, rsqrtf(ss * (1.f / 1024.f) + EPS), __ATOMIC_RELAXED, __HIP_MEMORY_SCOPE_AGENT);
        }
    }
#endif
#if SUB_MASK & 8
    {
        const float* f_w1 = p.in[10]; const float* f_b1 = p.in[11]; const float* f_freq = p.in[12]; const float* f_w2 = p.in[13];
        const float* f_b2 = p.in[14]; const float* f_w3 = p.in[15]; const float* f_decay = p.in[16];
        LAS float* feats = (LAS float*)lds;
        LAS float* h1 = feats + 16 * 34;
        LAS float* h2 = h1 + 16 * 64;
        for (int u = blockIdx.x; u < 513 + 129; u += G) {
            const int set = u < 513 ? 0 : 1; const int t0 = 16 * (set ? u - 513 : u); const int L = set ? LS : LP; const int C0 = set ? LGS : LGP;
            bf16_t* GR = (bf16_t*)(ws + (set ? OFF_GR1 : OFF_GR0));
            const float invLm1 = 1.0f / (float)(L - 1);
            if (tid < 256) {
                const int tt = tid >> 4, k = tid & 15; const int t = t0 + tt;
                const float w = (6.2831853071795865f * (float)t) / (float)L;
                const float f = 1e-4f + (float)k * ((15.0f - 1e-4f) / 15.0f);
                float s, c; sincos_red(f * w, s, c);
                feats[tt * 34 + 1 + k] = c; feats[tt * 34 + 17 + k] = -s;
                if (k == 0) feats[tt * 34] = (float)t * invLm1;
            }
            __syncthreads();
#pragma unroll 1
            for (int q = 0; q < 2; ++q) {
                const int o = tid + 512 * q, tt = o >> 6, j = o & 63;
                float a = f_b1[j];
#pragma unroll 3
                for (int e = 0; e < 33; ++e) a += feats[tt * 34 + e] * f_w1[e * 64 + j];
                h1[tt * 64 + j] = sin_red(f_freq[j] * a);
            }
            __syncthreads();
#pragma unroll 1
            for (int q = 0; q < 2; ++q) {
                const int o = tid + 512 * q, tt = o >> 6, j = o & 63;
                float a = f_b2[j];
#pragma unroll 4
                for (int e = 0; e < 64; ++e) a += h1[tt * 64 + e] * f_w2[e * 64 + j];
                h2[tt * 64 + j] = sin_red(f_freq[j] * a);
            }
            __syncthreads();
#pragma unroll 1
            for (int q = 0; q < 4; ++q) {
                const int n = tid + 512 * q;
                float a[16];
#pragma unroll
                for (int i = 0; i < 16; ++i) a[i] = 0.f;
#pragma unroll 2
                for (int j = 0; j < 64; ++j) {
                    const float w = f_w3[j * 2048 + n];
#pragma unroll
                    for (int i = 0; i < 16; ++i) a[i] += h2[i * 64 + j] * w;
                }
                const float dec = fabsf(f_decay[n]);
                const int order = n >> 10, dir = (n >> 9) & 1, c = n & 511;
                bf16_t* row = GR + (size_t)(order * 512 + c) * (2 * C0);
#pragma unroll
                for (int i = 0; i < 16; ++i) {
                    const int t = t0 + i;
                    const float val = a[i] * __expf(-((float)t * invLm1) * dec);
                    const unsigned short b = (unsigned short)(cvt_pk_bf16(val, 0.f) & 0xffffu);
                    if (dir == 0) row[C0 - t] = b; else if (t > 0) row[C0 + t] = b;
                }
            }
            __syncthreads();
        }
        for (int e = gtid; e < 2 * 1024 * 97; e += gthreads) {
            const int set = e / (1024 * 97), r = (e / 97) % 1024, i = e % 97; const int L = set ? LS : LP; const int C0 = set ? LGS : LGP;
            bf16_t* row = (bf16_t*)(ws + (set ? OFF_GR1 : OFF_GR0)) + (size_t)r * (2 * C0);
            const int idx = i < 49 ? i : C0 + L + (i - 49);
            row[idx] = 0;
        }
    }
#endif
}

__device__ __forceinline__ void rownorm_phase(const Params& p) {
    unsigned char* ws = launder(p.ws); const int gtid = blockIdx.x * 512 + tid_l(), gthreads = gridDim.x * 512;
    const float* sqq = (const float*)(ws + OFF_SQQP); const float* sqkv = (const float*)(ws + OFF_SQKVP);
    float* rq = (float*)(ws + OFF_RQ); float* rkv = (float*)(ws + OFF_RKV);
    for (int r = gtid; r < TPAD; r += gthreads) {
        const float a = (ldco(sqq + r * 4) + ldco(sqq + r * 4 + 1)) + (ldco(sqq + r * 4 + 2) + ldco(sqq + r * 4 + 3));
        const float b = (ldco(sqkv + r * 4) + ldco(sqkv + r * 4 + 1)) + (ldco(sqkv + r * 4 + 2) + ldco(sqkv + r * 4 + 3));
        rq[r] = rsqrtf(a * (1.f / 256.f) + EPS) * QSCALE; rkv[r] = rsqrtf(b * (1.f / 128.f) + EPS);
    }
}
__device__ __forceinline__ void krope_phase(const Params& p) {
    unsigned char* ws = launder(p.ws); unsigned char* ob = launder((unsigned char*)p.out);
    const int gtid = blockIdx.x * 512 + tid_l(), gthreads = gridDim.x * 512;
    const bf16_t* P = (const bf16_t*)(ws + OFF_P); bf16_t* KR = (bf16_t*)(ob + DO_KR); const float2* RT = (const float2*)(ws + OFF_RT);
    for (int e = gtid; e < TPAD * 8; e += gthreads) {
        const int row = e >> 3, ch = e & 7;
        int pos, seq; row_info(row, pos, seq);
        const u32x4 v = *(const u32x4*)(P + (size_t)row * NPP + 384 + ch * 8);
        f32x4 v0 = (f32x4){bflo(v.x), bfhi(v.x), bflo(v.y), bfhi(v.y)}, v1 = (f32x4){bflo(v.z), bfhi(v.z), bflo(v.w), bfhi(v.w)};
        rope8(v0, v1, RT + pos * 32 + ch * 4);
        *(u32x4*)(KR + (size_t)row * 64 + ch * 8) = pack8(v0, v1);
    }
}
__device__ __forceinline__ void hyprep_phase(const Params& p, LAS unsigned char* lds) {
    unsigned char* ws = launder(p.ws); const int tid = tid_l(), G = gridDim.x;
    const bf16_t* P = (const bf16_t*)(ws + OFF_P); const float* conv_w = p.in[9];
    constexpr int RSB = 1040;
    for (int u = blockIdx.x; u < 3096 + 3168; u += G) {
        int seq, j, which;
        if (u < 3096) { seq = u / 387; const int rem = u % 387; j = rem / 3; which = rem % 3; }
        else { const int v = u - 3096; seq = NBP + v / 99; const int rem = v % 99; j = rem / 3; which = rem % 3; }
        const int set = seq < NBP ? 0 : 1; const int L = set ? LS : LP; const int Lg = set ? LGS : LGP; const int NB = set ? NBS : NBP;
        const int b = set ? seq - NBP : seq; const int row0 = set ? TPR + b * LS : b * LP;
        const int posb = 64 * j - 49;
        for (int i = 0; i < 9; ++i) {
            const int id = tid + 512 * i; if (id >= 66 * 64) break;
            const int rr = id >> 6, ch = id & 63; const int pos = posb + rr;
            u32x4 v = (u32x4){0u, 0u, 0u, 0u};
            if (pos >= 0 && pos < L) v = *(const GAS u32x4*)(P + (size_t)(row0 + pos) * NPP + 448 + which * 512 + ch * 8);
            *(LAS u32x4*)(lds + rr * RSB + ch * 16) = v;
        }
        __syncthreads();
        {
            const int c = tid; const float w0 = conv_w[which * 512 + c], w1 = conv_w[1536 + which * 512 + c], w2 = conv_w[3072 + which * 512 + c];
            bf16_t* XT = (bf16_t*)(ws + (which == 0 ? OFF_X1T : (which == 1 ? OFF_X2T : OFF_V0T))) + (set ? XT_SET1 : 0) + ((size_t)c * NB + b) * Lg + 64 * j;
            const LAS unsigned short* tl = (const LAS unsigned short*)lds + c;
            float prev = bf2f(tl[0]), cur = bf2f(tl[RSB / 2]);
            for (int o8 = 0; o8 < 8; ++o8) {
                float r[8];
#pragma unroll
                for (int k = 0; k < 8; ++k) {
                    const int o = o8 * 8 + k; const float nxt = bf2f(tl[(o + 2) * (RSB / 2)]);
                    const int pos = posb + 1 + o;
                    r[k] = (pos >= 0 && pos < L) ? (prev * w0 + cur * w1 + nxt * w2) : 0.f;
                    prev = cur; cur = nxt;
                }
                u32x4 w; w.x = cvt_pk_bf16(r[0], r[1]); w.y = cvt_pk_bf16(r[2], r[3]); w.z = cvt_pk_bf16(r[4], r[5]); w.w = cvt_pk_bf16(r[6], r[7]);
                *(GAS u32x4*)(XT + o8 * 8) = w;
            }
        }
        __syncthreads();
    }
}

__device__ __forceinline__ f32x16 mfma32(bf16x8 a, bf16x8 b, f32x16 c) { return __builtin_amdgcn_mfma_f32_32x32x16_bf16(a, b, c, 0, 0, 0); }

__device__ __forceinline__ void attn_phase(const Params& p, LAS unsigned char* lds) {
    const int tid = tid_l(), lane = tid & 63, wave = tid >> 6, G = gridDim.x, h = lane >> 5, l32 = lane & 31;
    unsigned char* ob = launder((unsigned char*)p.out);
    bf16_t* Q = (bf16_t*)(ob + DO_Q);
    const bf16_t* KN = (const bf16_t*)(ob + DO_KN);
    const bf16_t* KR = (const bf16_t*)(ob + DO_KR);
    const bf16_t* VT = (const bf16_t*)(ob + DO_VT);
    constexpr int KROW = 400, VROW = 136, KBYTES = 64 * KROW, BUFB = KBYTES + 128 * VROW;
    for (int u = blockIdx.x; u < 2048; u += G) {
        int seq, head, qb;
        if (u < 1024) { seq = u >> 7; head = (u >> 5) & 3; qb = u & 31; } else { const int v = u - 1024; seq = NBP + (v >> 5); head = (v >> 3) & 3; qb = v & 7; }
        const int L = seq < NBP ? LP : LS; const int row0 = seq < NBP ? seq * LP : TPR + (seq - NBP) * LS;
        const int ntiles = (L + 63) >> 6;
        const int qrow = row0 + 16 + qb * 256 + wave * 32 + l32;
        bf16x8 qf[12];
#pragma unroll
        for (int ks = 0; ks < 12; ++ks) qf[ks] = *(const GAS bf16x8*)(Q + (size_t)qrow * 768 + head * 192 + 16 * ks + 8 * h);
        {
            const float2* RT = (const float2*)(launder(p.ws) + OFF_RT);
            const int qpos = 16 + qb * 256 + wave * 32 + l32;
#pragma unroll
            for (int ks = 8; ks < 12; ++ks) {
                const u32x4 v = __builtin_bit_cast(u32x4, qf[ks]);
                f32x4 v0 = (f32x4){bflo(v.x), bfhi(v.x), bflo(v.y), bfhi(v.y)}, v1 = (f32x4){bflo(v.z), bfhi(v.z), bflo(v.w), bfhi(v.w)};
                rope8(v0, v1, RT + qpos * 32 + 8 * (ks - 8) + 4 * h);
                qf[ks] = __builtin_bit_cast(bf16x8, pack8(v0, v1));
            }
        }
        const int kkey0 = tid >> 4, kch0 = tid & 15;
        const int rkey = tid >> 3, rch = tid & 7;
        const int vdv0 = tid >> 3, vch = tid & 7;
        const unsigned kn_off = (unsigned)(kkey0 * 512 + head * 128 + kch0 * 8) * 2u;
        const unsigned kr_off = (unsigned)(rkey * 64 + rch * 8) * 2u;
        const unsigned vt_off = (unsigned)(vdv0 * TPAD + vch * 8) * 2u;
        const unsigned char* knb = (const unsigned char*)KN + (size_t)row0 * 1024;
        const unsigned char* krb = (const unsigned char*)KR + (size_t)row0 * 128;
        const unsigned char* vtb = (const unsigned char*)VT + ((size_t)head * 128 * TPAD + row0) * 2;
        u32x4 g0, g1, g2, g3, g4;
#define ATT_LOAD(tile) do { const unsigned char* kb__ = knb + (size_t)(tile) * 65536; const unsigned char* rb__ = krb + (size_t)(tile) * 8192; const unsigned char* vb__ = vtb + (size_t)(tile) * 128; \
        g0 = *(const GAS u32x4*)(kb__ + kn_off); g1 = *(const GAS u32x4*)(kb__ + 32768 + kn_off); \
        g2 = *(const GAS u32x4*)(rb__ + kr_off); (void)vb__; } while (0)
#define ATT_LOADV(tile) do { const unsigned char* vb__ = vtb + (size_t)(tile) * 128; g3 = *(const GAS u32x4*)(vb__ + vt_off); g4 = *(const GAS u32x4*)(vb__ + (size_t)64 * TPAD * 2 + vt_off); } while (0)
#define ATT_STOREK(buf) do { LAS unsigned char* kb_ = lds + (buf) * BUFB; \
        *(LAS u32x4*)(kb_ + kkey0 * KROW + kch0 * 16) = g0; *(LAS u32x4*)(kb_ + (kkey0 + 32) * KROW + kch0 * 16) = g1; \
        *(LAS u32x4*)(kb_ + rkey * KROW + 256 + rch * 16) = g2; } while (0)
#define ATT_STORE(buf) do { LAS unsigned char* vb_ = lds + (buf) * BUFB + KBYTES; \
        *(LAS u32x2*)(vb_ + vdv0 * VROW + vch * 16) = (u32x2){g3.x, g3.y}; *(LAS u32x2*)(vb_ + vdv0 * VROW + vch * 16 + 8) = (u32x2){g3.z, g3.w}; \
        *(LAS u32x2*)(vb_ + (vdv0 + 64) * VROW + vch * 16) = (u32x2){g4.x, g4.y}; *(LAS u32x2*)(vb_ + (vdv0 + 64) * VROW + vch * 16 + 8) = (u32x2){g4.z, g4.w}; } while (0)
        ATT_LOAD(0); ATT_LOADV(0); ATT_STOREK(0); ATT_STORE(0);
        __syncthreads();
        f32x16 o[4];
#pragma unroll
        for (int d = 0; d < 4; ++d)
#pragma unroll
            for (int r = 0; r < 16; ++r) o[d][r] = 0.f;
        float m_run = -INFINITY, l_run = 0.f;
        for (int j = 0; j < ntiles; ++j) {
            const int buf = j & 1;
            if (j + 1 < ntiles) ATT_LOAD(j + 1);
            const LAS unsigned char* kb = lds + buf * BUFB;
            f32x16 s0, s1;
#pragma unroll
            for (int r = 0; r < 16; ++r) { s0[r] = 0.f; s1[r] = 0.f; }
#pragma unroll
            for (int ks = 0; ks < 12; ++ks) {
                const bf16x8 a0 = *(const LAS bf16x8*)(kb + l32 * KROW + ks * 32 + h * 16);
                const bf16x8 a1 = *(const LAS bf16x8*)(kb + (l32 + 32) * KROW + ks * 32 + h * 16);
                s0 = mfma32(a0, qf[ks], s0); s1 = mfma32(a1, qf[ks], s1);
                if ((ks % 3) == 2) __builtin_amdgcn_sched_barrier(0);
            }
            if (j + 1 < ntiles) ATT_STOREK(buf ^ 1);
            const int vc = L - j * 64;
            if (vc < 64) {
                const int vch = vc - 4 * h;
#pragma unroll
                for (int r = 0; r < 16; ++r) {
                    if ((r & 3) + 8 * (r >> 2) >= vch) s0[r] = -INFINITY;
                    if ((r & 3) + 8 * (r >> 2) + 32 >= vch) s1[r] = -INFINITY;
                }
            }
            float mx = fmaxf(s0[0], s1[0]);
#pragma unroll
            for (int r = 1; r < 16; ++r) mx = fmaxf(mx, fmaxf(s0[r], s1[r]));
            mx = fmaxf(mx, __shfl_xor(mx, 32));
            const float m_new = fmaxf(m_run, mx);
            const float alpha = __builtin_amdgcn_exp2f(m_run - m_new);
            m_run = m_new;
            float ls = 0.f;
#pragma unroll
            for (int r = 0; r < 16; ++r) { s0[r] = __builtin_amdgcn_exp2f(s0[r] - m_new); s1[r] = __builtin_amdgcn_exp2f(s1[r] - m_new); ls += s0[r] + s1[r]; }
            l_run = l_run * alpha + ls;
            if (__any(alpha != 1.0f)) {
#pragma unroll
                for (int d = 0; d < 4; ++d)
#pragma unroll
                    for (int r = 0; r < 16; ++r) o[d][r] *= alpha;
            }
            bf16x8 pb[4];
            {
                u32x4 w;
                w.x = cvt_pk_bf16(s0[0], s0[1]); w.y = cvt_pk_bf16(s0[2], s0[3]); w.z = cvt_pk_bf16(s0[4], s0[5]); w.w = cvt_pk_bf16(s0[6], s0[7]); pb[0] = __builtin_bit_cast(bf16x8, w);
                w.x = cvt_pk_bf16(s0[8], s0[9]); w.y = cvt_pk_bf16(s0[10], s0[11]); w.z = cvt_pk_bf16(s0[12], s0[13]); w.w = cvt_pk_bf16(s0[14], s0[15]); pb[1] = __builtin_bit_cast(bf16x8, w);
                w.x = cvt_pk_bf16(s1[0], s1[1]); w.y = cvt_pk_bf16(s1[2], s1[3]); w.z = cvt_pk_bf16(s1[4], s1[5]); w.w = cvt_pk_bf16(s1[6], s1[7]); pb[2] = __builtin_bit_cast(bf16x8, w);
                w.x = cvt_pk_bf16(s1[8], s1[9]); w.y = cvt_pk_bf16(s1[10], s1[11]); w.z = cvt_pk_bf16(s1[12], s1[13]); w.w = cvt_pk_bf16(s1[14], s1[15]); pb[3] = __builtin_bit_cast(bf16x8, w);
            }
            if (j + 1 < ntiles) ATT_LOADV(j + 1);
            const LAS unsigned char* vb = kb + KBYTES;
#pragma unroll
            for (int d = 0; d < 4; ++d)
#pragma unroll
                for (int ks = 0; ks < 4; ++ks) {
                    const LAS unsigned char* ap = vb + (d * 32 + l32) * VROW + (16 * ks + 4 * h) * 2;
                    const u32x2 lo = *(const LAS u32x2*)ap, hi = *(const LAS u32x2*)(ap + 16);
                    const u32x4 w = (u32x4){lo.x, lo.y, hi.x, hi.y};
                    o[d] = mfma32(__builtin_bit_cast(bf16x8, w), pb[ks], o[d]);
                    if (ks == 3) __builtin_amdgcn_sched_barrier(0);
                }
            if (j + 1 < ntiles) ATT_STORE(buf ^ 1);
            __syncthreads();
        }
        l_run += __shfl_xor(l_run, 32);
        const float inv = 1.0f / l_run;
#if DEBUG_CHECK == 5
        bf16_t* orow = (bf16_t*)(launder(p.ws) + OFF_ODBG) + (size_t)qrow * 512 + head * 128;
#else
        bf16_t* orow = Q + (size_t)qrow * 768 + head * 192;
#endif
#pragma unroll
        for (int d = 0; d < 4; ++d)
#pragma unroll
            for (int rq = 0; rq < 4; ++rq) {
                const u32x2 w = (u32x2){cvt_pk_bf16(o[d][4 * rq] * inv, o[d][4 * rq + 1] * inv), cvt_pk_bf16(o[d][4 * rq + 2] * inv, o[d][4 * rq + 3] * inv)};
                *(GAS u32x2*)(orow + 32 * d + 8 * rq + 4 * h) = w;
            }
#undef ATT_LOAD
#undef ATT_LOADV
#undef ATT_STORE
#undef ATT_STOREK
    }
}

template <int SET> __device__ __forceinline__ void hyena_unit(const Params& p, LAS unsigned char* lds, int c, int bg) {
    constexpr int P = SET ? 32 : 128;
    constexpr int NBU = SET ? 16 : 4;
    constexpr int NBT = SET ? 8 : 2;
    constexpr int GP = SET ? 4 : 16;
    constexpr int LG = SET ? LGS : LGP;
    constexpr int NB = SET ? NBS : NBP;
    constexpr int RS = SET ? 4896 : 18816;
    constexpr int GBYTES = 2 * LG * 2;
    constexpr int G1OFF = 33220;
    constexpr int ZOFF = 66560;
    unsigned char* ws = launder(p.ws);
    const int tid = tid_l(), lane = tid & 63, wave = tid >> 6, h = lane >> 5, l32 = lane & 31;
    const bf16_t* X1T = (const bf16_t*)(ws + OFF_X1T) + (SET ? XT_SET1 : 0);
    bf16_t* X2T = (bf16_t*)(ws + OFF_X2T) + (SET ? XT_SET1 : 0);
    const bf16_t* V0T = (const bf16_t*)(ws + OFF_V0T) + (SET ? XT_SET1 : 0);
    const bf16_t* GR = (const bf16_t*)(ws + (SET ? OFF_GR1 : OFF_GR0));
    const float* hy_bias = launder(p.in[17]);
    LAS unsigned char* gL = lds; LAS unsigned char* zL = lds + ZOFF;
    const size_t rowbase = ((size_t)c * NB + bg * NBU) * LG;
    for (int id = tid; id < NBU * (P + 1) * 8; id += 512) {
        const int bl = id / ((P + 1) * 8), rem = id % ((P + 1) * 8), blk = rem >> 3, ch = rem & 7;
        *(LAS u32x4*)(zL + bl * RS + blk * 144 + ch * 16) = *(const GAS u32x4*)(V0T + rowbase + (size_t)bl * LG + blk * 64 + ch * 8);
    }
    for (int id = tid; id < NBU * 9; id += 512) { const int bl = id / 9, ch = id % 9; *(LAS u32x4*)(zL + bl * RS + (P + 1) * 144 + ch * 16) = (u32x4){0u, 0u, 0u, 0u}; }
#define HY_LOADG(rowidx) do { const unsigned* g32_ = (const unsigned*)(GR + (size_t)(rowidx) * (2 * LG)); \
        for (int id = tid; id < GBYTES / 4; id += 512) { const unsigned a_ = g32_[id], b_ = (id + 1 < GBYTES / 4) ? g32_[id + 1] : 0u; \
            *(LAS unsigned*)(gL + id * 4) = a_; *(LAS unsigned*)(gL + G1OFF + id * 4) = (a_ >> 16) | (b_ << 16); } } while (0)
    HY_LOADG(c);
    __syncthreads();
    const LAS unsigned short* g16 = (const LAS unsigned short*)gL;
    constexpr int PARTS = 512 / (NBU * 16);
    float zmeta = 0.f; int mo_bl, mo_m;
    {
        const int part = tid % PARTS, out = tid / PARTS; mo_bl = out >> 4; mo_m = out & 15;
        const LAS unsigned char* zr = zL + mo_bl * RS;
        float a = 0.f;
        const LAS unsigned char* gm = gL + (mo_m & 1) * G1OFF;
        for (int ci = part; ci < (LG - 48) / 8; ci += PARTS) {
            const int tt0 = 48 + 8 * ci;
            const u32x4 zv = *(const LAS u32x4*)(zr + (tt0 >> 6) * 144 + (tt0 & 63) * 2);
            const LAS unsigned* gp = (const LAS unsigned*)(gm + ((LG - mo_m - 48 + tt0) >> 1) * 4);
            const unsigned g0 = gp[0], g1 = gp[1], g2 = gp[2], g3 = gp[3];
            a += (bflo(zv.x) * bflo(g0) + bfhi(zv.x) * bfhi(g0)) + (bflo(zv.y) * bflo(g1) + bfhi(zv.y) * bfhi(g1))
               + (bflo(zv.z) * bflo(g2) + bfhi(zv.z) * bfhi(g2)) + (bflo(zv.w) * bflo(g3) + bfhi(zv.w) * bfhi(g3));
        }
#pragma unroll
        for (int o = 1; o < PARTS; o <<= 1) a += __shfl_xor(a, o);
        const float bias0 = hy_bias[c];
        const float z0 = bf2f(*(const LAS unsigned short*)(zr + (48 + mo_m) * 2));
        const float x1 = bf2f(X1T[rowbase + (size_t)mo_bl * LG + 48 + mo_m]);
        zmeta = x1 * (a + z0 * bias0);
    }
    const int p0 = GP * wave;
    const int pp = l32 / NBT, blA = l32 % NBT, blB = NBT + blA;
#pragma unroll 1
    for (int order = 0; order < 2; ++order) {
        f32x16 acc[2][2];
#pragma unroll
        for (int a = 0; a < 2; ++a)
#pragma unroll
            for (int b = 0; b < 2; ++b)
#pragma unroll
                for (int r = 0; r < 16; ++r) acc[a][b][r] = 0.f;
        bf16x8 Ep4, Ep5;
        {
            const int d0 = p0 - (P - 1); const int ib0 = LG - 64 * d0 - l32 + 8 * h;
            const LAS unsigned char* g0 = gL + (l32 & 1) * G1OFF + (ib0 >> 1) * 4;
            const LAS unsigned* ga = (const LAS unsigned*)(g0 + 96); const LAS unsigned* gb = (const LAS unsigned*)(g0 + 64);
            Ep4 = __builtin_bit_cast(bf16x8, (u32x4){ga[0], ga[1], ga[2], ga[3]}); Ep5 = __builtin_bit_cast(bf16x8, (u32x4){gb[0], gb[1], gb[2], gb[3]});
        }
#define HY_LOAD(dd, Bv, Ev) do { \
            const int ib_ = LG - 64 * (dd) - l32 + 8 * h; \
            const LAS unsigned char* gpl_ = gL + (l32 & 1) * G1OFF + (ib_ >> 1) * 4; \
            _Pragma("unroll") for (int e = 2; e < 6; ++e) { const LAS unsigned* gp_ = (const LAS unsigned*)(gpl_ - 32 * (e - 3)); \
                Ev[e - 2] = __builtin_bit_cast(bf16x8, (u32x4){gp_[0], gp_[1], gp_[2], gp_[3]}); } \
            const int q_ = p0 + pp - (dd); const int slot_ = ((unsigned)(q_ + 1) <= (unsigned)P) ? q_ + 1 : P + 1; \
            const LAS unsigned char* zA_ = zL + blA * RS + slot_ * 144 + h * 16; const LAS unsigned char* zB_ = zL + blB * RS + slot_ * 144 + h * 16; \
            _Pragma("unroll") for (int ks = 0; ks < 4; ++ks) { Bv[0][ks] = *(const LAS bf16x8*)(zA_ + ks * 32); Bv[1][ks] = *(const LAS bf16x8*)(zB_ + ks * 32); } } while (0)
#define HY_MMA(Bv, Ev) do { \
            _Pragma("unroll") for (int ks = 0; ks < 4; ++ks) { \
                const bf16x8 a0_ = (ks == 0) ? Ev[1] : (ks == 1) ? Ev[0] : (ks == 2) ? Ep5 : Ep4; \
                const bf16x8 a1_ = (ks == 0) ? Ev[3] : (ks == 1) ? Ev[2] : (ks == 2) ? Ev[1] : Ev[0]; \
                acc[0][0] = mfma32(a0_, Bv[0][ks], acc[0][0]); acc[1][0] = mfma32(a0_, Bv[1][ks], acc[1][0]); \
                acc[0][1] = mfma32(a1_, Bv[0][ks], acc[0][1]); acc[1][1] = mfma32(a1_, Bv[1][ks], acc[1][1]); } \
            Ep4 = Ev[2]; Ep5 = Ev[3]; } while (0)
        {
            bf16x8 BA[2][4], BB[2][4], EA[4], EB[4];
            const int dlo = p0 - (P - 1), dhi = p0 + GP;
            HY_LOAD(dlo, BA, EA);
#pragma unroll 1
            for (int d = dlo; d <= dhi; d += 2) {
                HY_LOAD(d + 1, BB, EB);
                HY_MMA(BA, EA);
                if (d + 2 <= dhi) HY_LOAD(d + 2, BA, EA);
                HY_MMA(BB, EB);
            }
        }
#undef HY_LOAD
#undef HY_MMA
        __syncthreads();
        const float bias = hy_bias[order * 512 + c];
#pragma unroll
        for (int tl = 0; tl < 2; ++tl) {
            const int bl = tl ? blB : blA;
            const size_t grow = rowbase + (size_t)bl * LG + 64 * (p0 + pp + 1);
            LAS unsigned char* zr = zL + bl * RS + (p0 + pp + 1) * 144;
#pragma unroll
            for (int m = 0; m < 2; ++m)
#pragma unroll
                for (int rq = 0; rq < 4; ++rq) {
                    const int off = 32 * m + 8 * rq + 4 * h;
                    const u32x2 zw = *(const LAS u32x2*)(zr + off * 2);
                    const u32x2 xw = *(const GAS u32x2*)((order ? (const bf16_t*)X2T : X1T) + grow + off);
                    const float y0 = acc[tl][m][4 * rq], y1 = acc[tl][m][4 * rq + 1], y2 = acc[tl][m][4 * rq + 2], y3 = acc[tl][m][4 * rq + 3];
                    const float r0 = bflo(xw.x) * (y0 + bflo(zw.x) * bias), r1 = bfhi(xw.x) * (y1 + bfhi(zw.x) * bias);
                    const float r2 = bflo(xw.y) * (y2 + bflo(zw.y) * bias), r3 = bfhi(xw.y) * (y3 + bfhi(zw.y) * bias);
                    const u32x2 w = (u32x2){cvt_pk_bf16(r0, r1), cvt_pk_bf16(r2, r3)};
#if DEBUG_CHECK == 5
                    if (order == 0) *(LAS u32x2*)(zr + off * 2) = w; else *(GAS u32x2*)((bf16_t*)(ws + OFF_HDBG) + (SET ? XT_SET1 : 0) + grow + off) = w;
#else
                    if (order == 0) *(LAS u32x2*)(zr + off * 2) = w; else *(GAS u32x2*)(X2T + grow + off) = w;
#endif
                }
        }
        if (order == 0) {
            if ((tid % PARTS) == 0) *(LAS unsigned short*)(zL + mo_bl * RS + (48 + mo_m) * 2) = (unsigned short)(cvt_pk_bf16(zmeta, 0.f) & 0xffffu);
            HY_LOADG(512 + c);
        }
        __syncthreads();
    }
}
#undef HY_LOADG
__device__ __forceinline__ void hyena_phase(const Params& p, LAS unsigned char* lds) {
    for (int u = blockIdx.x; u < 2048; u += gridDim.x) {
        if (u < 1024) hyena_unit<0>(p, lds, u >> 1, u & 1); else hyena_unit<1>(p, lds, (u - 1024) >> 1, u & 1);
    }
}

__device__ __forceinline__ void mixnorm_phase(const Params& p, LAS unsigned char* lds) {
    unsigned char* ws = launder(p.ws); const int tid = tid_l(), lane = tid & 63, wave = tid >> 6, G = gridDim.x;
    const bf16_t* Q = (const bf16_t*)(launder((unsigned char*)p.out) + DO_Q);
    bf16_t* MIXN = (bf16_t*)(ws + OFF_MIXN);
    const float* ga = launder(p.in[18]); const float* gh = launder(p.in[19]);
    constexpr int RSB = 1040;
    for (int u = blockIdx.x; u < 2048; u += G) {
        const int n0 = u * 64;
        int set, b, tok0;
        if (n0 < 65536) { set = 0; b = n0 >> 13; tok0 = n0 & 8191; } else { set = 1; const int q = n0 - 65536; b = q >> 11; tok0 = q & 2047; }
        const int Lg = set ? LGS : LGP, NB = set ? NBS : NBP;
        {
            const int c = tid;
#if DEBUG_CHECK == 5
            const bf16_t* src = (const bf16_t*)(ws + OFF_HDBG) + (set ? XT_SET1 : 0) + ((size_t)c * NB + b) * Lg + tok0 + 64;
#else
            const bf16_t* src = (const bf16_t*)(ws + OFF_X2T) + (set ? XT_SET1 : 0) + ((size_t)c * NB + b) * Lg + tok0 + 64;
#endif
            LAS unsigned short* tl = (LAS unsigned short*)lds + c;
#pragma unroll
            for (int k8 = 0; k8 < 8; ++k8) {
                const u32x4 v = *(const GAS u32x4*)(src + k8 * 8);
                tl[(k8 * 8 + 0) * (RSB / 2)] = (unsigned short)(v.x & 0xffffu); tl[(k8 * 8 + 1) * (RSB / 2)] = (unsigned short)(v.x >> 16);
                tl[(k8 * 8 + 2) * (RSB / 2)] = (unsigned short)(v.y & 0xffffu); tl[(k8 * 8 + 3) * (RSB / 2)] = (unsigned short)(v.y >> 16);
                tl[(k8 * 8 + 4) * (RSB / 2)] = (unsigned short)(v.z & 0xffffu); tl[(k8 * 8 + 5) * (RSB / 2)] = (unsigned short)(v.z >> 16);
                tl[(k8 * 8 + 6) * (RSB / 2)] = (unsigned short)(v.w & 0xffffu); tl[(k8 * 8 + 7) * (RSB / 2)] = (unsigned short)(v.w >> 16);
            }
        }
        __syncthreads();
        for (int i = 0; i < 8; ++i) {
            const int rr = wave + 8 * i; const int n = n0 + rr; const int r = full_row(n);
            const u32x4 hv = *(const LAS u32x4*)(lds + rr * RSB + lane * 16);
#if DEBUG_CHECK == 5
            const u32x4 av = *(const GAS u32x4*)((const bf16_t*)(ws + OFF_ODBG) + (size_t)r * 512 + lane * 8);
#else
            const u32x4 av = *(const GAS u32x4*)(Q + (size_t)r * 768 + (lane >> 4) * 192 + (lane & 15) * 8);
#endif
            float hf[8] = {bflo(hv.x), bfhi(hv.x), bflo(hv.y), bfhi(hv.y), bflo(hv.z), bfhi(hv.z), bflo(hv.w), bfhi(hv.w)};
            float af[8] = {bflo(av.x), bfhi(av.x), bflo(av.y), bfhi(av.y), bflo(av.z), bfhi(av.z), bflo(av.w), bfhi(av.w)};
            float sh = 0.f, sa = 0.f;
#pragma unroll
            for (int k = 0; k < 8; ++k) { sh += hf[k] * hf[k]; sa += af[k] * af[k]; }
            sh = wave_sum(sh); sa = wave_sum(sa);
            const float rh = rsqrtf(sh * (1.f / 512.f) + EPS), ra = rsqrtf(sa * (1.f / 512.f) + EPS);
            const f32x4 ga0 = *(const GAS f32x4*)(ga + lane * 8), ga1 = *(const GAS f32x4*)(ga + lane * 8 + 4);
            const f32x4 gh0 = *(const GAS f32x4*)(gh + lane * 8), gh1 = *(const GAS f32x4*)(gh + lane * 8 + 4);
            u32x4 wa, wh;
            wa.x = cvt_pk_bf16(af[0] * ra * ga0[0], af[1] * ra * ga0[1]); wa.y = cvt_pk_bf16(af[2] * ra * ga0[2], af[3] * ra * ga0[3]);
            wa.z = cvt_pk_bf16(af[4] * ra * ga1[0], af[5] * ra * ga1[1]); wa.w = cvt_pk_bf16(af[6] * ra * ga1[2], af[7] * ra * ga1[3]);
            wh.x = cvt_pk_bf16(hf[0] * rh * gh0[0], hf[1] * rh * gh0[1]); wh.y = cvt_pk_bf16(hf[2] * rh * gh0[2], hf[3] * rh * gh0[3]);
            wh.z = cvt_pk_bf16(hf[4] * rh * gh1[0], hf[5] * rh * gh1[1]); wh.w = cvt_pk_bf16(hf[6] * rh * gh1[2], hf[7] * rh * gh1[3]);
#if EXPT == 1
            wa = (u32x4){0u, 0u, 0u, 0u};
#endif
#if EXPT == 2
            wh = (u32x4){0u, 0u, 0u, 0u};
#endif
            *(GAS u32x4*)(MIXN + (size_t)n * 1024 + lane * 8) = wa;
            *(GAS u32x4*)(MIXN + (size_t)n * 1024 + 512 + lane * 8) = wh;
        }
        __syncthreads();
    }
}

__device__ __forceinline__ void h1_phase(const Params& p) {
    unsigned char* ws = launder(p.ws); const int tid = tid_l(), lane = tid & 63, wave = tid >> 6;
    const int gw = blockIdx.x * 8 + wave, NGW = gridDim.x * 8;
    const bf16_t* MIX = (const bf16_t*)(ws + OFF_MIX); bf16_t* H1B = (bf16_t*)(ws + OFF_H1B);
    const float* sqmix = (const float*)(ws + OFF_SQMIXP); float* r1 = (float*)(ws + OFF_R1); const float* g = p.in[21];
    for (int n = gw; n < TN; n += NGW) {
        const float* xrow = n < 65536 ? p.in[0] + (size_t)n * 1024 : p.in[1] + (size_t)(n - 65536) * 1024;
        const float rm = rsqrtf(wave_sum(lane < 16 ? ldco(sqmix + (size_t)n * 16 + lane) : 0.f) * (1.f / 1024.f) + EPS);
        float ss = 0.f;
#pragma unroll
        for (int hh = 0; hh < 2; ++hh) {
            const int c0 = hh * 512 + lane * 8;
            const u32x4 mv = *(const u32x4*)(MIX + (size_t)n * 1024 + c0);
            const f32x4 x0 = *(const f32x4*)(xrow + c0), x1 = *(const f32x4*)(xrow + c0 + 4);
            const f32x4 g0 = *(const f32x4*)(g + c0), g1 = *(const f32x4*)(g + c0 + 4);
            f32x4 h0, h1;
            h0[0] = x0[0] + bflo(mv.x) * rm * g0[0]; h0[1] = x0[1] + bfhi(mv.x) * rm * g0[1]; h0[2] = x0[2] + bflo(mv.y) * rm * g0[2]; h0[3] = x0[3] + bfhi(mv.y) * rm * g0[3];
            h1[0] = x1[0] + bflo(mv.z) * rm * g1[0]; h1[1] = x1[1] + bfhi(mv.z) * rm * g1[1]; h1[2] = x1[2] + bflo(mv.w) * rm * g1[2]; h1[3] = x1[3] + bfhi(mv.w) * rm * g1[3];
            ss += sq8(h0, h1);
            *(u32x4*)(H1B + (size_t)n * 1024 + c0) = pack8(h0, h1);
        }
        ss = wave_sum(ss);
        if (lane == 0) r1[n] = rsqrtf(ss * (1.f / 1024.f) + EPS);
    }
}
__device__ __forceinline__ void final_phase(const Params& p, int half) {
    unsigned char* ws = launder(p.ws); const int tid = tid_l(), lane = tid & 63, wave = tid >> 6;
    const int gw = blockIdx.x * 8 + wave, NGW = gridDim.x * 8;
    const bf16_t* M2 = (const bf16_t*)(ws + OFF_M2); const float* sqm2 = (const float*)(ws + OFF_SQM2P); const float* g = p.in[25];
    float dbg_off = 0.f, dbg_one = 0.f;
#if DEBUG_CHECK
    { const unsigned* dc = (const unsigned*)(ws + OFF_DBGW); dbg_off = 100.f * (float)dc[8] * (1.f / 131072.f); dbg_one = 1000.f * (float)dc[9] * (1.f / 131072.f); }
#endif
    for (int i = gw; i < 65536; i += NGW) {
        const int n = half * 65536 + i;
        const float rm = rsqrtf(wave_sum(lane < 16 ? ldco(sqm2 + (size_t)n * 16 + lane) : 0.f) * (1.f / 1024.f) + EPS);
#pragma unroll
        for (int hh = 0; hh < 2; ++hh) {
            const int c0 = hh * 512 + lane * 8;
            const u32x4 mv = *(const u32x4*)(M2 + (size_t)i * 1024 + c0);
            const u32x4 hv = *(const u32x4*)((const bf16_t*)(ws + OFF_H1B) + (size_t)n * 1024 + c0);
            f32x4 h0 = (f32x4){bflo(hv.x), bfhi(hv.x), bflo(hv.y), bfhi(hv.y)}, h1 = (f32x4){bflo(hv.z), bfhi(hv.z), bflo(hv.w), bfhi(hv.w)};
            const f32x4 g0 = *(const f32x4*)(g + c0), g1 = *(const f32x4*)(g + c0 + 4);
            h0 += dbg_off; h1 += dbg_off; if (n == 0 && c0 == 0) h0[0] += dbg_one;
            h0[0] += bflo(mv.x) * rm * g0[0]; h0[1] += bfhi(mv.x) * rm * g0[1]; h0[2] += bflo(mv.y) * rm * g0[2]; h0[3] += bfhi(mv.y) * rm * g0[3];
            h1[0] += bflo(mv.z) * rm * g1[0]; h1[1] += bfhi(mv.z) * rm * g1[1]; h1[2] += bflo(mv.w) * rm * g1[2]; h1[3] += bfhi(mv.w) * rm * g1[3];
            *(f32x4*)(p.out + (size_t)n * 1024 + c0) = h0; *(f32x4*)(p.out + (size_t)n * 1024 + c0 + 4) = h1;
        }
    }
}


#if DEBUG_CHECK
constexpr size_t OFF_DBG = OFF_DBGW;
__device__ __forceinline__ void check_gemm(const bf16_t* A, int lda, const bf16_t* Bt, int ldb, int K, int M, int N, int mode, const bf16_t* O, int ldc, const float* rs, unsigned* cnt, int col_lo) {
    const unsigned idx = blockIdx.x * 512u + (unsigned)tid_l();
    unsigned hsh = idx * 2654435761u + 12345u + (unsigned)mode * 977u; hsh ^= hsh >> 15; hsh *= 2246822519u; hsh ^= hsh >> 13;
    const int row = (int)(hsh % (unsigned)M); hsh = hsh * 3266489917u + 668265263u; hsh ^= hsh >> 16;
    const int col = col_lo + (int)(hsh % (unsigned)(N - col_lo));
    float d = 0.f;
    for (int k = 0; k < K; ++k) d += bf2f(A[(size_t)row * lda + k]) * bf2f(Bt[(size_t)col * ldb + k]);
    float e = d;
    if (mode == 0 || mode == 7) e = d * rs[row];
    if (mode == 5) { const float t = fmaxf(d * rs[row], 0.f); e = t * t; }
    const float st = bf2f(O[(size_t)row * ldc + col]);
    if (!(fabsf(st - e) <= 0.03f * fabsf(e) + 0.03f)) atomicAdd(cnt, 1u);
}
#endif

#if DEBUG_CHECK == 2
__device__ __forceinline__ void check_proj(const Params& p) {
    unsigned char* ws = launder(p.ws); unsigned char* ob = launder((unsigned char*)p.out);
    const bf16_t* P = (const bf16_t*)(ws + OFF_P); unsigned* cnt = (unsigned*)(ws + OFF_DBG);
    const unsigned idx = blockIdx.x * 512u + (unsigned)tid_l();
    unsigned hsh = idx * 2654435761u + 777u; hsh ^= hsh >> 15; hsh *= 2246822519u; hsh ^= hsh >> 13;
    const int row = (int)(hsh % (unsigned)T); hsh = hsh * 3266489917u + 668265263u; hsh ^= hsh >> 16;
    int pos, seq; row_info(row, pos, seq);
    {
        const int n = (int)(hsh % 768u); const int hh = n / 192, w = n % 192;
        float ss = 0.f, x1 = 0.f, x2 = 0.f; const float* W = p.in[6]; const float* g = p.in[5];
        const int j = w - 128, i = j >> 1;
        const int c1 = w < 128 ? hh * 192 + w : hh * 192 + 128 + i, c2 = hh * 192 + 160 + (w < 128 ? 0 : i);
        for (int k = 0; k < 256; ++k) { const float a = bf2f(P[(size_t)row * NPP + k]); ss += a * a; x1 += a * g[k] * W[k * 768 + c1]; x2 += a * g[k] * W[k * 768 + c2]; }
        const float rq = rsqrtf(ss * (1.f / 256.f) + EPS) * QSCALE; x1 *= rq; x2 *= rq;
        float e = x1;
        if (w >= 128) { const float inv = 1.0f / exp2f((float)i * (13.287712379549449f / 32.f)); float sn, cs; sincos_red((float)pos * inv, sn, cs); e = (j & 1) ? x2 * cs + x1 * sn : x1 * cs - x2 * sn; }
        const float st = bf2f(((const bf16_t*)(ob + DO_Q))[(size_t)row * 768 + n]);
        if (!(fabsf(st - e) <= 0.03f * fabsf(e) + 0.01f)) atomicAdd(cnt + (w < 128 ? 0 : 4), 1u);
    }
    {
        const int n = (int)((hsh >> 3) % 512u); const int hh = n >> 7, i = n & 127;
        float ss = 0.f, x1 = 0.f, x2 = 0.f; const float* W = p.in[8]; const float* g = p.in[7];
        for (int k = 0; k < 128; ++k) { const float a = bf2f(P[(size_t)row * NPP + 256 + k]); ss += a * a; x1 += a * g[k] * W[k * 1024 + hh * 256 + i]; x2 += a * g[k] * W[k * 1024 + hh * 256 + 128 + i]; }
        const float rk = rsqrtf(ss * (1.f / 128.f) + EPS); x1 *= rk; x2 *= rk;
        const float s1 = bf2f(((const bf16_t*)(ob + DO_KN))[(size_t)row * 512 + n]);
        const float s2 = bf2f(((const bf16_t*)(ob + DO_VT))[(size_t)n * TPAD + row]);
        if (!(fabsf(s1 - x1) <= 0.03f * fabsf(x1) + 0.03f)) atomicAdd(cnt + 1, 1u);
        if (!(fabsf(s2 - x2) <= 0.03f * fabsf(x2) + 0.03f)) atomicAdd(cnt + 2, 1u);
    }
    {
        const int jj = (int)((hsh >> 5) % 64u); const int i = jj >> 1;
        const float* xr = pos < 16 ? p.in[2] + (size_t)pos * 1024 : (seq < NBP ? p.in[0] + ((size_t)seq * 8192 + (pos - 16)) * 1024 : p.in[1] + ((size_t)(seq - NBP) * 2048 + (pos - 16)) * 1024);
        const float* W = p.in[4]; const float* g = p.in[3]; float x1 = 0.f, x2 = 0.f;
        for (int k = 0; k < 1024; ++k) { const float a = xr[k] * g[k]; x1 += a * W[(size_t)k * 1984 + 384 + i]; x2 += a * W[(size_t)k * 1984 + 416 + i]; }
        const float r0 = ((const float*)(ws + OFF_R0))[row]; x1 *= r0; x2 *= r0;
        const float inv = 1.0f / exp2f((float)i * (13.287712379549449f / 32.f)); float sn, cs; sincos_red((float)pos * inv, sn, cs);
        const float e = (jj & 1) ? x2 * cs + x1 * sn : x1 * cs - x2 * sn;
        const float st = bf2f(((const bf16_t*)(ob + DO_KR))[(size_t)row * 64 + jj]);
        if (!(fabsf(st - e) <= 0.03f * fabsf(e) + 0.03f)) { atomicAdd(cnt + 3, 1u); atomicAdd(cnt + 5, (unsigned)i); atomicAdd(cnt + 6, (unsigned)(pos >> 3)); }
    }
}
#endif

#if DEBUG_CHECK == 3
__device__ __forceinline__ void check_h0b(const Params& p, int slot) {
    unsigned char* ws = launder(p.ws); unsigned* cnt = (unsigned*)(ws + OFF_DBGW);
    const bf16_t* h0b = (const bf16_t*)(ws + OFF_H0B);
    const unsigned idx = blockIdx.x * 512u + (unsigned)tid_l();
    unsigned hsh = idx * 2654435761u + 4242u + (unsigned)slot * 31u; hsh ^= hsh >> 15; hsh *= 2246822519u; hsh ^= hsh >> 13;
    const int row = (int)(hsh % (unsigned)T); hsh = hsh * 3266489917u + 668265263u; hsh ^= hsh >> 16;
    const int col = (int)(hsh % 1024u);
    int pos, seq; row_info(row, pos, seq);
    const float* xr = pos < 16 ? p.in[2] + (size_t)pos * 1024 : (seq < NBP ? p.in[0] + ((size_t)seq * 8192 + (pos - 16)) * 1024 : p.in[1] + ((size_t)(seq - NBP) * 2048 + (pos - 16)) * 1024);
    const float e = xr[col]; const float st = bf2f(h0b[(size_t)row * 1024 + col]);
    if (!(fabsf(st - e) <= 0.01f * fabsf(e) + 0.001f)) atomicAdd(cnt + slot, 1u);
}
#endif

#if DEBUG_CHECK == 4
__device__ __forceinline__ void check_stale(const Params& p, const unsigned* base, unsigned ndw, int slot) {
    unsigned* cnt = (unsigned*)(launder(p.ws) + OFF_DBGW);
    const unsigned idx = blockIdx.x * 512u + (unsigned)tid_l();
    unsigned hsh = idx * 2654435761u + 999u + (unsigned)slot * 131u; hsh ^= hsh >> 15; hsh *= 2246822519u; hsh ^= hsh >> 13;
#pragma unroll 1
    for (int it = 0; it < 16; ++it) {
        hsh = hsh * 3266489917u + 668265263u; hsh ^= hsh >> 16;
        const unsigned i = hsh % ndw;
        const unsigned a = base[i];
        const unsigned b = __hip_atomic_load(base + i, __ATOMIC_RELAXED, __HIP_MEMORY_SCOPE_AGENT);
        if (a != b) atomicAdd(cnt + slot, 1u);
    }
}
#endif

#if DEBUG_CHECK == 5
__device__ __forceinline__ void check_attn(const Params& p) {
    unsigned char* ws = launder(p.ws); unsigned char* ob = launder((unsigned char*)p.out); unsigned* cnt = (unsigned*)(ws + OFF_DBGW);
    const int tid = tid_l(), lane = tid & 63, wave = tid >> 6;
    const bf16_t* Q = (const bf16_t*)(ob + DO_Q); const bf16_t* KN = (const bf16_t*)(ob + DO_KN); const bf16_t* KR = (const bf16_t*)(ob + DO_KR); const bf16_t* VT = (const bf16_t*)(ob + DO_VT);
    const bf16_t* OD = (const bf16_t*)(ws + OFF_ODBG); const float2* RT = (const float2*)(ws + OFF_RT);
    unsigned hsh = (unsigned)(blockIdx.x * 8 + wave) * 2654435761u + 31337u; hsh ^= hsh >> 15; hsh *= 2246822519u; hsh ^= hsh >> 13;
    const int n = (int)(hsh % (unsigned)TN); const int head = (int)((hsh >> 20) & 3u); const int r = full_row(n);
    int pos, seq; row_info(r, pos, seq);
    const int L = seq < NBP ? LP : LS; const int row0 = r - pos;
    const bf16_t* qp = Q + (size_t)r * 768 + head * 192;
    float mx = -INFINITY;
    for (int k = lane; k < L; k += 64) {
        float sdot = 0.f;
        for (int d = 0; d < 128; ++d) sdot += bf2f(qp[d]) * bf2f(KN[(size_t)(row0 + k) * 512 + head * 128 + d]);
        for (int i = 0; i < 32; ++i) { const float2 cs = ldco2(RT + pos * 32 + i); const float a = bf2f(qp[128 + 2 * i]), b = bf2f(qp[129 + 2 * i]);
            sdot += (a * cs.x - b * cs.y) * bf2f(KR[(size_t)(row0 + k) * 64 + 2 * i]) + (b * cs.x + a * cs.y) * bf2f(KR[(size_t)(row0 + k) * 64 + 2 * i + 1]); }
        mx = fmaxf(mx, sdot);
    }
#pragma unroll
    for (int o = 1; o < 64; o <<= 1) mx = fmaxf(mx, __shfl_xor(mx, o));
    float sw = 0.f, o0 = 0.f, o1 = 0.f; const int dv0 = (int)((hsh >> 8) & 127u), dv1 = (dv0 + 37) & 127;
    for (int k = lane; k < L; k += 64) {
        float sdot = 0.f;
        for (int d = 0; d < 128; ++d) sdot += bf2f(qp[d]) * bf2f(KN[(size_t)(row0 + k) * 512 + head * 128 + d]);
        for (int i = 0; i < 32; ++i) { const float2 cs = ldco2(RT + pos * 32 + i); const float a = bf2f(qp[128 + 2 * i]), b = bf2f(qp[129 + 2 * i]);
            sdot += (a * cs.x - b * cs.y) * bf2f(KR[(size_t)(row0 + k) * 64 + 2 * i]) + (b * cs.x + a * cs.y) * bf2f(KR[(size_t)(row0 + k) * 64 + 2 * i + 1]); }
        const float w = exp2f(sdot - mx); sw += w;
        o0 += w * bf2f(VT[(size_t)(head * 128 + dv0) * TPAD + row0 + k]); o1 += w * bf2f(VT[(size_t)(head * 128 + dv1) * TPAD + row0 + k]);
    }
    sw = wave_sum(sw); o0 = wave_sum(o0) / sw; o1 = wave_sum(o1) / sw;
    if (lane == 0) {
        const float s0 = bf2f(OD[(size_t)r * 512 + head * 128 + dv0]), s1 = bf2f(OD[(size_t)r * 512 + head * 128 + dv1]);
        atomicAdd(cnt + 10, 2u);
        if (!(fabsf(s0 - o0) <= 0.05f * fabsf(o0) + 0.002f)) atomicAdd(cnt + 8, 1u);
        if (!(fabsf(s1 - o1) <= 0.05f * fabsf(o1) + 0.002f)) atomicAdd(cnt + 8, 1u);
    }
}
__device__ __forceinline__ void check_hyena(const Params& p, LAS unsigned char* lds) {
    unsigned char* ws = launder(p.ws); unsigned* cnt = (unsigned*)(ws + OFF_DBGW);
    const int tid = tid_l();
    unsigned hsh = (unsigned)blockIdx.x * 2654435761u + 555u; hsh ^= hsh >> 15; hsh *= 2246822519u; hsh ^= hsh >> 13;
    const int set = (int)(blockIdx.x & 1u); const int c = (int)(hsh % 512u); const int NB = set ? NBS : NBP; const int b = (int)((hsh >> 12) % (unsigned)NB);
    const int LG = set ? LGS : LGP;
    const size_t base = (set ? XT_SET1 : 0) + ((size_t)c * NB + b) * LG;
    const bf16_t* X1 = (const bf16_t*)(ws + OFF_X1T) + base; const bf16_t* X2 = (const bf16_t*)(ws + OFF_X2T) + base; const bf16_t* V0 = (const bf16_t*)(ws + OFF_V0T) + base;
    const bf16_t* HD = (const bf16_t*)(ws + OFF_HDBG) + base;
    const bf16_t* G0 = (const bf16_t*)(ws + (set ? OFF_GR1 : OFF_GR0)) + (size_t)c * (2 * LG); const bf16_t* G1 = G0 + (size_t)512 * (2 * LG);
    const float bias0 = p.in[17][c], bias1 = p.in[17][512 + c];
    LAS float* z1 = (LAS float*)lds;
    for (int t = tid; t < LG; t += 512) {
        float y = 0.f;
        for (int s2 = 48; s2 < LG; ++s2) y += bf2f(G0[LG - (t - s2)]) * bf2f(V0[s2]);
        const float v = bf2f(X1[t]) * (y + bf2f(V0[t]) * bias0);
        z1[t] = (t >= 48) ? bf2f((unsigned short)(cvt_pk_bf16(v, 0.f) & 0xffffu)) : 0.f;
    }
    __syncthreads();
    {
        unsigned h2 = hsh * 3266489917u + (unsigned)tid * 2246822519u; h2 ^= h2 >> 15; h2 *= 2654435761u; h2 ^= h2 >> 13;
        const int t = 64 + (int)(h2 % (unsigned)(LG - 64));
        float y = 0.f;
        for (int s2 = 48; s2 < LG; ++s2) y += bf2f(G1[LG - (t - s2)]) * z1[s2];
        const float e = bf2f(X2[t]) * (y + z1[t] * bias1);
        const float st = bf2f(HD[t]);
        atomicAdd(cnt + 11, 1u);
        if (!(fabsf(st - e) <= 0.05f * fabsf(e) + 1.0f)) atomicAdd(cnt + 9, 1u);
    }
    __syncthreads();
}
#endif

#if DEBUG_CHECK == 7
__device__ __forceinline__ void check_h0b_full(const Params& p, int slot) {
    unsigned char* ws = launder(p.ws); unsigned* cnt = (unsigned*)(ws + OFF_DBGW);
    const bf16_t* h0b = (const bf16_t*)(ws + OFF_H0B);
    const int tid = tid_l(), lane = tid & 63, wave = tid >> 6;
    for (int row = blockIdx.x * 8 + wave; row < T; row += gridDim.x * 8) {
        int pos, seq; row_info(row, pos, seq);
        const float* xr = pos < 16 ? p.in[2] + (size_t)pos * 1024 : (seq < NBP ? p.in[0] + ((size_t)seq * 8192 + (pos - 16)) * 1024 : p.in[1] + ((size_t)(seq - NBP) * 2048 + (pos - 16)) * 1024);
        int bad = 0;
        for (int c = lane; c < 1024; c += 64) { const float e = xr[c]; const float st = bf2f(h0b[(size_t)row * 1024 + c]); if (!(fabsf(st - e) <= 0.01f * fabsf(e) + 0.001f)) bad = 1; }
        bad = __any(bad);
        if (lane == 0 && bad) atomicAdd(cnt + slot, 1u);
    }
}
#endif

#if DEBUG_CHECK == 8
__device__ __forceinline__ void check_p_golden(const Params& p) {
    unsigned char* ws = launder(p.ws); unsigned* cnt = (unsigned*)(ws + OFF_DBGW);
    const bf16_t* P = (const bf16_t*)(ws + OFF_P);
    const unsigned idx = blockIdx.x * 512u + (unsigned)tid_l();
    unsigned hsh = idx * 2654435761u + 8888u; hsh ^= hsh >> 15; hsh *= 2246822519u; hsh ^= hsh >> 13;
    const int row = (int)(hsh % (unsigned)T); hsh = hsh * 3266489917u + 668265263u; hsh ^= hsh >> 16;
    int pos, seq; row_info(row, pos, seq);
    const float* xr = pos < 16 ? p.in[2] + (size_t)pos * 1024 : (seq < NBP ? p.in[0] + ((size_t)seq * 8192 + (pos - 16)) * 1024 : p.in[1] + ((size_t)(seq - NBP) * 2048 + (pos - 16)) * 1024);
    const float* W = p.in[4]; const float* g = p.in[3];
    const int colA = 448 + (int)(hsh % 1536u), colB = (int)((hsh >> 7) % 384u);
    float ss = 0.f, a = 0.f, b = 0.f;
    for (int k = 0; k < 1024; ++k) { const float x = xr[k]; ss += x * x; a += x * g[k] * W[(size_t)k * 1984 + colA]; b += x * g[k] * W[(size_t)k * 1984 + colB]; }
    const float r0 = rsqrtf(ss * (1.f / 1024.f) + EPS); a *= r0; b *= r0;
    const float sa = bf2f(P[(size_t)row * NPP + colA]), sb = bf2f(P[(size_t)row * NPP + colB]);
    if (!(fabsf(sa - a) <= 0.03f * fabsf(a) + 0.03f)) atomicAdd(cnt + 8, 1u);
    if (!(fabsf(sb - b) <= 0.03f * fabsf(b) + 0.03f)) atomicAdd(cnt + 9, 1u);
}
#endif

#if DEBUG_CHECK == 9
__device__ __forceinline__ void check_win_r0(const Params& p) {
    unsigned char* ws = launder(p.ws); unsigned* cnt = (unsigned*)(ws + OFF_DBGW);
    const bf16_t* WT = (const bf16_t*)(ws + OFF_WIN); const float* W = p.in[4]; const float* g = p.in[3]; const float* R0 = (const float*)(ws + OFF_R0);
    const int tid = tid_l(), lane = tid & 63, wave = tid >> 6;
    const int gtid = blockIdx.x * 512 + tid, gthreads = gridDim.x * 512;
    for (int e = gtid; e < 1984 * 1024; e += gthreads) {
        const int n = e >> 10, k = e & 1023; const int sc = src_col(1, n);
        const float ex = W[(size_t)k * 1984 + sc] * g[k]; const float st = bf2f(WT[(size_t)n * 1024 + k]);
        if (!(fabsf(st - ex) <= 0.01f * fabsf(ex) + 1e-5f)) atomicAdd(cnt + 8, 1u);
    }
    for (int row = blockIdx.x * 8 + wave; row < T; row += gridDim.x * 8) {
        int pos, seq; row_info(row, pos, seq);
        const float* xr = pos < 16 ? p.in[2] + (size_t)pos * 1024 : (seq < NBP ? p.in[0] + ((size_t)seq * 8192 + (pos - 16)) * 1024 : p.in[1] + ((size_t)(seq - NBP) * 2048 + (pos - 16)) * 1024);
        float ss = 0.f;
        for (int c = lane; c < 1024; c += 64) ss += xr[c] * xr[c];
        ss = wave_sum(ss);
        const float ex = rsqrtf(ss * (1.f / 1024.f) + EPS); const float st = R0[row];
        if (lane == 0 && !(fabsf(st - ex) <= 0.001f * ex)) { atomicAdd(cnt + 9, 1u); atomicAdd(cnt + 12, (unsigned)(row >> 6)); }
    }
}
#endif

#if DEBUG_CHECK == 10
__device__ __forceinline__ void check_x(const Params& p, int mode) {
    unsigned char* ws = launder(p.ws); unsigned* cnt = (unsigned*)(ws + OFF_DBGW); unsigned* sums = (unsigned*)(ws + OFF_DBGW + MiB);
    const int tid = tid_l(), lane = tid & 63, wave = tid >> 6;
    for (int n = blockIdx.x * 8 + wave; n < TN; n += gridDim.x * 8) {
        const unsigned* xr = (const unsigned*)(n < 65536 ? p.in[0] + (size_t)n * 1024 : p.in[1] + (size_t)(n - 65536) * 1024);
        unsigned a = 0u;
        for (int c = lane; c < 1024; c += 64) a += xr[c] * (2u * (unsigned)c + 1u);
#pragma unroll
        for (int o = 1; o < 64; o <<= 1) a += __shfl_xor(a, o);
        if (lane == 0) {
            if (mode == 0) __hip_atomic_store(sums + n, a, __ATOMIC_RELAXED, __HIP_MEMORY_SCOPE_AGENT);
            else if (__hip_atomic_load(sums + n, __ATOMIC_RELAXED, __HIP_MEMORY_SCOPE_AGENT) != a) atomicAdd(cnt + 8, 1u);
        }
    }
}
#endif

#if DEBUG_CHECK == 11
__device__ __forceinline__ void check_filt_prep(const Params& p) {
    unsigned char* ws = launder(p.ws); unsigned* cnt = (unsigned*)(ws + OFF_DBGW);
    const unsigned idx = blockIdx.x * 512u + (unsigned)tid_l();
    unsigned hsh = idx * 2654435761u + 1111u; hsh ^= hsh >> 15; hsh *= 2246822519u; hsh ^= hsh >> 13;
    {
        const int set = (int)(hsh & 1u); const int L = set ? LS : LP; const int C0 = set ? LGS : LGP;
        const int n = (int)((hsh >> 1) % 2048u); hsh = hsh * 3266489917u + 668265263u; hsh ^= hsh >> 16;
        const int t = (int)(hsh % (unsigned)L);
        const float* f_w1 = p.in[10]; const float* f_b1 = p.in[11]; const float* f_freq = p.in[12]; const float* f_w2 = p.in[13];
        const float* f_b2 = p.in[14]; const float* f_w3 = p.in[15]; const float* f_decay = p.in[16];
        const float tn = (float)t / (float)(L - 1); const float w = (6.2831853071795865f * (float)t) / (float)L;
        float acc = 0.f;
        for (int j2 = 0; j2 < 64; ++j2) {
            float a2 = f_b2[j2];
            for (int j1 = 0; j1 < 64; ++j1) {
                float a1 = f_b1[j1] + tn * f_w1[j1];
                for (int k = 0; k < 16; ++k) { const float f = 1e-4f + (float)k * ((15.0f - 1e-4f) / 15.0f); float sn, cs; sincos_red(f * w, sn, cs);
                    a1 += cs * f_w1[(1 + k) * 64 + j1] - sn * f_w1[(17 + k) * 64 + j1]; }
                a2 += sin_red(f_freq[j1] * a1) * f_w2[j1 * 64 + j2];
            }
            acc += sin_red(f_freq[j2] * a2) * f_w3[j2 * 2048 + n];
        }
        const float e = acc * __expf(-tn * fabsf(f_decay[n]));
        const int order = n >> 10, dir = (n >> 9) & 1, c = n & 511;
        if (!(dir == 1 && t == 0)) {
            const bf16_t* row = (const bf16_t*)(ws + (set ? OFF_GR1 : OFF_GR0)) + (size_t)(order * 512 + c) * (2 * C0);
            const float st = bf2f(row[dir ? C0 + t : C0 - t]);
            if (!(fabsf(st - e) <= 0.02f * fabsf(e) + 0.003f)) atomicAdd(cnt + 8, 1u);
        }
    }
    {
        const int seq = (int)(hsh % 40u); const int set = seq < NBP ? 0 : 1; const int L = set ? LS : LP; const int Lg = set ? LGS : LGP; const int NB = set ? NBS : NBP;
        const int b = set ? seq - NBP : seq; const int row0 = set ? TPR + b * LS : b * LP;
        hsh = hsh * 3266489917u + 668265263u; hsh ^= hsh >> 16;
        const int pos = (int)(hsh % (unsigned)L); const int which = (int)((hsh >> 16) % 3u); const int c = (int)((hsh >> 20) % 512u);
        const bf16_t* P = (const bf16_t*)(ws + OFF_P); const float* cw = p.in[9]; const int col = 448 + which * 512 + c;
        const float um = pos > 0 ? bf2f(P[(size_t)(row0 + pos - 1) * NPP + col]) : 0.f, u0 = bf2f(P[(size_t)(row0 + pos) * NPP + col]), up = pos + 1 < L ? bf2f(P[(size_t)(row0 + pos + 1) * NPP + col]) : 0.f;
        const float e = um * cw[which * 512 + c] + u0 * cw[1536 + which * 512 + c] + up * cw[3072 + which * 512 + c];
        const bf16_t* XT = (const bf16_t*)(ws + (which == 0 ? OFF_X1T : (which == 1 ? OFF_X2T : OFF_V0T))) + (set ? XT_SET1 : 0) + ((size_t)c * NB + b) * Lg;
        const float st = bf2f(XT[pos + 48]);
        if (!(fabsf(st - e) <= 0.02f * fabsf(e) + 0.02f)) atomicAdd(cnt + 9, 1u);
    }
}
#endif
#ifndef SUB_MASK
#define SUB_MASK 15
#endif
#ifndef PHASE_MASK
#define PHASE_MASK 1023
#endif
__global__ void __launch_bounds__(512) hymba_fwd(Params p) {
    extern __shared__ __attribute__((aligned(16))) unsigned char lds_raw[];
    LAS unsigned char* lds = (LAS unsigned char*)lds_raw;
    cg::grid_group grid = cg::this_grid();
#define GSYNC() do { asm volatile("s_waitcnt vmcnt(0) lgkmcnt(0)" ::: "memory"); grid.sync(); } while (0)
    const int G = gridDim.x;
    __builtin_amdgcn_fence(__ATOMIC_SEQ_CST, "agent");
    asm volatile("buffer_inv sc1\n\ts_waitcnt vmcnt(0)" ::: "memory");
#if DEBUG_CHECK == 10
    check_x(p, 0);
#endif
#if PHASE_MASK & 1
    p0_prologue(p, lds);
#endif
    GSYNC();
#if DEBUG_CHECK == 3
    check_h0b(p, 8);
#endif
#if DEBUG_CHECK == 7
    check_h0b_full(p, 8);
#endif
#if DEBUG_CHECK == 4
    check_stale(p, (const unsigned*)(launder(p.ws) + OFF_H0B), (unsigned)((size_t)T * 512), 9);
#endif
#if PHASE_MASK & 2
    {
        unsigned char* ws = launder(p.ws); unsigned char* ob = launder((unsigned char*)p.out);
        pg8::Gemm g{(const bf16_t*)(ws + OFF_H0B), (const bf16_t*)(ws + OFF_WIN), TPAD, 2048, 1024, 1024, 1024};
        pg8::StaticOrder S; S.init(TPAD, 2048, G, blockIdx.x);
        Epi<0> E{(bf16_t*)(ws + OFF_P), NPP, (const float*)(ws + OFF_R0), (float*)(ws + OFF_SQQP), (float*)(ws + OFF_SQKVP), (bf16_t*)(ob + DO_KR), (const float2*)(ws + OFF_RT)};
        pg8::gemm_phase(lds, g, S, E);
    }
#endif
    GSYNC();
#if DEBUG_CHECK == 1
    { unsigned char* ws = launder(p.ws); check_gemm((const bf16_t*)(ws + OFF_H0B), 1024, (const bf16_t*)(ws + OFF_WIN), 1024, 1024, T, 1984, 0, (const bf16_t*)(ws + OFF_P), NPP, (const float*)(ws + OFF_R0), (unsigned*)(ws + OFF_DBG) + 0, 448); }
    GSYNC();
#endif
#if DEBUG_CHECK == 3
    check_h0b(p, 9);
#endif
#if DEBUG_CHECK == 8
    check_p_golden(p);
#endif
#if DEBUG_CHECK == 9
    check_win_r0(p);
#endif
#if DEBUG_CHECK == 7
    check_h0b_full(p, 9);
    GSYNC();
#endif
#if DEBUG_CHECK == 6
    { unsigned char* ws = launder(p.ws);
      check_gemm((const bf16_t*)(ws + OFF_H0B), 1024, (const bf16_t*)(ws + OFF_WIN), 1024, 1024, T, 448, 0, (const bf16_t*)(ws + OFF_P), NPP, (const float*)(ws + OFF_R0), (unsigned*)(ws + OFF_DBG) + 8, 384);
      check_gemm((const bf16_t*)(ws + OFF_H0B), 1024, (const bf16_t*)(ws + OFF_WIN), 1024, 1024, T, 384, 7, (const bf16_t*)(ws + OFF_P), NPP, (const float*)(ws + OFF_R0), (unsigned*)(ws + OFF_DBG) + 9, 0); }
    GSYNC();
#endif
#if DEBUG_CHECK == 4
    check_stale(p, (const unsigned*)(launder(p.ws) + OFF_P), (unsigned)((size_t)T * 1024), 8);
#endif
    rownorm_phase(p);
    krope_phase(p);
    GSYNC();
#if (PHASE_MASK & 4) && (SUB2 & 1)
    {
        unsigned char* ws = launder(p.ws); unsigned char* ob = launder((unsigned char*)p.out);
        pg8::Gemm g{(const bf16_t*)(ws + OFF_P), (const bf16_t*)(ws + OFF_WUQ), TPAD, 768, 256, NPP, 256};
        pg8::StaticOrder S; S.init(TPAD, 768, G, blockIdx.x);
        Epi<1> E{(bf16_t*)(ob + DO_Q), 768, (const float*)(ws + OFF_RQ), nullptr, nullptr, nullptr, (const float2*)(ws + OFF_RT)};
        pg8::gemm_phase(lds, g, S, E);
    }
#endif
#if (PHASE_MASK & 4) && (SUB2 & 2)
    {
        unsigned char* ws = launder(p.ws); unsigned char* ob = launder((unsigned char*)p.out);
        pg8::Gemm g{(const bf16_t*)(ws + OFF_P) + 256, (const bf16_t*)(ws + OFF_WKN), TPAD, 512, 128, NPP, 128};
        pg8::StaticOrder S; S.init(TPAD, 512, G, blockIdx.x);
        Epi<2> E{(bf16_t*)(ob + DO_KN), 512, (const float*)(ws + OFF_RKV), nullptr, nullptr, nullptr, nullptr};
        pg8::gemm_phase(lds, g, S, E);
    }
#endif
#if (PHASE_MASK & 4) && (SUB2 & 4)
    {
        unsigned char* ws = launder(p.ws); unsigned char* ob = launder((unsigned char*)p.out);
        pg8::Gemm g{(const bf16_t*)(ws + OFF_WV), (const bf16_t*)(ws + OFF_P) + 256, 512, TPAD, 128, 128, NPP};
        pg8::StaticOrder S; S.init(512, TPAD, G, blockIdx.x);
        Epi<3> E{(bf16_t*)(ob + DO_VT), TPAD, (const float*)(ws + OFF_RKV), nullptr, nullptr, nullptr, nullptr};
        pg8::gemm_phase(lds, g, S, E);
    }
#endif
#if PHASE_MASK & 8
    hyprep_phase(p, lds);
#endif
    GSYNC();
#if DEBUG_CHECK == 2
    check_proj(p);
    GSYNC();
#endif
#if DEBUG_CHECK == 11
    check_filt_prep(p);
    GSYNC();
#endif
#if PHASE_MASK & 16
    attn_phase(p, lds);
#endif
#if PHASE_MASK & 32
    hyena_phase(p, lds);
#endif
    GSYNC();
#if DEBUG_CHECK == 5
    check_attn(p);
    check_hyena(p, lds);
    GSYNC();
#endif
#if PHASE_MASK & 64
    mixnorm_phase(p, lds);
#endif
    GSYNC();
#if PHASE_MASK & 128
    {
        unsigned char* ws = launder(p.ws);
        pg8::Gemm g{(const bf16_t*)(ws + OFF_MIXN), (const bf16_t*)(ws + OFF_WO), TN, 1024, 1024, 1024, 1024};
        pg8::StaticOrder S; S.init(TN, 1024, G, blockIdx.x);
        Epi<4> E{(bf16_t*)(ws + OFF_MIX), 1024, nullptr, (float*)(ws + OFF_SQMIXP), nullptr, nullptr, nullptr};
        pg8::gemm_phase(lds, g, S, E);
    }
#endif
    GSYNC();
#if DEBUG_CHECK == 1
    { unsigned char* ws = launder(p.ws); check_gemm((const bf16_t*)(ws + OFF_MIXN), 1024, (const bf16_t*)(ws + OFF_WO), 1024, 1024, TN, 1024, 4, (const bf16_t*)(ws + OFF_MIX), 1024, nullptr, (unsigned*)(ws + OFF_DBG) + 1, 0); }
#endif
#if DEBUG_CHECK == 10
    check_x(p, 1);
#endif
#if PHASE_MASK & 256
    h1_phase(p);
#endif
    GSYNC();
#if PHASE_MASK & 512
#if DEBUG_CHECK == 1
#define DBG_FF1(half) if ((half) == 0) { unsigned char* ws = launder(p.ws); check_gemm((const bf16_t*)(ws + OFF_H1B), 1024, (const bf16_t*)(ws + OFF_WF1), 1024, 1024, 65536, 4096, 5, (const bf16_t*)(ws + OFF_M), 4096, (const float*)(ws + OFF_R1), (unsigned*)(ws + OFF_DBG) + 2, 0); }
#define DBG_FF2(half) if ((half) == 0) { unsigned char* ws = launder(p.ws); check_gemm((const bf16_t*)(ws + OFF_M), 4096, (const bf16_t*)(ws + OFF_WF2), 4096, 4096, 65536, 1024, 6, (const bf16_t*)(ws + OFF_M2), 1024, nullptr, (unsigned*)(ws + OFF_DBG) + 3, 0); } GSYNC();
#else
#define DBG_FF1(half)
#define DBG_FF2(half)
#endif
#define FFN_HALF(half) \
    { \
        unsigned char* ws = launder(p.ws); \
        pg8::Gemm g{(const bf16_t*)(ws + OFF_H1B) + (size_t)(half) * 65536 * 1024, (const bf16_t*)(ws + OFF_WF1), 65536, 4096, 1024, 1024, 1024}; \
        pg8::StaticOrder S; S.init(65536, 4096, G, blockIdx.x); \
        Epi<5> E{(bf16_t*)(ws + OFF_M), 4096, (const float*)(ws + OFF_R1) + (half) * 65536, nullptr, nullptr, nullptr, nullptr}; \
        pg8::gemm_phase(lds, g, S, E); \
    } \
    GSYNC(); \
    DBG_FF1(half) \
    { \
        unsigned char* ws = launder(p.ws); \
        pg8::Gemm g{(const bf16_t*)(ws + OFF_M), (const bf16_t*)(ws + OFF_WF2), 65536, 1024, 4096, 4096, 4096}; \
        pg8::StaticOrder S; S.init(65536, 1024, G, blockIdx.x); \
        Epi<6> E{(bf16_t*)(ws + OFF_M2), 1024, nullptr, (float*)(ws + OFF_SQM2P) + (size_t)(half) * 65536 * 16, nullptr, nullptr, nullptr}; \
        pg8::gemm_phase(lds, g, S, E); \
    } \
    GSYNC(); \
    DBG_FF2(half) \
    final_phase(p, half);
    FFN_HALF(0)
    FFN_HALF(1)
#undef FFN_HALF
#endif
}

extern "C" void kernel_launch(void* const* d_in, const int* in_sizes, int n_in, void* d_out, int out_size, void* d_ws, size_t ws_size, hipStream_t stream) {
    static int grid = 0;
    if (grid == 0) {
        int dev = 0, cus = 0, per_cu = 0;
        hipGetDevice(&dev);
        hipDeviceGetAttribute(&cus, hipDeviceAttributeMultiprocessorCount, dev);
        hipFuncSetAttribute((const void*)hymba_fwd, hipFuncAttributeMaxDynamicSharedMemorySize, LDS_BYTES);
        hipOccupancyMaxActiveBlocksPerMultiprocessor(&per_cu, (const void*)hymba_fwd, 512, LDS_BYTES);
        if (per_cu < 1) per_cu = 1;
        grid = cus * 1;
        if (n_in != 26 || ws_size < 1024 * MiB) fprintf(stderr, "kernel_launch: unexpected n_in %d / ws_size %zu\n", n_in, ws_size);
    }
    Params p{};
    for (int i = 0; i < 26; ++i) p.in[i] = (const float*)d_in[i];
    p.out = (float*)d_out; p.ws = (unsigned char*)d_ws;
    void* args[] = {&p};
    hipError_t e = hipLaunchCooperativeKernel((const void*)hymba_fwd, dim3(grid), dim3(512), args, LDS_BYTES, stream);
    if (e != hipSuccess) fprintf(stderr, "cooperative launch failed: %s (grid %d)\n", hipGetErrorString(e), grid);
}
```

```cpp
#include <hip/hip_runtime.h>
#include <hip/hip_cooperative_groups.h>
#include <cstdio>
#include <cstdint>
namespace cg = cooperative_groups;
#ifndef DBG_SEL0
#define DBG_SEL0 3
#endif
#ifndef DBG_SEL1
#define DBG_SEL1 0
#endif
#ifndef DEBUG_CHECK
#define DEBUG_CHECK 0
#endif
#ifndef EXPT
#define EXPT 0
#endif
#ifndef SUB_MASK
#define SUB_MASK 15
#endif
#ifndef SUB2
#define SUB2 7
#endif

#define LAS __attribute__((address_space(3)))
#define GAS __attribute__((address_space(1)))
typedef unsigned short bf16_t;
typedef short bf16x8 __attribute__((ext_vector_type(8)));
typedef float f32x4 __attribute__((ext_vector_type(4)));
typedef float f32x16 __attribute__((ext_vector_type(16)));
typedef unsigned u32x4 __attribute__((ext_vector_type(4)));
typedef unsigned u32x2 __attribute__((ext_vector_type(2)));

constexpr int DM = 1024, LP = 8208, LS = 2064, NBP = 8, NBS = 32;
constexpr int TPR = NBP * LP;
constexpr int TSR = NBS * LS;
constexpr int T = TPR + TSR;
constexpr int TPAD = 131840;
constexpr int TN = 131072;
constexpr int NPP = 2048;
constexpr int LGP = 8256, LGS = 2112;
constexpr float EPS = 1e-6f;
constexpr float QSCALE = 0.07216878364870322f * 1.4426950408889634f;

constexpr size_t MiB = 1ull << 20;
constexpr size_t OFF_H0B = 0;
constexpr size_t XT_SET1 = (size_t)512 * NBP * LGP;
constexpr size_t OFF_X1T = 0;
constexpr size_t OFF_X2T = 131 * MiB;
constexpr size_t OFF_P = 262 * MiB;
constexpr size_t OFF_V0T = 778 * MiB;
constexpr size_t OFF_MIXN = 262 * MiB;
constexpr size_t OFF_MIX = 518 * MiB;
constexpr size_t OFF_H1B = 0;
constexpr size_t OFF_M = 256 * MiB;
constexpr size_t OFF_M2 = 768 * MiB;
constexpr size_t OFF_SQMIXP = 896 * MiB;
constexpr size_t OFF_SQM2P = 904 * MiB;
constexpr size_t OFF_SMALL = 912 * MiB;
constexpr size_t OFF_WIN = OFF_SMALL;
constexpr size_t OFF_WUQ = OFF_SMALL + 4 * MiB;
constexpr size_t OFF_WKN = OFF_SMALL + 4 * MiB + 512 * 1024;
constexpr size_t OFF_WV = OFF_SMALL + 4 * MiB + 768 * 1024;
constexpr size_t OFF_WO = OFF_SMALL + 5 * MiB;
constexpr size_t OFF_WF1 = OFF_SMALL + 7 * MiB;
constexpr size_t OFF_WF2 = OFF_SMALL + 15 * MiB;
constexpr size_t OFF_GR0 = OFF_SMALL + 23 * MiB;
constexpr size_t OFF_GR1 = OFF_SMALL + 56 * MiB;
constexpr size_t OFF_RT = OFF_SMALL + 65 * MiB;
constexpr size_t OFF_R0 = OFF_SMALL + 68 * MiB;
constexpr size_t OFF_R1 = OFF_SMALL + 69 * MiB;
constexpr size_t OFF_RQ = OFF_SMALL + 70 * MiB;
constexpr size_t OFF_RKV = OFF_SMALL + 71 * MiB;
constexpr size_t OFF_SQQP = OFF_SMALL + 72 * MiB;
constexpr size_t OFF_SQKVP = OFF_SMALL + 75 * MiB;
constexpr size_t OFF_DBGW = OFF_SMALL + 78 * MiB;
constexpr size_t DO_Q = 0;
constexpr size_t DO_KN = 194 * MiB;
constexpr size_t DO_KR = 323 * MiB;
constexpr size_t DO_VT = 340 * MiB;

constexpr size_t OFF_ODBG = 518 * MiB;
constexpr size_t OFF_HDBG = 647 * MiB;
constexpr int LDS_BYTES = 147456;

struct Params {
    const float* in[26];
    float* out;
    unsigned char* ws;
};

__device__ __forceinline__ f32x4 ld_sys(const float* q) { f32x4 v; asm volatile("global_load_dwordx4 %0, %1, off sc0 sc1\n\ts_waitcnt vmcnt(0)" : "=v"(v) : "v"(q) : "memory"); return v; }
__device__ __forceinline__ float ldco(const float* q) { return __builtin_bit_cast(float, __hip_atomic_load((const unsigned*)q, __ATOMIC_RELAXED, __HIP_MEMORY_SCOPE_AGENT)); }
__device__ __forceinline__ float2 ldco2(const float2* q) { const unsigned long long w = __hip_atomic_load((const unsigned long long*)q, __ATOMIC_RELAXED, __HIP_MEMORY_SCOPE_AGENT); return make_float2(__builtin_bit_cast(float, (unsigned)w), __builtin_bit_cast(float, (unsigned)(w >> 32))); }
template <class Tp> __device__ __forceinline__ Tp* launder(Tp* q) { asm volatile("" : "+s"(q)); return q; }
__device__ __forceinline__ int tid_l() { int t = threadIdx.x; asm volatile("" : "+v"(t)); return t; }
__device__ __forceinline__ unsigned cvt_pk_bf16(float lo, float hi) { unsigned r; asm volatile("v_cvt_pk_bf16_f32 %0, %1, %2" : "=v"(r) : "v"(lo), "v"(hi)); return r; }
__device__ __forceinline__ float bf2f(unsigned short b) { return __builtin_bit_cast(float, (unsigned)b << 16); }
__device__ __forceinline__ float bflo(unsigned w) { return __builtin_bit_cast(float, w << 16); }
__device__ __forceinline__ float bfhi(unsigned w) { return __builtin_bit_cast(float, w & 0xffff0000u); }
__device__ __forceinline__ float wave_sum(float v) {
#pragma unroll
    for (int o = 1; o < 64; o <<= 1) v += __shfl_xor(v, o);
    return v;
}
__device__ __forceinline__ void sincos_red(float x, float& s, float& c) {
    const double xd = (double)x; const double k = rint(xd * 0.15915494309189535); const float r = (float)(xd - k * 6.283185307179586);
    s = __sinf(r); c = __cosf(r);
}
__device__ __forceinline__ float sin_red(float x) { float s, c; sincos_red(x, s, c); return s; }
__device__ __forceinline__ void row_info(int r, int& pos, int& seq) {
    if (r < TPR) { seq = r / LP; pos = r - seq * LP; }
    else { int q = r - TPR; if (q >= TSR) q = TSR - 1; const int b = q / LS; pos = q - b * LS; seq = NBP + b; }
}
__device__ __forceinline__ int full_row(int n) {
    if (n < 65536) { const int b = n >> 13; return b * LP + 16 + (n & 8191); }
    const int q = n - 65536; const int b = q >> 11; return TPR + b * LS + 16 + (q & 2047);
}

namespace pg8 {
constexpr int BM = 256, BK = 64, HALF = 128, HTB = HALF * BK * 2, STAGE_BYTES = 8 * HTB, NXCD = 8, WGM = 8;
__host__ __device__ __forceinline__ int lds_byte(int r, int c) { const int st = (r >> 4) * 2 + (c >> 5), rr = r & 15, cc = c & 31, ob = rr * 64 + cc * 2; return st * 1024 + (ob ^ (((ob >> 9) & 1) << 5)); }
__host__ __device__ __forceinline__ void stage_rc(int b, int& R, int& C) { const int st = b / 1024, sb = b % 1024, swz = sb ^ (((sb >> 9) & 1) << 5); R = (st >> 1) * 16 + swz / 64; C = (st & 1) * 32 + (swz % 64) / 2; }
__host__ __device__ __forceinline__ int perm32(int rho) { const int n = rho >> 4, i = rho & 15; return 8 * (i >> 2) + 4 * n + (i & 3); }
struct Unit { int pm, pn; };
struct Gemm { const bf16_t* A; const bf16_t* Bt; int M, N, K, lda, ldb; };
struct StaticOrder {
    int nM, nN, nwg, G, c;
    __device__ void init(int M, int N, int G_, int c_) { nM = M / BM; nN = N / BM; nwg = nM * nN; G = G_; c = c_; }
    __device__ bool next(int i, Unit& u) const {
        const long L = (long)i * G + c; if (L >= nwg) return false;
        int wgid = (int)L; { const int q = nwg / NXCD, r = nwg % NXCD, xcd = wgid % NXCD, off = wgid / NXCD; wgid = (xcd < r ? xcd * (q + 1) : r * (q + 1) + (xcd - r) * q) + off; }
        const int nig = WGM * nN, gid = wgid / nig, fm = gid * WGM, gsz = (nM - fm) < WGM ? (nM - fm) : WGM;
        u.pm = fm + ((wgid % nig) % gsz); u.pn = (wgid % nig) / gsz; return true;
    }
};
template <class Epi>
__device__ __forceinline__ void gemm_phase(LAS unsigned char* lds, const Gemm g, const StaticOrder& S, const Epi& E) {
    const int tid = tid_l(), wid = __builtin_amdgcn_readfirstlane(tid >> 6), lane = tid & 63, wr = wid >> 2, wc = wid & 3, fr = lane & 15, fq = lane >> 4;
    const int K = g.K, nt = K / BK;
    unsigned voffA[2], voffB[2];
#pragma unroll
    for (int i = 0; i < 2; ++i) { int R, C; stage_rc(tid * 16 + i * 8192, R, C); const int Rb = (R & ~31) + perm32(R & 31);
        voffA[i] = (unsigned)(R * g.lda + C) * 2u; voffB[i] = (unsigned)(Rb * g.ldb + C) * 2u; }
    const size_t kstep = (size_t)(BK * 2);
    const size_t hstepA = (size_t)HALF * g.lda * 2, hstepB = (size_t)HALF * g.ldb * 2;
    const size_t tstepA = 2 * hstepA, tstepB = 2 * hstepB;
    const unsigned ldsw = (unsigned)wid * 1024u;
    const int aoff = lds_byte(wr * 64 + fr, fq * 8), boff = lds_byte(wc * 32 + fr, fq * 8);
#define PG8_SA(b, h) (((b) * 2 + (h)) * HTB)
#define PG8_SB(b, h) ((4 + (b) * 2 + (h)) * HTB)
#define PG8_STAGE(bufoff, gbase, voff) do { _Pragma("unroll") for (int _i = 0; _i < 2; ++_i) \
        __builtin_amdgcn_global_load_lds((const unsigned*)((const char*)(gbase) + (voff)[_i]), (LAS unsigned*)(lds + (bufoff) + ldsw + _i * 8192), 16, 0, 0); } while (0)
#define PG8_LDA(dst, b, h) do { _Pragma("unroll") for (int m = 0; m < 4; ++m) _Pragma("unroll") for (int k = 0; k < 2; ++k) dst[m][k] = *(const LAS bf16x8*)(lds + PG8_SA(b, h) + aoff + m * 2048 + k * 1024); } while (0)
#define PG8_LDB(dst, b, h) do { _Pragma("unroll") for (int n = 0; n < 2; ++n) _Pragma("unroll") for (int k = 0; k < 2; ++k) dst[n][k] = *(const LAS bf16x8*)(lds + PG8_SB(b, h) + boff + n * 2048 + k * 1024); } while (0)
#define PG8_MMA(ai, bj, At, Bt) do { __builtin_amdgcn_s_setprio(1); _Pragma("unroll") for (int m = 0; m < 4; ++m) _Pragma("unroll") for (int n = 0; n < 2; ++n) _Pragma("unroll") for (int k = 0; k < 2; ++k) \
        acc[ai][bj][m][n] = __builtin_amdgcn_mfma_f32_16x16x32_bf16(Bt[n][k], At[m][k], acc[ai][bj][m][n], 0, 0, 0); __builtin_amdgcn_s_setprio(0); } while (0)
#define PG8_WAIT_V(n) asm volatile("s_waitcnt vmcnt(" #n ")" ::: "memory")
#define PG8_WAIT_L(n) asm volatile("s_waitcnt lgkmcnt(" #n ")" ::: "memory")
#define PG8_BAR __builtin_amdgcn_s_barrier()
#define PG8_SCHED __builtin_amdgcn_sched_barrier(0)
    Unit cur, nxt; int ui = 0;
    if (!S.next(0, cur)) return;
    f32x4 acc[2][2][4][2];
#pragma unroll
    for (int a = 0; a < 2; ++a)
#pragma unroll
        for (int b = 0; b < 2; ++b)
#pragma unroll
            for (int m = 0; m < 4; ++m)
#pragma unroll
                for (int n = 0; n < 2; ++n) acc[a][b][m][n] = (f32x4){0.f, 0.f, 0.f, 0.f};
    bf16x8 At[4][2], B0[2][2], B1[2][2];
    const char* cA = (const char*)g.A + (size_t)cur.pm * tstepA; const char* cB = (const char*)g.Bt + (size_t)cur.pn * tstepB;
    PG8_STAGE(PG8_SB(0, 0), cB, voffB); PG8_STAGE(PG8_SB(0, 1), cB + hstepB, voffB); PG8_STAGE(PG8_SA(0, 0), cA, voffA); PG8_STAGE(PG8_SA(0, 1), cA + hstepA, voffA);
    if (wr == 1) PG8_BAR;
    PG8_WAIT_V(2); PG8_BAR;
    PG8_STAGE(PG8_SB(1, 0), cB + kstep, voffB); PG8_STAGE(PG8_SA(1, 0), cA + kstep, voffA); PG8_STAGE(PG8_SB(1, 1), cB + hstepB + kstep, voffB);
    PG8_WAIT_V(6); PG8_BAR;
    for (;;) {
        const bool has_next = S.next(ui + 1, nxt);
        const char* nA = has_next ? (const char*)g.A + (size_t)nxt.pm * tstepA : cA; const char* nB = has_next ? (const char*)g.Bt + (size_t)nxt.pn * tstepB : cB;
        for (int t = 0; t < nt; t += 2) {
            const bool last = (t == nt - 2);
            const char* a1 = cA + (size_t)(t + 1) * kstep;
            const char* a2 = last ? nA : cA + (size_t)(t + 2) * kstep; const char* b2 = last ? nB : cB + (size_t)(t + 2) * kstep;
            const char* a3 = a2 + kstep; const char* b3 = b2 + kstep;
            PG8_LDB(B0, 0, 0); PG8_LDB(B1, 0, 1); PG8_SCHED; PG8_LDA(At, 0, 0); PG8_STAGE(PG8_SA(1, 1), a1 + hstepA, voffA);
            PG8_WAIT_V(8); PG8_WAIT_L(0); PG8_BAR; PG8_MMA(0, 0, At, B0); PG8_MMA(0, 1, At, B1); PG8_BAR; PG8_SCHED;
            PG8_LDA(At, 0, 1); PG8_STAGE(PG8_SB(0, 0), b2, voffB); PG8_STAGE(PG8_SB(0, 1), b2 + hstepB, voffB); PG8_STAGE(PG8_SA(0, 0), a2, voffA);
            PG8_WAIT_V(8); PG8_WAIT_L(0); PG8_BAR; PG8_MMA(1, 0, At, B0); PG8_MMA(1, 1, At, B1); PG8_BAR; PG8_SCHED;
            PG8_LDB(B0, 1, 0); PG8_LDB(B1, 1, 1); PG8_SCHED; PG8_LDA(At, 1, 0); PG8_STAGE(PG8_SA(0, 1), a2 + hstepA, voffA);
            PG8_WAIT_V(8); PG8_WAIT_L(0); PG8_BAR; PG8_MMA(0, 0, At, B0); PG8_MMA(0, 1, At, B1); PG8_BAR; PG8_SCHED;
            PG8_LDA(At, 1, 1); PG8_STAGE(PG8_SB(1, 0), b3, voffB); PG8_STAGE(PG8_SB(1, 1), b3 + hstepB, voffB); PG8_STAGE(PG8_SA(1, 0), a3, voffA);
            PG8_WAIT_V(8); PG8_WAIT_L(0); PG8_BAR; PG8_MMA(1, 0, At, B0); PG8_MMA(1, 1, At, B1); PG8_BAR; PG8_SCHED;
        }
        if (wr == 0) PG8_BAR;
        E(acc, cur, wr, wc, fr, fq);
        if (!has_next) break;
#pragma unroll
        for (int a = 0; a < 2; ++a)
#pragma unroll
            for (int b = 0; b < 2; ++b)
#pragma unroll
                for (int m = 0; m < 4; ++m)
#pragma unroll
                    for (int n = 0; n < 2; ++n) acc[a][b][m][n] = (f32x4){0.f, 0.f, 0.f, 0.f};
        cur = nxt; cA = nA; cB = nB; ++ui;
        if (wr == 1) PG8_BAR;
    }
    PG8_WAIT_V(0);
    PG8_BAR;
#undef PG8_SA
#undef PG8_SB
#undef PG8_STAGE
#undef PG8_LDA
#undef PG8_LDB
#undef PG8_MMA
#undef PG8_WAIT_V
#undef PG8_WAIT_L
#undef PG8_BAR
#undef PG8_SCHED
}
}

__device__ __forceinline__ void rope8(f32x4& v0, f32x4& v1, const float2* rt  ) {
    const float2 c0 = ldco2(rt), c1 = ldco2(rt + 1), c2 = ldco2(rt + 2), c3 = ldco2(rt + 3);
    float a, b;
    a = v0[0]; b = v0[1]; v0[0] = a * c0.x - b * c0.y; v0[1] = b * c0.x + a * c0.y;
    a = v0[2]; b = v0[3]; v0[2] = a * c1.x - b * c1.y; v0[3] = b * c1.x + a * c1.y;
    a = v1[0]; b = v1[1]; v1[0] = a * c2.x - b * c2.y; v1[1] = b * c2.x + a * c2.y;
    a = v1[2]; b = v1[3]; v1[2] = a * c3.x - b * c3.y; v1[3] = b * c3.x + a * c3.y;
}
__device__ __forceinline__ u32x4 pack8(const f32x4& v0, const f32x4& v1) {
    u32x4 w; w.x = cvt_pk_bf16(v0[0], v0[1]); w.y = cvt_pk_bf16(v0[2], v0[3]); w.z = cvt_pk_bf16(v1[0], v1[1]); w.w = cvt_pk_bf16(v1[2], v1[3]); return w;
}
__device__ __forceinline__ float sq8(const f32x4& a, const f32x4& b) {
    return (a[0] * a[0] + a[1] * a[1]) + (a[2] * a[2] + a[3] * a[3]) + (b[0] * b[0] + b[1] * b[1]) + (b[2] * b[2] + b[3] * b[3]);
}
template <int MODE> struct Epi {
    bf16_t* O; int ldc; const float* rs; float* sq0; float* sq1; bf16_t* KR; const float2* RT;
    __device__ __forceinline__ void operator()(const f32x4 (&acc)[2][2][4][2], const pg8::Unit& u, int wr, int wc, int fr, int fq) const {
#pragma unroll
        for (int ai = 0; ai < 2; ++ai)
#pragma unroll
            for (int m = 0; m < 4; ++m) {
                const int row = u.pm * 256 + ai * 128 + wr * 64 + m * 16 + fr;
                float sc = 1.f;
                if (MODE == 0 || MODE == 1 || MODE == 2 || MODE == 5) sc = ldco(rs + row);
                float ssum[2];
#pragma unroll
                for (int bj = 0; bj < 2; ++bj) {
                    const int col0 = u.pn * 256 + bj * 128 + wc * 32 + 8 * fq;
                    f32x4 v0 = acc[ai][bj][m][0] * sc, v1 = acc[ai][bj][m][1] * sc;
                    if (MODE == 3) {
#pragma unroll
                        for (int j = 0; j < 4; ++j) { v0[j] *= ldco(rs + col0 + j); v1[j] *= ldco(rs + col0 + 4 + j); }
                    }
                    if (MODE == 5) {
#pragma unroll
                        for (int j = 0; j < 4; ++j) { const float a = fmaxf(v0[j], 0.f), b = fmaxf(v1[j], 0.f); v0[j] = a * a; v1[j] = b * b; }
                    }
                    ssum[bj] = sq8(v0, v1);
                    *(u32x4*)(O + (size_t)row * ldc + col0) = pack8(v0, v1);
                }
                if (MODE == 0) {
                    if (u.pn == 0) { float s = ssum[0] + ssum[1]; s += __shfl_xor(s, 16); s += __shfl_xor(s, 32); if (fq == 0) sq0[row * 4 + wc] = s; }
                    else if (u.pn == 1) { float s = ssum[0]; s += __shfl_xor(s, 16); s += __shfl_xor(s, 32); if (fq == 0) sq1[row * 4 + wc] = s; }
                }
                if (MODE == 4 || MODE == 6) { float s = ssum[0] + ssum[1]; s += __shfl_xor(s, 16); s += __shfl_xor(s, 32); if (fq == 0) sq0[(size_t)row * 16 + u.pn * 4 + wc] = s; }
            }
    }
};

__device__ __forceinline__ int src_col(int mode, int n) {
    if (mode == 0) return n;
    if (mode == 1) { if (n >= 1984) return -1; if (n >= 384 && n < 448) { const int j = n - 384; return 384 + ((j & 1) ? 32 + (j >> 1) : (j >> 1)); } return n; }
    if (mode == 2) { const int h = n / 192, w = n % 192; if (w < 128) return n; const int j = w - 128; return h * 192 + 128 + ((j & 1) ? 32 + (j >> 1) : (j >> 1)); }
    if (mode == 3) return (n >> 7) * 256 + (n & 127);
    return (n >> 7) * 256 + 128 + (n & 127);
}
__device__ __forceinline__ void conv_weight(const float* W, const float* g, bf16_t* out, int K, int Nsrc, int Nout, int mode, int gtid, int gthreads) {
    const int nch = Nout * (K / 8);
    for (int e = gtid; e < nch; e += gthreads) {
        const int n = e % Nout, kc = e / Nout, k0 = kc * 8; const int sc = src_col(mode, n);
        float v[8];
#pragma unroll
        for (int j = 0; j < 8; ++j) v[j] = (sc >= 0) ? W[(size_t)(k0 + j) * Nsrc + sc] * (g ? g[k0 + j] : 1.f) : 0.f;
        u32x4 w; w.x = cvt_pk_bf16(v[0], v[1]); w.y = cvt_pk_bf16(v[2], v[3]); w.z = cvt_pk_bf16(v[4], v[5]); w.w = cvt_pk_bf16(v[6], v[7]);
        *(u32x4*)(out + (size_t)n * K + k0) = w;
    }
}

__device__ __forceinline__ void p0_prologue(const Params& p, LAS unsigned char* lds) {
    unsigned char* ws = launder(p.ws);
    const int tid = tid_l(), lane = tid & 63, wave = tid >> 6, G = gridDim.x;
    const int gtid = blockIdx.x * 512 + tid, gthreads = G * 512;
    const int gw = blockIdx.x * 8 + wave, NGW = G * 8;
#if SUB_MASK & 1
    conv_weight(p.in[4], p.in[3], (bf16_t*)(ws + OFF_WIN), 1024, 1984, 2048, 1, gtid, gthreads);
    conv_weight(p.in[6], p.in[5], (bf16_t*)(ws + OFF_WUQ), 256, 768, 768, 2, gtid, gthreads);
    conv_weight(p.in[8], p.in[7], (bf16_t*)(ws + OFF_WKN), 128, 1024, 512, 3, gtid, gthreads);
    conv_weight(p.in[8], p.in[7], (bf16_t*)(ws + OFF_WV), 128, 1024, 512, 4, gtid, gthreads);
    conv_weight(p.in[20], nullptr, (bf16_t*)(ws + OFF_WO), 1024, 1024, 1024, 0, gtid, gthreads);
    conv_weight(p.in[23], p.in[22], (bf16_t*)(ws + OFF_WF1), 1024, 4096, 4096, 0, gtid, gthreads);
    conv_weight(p.in[24], nullptr, (bf16_t*)(ws + OFF_WF2), 4096, 1024, 1024, 0, gtid, gthreads);
#endif
#if SUB_MASK & 2
#if DEBUG_CHECK
    if (blockIdx.x == 0 && tid < 64) ((unsigned*)(ws + OFF_DBGW))[tid] = 0u;
#endif
    {
        float2* RT = (float2*)(ws + OFF_RT);
        for (int e = gtid; e < LP * 32; e += gthreads) {
            const int pos = e >> 5, i = e & 31;
            const float inv = 1.0f / exp2f((float)i * (13.287712379549449f / 32.f));
            float s, c; sincos_red((float)pos * inv, s, c);
            RT[e] = make_float2(c, s);
        }
    }
#endif
#if SUB_MASK & 4
    {
        bf16_t* h0b = (bf16_t*)(ws + OFF_H0B); float* r0 = (float*)(ws + OFF_R0);
        for (int r = gw; r < TPAD; r += NGW) {
            u32x2* o = (u32x2*)(h0b + (size_t)r * 1024) + lane;
            if (r >= T) {
#pragma unroll
                for (int j = 0; j < 4; ++j) o[64 * j] = (u32x2){0u, 0u};
                if (lane == 0) __hip_atomic_store(r0 + r, 0.f, __ATOMIC_RELAXED, __HIP_MEMORY_SCOPE_AGENT);
                continue;
            }
            int pos, seq; row_info(r, pos, seq);
            const float* src = pos < 16 ? p.in[2] + (size_t)pos * 1024
                                        : (seq < NBP ? p.in[0] + ((size_t)seq * 8192 + (pos - 16)) * 1024 : p.in[1] + ((size_t)(seq - NBP) * 2048 + (pos - 16)) * 1024);
            const f32x4* xr = (const f32x4*)src + lane;
            f32x4 v[4]; float ss = 0.f;
#pragma unroll
            for (int j = 0; j < 4; ++j) { v[j] = xr[64 * j]; ss += (v[j][0] * v[j][0] + v[j][1] * v[j][1]) + (v[j][2] * v[j][2] + v[j][3] * v[j][3]); }
            ss = wave_sum(ss);
#pragma unroll
            for (int j = 0; j < 4; ++j) o[64 * j] = (u32x2){cvt_pk_bf16(v[j][0], v[j][1]), cvt_pk_bf16(v[j][2], v[j][3])};
            if (lane == 0) __hip_atomic_store(r0 + r, rsqrtf(ss * (1.f / 1024.f) + EPS), __ATOMIC_RELAXED, __HIP_MEMORY_SCOPE_AGENT);
        }
    }
#endif
#if SUB_MASK & 8
    {
        const float* f_w1 = p.in[10]; const float* f_b1 = p.in[11]; const float* f_freq = p.in[12]; const float* f_w2 = p.in[13];
        const float* f_b2 = p.in[14]; const float* f_w3 = p.in[15]; const float* f_decay = p.in[16];
        LAS float* feats = (LAS float*)lds;
        LAS float* h1 = feats + 16 * 34;
        LAS float* h2 = h1 + 16 * 64;
        for (int u = blockIdx.x; u < 513 + 129; u += G) {
            const int set = u < 513 ? 0 : 1; const int t0 = 16 * (set ? u - 513 : u); const int L = set ? LS : LP; const int C0 = set ? LGS : LGP;
            bf16_t* GR = (bf16_t*)(ws + (set ? OFF_GR1 : OFF_GR0));
            const float invLm1 = 1.0f / (float)(L - 1);
            if (tid < 256) {
                const int tt = tid >> 4, k = tid & 15; const int t = t0 + tt;
                const float w = (6.2831853071795865f * (float)t) / (float)L;
                const float f = 1e-4f + (float)k * ((15.0f - 1e-4f) / 15.0f);
                float s, c; sincos_red(f * w, s, c);
                feats[tt * 34 + 1 + k] = c; feats[tt * 34 + 17 + k] = -s;
                if (k == 0) feats[tt * 34] = (float)t * invLm1;
            }
            __syncthreads();
#pragma unroll 1
            for (int q = 0; q < 2; ++q) {
                const int o = tid + 512 * q, tt = o >> 6, j = o & 63;
                float a = f_b1[j];
#pragma unroll 3
                for (int e = 0; e < 33; ++e) a += feats[tt * 34 + e] * f_w1[e * 64 + j];
                h1[tt * 64 + j] = sin_red(f_freq[j] * a);
            }
            __syncthreads();
#pragma unroll 1
            for (int q = 0; q < 2; ++q) {
                const int o = tid + 512 * q, tt = o >> 6, j = o & 63;
                float a = f_b2[j];
#pragma unroll 4
                for (int e = 0; e < 64; ++e) a += h1[tt * 64 + e] * f_w2[e * 64 + j];
                h2[tt * 64 + j] = sin_red(f_freq[j] * a);
            }
            __syncthreads();
            {
                float a[4][16];
#pragma unroll
                for (int q = 0; q < 4; ++q)
#pragma unroll
                    for (int i = 0; i < 16; ++i) a[q][i] = 0.f;
#pragma unroll 2
                for (int j = 0; j < 64; ++j) {
                    float hv[16];
#pragma unroll
                    for (int i = 0; i < 16; ++i) hv[i] = h2[i * 64 + j];
#pragma unroll
                    for (int q = 0; q < 4; ++q) {
                        const float w = f_w3[j * 2048 + tid + 512 * q];
#pragma unroll
                        for (int i = 0; i < 16; ++i) a[q][i] += hv[i] * w;
                    }
                }
#pragma unroll
                for (int q = 0; q < 4; ++q) {
                    const int n = tid + 512 * q;
                    const float dec = fabsf(f_decay[n]);
                    const int order = n >> 10, dir = (n >> 9) & 1, c = n & 511;
                    bf16_t* row = GR + (size_t)(order * 512 + c) * (2 * C0);
#pragma unroll
                    for (int i = 0; i < 16; ++i) {
                        const int t = t0 + i;
                        const float val = a[q][i] * __expf(-((float)t * invLm1) * dec);
                        const unsigned short b = (unsigned short)(cvt_pk_bf16(val, 0.f) & 0xffffu);
                        if (dir == 0) row[C0 - t] = b; else if (t > 0) row[C0 + t] = b;
                    }
                }
            }
            __syncthreads();
        }
        for (int e = gtid; e < 2 * 1024 * 97; e += gthreads) {
            const int set = e / (1024 * 97), r = (e / 97) % 1024, i = e % 97; const int L = set ? LS : LP; const int C0 = set ? LGS : LGP;
            bf16_t* row = (bf16_t*)(ws + (set ? OFF_GR1 : OFF_GR0)) + (size_t)r * (2 * C0);
            const int idx = i < 49 ? i : C0 + L + (i - 49);
            row[idx] = 0;
        }
    }
#endif
}

__device__ __forceinline__ void rownorm_phase(const Params& p) {
    unsigned char* ws = launder(p.ws); const int gtid = blockIdx.x * 512 + tid_l(), gthreads = gridDim.x * 512;
    const float* sqq = (const float*)(ws + OFF_SQQP); const float* sqkv = (const float*)(ws + OFF_SQKVP);
    float* rq = (float*)(ws + OFF_RQ); float* rkv = (float*)(ws + OFF_RKV);
    for (int r = gtid; r < TPAD; r += gthreads) {
        const float a = (ldco(sqq + r * 4) + ldco(sqq + r * 4 + 1)) + (ldco(sqq + r * 4 + 2) + ldco(sqq + r * 4 + 3));
        const float b = (ldco(sqkv + r * 4) + ldco(sqkv + r * 4 + 1)) + (ldco(sqkv + r * 4 + 2) + ldco(sqkv + r * 4 + 3));
        rq[r] = rsqrtf(a * (1.f / 256.f) + EPS) * QSCALE; rkv[r] = rsqrtf(b * (1.f / 128.f) + EPS);
    }
}
__device__ __forceinline__ void krope_phase(const Params& p) {
    unsigned char* ws = launder(p.ws); unsigned char* ob = launder((unsigned char*)p.out);
    const int gtid = blockIdx.x * 512 + tid_l(), gthreads = gridDim.x * 512;
    const bf16_t* P = (const bf16_t*)(ws + OFF_P); bf16_t* KR = (bf16_t*)(ob + DO_KR); const float2* RT = (const float2*)(ws + OFF_RT);
    for (int e = gtid; e < TPAD * 8; e += gthreads) {
        const int row = e >> 3, ch = e & 7;
        int pos, seq; row_info(row, pos, seq);
        const u32x4 v = *(const u32x4*)(P + (size_t)row * NPP + 384 + ch * 8);
        f32x4 v0 = (f32x4){bflo(v.x), bfhi(v.x), bflo(v.y), bfhi(v.y)}, v1 = (f32x4){bflo(v.z), bfhi(v.z), bflo(v.w), bfhi(v.w)};
        rope8(v0, v1, RT + pos * 32 + ch * 4);
        *(u32x4*)(KR + (size_t)row * 64 + ch * 8) = pack8(v0, v1);
    }
}
__device__ __forceinline__ void hyprep_phase(const Params& p, LAS unsigned char* lds) {
    unsigned char* ws = launder(p.ws); const int tid = tid_l(), G = gridDim.x;
    const bf16_t* P = (const bf16_t*)(ws + OFF_P); const float* conv_w = p.in[9];
    constexpr int RSB = 1040;
    for (int u = blockIdx.x; u < 3096 + 3168; u += G) {
        int seq, j, which;
        if (u < 3096) { seq = u / 387; const int rem = u % 387; j = rem / 3; which = rem % 3; }
        else { const int v = u - 3096; seq = NBP + v / 99; const int rem = v % 99; j = rem / 3; which = rem % 3; }
        const int set = seq < NBP ? 0 : 1; const int L = set ? LS : LP; const int Lg = set ? LGS : LGP; const int NB = set ? NBS : NBP;
        const int b = set ? seq - NBP : seq; const int row0 = set ? TPR + b * LS : b * LP;
        const int posb = 64 * j - 49;
        for (int i = 0; i < 9; ++i) {
            const int id = tid + 512 * i; if (id >= 66 * 64) break;
            const int rr = id >> 6, ch = id & 63; const int pos = posb + rr;
            u32x4 v = (u32x4){0u, 0u, 0u, 0u};
            if (pos >= 0 && pos < L) v = *(const GAS u32x4*)(P + (size_t)(row0 + pos) * NPP + 448 + which * 512 + ch * 8);
            *(LAS u32x4*)(lds + rr * RSB + ch * 16) = v;
        }
        __syncthreads();
        {
            const int c = tid; const float w0 = conv_w[which * 512 + c], w1 = conv_w[1536 + which * 512 + c], w2 = conv_w[3072 + which * 512 + c];
            bf16_t* XT = (bf16_t*)(ws + (which == 0 ? OFF_X1T : (which == 1 ? OFF_X2T : OFF_V0T))) + (set ? XT_SET1 : 0) + ((size_t)c * NB + b) * Lg + 64 * j;
            const LAS unsigned short* tl = (const LAS unsigned short*)lds + c;
            float prev = bf2f(tl[0]), cur = bf2f(tl[RSB / 2]);
            for (int o8 = 0; o8 < 8; ++o8) {
                float r[8];
#pragma unroll
                for (int k = 0; k < 8; ++k) {
                    const int o = o8 * 8 + k; const float nxt = bf2f(tl[(o + 2) * (RSB / 2)]);
                    const int pos = posb + 1 + o;
                    r[k] = (pos >= 0 && pos < L) ? (prev * w0 + cur * w1 + nxt * w2) : 0.f;
                    prev = cur; cur = nxt;
                }
                u32x4 w; w.x = cvt_pk_bf16(r[0], r[1]); w.y = cvt_pk_bf16(r[2], r[3]); w.z = cvt_pk_bf16(r[4], r[5]); w.w = cvt_pk_bf16(r[6], r[7]);
                *(GAS u32x4*)(XT + o8 * 8) = w;
            }
        }
        __syncthreads();
    }
}

__device__ __forceinline__ f32x16 mfma32(bf16x8 a, bf16x8 b, f32x16 c) { return __builtin_amdgcn_mfma_f32_32x32x16_bf16(a, b, c, 0, 0, 0); }

__device__ __forceinline__ void attn_phase(const Params& p, LAS unsigned char* lds) {
    const int tid = tid_l(), lane = tid & 63, wave = tid >> 6, G = gridDim.x, h = lane >> 5, l32 = lane & 31;
    unsigned char* ob = launder((unsigned char*)p.out);
    bf16_t* Q = (bf16_t*)(ob + DO_Q);
    const bf16_t* KN = (const bf16_t*)(ob + DO_KN);
    const bf16_t* KR = (const bf16_t*)(ob + DO_KR);
    const bf16_t* VT = (const bf16_t*)(ob + DO_VT);
    constexpr int KROW = 400, VROW = 136, KBYTES = 64 * KROW, BUFB = KBYTES + 128 * VROW;
    for (int u = blockIdx.x; u < 2048; u += G) {
        int seq, head, qb;
        if (u < 1024) { seq = u >> 7; head = (u >> 5) & 3; qb = u & 31; } else { const int v = u - 1024; seq = NBP + (v >> 5); head = (v >> 3) & 3; qb = v & 7; }
        const int L = seq < NBP ? LP : LS; const int row0 = seq < NBP ? seq * LP : TPR + (seq - NBP) * LS;
        const int ntiles = (L + 63) >> 6;
        const int qrow = row0 + 16 + qb * 256 + wave * 32 + l32;
        bf16x8 qf[12];
#pragma unroll
        for (int ks = 0; ks < 12; ++ks) qf[ks] = *(const GAS bf16x8*)(Q + (size_t)qrow * 768 + head * 192 + 16 * ks + 8 * h);
        {
            const float2* RT = (const float2*)(launder(p.ws) + OFF_RT);
            const int qpos = 16 + qb * 256 + wave * 32 + l32;
#pragma unroll
            for (int ks = 8; ks < 12; ++ks) {
                const u32x4 v = __builtin_bit_cast(u32x4, qf[ks]);
                f32x4 v0 = (f32x4){bflo(v.x), bfhi(v.x), bflo(v.y), bfhi(v.y)}, v1 = (f32x4){bflo(v.z), bfhi(v.z), bflo(v.w), bfhi(v.w)};
                rope8(v0, v1, RT + qpos * 32 + 8 * (ks - 8) + 4 * h);
                qf[ks] = __builtin_bit_cast(bf16x8, pack8(v0, v1));
            }
        }
        const int kkey0 = tid >> 4, kch0 = tid & 15;
        const int rkey = tid >> 3, rch = tid & 7;
        const int vdv0 = tid >> 3, vch = tid & 7;
        const unsigned kn_off = (unsigned)(kkey0 * 512 + head * 128 + kch0 * 8) * 2u;
        const unsigned kr_off = (unsigned)(rkey * 64 + rch * 8) * 2u;
        const unsigned vt_off = (unsigned)(vdv0 * TPAD + vch * 8) * 2u;
        const unsigned char* knb = (const unsigned char*)KN + (size_t)row0 * 1024;
        const unsigned char* krb = (const unsigned char*)KR + (size_t)row0 * 128;
        const unsigned char* vtb = (const unsigned char*)VT + ((size_t)head * 128 * TPAD + row0) * 2;
        u32x4 g0, g1, g2, g3, g4;
#define ATT_LOAD(tile) do { const unsigned char* kb__ = knb + (size_t)(tile) * 65536; const unsigned char* rb__ = krb + (size_t)(tile) * 8192; const unsigned char* vb__ = vtb + (size_t)(tile) * 128; \
        g0 = *(const GAS u32x4*)(kb__ + kn_off); g1 = *(const GAS u32x4*)(kb__ + 32768 + kn_off); \
        g2 = *(const GAS u32x4*)(rb__ + kr_off); (void)vb__; } while (0)
#define ATT_LOADV(tile) do { const unsigned char* vb__ = vtb + (size_t)(tile) * 128; g3 = *(const GAS u32x4*)(vb__ + vt_off); g4 = *(const GAS u32x4*)(vb__ + (size_t)64 * TPAD * 2 + vt_off); } while (0)
#define ATT_STOREK(buf) do { LAS unsigned char* kb_ = lds + (buf) * BUFB; \
        *(LAS u32x4*)(kb_ + kkey0 * KROW + kch0 * 16) = g0; *(LAS u32x4*)(kb_ + (kkey0 + 32) * KROW + kch0 * 16) = g1; \
        *(LAS u32x4*)(kb_ + rkey * KROW + 256 + rch * 16) = g2; } while (0)
#define ATT_STORE(buf) do { LAS unsigned char* vb_ = lds + (buf) * BUFB + KBYTES; \
        *(LAS u32x2*)(vb_ + vdv0 * VROW + vch * 16) = (u32x2){g3.x, g3.y}; *(LAS u32x2*)(vb_ + vdv0 * VROW + vch * 16 + 8) = (u32x2){g3.z, g3.w}; \
        *(LAS u32x2*)(vb_ + (vdv0 + 64) * VROW + vch * 16) = (u32x2){g4.x, g4.y}; *(LAS u32x2*)(vb_ + (vdv0 + 64) * VROW + vch * 16 + 8) = (u32x2){g4.z, g4.w}; } while (0)
        ATT_LOAD(0); ATT_LOADV(0); ATT_STOREK(0); ATT_STORE(0);
        __syncthreads();
        f32x16 o[4];
#pragma unroll
        for (int d = 0; d < 4; ++d)
#pragma unroll
            for (int r = 0; r < 16; ++r) o[d][r] = 0.f;
        float m_run = -INFINITY, l_run = 0.f;
        for (int j = 0; j < ntiles; ++j) {
            const int buf = j & 1;
            if (j + 1 < ntiles) ATT_LOAD(j + 1);
            const LAS unsigned char* kb = lds + buf * BUFB;
            f32x16 s0, s1;
#pragma unroll
            for (int r = 0; r < 16; ++r) { s0[r] = 0.f; s1[r] = 0.f; }
#pragma unroll
            for (int ks = 0; ks < 12; ++ks) {
                const bf16x8 a0 = *(const LAS bf16x8*)(kb + l32 * KROW + ks * 32 + h * 16);
                const bf16x8 a1 = *(const LAS bf16x8*)(kb + (l32 + 32) * KROW + ks * 32 + h * 16);
                s0 = mfma32(a0, qf[ks], s0); s1 = mfma32(a1, qf[ks], s1);
                if (ks == 5) __builtin_amdgcn_sched_barrier(0);
            }
            if (j + 1 < ntiles) ATT_STOREK(buf ^ 1);
            const int vc = L - j * 64;
            if (vc < 64) {
                const int vch = vc - 4 * h;
#pragma unroll
                for (int r = 0; r < 16; ++r) {
                    if ((r & 3) + 8 * (r >> 2) >= vch) s0[r] = -INFINITY;
                    if ((r & 3) + 8 * (r >> 2) + 32 >= vch) s1[r] = -INFINITY;
                }
            }
            float mx = fmaxf(s0[0], s1[0]);
#pragma unroll
            for (int r = 1; r < 16; ++r) mx = fmaxf(mx, fmaxf(s0[r], s1[r]));
            mx = fmaxf(mx, __shfl_xor(mx, 32));
            const float m_new = fmaxf(m_run, mx);
            const float alpha = __builtin_amdgcn_exp2f(m_run - m_new);
            m_run = m_new;
            float ls = 0.f;
#pragma unroll
            for (int r = 0; r < 16; ++r) { s0[r] = __builtin_amdgcn_exp2f(s0[r] - m_new); s1[r] = __builtin_amdgcn_exp2f(s1[r] - m_new); ls += s0[r] + s1[r]; }
            l_run = l_run * alpha + ls;
            if (__any(alpha != 1.0f)) {
#pragma unroll
                for (int d = 0; d < 4; ++d)
#pragma unroll
                    for (int r = 0; r < 16; ++r) o[d][r] *= alpha;
            }
            bf16x8 pb[4];
            {
                u32x4 w;
                w.x = cvt_pk_bf16(s0[0], s0[1]); w.y = cvt_pk_bf16(s0[2], s0[3]); w.z = cvt_pk_bf16(s0[4], s0[5]); w.w = cvt_pk_bf16(s0[6], s0[7]); pb[0] = __builtin_bit_cast(bf16x8, w);
                w.x = cvt_pk_bf16(s0[8], s0[9]); w.y = cvt_pk_bf16(s0[10], s0[11]); w.z = cvt_pk_bf16(s0[12], s0[13]); w.w = cvt_pk_bf16(s0[14], s0[15]); pb[1] = __builtin_bit_cast(bf16x8, w);
                w.x = cvt_pk_bf16(s1[0], s1[1]); w.y = cvt_pk_bf16(s1[2], s1[3]); w.z = cvt_pk_bf16(s1[4], s1[5]); w.w = cvt_pk_bf16(s1[6], s1[7]); pb[2] = __builtin_bit_cast(bf16x8, w);
                w.x = cvt_pk_bf16(s1[8], s1[9]); w.y = cvt_pk_bf16(s1[10], s1[11]); w.z = cvt_pk_bf16(s1[12], s1[13]); w.w = cvt_pk_bf16(s1[14], s1[15]); pb[3] = __builtin_bit_cast(bf16x8, w);
            }
            if (j + 1 < ntiles) ATT_LOADV(j + 1);
            const LAS unsigned char* vb = kb + KBYTES;
#pragma unroll
            for (int d = 0; d < 4; ++d)
#pragma unroll
                for (int ks = 0; ks < 4; ++ks) {
                    const LAS unsigned char* ap = vb + (d * 32 + l32) * VROW + (16 * ks + 4 * h) * 2;
                    const u32x2 lo = *(const LAS u32x2*)ap, hi = *(const LAS u32x2*)(ap + 16);
                    const u32x4 w = (u32x4){lo.x, lo.y, hi.x, hi.y};
                    o[d] = mfma32(__builtin_bit_cast(bf16x8, w), pb[ks], o[d]);
                    if (ks == 3) __builtin_amdgcn_sched_barrier(0);
                }
            if (j + 1 < ntiles) ATT_STORE(buf ^ 1);
            __syncthreads();
        }
        l_run += __shfl_xor(l_run, 32);
        const float inv = 1.0f / l_run;
#if DEBUG_CHECK == 5
        bf16_t* orow = (bf16_t*)(launder(p.ws) + OFF_ODBG) + (size_t)qrow * 512 + head * 128;
#else
        bf16_t* orow = Q + (size_t)qrow * 768 + head * 192;
#endif
#pragma unroll
        for (int d = 0; d < 4; ++d)
#pragma unroll
            for (int rq = 0; rq < 4; ++rq) {
                const u32x2 w = (u32x2){cvt_pk_bf16(o[d][4 * rq] * inv, o[d][4 * rq + 1] * inv), cvt_pk_bf16(o[d][4 * rq + 2] * inv, o[d][4 * rq + 3] * inv)};
                *(GAS u32x2*)(orow + 32 * d + 8 * rq + 4 * h) = w;
            }
#undef ATT_LOAD
#undef ATT_LOADV
#undef ATT_STORE
#undef ATT_STOREK
    }
}

template <int SET> __device__ __forceinline__ void hyena_unit(const Params& p, LAS unsigned char* lds, int c, int bg) {
    constexpr int P = SET ? 32 : 128;
    constexpr int NBU = SET ? 16 : 4;
    constexpr int NBT = SET ? 8 : 2;
    constexpr int GP = SET ? 4 : 16;
    constexpr int LG = SET ? LGS : LGP;
    constexpr int NB = SET ? NBS : NBP;
    constexpr int RS = SET ? 4896 : 18816;
    constexpr int GBYTES = 2 * LG * 2;
    constexpr int G1OFF = 33220;
    constexpr int ZOFF = 66560;
    unsigned char* ws = launder(p.ws);
    const int tid = tid_l(), lane = tid & 63, wave = tid >> 6, h = lane >> 5, l32 = lane & 31;
    const bf16_t* X1T = (const bf16_t*)(ws + OFF_X1T) + (SET ? XT_SET1 : 0);
    bf16_t* X2T = (bf16_t*)(ws + OFF_X2T) + (SET ? XT_SET1 : 0);
    const bf16_t* V0T = (const bf16_t*)(ws + OFF_V0T) + (SET ? XT_SET1 : 0);
    const bf16_t* GR = (const bf16_t*)(ws + (SET ? OFF_GR1 : OFF_GR0));
    const float* hy_bias = launder(p.in[17]);
    LAS unsigned char* gL = lds; LAS unsigned char* zL = lds + ZOFF;
    const size_t rowbase = ((size_t)c * NB + bg * NBU) * LG;
    for (int id = tid; id < NBU * (P + 1) * 8; id += 512) {
        const int bl = id / ((P + 1) * 8), rem = id % ((P + 1) * 8), blk = rem >> 3, ch = rem & 7;
        *(LAS u32x4*)(zL + bl * RS + blk * 144 + ch * 16) = *(const GAS u32x4*)(V0T + rowbase + (size_t)bl * LG + blk * 64 + ch * 8);
    }
    for (int id = tid; id < NBU * 9; id += 512) { const int bl = id / 9, ch = id % 9; *(LAS u32x4*)(zL + bl * RS + (P + 1) * 144 + ch * 16) = (u32x4){0u, 0u, 0u, 0u}; }
#define HY_LOADG(rowidx) do { const unsigned* g32_ = (const unsigned*)(GR + (size_t)(rowidx) * (2 * LG)); \
        for (int id = tid; id < GBYTES / 4; id += 512) { const unsigned a_ = g32_[id], b_ = (id + 1 < GBYTES / 4) ? g32_[id + 1] : 0u; \
            *(LAS unsigned*)(gL + id * 4) = a_; *(LAS unsigned*)(gL + G1OFF + id * 4) = (a_ >> 16) | (b_ << 16); } } while (0)
    HY_LOADG(c);
    __syncthreads();
    const LAS unsigned short* g16 = (const LAS unsigned short*)gL;
    constexpr int PARTS = 512 / (NBU * 16);
    float zmeta = 0.f; int mo_bl, mo_m;
    {
        const int part = tid % PARTS, out = tid / PARTS; mo_bl = out >> 4; mo_m = out & 15;
        const LAS unsigned char* zr = zL + mo_bl * RS;
        float a = 0.f;
        const LAS unsigned char* gm = gL + (mo_m & 1) * G1OFF;
        for (int ci = part; ci < (LG - 48) / 8; ci += PARTS) {
            const int tt0 = 48 + 8 * ci;
            const u32x4 zv = *(const LAS u32x4*)(zr + (tt0 >> 6) * 144 + (tt0 & 63) * 2);
            const LAS unsigned* gp = (const LAS unsigned*)(gm + ((LG - mo_m - 48 + tt0) >> 1) * 4);
            const unsigned g0 = gp[0], g1 = gp[1], g2 = gp[2], g3 = gp[3];
            a += (bflo(zv.x) * bflo(g0) + bfhi(zv.x) * bfhi(g0)) + (bflo(zv.y) * bflo(g1) + bfhi(zv.y) * bfhi(g1))
               + (bflo(zv.z) * bflo(g2) + bfhi(zv.z) * bfhi(g2)) + (bflo(zv.w) * bflo(g3) + bfhi(zv.w) * bfhi(g3));
        }
#pragma unroll
        for (int o = 1; o < PARTS; o <<= 1) a += __shfl_xor(a, o);
        const float bias0 = hy_bias[c];
        const float z0 = bf2f(*(const LAS unsigned short*)(zr + (48 + mo_m) * 2));
        const float x1 = bf2f(X1T[rowbase + (size_t)mo_bl * LG + 48 + mo_m]);
        zmeta = x1 * (a + z0 * bias0);
    }
    const int p0 = GP * wave;
    const int pp = l32 / NBT, blA = l32 % NBT, blB = NBT + blA;
#pragma unroll 1
    for (int order = 0; order < 2; ++order) {
        f32x16 acc[2][2];
#pragma unroll
        for (int a = 0; a < 2; ++a)
#pragma unroll
            for (int b = 0; b < 2; ++b)
#pragma unroll
                for (int r = 0; r < 16; ++r) acc[a][b][r] = 0.f;
        bf16x8 Ep4, Ep5;
        {
            const int d0 = p0 - (P - 1); const int ib0 = LG - 64 * d0 - l32 + 8 * h;
            const LAS unsigned char* g0 = gL + (l32 & 1) * G1OFF + (ib0 >> 1) * 4;
            const LAS unsigned* ga = (const LAS unsigned*)(g0 + 96); const LAS unsigned* gb = (const LAS unsigned*)(g0 + 64);
            Ep4 = __builtin_bit_cast(bf16x8, (u32x4){ga[0], ga[1], ga[2], ga[3]}); Ep5 = __builtin_bit_cast(bf16x8, (u32x4){gb[0], gb[1], gb[2], gb[3]});
        }
#define HY_LOAD(dd, Bv, Ev) do { \
            const int ib_ = LG - 64 * (dd) - l32 + 8 * h; \
            const LAS unsigned char* gpl_ = gL + (l32 & 1) * G1OFF + (ib_ >> 1) * 4; \
            _Pragma("unroll") for (int e = 2; e < 6; ++e) { const LAS unsigned* gp_ = (const LAS unsigned*)(gpl_ - 32 * (e - 3)); \
                Ev[e - 2] = __builtin_bit_cast(bf16x8, (u32x4){gp_[0], gp_[1], gp_[2], gp_[3]}); } \
            const int q_ = p0 + pp - (dd); const int slot_ = ((unsigned)(q_ + 1) <= (unsigned)P) ? q_ + 1 : P + 1; \
            const LAS unsigned char* zA_ = zL + blA * RS + slot_ * 144 + h * 16; const LAS unsigned char* zB_ = zL + blB * RS + slot_ * 144 + h * 16; \
            _Pragma("unroll") for (int ks = 0; ks < 4; ++ks) { Bv[0][ks] = *(const LAS bf16x8*)(zA_ + ks * 32); Bv[1][ks] = *(const LAS bf16x8*)(zB_ + ks * 32); } } while (0)
#define HY_MMA(Bv, Ev) do { \
            _Pragma("unroll") for (int ks = 0; ks < 4; ++ks) { \
                const bf16x8 a0_ = (ks == 0) ? Ev[1] : (ks == 1) ? Ev[0] : (ks == 2) ? Ep5 : Ep4; \
                const bf16x8 a1_ = (ks == 0) ? Ev[3] : (ks == 1) ? Ev[2] : (ks == 2) ? Ev[1] : Ev[0]; \
                acc[0][0] = mfma32(a0_, Bv[0][ks], acc[0][0]); acc[1][0] = mfma32(a0_, Bv[1][ks], acc[1][0]); \
                acc[0][1] = mfma32(a1_, Bv[0][ks], acc[0][1]); acc[1][1] = mfma32(a1_, Bv[1][ks], acc[1][1]); } \
            Ep4 = Ev[2]; Ep5 = Ev[3]; } while (0)
        {
            bf16x8 BA[2][4], BB[2][4], EA[4], EB[4];
            const int dlo = p0 - (P - 1), dhi = p0 + GP;
            HY_LOAD(dlo, BA, EA);
#pragma unroll 1
            for (int d = dlo; d <= dhi; d += 2) {
                HY_LOAD(d + 1, BB, EB);
                HY_MMA(BA, EA);
                if (d + 2 <= dhi) HY_LOAD(d + 2, BA, EA);
                HY_MMA(BB, EB);
            }
        }
#undef HY_LOAD
#undef HY_MMA
        __syncthreads();
        const float bias = hy_bias[order * 512 + c];
#pragma unroll
        for (int tl = 0; tl < 2; ++tl) {
            const int bl = tl ? blB : blA;
            const size_t grow = rowbase + (size_t)bl * LG + 64 * (p0 + pp + 1);
            LAS unsigned char* zr = zL + bl * RS + (p0 + pp + 1) * 144;
#pragma unroll
            for (int m = 0; m < 2; ++m)
#pragma unroll
                for (int rq = 0; rq < 4; ++rq) {
                    const int off = 32 * m + 8 * rq + 4 * h;
                    const u32x2 zw = *(const LAS u32x2*)(zr + off * 2);
                    const u32x2 xw = *(const GAS u32x2*)((order ? (const bf16_t*)X2T : X1T) + grow + off);
                    const float y0 = acc[tl][m][4 * rq], y1 = acc[tl][m][4 * rq + 1], y2 = acc[tl][m][4 * rq + 2], y3 = acc[tl][m][4 * rq + 3];
                    const float r0 = bflo(xw.x) * (y0 + bflo(zw.x) * bias), r1 = bfhi(xw.x) * (y1 + bfhi(zw.x) * bias);
                    const float r2 = bflo(xw.y) * (y2 + bflo(zw.y) * bias), r3 = bfhi(xw.y) * (y3 + bfhi(zw.y) * bias);
                    const u32x2 w = (u32x2){cvt_pk_bf16(r0, r1), cvt_pk_bf16(r2, r3)};
#if DEBUG_CHECK == 5
                    if (order == 0) *(LAS u32x2*)(zr + off * 2) = w; else *(GAS u32x2*)((bf16_t*)(ws + OFF_HDBG) + (SET ? XT_SET1 : 0) + grow + off) = w;
#else
                    if (order == 0) *(LAS u32x2*)(zr + off * 2) = w; else *(GAS u32x2*)(X2T + grow + off) = w;
#endif
                }
        }
        if (order == 0) {
            if ((tid % PARTS) == 0) *(LAS unsigned short*)(zL + mo_bl * RS + (48 + mo_m) * 2) = (unsigned short)(cvt_pk_bf16(zmeta, 0.f) & 0xffffu);
            HY_LOADG(512 + c);
        }
        __syncthreads();
    }
}
#undef HY_LOADG
__device__ __forceinline__ void hyena_phase(const Params& p, LAS unsigned char* lds) {
    for (int u = blockIdx.x; u < 2048; u += gridDim.x) {
        if (u < 1024) hyena_unit<0>(p, lds, u >> 1, u & 1); else hyena_unit<1>(p, lds, (u - 1024) >> 1, u & 1);
    }
}

__device__ __forceinline__ void mixnorm_phase(const Params& p, LAS unsigned char* lds) {
    unsigned char* ws = launder(p.ws); const int tid = tid_l(), lane = tid & 63, wave = tid >> 6, G = gridDim.x;
    const bf16_t* Q = (const bf16_t*)(launder((unsigned char*)p.out) + DO_Q);
    bf16_t* MIXN = (bf16_t*)(ws + OFF_MIXN);
    const float* ga = launder(p.in[18]); const float* gh = launder(p.in[19]);
    constexpr int RSB = 1040;
    for (int u = blockIdx.x; u < 2048; u += G) {
        const int n0 = u * 64;
        int set, b, tok0;
        if (n0 < 65536) { set = 0; b = n0 >> 13; tok0 = n0 & 8191; } else { set = 1; const int q = n0 - 65536; b = q >> 11; tok0 = q & 2047; }
        const int Lg = set ? LGS : LGP, NB = set ? NBS : NBP;
        {
            const int c = tid;
#if DEBUG_CHECK == 5
            const bf16_t* src = (const bf16_t*)(ws + OFF_HDBG) + (set ? XT_SET1 : 0) + ((size_t)c * NB + b) * Lg + tok0 + 64;
#else
            const bf16_t* src = (const bf16_t*)(ws + OFF_X2T) + (set ? XT_SET1 : 0) + ((size_t)c * NB + b) * Lg + tok0 + 64;
#endif
            LAS unsigned short* tl = (LAS unsigned short*)lds + c;
#pragma unroll
            for (int k8 = 0; k8 < 8; ++k8) {
                const u32x4 v = *(const GAS u32x4*)(src + k8 * 8);
                tl[(k8 * 8 + 0) * (RSB / 2)] = (unsigned short)(v.x & 0xffffu); tl[(k8 * 8 + 1) * (RSB / 2)] = (unsigned short)(v.x >> 16);
                tl[(k8 * 8 + 2) * (RSB / 2)] = (unsigned short)(v.y & 0xffffu); tl[(k8 * 8 + 3) * (RSB / 2)] = (unsigned short)(v.y >> 16);
                tl[(k8 * 8 + 4) * (RSB / 2)] = (unsigned short)(v.z & 0xffffu); tl[(k8 * 8 + 5) * (RSB / 2)] = (unsigned short)(v.z >> 16);
                tl[(k8 * 8 + 6) * (RSB / 2)] = (unsigned short)(v.w & 0xffffu); tl[(k8 * 8 + 7) * (RSB / 2)] = (unsigned short)(v.w >> 16);
            }
        }
        __syncthreads();
        for (int i = 0; i < 8; ++i) {
            const int rr = wave + 8 * i; const int n = n0 + rr; const int r = full_row(n);
            const u32x4 hv = *(const LAS u32x4*)(lds + rr * RSB + lane * 16);
#if DEBUG_CHECK == 5
            const u32x4 av = *(const GAS u32x4*)((const bf16_t*)(ws + OFF_ODBG) + (size_t)r * 512 + lane * 8);
#else
            const u32x4 av = *(const GAS u32x4*)(Q + (size_t)r * 768 + (lane >> 4) * 192 + (lane & 15) * 8);
#endif
            float hf[8] = {bflo(hv.x), bfhi(hv.x), bflo(hv.y), bfhi(hv.y), bflo(hv.z), bfhi(hv.z), bflo(hv.w), bfhi(hv.w)};
            float af[8] = {bflo(av.x), bfhi(av.x), bflo(av.y), bfhi(av.y), bflo(av.z), bfhi(av.z), bflo(av.w), bfhi(av.w)};
            float sh = 0.f, sa = 0.f;
#pragma unroll
            for (int k = 0; k < 8; ++k) { sh += hf[k] * hf[k]; sa += af[k] * af[k]; }
            sh = wave_sum(sh); sa = wave_sum(sa);
            const float rh = rsqrtf(sh * (1.f / 512.f) + EPS), ra = rsqrtf(sa * (1.f / 512.f) + EPS);
            const f32x4 ga0 = *(const GAS f32x4*)(ga + lane * 8), ga1 = *(const GAS f32x4*)(ga + lane * 8 + 4);
            const f32x4 gh0 = *(const GAS f32x4*)(gh + lane * 8), gh1 = *(const GAS f32x4*)(gh + lane * 8 + 4);
            u32x4 wa, wh;
            wa.x = cvt_pk_bf16(af[0] * ra * ga0[0], af[1] * ra * ga0[1]); wa.y = cvt_pk_bf16(af[2] * ra * ga0[2], af[3] * ra * ga0[3]);
            wa.z = cvt_pk_bf16(af[4] * ra * ga1[0], af[5] * ra * ga1[1]); wa.w = cvt_pk_bf16(af[6] * ra * ga1[2], af[7] * ra * ga1[3]);
            wh.x = cvt_pk_bf16(hf[0] * rh * gh0[0], hf[1] * rh * gh0[1]); wh.y = cvt_pk_bf16(hf[2] * rh * gh0[2], hf[3] * rh * gh0[3]);
            wh.z = cvt_pk_bf16(hf[4] * rh * gh1[0], hf[5] * rh * gh1[1]); wh.w = cvt_pk_bf16(hf[6] * rh * gh1[2], hf[7] * rh * gh1[3]);
#if EXPT == 1
            wa = (u32x4){0u, 0u, 0u, 0u};
#endif
#if EXPT == 2
            wh = (u32x4){0u, 0u, 0u, 0u};
#endif
            *(GAS u32x4*)(MIXN + (size_t)n * 1024 + lane * 8) = wa;
            *(GAS u32x4*)(MIXN + (size_t)n * 1024 + 512 + lane * 8) = wh;
        }
        __syncthreads();
    }
}

__device__ __forceinline__ void h1_phase(const Params& p) {
    unsigned char* ws = launder(p.ws); const int tid = tid_l(), lane = tid & 63, wave = tid >> 6;
    const int gw = blockIdx.x * 8 + wave, NGW = gridDim.x * 8;
    const bf16_t* MIX = (const bf16_t*)(ws + OFF_MIX); bf16_t* H1B = (bf16_t*)(ws + OFF_H1B);
    const float* sqmix = (const float*)(ws + OFF_SQMIXP); float* r1 = (float*)(ws + OFF_R1); const float* g = p.in[21];
    for (int n = gw; n < TN; n += NGW) {
        const float* xrow = n < 65536 ? p.in[0] + (size_t)n * 1024 : p.in[1] + (size_t)(n - 65536) * 1024;
        const float rm = rsqrtf(wave_sum(lane < 16 ? ldco(sqmix + (size_t)n * 16 + lane) : 0.f) * (1.f / 1024.f) + EPS);
        float ss = 0.f;
#pragma unroll
        for (int hh = 0; hh < 2; ++hh) {
            const int c0 = hh * 512 + lane * 8;
            const u32x4 mv = *(const u32x4*)(MIX + (size_t)n * 1024 + c0);
            const f32x4 x0 = *(const f32x4*)(xrow + c0), x1 = *(const f32x4*)(xrow + c0 + 4);
            const f32x4 g0 = *(const f32x4*)(g + c0), g1 = *(const f32x4*)(g + c0 + 4);
            f32x4 h0, h1;
            h0[0] = x0[0] + bflo(mv.x) * rm * g0[0]; h0[1] = x0[1] + bfhi(mv.x) * rm * g0[1]; h0[2] = x0[2] + bflo(mv.y) * rm * g0[2]; h0[3] = x0[3] + bfhi(mv.y) * rm * g0[3];
            h1[0] = x1[0] + bflo(mv.z) * rm * g1[0]; h1[1] = x1[1] + bfhi(mv.z) * rm * g1[1]; h1[2] = x1[2] + bflo(mv.w) * rm * g1[2]; h1[3] = x1[3] + bfhi(mv.w) * rm * g1[3];
            ss += sq8(h0, h1);
            *(u32x4*)(H1B + (size_t)n * 1024 + c0) = pack8(h0, h1);
        }
        ss = wave_sum(ss);
        if (lane == 0) r1[n] = rsqrtf(ss * (1.f / 1024.f) + EPS);
    }
}
__device__ __forceinline__ void final_phase(const Params& p, int half) {
    unsigned char* ws = launder(p.ws); const int tid = tid_l(), lane = tid & 63, wave = tid >> 6;
    const int gw = blockIdx.x * 8 + wave, NGW = gridDim.x * 8;
    const bf16_t* M2 = (const bf16_t*)(ws + OFF_M2); const float* sqm2 = (const float*)(ws + OFF_SQM2P); const float* g = p.in[25];
    float dbg_off = 0.f, dbg_one = 0.f;
#if DEBUG_CHECK
    { const unsigned* dc = (const unsigned*)(ws + OFF_DBGW); dbg_off = 100.f * (float)dc[8] * (1.f / 131072.f); dbg_one = 1000.f * (float)dc[9] * (1.f / 131072.f); }
#endif
    for (int i = gw; i < 65536; i += NGW) {
        const int n = half * 65536 + i;
        const float rm = rsqrtf(wave_sum(lane < 16 ? ldco(sqm2 + (size_t)n * 16 + lane) : 0.f) * (1.f / 1024.f) + EPS);
#pragma unroll
        for (int hh = 0; hh < 2; ++hh) {
            const int c0 = hh * 512 + lane * 8;
            const u32x4 mv = *(const u32x4*)(M2 + (size_t)i * 1024 + c0);
            const u32x4 hv = *(const u32x4*)((const bf16_t*)(ws + OFF_H1B) + (size_t)n * 1024 + c0);
            f32x4 h0 = (f32x4){bflo(hv.x), bfhi(hv.x), bflo(hv.y), bfhi(hv.y)}, h1 = (f32x4){bflo(hv.z), bfhi(hv.z), bflo(hv.w), bfhi(hv.w)};
            const f32x4 g0 = *(const f32x4*)(g + c0), g1 = *(const f32x4*)(g + c0 + 4);
            h0 += dbg_off; h1 += dbg_off; if (n == 0 && c0 == 0) h0[0] += dbg_one;
            h0[0] += bflo(mv.x) * rm * g0[0]; h0[1] += bfhi(mv.x) * rm * g0[1]; h0[2] += bflo(mv.y) * rm * g0[2]; h0[3] += bfhi(mv.y) * rm * g0[3];
            h1[0] += bflo(mv.z) * rm * g1[0]; h1[1] += bfhi(mv.z) * rm * g1[1]; h1[2] += bflo(mv.w) * rm * g1[2]; h1[3] += bfhi(mv.w) * rm * g1[3];
            *(f32x4*)(p.out + (size_t)n * 1024 + c0) = h0; *(f32x4*)(p.out + (size_t)n * 1024 + c0 + 4) = h1;
        }
    }
}


#if DEBUG_CHECK
constexpr size_t OFF_DBG = OFF_DBGW;
__device__ __forceinline__ void check_gemm(const bf16_t* A, int lda, const bf16_t* Bt, int ldb, int K, int M, int N, int mode, const bf16_t* O, int ldc, const float* rs, unsigned* cnt, int col_lo) {
    const unsigned idx = blockIdx.x * 512u + (unsigned)tid_l();
    unsigned hsh = idx * 2654435761u + 12345u + (unsigned)mode * 977u; hsh ^= hsh >> 15; hsh *= 2246822519u; hsh ^= hsh >> 13;
    const int row = (int)(hsh % (unsigned)M); hsh = hsh * 3266489917u + 668265263u; hsh ^= hsh >> 16;
    const int col = col_lo + (int)(hsh % (unsigned)(N - col_lo));
    float d = 0.f;
    for (int k = 0; k < K; ++k) d += bf2f(A[(size_t)row * lda + k]) * bf2f(Bt[(size_t)col * ldb + k]);
    float e = d;
    if (mode == 0 || mode == 7) e = d * rs[row];
    if (mode == 5) { const float t = fmaxf(d * rs[row], 0.f); e = t * t; }
    const float st = bf2f(O[(size_t)row * ldc + col]);
    if (!(fabsf(st - e) <= 0.03f * fabsf(e) + 0.03f)) atomicAdd(cnt, 1u);
}
#endif

#if DEBUG_CHECK == 2
__device__ __forceinline__ void check_proj(const Params& p) {
    unsigned char* ws = launder(p.ws); unsigned char* ob = launder((unsigned char*)p.out);
    const bf16_t* P = (const bf16_t*)(ws + OFF_P); unsigned* cnt = (unsigned*)(ws + OFF_DBG);
    const unsigned idx = blockIdx.x * 512u + (unsigned)tid_l();
    unsigned hsh = idx * 2654435761u + 777u; hsh ^= hsh >> 15; hsh *= 2246822519u; hsh ^= hsh >> 13;
    const int row = (int)(hsh % (unsigned)T); hsh = hsh * 3266489917u + 668265263u; hsh ^= hsh >> 16;
    int pos, seq; row_info(row, pos, seq);
    {
        const int n = (int)(hsh % 768u); const int hh = n / 192, w = n % 192;
        float ss = 0.f, x1 = 0.f, x2 = 0.f; const float* W = p.in[6]; const float* g = p.in[5];
        const int j = w - 128, i = j >> 1;
        const int c1 = w < 128 ? hh * 192 + w : hh * 192 + 128 + i, c2 = hh * 192 + 160 + (w < 128 ? 0 : i);
        for (int k = 0; k < 256; ++k) { const float a = bf2f(P[(size_t)row * NPP + k]); ss += a * a; x1 += a * g[k] * W[k * 768 + c1]; x2 += a * g[k] * W[k * 768 + c2]; }
        const float rq = rsqrtf(ss * (1.f / 256.f) + EPS) * QSCALE; x1 *= rq; x2 *= rq;
        float e = x1;
        if (w >= 128) { const float inv = 1.0f / exp2f((float)i * (13.287712379549449f / 32.f)); float sn, cs; sincos_red((float)pos * inv, sn, cs); e = (j & 1) ? x2 * cs + x1 * sn : x1 * cs - x2 * sn; }
        const float st = bf2f(((const bf16_t*)(ob + DO_Q))[(size_t)row * 768 + n]);
        if (!(fabsf(st - e) <= 0.03f * fabsf(e) + 0.01f)) atomicAdd(cnt + (w < 128 ? 0 : 4), 1u);
    }
    {
        const int n = (int)((hsh >> 3) % 512u); const int hh = n >> 7, i = n & 127;
        float ss = 0.f, x1 = 0.f, x2 = 0.f; const float* W = p.in[8]; const float* g = p.in[7];
        for (int k = 0; k < 128; ++k) { const float a = bf2f(P[(size_t)row * NPP + 256 + k]); ss += a * a; x1 += a * g[k] * W[k * 1024 + hh * 256 + i]; x2 += a * g[k] * W[k * 1024 + hh * 256 + 128 + i]; }
        const float rk = rsqrtf(ss * (1.f / 128.f) + EPS); x1 *= rk; x2 *= rk;
        const float s1 = bf2f(((const bf16_t*)(ob + DO_KN))[(size_t)row * 512 + n]);
        const float s2 = bf2f(((const bf16_t*)(ob + DO_VT))[(size_t)n * TPAD + row]);
        if (!(fabsf(s1 - x1) <= 0.03f * fabsf(x1) + 0.03f)) atomicAdd(cnt + 1, 1u);
        if (!(fabsf(s2 - x2) <= 0.03f * fabsf(x2) + 0.03f)) atomicAdd(cnt + 2, 1u);
    }
    {
        const int jj = (int)((hsh >> 5) % 64u); const int i = jj >> 1;
        const float* xr = pos < 16 ? p.in[2] + (size_t)pos * 1024 : (seq < NBP ? p.in[0] + ((size_t)seq * 8192 + (pos - 16)) * 1024 : p.in[1] + ((size_t)(seq - NBP) * 2048 + (pos - 16)) * 1024);
        const float* W = p.in[4]; const float* g = p.in[3]; float x1 = 0.f, x2 = 0.f;
        for (int k = 0; k < 1024; ++k) { const float a = xr[k] * g[k]; x1 += a * W[(size_t)k * 1984 + 384 + i]; x2 += a * W[(size_t)k * 1984 + 416 + i]; }
        const float r0 = ((const float*)(ws + OFF_R0))[row]; x1 *= r0; x2 *= r0;
        const float inv = 1.0f / exp2f((float)i * (13.287712379549449f / 32.f)); float sn, cs; sincos_red((float)pos * inv, sn, cs);
        const float e = (jj & 1) ? x2 * cs + x1 * sn : x1 * cs - x2 * sn;
        const float st = bf2f(((const bf16_t*)(ob + DO_KR))[(size_t)row * 64 + jj]);
        if (!(fabsf(st - e) <= 0.03f * fabsf(e) + 0.03f)) { atomicAdd(cnt + 3, 1u); atomicAdd(cnt + 5, (unsigned)i); atomicAdd(cnt + 6, (unsigned)(pos >> 3)); }
    }
}
#endif

#if DEBUG_CHECK == 3
__device__ __forceinline__ void check_h0b(const Params& p, int slot) {
    unsigned char* ws = launder(p.ws); unsigned* cnt = (unsigned*)(ws + OFF_DBGW);
    const bf16_t* h0b = (const bf16_t*)(ws + OFF_H0B);
    const unsigned idx = blockIdx.x * 512u + (unsigned)tid_l();
    unsigned hsh = idx * 2654435761u + 4242u + (unsigned)slot * 31u; hsh ^= hsh >> 15; hsh *= 2246822519u; hsh ^= hsh >> 13;
    const int row = (int)(hsh % (unsigned)T); hsh = hsh * 3266489917u + 668265263u; hsh ^= hsh >> 16;
    const int col = (int)(hsh % 1024u);
    int pos, seq; row_info(row, pos, seq);
    const float* xr = pos < 16 ? p.in[2] + (size_t)pos * 1024 : (seq < NBP ? p.in[0] + ((size_t)seq * 8192 + (pos - 16)) * 1024 : p.in[1] + ((size_t)(seq - NBP) * 2048 + (pos - 16)) * 1024);
    const float e = xr[col]; const float st = bf2f(h0b[(size_t)row * 1024 + col]);
    if (!(fabsf(st - e) <= 0.01f * fabsf(e) + 0.001f)) atomicAdd(cnt + slot, 1u);
}
#endif

#if DEBUG_CHECK == 4
__device__ __forceinline__ void check_stale(const Params& p, const unsigned* base, unsigned ndw, int slot) {
    unsigned* cnt = (unsigned*)(launder(p.ws) + OFF_DBGW);
    const unsigned idx = blockIdx.x * 512u + (unsigned)tid_l();
    unsigned hsh = idx * 2654435761u + 999u + (unsigned)slot * 131u; hsh ^= hsh >> 15; hsh *= 2246822519u; hsh ^= hsh >> 13;
#pragma unroll 1
    for (int it = 0; it < 16; ++it) {
        hsh = hsh * 3266489917u + 668265263u; hsh ^= hsh >> 16;
        const unsigned i = hsh % ndw;
        const unsigned a = base[i];
        const unsigned b = __hip_atomic_load(base + i, __ATOMIC_RELAXED, __HIP_MEMORY_SCOPE_AGENT);
        if (a != b) atomicAdd(cnt + slot, 1u);
    }
}
#endif

#if DEBUG_CHECK == 5
__device__ __forceinline__ void check_attn(const Params& p) {
    unsigned char* ws = launder(p.ws); unsigned char* ob = launder((unsigned char*)p.out); unsigned* cnt = (unsigned*)(ws + OFF_DBGW);
    const int tid = tid_l(), lane = tid & 63, wave = tid >> 6;
    const bf16_t* Q = (const bf16_t*)(ob + DO_Q); const bf16_t* KN = (const bf16_t*)(ob + DO_KN); const bf16_t* KR = (const bf16_t*)(ob + DO_KR); const bf16_t* VT = (const bf16_t*)(ob + DO_VT);
    const bf16_t* OD = (const bf16_t*)(ws + OFF_ODBG); const float2* RT = (const float2*)(ws + OFF_RT);
    unsigned hsh = (unsigned)(blockIdx.x * 8 + wave) * 2654435761u + 31337u; hsh ^= hsh >> 15; hsh *= 2246822519u; hsh ^= hsh >> 13;
    const int n = (int)(hsh % (unsigned)TN); const int head = (int)((hsh >> 20) & 3u); const int r = full_row(n);
    int pos, seq; row_info(r, pos, seq);
    const int L = seq < NBP ? LP : LS; const int row0 = r - pos;
    const bf16_t* qp = Q + (size_t)r * 768 + head * 192;
    float mx = -INFINITY;
    for (int k = lane; k < L; k += 64) {
        float sdot = 0.f;
        for (int d = 0; d < 128; ++d) sdot += bf2f(qp[d]) * bf2f(KN[(size_t)(row0 + k) * 512 + head * 128 + d]);
        for (int i = 0; i < 32; ++i) { const float2 cs = ldco2(RT + pos * 32 + i); const float a = bf2f(qp[128 + 2 * i]), b = bf2f(qp[129 + 2 * i]);
            sdot += (a * cs.x - b * cs.y) * bf2f(KR[(size_t)(row0 + k) * 64 + 2 * i]) + (b * cs.x + a * cs.y) * bf2f(KR[(size_t)(row0 + k) * 64 + 2 * i + 1]); }
        mx = fmaxf(mx, sdot);
    }
#pragma unroll
    for (int o = 1; o < 64; o <<= 1) mx = fmaxf(mx, __shfl_xor(mx, o));
    float sw = 0.f, o0 = 0.f, o1 = 0.f; const int dv0 = (int)((hsh >> 8) & 127u), dv1 = (dv0 + 37) & 127;
    for (int k = lane; k < L; k += 64) {
        float sdot = 0.f;
        for (int d = 0; d < 128; ++d) sdot += bf2f(qp[d]) * bf2f(KN[(size_t)(row0 + k) * 512 + head * 128 + d]);
        for (int i = 0; i < 32; ++i) { const float2 cs = ldco2(RT + pos * 32 + i); const float a = bf2f(qp[128 + 2 * i]), b = bf2f(qp[129 + 2 * i]);
            sdot += (a * cs.x - b * cs.y) * bf2f(KR[(size_t)(row0 + k) * 64 + 2 * i]) + (b * cs.x + a * cs.y) * bf2f(KR[(size_t)(row0 + k) * 64 + 2 * i + 1]); }
        const float w = exp2f(sdot - mx); sw += w;
        o0 += w * bf2f(VT[(size_t)(head * 128 + dv0) * TPAD + row0 + k]); o1 += w * bf2f(VT[(size_t)(head * 128 + dv1) * TPAD + row0 + k]);
    }
    sw = wave_sum(sw); o0 = wave_sum(o0) / sw; o1 = wave_sum(o1) / sw;
    if (lane == 0) {
        const float s0 = bf2f(OD[(size_t)r * 512 + head * 128 + dv0]), s1 = bf2f(OD[(size_t)r * 512 + head * 128 + dv1]);
        atomicAdd(cnt + 10, 2u);
        if (!(fabsf(s0 - o0) <= 0.05f * fabsf(o0) + 0.002f)) atomicAdd(cnt + 8, 1u);
        if (!(fabsf(s1 - o1) <= 0.05f * fabsf(o1) + 0.002f)) atomicAdd(cnt + 8, 1u);
    }
}
__device__ __forceinline__ void check_hyena(const Params& p, LAS unsigned char* lds) {
    unsigned char* ws = launder(p.ws); unsigned* cnt = (unsigned*)(ws + OFF_DBGW);
    const int tid = tid_l();
    unsigned hsh = (unsigned)blockIdx.x * 2654435761u + 555u; hsh ^= hsh >> 15; hsh *= 2246822519u; hsh ^= hsh >> 13;
    const int set = (int)(blockIdx.x & 1u); const int c = (int)(hsh % 512u); const int NB = set ? NBS : NBP; const int b = (int)((hsh >> 12) % (unsigned)NB);
    const int LG = set ? LGS : LGP;
    const size_t base = (set ? XT_SET1 : 0) + ((size_t)c * NB + b) * LG;
    const bf16_t* X1 = (const bf16_t*)(ws + OFF_X1T) + base; const bf16_t* X2 = (const bf16_t*)(ws + OFF_X2T) + base; const bf16_t* V0 = (const bf16_t*)(ws + OFF_V0T) + base;
    const bf16_t* HD = (const bf16_t*)(ws + OFF_HDBG) + base;
    const bf16_t* G0 = (const bf16_t*)(ws + (set ? OFF_GR1 : OFF_GR0)) + (size_t)c * (2 * LG); const bf16_t* G1 = G0 + (size_t)512 * (2 * LG);
    const float bias0 = p.in[17][c], bias1 = p.in[17][512 + c];
    LAS float* z1 = (LAS float*)lds;
    for (int t = tid; t < LG; t += 512) {
        float y = 0.f;
        for (int s2 = 48; s2 < LG; ++s2) y += bf2f(G0[LG - (t - s2)]) * bf2f(V0[s2]);
        const float v = bf2f(X1[t]) * (y + bf2f(V0[t]) * bias0);
        z1[t] = (t >= 48) ? bf2f((unsigned short)(cvt_pk_bf16(v, 0.f) & 0xffffu)) : 0.f;
    }
    __syncthreads();
    {
        unsigned h2 = hsh * 3266489917u + (unsigned)tid * 2246822519u; h2 ^= h2 >> 15; h2 *= 2654435761u; h2 ^= h2 >> 13;
        const int t = 64 + (int)(h2 % (unsigned)(LG - 64));
        float y = 0.f;
        for (int s2 = 48; s2 < LG; ++s2) y += bf2f(G1[LG - (t - s2)]) * z1[s2];
        const float e = bf2f(X2[t]) * (y + z1[t] * bias1);
        const float st = bf2f(HD[t]);
        atomicAdd(cnt + 11, 1u);
        if (!(fabsf(st - e) <= 0.05f * fabsf(e) + 1.0f)) atomicAdd(cnt + 9, 1u);
    }
    __syncthreads();
}
#endif

#if DEBUG_CHECK == 7
__device__ __forceinline__ void check_h0b_full(const Params& p, int slot) {
    unsigned char* ws = launder(p.ws); unsigned* cnt = (unsigned*)(ws + OFF_DBGW);
    const bf16_t* h0b = (const bf16_t*)(ws + OFF_H0B);
    const int tid = tid_l(), lane = tid & 63, wave = tid >> 6;
    for (int row = blockIdx.x * 8 + wave; row < T; row += gridDim.x * 8) {
        int pos, seq; row_info(row, pos, seq);
        const float* xr = pos < 16 ? p.in[2] + (size_t)pos * 1024 : (seq < NBP ? p.in[0] + ((size_t)seq * 8192 + (pos - 16)) * 1024 : p.in[1] + ((size_t)(seq - NBP) * 2048 + (pos - 16)) * 1024);
        int bad = 0;
        for (int c = lane; c < 1024; c += 64) { const float e = xr[c]; const float st = bf2f(h0b[(size_t)row * 1024 + c]); if (!(fabsf(st - e) <= 0.01f * fabsf(e) + 0.001f)) bad = 1; }
        bad = __any(bad);
        if (lane == 0 && bad) atomicAdd(cnt + slot, 1u);
    }
}
#endif

#if DEBUG_CHECK == 8
__device__ __forceinline__ void check_p_golden(const Params& p) {
    unsigned char* ws = launder(p.ws); unsigned* cnt = (unsigned*)(ws + OFF_DBGW);
    const bf16_t* P = (const bf16_t*)(ws + OFF_P);
    const unsigned idx = blockIdx.x * 512u + (unsigned)tid_l();
    unsigned hsh = idx * 2654435761u + 8888u; hsh ^= hsh >> 15; hsh *= 2246822519u; hsh ^= hsh >> 13;
    const int row = (int)(hsh % (unsigned)T); hsh = hsh * 3266489917u + 668265263u; hsh ^= hsh >> 16;
    int pos, seq; row_info(row, pos, seq);
    const float* xr = pos < 16 ? p.in[2] + (size_t)pos * 1024 : (seq < NBP ? p.in[0] + ((size_t)seq * 8192 + (pos - 16)) * 1024 : p.in[1] + ((size_t)(seq - NBP) * 2048 + (pos - 16)) * 1024);
    const float* W = p.in[4]; const float* g = p.in[3];
    const int colA = 448 + (int)(hsh % 1536u), colB = (int)((hsh >> 7) % 384u);
    float ss = 0.f, a = 0.f, b = 0.f;
    for (int k = 0; k < 1024; ++k) { const float x = xr[k]; ss += x * x; a += x * g[k] * W[(size_t)k * 1984 + colA]; b += x * g[k] * W[(size_t)k * 1984 + colB]; }
    const float r0 = rsqrtf(ss * (1.f / 1024.f) + EPS); a *= r0; b *= r0;
    const float sa = bf2f(P[(size_t)row * NPP + colA]), sb = bf2f(P[(size_t)row * NPP + colB]);
    if (!(fabsf(sa - a) <= 0.03f * fabsf(a) + 0.03f)) atomicAdd(cnt + 8, 1u);
    if (!(fabsf(sb - b) <= 0.03f * fabsf(b) + 0.03f)) atomicAdd(cnt + 9, 1u);
}
#endif

#if DEBUG_CHECK == 9
__device__ __forceinline__ void check_win_r0(const Params& p) {
    unsigned char* ws = launder(p.ws); unsigned* cnt = (unsigned*)(ws + OFF_DBGW);
    const bf16_t* WT = (const bf16_t*)(ws + OFF_WIN); const float* W = p.in[4]; const float* g = p.in[3]; const float* R0 = (const float*)(ws + OFF_R0);
    const int tid = tid_l(), lane = tid & 63, wave = tid >> 6;
    const int gtid = blockIdx.x * 512 + tid, gthreads = gridDim.x * 512;
    for (int e = gtid; e < 1984 * 1024; e += gthreads) {
        const int n = e >> 10, k = e & 1023; const int sc = src_col(1, n);
        const float ex = W[(size_t)k * 1984 + sc] * g[k]; const float st = bf2f(WT[(size_t)n * 1024 + k]);
        if (!(fabsf(st - ex) <= 0.01f * fabsf(ex) + 1e-5f)) atomicAdd(cnt + 8, 1u);
    }
    for (int row = blockIdx.x * 8 + wave; row < T; row += gridDim.x * 8) {
        int pos, seq; row_info(row, pos, seq);
        const float* xr = pos < 16 ? p.in[2] + (size_t)pos * 1024 : (seq < NBP ? p.in[0] + ((size_t)seq * 8192 + (pos - 16)) * 1024 : p.in[1] + ((size_t)(seq - NBP) * 2048 + (pos - 16)) * 1024);
        float ss = 0.f;
        for (int c = lane; c < 1024; c += 64) ss += xr[c] * xr[c];
        ss = wave_sum(ss);
        const float ex = rsqrtf(ss * (1.f / 1024.f) + EPS); const float st = R0[row];
        if (lane == 0 && !(fabsf(st - ex) <= 0.001f * ex)) { atomicAdd(cnt + 9, 1u); atomicAdd(cnt + 12, (unsigned)(row >> 6)); }
    }
}
#endif

#if DEBUG_CHECK == 10
__device__ __forceinline__ void check_x(const Params& p, int mode) {
    unsigned char* ws = launder(p.ws); unsigned* cnt = (unsigned*)(ws + OFF_DBGW); unsigned* sums = (unsigned*)(ws + OFF_DBGW + MiB);
    const int tid = tid_l(), lane = tid & 63, wave = tid >> 6;
    for (int n = blockIdx.x * 8 + wave; n < TN; n += gridDim.x * 8) {
        const unsigned* xr = (const unsigned*)(n < 65536 ? p.in[0] + (size_t)n * 1024 : p.in[1] + (size_t)(n - 65536) * 1024);
        unsigned a = 0u;
        for (int c = lane; c < 1024; c += 64) a += xr[c] * (2u * (unsigned)c + 1u);
#pragma unroll
        for (int o = 1; o < 64; o <<= 1) a += __shfl_xor(a, o);
        if (lane == 0) {
            if (mode == 0) __hip_atomic_store(sums + n, a, __ATOMIC_RELAXED, __HIP_MEMORY_SCOPE_AGENT);
            else if (__hip_atomic_load(sums + n, __ATOMIC_RELAXED, __HIP_MEMORY_SCOPE_AGENT) != a) atomicAdd(cnt + 8, 1u);
        }
    }
}
#endif

#if DEBUG_CHECK == 11
__device__ __forceinline__ void check_filt_prep(const Params& p) {
    unsigned char* ws = launder(p.ws); unsigned* cnt = (unsigned*)(ws + OFF_DBGW);
    const unsigned idx = blockIdx.x * 512u + (unsigned)tid_l();
    unsigned hsh = idx * 2654435761u + 1111u; hsh ^= hsh >> 15; hsh *= 2246822519u; hsh ^= hsh >> 13;
    {
        const int set = (int)(hsh & 1u); const int L = set ? LS : LP; const int C0 = set ? LGS : LGP;
        const int n = (int)((hsh >> 1) % 2048u); hsh = hsh * 3266489917u + 668265263u; hsh ^= hsh >> 16;
        const int t = (int)(hsh % (unsigned)L);
        const float* f_w1 = p.in[10]; const float* f_b1 = p.in[11]; const float* f_freq = p.in[12]; const float* f_w2 = p.in[13];
        const float* f_b2 = p.in[14]; const float* f_w3 = p.in[15]; const float* f_decay = p.in[16];
        const float tn = (float)t / (float)(L - 1); const float w = (6.2831853071795865f * (float)t) / (float)L;
        float acc = 0.f;
        for (int j2 = 0; j2 < 64; ++j2) {
            float a2 = f_b2[j2];
            for (int j1 = 0; j1 < 64; ++j1) {
                float a1 = f_b1[j1] + tn * f_w1[j1];
                for (int k = 0; k < 16; ++k) { const float f = 1e-4f + (float)k * ((15.0f - 1e-4f) / 15.0f); float sn, cs; sincos_red(f * w, sn, cs);
                    a1 += cs * f_w1[(1 + k) * 64 + j1] - sn * f_w1[(17 + k) * 64 + j1]; }
                a2 += sin_red(f_freq[j1] * a1) * f_w2[j1 * 64 + j2];
            }
            acc += sin_red(f_freq[j2] * a2) * f_w3[j2 * 2048 + n];
        }
        const float e = acc * __expf(-tn * fabsf(f_decay[n]));
        const int order = n >> 10, dir = (n >> 9) & 1, c = n & 511;
        if (!(dir == 1 && t == 0)) {
            const bf16_t* row = (const bf16_t*)(ws + (set ? OFF_GR1 : OFF_GR0)) + (size_t)(order * 512 + c) * (2 * C0);
            const float st = bf2f(row[dir ? C0 + t : C0 - t]);
            if (!(fabsf(st - e) <= 0.02f * fabsf(e) + 0.003f)) atomicAdd(cnt + 8, 1u);
        }
    }
    {
        const int seq = (int)(hsh % 40u); const int set = seq < NBP ? 0 : 1; const int L = set ? LS : LP; const int Lg = set ? LGS : LGP; const int NB = set ? NBS : NBP;
        const int b = set ? seq - NBP : seq; const int row0 = set ? TPR + b * LS : b * LP;
        hsh = hsh * 3266489917u + 668265263u; hsh ^= hsh >> 16;
        const int pos = (int)(hsh % (unsigned)L); const int which = (int)((hsh >> 16) % 3u); const int c = (int)((hsh >> 20) % 512u);
        const bf16_t* P = (const bf16_t*)(ws + OFF_P); const float* cw = p.in[9]; const int col = 448 + which * 512 + c;
        const float um = pos > 0 ? bf2f(P[(size_t)(row0 + pos - 1) * NPP + col]) : 0.f, u0 = bf2f(P[(size_t)(row0 + pos) * NPP + col]), up = pos + 1 < L ? bf2f(P[(size_t)(row0 + pos + 1) * NPP + col]) : 0.f;
        const float e = um * cw[which * 512 + c] + u0 * cw[1536 + which * 512 + c] + up * cw[3072 + which * 512 + c];
        const bf16_t* XT = (const bf16_t*)(ws + (which == 0 ? OFF_X1T : (which == 1 ? OFF_X2T : OFF_V0T))) + (set ? XT_SET1 : 0) + ((size_t)c * NB + b) * Lg;
        const float st = bf2f(XT[pos + 48]);
        if (!(fabsf(st - e) <= 0.02f * fabsf(e) + 0.02f)) atomicAdd(cnt + 9, 1u);
    }
}
#endif
#ifndef SUB_MASK
#define SUB_MASK 15
#endif
#ifndef PHASE_MASK
#define PHASE_MASK 1023
#endif
__global__ void __launch_bounds__(512) hymba_fwd(Params p) {
    extern __shared__ __attribute__((aligned(16))) unsigned char lds_raw[];
    LAS unsigned char* lds = (LAS unsigned char*)lds_raw;
    cg::grid_group grid = cg::this_grid();
#define GSYNC() do { asm volatile("s_waitcnt vmcnt(0) lgkmcnt(0)" ::: "memory"); grid.sync(); } while (0)
    const int G = gridDim.x;
    __builtin_amdgcn_fence(__ATOMIC_SEQ_CST, "agent");
    asm volatile("buffer_inv sc1\n\ts_waitcnt vmcnt(0)" ::: "memory");
#if DEBUG_CHECK == 10
    check_x(p, 0);
#endif
#if PHASE_MASK & 1
    p0_prologue(p, lds);
#endif
    GSYNC();
#if DEBUG_CHECK == 3
    check_h0b(p, 8);
#endif
#if DEBUG_CHECK == 7
    check_h0b_full(p, 8);
#endif
#if DEBUG_CHECK == 4
    check_stale(p, (const unsigned*)(launder(p.ws) + OFF_H0B), (unsigned)((size_t)T * 512), 9);
#endif
#if PHASE_MASK & 2
    {
        unsigned char* ws = launder(p.ws); unsigned char* ob = launder((unsigned char*)p.out);
        pg8::Gemm g{(const bf16_t*)(ws + OFF_H0B), (const bf16_t*)(ws + OFF_WIN), TPAD, 2048, 1024, 1024, 1024};
        pg8::StaticOrder S; S.init(TPAD, 2048, G, blockIdx.x);
        Epi<0> E{(bf16_t*)(ws + OFF_P), NPP, (const float*)(ws + OFF_R0), (float*)(ws + OFF_SQQP), (float*)(ws + OFF_SQKVP), (bf16_t*)(ob + DO_KR), (const float2*)(ws + OFF_RT)};
        pg8::gemm_phase(lds, g, S, E);
    }
#endif
    GSYNC();
#if DEBUG_CHECK == 1
    { unsigned char* ws = launder(p.ws); check_gemm((const bf16_t*)(ws + OFF_H0B), 1024, (const bf16_t*)(ws + OFF_WIN), 1024, 1024, T, 1984, 0, (const bf16_t*)(ws + OFF_P), NPP, (const float*)(ws + OFF_R0), (unsigned*)(ws + OFF_DBG) + 0, 448); }
    GSYNC();
#endif
#if DEBUG_CHECK == 3
    check_h0b(p, 9);
#endif
#if DEBUG_CHECK == 8
    check_p_golden(p);
#endif
#if DEBUG_CHECK == 9
    check_win_r0(p);
#endif
#if DEBUG_CHECK == 7
    check_h0b_full(p, 9);
    GSYNC();
#endif
#if DEBUG_CHECK == 6
    { unsigned char* ws = launder(p.ws);
      check_gemm((const bf16_t*)(ws + OFF_H0B), 1024, (const bf16_t*)(ws + OFF_WIN), 1024, 1024, T, 448, 0, (const bf16_t*)(ws + OFF_P), NPP, (const float*)(ws + OFF_R0), (unsigned*)(ws + OFF_DBG) + 8, 384);
      check_gemm((const bf16_t*)(ws + OFF_H0B), 1024, (const bf16_t*)(ws + OFF_WIN), 1024, 1024, T, 384, 7, (const bf16_t*)(ws + OFF_P), NPP, (const float*)(ws + OFF_R0), (unsigned*)(ws + OFF_DBG) + 9, 0); }
    GSYNC();
#endif
#if DEBUG_CHECK == 4
    check_stale(p, (const unsigned*)(launder(p.ws) + OFF_P), (unsigned)((size_t)T * 1024), 8);
#endif
    rownorm_phase(p);
    krope_phase(p);
    GSYNC();
#if (PHASE_MASK & 4) && (SUB2 & 1)
    {
        unsigned char* ws = launder(p.ws); unsigned char* ob = launder((unsigned char*)p.out);
        pg8::Gemm g{(const bf16_t*)(ws + OFF_P), (const bf16_t*)(ws + OFF_WUQ), TPAD, 768, 256, NPP, 256};
        pg8::StaticOrder S; S.init(TPAD, 768, G, blockIdx.x);
        Epi<1> E{(bf16_t*)(ob + DO_Q), 768, (const float*)(ws + OFF_RQ), nullptr, nullptr, nullptr, (const float2*)(ws + OFF_RT)};
        pg8::gemm_phase(lds, g, S, E);
    }
#endif
#if (PHASE_MASK & 4) && (SUB2 & 2)
    {
        unsigned char* ws = launder(p.ws); unsigned char* ob = launder((unsigned char*)p.out);
        pg8::Gemm g{(const bf16_t*)(ws + OFF_P) + 256, (const bf16_t*)(ws + OFF_WKN), TPAD, 512, 128, NPP, 128};
        pg8::StaticOrder S; S.init(TPAD, 512, G, blockIdx.x);
        Epi<2> E{(bf16_t*)(ob + DO_KN), 512, (const float*)(ws + OFF_RKV), nullptr, nullptr, nullptr, nullptr};
        pg8::gemm_phase(lds, g, S, E);
    }
#endif
#if (PHASE_MASK & 4) && (SUB2 & 4)
    {
        unsigned char* ws = launder(p.ws); unsigned char* ob = launder((unsigned char*)p.out);
        pg8::Gemm g{(const bf16_t*)(ws + OFF_WV), (const bf16_t*)(ws + OFF_P) + 256, 512, TPAD, 128, 128, NPP};
        pg8::StaticOrder S; S.init(512, TPAD, G, blockIdx.x);
        Epi<3> E{(bf16_t*)(ob + DO_VT), TPAD, (const float*)(ws + OFF_RKV), nullptr, nullptr, nullptr, nullptr};
        pg8::gemm_phase(lds, g, S, E);
    }
#endif
#if PHASE_MASK & 8
    hyprep_phase(p, lds);
#endif
    GSYNC();
#if DEBUG_CHECK == 2
    check_proj(p);
    GSYNC();
#endif
#if DEBUG_CHECK == 11
    check_filt_prep(p);
    GSYNC();
#endif
#if PHASE_MASK & 16
    attn_phase(p, lds);
#endif
#if PHASE_MASK & 32
    hyena_phase(p, lds);
#endif
    GSYNC();
#if DEBUG_CHECK == 5
    check_attn(p);
    check_hyena(p, lds);
    GSYNC();
#endif
#if PHASE_MASK & 64
    mixnorm_phase(p, lds);
#endif
    GSYNC();
#if PHASE_MASK & 128
    {
        unsigned char* ws = launder(p.ws);
        pg8::Gemm g{(const bf16_t*)(ws + OFF_MIXN), (const bf16_t*)(ws + OFF_WO), TN, 1024, 1024, 1024, 1024};
        pg8::StaticOrder S; S.init(TN, 1024, G, blockIdx.x);
        Epi<4> E{(bf16_t*)(ws + OFF_MIX), 1024, nullptr, (float*)(ws + OFF_SQMIXP), nullptr, nullptr, nullptr};
        pg8::gemm_phase(lds, g, S, E);
    }
#endif
    GSYNC();
#if DEBUG_CHECK == 1
    { unsigned char* ws = launder(p.ws); check_gemm((const bf16_t*)(ws + OFF_MIXN), 1024, (const bf16_t*)(ws + OFF_WO), 1024, 1024, TN, 1024, 4, (const bf16_t*)(ws + OFF_MIX), 1024, nullptr, (unsigned*)(ws + OFF_DBG) + 1, 0); }
#endif
#if DEBUG_CHECK == 10
    check_x(p, 1);
#endif
#if PHASE_MASK & 256
    h1_phase(p);
#endif
    GSYNC();
#if PHASE_MASK & 512
#if DEBUG_CHECK == 1
#define DBG_FF1(half) if ((half) == 0) { unsigned char* ws = launder(p.ws); check_gemm((const bf16_t*)(ws + OFF_H1B), 1024, (const bf16_t*)(ws + OFF_WF1), 1024, 1024, 65536, 4096, 5, (const bf16_t*)(ws + OFF_M), 4096, (const float*)(ws + OFF_R1), (unsigned*)(ws + OFF_DBG) + 2, 0); }
#define DBG_FF2(half) if ((half) == 0) { unsigned char* ws = launder(p.ws); check_gemm((const bf16_t*)(ws + OFF_M), 4096, (const bf16_t*)(ws + OFF_WF2), 4096, 4096, 65536, 1024, 6, (const bf16_t*)(ws + OFF_M2), 1024, nullptr, (unsigned*)(ws + OFF_DBG) + 3, 0); } GSYNC();
#else
#define DBG_FF1(half)
#define DBG_FF2(half)
#endif
#define FFN_HALF(half) \
    { \
        unsigned char* ws = launder(p.ws); \
        pg8::Gemm g{(const bf16_t*)(ws + OFF_H1B) + (size_t)(half) * 65536 * 1024, (const bf16_t*)(ws + OFF_WF1), 65536, 4096, 1024, 1024, 1024}; \
        pg8::StaticOrder S; S.init(65536, 4096, G, blockIdx.x); \
        Epi<5> E{(bf16_t*)(ws + OFF_M), 4096, (const float*)(ws + OFF_R1) + (half) * 65536, nullptr, nullptr, nullptr, nullptr}; \
        pg8::gemm_phase(lds, g, S, E); \
    } \
    GSYNC(); \
    DBG_FF1(half) \
    { \
        unsigned char* ws = launder(p.ws); \
        pg8::Gemm g{(const bf16_t*)(ws + OFF_M), (const bf16_t*)(ws + OFF_WF2), 65536, 1024, 4096, 4096, 4096}; \
        pg8::StaticOrder S; S.init(65536, 1024, G, blockIdx.x); \
        Epi<6> E{(bf16_t*)(ws + OFF_M2), 1024, nullptr, (float*)(ws + OFF_SQM2P) + (size_t)(half) * 65536 * 16, nullptr, nullptr, nullptr}; \
        pg8::gemm_phase(lds, g, S, E); \
    } \
    GSYNC(); \
    DBG_FF2(half) \
    final_phase(p, half);
    FFN_HALF(0)
    FFN_HALF(1)
#undef FFN_HALF
#endif
}

extern "C" void kernel_launch(void* const* d_in, const int* in_sizes, int n_in, void* d_out, int out_size, void* d_ws, size_t ws_size, hipStream_t stream) {
    static int grid = 0;
    if (grid == 0) {
        int dev = 0, cus = 0, per_cu = 0;
        hipGetDevice(&dev);
        hipDeviceGetAttribute(&cus, hipDeviceAttributeMultiprocessorCount, dev);
        hipFuncSetAttribute((const void*)hymba_fwd, hipFuncAttributeMaxDynamicSharedMemorySize, LDS_BYTES);
        hipOccupancyMaxActiveBlocksPerMultiprocessor(&per_cu, (const void*)hymba_fwd, 512, LDS_BYTES);
        if (per_cu < 1) per_cu = 1;
        grid = cus * 1;
        if (n_in != 26 || ws_size < 1024 * MiB) fprintf(stderr, "kernel_launch: unexpected n_in %d / ws_size %zu\n", n_in, ws_size);
    }
    Params p{};
    for (int i = 0; i < 26; ++i) p.in[i] = (const float*)d_in[i];
    p.out = (float*)d_out; p.ws = (unsigned char*)d_ws;
    void* args[] = {&p};
    hipError_t e = hipLaunchCooperativeKernel((const void*)hymba_fwd, dim3(grid), dim3(512), args, LDS_BYTES, stream);
    if (e != hipSuccess) fprintf(stderr, "cooperative launch failed: %s (grid %d)\n", hipGetErrorString(e), grid);
}
```

```cpp
#include <hip/hip_runtime.h>
#include <hip/hip_cooperative_groups.h>
#include <cstdio>
#include <cstdint>
namespace cg = cooperative_groups;
#ifndef DBG_SEL0
#define DBG_SEL0 3
#endif
#ifndef DBG_SEL1
#define DBG_SEL1 0
#endif
#ifndef DEBUG_CHECK
#define DEBUG_CHECK 0
#endif
#ifndef EXPT
#define EXPT 0
#endif
#ifndef SUB_MASK
#define SUB_MASK 15
#endif
#ifndef SUB2
#define SUB2 7
#endif

#define LAS __attribute__((address_space(3)))
#define GAS __attribute__((address_space(1)))
typedef unsigned short bf16_t;
typedef short bf16x8 __attribute__((ext_vector_type(8)));
typedef float f32x4 __attribute__((ext_vector_type(4)));
typedef float f32x16 __attribute__((ext_vector_type(16)));
typedef unsigned u32x4 __attribute__((ext_vector_type(4)));
typedef unsigned u32x2 __attribute__((ext_vector_type(2)));

constexpr int DM = 1024, LP = 8208, LS = 2064, NBP = 8, NBS = 32;
constexpr int TPR = NBP * LP;
constexpr int TSR = NBS * LS;
constexpr int T = TPR + TSR;
constexpr int TPAD = 131840;
constexpr int TN = 131072;
constexpr int NPP = 2048;
constexpr int LGP = 8256, LGS = 2112;
constexpr float EPS = 1e-6f;
constexpr float QSCALE = 0.07216878364870322f * 1.4426950408889634f;

constexpr size_t MiB = 1ull << 20;
constexpr size_t OFF_H0B = 0;
constexpr size_t XT_SET1 = (size_t)512 * NBP * LGP;
constexpr size_t OFF_X1T = 0;
constexpr size_t OFF_X2T = 131 * MiB;
constexpr size_t OFF_P = 262 * MiB;
constexpr size_t OFF_V0T = 778 * MiB;
constexpr size_t OFF_MIXN = 262 * MiB;
constexpr size_t OFF_MIX = 518 * MiB;
constexpr size_t OFF_H1B = 0;
constexpr size_t OFF_M = 256 * MiB;
constexpr size_t OFF_M2 = 768 * MiB;
constexpr size_t OFF_SQMIXP = 896 * MiB;
constexpr size_t OFF_SQM2P = 904 * MiB;
constexpr size_t OFF_SMALL = 912 * MiB;
constexpr size_t OFF_WIN = OFF_SMALL;
constexpr size_t OFF_WUQ = OFF_SMALL + 4 * MiB;
constexpr size_t OFF_WKN = OFF_SMALL + 4 * MiB + 512 * 1024;
constexpr size_t OFF_WV = OFF_SMALL + 4 * MiB + 768 * 1024;
constexpr size_t OFF_WO = OFF_SMALL + 5 * MiB;
constexpr size_t OFF_WF1 = OFF_SMALL + 7 * MiB;
constexpr size_t OFF_WF2 = OFF_SMALL + 15 * MiB;
constexpr size_t OFF_GR0 = OFF_SMALL + 23 * MiB;
constexpr size_t OFF_GR1 = OFF_SMALL + 56 * MiB;
constexpr size_t OFF_RT = OFF_SMALL + 65 * MiB;
constexpr size_t OFF_R0 = OFF_SMALL + 68 * MiB;
constexpr size_t OFF_R1 = OFF_SMALL + 69 * MiB;
constexpr size_t OFF_RQ = OFF_SMALL + 70 * MiB;
constexpr size_t OFF_RKV = OFF_SMALL + 71 * MiB;
constexpr size_t OFF_SQQP = OFF_SMALL + 72 * MiB;
constexpr size_t OFF_SQKVP = OFF_SMALL + 75 * MiB;
constexpr size_t OFF_DBGW = OFF_SMALL + 78 * MiB;
constexpr size_t DO_Q = 0;
constexpr size_t DO_KN = 194 * MiB;
constexpr size_t DO_KR = 323 * MiB;
constexpr size_t DO_VT = 340 * MiB;

constexpr size_t OFF_ODBG = 518 * MiB;
constexpr size_t OFF_HDBG = 647 * MiB;
constexpr int LDS_BYTES = 147456;

struct Params {
    const float* in[26];
    float* out;
    unsigned char* ws;
};

__device__ __forceinline__ f32x4 ld_sys(const float* q) { f32x4 v; asm volatile("global_load_dwordx4 %0, %1, off sc0 sc1\n\ts_waitcnt vmcnt(0)" : "=v"(v) : "v"(q) : "memory"); return v; }
__device__ __forceinline__ float ldco(const float* q) { return __builtin_bit_cast(float, __hip_atomic_load((const unsigned*)q, __ATOMIC_RELAXED, __HIP_MEMORY_SCOPE_AGENT)); }
__device__ __forceinline__ float2 ldco2(const float2* q) { const unsigned long long w = __hip_atomic_load((const unsigned long long*)q, __ATOMIC_RELAXED, __HIP_MEMORY_SCOPE_AGENT); return make_float2(__builtin_bit_cast(float, (unsigned)w), __builtin_bit_cast(float, (unsigned)(w >> 32))); }
template <class Tp> __device__ __forceinline__ Tp* launder(Tp* q) { asm volatile("" : "+s"(q)); return q; }
__device__ __forceinline__ int tid_l() { int t = threadIdx.x; asm volatile("" : "+v"(t)); return t; }
__device__ __forceinline__ unsigned cvt_pk_bf16(float lo, float hi) { unsigned r; asm volatile("v_cvt_pk_bf16_f32 %0, %1, %2" : "=v"(r) : "v"(lo), "v"(hi)); return r; }
__device__ __forceinline__ float bf2f(unsigned short b) { return __builtin_bit_cast(float, (unsigned)b << 16); }
__device__ __forceinline__ float bflo(unsigned w) { return __builtin_bit_cast(float, w << 16); }
__device__ __forceinline__ float bfhi(unsigned w) { return __builtin_bit_cast(float, w & 0xffff0000u); }
__device__ __forceinline__ float wave_sum(float v) {
#pragma unroll
    for (int o = 1; o < 64; o <<= 1) v += __shfl_xor(v, o);
    return v;
}
__device__ __forceinline__ void sincos_red(float x, float& s, float& c) {
    const double xd = (double)x; const double k = rint(xd * 0.15915494309189535); const float r = (float)(xd - k * 6.283185307179586);
    s = __sinf(r); c = __cosf(r);
}
__device__ __forceinline__ float sin_red(float x) { float s, c; sincos_red(x, s, c); return s; }
__device__ __forceinline__ void row_info(int r, int& pos, int& seq) {
    if (r < TPR) { seq = r / LP; pos = r - seq * LP; }
    else { int q = r - TPR; if (q >= TSR) q = TSR - 1; const int b = q / LS; pos = q - b * LS; seq = NBP + b; }
}
__device__ __forceinline__ int full_row(int n) {
    if (n < 65536) { const int b = n >> 13; return b * LP + 16 + (n & 8191); }
    const int q = n - 65536; const int b = q >> 11; return TPR + b * LS + 16 + (q & 2047);
}

namespace pg8 {
constexpr int BM = 256, BK = 64, HALF = 128, HTB = HALF * BK * 2, STAGE_BYTES = 8 * HTB, NXCD = 8, WGM = 8;
__host__ __device__ __forceinline__ int lds_byte(int r, int c) { const int st = (r >> 4) * 2 + (c >> 5), rr = r & 15, cc = c & 31, ob = rr * 64 + cc * 2; return st * 1024 + (ob ^ (((ob >> 9) & 1) << 5)); }
__host__ __device__ __forceinline__ void stage_rc(int b, int& R, int& C) { const int st = b / 1024, sb = b % 1024, swz = sb ^ (((sb >> 9) & 1) << 5); R = (st >> 1) * 16 + swz / 64; C = (st & 1) * 32 + (swz % 64) / 2; }
__host__ __device__ __forceinline__ int perm32(int rho) { const int n = rho >> 4, i = rho & 15; return 8 * (i >> 2) + 4 * n + (i & 3); }
struct Unit { int pm, pn; };
struct Gemm { const bf16_t* A; const bf16_t* Bt; int M, N, K, lda, ldb; };
struct StaticOrder {
    int nM, nN, nwg, G, c;
    __device__ void init(int M, int N, int G_, int c_) { nM = M / BM; nN = N / BM; nwg = nM * nN; G = G_; c = c_; }
    __device__ bool next(int i, Unit& u) const {
        const long L = (long)i * G + c; if (L >= nwg) return false;
        int wgid = (int)L; { const int q = nwg / NXCD, r = nwg % NXCD, xcd = wgid % NXCD, off = wgid / NXCD; wgid = (xcd < r ? xcd * (q + 1) : r * (q + 1) + (xcd - r) * q) + off; }
        const int nig = WGM * nN, gid = wgid / nig, fm = gid * WGM, gsz = (nM - fm) < WGM ? (nM - fm) : WGM;
        u.pm = fm + ((wgid % nig) % gsz); u.pn = (wgid % nig) / gsz; return true;
    }
};
template <class Epi>
__device__ __forceinline__ void gemm_phase(LAS unsigned char* lds, const Gemm g, const StaticOrder& S, const Epi& E) {
    const int tid = tid_l(), wid = __builtin_amdgcn_readfirstlane(tid >> 6), lane = tid & 63, wr = wid >> 2, wc = wid & 3, fr = lane & 15, fq = lane >> 4;
    const int K = g.K, nt = K / BK;
    unsigned voffA[2], voffB[2];
#pragma unroll
    for (int i = 0; i < 2; ++i) { int R, C; stage_rc(tid * 16 + i * 8192, R, C); const int Rb = (R & ~31) + perm32(R & 31);
        voffA[i] = (unsigned)(R * g.lda + C) * 2u; voffB[i] = (unsigned)(Rb * g.ldb + C) * 2u; }
    const size_t kstep = (size_t)(BK * 2);
    const size_t hstepA = (size_t)HALF * g.lda * 2, hstepB = (size_t)HALF * g.ldb * 2;
    const size_t tstepA = 2 * hstepA, tstepB = 2 * hstepB;
    const unsigned ldsw = (unsigned)wid * 1024u;
    const int aoff = lds_byte(wr * 64 + fr, fq * 8), boff = lds_byte(wc * 32 + fr, fq * 8);
#define PG8_SA(b, h) (((b) * 2 + (h)) * HTB)
#define PG8_SB(b, h) ((4 + (b) * 2 + (h)) * HTB)
#define PG8_STAGE(bufoff, gbase, voff) do { _Pragma("unroll") for (int _i = 0; _i < 2; ++_i) \
        __builtin_amdgcn_global_load_lds((const unsigned*)((const char*)(gbase) + (voff)[_i]), (LAS unsigned*)(lds + (bufoff) + ldsw + _i * 8192), 16, 0, 0); } while (0)
#define PG8_LDA(dst, b, h) do { _Pragma("unroll") for (int m = 0; m < 4; ++m) _Pragma("unroll") for (int k = 0; k < 2; ++k) dst[m][k] = *(const LAS bf16x8*)(lds + PG8_SA(b, h) + aoff + m * 2048 + k * 1024); } while (0)
#define PG8_LDB(dst, b, h) do { _Pragma("unroll") for (int n = 0; n < 2; ++n) _Pragma("unroll") for (int k = 0; k < 2; ++k) dst[n][k] = *(const LAS bf16x8*)(lds + PG8_SB(b, h) + boff + n * 2048 + k * 1024); } while (0)
#define PG8_MMA(ai, bj, At, Bt) do { __builtin_amdgcn_s_setprio(1); _Pragma("unroll") for (int m = 0; m < 4; ++m) _Pragma("unroll") for (int n = 0; n < 2; ++n) _Pragma("unroll") for (int k = 0; k < 2; ++k) \
        acc[ai][bj][m][n] = __builtin_amdgcn_mfma_f32_16x16x32_bf16(Bt[n][k], At[m][k], acc[ai][bj][m][n], 0, 0, 0); __builtin_amdgcn_s_setprio(0); } while (0)
#define PG8_WAIT_V(n) asm volatile("s_waitcnt vmcnt(" #n ")" ::: "memory")
#define PG8_WAIT_L(n) asm volatile("s_waitcnt lgkmcnt(" #n ")" ::: "memory")
#define PG8_BAR __builtin_amdgcn_s_barrier()
#define PG8_SCHED __builtin_amdgcn_sched_barrier(0)
    Unit cur, nxt; int ui = 0;
    if (!S.next(0, cur)) return;
    f32x4 acc[2][2][4][2];
#pragma unroll
    for (int a = 0; a < 2; ++a)
#pragma unroll
        for (int b = 0; b < 2; ++b)
#pragma unroll
            for (int m = 0; m < 4; ++m)
#pragma unroll
                for (int n = 0; n < 2; ++n) acc[a][b][m][n] = (f32x4){0.f, 0.f, 0.f, 0.f};
    bf16x8 At[4][2], B0[2][2], B1[2][2];
    const char* cA = (const char*)g.A + (size_t)cur.pm * tstepA; const char* cB = (const char*)g.Bt + (size_t)cur.pn * tstepB;
    PG8_STAGE(PG8_SB(0, 0), cB, voffB); PG8_STAGE(PG8_SB(0, 1), cB + hstepB, voffB); PG8_STAGE(PG8_SA(0, 0), cA, voffA); PG8_STAGE(PG8_SA(0, 1), cA + hstepA, voffA);
    if (wr == 1) PG8_BAR;
    PG8_WAIT_V(2); PG8_BAR;
    PG8_STAGE(PG8_SB(1, 0), cB + kstep, voffB); PG8_STAGE(PG8_SA(1, 0), cA + kstep, voffA); PG8_STAGE(PG8_SB(1, 1), cB + hstepB + kstep, voffB);
    PG8_WAIT_V(6); PG8_BAR;
    for (;;) {
        const bool has_next = S.next(ui + 1, nxt);
        const char* nA = has_next ? (const char*)g.A + (size_t)nxt.pm * tstepA : cA; const char* nB = has_next ? (const char*)g.Bt + (size_t)nxt.pn * tstepB : cB;
        for (int t = 0; t < nt; t += 2) {
            const bool last = (t == nt - 2);
            const char* a1 = cA + (size_t)(t + 1) * kstep;
            const char* a2 = last ? nA : cA + (size_t)(t + 2) * kstep; const char* b2 = last ? nB : cB + (size_t)(t + 2) * kstep;
            const char* a3 = a2 + kstep; const char* b3 = b2 + kstep;
            PG8_LDB(B0, 0, 0); PG8_LDB(B1, 0, 1); PG8_SCHED; PG8_LDA(At, 0, 0); PG8_STAGE(PG8_SA(1, 1), a1 + hstepA, voffA);
            PG8_WAIT_V(8); PG8_WAIT_L(0); PG8_BAR; PG8_MMA(0, 0, At, B0); PG8_MMA(0, 1, At, B1); PG8_BAR; PG8_SCHED;
            PG8_LDA(At, 0, 1); PG8_STAGE(PG8_SB(0, 0), b2, voffB); PG8_STAGE(PG8_SB(0, 1), b2 + hstepB, voffB); PG8_STAGE(PG8_SA(0, 0), a2, voffA);
            PG8_WAIT_V(8); PG8_WAIT_L(0); PG8_BAR; PG8_MMA(1, 0, At, B0); PG8_MMA(1, 1, At, B1); PG8_BAR; PG8_SCHED;
            PG8_LDB(B0, 1, 0); PG8_LDB(B1, 1, 1); PG8_SCHED; PG8_LDA(At, 1, 0); PG8_STAGE(PG8_SA(0, 1), a2 + hstepA, voffA);
            PG8_WAIT_V(8); PG8_WAIT_L(0); PG8_BAR; PG8_MMA(0, 0, At, B0); PG8_MMA(0, 1, At, B1); PG8_BAR; PG8_SCHED;
            PG8_LDA(At, 1, 1); PG8_STAGE(PG8_SB(1, 0), b3, voffB); PG8_STAGE(PG8_SB(1, 1), b3 + hstepB, voffB); PG8_STAGE(PG8_SA(1, 0), a3, voffA);
            PG8_WAIT_V(8); PG8_WAIT_L(0); PG8_BAR; PG8_MMA(1, 0, At, B0); PG8_MMA(1, 1, At, B1); PG8_BAR; PG8_SCHED;
        }
        if (wr == 0) PG8_BAR;
        E(acc, cur, wr, wc, fr, fq);
        if (!has_next) break;
#pragma unroll
        for (int a = 0; a < 2; ++a)
#pragma unroll
            for (int b = 0; b < 2; ++b)
#pragma unroll
                for (int m = 0; m < 4; ++m)
#pragma unroll
                    for (int n = 0; n < 2; ++n) acc[a][b][m][n] = (f32x4){0.f, 0.f, 0.f, 0.f};
        cur = nxt; cA = nA; cB = nB; ++ui;
        if (wr == 1) PG8_BAR;
    }
    PG8_WAIT_V(0);
    PG8_BAR;
#undef PG8_SA
#undef PG8_SB
#undef PG8_STAGE
#undef PG8_LDA
#undef PG8_LDB
#undef PG8_MMA
#undef PG8_WAIT_V
#undef PG8_WAIT_L
#undef PG8_BAR
#undef PG8_SCHED
}
}

__device__ __forceinline__ void rope8(f32x4& v0, f32x4& v1, const float2* rt  ) {
    const float2 c0 = ldco2(rt), c1 = ldco2(rt + 1), c2 = ldco2(rt + 2), c3 = ldco2(rt + 3);
    float a, b;
    a = v0[0]; b = v0[1]; v0[0] = a * c0.x - b * c0.y; v0[1] = b * c0.x + a * c0.y;
    a = v0[2]; b = v0[3]; v0[2] = a * c1.x - b * c1.y; v0[3] = b * c1.x + a * c1.y;
    a = v1[0]; b = v1[1]; v1[0] = a * c2.x - b * c2.y; v1[1] = b * c2.x + a * c2.y;
    a = v1[2]; b = v1[3]; v1[2] = a * c3.x - b * c3.y; v1[3] = b * c3.x + a * c3.y;
}
__device__ __forceinline__ u32x4 pack8(const f32x4& v0, const f32x4& v1) {
    u32x4 w; w.x = cvt_pk_bf16(v0[0], v0[1]); w.y = cvt_pk_bf16(v0[2], v0[3]); w.z = cvt_pk_bf16(v1[0], v1[1]); w.w = cvt_pk_bf16(v1[2], v1[3]); return w;
}
__device__ __forceinline__ float sq8(const f32x4& a, const f32x4& b) {
    return (a[0] * a[0] + a[1] * a[1]) + (a[2] * a[2] + a[3] * a[3]) + (b[0] * b[0] + b[1] * b[1]) + (b[2] * b[2] + b[3] * b[3]);
}
template <int MODE> struct Epi {
    bf16_t* O; int ldc; const float* rs; float* sq0; float* sq1; bf16_t* KR; const float2* RT;
    __device__ __forceinline__ void operator()(const f32x4 (&acc)[2][2][4][2], const pg8::Unit& u, int wr, int wc, int fr, int fq) const {
#pragma unroll
        for (int ai = 0; ai < 2; ++ai)
#pragma unroll
            for (int m = 0; m < 4; ++m) {
                const int row = u.pm * 256 + ai * 128 + wr * 64 + m * 16 + fr;
                float sc = 1.f;
                if (MODE == 0 || MODE == 1 || MODE == 2 || MODE == 5) sc = ldco(rs + row);
                float ssum[2];
#pragma unroll
                for (int bj = 0; bj < 2; ++bj) {
                    const int col0 = u.pn * 256 + bj * 128 + wc * 32 + 8 * fq;
                    f32x4 v0 = acc[ai][bj][m][0] * sc, v1 = acc[ai][bj][m][1] * sc;
                    if (MODE == 3) {
#pragma unroll
                        for (int j = 0; j < 4; ++j) { v0[j] *= ldco(rs + col0 + j); v1[j] *= ldco(rs + col0 + 4 + j); }
                    }
                    if (MODE == 5) {
#pragma unroll
                        for (int j = 0; j < 4; ++j) { const float a = fmaxf(v0[j], 0.f), b = fmaxf(v1[j], 0.f); v0[j] = a * a; v1[j] = b * b; }
                    }
                    ssum[bj] = sq8(v0, v1);
                    *(u32x4*)(O + (size_t)row * ldc + col0) = pack8(v0, v1);
                }
                if (MODE == 0) {
                    if (u.pn == 0) { float s = ssum[0] + ssum[1]; s += __shfl_xor(s, 16); s += __shfl_xor(s, 32); if (fq == 0) sq0[row * 4 + wc] = s; }
                    else if (u.pn == 1) { float s = ssum[0]; s += __shfl_xor(s, 16); s += __shfl_xor(s, 32); if (fq == 0) sq1[row * 4 + wc] = s; }
                }
                if (MODE == 4 || MODE == 6) { float s = ssum[0] + ssum[1]; s += __shfl_xor(s, 16); s += __shfl_xor(s, 32); if (fq == 0) sq0[(size_t)row * 16 + u.pn * 4 + wc] = s; }
            }
    }
};

__device__ __forceinline__ int src_col(int mode, int n) {
    if (mode == 0) return n;
    if (mode == 1) { if (n >= 1984) return -1; if (n >= 384 && n < 448) { const int j = n - 384; return 384 + ((j & 1) ? 32 + (j >> 1) : (j >> 1)); } return n; }
    if (mode == 2) { const int h = n / 192, w = n % 192; if (w < 128) return n; const int j = w - 128; return h * 192 + 128 + ((j & 1) ? 32 + (j >> 1) : (j >> 1)); }
    if (mode == 3) return (n >> 7) * 256 + (n & 127);
    return (n >> 7) * 256 + 128 + (n & 127);
}
__device__ __forceinline__ void conv_weight(const float* W, const float* g, bf16_t* out, int K, int Nsrc, int Nout, int mode, int gtid, int gthreads) {
    const int nch = Nout * (K / 8);
    for (int e = gtid; e < nch; e += gthreads) {
        const int n = e % Nout, kc = e / Nout, k0 = kc * 8; const int sc = src_col(mode, n);
        float v[8];
#pragma unroll
        for (int j = 0; j < 8; ++j) v[j] = (sc >= 0) ? W[(size_t)(k0 + j) * Nsrc + sc] * (g ? g[k0 + j] : 1.f) : 0.f;
        u32x4 w; w.x = cvt_pk_bf16(v[0], v[1]); w.y = cvt_pk_bf16(v[2], v[3]); w.z = cvt_pk_bf16(v[4], v[5]); w.w = cvt_pk_bf16(v[6], v[7]);
        *(u32x4*)(out + (size_t)n * K + k0) = w;
    }
}

__device__ __forceinline__ void p0_prologue(const Params& p, LAS unsigned char* lds) {
    unsigned char* ws = launder(p.ws);
    const int tid = tid_l(), lane = tid & 63, wave = tid >> 6, G = gridDim.x;
    const int gtid = blockIdx.x * 512 + tid, gthreads = G * 512;
    const int gw = blockIdx.x * 8 + wave, NGW = G * 8;
#if SUB_MASK & 1
    conv_weight(p.in[4], p.in[3], (bf16_t*)(ws + OFF_WIN), 1024, 1984, 2048, 1, gtid, gthreads);
    conv_weight(p.in[6], p.in[5], (bf16_t*)(ws + OFF_WUQ), 256, 768, 768, 2, gtid, gthreads);
    conv_weight(p.in[8], p.in[7], (bf16_t*)(ws + OFF_WKN), 128, 1024, 512, 3, gtid, gthreads);
    conv_weight(p.in[8], p.in[7], (bf16_t*)(ws + OFF_WV), 128, 1024, 512, 4, gtid, gthreads);
    conv_weight(p.in[20], nullptr, (bf16_t*)(ws + OFF_WO), 1024, 1024, 1024, 0, gtid, gthreads);
    conv_weight(p.in[23], p.in[22], (bf16_t*)(ws + OFF_WF1), 1024, 4096, 4096, 0, gtid, gthreads);
    conv_weight(p.in[24], nullptr, (bf16_t*)(ws + OFF_WF2), 4096, 1024, 1024, 0, gtid, gthreads);
#endif
#if SUB_MASK & 2
#if DEBUG_CHECK
    if (blockIdx.x == 0 && tid < 64) ((unsigned*)(ws + OFF_DBGW))[tid] = 0u;
#endif
    {
        float2* RT = (float2*)(ws + OFF_RT);
        for (int e = gtid; e < LP * 32; e += gthreads) {
            const int pos = e >> 5, i = e & 31;
            const float inv = 1.0f / exp2f((float)i * (13.287712379549449f / 32.f));
            float s, c; sincos_red((float)pos * inv, s, c);
            RT[e] = make_float2(c, s);
        }
    }
#endif
#if SUB_MASK & 4
    {
        bf16_t* h0b = (bf16_t*)(ws + OFF_H0B); float* r0 = (float*)(ws + OFF_R0);
        for (int r = gw; r < TPAD; r += NGW) {
            u32x2* o = (u32x2*)(h0b + (size_t)r * 1024) + lane;
            if (r >= T) {
#pragma unroll
                for (int j = 0; j < 4; ++j) o[64 * j] = (u32x2){0u, 0u};
                if (lane == 0) __hip_atomic_store(r0 + r, 0.f, __ATOMIC_RELAXED, __HIP_MEMORY_SCOPE_AGENT);
                continue;
            }
            int pos, seq; row_info(r, pos, seq);
            const float* src = pos < 16 ? p.in[2] + (size_t)pos * 1024
                                        : (seq < NBP ? p.in[0] + ((size_t)seq * 8192 + (pos - 16)) * 1024 : p.in[1] + ((size_t)(seq - NBP) * 2048 + (pos - 16)) * 1024);
            const f32x4* xr = (const f32x4*)src + lane;
            f32x4 v[4]; float ss = 0.f;
#pragma unroll
            for (int j = 0; j < 4; ++j) { v[j] = xr[64 * j]; ss += (v[j][0] * v[j][0] + v[j][1] * v[j][1]) + (v[j][2] * v[j][2] + v[j][3] * v[j][3]); }
            ss = wave_sum(ss);
#pragma unroll
            for (int j = 0; j < 4; ++j) o[64 * j] = (u32x2){cvt_pk_bf16(v[j][0], v[j][1]), cvt_pk_bf16(v[j][2], v[j][3])};
            if (lane == 0) __hip_atomic_store(r0 + r, rsqrtf(ss * (1.f / 1024.f) + EPS), __ATOMIC_RELAXED, __HIP_MEMORY_SCOPE_AGENT);
        }
    }
#endif
#if SUB_MASK & 8
    {
        const float* f_w1 = p.in[10]; const float* f_b1 = p.in[11]; const float* f_freq = p.in[12]; const float* f_w2 = p.in[13];
        const float* f_b2 = p.in[14]; const float* f_w3 = p.in[15]; const float* f_decay = p.in[16];
        LAS float* feats = (LAS float*)lds;
        LAS float* h1 = feats + 16 * 34;
        LAS float* h2 = h1 + 16 * 64;
        for (int u = blockIdx.x; u < 513 + 129; u += G) {
            const int set = u < 513 ? 0 : 1; const int t0 = 16 * (set ? u - 513 : u); const int L = set ? LS : LP; const int C0 = set ? LGS : LGP;
            bf16_t* GR = (bf16_t*)(ws + (set ? OFF_GR1 : OFF_GR0));
            const float invLm1 = 1.0f / (float)(L - 1);
            if (tid < 256) {
                const int tt = tid >> 4, k = tid & 15; const int t = t0 + tt;
                const float w = (6.2831853071795865f * (float)t) / (float)L;
                const float f = 1e-4f + (float)k * ((15.0f - 1e-4f) / 15.0f);
                float s, c; sincos_red(f * w, s, c);
                feats[tt * 34 + 1 + k] = c; feats[tt * 34 + 17 + k] = -s;
                if (k == 0) feats[tt * 34] = (float)t * invLm1;
            }
            __syncthreads();
#pragma unroll 1
            for (int q = 0; q < 2; ++q) {
                const int o = tid + 512 * q, tt = o >> 6, j = o & 63;
                float a = f_b1[j];
#pragma unroll 3
                for (int e = 0; e < 33; ++e) a += feats[tt * 34 + e] * f_w1[e * 64 + j];
                h1[tt * 64 + j] = sin_red(f_freq[j] * a);
            }
            __syncthreads();
#pragma unroll 1
            for (int q = 0; q < 2; ++q) {
                const int o = tid + 512 * q, tt = o >> 6, j = o & 63;
                float a = f_b2[j];
#pragma unroll 4
                for (int e = 0; e < 64; ++e) a += h1[tt * 64 + e] * f_w2[e * 64 + j];
                h2[tt * 64 + j] = sin_red(f_freq[j] * a);
            }
            __syncthreads();
            {
                float a[4][16];
#pragma unroll
                for (int q = 0; q < 4; ++q)
#pragma unroll
                    for (int i = 0; i < 16; ++i) a[q][i] = 0.f;
#pragma unroll 2
                for (int j = 0; j < 64; ++j) {
                    float hv[16];
#pragma unroll
                    for (int i = 0; i < 16; ++i) hv[i] = h2[i * 64 + j];
#pragma unroll
                    for (int q = 0; q < 4; ++q) {
                        const float w = f_w3[j * 2048 + tid + 512 * q];
#pragma unroll
                        for (int i = 0; i < 16; ++i) a[q][i] += hv[i] * w;
                    }
                }
#pragma unroll
                for (int q = 0; q < 4; ++q) {
                    const int n = tid + 512 * q;
                    const float dec = fabsf(f_decay[n]);
                    const int order = n >> 10, dir = (n >> 9) & 1, c = n & 511;
                    bf16_t* row = GR + (size_t)(order * 512 + c) * (2 * C0);
#pragma unroll
                    for (int i = 0; i < 16; ++i) {
                        const int t = t0 + i;
                        const float val = a[q][i] * __expf(-((float)t * invLm1) * dec);
                        const unsigned short b = (unsigned short)(cvt_pk_bf16(val, 0.f) & 0xffffu);
                        if (dir == 0) row[C0 - t] = b; else if (t > 0) row[C0 + t] = b;
                    }
                }
            }
            __syncthreads();
        }
        for (int e = gtid; e < 2 * 1024 * 97; e += gthreads) {
            const int set = e / (1024 * 97), r = (e / 97) % 1024, i = e % 97; const int L = set ? LS : LP; const int C0 = set ? LGS : LGP;
            bf16_t* row = (bf16_t*)(ws + (set ? OFF_GR1 : OFF_GR0)) + (size_t)r * (2 * C0);
            const int idx = i < 49 ? i : C0 + L + (i - 49);
            row[idx] = 0;
        }
    }
#endif
}

__device__ __forceinline__ void rownorm_phase(const Params& p) {
    unsigned char* ws = launder(p.ws); const int gtid = blockIdx.x * 512 + tid_l(), gthreads = gridDim.x * 512;
    const float* sqq = (const float*)(ws + OFF_SQQP); const float* sqkv = (const float*)(ws + OFF_SQKVP);
    float* rq = (float*)(ws + OFF_RQ); float* rkv = (float*)(ws + OFF_RKV);
    for (int r = gtid; r < TPAD; r += gthreads) {
        const float a = (ldco(sqq + r * 4) + ldco(sqq + r * 4 + 1)) + (ldco(sqq + r * 4 + 2) + ldco(sqq + r * 4 + 3));
        const float b = (ldco(sqkv + r * 4) + ldco(sqkv + r * 4 + 1)) + (ldco(sqkv + r * 4 + 2) + ldco(sqkv + r * 4 + 3));
        rq[r] = rsqrtf(a * (1.f / 256.f) + EPS) * QSCALE; rkv[r] = rsqrtf(b * (1.f / 128.f) + EPS);
    }
}
__device__ __forceinline__ void krope_phase(const Params& p) {
    unsigned char* ws = launder(p.ws); unsigned char* ob = launder((unsigned char*)p.out);
    const int gtid = blockIdx.x * 512 + tid_l(), gthreads = gridDim.x * 512;
    const bf16_t* P = (const bf16_t*)(ws + OFF_P); bf16_t* KR = (bf16_t*)(ob + DO_KR); const float2* RT = (const float2*)(ws + OFF_RT);
    for (int e = gtid; e < TPAD * 8; e += gthreads) {
        const int row = e >> 3, ch = e & 7;
        int pos, seq; row_info(row, pos, seq);
        const u32x4 v = *(const u32x4*)(P + (size_t)row * NPP + 384 + ch * 8);
        f32x4 v0 = (f32x4){bflo(v.x), bfhi(v.x), bflo(v.y), bfhi(v.y)}, v1 = (f32x4){bflo(v.z), bfhi(v.z), bflo(v.w), bfhi(v.w)};
        rope8(v0, v1, RT + pos * 32 + ch * 4);
        *(u32x4*)(KR + (size_t)row * 64 + ch * 8) = pack8(v0, v1);
    }
}
__device__ __forceinline__ void hyprep_phase(const Params& p, LAS unsigned char* lds) {
    unsigned char* ws = launder(p.ws); const int tid = tid_l(), G = gridDim.x;
    const bf16_t* P = (const bf16_t*)(ws + OFF_P); const float* conv_w = p.in[9];
    constexpr int RSB = 1040;
    for (int u = blockIdx.x; u < 3096 + 3168; u += G) {
        int seq, j, which;
        if (u < 3096) { seq = u / 387; const int rem = u % 387; j = rem / 3; which = rem % 3; }
        else { const int v = u - 3096; seq = NBP + v / 99; const int rem = v % 99; j = rem / 3; which = rem % 3; }
        const int set = seq < NBP ? 0 : 1; const int L = set ? LS : LP; const int Lg = set ? LGS : LGP; const int NB = set ? NBS : NBP;
        const int b = set ? seq - NBP : seq; const int row0 = set ? TPR + b * LS : b * LP;
        const int posb = 64 * j - 49;
        for (int i = 0; i < 9; ++i) {
            const int id = tid + 512 * i; if (id >= 66 * 64) break;
            const int rr = id >> 6, ch = id & 63; const int pos = posb + rr;
            u32x4 v = (u32x4){0u, 0u, 0u, 0u};
            if (pos >= 0 && pos < L) v = *(const GAS u32x4*)(P + (size_t)(row0 + pos) * NPP + 448 + which * 512 + ch * 8);
            *(LAS u32x4*)(lds + rr * RSB + ch * 16) = v;
        }
        __syncthreads();
        {
            const int c = tid; const float w0 = conv_w[which * 512 + c], w1 = conv_w[1536 + which * 512 + c], w2 = conv_w[3072 + which * 512 + c];
            bf16_t* XT = (bf16_t*)(ws + (which == 0 ? OFF_X1T : (which == 1 ? OFF_X2T : OFF_V0T))) + (set ? XT_SET1 : 0) + ((size_t)c * NB + b) * Lg + 64 * j;
            const LAS unsigned short* tl = (const LAS unsigned short*)lds + c;
            float prev = bf2f(tl[0]), cur = bf2f(tl[RSB / 2]);
            for (int o8 = 0; o8 < 8; ++o8) {
                float r[8];
#pragma unroll
                for (int k = 0; k < 8; ++k) {
                    const int o = o8 * 8 + k; const float nxt = bf2f(tl[(o + 2) * (RSB / 2)]);
                    const int pos = posb + 1 + o;
                    r[k] = (pos >= 0 && pos < L) ? (prev * w0 + cur * w1 + nxt * w2) : 0.f;
                    prev = cur; cur = nxt;
                }
                u32x4 w; w.x = cvt_pk_bf16(r[0], r[1]); w.y = cvt_pk_bf16(r[2], r[3]); w.z = cvt_pk_bf16(r[4], r[5]); w.w = cvt_pk_bf16(r[6], r[7]);
                *(GAS u32x4*)(XT + o8 * 8) = w;
            }
        }
        __syncthreads();
    }
}

__device__ __forceinline__ f32x16 mfma32(bf16x8 a, bf16x8 b, f32x16 c) { return __builtin_amdgcn_mfma_f32_32x32x16_bf16(a, b, c, 0, 0, 0); }

__device__ __forceinline__ void attn_phase(const Params& p, LAS unsigned char* lds) {
    const int tid = tid_l(), lane = tid & 63, wave = tid >> 6, G = gridDim.x, h = lane >> 5, l32 = lane & 31;
    unsigned char* ob = launder((unsigned char*)p.out);
    bf16_t* Q = (bf16_t*)(ob + DO_Q);
    const bf16_t* KN = (const bf16_t*)(ob + DO_KN);
    const bf16_t* KR = (const bf16_t*)(ob + DO_KR);
    const bf16_t* VT = (const bf16_t*)(ob + DO_VT);
    constexpr int KROW = 400, VROW = 136, KBYTES = 64 * KROW, BUFB = KBYTES + 128 * VROW;
    for (int u = blockIdx.x; u < 2048; u += G) {
        int seq, head, qb;
        if (u < 1024) { seq = u >> 7; head = (u >> 5) & 3; qb = u & 31; } else { const int v = u - 1024; seq = NBP + (v >> 5); head = (v >> 3) & 3; qb = v & 7; }
        const int L = seq < NBP ? LP : LS; const int row0 = seq < NBP ? seq * LP : TPR + (seq - NBP) * LS;
        const int ntiles = (L + 63) >> 6;
        const int qrow = row0 + 16 + qb * 256 + wave * 32 + l32;
        bf16x8 qf[12];
#pragma unroll
        for (int ks = 0; ks < 12; ++ks) qf[ks] = *(const GAS bf16x8*)(Q + (size_t)qrow * 768 + head * 192 + 16 * ks + 8 * h);
        {
            const float2* RT = (const float2*)(launder(p.ws) + OFF_RT);
            const int qpos = 16 + qb * 256 + wave * 32 + l32;
#pragma unroll
            for (int ks = 8; ks < 12; ++ks) {
                const u32x4 v = __builtin_bit_cast(u32x4, qf[ks]);
                f32x4 v0 = (f32x4){bflo(v.x), bfhi(v.x), bflo(v.y), bfhi(v.y)}, v1 = (f32x4){bflo(v.z), bfhi(v.z), bflo(v.w), bfhi(v.w)};
                rope8(v0, v1, RT + qpos * 32 + 8 * (ks - 8) + 4 * h);
                qf[ks] = __builtin_bit_cast(bf16x8, pack8(v0, v1));
            }
        }
        const int kkey0 = tid >> 4, kch0 = tid & 15;
        const int rkey = tid >> 3, rch = tid & 7;
        const int vdv0 = tid >> 3, vch = tid & 7;
        const unsigned kn_off = (unsigned)(kkey0 * 512 + head * 128 + kch0 * 8) * 2u;
        const unsigned kr_off = (unsigned)(rkey * 64 + rch * 8) * 2u;
        const unsigned vt_off = (unsigned)(vdv0 * TPAD + vch * 8) * 2u;
        const unsigned char* knb = (const unsigned char*)KN + (size_t)row0 * 1024;
        const unsigned char* krb = (const unsigned char*)KR + (size_t)row0 * 128;
        const unsigned char* vtb = (const unsigned char*)VT + ((size_t)head * 128 * TPAD + row0) * 2;
        u32x4 g0, g1, g2, g3, g4;
#define ATT_LOAD(tile) do { const unsigned char* kb__ = knb + (size_t)(tile) * 65536; const unsigned char* rb__ = krb + (size_t)(tile) * 8192; const unsigned char* vb__ = vtb + (size_t)(tile) * 128; \
        g0 = *(const GAS u32x4*)(kb__ + kn_off); g1 = *(const GAS u32x4*)(kb__ + 32768 + kn_off); \
        g2 = *(const GAS u32x4*)(rb__ + kr_off); (void)vb__; } while (0)
#define ATT_LOADV(tile) do { const unsigned char* vb__ = vtb + (size_t)(tile) * 128; g3 = *(const GAS u32x4*)(vb__ + vt_off); g4 = *(const GAS u32x4*)(vb__ + (size_t)64 * TPAD * 2 + vt_off); } while (0)
#define ATT_STOREK(buf) do { LAS unsigned char* kb_ = lds + (buf) * BUFB; \
        *(LAS u32x4*)(kb_ + kkey0 * KROW + kch0 * 16) = g0; *(LAS u32x4*)(kb_ + (kkey0 + 32) * KROW + kch0 * 16) = g1; \
        *(LAS u32x4*)(kb_ + rkey * KROW + 256 + rch * 16) = g2; } while (0)
#define ATT_STORE(buf) do { LAS unsigned char* vb_ = lds + (buf) * BUFB + KBYTES; \
        *(LAS u32x2*)(vb_ + vdv0 * VROW + vch * 16) = (u32x2){g3.x, g3.y}; *(LAS u32x2*)(vb_ + vdv0 * VROW + vch * 16 + 8) = (u32x2){g3.z, g3.w}; \
        *(LAS u32x2*)(vb_ + (vdv0 + 64) * VROW + vch * 16) = (u32x2){g4.x, g4.y}; *(LAS u32x2*)(vb_ + (vdv0 + 64) * VROW + vch * 16 + 8) = (u32x2){g4.z, g4.w}; } while (0)
        ATT_LOAD(0); ATT_LOADV(0); ATT_STOREK(0); ATT_STORE(0);
        __syncthreads();
        f32x16 o[4];
#pragma unroll
        for (int d = 0; d < 4; ++d)
#pragma unroll
            for (int r = 0; r < 16; ++r) o[d][r] = 0.f;
        float m_run = -INFINITY, l_run = 0.f;
        for (int j = 0; j < ntiles; ++j) {
            const int buf = j & 1;
            if (j + 1 < ntiles) ATT_LOAD(j + 1);
            const LAS unsigned char* kb = lds + buf * BUFB;
            f32x16 s0, s1;
#pragma unroll
            for (int r = 0; r < 16; ++r) { s0[r] = 0.f; s1[r] = 0.f; }
            {
                bf16x8 kA[6], kB[6];
                const LAS unsigned char* kr0 = kb + l32 * KROW + h * 16; const LAS unsigned char* kr1 = kr0 + 32 * KROW;
#define ATT_LDK(dst, ksb) do { _Pragma("unroll") for (int i = 0; i < 3; ++i) { dst[2 * i] = *(const LAS bf16x8*)(kr0 + ((ksb) + i) * 32); dst[2 * i + 1] = *(const LAS bf16x8*)(kr1 + ((ksb) + i) * 32); } } while (0)
#define ATT_MMK(src, ksb) do { _Pragma("unroll") for (int i = 0; i < 3; ++i) { s0 = mfma32(src[2 * i], qf[(ksb) + i], s0); s1 = mfma32(src[2 * i + 1], qf[(ksb) + i], s1); } } while (0)
                ATT_LDK(kA, 0); __builtin_amdgcn_sched_barrier(0);
                ATT_MMK(kA, 0); __builtin_amdgcn_sched_barrier(0);
                ATT_LDK(kB, 3); __builtin_amdgcn_sched_barrier(0);
                ATT_MMK(kB, 3); __builtin_amdgcn_sched_barrier(0);
                ATT_LDK(kA, 6); __builtin_amdgcn_sched_barrier(0);
                ATT_MMK(kA, 6); __builtin_amdgcn_sched_barrier(0);
                ATT_LDK(kB, 9); __builtin_amdgcn_sched_barrier(0);
                ATT_MMK(kB, 9); __builtin_amdgcn_sched_barrier(0);
#undef ATT_LDK
#undef ATT_MMK
            }
            if (j + 1 < ntiles) ATT_STOREK(buf ^ 1);
            const int vc = L - j * 64;
            if (vc < 64) {
                const int vch = vc - 4 * h;
#pragma unroll
                for (int r = 0; r < 16; ++r) {
                    if ((r & 3) + 8 * (r >> 2) >= vch) s0[r] = -INFINITY;
                    if ((r & 3) + 8 * (r >> 2) + 32 >= vch) s1[r] = -INFINITY;
                }
            }
            float mx = fmaxf(s0[0], s1[0]);
#pragma unroll
            for (int r = 1; r < 16; ++r) mx = fmaxf(mx, fmaxf(s0[r], s1[r]));
            mx = fmaxf(mx, __shfl_xor(mx, 32));
            const float m_new = fmaxf(m_run, mx);
            const float alpha = __builtin_amdgcn_exp2f(m_run - m_new);
            m_run = m_new;
            float ls = 0.f;
#pragma unroll
            for (int r = 0; r < 16; ++r) { s0[r] = __builtin_amdgcn_exp2f(s0[r] - m_new); s1[r] = __builtin_amdgcn_exp2f(s1[r] - m_new); ls += s0[r] + s1[r]; }
            l_run = l_run * alpha + ls;
            if (__any(alpha != 1.0f)) {
#pragma unroll
                for (int d = 0; d < 4; ++d)
#pragma unroll
                    for (int r = 0; r < 16; ++r) o[d][r] *= alpha;
            }
            bf16x8 pb[4];
            {
                u32x4 w;
                w.x = cvt_pk_bf16(s0[0], s0[1]); w.y = cvt_pk_bf16(s0[2], s0[3]); w.z = cvt_pk_bf16(s0[4], s0[5]); w.w = cvt_pk_bf16(s0[6], s0[7]); pb[0] = __builtin_bit_cast(bf16x8, w);
                w.x = cvt_pk_bf16(s0[8], s0[9]); w.y = cvt_pk_bf16(s0[10], s0[11]); w.z = cvt_pk_bf16(s0[12], s0[13]); w.w = cvt_pk_bf16(s0[14], s0[15]); pb[1] = __builtin_bit_cast(bf16x8, w);
                w.x = cvt_pk_bf16(s1[0], s1[1]); w.y = cvt_pk_bf16(s1[2], s1[3]); w.z = cvt_pk_bf16(s1[4], s1[5]); w.w = cvt_pk_bf16(s1[6], s1[7]); pb[2] = __builtin_bit_cast(bf16x8, w);
                w.x = cvt_pk_bf16(s1[8], s1[9]); w.y = cvt_pk_bf16(s1[10], s1[11]); w.z = cvt_pk_bf16(s1[12], s1[13]); w.w = cvt_pk_bf16(s1[14], s1[15]); pb[3] = __builtin_bit_cast(bf16x8, w);
            }
            if (j + 1 < ntiles) ATT_LOADV(j + 1);
            const LAS unsigned char* vb = kb + KBYTES;
            {
                const LAS unsigned char* vrow = vb + l32 * VROW + 8 * h;
#pragma unroll
                for (int d = 0; d < 4; ++d) {
                    u32x4 vf[4];
#pragma unroll
                    for (int ks = 0; ks < 4; ++ks) {
                        const LAS unsigned char* ap = vrow + d * 32 * VROW + 32 * ks;
                        const u32x2 lo = *(const LAS u32x2*)ap, hi = *(const LAS u32x2*)(ap + 16);
                        vf[ks] = (u32x4){lo.x, lo.y, hi.x, hi.y};
                    }
                    __builtin_amdgcn_sched_barrier(0);
#pragma unroll
                    for (int ks = 0; ks < 4; ++ks) o[d] = mfma32(__builtin_bit_cast(bf16x8, vf[ks]), pb[ks], o[d]);
                    __builtin_amdgcn_sched_barrier(0);
                }
            }
            if (j + 1 < ntiles) ATT_STORE(buf ^ 1);
            __syncthreads();
        }
        l_run += __shfl_xor(l_run, 32);
        const float inv = 1.0f / l_run;
#if DEBUG_CHECK == 5
        bf16_t* orow = (bf16_t*)(launder(p.ws) + OFF_ODBG) + (size_t)qrow * 512 + head * 128;
#else
        bf16_t* orow = Q + (size_t)qrow * 768 + head * 192;
#endif
#pragma unroll
        for (int d = 0; d < 4; ++d)
#pragma unroll
            for (int rq = 0; rq < 4; ++rq) {
                const u32x2 w = (u32x2){cvt_pk_bf16(o[d][4 * rq] * inv, o[d][4 * rq + 1] * inv), cvt_pk_bf16(o[d][4 * rq + 2] * inv, o[d][4 * rq + 3] * inv)};
                *(GAS u32x2*)(orow + 32 * d + 8 * rq + 4 * h) = w;
            }
#undef ATT_LOAD
#undef ATT_LOADV
#undef ATT_STORE
#undef ATT_STOREK
    }
}

template <int SET> __device__ __forceinline__ void hyena_unit(const Params& p, LAS unsigned char* lds, int c, int bg) {
    constexpr int P = SET ? 32 : 128;
    constexpr int NBU = SET ? 16 : 4;
    constexpr int NBT = SET ? 8 : 2;
    constexpr int GP = SET ? 4 : 16;
    constexpr int LG = SET ? LGS : LGP;
    constexpr int NB = SET ? NBS : NBP;
    constexpr int RS = SET ? 4896 : 18816;
    constexpr int GBYTES = 2 * LG * 2;
    constexpr int G1OFF = 33220;
    constexpr int ZOFF = 66560;
    unsigned char* ws = launder(p.ws);
    const int tid = tid_l(), lane = tid & 63, wave = tid >> 6, h = lane >> 5, l32 = lane & 31;
    const bf16_t* X1T = (const bf16_t*)(ws + OFF_X1T) + (SET ? XT_SET1 : 0);
    bf16_t* X2T = (bf16_t*)(ws + OFF_X2T) + (SET ? XT_SET1 : 0);
    const bf16_t* V0T = (const bf16_t*)(ws + OFF_V0T) + (SET ? XT_SET1 : 0);
    const bf16_t* GR = (const bf16_t*)(ws + (SET ? OFF_GR1 : OFF_GR0));
    const float* hy_bias = launder(p.in[17]);
    LAS unsigned char* gL = lds; LAS unsigned char* zL = lds + ZOFF;
    const size_t rowbase = ((size_t)c * NB + bg * NBU) * LG;
    for (int id = tid; id < NBU * (P + 1) * 8; id += 512) {
        const int bl = id / ((P + 1) * 8), rem = id % ((P + 1) * 8), blk = rem >> 3, ch = rem & 7;
        *(LAS u32x4*)(zL + bl * RS + blk * 144 + ch * 16) = *(const GAS u32x4*)(V0T + rowbase + (size_t)bl * LG + blk * 64 + ch * 8);
    }
    for (int id = tid; id < NBU * 9; id += 512) { const int bl = id / 9, ch = id % 9; *(LAS u32x4*)(zL + bl * RS + (P + 1) * 144 + ch * 16) = (u32x4){0u, 0u, 0u, 0u}; }
#define HY_LOADG(rowidx) do { const unsigned* g32_ = (const unsigned*)(GR + (size_t)(rowidx) * (2 * LG)); \
        for (int id = tid; id < GBYTES / 4; id += 512) { const unsigned a_ = g32_[id], b_ = (id + 1 < GBYTES / 4) ? g32_[id + 1] : 0u; \
            *(LAS unsigned*)(gL + id * 4) = a_; *(LAS unsigned*)(gL + G1OFF + id * 4) = (a_ >> 16) | (b_ << 16); } } while (0)
    HY_LOADG(c);
    __syncthreads();
    const LAS unsigned short* g16 = (const LAS unsigned short*)gL;
    constexpr int PARTS = 512 / (NBU * 16);
    float zmeta = 0.f; int mo_bl, mo_m;
    {
        const int part = tid % PARTS, out = tid / PARTS; mo_bl = out >> 4; mo_m = out & 15;
        const LAS unsigned char* zr = zL + mo_bl * RS;
        float a = 0.f;
        const LAS unsigned char* gm = gL + (mo_m & 1) * G1OFF;
        for (int ci = part; ci < (LG - 48) / 8; ci += PARTS) {
            const int tt0 = 48 + 8 * ci;
            const u32x4 zv = *(const LAS u32x4*)(zr + (tt0 >> 6) * 144 + (tt0 & 63) * 2);
            const LAS unsigned* gp = (const LAS unsigned*)(gm + ((LG - mo_m - 48 + tt0) >> 1) * 4);
            const unsigned g0 = gp[0], g1 = gp[1], g2 = gp[2], g3 = gp[3];
            a += (bflo(zv.x) * bflo(g0) + bfhi(zv.x) * bfhi(g0)) + (bflo(zv.y) * bflo(g1) + bfhi(zv.y) * bfhi(g1))
               + (bflo(zv.z) * bflo(g2) + bfhi(zv.z) * bfhi(g2)) + (bflo(zv.w) * bflo(g3) + bfhi(zv.w) * bfhi(g3));
        }
#pragma unroll
        for (int o = 1; o < PARTS; o <<= 1) a += __shfl_xor(a, o);
        const float bias0 = hy_bias[c];
        const float z0 = bf2f(*(const LAS unsigned short*)(zr + (48 + mo_m) * 2));
        const float x1 = bf2f(X1T[rowbase + (size_t)mo_bl * LG + 48 + mo_m]);
        zmeta = x1 * (a + z0 * bias0);
    }
    const int p0 = GP * wave;
    const int pp = l32 / NBT, blA = l32 % NBT, blB = NBT + blA;
#pragma unroll 1
    for (int order = 0; order < 2; ++order) {
        f32x16 acc[2][2];
#pragma unroll
        for (int a = 0; a < 2; ++a)
#pragma unroll
            for (int b = 0; b < 2; ++b)
#pragma unroll
                for (int r = 0; r < 16; ++r) acc[a][b][r] = 0.f;
        bf16x8 Ep4, Ep5;
        {
            const int d0 = p0 - (P - 1); const int ib0 = LG - 64 * d0 - l32 + 8 * h;
            const LAS unsigned char* g0 = gL + (l32 & 1) * G1OFF + (ib0 >> 1) * 4;
            const LAS unsigned* ga = (const LAS unsigned*)(g0 + 96); const LAS unsigned* gb = (const LAS unsigned*)(g0 + 64);
            Ep4 = __builtin_bit_cast(bf16x8, (u32x4){ga[0], ga[1], ga[2], ga[3]}); Ep5 = __builtin_bit_cast(bf16x8, (u32x4){gb[0], gb[1], gb[2], gb[3]});
        }
#define HY_LOAD(dd, Bv, Ev) do { \
            const int ib_ = LG - 64 * (dd) - l32 + 8 * h; \
            const LAS unsigned char* gpl_ = gL + (l32 & 1) * G1OFF + (ib_ >> 1) * 4; \
            _Pragma("unroll") for (int e = 2; e < 6; ++e) { const LAS unsigned* gp_ = (const LAS unsigned*)(gpl_ - 32 * (e - 3)); \
                Ev[e - 2] = __builtin_bit_cast(bf16x8, (u32x4){gp_[0], gp_[1], gp_[2], gp_[3]}); } \
            const int q_ = p0 + pp - (dd); const int slot_ = ((unsigned)(q_ + 1) <= (unsigned)P) ? q_ + 1 : P + 1; \
            const LAS unsigned char* zA_ = zL + blA * RS + slot_ * 144 + h * 16; const LAS unsigned char* zB_ = zL + blB * RS + slot_ * 144 + h * 16; \
            _Pragma("unroll") for (int ks = 0; ks < 4; ++ks) { Bv[0][ks] = *(const LAS bf16x8*)(zA_ + ks * 32); Bv[1][ks] = *(const LAS bf16x8*)(zB_ + ks * 32); } } while (0)
#define HY_MMA(Bv, Ev) do { \
            _Pragma("unroll") for (int ks = 0; ks < 4; ++ks) { \
                const bf16x8 a0_ = (ks == 0) ? Ev[1] : (ks == 1) ? Ev[0] : (ks == 2) ? Ep5 : Ep4; \
                const bf16x8 a1_ = (ks == 0) ? Ev[3] : (ks == 1) ? Ev[2] : (ks == 2) ? Ev[1] : Ev[0]; \
                acc[0][0] = mfma32(a0_, Bv[0][ks], acc[0][0]); acc[1][0] = mfma32(a0_, Bv[1][ks], acc[1][0]); \
                acc[0][1] = mfma32(a1_, Bv[0][ks], acc[0][1]); acc[1][1] = mfma32(a1_, Bv[1][ks], acc[1][1]); } \
            Ep4 = Ev[2]; Ep5 = Ev[3]; } while (0)
        {
            bf16x8 BA[2][4], BB[2][4], EA[4], EB[4];
            const int dlo = p0 - (P - 1), dhi = p0 + GP;
            HY_LOAD(dlo, BA, EA);
#pragma unroll 1
            for (int d = dlo; d <= dhi; d += 2) {
                HY_LOAD(d + 1, BB, EB);
                HY_MMA(BA, EA);
                if (d + 2 <= dhi) HY_LOAD(d + 2, BA, EA);
                HY_MMA(BB, EB);
            }
        }
#undef HY_LOAD
#undef HY_MMA
        __syncthreads();
        const float bias = hy_bias[order * 512 + c];
#pragma unroll
        for (int tl = 0; tl < 2; ++tl) {
            const int bl = tl ? blB : blA;
            const size_t grow = rowbase + (size_t)bl * LG + 64 * (p0 + pp + 1);
            LAS unsigned char* zr = zL + bl * RS + (p0 + pp + 1) * 144;
#pragma unroll
            for (int m = 0; m < 2; ++m)
#pragma unroll
                for (int rq = 0; rq < 4; ++rq) {
                    const int off = 32 * m + 8 * rq + 4 * h;
                    const u32x2 zw = *(const LAS u32x2*)(zr + off * 2);
                    const u32x2 xw = *(const GAS u32x2*)((order ? (const bf16_t*)X2T : X1T) + grow + off);
                    const float y0 = acc[tl][m][4 * rq], y1 = acc[tl][m][4 * rq + 1], y2 = acc[tl][m][4 * rq + 2], y3 = acc[tl][m][4 * rq + 3];
                    const float r0 = bflo(xw.x) * (y0 + bflo(zw.x) * bias), r1 = bfhi(xw.x) * (y1 + bfhi(zw.x) * bias);
                    const float r2 = bflo(xw.y) * (y2 + bflo(zw.y) * bias), r3 = bfhi(xw.y) * (y3 + bfhi(zw.y) * bias);
                    const u32x2 w = (u32x2){cvt_pk_bf16(r0, r1), cvt_pk_bf16(r2, r3)};
#if DEBUG_CHECK == 5
                    if (order == 0) *(LAS u32x2*)(zr + off * 2) = w; else *(GAS u32x2*)((bf16_t*)(ws + OFF_HDBG) + (SET ? XT_SET1 : 0) + grow + off) = w;
#else
                    if (order == 0) *(LAS u32x2*)(zr + off * 2) = w; else *(GAS u32x2*)(X2T + grow + off) = w;
#endif
                }
        }
        if (order == 0) {
            if ((tid % PARTS) == 0) *(LAS unsigned short*)(zL + mo_bl * RS + (48 + mo_m) * 2) = (unsigned short)(cvt_pk_bf16(zmeta, 0.f) & 0xffffu);
            HY_LOADG(512 + c);
        }
        __syncthreads();
    }
}
#undef HY_LOADG
__device__ __forceinline__ void hyena_phase(const Params& p, LAS unsigned char* lds) {
    for (int u = blockIdx.x; u < 2048; u += gridDim.x) {
        if (u < 1024) hyena_unit<0>(p, lds, u >> 1, u & 1); else hyena_unit<1>(p, lds, (u - 1024) >> 1, u & 1);
    }
}

__device__ __forceinline__ void mixnorm_phase(const Params& p, LAS unsigned char* lds) {
    unsigned char* ws = launder(p.ws); const int tid = tid_l(), lane = tid & 63, wave = tid >> 6, G = gridDim.x;
    const bf16_t* Q = (const bf16_t*)(launder((unsigned char*)p.out) + DO_Q);
    bf16_t* MIXN = (bf16_t*)(ws + OFF_MIXN);
    const float* ga = launder(p.in[18]); const float* gh = launder(p.in[19]);
    constexpr int RSB = 1040;
    for (int u = blockIdx.x; u < 2048; u += G) {
        const int n0 = u * 64;
        int set, b, tok0;
        if (n0 < 65536) { set = 0; b = n0 >> 13; tok0 = n0 & 8191; } else { set = 1; const int q = n0 - 65536; b = q >> 11; tok0 = q & 2047; }
        const int Lg = set ? LGS : LGP, NB = set ? NBS : NBP;
        {
            const int c = tid;
#if DEBUG_CHECK == 5
            const bf16_t* src = (const bf16_t*)(ws + OFF_HDBG) + (set ? XT_SET1 : 0) + ((size_t)c * NB + b) * Lg + tok0 + 64;
#else
            const bf16_t* src = (const bf16_t*)(ws + OFF_X2T) + (set ? XT_SET1 : 0) + ((size_t)c * NB + b) * Lg + tok0 + 64;
#endif
            LAS unsigned short* tl = (LAS unsigned short*)lds + c;
#pragma unroll
            for (int k8 = 0; k8 < 8; ++k8) {
                const u32x4 v = *(const GAS u32x4*)(src + k8 * 8);
                tl[(k8 * 8 + 0) * (RSB / 2)] = (unsigned short)(v.x & 0xffffu); tl[(k8 * 8 + 1) * (RSB / 2)] = (unsigned short)(v.x >> 16);
                tl[(k8 * 8 + 2) * (RSB / 2)] = (unsigned short)(v.y & 0xffffu); tl[(k8 * 8 + 3) * (RSB / 2)] = (unsigned short)(v.y >> 16);
                tl[(k8 * 8 + 4) * (RSB / 2)] = (unsigned short)(v.z & 0xffffu); tl[(k8 * 8 + 5) * (RSB / 2)] = (unsigned short)(v.z >> 16);
                tl[(k8 * 8 + 6) * (RSB / 2)] = (unsigned short)(v.w & 0xffffu); tl[(k8 * 8 + 7) * (RSB / 2)] = (unsigned short)(v.w >> 16);
            }
        }
        __syncthreads();
        for (int i = 0; i < 8; ++i) {
            const int rr = wave + 8 * i; const int n = n0 + rr; const int r = full_row(n);
            const u32x4 hv = *(const LAS u32x4*)(lds + rr * RSB + lane * 16);
#if DEBUG_CHECK == 5
            const u32x4 av = *(const GAS u32x4*)((const bf16_t*)(ws + OFF_ODBG) + (size_t)r * 512 + lane * 8);
#else
            const u32x4 av = *(const GAS u32x4*)(Q + (size_t)r * 768 + (lane >> 4) * 192 + (lane & 15) * 8);
#endif
            float hf[8] = {bflo(hv.x), bfhi(hv.x), bflo(hv.y), bfhi(hv.y), bflo(hv.z), bfhi(hv.z), bflo(hv.w), bfhi(hv.w)};
            float af[8] = {bflo(av.x), bfhi(av.x), bflo(av.y), bfhi(av.y), bflo(av.z), bfhi(av.z), bflo(av.w), bfhi(av.w)};
            float sh = 0.f, sa = 0.f;
#pragma unroll
            for (int k = 0; k < 8; ++k) { sh += hf[k] * hf[k]; sa += af[k] * af[k]; }
            sh = wave_sum(sh); sa = wave_sum(sa);
            const float rh = rsqrtf(sh * (1.f / 512.f) + EPS), ra = rsqrtf(sa * (1.f / 512.f) + EPS);
            const f32x4 ga0 = *(const GAS f32x4*)(ga + lane * 8), ga1 = *(const GAS f32x4*)(ga + lane * 8 + 4);
            const f32x4 gh0 = *(const GAS f32x4*)(gh + lane * 8), gh1 = *(const GAS f32x4*)(gh + lane * 8 + 4);
            u32x4 wa, wh;
            wa.x = cvt_pk_bf16(af[0] * ra * ga0[0], af[1] * ra * ga0[1]); wa.y = cvt_pk_bf16(af[2] * ra * ga0[2], af[3] * ra * ga0[3]);
            wa.z = cvt_pk_bf16(af[4] * ra * ga1[0], af[5] * ra * ga1[1]); wa.w = cvt_pk_bf16(af[6] * ra * ga1[2], af[7] * ra * ga1[3]);
            wh.x = cvt_pk_bf16(hf[0] * rh * gh0[0], hf[1] * rh * gh0[1]); wh.y = cvt_pk_bf16(hf[2] * rh * gh0[2], hf[3] * rh * gh0[3]);
            wh.z = cvt_pk_bf16(hf[4] * rh * gh1[0], hf[5] * rh * gh1[1]); wh.w = cvt_pk_bf16(hf[6] * rh * gh1[2], hf[7] * rh * gh1[3]);
#if EXPT == 1
            wa = (u32x4){0u, 0u, 0u, 0u};
#endif
#if EXPT == 2
            wh = (u32x4){0u, 0u, 0u, 0u};
#endif
            *(GAS u32x4*)(MIXN + (size_t)n * 1024 + lane * 8) = wa;
            *(GAS u32x4*)(MIXN + (size_t)n * 1024 + 512 + lane * 8) = wh;
        }
        __syncthreads();
    }
}

__device__ __forceinline__ void h1_phase(const Params& p) {
    unsigned char* ws = launder(p.ws); const int tid = tid_l(), lane = tid & 63, wave = tid >> 6;
    const int gw = blockIdx.x * 8 + wave, NGW = gridDim.x * 8;
    const bf16_t* MIX = (const bf16_t*)(ws + OFF_MIX); bf16_t* H1B = (bf16_t*)(ws + OFF_H1B);
    const float* sqmix = (const float*)(ws + OFF_SQMIXP); float* r1 = (float*)(ws + OFF_R1); const float* g = p.in[21];
    for (int n = gw; n < TN; n += NGW) {
        const float* xrow = n < 65536 ? p.in[0] + (size_t)n * 1024 : p.in[1] + (size_t)(n - 65536) * 1024;
        const float rm = rsqrtf(wave_sum(lane < 16 ? ldco(sqmix + (size_t)n * 16 + lane) : 0.f) * (1.f / 1024.f) + EPS);
        float ss = 0.f;
#pragma unroll
        for (int hh = 0; hh < 2; ++hh) {
            const int c0 = hh * 512 + lane * 8;
            const u32x4 mv = *(const u32x4*)(MIX + (size_t)n * 1024 + c0);
            const f32x4 x0 = *(const f32x4*)(xrow + c0), x1 = *(const f32x4*)(xrow + c0 + 4);
            const f32x4 g0 = *(const f32x4*)(g + c0), g1 = *(const f32x4*)(g + c0 + 4);
            f32x4 h0, h1;
            h0[0] = x0[0] + bflo(mv.x) * rm * g0[0]; h0[1] = x0[1] + bfhi(mv.x) * rm * g0[1]; h0[2] = x0[2] + bflo(mv.y) * rm * g0[2]; h0[3] = x0[3] + bfhi(mv.y) * rm * g0[3];
            h1[0] = x1[0] + bflo(mv.z) * rm * g1[0]; h1[1] = x1[1] + bfhi(mv.z) * rm * g1[1]; h1[2] = x1[2] + bflo(mv.w) * rm * g1[2]; h1[3] = x1[3] + bfhi(mv.w) * rm * g1[3];
            ss += sq8(h0, h1);
            *(u32x4*)(H1B + (size_t)n * 1024 + c0) = pack8(h0, h1);
        }
        ss = wave_sum(ss);
        if (lane == 0) r1[n] = rsqrtf(ss * (1.f / 1024.f) + EPS);
    }
}
__device__ __forceinline__ void final_phase(const Params& p, int half) {
    unsigned char* ws = launder(p.ws); const int tid = tid_l(), lane = tid & 63, wave = tid >> 6;
    const int gw = blockIdx.x * 8 + wave, NGW = gridDim.x * 8;
    const bf16_t* M2 = (const bf16_t*)(ws + OFF_M2); const float* sqm2 = (const float*)(ws + OFF_SQM2P); const float* g = p.in[25];
    float dbg_off = 0.f, dbg_one = 0.f;
#if DEBUG_CHECK
    { const unsigned* dc = (const unsigned*)(ws + OFF_DBGW); dbg_off = 100.f * (float)dc[8] * (1.f / 131072.f); dbg_one = 1000.f * (float)dc[9] * (1.f / 131072.f); }
#endif
    for (int i = gw; i < 65536; i += NGW) {
        const int n = half * 65536 + i;
        const float rm = rsqrtf(wave_sum(lane < 16 ? ldco(sqm2 + (size_t)n * 16 + lane) : 0.f) * (1.f / 1024.f) + EPS);
#pragma unroll
        for (int hh = 0; hh < 2; ++hh) {
            const int c0 = hh * 512 + lane * 8;
            const u32x4 mv = *(const u32x4*)(M2 + (size_t)i * 1024 + c0);
            const u32x4 hv = *(const u32x4*)((const bf16_t*)(ws + OFF_H1B) + (size_t)n * 1024 + c0);
            f32x4 h0 = (f32x4){bflo(hv.x), bfhi(hv.x), bflo(hv.y), bfhi(hv.y)}, h1 = (f32x4){bflo(hv.z), bfhi(hv.z), bflo(hv.w), bfhi(hv.w)};
            const f32x4 g0 = *(const f32x4*)(g + c0), g1 = *(const f32x4*)(g + c0 + 4);
            h0 += dbg_off; h1 += dbg_off; if (n == 0 && c0 == 0) h0[0] += dbg_one;
            h0[0] += bflo(mv.x) * rm * g0[0]; h0[1] += bfhi(mv.x) * rm * g0[1]; h0[2] += bflo(mv.y) * rm * g0[2]; h0[3] += bfhi(mv.y) * rm * g0[3];
            h1[0] += bflo(mv.z) * rm * g1[0]; h1[1] += bfhi(mv.z) * rm * g1[1]; h1[2] += bflo(mv.w) * rm * g1[2]; h1[3] += bfhi(mv.w) * rm * g1[3];
            *(f32x4*)(p.out + (size_t)n * 1024 + c0) = h0; *(f32x4*)(p.out + (size_t)n * 1024 + c0 + 4) = h1;
        }
    }
}


#if DEBUG_CHECK
constexpr size_t OFF_DBG = OFF_DBGW;
__device__ __forceinline__ void check_gemm(const bf16_t* A, int lda, const bf16_t* Bt, int ldb, int K, int M, int N, int mode, const bf16_t* O, int ldc, const float* rs, unsigned* cnt, int col_lo) {
    const unsigned idx = blockIdx.x * 512u + (unsigned)tid_l();
    unsigned hsh = idx * 2654435761u + 12345u + (unsigned)mode * 977u; hsh ^= hsh >> 15; hsh *= 2246822519u; hsh ^= hsh >> 13;
    const int row = (int)(hsh % (unsigned)M); hsh = hsh * 3266489917u + 668265263u; hsh ^= hsh >> 16;
    const int col = col_lo + (int)(hsh % (unsigned)(N - col_lo));
    float d = 0.f;
    for (int k = 0; k < K; ++k) d += bf2f(A[(size_t)row * lda + k]) * bf2f(Bt[(size_t)col * ldb + k]);
    float e = d;
    if (mode == 0 || mode == 7) e = d * rs[row];
    if (mode == 5) { const float t = fmaxf(d * rs[row], 0.f); e = t * t; }
    const float st = bf2f(O[(size_t)row * ldc + col]);
    if (!(fabsf(st - e) <= 0.03f * fabsf(e) + 0.03f)) atomicAdd(cnt, 1u);
}
#endif

#if DEBUG_CHECK == 2
__device__ __forceinline__ void check_proj(const Params& p) {
    unsigned char* ws = launder(p.ws); unsigned char* ob = launder((unsigned char*)p.out);
    const bf16_t* P = (const bf16_t*)(ws + OFF_P); unsigned* cnt = (unsigned*)(ws + OFF_DBG);
    const unsigned idx = blockIdx.x * 512u + (unsigned)tid_l();
    unsigned hsh = idx * 2654435761u + 777u; hsh ^= hsh >> 15; hsh *= 2246822519u; hsh ^= hsh >> 13;
    const int row = (int)(hsh % (unsigned)T); hsh = hsh * 3266489917u + 668265263u; hsh ^= hsh >> 16;
    int pos, seq; row_info(row, pos, seq);
    {
        const int n = (int)(hsh % 768u); const int hh = n / 192, w = n % 192;
        float ss = 0.f, x1 = 0.f, x2 = 0.f; const float* W = p.in[6]; const float* g = p.in[5];
        const int j = w - 128, i = j >> 1;
        const int c1 = w < 128 ? hh * 192 + w : hh * 192 + 128 + i, c2 = hh * 192 + 160 + (w < 128 ? 0 : i);
        for (int k = 0; k < 256; ++k) { const float a = bf2f(P[(size_t)row * NPP + k]); ss += a * a; x1 += a * g[k] * W[k * 768 + c1]; x2 += a * g[k] * W[k * 768 + c2]; }
        const float rq = rsqrtf(ss * (1.f / 256.f) + EPS) * QSCALE; x1 *= rq; x2 *= rq;
        float e = x1;
        if (w >= 128) { const float inv = 1.0f / exp2f((float)i * (13.287712379549449f / 32.f)); float sn, cs; sincos_red((float)pos * inv, sn, cs); e = (j & 1) ? x2 * cs + x1 * sn : x1 * cs - x2 * sn; }
        const float st = bf2f(((const bf16_t*)(ob + DO_Q))[(size_t)row * 768 + n]);
        if (!(fabsf(st - e) <= 0.03f * fabsf(e) + 0.01f)) atomicAdd(cnt + (w < 128 ? 0 : 4), 1u);
    }
    {
        const int n = (int)((hsh >> 3) % 512u); const int hh = n >> 7, i = n & 127;
        float ss = 0.f, x1 = 0.f, x2 = 0.f; const float* W = p.in[8]; const float* g = p.in[7];
        for (int k = 0; k < 128; ++k) { const float a = bf2f(P[(size_t)row * NPP + 256 + k]); ss += a * a; x1 += a * g[k] * W[k * 1024 + hh * 256 + i]; x2 += a * g[k] * W[k * 1024 + hh * 256 + 128 + i]; }
        const float rk = rsqrtf(ss * (1.f / 128.f) + EPS); x1 *= rk; x2 *= rk;
        const float s1 = bf2f(((const bf16_t*)(ob + DO_KN))[(size_t)row * 512 + n]);
        const float s2 = bf2f(((const bf16_t*)(ob + DO_VT))[(size_t)n * TPAD + row]);
        if (!(fabsf(s1 - x1) <= 0.03f * fabsf(x1) + 0.03f)) atomicAdd(cnt + 1, 1u);
        if (!(fabsf(s2 - x2) <= 0.03f * fabsf(x2) + 0.03f)) atomicAdd(cnt + 2, 1u);
    }
    {
        const int jj = (int)((hsh >> 5) % 64u); const int i = jj >> 1;
        const float* xr = pos < 16 ? p.in[2] + (size_t)pos * 1024 : (seq < NBP ? p.in[0] + ((size_t)seq * 8192 + (pos - 16)) * 1024 : p.in[1] + ((size_t)(seq - NBP) * 2048 + (pos - 16)) * 1024);
        const float* W = p.in[4]; const float* g = p.in[3]; float x1 = 0.f, x2 = 0.f;
        for (int k = 0; k < 1024; ++k) { const float a = xr[k] * g[k]; x1 += a * W[(size_t)k * 1984 + 384 + i]; x2 += a * W[(size_t)k * 1984 + 416 + i]; }
        const float r0 = ((const float*)(ws + OFF_R0))[row]; x1 *= r0; x2 *= r0;
        const float inv = 1.0f / exp2f((float)i * (13.287712379549449f / 32.f)); float sn, cs; sincos_red((float)pos * inv, sn, cs);
        const float e = (jj & 1) ? x2 * cs + x1 * sn : x1 * cs - x2 * sn;
        const float st = bf2f(((const bf16_t*)(ob + DO_KR))[(size_t)row * 64 + jj]);
        if (!(fabsf(st - e) <= 0.03f * fabsf(e) + 0.03f)) { atomicAdd(cnt + 3, 1u); atomicAdd(cnt + 5, (unsigned)i); atomicAdd(cnt + 6, (unsigned)(pos >> 3)); }
    }
}
#endif

#if DEBUG_CHECK == 3
__device__ __forceinline__ void check_h0b(const Params& p, int slot) {
    unsigned char* ws = launder(p.ws); unsigned* cnt = (unsigned*)(ws + OFF_DBGW);
    const bf16_t* h0b = (const bf16_t*)(ws + OFF_H0B);
    const unsigned idx = blockIdx.x * 512u + (unsigned)tid_l();
    unsigned hsh = idx * 2654435761u + 4242u + (unsigned)slot * 31u; hsh ^= hsh >> 15; hsh *= 2246822519u; hsh ^= hsh >> 13;
    const int row = (int)(hsh % (unsigned)T); hsh = hsh * 3266489917u + 668265263u; hsh ^= hsh >> 16;
    const int col = (int)(hsh % 1024u);
    int pos, seq; row_info(row, pos, seq);
    const float* xr = pos < 16 ? p.in[2] + (size_t)pos * 1024 : (seq < NBP ? p.in[0] + ((size_t)seq * 8192 + (pos - 16)) * 1024 : p.in[1] + ((size_t)(seq - NBP) * 2048 + (pos - 16)) * 1024);
    const float e = xr[col]; const float st = bf2f(h0b[(size_t)row * 1024 + col]);
    if (!(fabsf(st - e) <= 0.01f * fabsf(e) + 0.001f)) atomicAdd(cnt + slot, 1u);
}
#endif

#if DEBUG_CHECK == 4
__device__ __forceinline__ void check_stale(const Params& p, const unsigned* base, unsigned ndw, int slot) {
    unsigned* cnt = (unsigned*)(launder(p.ws) + OFF_DBGW);
    const unsigned idx = blockIdx.x * 512u + (unsigned)tid_l();
    unsigned hsh = idx * 2654435761u + 999u + (unsigned)slot * 131u; hsh ^= hsh >> 15; hsh *= 2246822519u; hsh ^= hsh >> 13;
#pragma unroll 1
    for (int it = 0; it < 16; ++it) {
        hsh = hsh * 3266489917u + 668265263u; hsh ^= hsh >> 16;
        const unsigned i = hsh % ndw;
        const unsigned a = base[i];
        const unsigned b = __hip_atomic_load(base + i, __ATOMIC_RELAXED, __HIP_MEMORY_SCOPE_AGENT);
        if (a != b) atomicAdd(cnt + slot, 1u);
    }
}
#endif

#if DEBUG_CHECK == 5
__device__ __forceinline__ void check_attn(const Params& p) {
    unsigned char* ws = launder(p.ws); unsigned char* ob = launder((unsigned char*)p.out); unsigned* cnt = (unsigned*)(ws + OFF_DBGW);
    const int tid = tid_l(), lane = tid & 63, wave = tid >> 6;
    const bf16_t* Q = (const bf16_t*)(ob + DO_Q); const bf16_t* KN = (const bf16_t*)(ob + DO_KN); const bf16_t* KR = (const bf16_t*)(ob + DO_KR); const bf16_t* VT = (const bf16_t*)(ob + DO_VT);
    const bf16_t* OD = (const bf16_t*)(ws + OFF_ODBG); const float2* RT = (const float2*)(ws + OFF_RT);
    unsigned hsh = (unsigned)(blockIdx.x * 8 + wave) * 2654435761u + 31337u; hsh ^= hsh >> 15; hsh *= 2246822519u; hsh ^= hsh >> 13;
    const int n = (int)(hsh % (unsigned)TN); const int head = (int)((hsh >> 20) & 3u); const int r = full_row(n);
    int pos, seq; row_info(r, pos, seq);
    const int L = seq < NBP ? LP : LS; const int row0 = r - pos;
    const bf16_t* qp = Q + (size_t)r * 768 + head * 192;
    float mx = -INFINITY;
    for (int k = lane; k < L; k += 64) {
        float sdot = 0.f;
        for (int d = 0; d < 128; ++d) sdot += bf2f(qp[d]) * bf2f(KN[(size_t)(row0 + k) * 512 + head * 128 + d]);
        for (int i = 0; i < 32; ++i) { const float2 cs = ldco2(RT + pos * 32 + i); const float a = bf2f(qp[128 + 2 * i]), b = bf2f(qp[129 + 2 * i]);
            sdot += (a * cs.x - b * cs.y) * bf2f(KR[(size_t)(row0 + k) * 64 + 2 * i]) + (b * cs.x + a * cs.y) * bf2f(KR[(size_t)(row0 + k) * 64 + 2 * i + 1]); }
        mx = fmaxf(mx, sdot);
    }
#pragma unroll
    for (int o = 1; o < 64; o <<= 1) mx = fmaxf(mx, __shfl_xor(mx, o));
    float sw = 0.f, o0 = 0.f, o1 = 0.f; const int dv0 = (int)((hsh >> 8) & 127u), dv1 = (dv0 + 37) & 127;
    for (int k = lane; k < L; k += 64) {
        float sdot = 0.f;
        for (int d = 0; d < 128; ++d) sdot += bf2f(qp[d]) * bf2f(KN[(size_t)(row0 + k) * 512 + head * 128 + d]);
        for (int i = 0; i < 32; ++i) { const float2 cs = ldco2(RT + pos * 32 + i); const float a = bf2f(qp[128 + 2 * i]), b = bf2f(qp[129 + 2 * i]);
            sdot += (a * cs.x - b * cs.y) * bf2f(KR[(size_t)(row0 + k) * 64 + 2 * i]) + (b * cs.x + a * cs.y) * bf2f(KR[(size_t)(row0 + k) * 64 + 2 * i + 1]); }
        const float w = exp2f(sdot - mx); sw += w;
        o0 += w * bf2f(VT[(size_t)(head * 128 + dv0) * TPAD + row0 + k]); o1 += w * bf2f(VT[(size_t)(head * 128 + dv1) * TPAD + row0 + k]);
    }
    sw = wave_sum(sw); o0 = wave_sum(o0) / sw; o1 = wave_sum(o1) / sw;
    if (lane == 0) {
        const float s0 = bf2f(OD[(size_t)r * 512 + head * 128 + dv0]), s1 = bf2f(OD[(size_t)r * 512 + head * 128 + dv1]);
        atomicAdd(cnt + 10, 2u);
        if (!(fabsf(s0 - o0) <= 0.05f * fabsf(o0) + 0.002f)) atomicAdd(cnt + 8, 1u);
        if (!(fabsf(s1 - o1) <= 0.05f * fabsf(o1) + 0.002f)) atomicAdd(cnt + 8, 1u);
    }
}
__device__ __forceinline__ void check_hyena(const Params& p, LAS unsigned char* lds) {
    unsigned char* ws = launder(p.ws); unsigned* cnt = (unsigned*)(ws + OFF_DBGW);
    const int tid = tid_l();
    unsigned hsh = (unsigned)blockIdx.x * 2654435761u + 555u; hsh ^= hsh >> 15; hsh *= 2246822519u; hsh ^= hsh >> 13;
    const int set = (int)(blockIdx.x & 1u); const int c = (int)(hsh % 512u); const int NB = set ? NBS : NBP; const int b = (int)((hsh >> 12) % (unsigned)NB);
    const int LG = set ? LGS : LGP;
    const size_t base = (set ? XT_SET1 : 0) + ((size_t)c * NB + b) * LG;
    const bf16_t* X1 = (const bf16_t*)(ws + OFF_X1T) + base; const bf16_t* X2 = (const bf16_t*)(ws + OFF_X2T) + base; const bf16_t* V0 = (const bf16_t*)(ws + OFF_V0T) + base;
    const bf16_t* HD = (const bf16_t*)(ws + OFF_HDBG) + base;
    const bf16_t* G0 = (const bf16_t*)(ws + (set ? OFF_GR1 : OFF_GR0)) + (size_t)c * (2 * LG); const bf16_t* G1 = G0 + (size_t)512 * (2 * LG);
    const float bias0 = p.in[17][c], bias1 = p.in[17][512 + c];
    LAS float* z1 = (LAS float*)lds;
    for (int t = tid; t < LG; t += 512) {
        float y = 0.f;
        for (int s2 = 48; s2 < LG; ++s2) y += bf2f(G0[LG - (t - s2)]) * bf2f(V0[s2]);
        const float v = bf2f(X1[t]) * (y + bf2f(V0[t]) * bias0);
        z1[t] = (t >= 48) ? bf2f((unsigned short)(cvt_pk_bf16(v, 0.f) & 0xffffu)) : 0.f;
    }
    __syncthreads();
    {
        unsigned h2 = hsh * 3266489917u + (unsigned)tid * 2246822519u; h2 ^= h2 >> 15; h2 *= 2654435761u; h2 ^= h2 >> 13;
        const int t = 64 + (int)(h2 % (unsigned)(LG - 64));
        float y = 0.f;
        for (int s2 = 48; s2 < LG; ++s2) y += bf2f(G1[LG - (t - s2)]) * z1[s2];
        const float e = bf2f(X2[t]) * (y + z1[t] * bias1);
        const float st = bf2f(HD[t]);
        atomicAdd(cnt + 11, 1u);
        if (!(fabsf(st - e) <= 0.05f * fabsf(e) + 1.0f)) atomicAdd(cnt + 9, 1u);
    }
    __syncthreads();
}
#endif

#if DEBUG_CHECK == 7
__device__ __forceinline__ void check_h0b_full(const Params& p, int slot) {
    unsigned char* ws = launder(p.ws); unsigned* cnt = (unsigned*)(ws + OFF_DBGW);
    const bf16_t* h0b = (const bf16_t*)(ws + OFF_H0B);
    const int tid = tid_l(), lane = tid & 63, wave = tid >> 6;
    for (int row = blockIdx.x * 8 + wave; row < T; row += gridDim.x * 8) {
        int pos, seq; row_info(row, pos, seq);
        const float* xr = pos < 16 ? p.in[2] + (size_t)pos * 1024 : (seq < NBP ? p.in[0] + ((size_t)seq * 8192 + (pos - 16)) * 1024 : p.in[1] + ((size_t)(seq - NBP) * 2048 + (pos - 16)) * 1024);
        int bad = 0;
        for (int c = lane; c < 1024; c += 64) { const float e = xr[c]; const float st = bf2f(h0b[(size_t)row * 1024 + c]); if (!(fabsf(st - e) <= 0.01f * fabsf(e) + 0.001f)) bad = 1; }
        bad = __any(bad);
        if (lane == 0 && bad) atomicAdd(cnt + slot, 1u);
    }
}
#endif

#if DEBUG_CHECK == 8
__device__ __forceinline__ void check_p_golden(const Params& p) {
    unsigned char* ws = launder(p.ws); unsigned* cnt = (unsigned*)(ws + OFF_DBGW);
    const bf16_t* P = (const bf16_t*)(ws + OFF_P);
    const unsigned idx = blockIdx.x * 512u + (unsigned)tid_l();
    unsigned hsh = idx * 2654435761u + 8888u; hsh ^= hsh >> 15; hsh *= 2246822519u; hsh ^= hsh >> 13;
    const int row = (int)(hsh % (unsigned)T); hsh = hsh * 3266489917u + 668265263u; hsh ^= hsh >> 16;
    int pos, seq; row_info(row, pos, seq);
    const float* xr = pos < 16 ? p.in[2] + (size_t)pos * 1024 : (seq < NBP ? p.in[0] + ((size_t)seq * 8192 + (pos - 16)) * 1024 : p.in[1] + ((size_t)(seq - NBP) * 2048 + (pos - 16)) * 1024);
    const float* W = p.in[4]; const float* g = p.in[3];
    const int colA = 448 + (int)(hsh % 1536u), colB = (int)((hsh >> 7) % 384u);
    float ss = 0.f, a = 0.f, b = 0.f;
    for (int k = 0; k < 1024; ++k) { const float x = xr[k]; ss += x * x; a += x * g[k] * W[(size_t)k * 1984 + colA]; b += x * g[k] * W[(size_t)k * 1984 + colB]; }
    const float r0 = rsqrtf(ss * (1.f / 1024.f) + EPS); a *= r0; b *= r0;
    const float sa = bf2f(P[(size_t)row * NPP + colA]), sb = bf2f(P[(size_t)row * NPP + colB]);
    if (!(fabsf(sa - a) <= 0.03f * fabsf(a) + 0.03f)) atomicAdd(cnt + 8, 1u);
    if (!(fabsf(sb - b) <= 0.03f * fabsf(b) + 0.03f)) atomicAdd(cnt + 9, 1u);
}
#endif

#if DEBUG_CHECK == 9
__device__ __forceinline__ void check_win_r0(const Params& p) {
    unsigned char* ws = launder(p.ws); unsigned* cnt = (unsigned*)(ws + OFF_DBGW);
    const bf16_t* WT = (const bf16_t*)(ws + OFF_WIN); const float* W = p.in[4]; const float* g = p.in[3]; const float* R0 = (const float*)(ws + OFF_R0);
    const int tid = tid_l(), lane = tid & 63, wave = tid >> 6;
    const int gtid = blockIdx.x * 512 + tid, gthreads = gridDim.x * 512;
    for (int e = gtid; e < 1984 * 1024; e += gthreads) {
        const int n = e >> 10, k = e & 1023; const int sc = src_col(1, n);
        const float ex = W[(size_t)k * 1984 + sc] * g[k]; const float st = bf2f(WT[(size_t)n * 1024 + k]);
        if (!(fabsf(st - ex) <= 0.01f * fabsf(ex) + 1e-5f)) atomicAdd(cnt + 8, 1u);
    }
    for (int row = blockIdx.x * 8 + wave; row < T; row += gridDim.x * 8) {
        int pos, seq; row_info(row, pos, seq);
        const float* xr = pos < 16 ? p.in[2] + (size_t)pos * 1024 : (seq < NBP ? p.in[0] + ((size_t)seq * 8192 + (pos - 16)) * 1024 : p.in[1] + ((size_t)(seq - NBP) * 2048 + (pos - 16)) * 1024);
        float ss = 0.f;
        for (int c = lane; c < 1024; c += 64) ss += xr[c] * xr[c];
        ss = wave_sum(ss);
        const float ex = rsqrtf(ss * (1.f / 1024.f) + EPS); const float st = R0[row];
        if (lane == 0 && !(fabsf(st - ex) <= 0.001f * ex)) { atomicAdd(cnt + 9, 1u); atomicAdd(cnt + 12, (unsigned)(row >> 6)); }
    }
}
#endif

#if DEBUG_CHECK == 10
__device__ __forceinline__ void check_x(const Params& p, int mode) {
    unsigned char* ws = launder(p.ws); unsigned* cnt = (unsigned*)(ws + OFF_DBGW); unsigned* sums = (unsigned*)(ws + OFF_DBGW + MiB);
    const int tid = tid_l(), lane = tid & 63, wave = tid >> 6;
    for (int n = blockIdx.x * 8 + wave; n < TN; n += gridDim.x * 8) {
        const unsigned* xr = (const unsigned*)(n < 65536 ? p.in[0] + (size_t)n * 1024 : p.in[1] + (size_t)(n - 65536) * 1024);
        unsigned a = 0u;
        for (int c = lane; c < 1024; c += 64) a += xr[c] * (2u * (unsigned)c + 1u);
#pragma unroll
        for (int o = 1; o < 64; o <<= 1) a += __shfl_xor(a, o);
        if (lane == 0) {
            if (mode == 0) __hip_atomic_store(sums + n, a, __ATOMIC_RELAXED, __HIP_MEMORY_SCOPE_AGENT);
            else if (__hip_atomic_load(sums + n, __ATOMIC_RELAXED, __HIP_MEMORY_SCOPE_AGENT) != a) atomicAdd(cnt + 8, 1u);
        }
    }
}
#endif

#if DEBUG_CHECK == 11
__device__ __forceinline__ void check_filt_prep(const Params& p) {
    unsigned char* ws = launder(p.ws); unsigned* cnt = (unsigned*)(ws + OFF_DBGW);
    const unsigned idx = blockIdx.x * 512u + (unsigned)tid_l();
    unsigned hsh = idx * 2654435761u + 1111u; hsh ^= hsh >> 15; hsh *= 2246822519u; hsh ^= hsh >> 13;
    {
        const int set = (int)(hsh & 1u); const int L = set ? LS : LP; const int C0 = set ? LGS : LGP;
        const int n = (int)((hsh >> 1) % 2048u); hsh = hsh * 3266489917u + 668265263u; hsh ^= hsh >> 16;
        const int t = (int)(hsh % (unsigned)L);
        const float* f_w1 = p.in[10]; const float* f_b1 = p.in[11]; const float* f_freq = p.in[12]; const float* f_w2 = p.in[13];
        const float* f_b2 = p.in[14]; const float* f_w3 = p.in[15]; const float* f_decay = p.in[16];
        const float tn = (float)t / (float)(L - 1); const float w = (6.2831853071795865f * (float)t) / (float)L;
        float acc = 0.f;
        for (int j2 = 0; j2 < 64; ++j2) {
            float a2 = f_b2[j2];
            for (int j1 = 0; j1 < 64; ++j1) {
                float a1 = f_b1[j1] + tn * f_w1[j1];
                for (int k = 0; k < 16; ++k) { const float f = 1e-4f + (float)k * ((15.0f - 1e-4f) / 15.0f); float sn, cs; sincos_red(f * w, sn, cs);
                    a1 += cs * f_w1[(1 + k) * 64 + j1] - sn * f_w1[(17 + k) * 64 + j1]; }
                a2 += sin_red(f_freq[j1] * a1) * f_w2[j1 * 64 + j2];
            }
            acc += sin_red(f_freq[j2] * a2) * f_w3[j2 * 2048 + n];
        }
        const float e = acc * __expf(-tn * fabsf(f_decay[n]));
        const int order = n >> 10, dir = (n >> 9) & 1, c = n & 511;
        if (!(dir == 1 && t == 0)) {
            const bf16_t* row = (const bf16_t*)(ws + (set ? OFF_GR1 : OFF_GR0)) + (size_t)(order * 512 + c) * (2 * C0);
            const float st = bf2f(row[dir ? C0 + t : C0 - t]);
            if (!(fabsf(st - e) <= 0.02f * fabsf(e) + 0.003f)) atomicAdd(cnt + 8, 1u);
        }
    }
    {
        const int seq = (int)(hsh % 40u); const int set = seq < NBP ? 0 : 1; const int L = set ? LS : LP; const int Lg = set ? LGS : LGP; const int NB = set ? NBS : NBP;
        const int b = set ? seq - NBP : seq; const int row0 = set ? TPR + b * LS : b * LP;
        hsh = hsh * 3266489917u + 668265263u; hsh ^= hsh >> 16;
        const int pos = (int)(hsh % (unsigned)L); const int which = (int)((hsh >> 16) % 3u); const int c = (int)((hsh >> 20) % 512u);
        const bf16_t* P = (const bf16_t*)(ws + OFF_P); const float* cw = p.in[9]; const int col = 448 + which * 512 + c;
        const float um = pos > 0 ? bf2f(P[(size_t)(row0 + pos - 1) * NPP + col]) : 0.f, u0 = bf2f(P[(size_t)(row0 + pos) * NPP + col]), up = pos + 1 < L ? bf2f(P[(size_t)(row0 + pos + 1) * NPP + col]) : 0.f;
        const float e = um * cw[which * 512 + c] + u0 * cw[1536 + which * 512 + c] + up * cw[3072 + which * 512 + c];
        const bf16_t* XT = (const bf16_t*)(ws + (which == 0 ? OFF_X1T : (which == 1 ? OFF_X2T : OFF_V0T))) + (set ? XT_SET1 : 0) + ((size_t)c * NB + b) * Lg;
        const float st = bf2f(XT[pos + 48]);
        if (!(fabsf(st - e) <= 0.02f * fabsf(e) + 0.02f)) atomicAdd(cnt + 9, 1u);
    }
}
#endif
#ifndef SUB_MASK
#define SUB_MASK 15
#endif
#ifndef PHASE_MASK
#define PHASE_MASK 1023
#endif
__global__ void __launch_bounds__(512) hymba_fwd(Params p) {
    extern __shared__ __attribute__((aligned(16))) unsigned char lds_raw[];
    LAS unsigned char* lds = (LAS unsigned char*)lds_raw;
    cg::grid_group grid = cg::this_grid();
#define GSYNC() do { asm volatile("s_waitcnt vmcnt(0) lgkmcnt(0)" ::: "memory"); grid.sync(); } while (0)
    const int G = gridDim.x;
    __builtin_amdgcn_fence(__ATOMIC_SEQ_CST, "agent");
    asm volatile("buffer_inv sc1\n\ts_waitcnt vmcnt(0)" ::: "memory");
#if DEBUG_CHECK == 10
    check_x(p, 0);
#endif
#if PHASE_MASK & 1
    p0_prologue(p, lds);
#endif
    GSYNC();
#if DEBUG_CHECK == 3
    check_h0b(p, 8);
#endif
#if DEBUG_CHECK == 7
    check_h0b_full(p, 8);
#endif
#if DEBUG_CHECK == 4
    check_stale(p, (const unsigned*)(launder(p.ws) + OFF_H0B), (unsigned)((size_t)T * 512), 9);
#endif
#if PHASE_MASK & 2
    {
        unsigned char* ws = launder(p.ws); unsigned char* ob = launder((unsigned char*)p.out);
        pg8::Gemm g{(const bf16_t*)(ws + OFF_H0B), (const bf16_t*)(ws + OFF_WIN), TPAD, 2048, 1024, 1024, 1024};
        pg8::StaticOrder S; S.init(TPAD, 2048, G, blockIdx.x);
        Epi<0> E{(bf16_t*)(ws + OFF_P), NPP, (const float*)(ws + OFF_R0), (float*)(ws + OFF_SQQP), (float*)(ws + OFF_SQKVP), (bf16_t*)(ob + DO_KR), (const float2*)(ws + OFF_RT)};
        pg8::gemm_phase(lds, g, S, E);
    }
#endif
    GSYNC();
#if DEBUG_CHECK == 1
    { unsigned char* ws = launder(p.ws); check_gemm((const bf16_t*)(ws + OFF_H0B), 1024, (const bf16_t*)(ws + OFF_WIN), 1024, 1024, T, 1984, 0, (const bf16_t*)(ws + OFF_P), NPP, (const float*)(ws + OFF_R0), (unsigned*)(ws + OFF_DBG) + 0, 448); }
    GSYNC();
#endif
#if DEBUG_CHECK == 3
    check_h0b(p, 9);
#endif
#if DEBUG_CHECK == 8
    check_p_golden(p);
#endif
#if DEBUG_CHECK == 9
    check_win_r0(p);
#endif
#if DEBUG_CHECK == 7
    check_h0b_full(p, 9);
    GSYNC();
#endif
#if DEBUG_CHECK == 6
    { unsigned char* ws = launder(p.ws);
      check_gemm((const bf16_t*)(ws + OFF_H0B), 1024, (const bf16_t*)(ws + OFF_WIN), 1024, 1024, T, 448, 0, (const bf16_t*)(ws + OFF_P), NPP, (const float*)(ws + OFF_R0), (unsigned*)(ws + OFF_DBG) + 8, 384);
      check_gemm((const bf16_t*)(ws + OFF_H0B), 1024, (const bf16_t*)(ws + OFF_WIN), 1024, 1024, T, 384, 7, (const bf16_t*)(ws + OFF_P), NPP, (const float*)(ws + OFF_R0), (unsigned*)(ws + OFF_DBG) + 9, 0); }
    GSYNC();
#endif
#if DEBUG_CHECK == 4
    check_stale(p, (const unsigned*)(launder(p.ws) + OFF_P), (unsigned)((size_t)T * 1024), 8);
#endif
    rownorm_phase(p);
    krope_phase(p);
    GSYNC();
#if (PHASE_MASK & 4) && (SUB2 & 1)
    {
        unsigned char* ws = launder(p.ws); unsigned char* ob = launder((unsigned char*)p.out);
        pg8::Gemm g{(const bf16_t*)(ws + OFF_P), (const bf16_t*)(ws + OFF_WUQ), TPAD, 768, 256, NPP, 256};
        pg8::StaticOrder S; S.init(TPAD, 768, G, blockIdx.x);
        Epi<1> E{(bf16_t*)(ob + DO_Q), 768, (const float*)(ws + OFF_RQ), nullptr, nullptr, nullptr, (const float2*)(ws + OFF_RT)};
        pg8::gemm_phase(lds, g, S, E);
    }
#endif
#if (PHASE_MASK & 4) && (SUB2 & 2)
    {
        unsigned char* ws = launder(p.ws); unsigned char* ob = launder((unsigned char*)p.out);
        pg8::Gemm g{(const bf16_t*)(ws + OFF_P) + 256, (const bf16_t*)(ws + OFF_WKN), TPAD, 512, 128, NPP, 128};
        pg8::StaticOrder S; S.init(TPAD, 512, G, blockIdx.x);
        Epi<2> E{(bf16_t*)(ob + DO_KN), 512, (const float*)(ws + OFF_RKV), nullptr, nullptr, nullptr, nullptr};
        pg8::gemm_phase(lds, g, S, E);
    }
#endif
#if (PHASE_MASK & 4) && (SUB2 & 4)
    {
        unsigned char* ws = launder(p.ws); unsigned char* ob = launder((unsigned char*)p.out);
        pg8::Gemm g{(const bf16_t*)(ws + OFF_WV), (const bf16_t*)(ws + OFF_P) + 256, 512, TPAD, 128, 128, NPP};
        pg8::StaticOrder S; S.init(512, TPAD, G, blockIdx.x);
        Epi<3> E{(bf16_t*)(ob + DO_VT), TPAD, (const float*)(ws + OFF_RKV), nullptr, nullptr, nullptr, nullptr};
        pg8::gemm_phase(lds, g, S, E);
    }
#endif
#if PHASE_MASK & 8
    hyprep_phase(p, lds);
#endif
    GSYNC();
#if DEBUG_CHECK == 2
    check_proj(p);
    GSYNC();
#endif
#if DEBUG_CHECK == 11
    check_filt_prep(p);
    GSYNC();
#endif
#if PHASE_MASK & 16
    attn_phase(p, lds);
#endif
#if PHASE_MASK & 32
    hyena_phase(p, lds);
#endif
    GSYNC();
#if DEBUG_CHECK == 5
    check_attn(p);
    check_hyena(p, lds);
    GSYNC();
#endif
#if PHASE_MASK & 64
    mixnorm_phase(p, lds);
#endif
    GSYNC();
#if PHASE_MASK & 128
    {
        unsigned char* ws = launder(p.ws);
        pg8::Gemm g{(const bf16_t*)(ws + OFF_MIXN), (const bf16_t*)(ws + OFF_WO), TN, 1024, 1024, 1024, 1024};
        pg8::StaticOrder S; S.init(TN, 1024, G, blockIdx.x);
        Epi<4> E{(bf16_t*)(ws + OFF_MIX), 1024, nullptr, (float*)(ws + OFF_SQMIXP), nullptr, nullptr, nullptr};
        pg8::gemm_phase(lds, g, S, E);
    }
#endif
    GSYNC();
#if DEBUG_CHECK == 1
    { unsigned char* ws = launder(p.ws); check_gemm((const bf16_t*)(ws + OFF_MIXN), 1024, (const bf16_t*)(ws + OFF_WO), 1024, 1024, TN, 1024, 4, (const bf16_t*)(ws + OFF_MIX), 1024, nullptr, (unsigned*)(ws + OFF_DBG) + 1, 0); }
#endif
#if DEBUG_CHECK == 10
    check_x(p, 1);
#endif
#if PHASE_MASK & 256
    h1_phase(p);
#endif
    GSYNC();
#if PHASE_MASK & 512
#if DEBUG_CHECK == 1
#define DBG_FF1(half) if ((half) == 0) { unsigned char* ws = launder(p.ws); check_gemm((const bf16_t*)(ws + OFF_H1B), 1024, (const bf16_t*)(ws + OFF_WF1), 1024, 1024, 65536, 4096, 5, (const bf16_t*)(ws + OFF_M), 4096, (const float*)(ws + OFF_R1), (unsigned*)(ws + OFF_DBG) + 2, 0); }
#define DBG_FF2(half) if ((half) == 0) { unsigned char* ws = launder(p.ws); check_gemm((const bf16_t*)(ws + OFF_M), 4096, (const bf16_t*)(ws + OFF_WF2), 4096, 4096, 65536, 1024, 6, (const bf16_t*)(ws + OFF_M2), 1024, nullptr, (unsigned*)(ws + OFF_DBG) + 3, 0); } GSYNC();
#else
#define DBG_FF1(half)
#define DBG_FF2(half)
#endif
#define FFN_HALF(half) \
    { \
        unsigned char* ws = launder(p.ws); \
        pg8::Gemm g{(const bf16_t*)(ws + OFF_H1B) + (size_t)(half) * 65536 * 1024, (const bf16_t*)(ws + OFF_WF1), 65536, 4096, 1024, 1024, 1024}; \
        pg8::StaticOrder S; S.init(65536, 4096, G, blockIdx.x); \
        Epi<5> E{(bf16_t*)(ws + OFF_M), 4096, (const float*)(ws + OFF_R1) + (half) * 65536, nullptr, nullptr, nullptr, nullptr}; \
        pg8::gemm_phase(lds, g, S, E); \
    } \
    GSYNC(); \
    DBG_FF1(half) \
    { \
        unsigned char* ws = launder(p.ws); \
        pg8::Gemm g{(const bf16_t*)(ws + OFF_M), (const bf16_t*)(ws + OFF_WF2), 65536, 1024, 4096, 4096, 4096}; \
        pg8::StaticOrder S; S.init(65536, 1024, G, blockIdx.x); \
        Epi<6> E{(bf16_t*)(ws + OFF_M2), 1024, nullptr, (float*)(ws + OFF_SQM2P) + (size_t)(half) * 65536 * 16, nullptr, nullptr, nullptr}; \
        pg8::gemm_phase(lds, g, S, E); \
    } \
    GSYNC(); \
    DBG_FF2(half) \
    final_phase(p, half);
    FFN_HALF(0)
    FFN_HALF(1)
#undef FFN_HALF
#endif
}

extern "C" void kernel_launch(void* const* d_in, const int* in_sizes, int n_in, void* d_out, int out_size, void* d_ws, size_t ws_size, hipStream_t stream) {
    static int grid = 0;
    if (grid == 0) {
        int dev = 0, cus = 0, per_cu = 0;
        hipGetDevice(&dev);
        hipDeviceGetAttribute(&cus, hipDeviceAttributeMultiprocessorCount, dev);
        hipFuncSetAttribute((const void*)hymba_fwd, hipFuncAttributeMaxDynamicSharedMemorySize, LDS_BYTES);
        hipOccupancyMaxActiveBlocksPerMultiprocessor(&per_cu, (const void*)hymba_fwd, 512, LDS_BYTES);
        if (per_cu < 1) per_cu = 1;
        grid = cus * 1;
        if (n_in != 26 || ws_size < 1024 * MiB) fprintf(stderr, "kernel_launch: unexpected n_in %d / ws_size %zu\n", n_in, ws_size);
    }
    Params p{};
    for (int i = 0; i < 26; ++i) p.in[i] = (const float*)d_in[i];
    p.out = (float*)d_out; p.ws = (unsigned char*)d_ws;
    void* args[] = {&p};
    hipError_t e = hipLaunchCooperativeKernel((const void*)hymba_fwd, dim3(grid), dim3(512), args, LDS_BYTES, stream);
    if (e != hipSuccess) fprintf(stderr, "cooperative launch failed: %s (grid %d)\n", hipGetErrorString(e), grid);
}
```

```cpp
#include <hip/hip_runtime.h>
#include <hip/hip_cooperative_groups.h>
#include <cstdio>
#include <cstdint>
namespace cg = cooperative_groups;
#ifndef DBG_SEL0
#define DBG_SEL0 3
#endif
#ifndef DBG_SEL1
#define DBG_SEL1 0
#endif
#ifndef DEBUG_CHECK
#define DEBUG_CHECK 0
#endif
#ifndef EXPT
#define EXPT 0
#endif
#ifndef SUB_MASK
#define SUB_MASK 15
#endif
#ifndef SUB2
#define SUB2 7
#endif

#define LAS __attribute__((address_space(3)))
#define GAS __attribute__((address_space(1)))
typedef unsigned short bf16_t;
typedef short bf16x8 __attribute__((ext_vector_type(8)));
typedef float f32x4 __attribute__((ext_vector_type(4)));
typedef float f32x16 __attribute__((ext_vector_type(16)));
typedef unsigned u32x4 __attribute__((ext_vector_type(4)));
typedef unsigned u32x2 __attribute__((ext_vector_type(2)));

constexpr int DM = 1024, LP = 8208, LS = 2064, NBP = 8, NBS = 32;
constexpr int TPR = NBP * LP;
constexpr int TSR = NBS * LS;
constexpr int T = TPR + TSR;
constexpr int TPAD = 131840;
constexpr int TN = 131072;
constexpr int NPP = 2048;
constexpr int LGP = 8256, LGS = 2112;
constexpr float EPS = 1e-6f;
constexpr float QSCALE = 0.07216878364870322f * 1.4426950408889634f;

constexpr size_t MiB = 1ull << 20;
constexpr size_t OFF_H0B = 0;
constexpr size_t XT_SET1 = (size_t)512 * NBP * LGP;
constexpr size_t OFF_X1T = 0;
constexpr size_t OFF_X2T = 131 * MiB;
constexpr size_t OFF_P = 262 * MiB;
constexpr size_t OFF_V0T = 778 * MiB;
constexpr size_t OFF_MIXN = 262 * MiB;
constexpr size_t OFF_MIX = 518 * MiB;
constexpr size_t OFF_H1B = 0;
constexpr size_t OFF_M = 256 * MiB;
constexpr size_t OFF_M2 = 768 * MiB;
constexpr size_t OFF_SQMIXP = 896 * MiB;
constexpr size_t OFF_SQM2P = 904 * MiB;
constexpr size_t OFF_SMALL = 912 * MiB;
constexpr size_t OFF_WIN = OFF_SMALL;
constexpr size_t OFF_WUQ = OFF_SMALL + 4 * MiB;
constexpr size_t OFF_WKN = OFF_SMALL + 4 * MiB + 512 * 1024;
constexpr size_t OFF_WV = OFF_SMALL + 4 * MiB + 768 * 1024;
constexpr size_t OFF_WO = OFF_SMALL + 5 * MiB;
constexpr size_t OFF_WF1 = OFF_SMALL + 7 * MiB;
constexpr size_t OFF_WF2 = OFF_SMALL + 15 * MiB;
constexpr size_t OFF_GR0 = OFF_SMALL + 23 * MiB;
constexpr size_t OFF_GR1 = OFF_SMALL + 56 * MiB;
constexpr size_t OFF_RT = OFF_SMALL + 65 * MiB;
constexpr size_t OFF_R0 = OFF_SMALL + 68 * MiB;
constexpr size_t OFF_R1 = OFF_SMALL + 69 * MiB;
constexpr size_t OFF_RQ = OFF_SMALL + 70 * MiB;
constexpr size_t OFF_RKV = OFF_SMALL + 71 * MiB;
constexpr size_t OFF_SQQP = OFF_SMALL + 72 * MiB;
constexpr size_t OFF_SQKVP = OFF_SMALL + 75 * MiB;
constexpr size_t OFF_DBGW = OFF_SMALL + 78 * MiB;
constexpr size_t DO_Q = 0;
constexpr size_t DO_KN = 194 * MiB;
constexpr size_t DO_KR = 323 * MiB;
constexpr size_t DO_VT = 340 * MiB;

constexpr size_t OFF_ODBG = 518 * MiB;
constexpr size_t OFF_HDBG = 647 * MiB;
constexpr int LDS_BYTES = 147456;

struct Params {
    const float* in[26];
    float* out;
    unsigned char* ws;
};

__device__ __forceinline__ f32x4 ld_sys(const float* q) { f32x4 v; asm volatile("global_load_dwordx4 %0, %1, off sc0 sc1\n\ts_waitcnt vmcnt(0)" : "=v"(v) : "v"(q) : "memory"); return v; }
__device__ __forceinline__ float ldco(const float* q) { return __builtin_bit_cast(float, __hip_atomic_load((const unsigned*)q, __ATOMIC_RELAXED, __HIP_MEMORY_SCOPE_AGENT)); }
__device__ __forceinline__ float2 ldco2(const float2* q) { const unsigned long long w = __hip_atomic_load((const unsigned long long*)q, __ATOMIC_RELAXED, __HIP_MEMORY_SCOPE_AGENT); return make_float2(__builtin_bit_cast(float, (unsigned)w), __builtin_bit_cast(float, (unsigned)(w >> 32))); }
template <class Tp> __device__ __forceinline__ Tp* launder(Tp* q) { asm volatile("" : "+s"(q)); return q; }
__device__ __forceinline__ int tid_l() { int t = threadIdx.x; asm volatile("" : "+v"(t)); return t; }
__device__ __forceinline__ unsigned cvt_pk_bf16(float lo, float hi) { unsigned r; asm volatile("v_cvt_pk_bf16_f32 %0, %1, %2" : "=v"(r) : "v"(lo), "v"(hi)); return r; }
__device__ __forceinline__ float bf2f(unsigned short b) { return __builtin_bit_cast(float, (unsigned)b << 16); }
__device__ __forceinline__ float bflo(unsigned w) { return __builtin_bit_cast(float, w << 16); }
__device__ __forceinline__ float bfhi(unsigned w) { return __builtin_bit_cast(float, w & 0xffff0000u); }
__device__ __forceinline__ float wave_sum(float v) {
#pragma unroll
    for (int o = 1; o < 64; o <<= 1) v += __shfl_xor(v, o);
    return v;
}
__device__ __forceinline__ void sincos_red(float x, float& s, float& c) {
    const double xd = (double)x; const double k = rint(xd * 0.15915494309189535); const float r = (float)(xd - k * 6.283185307179586);
    s = __sinf(r); c = __cosf(r);
}
__device__ __forceinline__ float sin_red(float x) { float s, c; sincos_red(x, s, c); return s; }
__device__ __forceinline__ void row_info(int r, int& pos, int& seq) {
    if (r < TPR) { seq = r / LP; pos = r - seq * LP; }
    else { int q = r - TPR; if (q >= TSR) q = TSR - 1; const int b = q / LS; pos = q - b * LS; seq = NBP + b; }
}
__device__ __forceinline__ int full_row(int n) {
    if (n < 65536) { const int b = n >> 13; return b * LP + 16 + (n & 8191); }
    const int q = n - 65536; const int b = q >> 11; return TPR + b * LS + 16 + (q & 2047);
}

namespace pg8 {
constexpr int BM = 256, BK = 64, HALF = 128, HTB = HALF * BK * 2, STAGE_BYTES = 8 * HTB, NXCD = 8, WGM = 8;
__host__ __device__ __forceinline__ int lds_byte(int r, int c) { const int st = (r >> 4) * 2 + (c >> 5), rr = r & 15, cc = c & 31, ob = rr * 64 + cc * 2; return st * 1024 + (ob ^ (((ob >> 9) & 1) << 5)); }
__host__ __device__ __forceinline__ void stage_rc(int b, int& R, int& C) { const int st = b / 1024, sb = b % 1024, swz = sb ^ (((sb >> 9) & 1) << 5); R = (st >> 1) * 16 + swz / 64; C = (st & 1) * 32 + (swz % 64) / 2; }
__host__ __device__ __forceinline__ int perm32(int rho) { const int n = rho >> 4, i = rho & 15; return 8 * (i >> 2) + 4 * n + (i & 3); }
struct Unit { int pm, pn; };
struct Gemm { const bf16_t* A; const bf16_t* Bt; int M, N, K, lda, ldb; };
struct StaticOrder {
    int nM, nN, nwg, G, c;
    __device__ void init(int M, int N, int G_, int c_) { nM = M / BM; nN = N / BM; nwg = nM * nN; G = G_; c = c_; }
    __device__ bool next(int i, Unit& u) const {
        const long L = (long)i * G + c; if (L >= nwg) return false;
        int wgid = (int)L; { const int q = nwg / NXCD, r = nwg % NXCD, xcd = wgid % NXCD, off = wgid / NXCD; wgid = (xcd < r ? xcd * (q + 1) : r * (q + 1) + (xcd - r) * q) + off; }
        const int nig = WGM * nN, gid = wgid / nig, fm = gid * WGM, gsz = (nM - fm) < WGM ? (nM - fm) : WGM;
        u.pm = fm + ((wgid % nig) % gsz); u.pn = (wgid % nig) / gsz; return true;
    }
};
template <class Epi>
__device__ __forceinline__ void gemm_phase(LAS unsigned char* lds, const Gemm g, const StaticOrder& S, const Epi& E) {
    const int tid = tid_l(), wid = __builtin_amdgcn_readfirstlane(tid >> 6), lane = tid & 63, wr = wid >> 2, wc = wid & 3, fr = lane & 15, fq = lane >> 4;
    const int K = g.K, nt = K / BK;
    unsigned voffA[2], voffB[2];
#pragma unroll
    for (int i = 0; i < 2; ++i) { int R, C; stage_rc(tid * 16 + i * 8192, R, C); const int Rb = (R & ~31) + perm32(R & 31);
        voffA[i] = (unsigned)(R * g.lda + C) * 2u; voffB[i] = (unsigned)(Rb * g.ldb + C) * 2u; }
    const size_t kstep = (size_t)(BK * 2);
    const size_t hstepA = (size_t)HALF * g.lda * 2, hstepB = (size_t)HALF * g.ldb * 2;
    const size_t tstepA = 2 * hstepA, tstepB = 2 * hstepB;
    const unsigned ldsw = (unsigned)wid * 1024u;
    const int aoff = lds_byte(wr * 64 + fr, fq * 8), boff = lds_byte(wc * 32 + fr, fq * 8);
#define PG8_SA(b, h) (((b) * 2 + (h)) * HTB)
#define PG8_SB(b, h) ((4 + (b) * 2 + (h)) * HTB)
#define PG8_STAGE(bufoff, gbase, voff) do { _Pragma("unroll") for (int _i = 0; _i < 2; ++_i) \
        __builtin_amdgcn_global_load_lds((const unsigned*)((const char*)(gbase) + (voff)[_i]), (LAS unsigned*)(lds + (bufoff) + ldsw + _i * 8192), 16, 0, 0); } while (0)
#define PG8_LDA(dst, b, h) do { _Pragma("unroll") for (int m = 0; m < 4; ++m) _Pragma("unroll") for (int k = 0; k < 2; ++k) dst[m][k] = *(const LAS bf16x8*)(lds + PG8_SA(b, h) + aoff + m * 2048 + k * 1024); } while (0)
#define PG8_LDB(dst, b, h) do { _Pragma("unroll") for (int n = 0; n < 2; ++n) _Pragma("unroll") for (int k = 0; k < 2; ++k) dst[n][k] = *(const LAS bf16x8*)(lds + PG8_SB(b, h) + boff + n * 2048 + k * 1024); } while (0)
#define PG8_MMA(ai, bj, At, Bt) do { __builtin_amdgcn_s_setprio(1); _Pragma("unroll") for (int m = 0; m < 4; ++m) _Pragma("unroll") for (int n = 0; n < 2; ++n) _Pragma("unroll") for (int k = 0; k < 2; ++k) \
        acc[ai][bj][m][n] = __builtin_amdgcn_mfma_f32_16x16x32_bf16(Bt[n][k], At[m][k], acc[ai][bj][m][n], 0, 0, 0); __builtin_amdgcn_s_setprio(0); } while (0)
#define PG8_WAIT_V(n) asm volatile("s_waitcnt vmcnt(" #n ")" ::: "memory")
#define PG8_WAIT_L(n) asm volatile("s_waitcnt lgkmcnt(" #n ")" ::: "memory")
#define PG8_BAR __builtin_amdgcn_s_barrier()
#define PG8_SCHED __builtin_amdgcn_sched_barrier(0)
    Unit cur, nxt; int ui = 0;
    if (!S.next(0, cur)) return;
    f32x4 acc[2][2][4][2];
#pragma unroll
    for (int a = 0; a < 2; ++a)
#pragma unroll
        for (int b = 0; b < 2; ++b)
#pragma unroll
            for (int m = 0; m < 4; ++m)
#pragma unroll
                for (int n = 0; n < 2; ++n) acc[a][b][m][n] = (f32x4){0.f, 0.f, 0.f, 0.f};
    bf16x8 At[4][2], B0[2][2], B1[2][2];
    const char* cA = (const char*)g.A + (size_t)cur.pm * tstepA; const char* cB = (const char*)g.Bt + (size_t)cur.pn * tstepB;
    PG8_STAGE(PG8_SB(0, 0), cB, voffB); PG8_STAGE(PG8_SB(0, 1), cB + hstepB, voffB); PG8_STAGE(PG8_SA(0, 0), cA, voffA); PG8_STAGE(PG8_SA(0, 1), cA + hstepA, voffA);
    if (wr == 1) PG8_BAR;
    PG8_WAIT_V(2); PG8_BAR;
    PG8_STAGE(PG8_SB(1, 0), cB + kstep, voffB); PG8_STAGE(PG8_SA(1, 0), cA + kstep, voffA); PG8_STAGE(PG8_SB(1, 1), cB + hstepB + kstep, voffB);
    PG8_WAIT_V(6); PG8_BAR;
    for (;;) {
        const bool has_next = S.next(ui + 1, nxt);
        const char* nA = has_next ? (const char*)g.A + (size_t)nxt.pm * tstepA : cA; const char* nB = has_next ? (const char*)g.Bt + (size_t)nxt.pn * tstepB : cB;
        for (int t = 0; t < nt; t += 2) {
            const bool last = (t == nt - 2);
            const char* a1 = cA + (size_t)(t + 1) * kstep;
            const char* a2 = last ? nA : cA + (size_t)(t + 2) * kstep; const char* b2 = last ? nB : cB + (size_t)(t + 2) * kstep;
            const char* a3 = a2 + kstep; const char* b3 = b2 + kstep;
            PG8_LDB(B0, 0, 0); PG8_LDB(B1, 0, 1); PG8_SCHED; PG8_LDA(At, 0, 0); PG8_STAGE(PG8_SA(1, 1), a1 + hstepA, voffA);
            PG8_WAIT_V(8); PG8_WAIT_L(0); PG8_BAR; PG8_MMA(0, 0, At, B0); PG8_MMA(0, 1, At, B1); PG8_BAR; PG8_SCHED;
            PG8_LDA(At, 0, 1); PG8_STAGE(PG8_SB(0, 0), b2, voffB); PG8_STAGE(PG8_SB(0, 1), b2 + hstepB, voffB); PG8_STAGE(PG8_SA(0, 0), a2, voffA);
            PG8_WAIT_V(8); PG8_WAIT_L(0); PG8_BAR; PG8_MMA(1, 0, At, B0); PG8_MMA(1, 1, At, B1); PG8_BAR; PG8_SCHED;
            PG8_LDB(B0, 1, 0); PG8_LDB(B1, 1, 1); PG8_SCHED; PG8_LDA(At, 1, 0); PG8_STAGE(PG8_SA(0, 1), a2 + hstepA, voffA);
            PG8_WAIT_V(8); PG8_WAIT_L(0); PG8_BAR; PG8_MMA(0, 0, At, B0); PG8_MMA(0, 1, At, B1); PG8_BAR; PG8_SCHED;
            PG8_LDA(At, 1, 1); PG8_STAGE(PG8_SB(1, 0), b3, voffB); PG8_STAGE(PG8_SB(1, 1), b3 + hstepB, voffB); PG8_STAGE(PG8_SA(1, 0), a3, voffA);
            PG8_WAIT_V(8); PG8_WAIT_L(0); PG8_BAR; PG8_MMA(1, 0, At, B0); PG8_MMA(1, 1, At, B1); PG8_BAR; PG8_SCHED;
        }
        if (wr == 0) PG8_BAR;
        E(acc, cur, wr, wc, fr, fq);
        if (!has_next) break;
#pragma unroll
        for (int a = 0; a < 2; ++a)
#pragma unroll
            for (int b = 0; b < 2; ++b)
#pragma unroll
                for (int m = 0; m < 4; ++m)
#pragma unroll
                    for (int n = 0; n < 2; ++n) acc[a][b][m][n] = (f32x4){0.f, 0.f, 0.f, 0.f};
        cur = nxt; cA = nA; cB = nB; ++ui;
        if (wr == 1) PG8_BAR;
    }
    PG8_WAIT_V(0);
    PG8_BAR;
#undef PG8_SA
#undef PG8_SB
#undef PG8_STAGE
#undef PG8_LDA
#undef PG8_LDB
#undef PG8_MMA
#undef PG8_WAIT_V
#undef PG8_WAIT_L
#undef PG8_BAR
#undef PG8_SCHED
}
}

__device__ __forceinline__ void rope8(f32x4& v0, f32x4& v1, const float2* rt  ) {
    const float2 c0 = ldco2(rt), c1 = ldco2(rt + 1), c2 = ldco2(rt + 2), c3 = ldco2(rt + 3);
    float a, b;
    a = v0[0]; b = v0[1]; v0[0] = a * c0.x - b * c0.y; v0[1] = b * c0.x + a * c0.y;
    a = v0[2]; b = v0[3]; v0[2] = a * c1.x - b * c1.y; v0[3] = b * c1.x + a * c1.y;
    a = v1[0]; b = v1[1]; v1[0] = a * c2.x - b * c2.y; v1[1] = b * c2.x + a * c2.y;
    a = v1[2]; b = v1[3]; v1[2] = a * c3.x - b * c3.y; v1[3] = b * c3.x + a * c3.y;
}
__device__ __forceinline__ u32x4 pack8(const f32x4& v0, const f32x4& v1) {
    u32x4 w; w.x = cvt_pk_bf16(v0[0], v0[1]); w.y = cvt_pk_bf16(v0[2], v0[3]); w.z = cvt_pk_bf16(v1[0], v1[1]); w.w = cvt_pk_bf16(v1[2], v1[3]); return w;
}
__device__ __forceinline__ float sq8(const f32x4& a, const f32x4& b) {
    return (a[0] * a[0] + a[1] * a[1]) + (a[2] * a[2] + a[3] * a[3]) + (b[0] * b[0] + b[1] * b[1]) + (b[2] * b[2] + b[3] * b[3]);
}
template <int MODE> struct Epi {
    bf16_t* O; int ldc; const float* rs; float* sq0; float* sq1; bf16_t* KR; const float2* RT;
    __device__ __forceinline__ void operator()(const f32x4 (&acc)[2][2][4][2], const pg8::Unit& u, int wr, int wc, int fr, int fq) const {
#pragma unroll
        for (int ai = 0; ai < 2; ++ai)
#pragma unroll
            for (int m = 0; m < 4; ++m) {
                const int row = u.pm * 256 + ai * 128 + wr * 64 + m * 16 + fr;
                float sc = 1.f;
                if (MODE == 0 || MODE == 1 || MODE == 2 || MODE == 5) sc = ldco(rs + row);
                float ssum[2];
#pragma unroll
                for (int bj = 0; bj < 2; ++bj) {
                    const int col0 = u.pn * 256 + bj * 128 + wc * 32 + 8 * fq;
                    f32x4 v0 = acc[ai][bj][m][0] * sc, v1 = acc[ai][bj][m][1] * sc;
                    if (MODE == 3) {
#pragma unroll
                        for (int j = 0; j < 4; ++j) { v0[j] *= ldco(rs + col0 + j); v1[j] *= ldco(rs + col0 + 4 + j); }
                    }
                    if (MODE == 5) {
#pragma unroll
                        for (int j = 0; j < 4; ++j) { const float a = fmaxf(v0[j], 0.f), b = fmaxf(v1[j], 0.f); v0[j] = a * a; v1[j] = b * b; }
                    }
                    ssum[bj] = sq8(v0, v1);
                    *(u32x4*)(O + (size_t)row * ldc + col0) = pack8(v0, v1);
                }
                if (MODE == 0) {
                    if (u.pn == 0) { float s = ssum[0] + ssum[1]; s += __shfl_xor(s, 16); s += __shfl_xor(s, 32); if (fq == 0) sq0[row * 4 + wc] = s; }
                    else if (u.pn == 1) { float s = ssum[0]; s += __shfl_xor(s, 16); s += __shfl_xor(s, 32); if (fq == 0) sq1[row * 4 + wc] = s; }
                }
                if (MODE == 4 || MODE == 6) { float s = ssum[0] + ssum[1]; s += __shfl_xor(s, 16); s += __shfl_xor(s, 32); if (fq == 0) sq0[(size_t)row * 16 + u.pn * 4 + wc] = s; }
            }
    }
};

__device__ __forceinline__ int src_col(int mode, int n) {
    if (mode == 0) return n;
    if (mode == 1) { if (n >= 1984) return -1; if (n >= 384 && n < 448) { const int j = n - 384; return 384 + ((j & 1) ? 32 + (j >> 1) : (j >> 1)); } return n; }
    if (mode == 2) { const int h = n / 192, w = n % 192; if (w < 128) return n; const int j = w - 128; return h * 192 + 128 + ((j & 1) ? 32 + (j >> 1) : (j >> 1)); }
    if (mode == 3) return (n >> 7) * 256 + (n & 127);
    return (n >> 7) * 256 + 128 + (n & 127);
}
__device__ __forceinline__ void conv_weight(const float* W, const float* g, bf16_t* out, int K, int Nsrc, int Nout, int mode, int gtid, int gthreads) {
    const int nch = Nout * (K / 8);
    for (int e = gtid; e < nch; e += gthreads) {
        const int n = e % Nout, kc = e / Nout, k0 = kc * 8; const int sc = src_col(mode, n);
        float v[8];
#pragma unroll
        for (int j = 0; j < 8; ++j) v[j] = (sc >= 0) ? W[(size_t)(k0 + j) * Nsrc + sc] * (g ? g[k0 + j] : 1.f) : 0.f;
        u32x4 w; w.x = cvt_pk_bf16(v[0], v[1]); w.y = cvt_pk_bf16(v[2], v[3]); w.z = cvt_pk_bf16(v[4], v[5]); w.w = cvt_pk_bf16(v[6], v[7]);
        *(u32x4*)(out + (size_t)n * K + k0) = w;
    }
}

__device__ __forceinline__ void p0_prologue(const Params& p, LAS unsigned char* lds) {
    unsigned char* ws = launder(p.ws);
    const int tid = tid_l(), lane = tid & 63, wave = tid >> 6, G = gridDim.x;
    const int gtid = blockIdx.x * 512 + tid, gthreads = G * 512;
    const int gw = blockIdx.x * 8 + wave, NGW = G * 8;
#if SUB_MASK & 1
    conv_weight(p.in[4], p.in[3], (bf16_t*)(ws + OFF_WIN), 1024, 1984, 2048, 1, gtid, gthreads);
    conv_weight(p.in[6], p.in[5], (bf16_t*)(ws + OFF_WUQ), 256, 768, 768, 2, gtid, gthreads);
    conv_weight(p.in[8], p.in[7], (bf16_t*)(ws + OFF_WKN), 128, 1024, 512, 3, gtid, gthreads);
    conv_weight(p.in[8], p.in[7], (bf16_t*)(ws + OFF_WV), 128, 1024, 512, 4, gtid, gthreads);
    conv_weight(p.in[20], nullptr, (bf16_t*)(ws + OFF_WO), 1024, 1024, 1024, 0, gtid, gthreads);
    conv_weight(p.in[23], p.in[22], (bf16_t*)(ws + OFF_WF1), 1024, 4096, 4096, 0, gtid, gthreads);
    conv_weight(p.in[24], nullptr, (bf16_t*)(ws + OFF_WF2), 4096, 1024, 1024, 0, gtid, gthreads);
#endif
#if SUB_MASK & 2
#if DEBUG_CHECK
    if (blockIdx.x == 0 && tid < 64) ((unsigned*)(ws + OFF_DBGW))[tid] = 0u;
#endif
    {
        float2* RT = (float2*)(ws + OFF_RT);
        for (int e = gtid; e < LP * 32; e += gthreads) {
            const int pos = e >> 5, i = e & 31;
            const float inv = 1.0f / exp2f((float)i * (13.287712379549449f / 32.f));
            float s, c; sincos_red((float)pos * inv, s, c);
            RT[e] = make_float2(c, s);
        }
    }
#endif
#if SUB_MASK & 4
    {
        bf16_t* h0b = (bf16_t*)(ws + OFF_H0B); float* r0 = (float*)(ws + OFF_R0);
        for (int r = gw; r < TPAD; r += NGW) {
            u32x2* o = (u32x2*)(h0b + (size_t)r * 1024) + lane;
            if (r >= T) {
#pragma unroll
                for (int j = 0; j < 4; ++j) o[64 * j] = (u32x2){0u, 0u};
                if (lane == 0) __hip_atomic_store(r0 + r, 0.f, __ATOMIC_RELAXED, __HIP_MEMORY_SCOPE_AGENT);
                continue;
            }
            int pos, seq; row_info(r, pos, seq);
            const float* src = pos < 16 ? p.in[2] + (size_t)pos * 1024
                                        : (seq < NBP ? p.in[0] + ((size_t)seq * 8192 + (pos - 16)) * 1024 : p.in[1] + ((size_t)(seq - NBP) * 2048 + (pos - 16)) * 1024);
            const f32x4* xr = (const f32x4*)src + lane;
            f32x4 v[4]; float ss = 0.f;
#pragma unroll
            for (int j = 0; j < 4; ++j) { v[j] = xr[64 * j]; ss += (v[j][0] * v[j][0] + v[j][1] * v[j][1]) + (v[j][2] * v[j][2] + v[j][3] * v[j][3]); }
            ss = wave_sum(ss);
#pragma unroll
            for (int j = 0; j < 4; ++j) o[64 * j] = (u32x2){cvt_pk_bf16(v[j][0], v[j][1]), cvt_pk_bf16(v[j][2], v[j][3])};
            if (lane == 0) __hip_atomic_store(r0 + r, rsqrtf(ss * (1.f / 1024.f) + EPS), __ATOMIC_RELAXED, __HIP_MEMORY_SCOPE_AGENT);
        }
    }
#endif
#if SUB_MASK & 8
    {
        const float* f_w1 = p.in[10]; const float* f_b1 = p.in[11]; const float* f_freq = p.in[12]; const float* f_w2 = p.in[13];
        const float* f_b2 = p.in[14]; const float* f_w3 = p.in[15]; const float* f_decay = p.in[16];
        LAS float* feats = (LAS float*)lds;
        LAS float* h1 = feats + 16 * 34;
        LAS float* h2 = h1 + 16 * 64;
        for (int u = blockIdx.x; u < 513 + 129; u += G) {
            const int set = u < 513 ? 0 : 1; const int t0 = 16 * (set ? u - 513 : u); const int L = set ? LS : LP; const int C0 = set ? LGS : LGP;
            bf16_t* GR = (bf16_t*)(ws + (set ? OFF_GR1 : OFF_GR0));
            const float invLm1 = 1.0f / (float)(L - 1);
            if (tid < 256) {
                const int tt = tid >> 4, k = tid & 15; const int t = t0 + tt;
                const float w = (6.2831853071795865f * (float)t) / (float)L;
                const float f = 1e-4f + (float)k * ((15.0f - 1e-4f) / 15.0f);
                float s, c; sincos_red(f * w, s, c);
                feats[tt * 34 + 1 + k] = c; feats[tt * 34 + 17 + k] = -s;
                if (k == 0) feats[tt * 34] = (float)t * invLm1;
            }
            __syncthreads();
#pragma unroll 1
            for (int q = 0; q < 2; ++q) {
                const int o = tid + 512 * q, tt = o >> 6, j = o & 63;
                float a = f_b1[j];
#pragma unroll 3
                for (int e = 0; e < 33; ++e) a += feats[tt * 34 + e] * f_w1[e * 64 + j];
                h1[tt * 64 + j] = sin_red(f_freq[j] * a);
            }
            __syncthreads();
#pragma unroll 1
            for (int q = 0; q < 2; ++q) {
                const int o = tid + 512 * q, tt = o >> 6, j = o & 63;
                float a = f_b2[j];
#pragma unroll 4
                for (int e = 0; e < 64; ++e) a += h1[tt * 64 + e] * f_w2[e * 64 + j];
                h2[tt * 64 + j] = sin_red(f_freq[j] * a);
            }
            __syncthreads();
            {
                float a[4][16];
#pragma unroll
                for (int q = 0; q < 4; ++q)
#pragma unroll
                    for (int i = 0; i < 16; ++i) a[q][i] = 0.f;
#pragma unroll 2
                for (int j = 0; j < 64; ++j) {
                    float hv[16];
#pragma unroll
                    for (int i = 0; i < 16; ++i) hv[i] = h2[i * 64 + j];
#pragma unroll
                    for (int q = 0; q < 4; ++q) {
                        const float w = f_w3[j * 2048 + tid + 512 * q];
#pragma unroll
                        for (int i = 0; i < 16; ++i) a[q][i] += hv[i] * w;
                    }
                }
#pragma unroll
                for (int q = 0; q < 4; ++q) {
                    const int n = tid + 512 * q;
                    const float dec = fabsf(f_decay[n]);
                    const int order = n >> 10, dir = (n >> 9) & 1, c = n & 511;
                    bf16_t* row = GR + (size_t)(order * 512 + c) * (2 * C0);
#pragma unroll
                    for (int i = 0; i < 16; ++i) {
                        const int t = t0 + i;
                        const float val = a[q][i] * __expf(-((float)t * invLm1) * dec);
                        const unsigned short b = (unsigned short)(cvt_pk_bf16(val, 0.f) & 0xffffu);
                        if (dir == 0) row[C0 - t] = b; else if (t > 0) row[C0 + t] = b;
                    }
                }
            }
            __syncthreads();
        }
        for (int e = gtid; e < 2 * 1024 * 97; e += gthreads) {
            const int set = e / (1024 * 97), r = (e / 97) % 1024, i = e % 97; const int L = set ? LS : LP; const int C0 = set ? LGS : LGP;
            bf16_t* row = (bf16_t*)(ws + (set ? OFF_GR1 : OFF_GR0)) + (size_t)r * (2 * C0);
            const int idx = i < 49 ? i : C0 + L + (i - 49);
            row[idx] = 0;
        }
    }
#endif
}

__device__ __forceinline__ void rownorm_phase(const Params& p) {
    unsigned char* ws = launder(p.ws); const int gtid = blockIdx.x * 512 + tid_l(), gthreads = gridDim.x * 512;
    const float* sqq = (const float*)(ws + OFF_SQQP); const float* sqkv = (const float*)(ws + OFF_SQKVP);
    float* rq = (float*)(ws + OFF_RQ); float* rkv = (float*)(ws + OFF_RKV);
    for (int r = gtid; r < TPAD; r += gthreads) {
        const float a = (ldco(sqq + r * 4) + ldco(sqq + r * 4 + 1)) + (ldco(sqq + r * 4 + 2) + ldco(sqq + r * 4 + 3));
        const float b = (ldco(sqkv + r * 4) + ldco(sqkv + r * 4 + 1)) + (ldco(sqkv + r * 4 + 2) + ldco(sqkv + r * 4 + 3));
        rq[r] = rsqrtf(a * (1.f / 256.f) + EPS) * QSCALE; rkv[r] = rsqrtf(b * (1.f / 128.f) + EPS);
    }
}
__device__ __forceinline__ void krope_phase(const Params& p) {
    unsigned char* ws = launder(p.ws); unsigned char* ob = launder((unsigned char*)p.out);
    const int gtid = blockIdx.x * 512 + tid_l(), gthreads = gridDim.x * 512;
    const bf16_t* P = (const bf16_t*)(ws + OFF_P); bf16_t* KR = (bf16_t*)(ob + DO_KR); const float2* RT = (const float2*)(ws + OFF_RT);
    for (int e = gtid; e < TPAD * 8; e += gthreads) {
        const int row = e >> 3, ch = e & 7;
        int pos, seq; row_info(row, pos, seq);
        const u32x4 v = *(const u32x4*)(P + (size_t)row * NPP + 384 + ch * 8);
        f32x4 v0 = (f32x4){bflo(v.x), bfhi(v.x), bflo(v.y), bfhi(v.y)}, v1 = (f32x4){bflo(v.z), bfhi(v.z), bflo(v.w), bfhi(v.w)};
        rope8(v0, v1, RT + pos * 32 + ch * 4);
        *(u32x4*)(KR + (size_t)row * 64 + ch * 8) = pack8(v0, v1);
    }
}
__device__ __forceinline__ void hyprep_phase(const Params& p, LAS unsigned char* lds) {
    unsigned char* ws = launder(p.ws); const int tid = tid_l(), G = gridDim.x;
    const bf16_t* P = (const bf16_t*)(ws + OFF_P); const float* conv_w = p.in[9];
    constexpr int RSB = 1040;
    for (int u = blockIdx.x; u < 3096 + 3168; u += G) {
        int seq, j, which;
        if (u < 3096) { seq = u / 387; const int rem = u % 387; j = rem / 3; which = rem % 3; }
        else { const int v = u - 3096; seq = NBP + v / 99; const int rem = v % 99; j = rem / 3; which = rem % 3; }
        const int set = seq < NBP ? 0 : 1; const int L = set ? LS : LP; const int Lg = set ? LGS : LGP; const int NB = set ? NBS : NBP;
        const int b = set ? seq - NBP : seq; const int row0 = set ? TPR + b * LS : b * LP;
        const int posb = 64 * j - 49;
        for (int i = 0; i < 9; ++i) {
            const int id = tid + 512 * i; if (id >= 66 * 64) break;
            const int rr = id >> 6, ch = id & 63; const int pos = posb + rr;
            u32x4 v = (u32x4){0u, 0u, 0u, 0u};
            if (pos >= 0 && pos < L) v = *(const GAS u32x4*)(P + (size_t)(row0 + pos) * NPP + 448 + which * 512 + ch * 8);
            *(LAS u32x4*)(lds + rr * RSB + ch * 16) = v;
        }
        __syncthreads();
        {
            const int c = tid; const float w0 = conv_w[which * 512 + c], w1 = conv_w[1536 + which * 512 + c], w2 = conv_w[3072 + which * 512 + c];
            bf16_t* XT = (bf16_t*)(ws + (which == 0 ? OFF_X1T : (which == 1 ? OFF_X2T : OFF_V0T))) + (set ? XT_SET1 : 0) + ((size_t)c * NB + b) * Lg + 64 * j;
            const LAS unsigned short* tl = (const LAS unsigned short*)lds + c;
            float prev = bf2f(tl[0]), cur = bf2f(tl[RSB / 2]);
            for (int o8 = 0; o8 < 8; ++o8) {
                float r[8];
#pragma unroll
                for (int k = 0; k < 8; ++k) {
                    const int o = o8 * 8 + k; const float nxt = bf2f(tl[(o + 2) * (RSB / 2)]);
                    const int pos = posb + 1 + o;
                    r[k] = (pos >= 0 && pos < L) ? (prev * w0 + cur * w1 + nxt * w2) : 0.f;
                    prev = cur; cur = nxt;
                }
                u32x4 w; w.x = cvt_pk_bf16(r[0], r[1]); w.y = cvt_pk_bf16(r[2], r[3]); w.z = cvt_pk_bf16(r[4], r[5]); w.w = cvt_pk_bf16(r[6], r[7]);
                *(GAS u32x4*)(XT + o8 * 8) = w;
            }
        }
        __syncthreads();
    }
}

__device__ __forceinline__ f32x16 mfma32(bf16x8 a, bf16x8 b, f32x16 c) { return __builtin_amdgcn_mfma_f32_32x32x16_bf16(a, b, c, 0, 0, 0); }

__device__ __forceinline__ void attn_phase(const Params& p, LAS unsigned char* lds) {
    const int tid = tid_l(), lane = tid & 63, wave = tid >> 6, G = gridDim.x, h = lane >> 5, l32 = lane & 31;
    unsigned char* ob = launder((unsigned char*)p.out);
    bf16_t* Q = (bf16_t*)(ob + DO_Q);
    const bf16_t* KN = (const bf16_t*)(ob + DO_KN);
    const bf16_t* KR = (const bf16_t*)(ob + DO_KR);
    const bf16_t* VT = (const bf16_t*)(ob + DO_VT);
    constexpr int KROW = 400, VROW = 136, KBYTES = 64 * KROW, BUFB = KBYTES + 128 * VROW;
    const int vblk = (G % 8 == 0) ? (int)(blockIdx.x % 8) * (G / 8) + (int)(blockIdx.x / 8) : (int)blockIdx.x;
    for (int u = vblk; u < 2048; u += G) {
        int seq, head, qb;
        if (u < 1024) { seq = u >> 7; head = (u >> 5) & 3; qb = u & 31; } else { const int v = u - 1024; seq = NBP + (v >> 5); head = (v >> 3) & 3; qb = v & 7; }
        const int L = seq < NBP ? LP : LS; const int row0 = seq < NBP ? seq * LP : TPR + (seq - NBP) * LS;
        const int ntiles = (L + 63) >> 6;
        const int qrow = row0 + 16 + qb * 256 + wave * 32 + l32;
        bf16x8 qf[12];
#pragma unroll
        for (int ks = 0; ks < 12; ++ks) qf[ks] = *(const GAS bf16x8*)(Q + (size_t)qrow * 768 + head * 192 + 16 * ks + 8 * h);
        {
            const float2* RT = (const float2*)(launder(p.ws) + OFF_RT);
            const int qpos = 16 + qb * 256 + wave * 32 + l32;
#pragma unroll
            for (int ks = 8; ks < 12; ++ks) {
                const u32x4 v = __builtin_bit_cast(u32x4, qf[ks]);
                f32x4 v0 = (f32x4){bflo(v.x), bfhi(v.x), bflo(v.y), bfhi(v.y)}, v1 = (f32x4){bflo(v.z), bfhi(v.z), bflo(v.w), bfhi(v.w)};
                rope8(v0, v1, RT + qpos * 32 + 8 * (ks - 8) + 4 * h);
                qf[ks] = __builtin_bit_cast(bf16x8, pack8(v0, v1));
            }
        }
        const int kkey0 = tid >> 4, kch0 = tid & 15;
        const int rkey = tid >> 3, rch = tid & 7;
        const int vdv0 = tid >> 3, vch = tid & 7;
        const unsigned kn_off = (unsigned)(kkey0 * 512 + head * 128 + kch0 * 8) * 2u;
        const unsigned kr_off = (unsigned)(rkey * 64 + rch * 8) * 2u;
        const unsigned vt_off = (unsigned)(vdv0 * TPAD + vch * 8) * 2u;
        const unsigned char* knb = (const unsigned char*)KN + (size_t)row0 * 1024;
        const unsigned char* krb = (const unsigned char*)KR + (size_t)row0 * 128;
        const unsigned char* vtb = (const unsigned char*)VT + ((size_t)head * 128 * TPAD + row0) * 2;
        u32x4 g0, g1, g2, g3, g4;
#define ATT_LOAD(tile) do { const unsigned char* kb__ = knb + (size_t)(tile) * 65536; const unsigned char* rb__ = krb + (size_t)(tile) * 8192; const unsigned char* vb__ = vtb + (size_t)(tile) * 128; \
        g0 = *(const GAS u32x4*)(kb__ + kn_off); g1 = *(const GAS u32x4*)(kb__ + 32768 + kn_off); \
        g2 = *(const GAS u32x4*)(rb__ + kr_off); (void)vb__; } while (0)
#define ATT_LOADV(tile) do { const unsigned char* vb__ = vtb + (size_t)(tile) * 128; g3 = *(const GAS u32x4*)(vb__ + vt_off); g4 = *(const GAS u32x4*)(vb__ + (size_t)64 * TPAD * 2 + vt_off); } while (0)
#define ATT_STOREK(buf) do { LAS unsigned char* kb_ = lds + (buf) * BUFB; \
        *(LAS u32x4*)(kb_ + kkey0 * KROW + kch0 * 16) = g0; *(LAS u32x4*)(kb_ + (kkey0 + 32) * KROW + kch0 * 16) = g1; \
        *(LAS u32x4*)(kb_ + rkey * KROW + 256 + rch * 16) = g2; } while (0)
#define ATT_STORE(buf) do { LAS unsigned char* vb_ = lds + (buf) * BUFB + KBYTES; \
        *(LAS u32x2*)(vb_ + vdv0 * VROW + vch * 16) = (u32x2){g3.x, g3.y}; *(LAS u32x2*)(vb_ + vdv0 * VROW + vch * 16 + 8) = (u32x2){g3.z, g3.w}; \
        *(LAS u32x2*)(vb_ + (vdv0 + 64) * VROW + vch * 16) = (u32x2){g4.x, g4.y}; *(LAS u32x2*)(vb_ + (vdv0 + 64) * VROW + vch * 16 + 8) = (u32x2){g4.z, g4.w}; } while (0)
        ATT_LOAD(0); ATT_LOADV(0); ATT_STOREK(0); ATT_STORE(0);
        __syncthreads();
        f32x16 o[4];
#pragma unroll
        for (int d = 0; d < 4; ++d)
#pragma unroll
            for (int r = 0; r < 16; ++r) o[d][r] = 0.f;
        float m_run = -INFINITY, l_run = 0.f;
        for (int j = 0; j < ntiles; ++j) {
            const int buf = j & 1;
            if (j + 1 < ntiles) ATT_LOAD(j + 1);
            const LAS unsigned char* kb = lds + buf * BUFB;
            f32x16 s0, s1;
#pragma unroll
            for (int r = 0; r < 16; ++r) { s0[r] = 0.f; s1[r] = 0.f; }
            {
                bf16x8 kA[6], kB[6];
                const LAS unsigned char* kr0 = kb + l32 * KROW + h * 16; const LAS unsigned char* kr1 = kr0 + 32 * KROW;
#define ATT_LDK(dst, ksb) do { _Pragma("unroll") for (int i = 0; i < 3; ++i) { dst[2 * i] = *(const LAS bf16x8*)(kr0 + ((ksb) + i) * 32); dst[2 * i + 1] = *(const LAS bf16x8*)(kr1 + ((ksb) + i) * 32); } } while (0)
#define ATT_MMK(src, ksb) do { _Pragma("unroll") for (int i = 0; i < 3; ++i) { s0 = mfma32(src[2 * i], qf[(ksb) + i], s0); s1 = mfma32(src[2 * i + 1], qf[(ksb) + i], s1); } } while (0)
                ATT_LDK(kA, 0); __builtin_amdgcn_sched_barrier(0);
                ATT_MMK(kA, 0); __builtin_amdgcn_sched_barrier(0);
                ATT_LDK(kB, 3); __builtin_amdgcn_sched_barrier(0);
                ATT_MMK(kB, 3); __builtin_amdgcn_sched_barrier(0);
                ATT_LDK(kA, 6); __builtin_amdgcn_sched_barrier(0);
                ATT_MMK(kA, 6); __builtin_amdgcn_sched_barrier(0);
                ATT_LDK(kB, 9); __builtin_amdgcn_sched_barrier(0);
                ATT_MMK(kB, 9); __builtin_amdgcn_sched_barrier(0);
#undef ATT_LDK
#undef ATT_MMK
            }
            if (j + 1 < ntiles) ATT_STOREK(buf ^ 1);
            const int vc = L - j * 64;
            if (vc < 64) {
                const int vch = vc - 4 * h;
#pragma unroll
                for (int r = 0; r < 16; ++r) {
                    if ((r & 3) + 8 * (r >> 2) >= vch) s0[r] = -INFINITY;
                    if ((r & 3) + 8 * (r >> 2) + 32 >= vch) s1[r] = -INFINITY;
                }
            }
            float mx = fmaxf(s0[0], s1[0]);
#pragma unroll
            for (int r = 1; r < 16; ++r) mx = fmaxf(mx, fmaxf(s0[r], s1[r]));
            mx = fmaxf(mx, __shfl_xor(mx, 32));
            const float m_new = fmaxf(m_run, mx);
            const float alpha = __builtin_amdgcn_exp2f(m_run - m_new);
            m_run = m_new;
            float ls = 0.f;
#pragma unroll
            for (int r = 0; r < 16; ++r) { s0[r] = __builtin_amdgcn_exp2f(s0[r] - m_new); s1[r] = __builtin_amdgcn_exp2f(s1[r] - m_new); ls += s0[r] + s1[r]; }
            l_run = l_run * alpha + ls;
            if (__any(alpha != 1.0f)) {
#pragma unroll
                for (int d = 0; d < 4; ++d)
#pragma unroll
                    for (int r = 0; r < 16; ++r) o[d][r] *= alpha;
            }
            bf16x8 pb[4];
            {
                u32x4 w;
                w.x = cvt_pk_bf16(s0[0], s0[1]); w.y = cvt_pk_bf16(s0[2], s0[3]); w.z = cvt_pk_bf16(s0[4], s0[5]); w.w = cvt_pk_bf16(s0[6], s0[7]); pb[0] = __builtin_bit_cast(bf16x8, w);
                w.x = cvt_pk_bf16(s0[8], s0[9]); w.y = cvt_pk_bf16(s0[10], s0[11]); w.z = cvt_pk_bf16(s0[12], s0[13]); w.w = cvt_pk_bf16(s0[14], s0[15]); pb[1] = __builtin_bit_cast(bf16x8, w);
                w.x = cvt_pk_bf16(s1[0], s1[1]); w.y = cvt_pk_bf16(s1[2], s1[3]); w.z = cvt_pk_bf16(s1[4], s1[5]); w.w = cvt_pk_bf16(s1[6], s1[7]); pb[2] = __builtin_bit_cast(bf16x8, w);
                w.x = cvt_pk_bf16(s1[8], s1[9]); w.y = cvt_pk_bf16(s1[10], s1[11]); w.z = cvt_pk_bf16(s1[12], s1[13]); w.w = cvt_pk_bf16(s1[14], s1[15]); pb[3] = __builtin_bit_cast(bf16x8, w);
            }
            if (j + 1 < ntiles) ATT_LOADV(j + 1);
            const LAS unsigned char* vb = kb + KBYTES;
            {
                const LAS unsigned char* vrow = vb + l32 * VROW + 8 * h;
#pragma unroll
                for (int d = 0; d < 4; ++d) {
                    u32x4 vf[4];
#pragma unroll
                    for (int ks = 0; ks < 4; ++ks) {
                        const LAS unsigned char* ap = vrow + d * 32 * VROW + 32 * ks;
                        const u32x2 lo = *(const LAS u32x2*)ap, hi = *(const LAS u32x2*)(ap + 16);
                        vf[ks] = (u32x4){lo.x, lo.y, hi.x, hi.y};
                    }
                    __builtin_amdgcn_sched_barrier(0);
#pragma unroll
                    for (int ks = 0; ks < 4; ++ks) o[d] = mfma32(__builtin_bit_cast(bf16x8, vf[ks]), pb[ks], o[d]);
                    __builtin_amdgcn_sched_barrier(0);
                }
            }
            if (j + 1 < ntiles) ATT_STORE(buf ^ 1);
            __syncthreads();
        }
        l_run += __shfl_xor(l_run, 32);
        const float inv = 1.0f / l_run;
#if DEBUG_CHECK == 5
        bf16_t* orow = (bf16_t*)(launder(p.ws) + OFF_ODBG) + (size_t)qrow * 512 + head * 128;
#else
        bf16_t* orow = Q + (size_t)qrow * 768 + head * 192;
#endif
#pragma unroll
        for (int d = 0; d < 4; ++d)
#pragma unroll
            for (int rq = 0; rq < 4; ++rq) {
                const u32x2 w = (u32x2){cvt_pk_bf16(o[d][4 * rq] * inv, o[d][4 * rq + 1] * inv), cvt_pk_bf16(o[d][4 * rq + 2] * inv, o[d][4 * rq + 3] * inv)};
                *(GAS u32x2*)(orow + 32 * d + 8 * rq + 4 * h) = w;
            }
#undef ATT_LOAD
#undef ATT_LOADV
#undef ATT_STORE
#undef ATT_STOREK
    }
}

template <int SET> __device__ __forceinline__ void hyena_unit(const Params& p, LAS unsigned char* lds, int c, int bg) {
    constexpr int P = SET ? 32 : 128;
    constexpr int NBU = SET ? 16 : 4;
    constexpr int NBT = SET ? 8 : 2;
    constexpr int GP = SET ? 4 : 16;
    constexpr int LG = SET ? LGS : LGP;
    constexpr int NB = SET ? NBS : NBP;
    constexpr int RS = SET ? 4896 : 18816;
    constexpr int GBYTES = 2 * LG * 2;
    constexpr int G1OFF = 33220;
    constexpr int ZOFF = 66560;
    unsigned char* ws = launder(p.ws);
    const int tid = tid_l(), lane = tid & 63, wave = tid >> 6, h = lane >> 5, l32 = lane & 31;
    const bf16_t* X1T = (const bf16_t*)(ws + OFF_X1T) + (SET ? XT_SET1 : 0);
    bf16_t* X2T = (bf16_t*)(ws + OFF_X2T) + (SET ? XT_SET1 : 0);
    const bf16_t* V0T = (const bf16_t*)(ws + OFF_V0T) + (SET ? XT_SET1 : 0);
    const bf16_t* GR = (const bf16_t*)(ws + (SET ? OFF_GR1 : OFF_GR0));
    const float* hy_bias = launder(p.in[17]);
    LAS unsigned char* gL = lds; LAS unsigned char* zL = lds + ZOFF;
    const size_t rowbase = ((size_t)c * NB + bg * NBU) * LG;
    for (int id = tid; id < NBU * (P + 1) * 8; id += 512) {
        const int bl = id / ((P + 1) * 8), rem = id % ((P + 1) * 8), blk = rem >> 3, ch = rem & 7;
        *(LAS u32x4*)(zL + bl * RS + blk * 144 + ch * 16) = *(const GAS u32x4*)(V0T + rowbase + (size_t)bl * LG + blk * 64 + ch * 8);
    }
    for (int id = tid; id < NBU * 9; id += 512) { const int bl = id / 9, ch = id % 9; *(LAS u32x4*)(zL + bl * RS + (P + 1) * 144 + ch * 16) = (u32x4){0u, 0u, 0u, 0u}; }
#define HY_LOADG(rowidx) do { const unsigned* g32_ = (const unsigned*)(GR + (size_t)(rowidx) * (2 * LG)); \
        for (int id = tid; id < GBYTES / 4; id += 512) { const unsigned a_ = g32_[id], b_ = (id + 1 < GBYTES / 4) ? g32_[id + 1] : 0u; \
            *(LAS unsigned*)(gL + id * 4) = a_; *(LAS unsigned*)(gL + G1OFF + id * 4) = (a_ >> 16) | (b_ << 16); } } while (0)
    HY_LOADG(c);
    __syncthreads();
    const LAS unsigned short* g16 = (const LAS unsigned short*)gL;
    constexpr int PARTS = 512 / (NBU * 16);
    float zmeta = 0.f; int mo_bl, mo_m;
    {
        const int part = tid % PARTS, out = tid / PARTS; mo_bl = out >> 4; mo_m = out & 15;
        const LAS unsigned char* zr = zL + mo_bl * RS;
        float a = 0.f;
        const LAS unsigned char* gm = gL + (mo_m & 1) * G1OFF;
        for (int ci = part; ci < (LG - 48) / 8; ci += PARTS) {
            const int tt0 = 48 + 8 * ci;
            const u32x4 zv = *(const LAS u32x4*)(zr + (tt0 >> 6) * 144 + (tt0 & 63) * 2);
            const LAS unsigned* gp = (const LAS unsigned*)(gm + ((LG - mo_m - 48 + tt0) >> 1) * 4);
            const unsigned g0 = gp[0], g1 = gp[1], g2 = gp[2], g3 = gp[3];
            a += (bflo(zv.x) * bflo(g0) + bfhi(zv.x) * bfhi(g0)) + (bflo(zv.y) * bflo(g1) + bfhi(zv.y) * bfhi(g1))
               + (bflo(zv.z) * bflo(g2) + bfhi(zv.z) * bfhi(g2)) + (bflo(zv.w) * bflo(g3) + bfhi(zv.w) * bfhi(g3));
        }
#pragma unroll
        for (int o = 1; o < PARTS; o <<= 1) a += __shfl_xor(a, o);
        const float bias0 = hy_bias[c];
        const float z0 = bf2f(*(const LAS unsigned short*)(zr + (48 + mo_m) * 2));
        const float x1 = bf2f(X1T[rowbase + (size_t)mo_bl * LG + 48 + mo_m]);
        zmeta = x1 * (a + z0 * bias0);
    }
    const int p0 = GP * wave;
    const int pp = l32 / NBT, blA = l32 % NBT, blB = NBT + blA;
#pragma unroll 1
    for (int order = 0; order < 2; ++order) {
        f32x16 acc[2][2];
#pragma unroll
        for (int a = 0; a < 2; ++a)
#pragma unroll
            for (int b = 0; b < 2; ++b)
#pragma unroll
                for (int r = 0; r < 16; ++r) acc[a][b][r] = 0.f;
        bf16x8 Ep4, Ep5;
        {
            const int d0 = p0 - (P - 1); const int ib0 = LG - 64 * d0 - l32 + 8 * h;
            const LAS unsigned char* g0 = gL + (l32 & 1) * G1OFF + (ib0 >> 1) * 4;
            const LAS unsigned* ga = (const LAS unsigned*)(g0 + 96); const LAS unsigned* gb = (const LAS unsigned*)(g0 + 64);
            Ep4 = __builtin_bit_cast(bf16x8, (u32x4){ga[0], ga[1], ga[2], ga[3]}); Ep5 = __builtin_bit_cast(bf16x8, (u32x4){gb[0], gb[1], gb[2], gb[3]});
        }
#define HY_LOAD(dd, Bv, Ev) do { \
            const int ib_ = LG - 64 * (dd) - l32 + 8 * h; \
            const LAS unsigned char* gpl_ = gL + (l32 & 1) * G1OFF + (ib_ >> 1) * 4; \
            _Pragma("unroll") for (int e = 2; e < 6; ++e) { const LAS unsigned* gp_ = (const LAS unsigned*)(gpl_ - 32 * (e - 3)); \
                Ev[e - 2] = __builtin_bit_cast(bf16x8, (u32x4){gp_[0], gp_[1], gp_[2], gp_[3]}); } \
            const int q_ = p0 + pp - (dd); const int slot_ = ((unsigned)(q_ + 1) <= (unsigned)P) ? q_ + 1 : P + 1; \
            const LAS unsigned char* zA_ = zL + blA * RS + slot_ * 144 + h * 16; const LAS unsigned char* zB_ = zL + blB * RS + slot_ * 144 + h * 16; \
            _Pragma("unroll") for (int ks = 0; ks < 4; ++ks) { Bv[0][ks] = *(const LAS bf16x8*)(zA_ + ks * 32); Bv[1][ks] = *(const LAS bf16x8*)(zB_ + ks * 32); } } while (0)
#define HY_MMA(Bv, Ev) do { \
            _Pragma("unroll") for (int ks = 0; ks < 4; ++ks) { \
                const bf16x8 a0_ = (ks == 0) ? Ev[1] : (ks == 1) ? Ev[0] : (ks == 2) ? Ep5 : Ep4; \
                const bf16x8 a1_ = (ks == 0) ? Ev[3] : (ks == 1) ? Ev[2] : (ks == 2) ? Ev[1] : Ev[0]; \
                acc[0][0] = mfma32(a0_, Bv[0][ks], acc[0][0]); acc[1][0] = mfma32(a0_, Bv[1][ks], acc[1][0]); \
                acc[0][1] = mfma32(a1_, Bv[0][ks], acc[0][1]); acc[1][1] = mfma32(a1_, Bv[1][ks], acc[1][1]); } \
            Ep4 = Ev[2]; Ep5 = Ev[3]; } while (0)
        {
            bf16x8 BA[2][4], BB[2][4], EA[4], EB[4];
            const int dlo = p0 - (P - 1), dhi = p0 + GP;
            HY_LOAD(dlo, BA, EA);
#pragma unroll 1
            for (int d = dlo; d <= dhi; d += 2) {
                HY_LOAD(d + 1, BB, EB);
                HY_MMA(BA, EA);
                if (d + 2 <= dhi) HY_LOAD(d + 2, BA, EA);
                HY_MMA(BB, EB);
            }
        }
#undef HY_LOAD
#undef HY_MMA
        __syncthreads();
        const float bias = hy_bias[order * 512 + c];
#pragma unroll
        for (int tl = 0; tl < 2; ++tl) {
            const int bl = tl ? blB : blA;
            const size_t grow = rowbase + (size_t)bl * LG + 64 * (p0 + pp + 1);
            LAS unsigned char* zr = zL + bl * RS + (p0 + pp + 1) * 144;
#pragma unroll
            for (int m = 0; m < 2; ++m)
#pragma unroll
                for (int rq = 0; rq < 4; ++rq) {
                    const int off = 32 * m + 8 * rq + 4 * h;
                    const u32x2 zw = *(const LAS u32x2*)(zr + off * 2);
                    const u32x2 xw = *(const GAS u32x2*)((order ? (const bf16_t*)X2T : X1T) + grow + off);
                    const float y0 = acc[tl][m][4 * rq], y1 = acc[tl][m][4 * rq + 1], y2 = acc[tl][m][4 * rq + 2], y3 = acc[tl][m][4 * rq + 3];
                    const float r0 = bflo(xw.x) * (y0 + bflo(zw.x) * bias), r1 = bfhi(xw.x) * (y1 + bfhi(zw.x) * bias);
                    const float r2 = bflo(xw.y) * (y2 + bflo(zw.y) * bias), r3 = bfhi(xw.y) * (y3 + bfhi(zw.y) * bias);
                    const u32x2 w = (u32x2){cvt_pk_bf16(r0, r1), cvt_pk_bf16(r2, r3)};
#if DEBUG_CHECK == 5
                    if (order == 0) *(LAS u32x2*)(zr + off * 2) = w; else *(GAS u32x2*)((bf16_t*)(ws + OFF_HDBG) + (SET ? XT_SET1 : 0) + grow + off) = w;
#else
                    if (order == 0) *(LAS u32x2*)(zr + off * 2) = w; else *(GAS u32x2*)(X2T + grow + off) = w;
#endif
                }
        }
        if (order == 0) {
            if ((tid % PARTS) == 0) *(LAS unsigned short*)(zL + mo_bl * RS + (48 + mo_m) * 2) = (unsigned short)(cvt_pk_bf16(zmeta, 0.f) & 0xffffu);
            HY_LOADG(512 + c);
        }
        __syncthreads();
    }
}
#undef HY_LOADG
__device__ __forceinline__ void hyena_phase(const Params& p, LAS unsigned char* lds) {
    for (int u = blockIdx.x; u < 2048; u += gridDim.x) {
        if (u < 1024) hyena_unit<0>(p, lds, u >> 1, u & 1); else hyena_unit<1>(p, lds, (u - 1024) >> 1, u & 1);
    }
}

__device__ __forceinline__ void mixnorm_phase(const Params& p, LAS unsigned char* lds) {
    unsigned char* ws = launder(p.ws); const int tid = tid_l(), lane = tid & 63, wave = tid >> 6, G = gridDim.x;
    const bf16_t* Q = (const bf16_t*)(launder((unsigned char*)p.out) + DO_Q);
    bf16_t* MIXN = (bf16_t*)(ws + OFF_MIXN);
    const float* ga = launder(p.in[18]); const float* gh = launder(p.in[19]);
    constexpr int RSB = 1040;
    for (int u = blockIdx.x; u < 2048; u += G) {
        const int n0 = u * 64;
        int set, b, tok0;
        if (n0 < 65536) { set = 0; b = n0 >> 13; tok0 = n0 & 8191; } else { set = 1; const int q = n0 - 65536; b = q >> 11; tok0 = q & 2047; }
        const int Lg = set ? LGS : LGP, NB = set ? NBS : NBP;
        {
            const int c = tid;
#if DEBUG_CHECK == 5
            const bf16_t* src = (const bf16_t*)(ws + OFF_HDBG) + (set ? XT_SET1 : 0) + ((size_t)c * NB + b) * Lg + tok0 + 64;
#else
            const bf16_t* src = (const bf16_t*)(ws + OFF_X2T) + (set ? XT_SET1 : 0) + ((size_t)c * NB + b) * Lg + tok0 + 64;
#endif
            LAS unsigned short* tl = (LAS unsigned short*)lds + c;
#pragma unroll
            for (int k8 = 0; k8 < 8; ++k8) {
                const u32x4 v = *(const GAS u32x4*)(src + k8 * 8);
                tl[(k8 * 8 + 0) * (RSB / 2)] = (unsigned short)(v.x & 0xffffu); tl[(k8 * 8 + 1) * (RSB / 2)] = (unsigned short)(v.x >> 16);
                tl[(k8 * 8 + 2) * (RSB / 2)] = (unsigned short)(v.y & 0xffffu); tl[(k8 * 8 + 3) * (RSB / 2)] = (unsigned short)(v.y >> 16);
                tl[(k8 * 8 + 4) * (RSB / 2)] = (unsigned short)(v.z & 0xffffu); tl[(k8 * 8 + 5) * (RSB / 2)] = (unsigned short)(v.z >> 16);
                tl[(k8 * 8 + 6) * (RSB / 2)] = (unsigned short)(v.w & 0xffffu); tl[(k8 * 8 + 7) * (RSB / 2)] = (unsigned short)(v.w >> 16);
            }
        }
        __syncthreads();
        for (int i = 0; i < 8; ++i) {
            const int rr = wave + 8 * i; const int n = n0 + rr; const int r = full_row(n);
            const u32x4 hv = *(const LAS u32x4*)(lds + rr * RSB + lane * 16);
#if DEBUG_CHECK == 5
            const u32x4 av = *(const GAS u32x4*)((const bf16_t*)(ws + OFF_ODBG) + (size_t)r * 512 + lane * 8);
#else
            const u32x4 av = *(const GAS u32x4*)(Q + (size_t)r * 768 + (lane >> 4) * 192 + (lane & 15) * 8);
#endif
            float hf[8] = {bflo(hv.x), bfhi(hv.x), bflo(hv.y), bfhi(hv.y), bflo(hv.z), bfhi(hv.z), bflo(hv.w), bfhi(hv.w)};
            float af[8] = {bflo(av.x), bfhi(av.x), bflo(av.y), bfhi(av.y), bflo(av.z), bfhi(av.z), bflo(av.w), bfhi(av.w)};
            float sh = 0.f, sa = 0.f;
#pragma unroll
            for (int k = 0; k < 8; ++k) { sh += hf[k] * hf[k]; sa += af[k] * af[k]; }
            sh = wave_sum(sh); sa = wave_sum(sa);
            const float rh = rsqrtf(sh * (1.f / 512.f) + EPS), ra = rsqrtf(sa * (1.f / 512.f) + EPS);
            const f32x4 ga0 = *(const GAS f32x4*)(ga + lane * 8), ga1 = *(const GAS f32x4*)(ga + lane * 8 + 4);
            const f32x4 gh0 = *(const GAS f32x4*)(gh + lane * 8), gh1 = *(const GAS f32x4*)(gh + lane * 8 + 4);
            u32x4 wa, wh;
            wa.x = cvt_pk_bf16(af[0] * ra * ga0[0], af[1] * ra * ga0[1]); wa.y = cvt_pk_bf16(af[2] * ra * ga0[2], af[3] * ra * ga0[3]);
            wa.z = cvt_pk_bf16(af[4] * ra * ga1[0], af[5] * ra * ga1[1]); wa.w = cvt_pk_bf16(af[6] * ra * ga1[2], af[7] * ra * ga1[3]);
            wh.x = cvt_pk_bf16(hf[0] * rh * gh0[0], hf[1] * rh * gh0[1]); wh.y = cvt_pk_bf16(hf[2] * rh * gh0[2], hf[3] * rh * gh0[3]);
            wh.z = cvt_pk_bf16(hf[4] * rh * gh1[0], hf[5] * rh * gh1[1]); wh.w = cvt_pk_bf16(hf[6] * rh * gh1[2], hf[7] * rh * gh1[3]);
#if EXPT == 1
            wa = (u32x4){0u, 0u, 0u, 0u};
#endif
#if EXPT == 2
            wh = (u32x4){0u, 0u, 0u, 0u};
#endif
            *(GAS u32x4*)(MIXN + (size_t)n * 1024 + lane * 8) = wa;
            *(GAS u32x4*)(MIXN + (size_t)n * 1024 + 512 + lane * 8) = wh;
        }
        __syncthreads();
    }
}

__device__ __forceinline__ void h1_phase(const Params& p) {
    unsigned char* ws = launder(p.ws); const int tid = tid_l(), lane = tid & 63, wave = tid >> 6;
    const int gw = blockIdx.x * 8 + wave, NGW = gridDim.x * 8;
    const bf16_t* MIX = (const bf16_t*)(ws + OFF_MIX); bf16_t* H1B = (bf16_t*)(ws + OFF_H1B);
    const float* sqmix = (const float*)(ws + OFF_SQMIXP); float* r1 = (float*)(ws + OFF_R1); const float* g = p.in[21];
    for (int n = gw; n < TN; n += NGW) {
        const float* xrow = n < 65536 ? p.in[0] + (size_t)n * 1024 : p.in[1] + (size_t)(n - 65536) * 1024;
        const float rm = rsqrtf(wave_sum(lane < 16 ? ldco(sqmix + (size_t)n * 16 + lane) : 0.f) * (1.f / 1024.f) + EPS);
        float ss = 0.f;
#pragma unroll
        for (int hh = 0; hh < 2; ++hh) {
            const int c0 = hh * 512 + lane * 8;
            const u32x4 mv = *(const u32x4*)(MIX + (size_t)n * 1024 + c0);
            const f32x4 x0 = *(const f32x4*)(xrow + c0), x1 = *(const f32x4*)(xrow + c0 + 4);
            const f32x4 g0 = *(const f32x4*)(g + c0), g1 = *(const f32x4*)(g + c0 + 4);
            f32x4 h0, h1;
            h0[0] = x0[0] + bflo(mv.x) * rm * g0[0]; h0[1] = x0[1] + bfhi(mv.x) * rm * g0[1]; h0[2] = x0[2] + bflo(mv.y) * rm * g0[2]; h0[3] = x0[3] + bfhi(mv.y) * rm * g0[3];
            h1[0] = x1[0] + bflo(mv.z) * rm * g1[0]; h1[1] = x1[1] + bfhi(mv.z) * rm * g1[1]; h1[2] = x1[2] + bflo(mv.w) * rm * g1[2]; h1[3] = x1[3] + bfhi(mv.w) * rm * g1[3];
            ss += sq8(h0, h1);
            *(u32x4*)(H1B + (size_t)n * 1024 + c0) = pack8(h0, h1);
        }
        ss = wave_sum(ss);
        if (lane == 0) r1[n] = rsqrtf(ss * (1.f / 1024.f) + EPS);
    }
}
__device__ __forceinline__ void final_phase(const Params& p, int half) {
    unsigned char* ws = launder(p.ws); const int tid = tid_l(), lane = tid & 63, wave = tid >> 6;
    const int gw = blockIdx.x * 8 + wave, NGW = gridDim.x * 8;
    const bf16_t* M2 = (const bf16_t*)(ws + OFF_M2); const float* sqm2 = (const float*)(ws + OFF_SQM2P); const float* g = p.in[25];
    float dbg_off = 0.f, dbg_one = 0.f;
#if DEBUG_CHECK
    { const unsigned* dc = (const unsigned*)(ws + OFF_DBGW); dbg_off = 100.f * (float)dc[8] * (1.f / 131072.f); dbg_one = 1000.f * (float)dc[9] * (1.f / 131072.f); }
#endif
    for (int i = gw; i < 65536; i += NGW) {
        const int n = half * 65536 + i;
        const float rm = rsqrtf(wave_sum(lane < 16 ? ldco(sqm2 + (size_t)n * 16 + lane) : 0.f) * (1.f / 1024.f) + EPS);
#pragma unroll
        for (int hh = 0; hh < 2; ++hh) {
            const int c0 = hh * 512 + lane * 8;
            const u32x4 mv = *(const u32x4*)(M2 + (size_t)i * 1024 + c0);
            const u32x4 hv = *(const u32x4*)((const bf16_t*)(ws + OFF_H1B) + (size_t)n * 1024 + c0);
            f32x4 h0 = (f32x4){bflo(hv.x), bfhi(hv.x), bflo(hv.y), bfhi(hv.y)}, h1 = (f32x4){bflo(hv.z), bfhi(hv.z), bflo(hv.w), bfhi(hv.w)};
            const f32x4 g0 = *(const f32x4*)(g + c0), g1 = *(const f32x4*)(g + c0 + 4);
            h0 += dbg_off; h1 += dbg_off; if (n == 0 && c0 == 0) h0[0] += dbg_one;
            h0[0] += bflo(mv.x) * rm * g0[0]; h0[1] += bfhi(mv.x) * rm * g0[1]; h0[2] += bflo(mv.y) * rm * g0[2]; h0[3] += bfhi(mv.y) * rm * g0[3];
            h1[0] += bflo(mv.z) * rm * g1[0]; h1[1] += bfhi(mv.z) * rm * g1[1]; h1[2] += bflo(mv.w) * rm * g1[2]; h1[3] += bfhi(mv.w) * rm * g1[3];
            *(f32x4*)(p.out + (size_t)n * 1024 + c0) = h0; *(f32x4*)(p.out + (size_t)n * 1024 + c0 + 4) = h1;
        }
    }
}


#if DEBUG_CHECK
constexpr size_t OFF_DBG = OFF_DBGW;
__device__ __forceinline__ void check_gemm(const bf16_t* A, int lda, const bf16_t* Bt, int ldb, int K, int M, int N, int mode, const bf16_t* O, int ldc, const float* rs, unsigned* cnt, int col_lo) {
    const unsigned idx = blockIdx.x * 512u + (unsigned)tid_l();
    unsigned hsh = idx * 2654435761u + 12345u + (unsigned)mode * 977u; hsh ^= hsh >> 15; hsh *= 2246822519u; hsh ^= hsh >> 13;
    const int row = (int)(hsh % (unsigned)M); hsh = hsh * 3266489917u + 668265263u; hsh ^= hsh >> 16;
    const int col = col_lo + (int)(hsh % (unsigned)(N - col_lo));
    float d = 0.f;
    for (int k = 0; k < K; ++k) d += bf2f(A[(size_t)row * lda + k]) * bf2f(Bt[(size_t)col * ldb + k]);
    float e = d;
    if (mode == 0 || mode == 7) e = d * rs[row];
    if (mode == 5) { const float t = fmaxf(d * rs[row], 0.f); e = t * t; }
    const float st = bf2f(O[(size_t)row * ldc + col]);
    if (!(fabsf(st - e) <= 0.03f * fabsf(e) + 0.03f)) atomicAdd(cnt, 1u);
}
#endif

#if DEBUG_CHECK == 2
__device__ __forceinline__ void check_proj(const Params& p) {
    unsigned char* ws = launder(p.ws); unsigned char* ob = launder((unsigned char*)p.out);
    const bf16_t* P = (const bf16_t*)(ws + OFF_P); unsigned* cnt = (unsigned*)(ws + OFF_DBG);
    const unsigned idx = blockIdx.x * 512u + (unsigned)tid_l();
    unsigned hsh = idx * 2654435761u + 777u; hsh ^= hsh >> 15; hsh *= 2246822519u; hsh ^= hsh >> 13;
    const int row = (int)(hsh % (unsigned)T); hsh = hsh * 3266489917u + 668265263u; hsh ^= hsh >> 16;
    int pos, seq; row_info(row, pos, seq);
    {
        const int n = (int)(hsh % 768u); const int hh = n / 192, w = n % 192;
        float ss = 0.f, x1 = 0.f, x2 = 0.f; const float* W = p.in[6]; const float* g = p.in[5];
        const int j = w - 128, i = j >> 1;
        const int c1 = w < 128 ? hh * 192 + w : hh * 192 + 128 + i, c2 = hh * 192 + 160 + (w < 128 ? 0 : i);
        for (int k = 0; k < 256; ++k) { const float a = bf2f(P[(size_t)row * NPP + k]); ss += a * a; x1 += a * g[k] * W[k * 768 + c1]; x2 += a * g[k] * W[k * 768 + c2]; }
        const float rq = rsqrtf(ss * (1.f / 256.f) + EPS) * QSCALE; x1 *= rq; x2 *= rq;
        float e = x1;
        if (w >= 128) { const float inv = 1.0f / exp2f((float)i * (13.287712379549449f / 32.f)); float sn, cs; sincos_red((float)pos * inv, sn, cs); e = (j & 1) ? x2 * cs + x1 * sn : x1 * cs - x2 * sn; }
        const float st = bf2f(((const bf16_t*)(ob + DO_Q))[(size_t)row * 768 + n]);
        if (!(fabsf(st - e) <= 0.03f * fabsf(e) + 0.01f)) atomicAdd(cnt + (w < 128 ? 0 : 4), 1u);
    }
    {
        const int n = (int)((hsh >> 3) % 512u); const int hh = n >> 7, i = n & 127;
        float ss = 0.f, x1 = 0.f, x2 = 0.f; const float* W = p.in[8]; const float* g = p.in[7];
        for (int k = 0; k < 128; ++k) { const float a = bf2f(P[(size_t)row * NPP + 256 + k]); ss += a * a; x1 += a * g[k] * W[k * 1024 + hh * 256 + i]; x2 += a * g[k] * W[k * 1024 + hh * 256 + 128 + i]; }
        const float rk = rsqrtf(ss * (1.f / 128.f) + EPS); x1 *= rk; x2 *= rk;
        const float s1 = bf2f(((const bf16_t*)(ob + DO_KN))[(size_t)row * 512 + n]);
        const float s2 = bf2f(((const bf16_t*)(ob + DO_VT))[(size_t)n * TPAD + row]);
        if (!(fabsf(s1 - x1) <= 0.03f * fabsf(x1) + 0.03f)) atomicAdd(cnt + 1, 1u);
        if (!(fabsf(s2 - x2) <= 0.03f * fabsf(x2) + 0.03f)) atomicAdd(cnt + 2, 1u);
    }
    {
        const int jj = (int)((hsh >> 5) % 64u); const int i = jj >> 1;
        const float* xr = pos < 16 ? p.in[2] + (size_t)pos * 1024 : (seq < NBP ? p.in[0] + ((size_t)seq * 8192 + (pos - 16)) * 1024 : p.in[1] + ((size_t)(seq - NBP) * 2048 + (pos - 16)) * 1024);
        const float* W = p.in[4]; const float* g = p.in[3]; float x1 = 0.f, x2 = 0.f;
        for (int k = 0; k < 1024; ++k) { const float a = xr[k] * g[k]; x1 += a * W[(size_t)k * 1984 + 384 + i]; x2 += a * W[(size_t)k * 1984 + 416 + i]; }
        const float r0 = ((const float*)(ws + OFF_R0))[row]; x1 *= r0; x2 *= r0;
        const float inv = 1.0f / exp2f((float)i * (13.287712379549449f / 32.f)); float sn, cs; sincos_red((float)pos * inv, sn, cs);
        const float e = (jj & 1) ? x2 * cs + x1 * sn : x1 * cs - x2 * sn;
        const float st = bf2f(((const bf16_t*)(ob + DO_KR))[(size_t)row * 64 + jj]);
        if (!(fabsf(st - e) <= 0.03f * fabsf(e) + 0.03f)) { atomicAdd(cnt + 3, 1u); atomicAdd(cnt + 5, (unsigned)i); atomicAdd(cnt + 6, (unsigned)(pos >> 3)); }
    }
}
#endif

#if DEBUG_CHECK == 3
__device__ __forceinline__ void check_h0b(const Params& p, int slot) {
    unsigned char* ws = launder(p.ws); unsigned* cnt = (unsigned*)(ws + OFF_DBGW);
    const bf16_t* h0b = (const bf16_t*)(ws + OFF_H0B);
    const unsigned idx = blockIdx.x * 512u + (unsigned)tid_l();
    unsigned hsh = idx * 2654435761u + 4242u + (unsigned)slot * 31u; hsh ^= hsh >> 15; hsh *= 2246822519u; hsh ^= hsh >> 13;
    const int row = (int)(hsh % (unsigned)T); hsh = hsh * 3266489917u + 668265263u; hsh ^= hsh >> 16;
    const int col = (int)(hsh % 1024u);
    int pos, seq; row_info(row, pos, seq);
    const float* xr = pos < 16 ? p.in[2] + (size_t)pos * 1024 : (seq < NBP ? p.in[0] + ((size_t)seq * 8192 + (pos - 16)) * 1024 : p.in[1] + ((size_t)(seq - NBP) * 2048 + (pos - 16)) * 1024);
    const float e = xr[col]; const float st = bf2f(h0b[(size_t)row * 1024 + col]);
    if (!(fabsf(st - e) <= 0.01f * fabsf(e) + 0.001f)) atomicAdd(cnt + slot, 1u);
}
#endif

#if DEBUG_CHECK == 4
__device__ __forceinline__ void check_stale(const Params& p, const unsigned* base, unsigned ndw, int slot) {
    unsigned* cnt = (unsigned*)(launder(p.ws) + OFF_DBGW);
    const unsigned idx = blockIdx.x * 512u + (unsigned)tid_l();
    unsigned hsh = idx * 2654435761u + 999u + (unsigned)slot * 131u; hsh ^= hsh >> 15; hsh *= 2246822519u; hsh ^= hsh >> 13;
#pragma unroll 1
    for (int it = 0; it < 16; ++it) {
        hsh = hsh * 3266489917u + 668265263u; hsh ^= hsh >> 16;
        const unsigned i = hsh % ndw;
        const unsigned a = base[i];
        const unsigned b = __hip_atomic_load(base + i, __ATOMIC_RELAXED, __HIP_MEMORY_SCOPE_AGENT);
        if (a != b) atomicAdd(cnt + slot, 1u);
    }
}
#endif

#if DEBUG_CHECK == 5
__device__ __forceinline__ void check_attn(const Params& p) {
    unsigned char* ws = launder(p.ws); unsigned char* ob = launder((unsigned char*)p.out); unsigned* cnt = (unsigned*)(ws + OFF_DBGW);
    const int tid = tid_l(), lane = tid & 63, wave = tid >> 6;
    const bf16_t* Q = (const bf16_t*)(ob + DO_Q); const bf16_t* KN = (const bf16_t*)(ob + DO_KN); const bf16_t* KR = (const bf16_t*)(ob + DO_KR); const bf16_t* VT = (const bf16_t*)(ob + DO_VT);
    const bf16_t* OD = (const bf16_t*)(ws + OFF_ODBG); const float2* RT = (const float2*)(ws + OFF_RT);
    unsigned hsh = (unsigned)(blockIdx.x * 8 + wave) * 2654435761u + 31337u; hsh ^= hsh >> 15; hsh *= 2246822519u; hsh ^= hsh >> 13;
    const int n = (int)(hsh % (unsigned)TN); const int head = (int)((hsh >> 20) & 3u); const int r = full_row(n);
    int pos, seq; row_info(r, pos, seq);
    const int L = seq < NBP ? LP : LS; const int row0 = r - pos;
    const bf16_t* qp = Q + (size_t)r * 768 + head * 192;
    float mx = -INFINITY;
    for (int k = lane; k < L; k += 64) {
        float sdot = 0.f;
        for (int d = 0; d < 128; ++d) sdot += bf2f(qp[d]) * bf2f(KN[(size_t)(row0 + k) * 512 + head * 128 + d]);
        for (int i = 0; i < 32; ++i) { const float2 cs = ldco2(RT + pos * 32 + i); const float a = bf2f(qp[128 + 2 * i]), b = bf2f(qp[129 + 2 * i]);
            sdot += (a * cs.x - b * cs.y) * bf2f(KR[(size_t)(row0 + k) * 64 + 2 * i]) + (b * cs.x + a * cs.y) * bf2f(KR[(size_t)(row0 + k) * 64 + 2 * i + 1]); }
        mx = fmaxf(mx, sdot);
    }
#pragma unroll
    for (int o = 1; o < 64; o <<= 1) mx = fmaxf(mx, __shfl_xor(mx, o));
    float sw = 0.f, o0 = 0.f, o1 = 0.f; const int dv0 = (int)((hsh >> 8) & 127u), dv1 = (dv0 + 37) & 127;
    for (int k = lane; k < L; k += 64) {
        float sdot = 0.f;
        for (int d = 0; d < 128; ++d) sdot += bf2f(qp[d]) * bf2f(KN[(size_t)(row0 + k) * 512 + head * 128 + d]);
        for (int i = 0; i < 32; ++i) { const float2 cs = ldco2(RT + pos * 32 + i); const float a = bf2f(qp[128 + 2 * i]), b = bf2f(qp[129 + 2 * i]);
            sdot += (a * cs.x - b * cs.y) * bf2f(KR[(size_t)(row0 + k) * 64 + 2 * i]) + (b * cs.x + a * cs.y) * bf2f(KR[(size_t)(row0 + k) * 64 + 2 * i + 1]); }
        const float w = exp2f(sdot - mx); sw += w;
        o0 += w * bf2f(VT[(size_t)(head * 128 + dv0) * TPAD + row0 + k]); o1 += w * bf2f(VT[(size_t)(head * 128 + dv1) * TPAD + row0 + k]);
    }
    sw = wave_sum(sw); o0 = wave_sum(o0) / sw; o1 = wave_sum(o1) / sw;
    if (lane == 0) {
        const float s0 = bf2f(OD[(size_t)r * 512 + head * 128 + dv0]), s1 = bf2f(OD[(size_t)r * 512 + head * 128 + dv1]);
        atomicAdd(cnt + 10, 2u);
        if (!(fabsf(s0 - o0) <= 0.05f * fabsf(o0) + 0.002f)) atomicAdd(cnt + 8, 1u);
        if (!(fabsf(s1 - o1) <= 0.05f * fabsf(o1) + 0.002f)) atomicAdd(cnt + 8, 1u);
    }
}
__device__ __forceinline__ void check_hyena(const Params& p, LAS unsigned char* lds) {
    unsigned char* ws = launder(p.ws); unsigned* cnt = (unsigned*)(ws + OFF_DBGW);
    const int tid = tid_l();
    unsigned hsh = (unsigned)blockIdx.x * 2654435761u + 555u; hsh ^= hsh >> 15; hsh *= 2246822519u; hsh ^= hsh >> 13;
    const int set = (int)(blockIdx.x & 1u); const int c = (int)(hsh % 512u); const int NB = set ? NBS : NBP; const int b = (int)((hsh >> 12) % (unsigned)NB);
    const int LG = set ? LGS : LGP;
    const size_t base = (set ? XT_SET1 : 0) + ((size_t)c * NB + b) * LG;
    const bf16_t* X1 = (const bf16_t*)(ws + OFF_X1T) + base; const bf16_t* X2 = (const bf16_t*)(ws + OFF_X2T) + base; const bf16_t* V0 = (const bf16_t*)(ws + OFF_V0T) + base;
    const bf16_t* HD = (const bf16_t*)(ws + OFF_HDBG) + base;
    const bf16_t* G0 = (const bf16_t*)(ws + (set ? OFF_GR1 : OFF_GR0)) + (size_t)c * (2 * LG); const bf16_t* G1 = G0 + (size_t)512 * (2 * LG);
    const float bias0 = p.in[17][c], bias1 = p.in[17][512 + c];
    LAS float* z1 = (LAS float*)lds;
    for (int t = tid; t < LG; t += 512) {
        float y = 0.f;
        for (int s2 = 48; s2 < LG; ++s2) y += bf2f(G0[LG - (t - s2)]) * bf2f(V0[s2]);
        const float v = bf2f(X1[t]) * (y + bf2f(V0[t]) * bias0);
        z1[t] = (t >= 48) ? bf2f((unsigned short)(cvt_pk_bf16(v, 0.f) & 0xffffu)) : 0.f;
    }
    __syncthreads();
    {
        unsigned h2 = hsh * 3266489917u + (unsigned)tid * 2246822519u; h2 ^= h2 >> 15; h2 *= 2654435761u; h2 ^= h2 >> 13;
        const int t = 64 + (int)(h2 % (unsigned)(LG - 64));
        float y = 0.f;
        for (int s2 = 48; s2 < LG; ++s2) y += bf2f(G1[LG - (t - s2)]) * z1[s2];
        const float e = bf2f(X2[t]) * (y + z1[t] * bias1);
        const float st = bf2f(HD[t]);
        atomicAdd(cnt + 11, 1u);
        if (!(fabsf(st - e) <= 0.05f * fabsf(e) + 1.0f)) atomicAdd(cnt + 9, 1u);
    }
    __syncthreads();
}
#endif

#if DEBUG_CHECK == 7
__device__ __forceinline__ void check_h0b_full(const Params& p, int slot) {
    unsigned char* ws = launder(p.ws); unsigned* cnt = (unsigned*)(ws + OFF_DBGW);
    const bf16_t* h0b = (const bf16_t*)(ws + OFF_H0B);
    const int tid = tid_l(), lane = tid & 63, wave = tid >> 6;
    for (int row = blockIdx.x * 8 + wave; row < T; row += gridDim.x * 8) {
        int pos, seq; row_info(row, pos, seq);
        const float* xr = pos < 16 ? p.in[2] + (size_t)pos * 1024 : (seq < NBP ? p.in[0] + ((size_t)seq * 8192 + (pos - 16)) * 1024 : p.in[1] + ((size_t)(seq - NBP) * 2048 + (pos - 16)) * 1024);
        int bad = 0;
        for (int c = lane; c < 1024; c += 64) { const float e = xr[c]; const float st = bf2f(h0b[(size_t)row * 1024 + c]); if (!(fabsf(st - e) <= 0.01f * fabsf(e) + 0.001f)) bad = 1; }
        bad = __any(bad);
        if (lane == 0 && bad) atomicAdd(cnt + slot, 1u);
    }
}
#endif

#if DEBUG_CHECK == 8
__device__ __forceinline__ void check_p_golden(const Params& p) {
    unsigned char* ws = launder(p.ws); unsigned* cnt = (unsigned*)(ws + OFF_DBGW);
    const bf16_t* P = (const bf16_t*)(ws + OFF_P);
    const unsigned idx = blockIdx.x * 512u + (unsigned)tid_l();
    unsigned hsh = idx * 2654435761u + 8888u; hsh ^= hsh >> 15; hsh *= 2246822519u; hsh ^= hsh >> 13;
    const int row = (int)(hsh % (unsigned)T); hsh = hsh * 3266489917u + 668265263u; hsh ^= hsh >> 16;
    int pos, seq; row_info(row, pos, seq);
    const float* xr = pos < 16 ? p.in[2] + (size_t)pos * 1024 : (seq < NBP ? p.in[0] + ((size_t)seq * 8192 + (pos - 16)) * 1024 : p.in[1] + ((size_t)(seq - NBP) * 2048 + (pos - 16)) * 1024);
    const float* W = p.in[4]; const float* g = p.in[3];
    const int colA = 448 + (int)(hsh % 1536u), colB = (int)((hsh >> 7) % 384u);
    float ss = 0.f, a = 0.f, b = 0.f;
    for (int k = 0; k < 1024; ++k) { const float x = xr[k]; ss += x * x; a += x * g[k] * W[(size_t)k * 1984 + colA]; b += x * g[k] * W[(size_t)k * 1984 + colB]; }
    const float r0 = rsqrtf(ss * (1.f / 1024.f) + EPS); a *= r0; b *= r0;
    const float sa = bf2f(P[(size_t)row * NPP + colA]), sb = bf2f(P[(size_t)row * NPP + colB]);
    if (!(fabsf(sa - a) <= 0.03f * fabsf(a) + 0.03f)) atomicAdd(cnt + 8, 1u);
    if (!(fabsf(sb - b) <= 0.03f * fabsf(b) + 0.03f)) atomicAdd(cnt + 9, 1u);
}
#endif

#if DEBUG_CHECK == 9
__device__ __forceinline__ void check_win_r0(const Params& p) {
    unsigned char* ws = launder(p.ws); unsigned* cnt = (unsigned*)(ws + OFF_DBGW);
    const bf16_t* WT = (const bf16_t*)(ws + OFF_WIN); const float* W = p.in[4]; const float* g = p.in[3]; const float* R0 = (const float*)(ws + OFF_R0);
    const int tid = tid_l(), lane = tid & 63, wave = tid >> 6;
    const int gtid = blockIdx.x * 512 + tid, gthreads = gridDim.x * 512;
    for (int e = gtid; e < 1984 * 1024; e += gthreads) {
        const int n = e >> 10, k = e & 1023; const int sc = src_col(1, n);
        const float ex = W[(size_t)k * 1984 + sc] * g[k]; const float st = bf2f(WT[(size_t)n * 1024 + k]);
        if (!(fabsf(st - ex) <= 0.01f * fabsf(ex) + 1e-5f)) atomicAdd(cnt + 8, 1u);
    }
    for (int row = blockIdx.x * 8 + wave; row < T; row += gridDim.x * 8) {
        int pos, seq; row_info(row, pos, seq);
        const float* xr = pos < 16 ? p.in[2] + (size_t)pos * 1024 : (seq < NBP ? p.in[0] + ((size_t)seq * 8192 + (pos - 16)) * 1024 : p.in[1] + ((size_t)(seq - NBP) * 2048 + (pos - 16)) * 1024);
        float ss = 0.f;
        for (int c = lane; c < 1024; c += 64) ss += xr[c] * xr[c];
        ss = wave_sum(ss);
        const float ex = rsqrtf(ss * (1.f / 1024.f) + EPS); const float st = R0[row];
        if (lane == 0 && !(fabsf(st - ex) <= 0.001f * ex)) { atomicAdd(cnt + 9, 1u); atomicAdd(cnt + 12, (unsigned)(row >> 6)); }
    }
}
#endif

#if DEBUG_CHECK == 10
__device__ __forceinline__ void check_x(const Params& p, int mode) {
    unsigned char* ws = launder(p.ws); unsigned* cnt = (unsigned*)(ws + OFF_DBGW); unsigned* sums = (unsigned*)(ws + OFF_DBGW + MiB);
    const int tid = tid_l(), lane = tid & 63, wave = tid >> 6;
    for (int n = blockIdx.x * 8 + wave; n < TN; n += gridDim.x * 8) {
        const unsigned* xr = (const unsigned*)(n < 65536 ? p.in[0] + (size_t)n * 1024 : p.in[1] + (size_t)(n - 65536) * 1024);
        unsigned a = 0u;
        for (int c = lane; c < 1024; c += 64) a += xr[c] * (2u * (unsigned)c + 1u);
#pragma unroll
        for (int o = 1; o < 64; o <<= 1) a += __shfl_xor(a, o);
        if (lane == 0) {
            if (mode == 0) __hip_atomic_store(sums + n, a, __ATOMIC_RELAXED, __HIP_MEMORY_SCOPE_AGENT);
            else if (__hip_atomic_load(sums + n, __ATOMIC_RELAXED, __HIP_MEMORY_SCOPE_AGENT) != a) atomicAdd(cnt + 8, 1u);
        }
    }
}
#endif

#if DEBUG_CHECK == 11
__device__ __forceinline__ void check_filt_prep(const Params& p) {
    unsigned char* ws = launder(p.ws); unsigned* cnt = (unsigned*)(ws + OFF_DBGW);
    const unsigned idx = blockIdx.x * 512u + (unsigned)tid_l();
    unsigned hsh = idx * 2654435761u + 1111u; hsh ^= hsh >> 15; hsh *= 2246822519u; hsh ^= hsh >> 13;
    {
        const int set = (int)(hsh & 1u); const int L = set ? LS : LP; const int C0 = set ? LGS : LGP;
        const int n = (int)((hsh >> 1) % 2048u); hsh = hsh * 3266489917u + 668265263u; hsh ^= hsh >> 16;
        const int t = (int)(hsh % (unsigned)L);
        const float* f_w1 = p.in[10]; const float* f_b1 = p.in[11]; const float* f_freq = p.in[12]; const float* f_w2 = p.in[13];
        const float* f_b2 = p.in[14]; const float* f_w3 = p.in[15]; const float* f_decay = p.in[16];
        const float tn = (float)t / (float)(L - 1); const float w = (6.2831853071795865f * (float)t) / (float)L;
        float acc = 0.f;
        for (int j2 = 0; j2 < 64; ++j2) {
            float a2 = f_b2[j2];
            for (int j1 = 0; j1 < 64; ++j1) {
                float a1 = f_b1[j1] + tn * f_w1[j1];
                for (int k = 0; k < 16; ++k) { const float f = 1e-4f + (float)k * ((15.0f - 1e-4f) / 15.0f); float sn, cs; sincos_red(f * w, sn, cs);
                    a1 += cs * f_w1[(1 + k) * 64 + j1] - sn * f_w1[(17 + k) * 64 + j1]; }
                a2 += sin_red(f_freq[j1] * a1) * f_w2[j1 * 64 + j2];
            }
            acc += sin_red(f_freq[j2] * a2) * f_w3[j2 * 2048 + n];
        }
        const float e = acc * __expf(-tn * fabsf(f_decay[n]));
        const int order = n >> 10, dir = (n >> 9) & 1, c = n & 511;
        if (!(dir == 1 && t == 0)) {
            const bf16_t* row = (const bf16_t*)(ws + (set ? OFF_GR1 : OFF_GR0)) + (size_t)(order * 512 + c) * (2 * C0);
            const float st = bf2f(row[dir ? C0 + t : C0 - t]);
            if (!(fabsf(st - e) <= 0.02f * fabsf(e) + 0.003f)) atomicAdd(cnt + 8, 1u);
        }
    }
    {
        const int seq = (int)(hsh % 40u); const int set = seq < NBP ? 0 : 1; const int L = set ? LS : LP; const int Lg = set ? LGS : LGP; const int NB = set ? NBS : NBP;
        const int b = set ? seq - NBP : seq; const int row0 = set ? TPR + b * LS : b * LP;
        hsh = hsh * 3266489917u + 668265263u; hsh ^= hsh >> 16;
        const int pos = (int)(hsh % (unsigned)L); const int which = (int)((hsh >> 16) % 3u); const int c = (int)((hsh >> 20) % 512u);
        const bf16_t* P = (const bf16_t*)(ws + OFF_P); const float* cw = p.in[9]; const int col = 448 + which * 512 + c;
        const float um = pos > 0 ? bf2f(P[(size_t)(row0 + pos - 1) * NPP + col]) : 0.f, u0 = bf2f(P[(size_t)(row0 + pos) * NPP + col]), up = pos + 1 < L ? bf2f(P[(size_t)(row0 + pos + 1) * NPP + col]) : 0.f;
        const float e = um * cw[which * 512 + c] + u0 * cw[1536 + which * 512 + c] + up * cw[3072 + which * 512 + c];
        const bf16_t* XT = (const bf16_t*)(ws + (which == 0 ? OFF_X1T : (which == 1 ? OFF_X2T : OFF_V0T))) + (set ? XT_SET1 : 0) + ((size_t)c * NB + b) * Lg;
        const float st = bf2f(XT[pos + 48]);
        if (!(fabsf(st - e) <= 0.02f * fabsf(e) + 0.02f)) atomicAdd(cnt + 9, 1u);
    }
}
#endif
#ifndef SUB_MASK
#define SUB_MASK 15
#endif
#ifndef PHASE_MASK
#define PHASE_MASK 1023
#endif
__global__ void __launch_bounds__(512) hymba_fwd(Params p) {
    extern __shared__ __attribute__((aligned(16))) unsigned char lds_raw[];
    LAS unsigned char* lds = (LAS unsigned char*)lds_raw;
    cg::grid_group grid = cg::this_grid();
#define GSYNC() do { asm volatile("s_waitcnt vmcnt(0) lgkmcnt(0)" ::: "memory"); grid.sync(); } while (0)
    const int G = gridDim.x;
    __builtin_amdgcn_fence(__ATOMIC_SEQ_CST, "agent");
    asm volatile("buffer_inv sc1\n\ts_waitcnt vmcnt(0)" ::: "memory");
#if DEBUG_CHECK == 10
    check_x(p, 0);
#endif
#if PHASE_MASK & 1
    p0_prologue(p, lds);
#endif
    GSYNC();
#if DEBUG_CHECK == 3
    check_h0b(p, 8);
#endif
#if DEBUG_CHECK == 7
    check_h0b_full(p, 8);
#endif
#if DEBUG_CHECK == 4
    check_stale(p, (const unsigned*)(launder(p.ws) + OFF_H0B), (unsigned)((size_t)T * 512), 9);
#endif
#if PHASE_MASK & 2
    {
        unsigned char* ws = launder(p.ws); unsigned char* ob = launder((unsigned char*)p.out);
        pg8::Gemm g{(const bf16_t*)(ws + OFF_H0B), (const bf16_t*)(ws + OFF_WIN), TPAD, 2048, 1024, 1024, 1024};
        pg8::StaticOrder S; S.init(TPAD, 2048, G, blockIdx.x);
        Epi<0> E{(bf16_t*)(ws + OFF_P), NPP, (const float*)(ws + OFF_R0), (float*)(ws + OFF_SQQP), (float*)(ws + OFF_SQKVP), (bf16_t*)(ob + DO_KR), (const float2*)(ws + OFF_RT)};
        pg8::gemm_phase(lds, g, S, E);
    }
#endif
    GSYNC();
#if DEBUG_CHECK == 1
    { unsigned char* ws = launder(p.ws); check_gemm((const bf16_t*)(ws + OFF_H0B), 1024, (const bf16_t*)(ws + OFF_WIN), 1024, 1024, T, 1984, 0, (const bf16_t*)(ws + OFF_P), NPP, (const float*)(ws + OFF_R0), (unsigned*)(ws + OFF_DBG) + 0, 448); }
    GSYNC();
#endif
#if DEBUG_CHECK == 3
    check_h0b(p, 9);
#endif
#if DEBUG_CHECK == 8
    check_p_golden(p);
#endif
#if DEBUG_CHECK == 9
    check_win_r0(p);
#endif
#if DEBUG_CHECK == 7
    check_h0b_full(p, 9);
    GSYNC();
#endif
#if DEBUG_CHECK == 6
    { unsigned char* ws = launder(p.ws);
      check_gemm((const bf16_t*)(ws + OFF_H0B), 1024, (const bf16_t*)(ws + OFF_WIN), 1024, 1024, T, 448, 0, (const bf16_t*)(ws + OFF_P), NPP, (const float*)(ws + OFF_R0), (unsigned*)(ws + OFF_DBG) + 8, 384);
      check_gemm((const bf16_t*)(ws + OFF_H0B), 1024, (const bf16_t*)(ws + OFF_WIN), 1024, 1024, T, 384, 7, (const bf16_t*)(ws + OFF_P), NPP, (const float*)(ws + OFF_R0), (unsigned*)(ws + OFF_DBG) + 9, 0); }
    GSYNC();
#endif
#if DEBUG_CHECK == 4
    check_stale(p, (const unsigned*)(launder(p.ws) + OFF_P), (unsigned)((size_t)T * 1024), 8);
#endif
    rownorm_phase(p);
    krope_phase(p);
    GSYNC();
#if (PHASE_MASK & 4) && (SUB2 & 1)
    {
        unsigned char* ws = launder(p.ws); unsigned char* ob = launder((unsigned char*)p.out);
        pg8::Gemm g{(const bf16_t*)(ws + OFF_P), (const bf16_t*)(ws + OFF_WUQ), TPAD, 768, 256, NPP, 256};
        pg8::StaticOrder S; S.init(TPAD, 768, G, blockIdx.x);
        Epi<1> E{(bf16_t*)(ob + DO_Q), 768, (const float*)(ws + OFF_RQ), nullptr, nullptr, nullptr, (const float2*)(ws + OFF_RT)};
        pg8::gemm_phase(lds, g, S, E);
    }
#endif
#if (PHASE_MASK & 4) && (SUB2 & 2)
    {
        unsigned char* ws = launder(p.ws); unsigned char* ob = launder((unsigned char*)p.out);
        pg8::Gemm g{(const bf16_t*)(ws + OFF_P) + 256, (const bf16_t*)(ws + OFF_WKN), TPAD, 512, 128, NPP, 128};
        pg8::StaticOrder S; S.init(TPAD, 512, G, blockIdx.x);
        Epi<2> E{(bf16_t*)(ob + DO_KN), 512, (const float*)(ws + OFF_RKV), nullptr, nullptr, nullptr, nullptr};
        pg8::gemm_phase(lds, g, S, E);
    }
#endif
#if (PHASE_MASK & 4) && (SUB2 & 4)
    {
        unsigned char* ws = launder(p.ws); unsigned char* ob = launder((unsigned char*)p.out);
        pg8::Gemm g{(const bf16_t*)(ws + OFF_WV), (const bf16_t*)(ws + OFF_P) + 256, 512, TPAD, 128, 128, NPP};
        pg8::StaticOrder S; S.init(512, TPAD, G, blockIdx.x);
        Epi<3> E{(bf16_t*)(ob + DO_VT), TPAD, (const float*)(ws + OFF_RKV), nullptr, nullptr, nullptr, nullptr};
        pg8::gemm_phase(lds, g, S, E);
    }
#endif
#if PHASE_MASK & 8
    hyprep_phase(p, lds);
#endif
    GSYNC();
#if DEBUG_CHECK == 2
    check_proj(p);
    GSYNC();
#endif
#if DEBUG_CHECK == 11
    check_filt_prep(p);
    GSYNC();
#endif
#if PHASE_MASK & 16
    attn_phase(p, lds);
#endif
#if PHASE_MASK & 32
    hyena_phase(p, lds);
#endif
    GSYNC();
#if DEBUG_CHECK == 5
    check_attn(p);
    check_hyena(p, lds);
    GSYNC();
#endif
#if PHASE_MASK & 64
    mixnorm_phase(p, lds);
#endif
    GSYNC();
#if PHASE_MASK & 128
    {
        unsigned char* ws = launder(p.ws);
        pg8::Gemm g{(const bf16_t*)(ws + OFF_MIXN), (const bf16_t*)(ws + OFF_WO), TN, 1024, 1024, 1024, 1024};
        pg8::StaticOrder S; S.init(TN, 1024, G, blockIdx.x);
        Epi<4> E{(bf16_t*)(ws + OFF_MIX), 1024, nullptr, (float*)(ws + OFF_SQMIXP), nullptr, nullptr, nullptr};
        pg8::gemm_phase(lds, g, S, E);
    }
#endif
    GSYNC();
#if DEBUG_CHECK == 1
    { unsigned char* ws = launder(p.ws); check_gemm((const bf16_t*)(ws + OFF_MIXN), 1024, (const bf16_t*)(ws + OFF_WO), 1024, 1024, TN, 1024, 4, (const bf16_t*)(ws + OFF_MIX), 1024, nullptr, (unsigned*)(ws + OFF_DBG) + 1, 0); }
#endif
#if DEBUG_CHECK == 10
    check_x(p, 1);
#endif
#if PHASE_MASK & 256
    h1_phase(p);
#endif
    GSYNC();
#if PHASE_MASK & 512
#if DEBUG_CHECK == 1
#define DBG_FF1(half) if ((half) == 0) { unsigned char* ws = launder(p.ws); check_gemm((const bf16_t*)(ws + OFF_H1B), 1024, (const bf16_t*)(ws + OFF_WF1), 1024, 1024, 65536, 4096, 5, (const bf16_t*)(ws + OFF_M), 4096, (const float*)(ws + OFF_R1), (unsigned*)(ws + OFF_DBG) + 2, 0); }
#define DBG_FF2(half) if ((half) == 0) { unsigned char* ws = launder(p.ws); check_gemm((const bf16_t*)(ws + OFF_M), 4096, (const bf16_t*)(ws + OFF_WF2), 4096, 4096, 65536, 1024, 6, (const bf16_t*)(ws + OFF_M2), 1024, nullptr, (unsigned*)(ws + OFF_DBG) + 3, 0); } GSYNC();
#else
#define DBG_FF1(half)
#define DBG_FF2(half)
#endif
#define FFN_HALF(half) \
    { \
        unsigned char* ws = launder(p.ws); \
        pg8::Gemm g{(const bf16_t*)(ws + OFF_H1B) + (size_t)(half) * 65536 * 1024, (const bf16_t*)(ws + OFF_WF1), 65536, 4096, 1024, 1024, 1024}; \
        pg8::StaticOrder S; S.init(65536, 4096, G, blockIdx.x); \
        Epi<5> E{(bf16_t*)(ws + OFF_M), 4096, (const float*)(ws + OFF_R1) + (half) * 65536, nullptr, nullptr, nullptr, nullptr}; \
        pg8::gemm_phase(lds, g, S, E); \
    } \
    GSYNC(); \
    DBG_FF1(half) \
    { \
        unsigned char* ws = launder(p.ws); \
        pg8::Gemm g{(const bf16_t*)(ws + OFF_M), (const bf16_t*)(ws + OFF_WF2), 65536, 1024, 4096, 4096, 4096}; \
        pg8::StaticOrder S; S.init(65536, 1024, G, blockIdx.x); \
        Epi<6> E{(bf16_t*)(ws + OFF_M2), 1024, nullptr, (float*)(ws + OFF_SQM2P) + (size_t)(half) * 65536 * 16, nullptr, nullptr, nullptr}; \
        pg8::gemm_phase(lds, g, S, E); \
    } \
    GSYNC(); \
    DBG_FF2(half) \
    final_phase(p, half);
    FFN_HALF(0)
    FFN_HALF(1)
#undef FFN_HALF
#endif
}

extern "C" void kernel_launch(void* const* d_in, const int* in_sizes, int n_in, void* d_out, int out_size, void* d_ws, size_t ws_size, hipStream_t stream) {
    static int grid = 0;
    if (grid == 0) {
        int dev = 0, cus = 0, per_cu = 0;
        hipGetDevice(&dev);
        hipDeviceGetAttribute(&cus, hipDeviceAttributeMultiprocessorCount, dev);
        hipFuncSetAttribute((const void*)hymba_fwd, hipFuncAttributeMaxDynamicSharedMemorySize, LDS_BYTES);
        hipOccupancyMaxActiveBlocksPerMultiprocessor(&per_cu, (const void*)hymba_fwd, 512, LDS_BYTES);
        if (per_cu < 1) per_cu = 1;
        grid = cus * 1;
        if (n_in != 26 || ws_size < 1024 * MiB) fprintf(stderr, "kernel_launch: unexpected n_in %d / ws_size %zu\n", n_in, ws_size);
    }
    Params p{};
    for (int i = 0; i < 26; ++i) p.in[i] = (const float*)d_in[i];
    p.out = (float*)d_out; p.ws = (unsigned char*)d_ws;
    void* args[] = {&p};
    hipError_t e = hipLaunchCooperativeKernel((const void*)hymba_fwd, dim3(grid), dim3(512), args, LDS_BYTES, stream);
    if (e != hipSuccess) fprintf(stderr, "cooperative launch failed: %s (grid %d)\n", hipGetErrorString(e), grid);
}
```

```cpp
#include <hip/hip_runtime.h>
#include <hip/hip_cooperative_groups.h>
#include <cstdio>
#include <cstdint>
namespace cg = cooperative_groups;
#ifndef DBG_SEL0
#define DBG_SEL0 3
#endif
#ifndef DBG_SEL1
#define DBG_SEL1 0
#endif
#ifndef DEBUG_CHECK
#define DEBUG_CHECK 0
#endif
#ifndef EXPT
#define EXPT 0
#endif
#ifndef SUB_MASK
#define SUB_MASK 15
#endif
#ifndef SUB2
#define SUB2 7
#endif

#define LAS __attribute__((address_space(3)))
#define GAS __attribute__((address_space(1)))
typedef unsigned short bf16_t;
typedef short bf16x8 __attribute__((ext_vector_type(8)));
typedef float f32x4 __attribute__((ext_vector_type(4)));
typedef float f32x16 __attribute__((ext_vector_type(16)));
typedef unsigned u32x4 __attribute__((ext_vector_type(4)));
typedef unsigned u32x2 __attribute__((ext_vector_type(2)));

constexpr int DM = 1024, LP = 8208, LS = 2064, NBP = 8, NBS = 32;
constexpr int TPR = NBP * LP;
constexpr int TSR = NBS * LS;
constexpr int T = TPR + TSR;
constexpr int TPAD = 131840;
constexpr int TN = 131072;
constexpr int NPP = 2048;
constexpr int LGP = 8256, LGS = 2112;
constexpr float EPS = 1e-6f;
constexpr float QSCALE = 0.07216878364870322f * 1.4426950408889634f;

constexpr size_t MiB = 1ull << 20;
constexpr size_t OFF_H0B = 0;
constexpr size_t XT_SET1 = (size_t)512 * NBP * LGP;
constexpr size_t OFF_X1T = 0;
constexpr size_t OFF_X2T = 131 * MiB;
constexpr size_t OFF_P = 262 * MiB;
constexpr size_t OFF_V0T = 778 * MiB;
constexpr size_t OFF_MIXN = 262 * MiB;
constexpr size_t OFF_MIX = 518 * MiB;
constexpr size_t OFF_H1B = 0;
constexpr size_t OFF_M = 256 * MiB;
constexpr size_t OFF_M2 = 768 * MiB;
constexpr size_t OFF_SQMIXP = 896 * MiB;
constexpr size_t OFF_SQM2P = 904 * MiB;
constexpr size_t OFF_SMALL = 912 * MiB;
constexpr size_t OFF_WIN = OFF_SMALL;
constexpr size_t OFF_WUQ = OFF_SMALL + 4 * MiB;
constexpr size_t OFF_WKN = OFF_SMALL + 4 * MiB + 512 * 1024;
constexpr size_t OFF_WV = OFF_SMALL + 4 * MiB + 768 * 1024;
constexpr size_t OFF_WO = OFF_SMALL + 5 * MiB;
constexpr size_t OFF_WF1 = OFF_SMALL + 7 * MiB;
constexpr size_t OFF_WF2 = OFF_SMALL + 15 * MiB;
constexpr size_t OFF_GR0 = OFF_SMALL + 23 * MiB;
constexpr size_t OFF_GR1 = OFF_SMALL + 56 * MiB;
constexpr size_t OFF_RT = OFF_SMALL + 65 * MiB;
constexpr size_t OFF_R0 = OFF_SMALL + 68 * MiB;
constexpr size_t OFF_R1 = OFF_SMALL + 69 * MiB;
constexpr size_t OFF_RQ = OFF_SMALL + 70 * MiB;
constexpr size_t OFF_RKV = OFF_SMALL + 71 * MiB;
constexpr size_t OFF_SQQP = OFF_SMALL + 72 * MiB;
constexpr size_t OFF_SQKVP = OFF_SMALL + 75 * MiB;
constexpr size_t OFF_DBGW = OFF_SMALL + 78 * MiB;
constexpr size_t DO_Q = 0;
constexpr size_t DO_KN = 194 * MiB;
constexpr size_t DO_KR = 323 * MiB;
constexpr size_t DO_VT = 340 * MiB;

constexpr size_t OFF_ODBG = 518 * MiB;
constexpr size_t OFF_HDBG = 647 * MiB;
constexpr int LDS_BYTES = 147456;

struct Params {
    const float* in[26];
    float* out;
    unsigned char* ws;
};

__device__ __forceinline__ f32x4 ld_sys(const float* q) { f32x4 v; asm volatile("global_load_dwordx4 %0, %1, off sc0 sc1\n\ts_waitcnt vmcnt(0)" : "=v"(v) : "v"(q) : "memory"); return v; }
typedef float f32x2_ld __attribute__((ext_vector_type(2)));
__device__ __forceinline__ float ldco(const float* q) { return *(const GAS float*)q; }
__device__ __forceinline__ float2 ldco2(const float2* q) { const f32x2_ld v = *(const GAS f32x2_ld*)q; return make_float2(v[0], v[1]); }
template <class Tp> __device__ __forceinline__ Tp* launder(Tp* q) { asm volatile("" : "+s"(q)); return q; }
__device__ __forceinline__ int tid_l() { int t = threadIdx.x; asm volatile("" : "+v"(t)); return t; }
__device__ __forceinline__ unsigned cvt_pk_bf16(float lo, float hi) { unsigned r; asm volatile("v_cvt_pk_bf16_f32 %0, %1, %2" : "=v"(r) : "v"(lo), "v"(hi)); return r; }
__device__ __forceinline__ float bf2f(unsigned short b) { return __builtin_bit_cast(float, (unsigned)b << 16); }
__device__ __forceinline__ float bflo(unsigned w) { return __builtin_bit_cast(float, w << 16); }
__device__ __forceinline__ float bfhi(unsigned w) { return __builtin_bit_cast(float, w & 0xffff0000u); }
__device__ __forceinline__ float wave_sum(float v) {
#pragma unroll
    for (int o = 1; o < 64; o <<= 1) v += __shfl_xor(v, o);
    return v;
}
__device__ __forceinline__ void sincos_red(float x, float& s, float& c) {
    const double xd = (double)x; const double k = rint(xd * 0.15915494309189535); const float r = (float)(xd - k * 6.283185307179586);
    s = __sinf(r); c = __cosf(r);
}
__device__ __forceinline__ float sin_red(float x) { float s, c; sincos_red(x, s, c); return s; }
__device__ __forceinline__ void row_info(int r, int& pos, int& seq) {
    if (r < TPR) { seq = r / LP; pos = r - seq * LP; }
    else { int q = r - TPR; if (q >= TSR) q = TSR - 1; const int b = q / LS; pos = q - b * LS; seq = NBP + b; }
}
__device__ __forceinline__ int full_row(int n) {
    if (n < 65536) { const int b = n >> 13; return b * LP + 16 + (n & 8191); }
    const int q = n - 65536; const int b = q >> 11; return TPR + b * LS + 16 + (q & 2047);
}

namespace pg8 {
constexpr int BM = 256, BK = 64, HALF = 128, HTB = HALF * BK * 2, STAGE_BYTES = 8 * HTB, NXCD = 8, WGM = 8;
__host__ __device__ __forceinline__ int lds_byte(int r, int c) { const int st = (r >> 4) * 2 + (c >> 5), rr = r & 15, cc = c & 31, ob = rr * 64 + cc * 2; return st * 1024 + (ob ^ (((ob >> 9) & 1) << 5)); }
__host__ __device__ __forceinline__ void stage_rc(int b, int& R, int& C) { const int st = b / 1024, sb = b % 1024, swz = sb ^ (((sb >> 9) & 1) << 5); R = (st >> 1) * 16 + swz / 64; C = (st & 1) * 32 + (swz % 64) / 2; }
__host__ __device__ __forceinline__ int perm32(int rho) { const int n = rho >> 4, i = rho & 15; return 8 * (i >> 2) + 4 * n + (i & 3); }
struct Unit { int pm, pn; };
struct Gemm { const bf16_t* A; const bf16_t* Bt; int M, N, K, lda, ldb; };
struct StaticOrder {
    int nM, nN, nwg, G, c;
    __device__ void init(int M, int N, int G_, int c_) { nM = M / BM; nN = N / BM; nwg = nM * nN; G = G_; c = c_; }
    __device__ bool next(int i, Unit& u) const {
        const long L = (long)i * G + c; if (L >= nwg) return false;
        int wgid = (int)L; { const int q = nwg / NXCD, r = nwg % NXCD, xcd = wgid % NXCD, off = wgid / NXCD; wgid = (xcd < r ? xcd * (q + 1) : r * (q + 1) + (xcd - r) * q) + off; }
        const int nig = WGM * nN, gid = wgid / nig, fm = gid * WGM, gsz = (nM - fm) < WGM ? (nM - fm) : WGM;
        u.pm = fm + ((wgid % nig) % gsz); u.pn = (wgid % nig) / gsz; return true;
    }
};
template <class Epi>
__device__ __forceinline__ void gemm_phase(LAS unsigned char* lds, const Gemm g, const StaticOrder& S, const Epi& E) {
    const int tid = tid_l(), wid = __builtin_amdgcn_readfirstlane(tid >> 6), lane = tid & 63, wr = wid >> 2, wc = wid & 3, fr = lane & 15, fq = lane >> 4;
    const int K = g.K, nt = K / BK;
    unsigned voffA[2], voffB[2];
#pragma unroll
    for (int i = 0; i < 2; ++i) { int R, C; stage_rc(tid * 16 + i * 8192, R, C); const int Rb = (R & ~31) + perm32(R & 31);
        voffA[i] = (unsigned)(R * g.lda + C) * 2u; voffB[i] = (unsigned)(Rb * g.ldb + C) * 2u; }
    const size_t kstep = (size_t)(BK * 2);
    const size_t hstepA = (size_t)HALF * g.lda * 2, hstepB = (size_t)HALF * g.ldb * 2;
    const size_t tstepA = 2 * hstepA, tstepB = 2 * hstepB;
    const unsigned ldsw = (unsigned)wid * 1024u;
    const int aoff = lds_byte(wr * 64 + fr, fq * 8), boff = lds_byte(wc * 32 + fr, fq * 8);
#define PG8_SA(b, h) (((b) * 2 + (h)) * HTB)
#define PG8_SB(b, h) ((4 + (b) * 2 + (h)) * HTB)
#define PG8_STAGE(bufoff, gbase, voff) do { _Pragma("unroll") for (int _i = 0; _i < 2; ++_i) \
        __builtin_amdgcn_global_load_lds((const unsigned*)((const char*)(gbase) + (voff)[_i]), (LAS unsigned*)(lds + (bufoff) + ldsw + _i * 8192), 16, 0, 0); } while (0)
#define PG8_LDA(dst, b, h) do { _Pragma("unroll") for (int m = 0; m < 4; ++m) _Pragma("unroll") for (int k = 0; k < 2; ++k) dst[m][k] = *(const LAS bf16x8*)(lds + PG8_SA(b, h) + aoff + m * 2048 + k * 1024); } while (0)
#define PG8_LDB(dst, b, h) do { _Pragma("unroll") for (int n = 0; n < 2; ++n) _Pragma("unroll") for (int k = 0; k < 2; ++k) dst[n][k] = *(const LAS bf16x8*)(lds + PG8_SB(b, h) + boff + n * 2048 + k * 1024); } while (0)
#define PG8_MMA(ai, bj, At, Bt) do { __builtin_amdgcn_s_setprio(1); _Pragma("unroll") for (int m = 0; m < 4; ++m) _Pragma("unroll") for (int n = 0; n < 2; ++n) _Pragma("unroll") for (int k = 0; k < 2; ++k) \
        acc[ai][bj][m][n] = __builtin_amdgcn_mfma_f32_16x16x32_bf16(Bt[n][k], At[m][k], acc[ai][bj][m][n], 0, 0, 0); __builtin_amdgcn_s_setprio(0); } while (0)
#define PG8_WAIT_V(n) asm volatile("s_waitcnt vmcnt(" #n ")" ::: "memory")
#define PG8_WAIT_L(n) asm volatile("s_waitcnt lgkmcnt(" #n ")" ::: "memory")
#define PG8_BAR __builtin_amdgcn_s_barrier()
#define PG8_SCHED __builtin_amdgcn_sched_barrier(0)
    Unit cur, nxt; int ui = 0;
    if (!S.next(0, cur)) return;
    f32x4 acc[2][2][4][2];
#pragma unroll
    for (int a = 0; a < 2; ++a)
#pragma unroll
        for (int b = 0; b < 2; ++b)
#pragma unroll
            for (int m = 0; m < 4; ++m)
#pragma unroll
                for (int n = 0; n < 2; ++n) acc[a][b][m][n] = (f32x4){0.f, 0.f, 0.f, 0.f};
    bf16x8 At[4][2], B0[2][2], B1[2][2];
    const char* cA = (const char*)g.A + (size_t)cur.pm * tstepA; const char* cB = (const char*)g.Bt + (size_t)cur.pn * tstepB;
    PG8_STAGE(PG8_SB(0, 0), cB, voffB); PG8_STAGE(PG8_SB(0, 1), cB + hstepB, voffB); PG8_STAGE(PG8_SA(0, 0), cA, voffA); PG8_STAGE(PG8_SA(0, 1), cA + hstepA, voffA);
    if (wr == 1) PG8_BAR;
    PG8_WAIT_V(2); PG8_BAR;
    PG8_STAGE(PG8_SB(1, 0), cB + kstep, voffB); PG8_STAGE(PG8_SA(1, 0), cA + kstep, voffA); PG8_STAGE(PG8_SB(1, 1), cB + hstepB + kstep, voffB);
    PG8_WAIT_V(6); PG8_BAR;
    for (;;) {
        const bool has_next = S.next(ui + 1, nxt);
        const char* nA = has_next ? (const char*)g.A + (size_t)nxt.pm * tstepA : cA; const char* nB = has_next ? (const char*)g.Bt + (size_t)nxt.pn * tstepB : cB;
        for (int t = 0; t < nt; t += 2) {
            const bool last = (t == nt - 2);
            const char* a1 = cA + (size_t)(t + 1) * kstep;
            const char* a2 = last ? nA : cA + (size_t)(t + 2) * kstep; const char* b2 = last ? nB : cB + (size_t)(t + 2) * kstep;
            const char* a3 = a2 + kstep; const char* b3 = b2 + kstep;
            PG8_LDB(B0, 0, 0); PG8_LDB(B1, 0, 1); PG8_SCHED; PG8_LDA(At, 0, 0); PG8_STAGE(PG8_SA(1, 1), a1 + hstepA, voffA);
            PG8_WAIT_V(8); PG8_WAIT_L(0); PG8_BAR; PG8_MMA(0, 0, At, B0); PG8_MMA(0, 1, At, B1); PG8_BAR; PG8_SCHED;
            PG8_LDA(At, 0, 1); PG8_STAGE(PG8_SB(0, 0), b2, voffB); PG8_STAGE(PG8_SB(0, 1), b2 + hstepB, voffB); PG8_STAGE(PG8_SA(0, 0), a2, voffA);
            PG8_WAIT_V(8); PG8_WAIT_L(0); PG8_BAR; PG8_MMA(1, 0, At, B0); PG8_MMA(1, 1, At, B1); PG8_BAR; PG8_SCHED;
            PG8_LDB(B0, 1, 0); PG8_LDB(B1, 1, 1); PG8_SCHED; PG8_LDA(At, 1, 0); PG8_STAGE(PG8_SA(0, 1), a2 + hstepA, voffA);
            PG8_WAIT_V(8); PG8_WAIT_L(0); PG8_BAR; PG8_MMA(0, 0, At, B0); PG8_MMA(0, 1, At, B1); PG8_BAR; PG8_SCHED;
            PG8_LDA(At, 1, 1); PG8_STAGE(PG8_SB(1, 0), b3, voffB); PG8_STAGE(PG8_SB(1, 1), b3 + hstepB, voffB); PG8_STAGE(PG8_SA(1, 0), a3, voffA);
            PG8_WAIT_V(8); PG8_WAIT_L(0); PG8_BAR; PG8_MMA(1, 0, At, B0); PG8_MMA(1, 1, At, B1); PG8_BAR; PG8_SCHED;
        }
        if (wr == 0) PG8_BAR;
        E(acc, cur, wr, wc, fr, fq);
        if (!has_next) break;
#pragma unroll
        for (int a = 0; a < 2; ++a)
#pragma unroll
            for (int b = 0; b < 2; ++b)
#pragma unroll
                for (int m = 0; m < 4; ++m)
#pragma unroll
                    for (int n = 0; n < 2; ++n) acc[a][b][m][n] = (f32x4){0.f, 0.f, 0.f, 0.f};
        cur = nxt; cA = nA; cB = nB; ++ui;
        if (wr == 1) PG8_BAR;
    }
    PG8_WAIT_V(0);
    PG8_BAR;
#undef PG8_SA
#undef PG8_SB
#undef PG8_STAGE
#undef PG8_LDA
#undef PG8_LDB
#undef PG8_MMA
#undef PG8_WAIT_V
#undef PG8_WAIT_L
#undef PG8_BAR
#undef PG8_SCHED
}
}

__device__ __forceinline__ void rope8(f32x4& v0, f32x4& v1, const float2* rt  ) {
    const float2 c0 = ldco2(rt), c1 = ldco2(rt + 1), c2 = ldco2(rt + 2), c3 = ldco2(rt + 3);
    float a, b;
    a = v0[0]; b = v0[1]; v0[0] = a * c0.x - b * c0.y; v0[1] = b * c0.x + a * c0.y;
    a = v0[2]; b = v0[3]; v0[2] = a * c1.x - b * c1.y; v0[3] = b * c1.x + a * c1.y;
    a = v1[0]; b = v1[1]; v1[0] = a * c2.x - b * c2.y; v1[1] = b * c2.x + a * c2.y;
    a = v1[2]; b = v1[3]; v1[2] = a * c3.x - b * c3.y; v1[3] = b * c3.x + a * c3.y;
}
__device__ __forceinline__ u32x4 pack8(const f32x4& v0, const f32x4& v1) {
    u32x4 w; w.x = cvt_pk_bf16(v0[0], v0[1]); w.y = cvt_pk_bf16(v0[2], v0[3]); w.z = cvt_pk_bf16(v1[0], v1[1]); w.w = cvt_pk_bf16(v1[2], v1[3]); return w;
}
__device__ __forceinline__ float sq8(const f32x4& a, const f32x4& b) {
    return (a[0] * a[0] + a[1] * a[1]) + (a[2] * a[2] + a[3] * a[3]) + (b[0] * b[0] + b[1] * b[1]) + (b[2] * b[2] + b[3] * b[3]);
}
template <int MODE> struct Epi {
    bf16_t* O; int ldc; const float* rs; float* sq0; float* sq1; bf16_t* KR; const float2* RT;
    __device__ __forceinline__ void operator()(const f32x4 (&acc)[2][2][4][2], const pg8::Unit& u, int wr, int wc, int fr, int fq) const {
#pragma unroll
        for (int ai = 0; ai < 2; ++ai)
#pragma unroll
            for (int m = 0; m < 4; ++m) {
                const int row = u.pm * 256 + ai * 128 + wr * 64 + m * 16 + fr;
                float sc = 1.f;
                if (MODE == 0 || MODE == 1 || MODE == 2 || MODE == 5) sc = ldco(rs + row);
                float ssum[2];
#pragma unroll
                for (int bj = 0; bj < 2; ++bj) {
                    const int col0 = u.pn * 256 + bj * 128 + wc * 32 + 8 * fq;
                    f32x4 v0 = acc[ai][bj][m][0] * sc, v1 = acc[ai][bj][m][1] * sc;
                    if (MODE == 3) {
#pragma unroll
                        for (int j = 0; j < 4; ++j) { v0[j] *= ldco(rs + col0 + j); v1[j] *= ldco(rs + col0 + 4 + j); }
                    }
                    if (MODE == 5) {
#pragma unroll
                        for (int j = 0; j < 4; ++j) { const float a = fmaxf(v0[j], 0.f), b = fmaxf(v1[j], 0.f); v0[j] = a * a; v1[j] = b * b; }
                    }
                    ssum[bj] = sq8(v0, v1);
                    *(u32x4*)(O + (size_t)row * ldc + col0) = pack8(v0, v1);
                }
                if (MODE == 0) {
                    if (u.pn == 0) { float s = ssum[0] + ssum[1]; s += __shfl_xor(s, 16); s += __shfl_xor(s, 32); if (fq == 0) sq0[row * 4 + wc] = s; }
                    else if (u.pn == 1) { float s = ssum[0]; s += __shfl_xor(s, 16); s += __shfl_xor(s, 32); if (fq == 0) sq1[row * 4 + wc] = s; }
                }
                if (MODE == 4 || MODE == 6) { float s = ssum[0] + ssum[1]; s += __shfl_xor(s, 16); s += __shfl_xor(s, 32); if (fq == 0) sq0[(size_t)row * 16 + u.pn * 4 + wc] = s; }
            }
    }
};

__device__ __forceinline__ int src_col(int mode, int n) {
    if (mode == 0) return n;
    if (mode == 1) { if (n >= 1984) return -1; if (n >= 384 && n < 448) { const int j = n - 384; return 384 + ((j & 1) ? 32 + (j >> 1) : (j >> 1)); } return n; }
    if (mode == 2) { const int h = n / 192, w = n % 192; if (w < 128) return n; const int j = w - 128; return h * 192 + 128 + ((j & 1) ? 32 + (j >> 1) : (j >> 1)); }
    if (mode == 3) return (n >> 7) * 256 + (n & 127);
    return (n >> 7) * 256 + 128 + (n & 127);
}
__device__ __forceinline__ void conv_weight(const float* W, const float* g, bf16_t* out, int K, int Nsrc, int Nout, int mode, int gtid, int gthreads) {
    const int nch = Nout * (K / 8);
    for (int e = gtid; e < nch; e += gthreads) {
        const int n = e % Nout, kc = e / Nout, k0 = kc * 8; const int sc = src_col(mode, n);
        float v[8];
#pragma unroll
        for (int j = 0; j < 8; ++j) v[j] = (sc >= 0) ? W[(size_t)(k0 + j) * Nsrc + sc] * (g ? g[k0 + j] : 1.f) : 0.f;
        u32x4 w; w.x = cvt_pk_bf16(v[0], v[1]); w.y = cvt_pk_bf16(v[2], v[3]); w.z = cvt_pk_bf16(v[4], v[5]); w.w = cvt_pk_bf16(v[6], v[7]);
        *(u32x4*)(out + (size_t)n * K + k0) = w;
    }
}

__device__ __forceinline__ void p0_prologue(const Params& p, LAS unsigned char* lds) {
    unsigned char* ws = launder(p.ws);
    const int tid = tid_l(), lane = tid & 63, wave = tid >> 6, G = gridDim.x;
    const int gtid = blockIdx.x * 512 + tid, gthreads = G * 512;
    const int gw = blockIdx.x * 8 + wave, NGW = G * 8;
#if SUB_MASK & 1
    conv_weight(p.in[4], p.in[3], (bf16_t*)(ws + OFF_WIN), 1024, 1984, 2048, 1, gtid, gthreads);
    conv_weight(p.in[6], p.in[5], (bf16_t*)(ws + OFF_WUQ), 256, 768, 768, 2, gtid, gthreads);
    conv_weight(p.in[8], p.in[7], (bf16_t*)(ws + OFF_WKN), 128, 1024, 512, 3, gtid, gthreads);
    conv_weight(p.in[8], p.in[7], (bf16_t*)(ws + OFF_WV), 128, 1024, 512, 4, gtid, gthreads);
    conv_weight(p.in[20], nullptr, (bf16_t*)(ws + OFF_WO), 1024, 1024, 1024, 0, gtid, gthreads);
    conv_weight(p.in[23], p.in[22], (bf16_t*)(ws + OFF_WF1), 1024, 4096, 4096, 0, gtid, gthreads);
    conv_weight(p.in[24], nullptr, (bf16_t*)(ws + OFF_WF2), 4096, 1024, 1024, 0, gtid, gthreads);
#endif
#if SUB_MASK & 2
#if DEBUG_CHECK
    if (blockIdx.x == 0 && tid < 64) ((unsigned*)(ws + OFF_DBGW))[tid] = 0u;
#endif
    {
        float2* RT = (float2*)(ws + OFF_RT);
        for (int e = gtid; e < LP * 32; e += gthreads) {
            const int pos = e >> 5, i = e & 31;
            const float inv = 1.0f / exp2f((float)i * (13.287712379549449f / 32.f));
            float s, c; sincos_red((float)pos * inv, s, c);
            RT[e] = make_float2(c, s);
        }
    }
#endif
#if SUB_MASK & 4
    {
        bf16_t* h0b = (bf16_t*)(ws + OFF_H0B); float* r0 = (float*)(ws + OFF_R0);
        for (int r = gw; r < TPAD; r += NGW) {
            u32x2* o = (u32x2*)(h0b + (size_t)r * 1024) + lane;
            if (r >= T) {
#pragma unroll
                for (int j = 0; j < 4; ++j) o[64 * j] = (u32x2){0u, 0u};
                if (lane == 0) __hip_atomic_store(r0 + r, 0.f, __ATOMIC_RELAXED, __HIP_MEMORY_SCOPE_AGENT);
                continue;
            }
            int pos, seq; row_info(r, pos, seq);
            const float* src = pos < 16 ? p.in[2] + (size_t)pos * 1024
                                        : (seq < NBP ? p.in[0] + ((size_t)seq * 8192 + (pos - 16)) * 1024 : p.in[1] + ((size_t)(seq - NBP) * 2048 + (pos - 16)) * 1024);
            const f32x4* xr = (const f32x4*)src + lane;
            f32x4 v[4]; float ss = 0.f;
#pragma unroll
            for (int j = 0; j < 4; ++j) { v[j] = xr[64 * j]; ss += (v[j][0] * v[j][0] + v[j][1] * v[j][1]) + (v[j][2] * v[j][2] + v[j][3] * v[j][3]); }
            ss = wave_sum(ss);
#pragma unroll
            for (int j = 0; j < 4; ++j) o[64 * j] = (u32x2){cvt_pk_bf16(v[j][0], v[j][1]), cvt_pk_bf16(v[j][2], v[j][3])};
            if (lane == 0) __hip_atomic_store(r0 + r, rsqrtf(ss * (1.f / 1024.f) + EPS), __ATOMIC_RELAXED, __HIP_MEMORY_SCOPE_AGENT);
        }
    }
#endif
#if SUB_MASK & 8
    {
        const float* f_w1 = p.in[10]; const float* f_b1 = p.in[11]; const float* f_freq = p.in[12]; const float* f_w2 = p.in[13];
        const float* f_b2 = p.in[14]; const float* f_w3 = p.in[15]; const float* f_decay = p.in[16];
        LAS float* feats = (LAS float*)lds;
        LAS float* h1 = feats + 16 * 34;
        LAS float* h2 = h1 + 16 * 64;
        for (int u = blockIdx.x; u < 513 + 129; u += G) {
            const int set = u < 513 ? 0 : 1; const int t0 = 16 * (set ? u - 513 : u); const int L = set ? LS : LP; const int C0 = set ? LGS : LGP;
            bf16_t* GR = (bf16_t*)(ws + (set ? OFF_GR1 : OFF_GR0));
            const float invLm1 = 1.0f / (float)(L - 1);
            if (tid < 256) {
                const int tt = tid >> 4, k = tid & 15; const int t = t0 + tt;
                const float w = (6.2831853071795865f * (float)t) / (float)L;
                const float f = 1e-4f + (float)k * ((15.0f - 1e-4f) / 15.0f);
                float s, c; sincos_red(f * w, s, c);
                feats[tt * 34 + 1 + k] = c; feats[tt * 34 + 17 + k] = -s;
                if (k == 0) feats[tt * 34] = (float)t * invLm1;
            }
            __syncthreads();
#pragma unroll 1
            for (int q = 0; q < 2; ++q) {
                const int o = tid + 512 * q, tt = o >> 6, j = o & 63;
                float a = f_b1[j];
#pragma unroll 3
                for (int e = 0; e < 33; ++e) a += feats[tt * 34 + e] * f_w1[e * 64 + j];
                h1[tt * 64 + j] = sin_red(f_freq[j] * a);
            }
            __syncthreads();
#pragma unroll 1
            for (int q = 0; q < 2; ++q) {
                const int o = tid + 512 * q, tt = o >> 6, j = o & 63;
                float a = f_b2[j];
#pragma unroll 4
                for (int e = 0; e < 64; ++e) a += h1[tt * 64 + e] * f_w2[e * 64 + j];
                h2[tt * 64 + j] = sin_red(f_freq[j] * a);
            }
            __syncthreads();
            {
                float a[4][16];
#pragma unroll
                for (int q = 0; q < 4; ++q)
#pragma unroll
                    for (int i = 0; i < 16; ++i) a[q][i] = 0.f;
#pragma unroll 2
                for (int j = 0; j < 64; ++j) {
                    float hv[16];
#pragma unroll
                    for (int i = 0; i < 16; ++i) hv[i] = h2[i * 64 + j];
#pragma unroll
                    for (int q = 0; q < 4; ++q) {
                        const float w = f_w3[j * 2048 + tid + 512 * q];
#pragma unroll
                        for (int i = 0; i < 16; ++i) a[q][i] += hv[i] * w;
                    }
                }
#pragma unroll
                for (int q = 0; q < 4; ++q) {
                    const int n = tid + 512 * q;
                    const float dec = fabsf(f_decay[n]);
                    const int order = n >> 10, dir = (n >> 9) & 1, c = n & 511;
                    bf16_t* row = GR + (size_t)(order * 512 + c) * (2 * C0);
#pragma unroll
                    for (int i = 0; i < 16; ++i) {
                        const int t = t0 + i;
                        const float val = a[q][i] * __expf(-((float)t * invLm1) * dec);
                        const unsigned short b = (unsigned short)(cvt_pk_bf16(val, 0.f) & 0xffffu);
                        if (dir == 0) row[C0 - t] = b; else if (t > 0) row[C0 + t] = b;
                    }
                }
            }
            __syncthreads();
        }
        for (int e = gtid; e < 2 * 1024 * 97; e += gthreads) {
            const int set = e / (1024 * 97), r = (e / 97) % 1024, i = e % 97; const int L = set ? LS : LP; const int C0 = set ? LGS : LGP;
            bf16_t* row = (bf16_t*)(ws + (set ? OFF_GR1 : OFF_GR0)) + (size_t)r * (2 * C0);
            const int idx = i < 49 ? i : C0 + L + (i - 49);
            row[idx] = 0;
        }
    }
#endif
}

__device__ __forceinline__ void rownorm_phase(const Params& p) {
    unsigned char* ws = launder(p.ws); const int gtid = blockIdx.x * 512 + tid_l(), gthreads = gridDim.x * 512;
    const float* sqq = (const float*)(ws + OFF_SQQP); const float* sqkv = (const float*)(ws + OFF_SQKVP);
    float* rq = (float*)(ws + OFF_RQ); float* rkv = (float*)(ws + OFF_RKV);
    for (int r = gtid; r < TPAD; r += gthreads) {
        const float a = (ldco(sqq + r * 4) + ldco(sqq + r * 4 + 1)) + (ldco(sqq + r * 4 + 2) + ldco(sqq + r * 4 + 3));
        const float b = (ldco(sqkv + r * 4) + ldco(sqkv + r * 4 + 1)) + (ldco(sqkv + r * 4 + 2) + ldco(sqkv + r * 4 + 3));
        rq[r] = rsqrtf(a * (1.f / 256.f) + EPS) * QSCALE; rkv[r] = rsqrtf(b * (1.f / 128.f) + EPS);
    }
}
__device__ __forceinline__ void krope_phase(const Params& p) {
    unsigned char* ws = launder(p.ws); unsigned char* ob = launder((unsigned char*)p.out);
    const int gtid = blockIdx.x * 512 + tid_l(), gthreads = gridDim.x * 512;
    const bf16_t* P = (const bf16_t*)(ws + OFF_P); bf16_t* KR = (bf16_t*)(ob + DO_KR); const float2* RT = (const float2*)(ws + OFF_RT);
    for (int e = gtid; e < TPAD * 8; e += gthreads) {
        const int row = e >> 3, ch = e & 7;
        int pos, seq; row_info(row, pos, seq);
        const u32x4 v = *(const u32x4*)(P + (size_t)row * NPP + 384 + ch * 8);
        f32x4 v0 = (f32x4){bflo(v.x), bfhi(v.x), bflo(v.y), bfhi(v.y)}, v1 = (f32x4){bflo(v.z), bfhi(v.z), bflo(v.w), bfhi(v.w)};
        rope8(v0, v1, RT + pos * 32 + ch * 4);
        *(u32x4*)(KR + (size_t)row * 64 + ch * 8) = pack8(v0, v1);
    }
}
__device__ __forceinline__ void hyprep_phase(const Params& p, LAS unsigned char* lds) {
    unsigned char* ws = launder(p.ws); const int tid = tid_l(), G = gridDim.x;
    const bf16_t* P = (const bf16_t*)(ws + OFF_P); const float* conv_w = p.in[9];
    constexpr int RSB = 1040;
    for (int u = blockIdx.x; u < 3096 + 3168; u += G) {
        int seq, j, which;
        if (u < 3096) { seq = u / 387; const int rem = u % 387; j = rem / 3; which = rem % 3; }
        else { const int v = u - 3096; seq = NBP + v / 99; const int rem = v % 99; j = rem / 3; which = rem % 3; }
        const int set = seq < NBP ? 0 : 1; const int L = set ? LS : LP; const int Lg = set ? LGS : LGP; const int NB = set ? NBS : NBP;
        const int b = set ? seq - NBP : seq; const int row0 = set ? TPR + b * LS : b * LP;
        const int posb = 64 * j - 49;
        for (int i = 0; i < 9; ++i) {
            const int id = tid + 512 * i; if (id >= 66 * 64) break;
            const int rr = id >> 6, ch = id & 63; const int pos = posb + rr;
            u32x4 v = (u32x4){0u, 0u, 0u, 0u};
            if (pos >= 0 && pos < L) v = *(const GAS u32x4*)(P + (size_t)(row0 + pos) * NPP + 448 + which * 512 + ch * 8);
            *(LAS u32x4*)(lds + rr * RSB + ch * 16) = v;
        }
        __syncthreads();
        {
            const int c = tid; const float w0 = conv_w[which * 512 + c], w1 = conv_w[1536 + which * 512 + c], w2 = conv_w[3072 + which * 512 + c];
            bf16_t* XT = (bf16_t*)(ws + (which == 0 ? OFF_X1T : (which == 1 ? OFF_X2T : OFF_V0T))) + (set ? XT_SET1 : 0) + ((size_t)c * NB + b) * Lg + 64 * j;
            const LAS unsigned short* tl = (const LAS unsigned short*)lds + c;
            float prev = bf2f(tl[0]), cur = bf2f(tl[RSB / 2]);
            for (int o8 = 0; o8 < 8; ++o8) {
                float r[8];
#pragma unroll
                for (int k = 0; k < 8; ++k) {
                    const int o = o8 * 8 + k; const float nxt = bf2f(tl[(o + 2) * (RSB / 2)]);
                    const int pos = posb + 1 + o;
                    r[k] = (pos >= 0 && pos < L) ? (prev * w0 + cur * w1 + nxt * w2) : 0.f;
                    prev = cur; cur = nxt;
                }
                u32x4 w; w.x = cvt_pk_bf16(r[0], r[1]); w.y = cvt_pk_bf16(r[2], r[3]); w.z = cvt_pk_bf16(r[4], r[5]); w.w = cvt_pk_bf16(r[6], r[7]);
                *(GAS u32x4*)(XT + o8 * 8) = w;
            }
        }
        __syncthreads();
    }
}

__device__ __forceinline__ f32x16 mfma32(bf16x8 a, bf16x8 b, f32x16 c) { return __builtin_amdgcn_mfma_f32_32x32x16_bf16(a, b, c, 0, 0, 0); }

__device__ __forceinline__ void attn_phase(const Params& p, LAS unsigned char* lds) {
    const int tid = tid_l(), lane = tid & 63, wave = tid >> 6, G = gridDim.x, h = lane >> 5, l32 = lane & 31;
    unsigned char* ob = launder((unsigned char*)p.out);
    bf16_t* Q = (bf16_t*)(ob + DO_Q);
    const bf16_t* KN = (const bf16_t*)(ob + DO_KN);
    const bf16_t* KR = (const bf16_t*)(ob + DO_KR);
    const bf16_t* VT = (const bf16_t*)(ob + DO_VT);
    constexpr int KROW = 400, VROW = 136, KBYTES = 64 * KROW, BUFB = KBYTES + 128 * VROW;
    const int vblk = (G % 8 == 0) ? (int)(blockIdx.x % 8) * (G / 8) + (int)(blockIdx.x / 8) : (int)blockIdx.x;
    for (int u = vblk; u < 2048; u += G) {
        int seq, head, qb;
        if (u < 1024) { seq = u >> 7; head = (u >> 5) & 3; qb = u & 31; } else { const int v = u - 1024; seq = NBP + (v >> 5); head = (v >> 3) & 3; qb = v & 7; }
        const int L = seq < NBP ? LP : LS; const int row0 = seq < NBP ? seq * LP : TPR + (seq - NBP) * LS;
        const int ntiles = (L + 63) >> 6;
        const int qrow = row0 + 16 + qb * 256 + wave * 32 + l32;
        bf16x8 qf[12];
#pragma unroll
        for (int ks = 0; ks < 12; ++ks) qf[ks] = *(const GAS bf16x8*)(Q + (size_t)qrow * 768 + head * 192 + 16 * ks + 8 * h);
        {
            const float2* RT = (const float2*)(launder(p.ws) + OFF_RT);
            const int qpos = 16 + qb * 256 + wave * 32 + l32;
#pragma unroll
            for (int ks = 8; ks < 12; ++ks) {
                const u32x4 v = __builtin_bit_cast(u32x4, qf[ks]);
                f32x4 v0 = (f32x4){bflo(v.x), bfhi(v.x), bflo(v.y), bfhi(v.y)}, v1 = (f32x4){bflo(v.z), bfhi(v.z), bflo(v.w), bfhi(v.w)};
                rope8(v0, v1, RT + qpos * 32 + 8 * (ks - 8) + 4 * h);
                qf[ks] = __builtin_bit_cast(bf16x8, pack8(v0, v1));
            }
        }
        const int kkey0 = tid >> 4, kch0 = tid & 15;
        const int rkey = tid >> 3, rch = tid & 7;
        const int vdv0 = tid >> 3, vch = tid & 7;
        const unsigned kn_off = (unsigned)(kkey0 * 512 + head * 128 + kch0 * 8) * 2u;
        const unsigned kr_off = (unsigned)(rkey * 64 + rch * 8) * 2u;
        const unsigned vt_off = (unsigned)(vdv0 * TPAD + vch * 8) * 2u;
        const unsigned char* knb = (const unsigned char*)KN + (size_t)row0 * 1024;
        const unsigned char* krb = (const unsigned char*)KR + (size_t)row0 * 128;
        const unsigned char* vtb = (const unsigned char*)VT + ((size_t)head * 128 * TPAD + row0) * 2;
        u32x4 g0, g1, g2, g3, g4;
#define ATT_LOAD(tile) do { const unsigned char* kb__ = knb + (size_t)(tile) * 65536; const unsigned char* rb__ = krb + (size_t)(tile) * 8192; const unsigned char* vb__ = vtb + (size_t)(tile) * 128; \
        g0 = *(const GAS u32x4*)(kb__ + kn_off); g1 = *(const GAS u32x4*)(kb__ + 32768 + kn_off); \
        g2 = *(const GAS u32x4*)(rb__ + kr_off); (void)vb__; } while (0)
#define ATT_LOADV(tile) do { const unsigned char* vb__ = vtb + (size_t)(tile) * 128; g3 = *(const GAS u32x4*)(vb__ + vt_off); g4 = *(const GAS u32x4*)(vb__ + (size_t)64 * TPAD * 2 + vt_off); } while (0)
#define ATT_STOREK(buf) do { LAS unsigned char* kb_ = lds + (buf) * BUFB; \
        *(LAS u32x4*)(kb_ + kkey0 * KROW + kch0 * 16) = g0; *(LAS u32x4*)(kb_ + (kkey0 + 32) * KROW + kch0 * 16) = g1; \
        *(LAS u32x4*)(kb_ + rkey * KROW + 256 + rch * 16) = g2; } while (0)
#define ATT_STORE(buf) do { LAS unsigned char* vb_ = lds + (buf) * BUFB + KBYTES; \
        *(LAS u32x2*)(vb_ + vdv0 * VROW + vch * 16) = (u32x2){g3.x, g3.y}; *(LAS u32x2*)(vb_ + vdv0 * VROW + vch * 16 + 8) = (u32x2){g3.z, g3.w}; \
        *(LAS u32x2*)(vb_ + (vdv0 + 64) * VROW + vch * 16) = (u32x2){g4.x, g4.y}; *(LAS u32x2*)(vb_ + (vdv0 + 64) * VROW + vch * 16 + 8) = (u32x2){g4.z, g4.w}; } while (0)
        ATT_LOAD(0); ATT_LOADV(0); ATT_STOREK(0); ATT_STORE(0);
        __syncthreads();
        f32x16 o[4];
#pragma unroll
        for (int d = 0; d < 4; ++d)
#pragma unroll
            for (int r = 0; r < 16; ++r) o[d][r] = 0.f;
        float m_run = -INFINITY, l_run = 0.f;
        for (int j = 0; j < ntiles; ++j) {
            const int buf = j & 1;
            if (j + 1 < ntiles) ATT_LOAD(j + 1);
            const LAS unsigned char* kb = lds + buf * BUFB;
            f32x16 s0, s1;
#pragma unroll
            for (int r = 0; r < 16; ++r) { s0[r] = 0.f; s1[r] = 0.f; }
            {
                bf16x8 kA[6], kB[6];
                const LAS unsigned char* kr0 = kb + l32 * KROW + h * 16; const LAS unsigned char* kr1 = kr0 + 32 * KROW;
#define ATT_LDK(dst, ksb) do { _Pragma("unroll") for (int i = 0; i < 3; ++i) { dst[2 * i] = *(const LAS bf16x8*)(kr0 + ((ksb) + i) * 32); dst[2 * i + 1] = *(const LAS bf16x8*)(kr1 + ((ksb) + i) * 32); } } while (0)
#define ATT_MMK(src, ksb) do { _Pragma("unroll") for (int i = 0; i < 3; ++i) { s0 = mfma32(src[2 * i], qf[(ksb) + i], s0); s1 = mfma32(src[2 * i + 1], qf[(ksb) + i], s1); } } while (0)
                ATT_LDK(kA, 0); __builtin_amdgcn_sched_barrier(0);
                ATT_MMK(kA, 0); __builtin_amdgcn_sched_barrier(0);
                ATT_LDK(kB, 3); __builtin_amdgcn_sched_barrier(0);
                ATT_MMK(kB, 3); __builtin_amdgcn_sched_barrier(0);
                ATT_LDK(kA, 6); __builtin_amdgcn_sched_barrier(0);
                ATT_MMK(kA, 6); __builtin_amdgcn_sched_barrier(0);
                ATT_LDK(kB, 9); __builtin_amdgcn_sched_barrier(0);
                ATT_MMK(kB, 9); __builtin_amdgcn_sched_barrier(0);
#undef ATT_LDK
#undef ATT_MMK
            }
            if (j + 1 < ntiles) ATT_STOREK(buf ^ 1);
            const int vc = L - j * 64;
            if (vc < 64) {
                const int vch = vc - 4 * h;
#pragma unroll
                for (int r = 0; r < 16; ++r) {
                    if ((r & 3) + 8 * (r >> 2) >= vch) s0[r] = -INFINITY;
                    if ((r & 3) + 8 * (r >> 2) + 32 >= vch) s1[r] = -INFINITY;
                }
            }
            float mx = fmaxf(s0[0], s1[0]);
#pragma unroll
            for (int r = 1; r < 16; ++r) mx = fmaxf(mx, fmaxf(s0[r], s1[r]));
            mx = fmaxf(mx, __shfl_xor(mx, 32));
            const float m_new = fmaxf(m_run, mx);
            const float alpha = __builtin_amdgcn_exp2f(m_run - m_new);
            m_run = m_new;
            float ls = 0.f;
#pragma unroll
            for (int r = 0; r < 16; ++r) { s0[r] = __builtin_amdgcn_exp2f(s0[r] - m_new); s1[r] = __builtin_amdgcn_exp2f(s1[r] - m_new); ls += s0[r] + s1[r]; }
            l_run = l_run * alpha + ls;
            if (__any(alpha != 1.0f)) {
#pragma unroll
                for (int d = 0; d < 4; ++d)
#pragma unroll
                    for (int r = 0; r < 16; ++r) o[d][r] *= alpha;
            }
            bf16x8 pb[4];
            {
                u32x4 w;
                w.x = cvt_pk_bf16(s0[0], s0[1]); w.y = cvt_pk_bf16(s0[2], s0[3]); w.z = cvt_pk_bf16(s0[4], s0[5]); w.w = cvt_pk_bf16(s0[6], s0[7]); pb[0] = __builtin_bit_cast(bf16x8, w);
                w.x = cvt_pk_bf16(s0[8], s0[9]); w.y = cvt_pk_bf16(s0[10], s0[11]); w.z = cvt_pk_bf16(s0[12], s0[13]); w.w = cvt_pk_bf16(s0[14], s0[15]); pb[1] = __builtin_bit_cast(bf16x8, w);
                w.x = cvt_pk_bf16(s1[0], s1[1]); w.y = cvt_pk_bf16(s1[2], s1[3]); w.z = cvt_pk_bf16(s1[4], s1[5]); w.w = cvt_pk_bf16(s1[6], s1[7]); pb[2] = __builtin_bit_cast(bf16x8, w);
                w.x = cvt_pk_bf16(s1[8], s1[9]); w.y = cvt_pk_bf16(s1[10], s1[11]); w.z = cvt_pk_bf16(s1[12], s1[13]); w.w = cvt_pk_bf16(s1[14], s1[15]); pb[3] = __builtin_bit_cast(bf16x8, w);
            }
            if (j + 1 < ntiles) ATT_LOADV(j + 1);
            const LAS unsigned char* vb = kb + KBYTES;
            {
                const LAS unsigned char* vrow = vb + l32 * VROW + 8 * h;
#pragma unroll
                for (int d = 0; d < 4; ++d) {
                    u32x4 vf[4];
#pragma unroll
                    for (int ks = 0; ks < 4; ++ks) {
                        const LAS unsigned char* ap = vrow + d * 32 * VROW + 32 * ks;
                        const u32x2 lo = *(const LAS u32x2*)ap, hi = *(const LAS u32x2*)(ap + 16);
                        vf[ks] = (u32x4){lo.x, lo.y, hi.x, hi.y};
                    }
                    __builtin_amdgcn_sched_barrier(0);
#pragma unroll
                    for (int ks = 0; ks < 4; ++ks) o[d] = mfma32(__builtin_bit_cast(bf16x8, vf[ks]), pb[ks], o[d]);
                    __builtin_amdgcn_sched_barrier(0);
                }
            }
            if (j + 1 < ntiles) ATT_STORE(buf ^ 1);
            __syncthreads();
        }
        l_run += __shfl_xor(l_run, 32);
        const float inv = 1.0f / l_run;
#if DEBUG_CHECK == 5
        bf16_t* orow = (bf16_t*)(launder(p.ws) + OFF_ODBG) + (size_t)qrow * 512 + head * 128;
#else
        bf16_t* orow = Q + (size_t)qrow * 768 + head * 192;
#endif
#pragma unroll
        for (int d = 0; d < 4; ++d)
#pragma unroll
            for (int rq = 0; rq < 4; ++rq) {
                const u32x2 w = (u32x2){cvt_pk_bf16(o[d][4 * rq] * inv, o[d][4 * rq + 1] * inv), cvt_pk_bf16(o[d][4 * rq + 2] * inv, o[d][4 * rq + 3] * inv)};
                *(GAS u32x2*)(orow + 32 * d + 8 * rq + 4 * h) = w;
            }
#undef ATT_LOAD
#undef ATT_LOADV
#undef ATT_STORE
#undef ATT_STOREK
    }
}

template <int SET> __device__ __forceinline__ void hyena_unit(const Params& p, LAS unsigned char* lds, int c, int bg) {
    constexpr int P = SET ? 32 : 128;
    constexpr int NBU = SET ? 16 : 4;
    constexpr int NBT = SET ? 8 : 2;
    constexpr int GP = SET ? 4 : 16;
    constexpr int LG = SET ? LGS : LGP;
    constexpr int NB = SET ? NBS : NBP;
    constexpr int RS = SET ? 4896 : 18816;
    constexpr int GBYTES = 2 * LG * 2;
    constexpr int G1OFF = 33220;
    constexpr int ZOFF = 66560;
    unsigned char* ws = launder(p.ws);
    const int tid = tid_l(), lane = tid & 63, wave = tid >> 6, h = lane >> 5, l32 = lane & 31;
    const bf16_t* X1T = (const bf16_t*)(ws + OFF_X1T) + (SET ? XT_SET1 : 0);
    bf16_t* X2T = (bf16_t*)(ws + OFF_X2T) + (SET ? XT_SET1 : 0);
    const bf16_t* V0T = (const bf16_t*)(ws + OFF_V0T) + (SET ? XT_SET1 : 0);
    const bf16_t* GR = (const bf16_t*)(ws + (SET ? OFF_GR1 : OFF_GR0));
    const float* hy_bias = launder(p.in[17]);
    LAS unsigned char* gL = lds; LAS unsigned char* zL = lds + ZOFF;
    const size_t rowbase = ((size_t)c * NB + bg * NBU) * LG;
    for (int id = tid; id < NBU * (P + 1) * 8; id += 512) {
        const int bl = id / ((P + 1) * 8), rem = id % ((P + 1) * 8), blk = rem >> 3, ch = rem & 7;
        *(LAS u32x4*)(zL + bl * RS + blk * 144 + ch * 16) = *(const GAS u32x4*)(V0T + rowbase + (size_t)bl * LG + blk * 64 + ch * 8);
    }
    for (int id = tid; id < NBU * 9; id += 512) { const int bl = id / 9, ch = id % 9; *(LAS u32x4*)(zL + bl * RS + (P + 1) * 144 + ch * 16) = (u32x4){0u, 0u, 0u, 0u}; }
#define HY_LOADG(rowidx) do { const unsigned* g32_ = (const unsigned*)(GR + (size_t)(rowidx) * (2 * LG)); \
        for (int id = tid; id < GBYTES / 4; id += 512) { const unsigned a_ = g32_[id], b_ = (id + 1 < GBYTES / 4) ? g32_[id + 1] : 0u; \
            *(LAS unsigned*)(gL + id * 4) = a_; *(LAS unsigned*)(gL + G1OFF + id * 4) = (a_ >> 16) | (b_ << 16); } } while (0)
    HY_LOADG(c);
    __syncthreads();
    const LAS unsigned short* g16 = (const LAS unsigned short*)gL;
    constexpr int PARTS = 512 / (NBU * 16);
    float zmeta = 0.f; int mo_bl, mo_m;
    {
        const int part = tid % PARTS, out = tid / PARTS; mo_bl = out >> 4; mo_m = out & 15;
        const LAS unsigned char* zr = zL + mo_bl * RS;
        float a = 0.f;
        const LAS unsigned char* gm = gL + (mo_m & 1) * G1OFF;
        for (int ci = part; ci < (LG - 48) / 8; ci += PARTS) {
            const int tt0 = 48 + 8 * ci;
            const u32x4 zv = *(const LAS u32x4*)(zr + (tt0 >> 6) * 144 + (tt0 & 63) * 2);
            const LAS unsigned* gp = (const LAS unsigned*)(gm + ((LG - mo_m - 48 + tt0) >> 1) * 4);
            const unsigned g0 = gp[0], g1 = gp[1], g2 = gp[2], g3 = gp[3];
            a += (bflo(zv.x) * bflo(g0) + bfhi(zv.x) * bfhi(g0)) + (bflo(zv.y) * bflo(g1) + bfhi(zv.y) * bfhi(g1))
               + (bflo(zv.z) * bflo(g2) + bfhi(zv.z) * bfhi(g2)) + (bflo(zv.w) * bflo(g3) + bfhi(zv.w) * bfhi(g3));
        }
#pragma unroll
        for (int o = 1; o < PARTS; o <<= 1) a += __shfl_xor(a, o);
        const float bias0 = hy_bias[c];
        const float z0 = bf2f(*(const LAS unsigned short*)(zr + (48 + mo_m) * 2));
        const float x1 = bf2f(X1T[rowbase + (size_t)mo_bl * LG + 48 + mo_m]);
        zmeta = x1 * (a + z0 * bias0);
    }
    const int p0 = GP * wave;
    const int pp = l32 / NBT, blA = l32 % NBT, blB = NBT + blA;
#pragma unroll 1
    for (int order = 0; order < 2; ++order) {
        f32x16 acc[2][2];
#pragma unroll
        for (int a = 0; a < 2; ++a)
#pragma unroll
            for (int b = 0; b < 2; ++b)
#pragma unroll
                for (int r = 0; r < 16; ++r) acc[a][b][r] = 0.f;
        bf16x8 Ep4, Ep5;
        {
            const int d0 = p0 - (P - 1); const int ib0 = LG - 64 * d0 - l32 + 8 * h;
            const LAS unsigned char* g0 = gL + (l32 & 1) * G1OFF + (ib0 >> 1) * 4;
            const LAS unsigned* ga = (const LAS unsigned*)(g0 + 96); const LAS unsigned* gb = (const LAS unsigned*)(g0 + 64);
            Ep4 = __builtin_bit_cast(bf16x8, (u32x4){ga[0], ga[1], ga[2], ga[3]}); Ep5 = __builtin_bit_cast(bf16x8, (u32x4){gb[0], gb[1], gb[2], gb[3]});
        }
#define HY_LOAD(dd, Bv, Ev) do { \
            const int ib_ = LG - 64 * (dd) - l32 + 8 * h; \
            const LAS unsigned char* gpl_ = gL + (l32 & 1) * G1OFF + (ib_ >> 1) * 4; \
            _Pragma("unroll") for (int e = 2; e < 6; ++e) { const LAS unsigned* gp_ = (const LAS unsigned*)(gpl_ - 32 * (e - 3)); \
                Ev[e - 2] = __builtin_bit_cast(bf16x8, (u32x4){gp_[0], gp_[1], gp_[2], gp_[3]}); } \
            const int q_ = p0 + pp - (dd); const int slot_ = ((unsigned)(q_ + 1) <= (unsigned)P) ? q_ + 1 : P + 1; \
            const LAS unsigned char* zA_ = zL + blA * RS + slot_ * 144 + h * 16; const LAS unsigned char* zB_ = zL + blB * RS + slot_ * 144 + h * 16; \
            _Pragma("unroll") for (int ks = 0; ks < 4; ++ks) { Bv[0][ks] = *(const LAS bf16x8*)(zA_ + ks * 32); Bv[1][ks] = *(const LAS bf16x8*)(zB_ + ks * 32); } } while (0)
#define HY_MMA(Bv, Ev) do { \
            _Pragma("unroll") for (int ks = 0; ks < 4; ++ks) { \
                const bf16x8 a0_ = (ks == 0) ? Ev[1] : (ks == 1) ? Ev[0] : (ks == 2) ? Ep5 : Ep4; \
                const bf16x8 a1_ = (ks == 0) ? Ev[3] : (ks == 1) ? Ev[2] : (ks == 2) ? Ev[1] : Ev[0]; \
                acc[0][0] = mfma32(a0_, Bv[0][ks], acc[0][0]); acc[1][0] = mfma32(a0_, Bv[1][ks], acc[1][0]); \
                acc[0][1] = mfma32(a1_, Bv[0][ks], acc[0][1]); acc[1][1] = mfma32(a1_, Bv[1][ks], acc[1][1]); } \
            Ep4 = Ev[2]; Ep5 = Ev[3]; } while (0)
        {
            bf16x8 BA[2][4], BB[2][4], EA[4], EB[4];
            const int dlo = p0 - (P - 1), dhi = p0 + GP;
            HY_LOAD(dlo, BA, EA);
#pragma unroll 1
            for (int d = dlo; d <= dhi; d += 2) {
                HY_LOAD(d + 1, BB, EB);
                HY_MMA(BA, EA);
                if (d + 2 <= dhi) HY_LOAD(d + 2, BA, EA);
                HY_MMA(BB, EB);
            }
        }
#undef HY_LOAD
#undef HY_MMA
        __syncthreads();
        const float bias = hy_bias[order * 512 + c];
#pragma unroll
        for (int tl = 0; tl < 2; ++tl) {
            const int bl = tl ? blB : blA;
            const size_t grow = rowbase + (size_t)bl * LG + 64 * (p0 + pp + 1);
            LAS unsigned char* zr = zL + bl * RS + (p0 + pp + 1) * 144;
#pragma unroll
            for (int m = 0; m < 2; ++m)
#pragma unroll
                for (int rq = 0; rq < 4; ++rq) {
                    const int off = 32 * m + 8 * rq + 4 * h;
                    const u32x2 zw = *(const LAS u32x2*)(zr + off * 2);
                    const u32x2 xw = *(const GAS u32x2*)((order ? (const bf16_t*)X2T : X1T) + grow + off);
                    const float y0 = acc[tl][m][4 * rq], y1 = acc[tl][m][4 * rq + 1], y2 = acc[tl][m][4 * rq + 2], y3 = acc[tl][m][4 * rq + 3];
                    const float r0 = bflo(xw.x) * (y0 + bflo(zw.x) * bias), r1 = bfhi(xw.x) * (y1 + bfhi(zw.x) * bias);
                    const float r2 = bflo(xw.y) * (y2 + bflo(zw.y) * bias), r3 = bfhi(xw.y) * (y3 + bfhi(zw.y) * bias);
                    const u32x2 w = (u32x2){cvt_pk_bf16(r0, r1), cvt_pk_bf16(r2, r3)};
#if DEBUG_CHECK == 5
                    if (order == 0) *(LAS u32x2*)(zr + off * 2) = w; else *(GAS u32x2*)((bf16_t*)(ws + OFF_HDBG) + (SET ? XT_SET1 : 0) + grow + off) = w;
#else
                    if (order == 0) *(LAS u32x2*)(zr + off * 2) = w; else *(GAS u32x2*)(X2T + grow + off) = w;
#endif
                }
        }
        if (order == 0) {
            if ((tid % PARTS) == 0) *(LAS unsigned short*)(zL + mo_bl * RS + (48 + mo_m) * 2) = (unsigned short)(cvt_pk_bf16(zmeta, 0.f) & 0xffffu);
            HY_LOADG(512 + c);
        }
        __syncthreads();
    }
}
#undef HY_LOADG
__device__ __forceinline__ void hyena_phase(const Params& p, LAS unsigned char* lds) {
    for (int u = blockIdx.x; u < 2048; u += gridDim.x) {
        if (u < 1024) hyena_unit<0>(p, lds, u >> 1, u & 1); else hyena_unit<1>(p, lds, (u - 1024) >> 1, u & 1);
    }
}

__device__ __forceinline__ void mixnorm_phase(const Params& p, LAS unsigned char* lds) {
    unsigned char* ws = launder(p.ws); const int tid = tid_l(), lane = tid & 63, wave = tid >> 6, G = gridDim.x;
    const bf16_t* Q = (const bf16_t*)(launder((unsigned char*)p.out) + DO_Q);
    bf16_t* MIXN = (bf16_t*)(ws + OFF_MIXN);
    const float* ga = launder(p.in[18]); const float* gh = launder(p.in[19]);
    constexpr int RSB = 1040;
    for (int u = blockIdx.x; u < 2048; u += G) {
        const int n0 = u * 64;
        int set, b, tok0;
        if (n0 < 65536) { set = 0; b = n0 >> 13; tok0 = n0 & 8191; } else { set = 1; const int q = n0 - 65536; b = q >> 11; tok0 = q & 2047; }
        const int Lg = set ? LGS : LGP, NB = set ? NBS : NBP;
        {
            const int c = tid;
#if DEBUG_CHECK == 5
            const bf16_t* src = (const bf16_t*)(ws + OFF_HDBG) + (set ? XT_SET1 : 0) + ((size_t)c * NB + b) * Lg + tok0 + 64;
#else
            const bf16_t* src = (const bf16_t*)(ws + OFF_X2T) + (set ? XT_SET1 : 0) + ((size_t)c * NB + b) * Lg + tok0 + 64;
#endif
            LAS unsigned short* tl = (LAS unsigned short*)lds + c;
#pragma unroll
            for (int k8 = 0; k8 < 8; ++k8) {
                const u32x4 v = *(const GAS u32x4*)(src + k8 * 8);
                tl[(k8 * 8 + 0) * (RSB / 2)] = (unsigned short)(v.x & 0xffffu); tl[(k8 * 8 + 1) * (RSB / 2)] = (unsigned short)(v.x >> 16);
                tl[(k8 * 8 + 2) * (RSB / 2)] = (unsigned short)(v.y & 0xffffu); tl[(k8 * 8 + 3) * (RSB / 2)] = (unsigned short)(v.y >> 16);
                tl[(k8 * 8 + 4) * (RSB / 2)] = (unsigned short)(v.z & 0xffffu); tl[(k8 * 8 + 5) * (RSB / 2)] = (unsigned short)(v.z >> 16);
                tl[(k8 * 8 + 6) * (RSB / 2)] = (unsigned short)(v.w & 0xffffu); tl[(k8 * 8 + 7) * (RSB / 2)] = (unsigned short)(v.w >> 16);
            }
        }
        __syncthreads();
        for (int i = 0; i < 8; ++i) {
            const int rr = wave + 8 * i; const int n = n0 + rr; const int r = full_row(n);
            const u32x4 hv = *(const LAS u32x4*)(lds + rr * RSB + lane * 16);
#if DEBUG_CHECK == 5
            const u32x4 av = *(const GAS u32x4*)((const bf16_t*)(ws + OFF_ODBG) + (size_t)r * 512 + lane * 8);
#else
            const u32x4 av = *(const GAS u32x4*)(Q + (size_t)r * 768 + (lane >> 4) * 192 + (lane & 15) * 8);
#endif
            float hf[8] = {bflo(hv.x), bfhi(hv.x), bflo(hv.y), bfhi(hv.y), bflo(hv.z), bfhi(hv.z), bflo(hv.w), bfhi(hv.w)};
            float af[8] = {bflo(av.x), bfhi(av.x), bflo(av.y), bfhi(av.y), bflo(av.z), bfhi(av.z), bflo(av.w), bfhi(av.w)};
            float sh = 0.f, sa = 0.f;
#pragma unroll
            for (int k = 0; k < 8; ++k) { sh += hf[k] * hf[k]; sa += af[k] * af[k]; }
            sh = wave_sum(sh); sa = wave_sum(sa);
            const float rh = rsqrtf(sh * (1.f / 512.f) + EPS), ra = rsqrtf(sa * (1.f / 512.f) + EPS);
            const f32x4 ga0 = *(const GAS f32x4*)(ga + lane * 8), ga1 = *(const GAS f32x4*)(ga + lane * 8 + 4);
            const f32x4 gh0 = *(const GAS f32x4*)(gh + lane * 8), gh1 = *(const GAS f32x4*)(gh + lane * 8 + 4);
            u32x4 wa, wh;
            wa.x = cvt_pk_bf16(af[0] * ra * ga0[0], af[1] * ra * ga0[1]); wa.y = cvt_pk_bf16(af[2] * ra * ga0[2], af[3] * ra * ga0[3]);
            wa.z = cvt_pk_bf16(af[4] * ra * ga1[0], af[5] * ra * ga1[1]); wa.w = cvt_pk_bf16(af[6] * ra * ga1[2], af[7] * ra * ga1[3]);
            wh.x = cvt_pk_bf16(hf[0] * rh * gh0[0], hf[1] * rh * gh0[1]); wh.y = cvt_pk_bf16(hf[2] * rh * gh0[2], hf[3] * rh * gh0[3]);
            wh.z = cvt_pk_bf16(hf[4] * rh * gh1[0], hf[5] * rh * gh1[1]); wh.w = cvt_pk_bf16(hf[6] * rh * gh1[2], hf[7] * rh * gh1[3]);
#if EXPT == 1
            wa = (u32x4){0u, 0u, 0u, 0u};
#endif
#if EXPT == 2
            wh = (u32x4){0u, 0u, 0u, 0u};
#endif
            *(GAS u32x4*)(MIXN + (size_t)n * 1024 + lane * 8) = wa;
            *(GAS u32x4*)(MIXN + (size_t)n * 1024 + 512 + lane * 8) = wh;
        }
        __syncthreads();
    }
}

__device__ __forceinline__ void h1_phase(const Params& p) {
    unsigned char* ws = launder(p.ws); const int tid = tid_l(), lane = tid & 63, wave = tid >> 6;
    const int gw = blockIdx.x * 8 + wave, NGW = gridDim.x * 8;
    const bf16_t* MIX = (const bf16_t*)(ws + OFF_MIX); bf16_t* H1B = (bf16_t*)(ws + OFF_H1B);
    const float* sqmix = (const float*)(ws + OFF_SQMIXP); float* r1 = (float*)(ws + OFF_R1); const float* g = p.in[21];
    for (int n = gw; n < TN; n += NGW) {
        const float* xrow = n < 65536 ? p.in[0] + (size_t)n * 1024 : p.in[1] + (size_t)(n - 65536) * 1024;
        const float rm = rsqrtf(wave_sum(lane < 16 ? ldco(sqmix + (size_t)n * 16 + lane) : 0.f) * (1.f / 1024.f) + EPS);
        float ss = 0.f;
#pragma unroll
        for (int hh = 0; hh < 2; ++hh) {
            const int c0 = hh * 512 + lane * 8;
            const u32x4 mv = *(const u32x4*)(MIX + (size_t)n * 1024 + c0);
            const f32x4 x0 = *(const f32x4*)(xrow + c0), x1 = *(const f32x4*)(xrow + c0 + 4);
            const f32x4 g0 = *(const f32x4*)(g + c0), g1 = *(const f32x4*)(g + c0 + 4);
            f32x4 h0, h1;
            h0[0] = x0[0] + bflo(mv.x) * rm * g0[0]; h0[1] = x0[1] + bfhi(mv.x) * rm * g0[1]; h0[2] = x0[2] + bflo(mv.y) * rm * g0[2]; h0[3] = x0[3] + bfhi(mv.y) * rm * g0[3];
            h1[0] = x1[0] + bflo(mv.z) * rm * g1[0]; h1[1] = x1[1] + bfhi(mv.z) * rm * g1[1]; h1[2] = x1[2] + bflo(mv.w) * rm * g1[2]; h1[3] = x1[3] + bfhi(mv.w) * rm * g1[3];
            ss += sq8(h0, h1);
            *(u32x4*)(H1B + (size_t)n * 1024 + c0) = pack8(h0, h1);
        }
        ss = wave_sum(ss);
        if (lane == 0) r1[n] = rsqrtf(ss * (1.f / 1024.f) + EPS);
    }
}
__device__ __forceinline__ void final_phase(const Params& p, int half) {
    unsigned char* ws = launder(p.ws); const int tid = tid_l(), lane = tid & 63, wave = tid >> 6;
    const int gw = blockIdx.x * 8 + wave, NGW = gridDim.x * 8;
    const bf16_t* M2 = (const bf16_t*)(ws + OFF_M2); const float* sqm2 = (const float*)(ws + OFF_SQM2P); const float* g = p.in[25];
    float dbg_off = 0.f, dbg_one = 0.f;
#if DEBUG_CHECK
    { const unsigned* dc = (const unsigned*)(ws + OFF_DBGW); dbg_off = 100.f * (float)dc[8] * (1.f / 131072.f); dbg_one = 1000.f * (float)dc[9] * (1.f / 131072.f); }
#endif
    for (int i = gw; i < 65536; i += NGW) {
        const int n = half * 65536 + i;
        const float rm = rsqrtf(wave_sum(lane < 16 ? ldco(sqm2 + (size_t)n * 16 + lane) : 0.f) * (1.f / 1024.f) + EPS);
#pragma unroll
        for (int hh = 0; hh < 2; ++hh) {
            const int c0 = hh * 512 + lane * 8;
            const u32x4 mv = *(const u32x4*)(M2 + (size_t)i * 1024 + c0);
            const u32x4 hv = *(const u32x4*)((const bf16_t*)(ws + OFF_H1B) + (size_t)n * 1024 + c0);
            f32x4 h0 = (f32x4){bflo(hv.x), bfhi(hv.x), bflo(hv.y), bfhi(hv.y)}, h1 = (f32x4){bflo(hv.z), bfhi(hv.z), bflo(hv.w), bfhi(hv.w)};
            const f32x4 g0 = *(const f32x4*)(g + c0), g1 = *(const f32x4*)(g + c0 + 4);
            h0 += dbg_off; h1 += dbg_off; if (n == 0 && c0 == 0) h0[0] += dbg_one;
            h0[0] += bflo(mv.x) * rm * g0[0]; h0[1] += bfhi(mv.x) * rm * g0[1]; h0[2] += bflo(mv.y) * rm * g0[2]; h0[3] += bfhi(mv.y) * rm * g0[3];
            h1[0] += bflo(mv.z) * rm * g1[0]; h1[1] += bfhi(mv.z) * rm * g1[1]; h1[2] += bflo(mv.w) * rm * g1[2]; h1[3] += bfhi(mv.w) * rm * g1[3];
            *(f32x4*)(p.out + (size_t)n * 1024 + c0) = h0; *(f32x4*)(p.out + (size_t)n * 1024 + c0 + 4) = h1;
        }
    }
}


#if DEBUG_CHECK
constexpr size_t OFF_DBG = OFF_DBGW;
__device__ __forceinline__ void check_gemm(const bf16_t* A, int lda, const bf16_t* Bt, int ldb, int K, int M, int N, int mode, const bf16_t* O, int ldc, const float* rs, unsigned* cnt, int col_lo) {
    const unsigned idx = blockIdx.x * 512u + (unsigned)tid_l();
    unsigned hsh = idx * 2654435761u + 12345u + (unsigned)mode * 977u; hsh ^= hsh >> 15; hsh *= 2246822519u; hsh ^= hsh >> 13;
    const int row = (int)(hsh % (unsigned)M); hsh = hsh * 3266489917u + 668265263u; hsh ^= hsh >> 16;
    const int col = col_lo + (int)(hsh % (unsigned)(N - col_lo));
    float d = 0.f;
    for (int k = 0; k < K; ++k) d += bf2f(A[(size_t)row * lda + k]) * bf2f(Bt[(size_t)col * ldb + k]);
    float e = d;
    if (mode == 0 || mode == 7) e = d * rs[row];
    if (mode == 5) { const float t = fmaxf(d * rs[row], 0.f); e = t * t; }
    const float st = bf2f(O[(size_t)row * ldc + col]);
    if (!(fabsf(st - e) <= 0.03f * fabsf(e) + 0.03f)) atomicAdd(cnt, 1u);
}
#endif

#if DEBUG_CHECK == 2
__device__ __forceinline__ void check_proj(const Params& p) {
    unsigned char* ws = launder(p.ws); unsigned char* ob = launder((unsigned char*)p.out);
    const bf16_t* P = (const bf16_t*)(ws + OFF_P); unsigned* cnt = (unsigned*)(ws + OFF_DBG);
    const unsigned idx = blockIdx.x * 512u + (unsigned)tid_l();
    unsigned hsh = idx * 2654435761u + 777u; hsh ^= hsh >> 15; hsh *= 2246822519u; hsh ^= hsh >> 13;
    const int row = (int)(hsh % (unsigned)T); hsh = hsh * 3266489917u + 668265263u; hsh ^= hsh >> 16;
    int pos, seq; row_info(row, pos, seq);
    {
        const int n = (int)(hsh % 768u); const int hh = n / 192, w = n % 192;
        float ss = 0.f, x1 = 0.f, x2 = 0.f; const float* W = p.in[6]; const float* g = p.in[5];
        const int j = w - 128, i = j >> 1;
        const int c1 = w < 128 ? hh * 192 + w : hh * 192 + 128 + i, c2 = hh * 192 + 160 + (w < 128 ? 0 : i);
        for (int k = 0; k < 256; ++k) { const float a = bf2f(P[(size_t)row * NPP + k]); ss += a * a; x1 += a * g[k] * W[k * 768 + c1]; x2 += a * g[k] * W[k * 768 + c2]; }
        const float rq = rsqrtf(ss * (1.f / 256.f) + EPS) * QSCALE; x1 *= rq; x2 *= rq;
        float e = x1;
        if (w >= 128) { const float inv = 1.0f / exp2f((float)i * (13.287712379549449f / 32.f)); float sn, cs; sincos_red((float)pos * inv, sn, cs); e = (j & 1) ? x2 * cs + x1 * sn : x1 * cs - x2 * sn; }
        const float st = bf2f(((const bf16_t*)(ob + DO_Q))[(size_t)row * 768 + n]);
        if (!(fabsf(st - e) <= 0.03f * fabsf(e) + 0.01f)) atomicAdd(cnt + (w < 128 ? 0 : 4), 1u);
    }
    {
        const int n = (int)((hsh >> 3) % 512u); const int hh = n >> 7, i = n & 127;
        float ss = 0.f, x1 = 0.f, x2 = 0.f; const float* W = p.in[8]; const float* g = p.in[7];
        for (int k = 0; k < 128; ++k) { const float a = bf2f(P[(size_t)row * NPP + 256 + k]); ss += a * a; x1 += a * g[k] * W[k * 1024 + hh * 256 + i]; x2 += a * g[k] * W[k * 1024 + hh * 256 + 128 + i]; }
        const float rk = rsqrtf(ss * (1.f / 128.f) + EPS); x1 *= rk; x2 *= rk;
        const float s1 = bf2f(((const bf16_t*)(ob + DO_KN))[(size_t)row * 512 + n]);
        const float s2 = bf2f(((const bf16_t*)(ob + DO_VT))[(size_t)n * TPAD + row]);
        if (!(fabsf(s1 - x1) <= 0.03f * fabsf(x1) + 0.03f)) atomicAdd(cnt + 1, 1u);
        if (!(fabsf(s2 - x2) <= 0.03f * fabsf(x2) + 0.03f)) atomicAdd(cnt + 2, 1u);
    }
    {
        const int jj = (int)((hsh >> 5) % 64u); const int i = jj >> 1;
        const float* xr = pos < 16 ? p.in[2] + (size_t)pos * 1024 : (seq < NBP ? p.in[0] + ((size_t)seq * 8192 + (pos - 16)) * 1024 : p.in[1] + ((size_t)(seq - NBP) * 2048 + (pos - 16)) * 1024);
        const float* W = p.in[4]; const float* g = p.in[3]; float x1 = 0.f, x2 = 0.f;
        for (int k = 0; k < 1024; ++k) { const float a = xr[k] * g[k]; x1 += a * W[(size_t)k * 1984 + 384 + i]; x2 += a * W[(size_t)k * 1984 + 416 + i]; }
        const float r0 = ((const float*)(ws + OFF_R0))[row]; x1 *= r0; x2 *= r0;
        const float inv = 1.0f / exp2f((float)i * (13.287712379549449f / 32.f)); float sn, cs; sincos_red((float)pos * inv, sn, cs);
        const float e = (jj & 1) ? x2 * cs + x1 * sn : x1 * cs - x2 * sn;
        const float st = bf2f(((const bf16_t*)(ob + DO_KR))[(size_t)row * 64 + jj]);
        if (!(fabsf(st - e) <= 0.03f * fabsf(e) + 0.03f)) { atomicAdd(cnt + 3, 1u); atomicAdd(cnt + 5, (unsigned)i); atomicAdd(cnt + 6, (unsigned)(pos >> 3)); }
    }
}
#endif

#if DEBUG_CHECK == 3
__device__ __forceinline__ void check_h0b(const Params& p, int slot) {
    unsigned char* ws = launder(p.ws); unsigned* cnt = (unsigned*)(ws + OFF_DBGW);
    const bf16_t* h0b = (const bf16_t*)(ws + OFF_H0B);
    const unsigned idx = blockIdx.x * 512u + (unsigned)tid_l();
    unsigned hsh = idx * 2654435761u + 4242u + (unsigned)slot * 31u; hsh ^= hsh >> 15; hsh *= 2246822519u; hsh ^= hsh >> 13;
    const int row = (int)(hsh % (unsigned)T); hsh = hsh * 3266489917u + 668265263u; hsh ^= hsh >> 16;
    const int col = (int)(hsh % 1024u);
    int pos, seq; row_info(row, pos, seq);
    const float* xr = pos < 16 ? p.in[2] + (size_t)pos * 1024 : (seq < NBP ? p.in[0] + ((size_t)seq * 8192 + (pos - 16)) * 1024 : p.in[1] + ((size_t)(seq - NBP) * 2048 + (pos - 16)) * 1024);
    const float e = xr[col]; const float st = bf2f(h0b[(size_t)row * 1024 + col]);
    if (!(fabsf(st - e) <= 0.01f * fabsf(e) + 0.001f)) atomicAdd(cnt + slot, 1u);
}
#endif

#if DEBUG_CHECK == 4
__device__ __forceinline__ void check_stale(const Params& p, const unsigned* base, unsigned ndw, int slot) {
    unsigned* cnt = (unsigned*)(launder(p.ws) + OFF_DBGW);
    const unsigned idx = blockIdx.x * 512u + (unsigned)tid_l();
    unsigned hsh = idx * 2654435761u + 999u + (unsigned)slot * 131u; hsh ^= hsh >> 15; hsh *= 2246822519u; hsh ^= hsh >> 13;
#pragma unroll 1
    for (int it = 0; it < 16; ++it) {
        hsh = hsh * 3266489917u + 668265263u; hsh ^= hsh >> 16;
        const unsigned i = hsh % ndw;
        const unsigned a = base[i];
        const unsigned b = __hip_atomic_load(base + i, __ATOMIC_RELAXED, __HIP_MEMORY_SCOPE_AGENT);
        if (a != b) atomicAdd(cnt + slot, 1u);
    }
}
#endif

#if DEBUG_CHECK == 5
__device__ __forceinline__ void check_attn(const Params& p) {
    unsigned char* ws = launder(p.ws); unsigned char* ob = launder((unsigned char*)p.out); unsigned* cnt = (unsigned*)(ws + OFF_DBGW);
    const int tid = tid_l(), lane = tid & 63, wave = tid >> 6;
    const bf16_t* Q = (const bf16_t*)(ob + DO_Q); const bf16_t* KN = (const bf16_t*)(ob + DO_KN); const bf16_t* KR = (const bf16_t*)(ob + DO_KR); const bf16_t* VT = (const bf16_t*)(ob + DO_VT);
    const bf16_t* OD = (const bf16_t*)(ws + OFF_ODBG); const float2* RT = (const float2*)(ws + OFF_RT);
    unsigned hsh = (unsigned)(blockIdx.x * 8 + wave) * 2654435761u + 31337u; hsh ^= hsh >> 15; hsh *= 2246822519u; hsh ^= hsh >> 13;
    const int n = (int)(hsh % (unsigned)TN); const int head = (int)((hsh >> 20) & 3u); const int r = full_row(n);
    int pos, seq; row_info(r, pos, seq);
    const int L = seq < NBP ? LP : LS; const int row0 = r - pos;
    const bf16_t* qp = Q + (size_t)r * 768 + head * 192;
    float mx = -INFINITY;
    for (int k = lane; k < L; k += 64) {
        float sdot = 0.f;
        for (int d = 0; d < 128; ++d) sdot += bf2f(qp[d]) * bf2f(KN[(size_t)(row0 + k) * 512 + head * 128 + d]);
        for (int i = 0; i < 32; ++i) { const float2 cs = ldco2(RT + pos * 32 + i); const float a = bf2f(qp[128 + 2 * i]), b = bf2f(qp[129 + 2 * i]);
            sdot += (a * cs.x - b * cs.y) * bf2f(KR[(size_t)(row0 + k) * 64 + 2 * i]) + (b * cs.x + a * cs.y) * bf2f(KR[(size_t)(row0 + k) * 64 + 2 * i + 1]); }
        mx = fmaxf(mx, sdot);
    }
#pragma unroll
    for (int o = 1; o < 64; o <<= 1) mx = fmaxf(mx, __shfl_xor(mx, o));
    float sw = 0.f, o0 = 0.f, o1 = 0.f; const int dv0 = (int)((hsh >> 8) & 127u), dv1 = (dv0 + 37) & 127;
    for (int k = lane; k < L; k += 64) {
        float sdot = 0.f;
        for (int d = 0; d < 128; ++d) sdot += bf2f(qp[d]) * bf2f(KN[(size_t)(row0 + k) * 512 + head * 128 + d]);
        for (int i = 0; i < 32; ++i) { const float2 cs = ldco2(RT + pos * 32 + i); const float a = bf2f(qp[128 + 2 * i]), b = bf2f(qp[129 + 2 * i]);
            sdot += (a * cs.x - b * cs.y) * bf2f(KR[(size_t)(row0 + k) * 64 + 2 * i]) + (b * cs.x + a * cs.y) * bf2f(KR[(size_t)(row0 + k) * 64 + 2 * i + 1]); }
        const float w = exp2f(sdot - mx); sw += w;
        o0 += w * bf2f(VT[(size_t)(head * 128 + dv0) * TPAD + row0 + k]); o1 += w * bf2f(VT[(size_t)(head * 128 + dv1) * TPAD + row0 + k]);
    }
    sw = wave_sum(sw); o0 = wave_sum(o0) / sw; o1 = wave_sum(o1) / sw;
    if (lane == 0) {
        const float s0 = bf2f(OD[(size_t)r * 512 + head * 128 + dv0]), s1 = bf2f(OD[(size_t)r * 512 + head * 128 + dv1]);
        atomicAdd(cnt + 10, 2u);
        if (!(fabsf(s0 - o0) <= 0.05f * fabsf(o0) + 0.002f)) atomicAdd(cnt + 8, 1u);
        if (!(fabsf(s1 - o1) <= 0.05f * fabsf(o1) + 0.002f)) atomicAdd(cnt + 8, 1u);
    }
}
__device__ __forceinline__ void check_hyena(const Params& p, LAS unsigned char* lds) {
    unsigned char* ws = launder(p.ws); unsigned* cnt = (unsigned*)(ws + OFF_DBGW);
    const int tid = tid_l();
    unsigned hsh = (unsigned)blockIdx.x * 2654435761u + 555u; hsh ^= hsh >> 15; hsh *= 2246822519u; hsh ^= hsh >> 13;
    const int set = (int)(blockIdx.x & 1u); const int c = (int)(hsh % 512u); const int NB = set ? NBS : NBP; const int b = (int)((hsh >> 12) % (unsigned)NB);
    const int LG = set ? LGS : LGP;
    const size_t base = (set ? XT_SET1 : 0) + ((size_t)c * NB + b) * LG;
    const bf16_t* X1 = (const bf16_t*)(ws + OFF_X1T) + base; const bf16_t* X2 = (const bf16_t*)(ws + OFF_X2T) + base; const bf16_t* V0 = (const bf16_t*)(ws + OFF_V0T) + base;
    const bf16_t* HD = (const bf16_t*)(ws + OFF_HDBG) + base;
    const bf16_t* G0 = (const bf16_t*)(ws + (set ? OFF_GR1 : OFF_GR0)) + (size_t)c * (2 * LG); const bf16_t* G1 = G0 + (size_t)512 * (2 * LG);
    const float bias0 = p.in[17][c], bias1 = p.in[17][512 + c];
    LAS float* z1 = (LAS float*)lds;
    for (int t = tid; t < LG; t += 512) {
        float y = 0.f;
        for (int s2 = 48; s2 < LG; ++s2) y += bf2f(G0[LG - (t - s2)]) * bf2f(V0[s2]);
        const float v = bf2f(X1[t]) * (y + bf2f(V0[t]) * bias0);
        z1[t] = (t >= 48) ? bf2f((unsigned short)(cvt_pk_bf16(v, 0.f) & 0xffffu)) : 0.f;
    }
    __syncthreads();
    {
        unsigned h2 = hsh * 3266489917u + (unsigned)tid * 2246822519u; h2 ^= h2 >> 15; h2 *= 2654435761u; h2 ^= h2 >> 13;
        const int t = 64 + (int)(h2 % (unsigned)(LG - 64));
        float y = 0.f;
        for (int s2 = 48; s2 < LG; ++s2) y += bf2f(G1[LG - (t - s2)]) * z1[s2];
        const float e = bf2f(X2[t]) * (y + z1[t] * bias1);
        const float st = bf2f(HD[t]);
        atomicAdd(cnt + 11, 1u);
        if (!(fabsf(st - e) <= 0.05f * fabsf(e) + 1.0f)) atomicAdd(cnt + 9, 1u);
    }
    __syncthreads();
}
#endif

#if DEBUG_CHECK == 7
__device__ __forceinline__ void check_h0b_full(const Params& p, int slot) {
    unsigned char* ws = launder(p.ws); unsigned* cnt = (unsigned*)(ws + OFF_DBGW);
    const bf16_t* h0b = (const bf16_t*)(ws + OFF_H0B);
    const int tid = tid_l(), lane = tid & 63, wave = tid >> 6;
    for (int row = blockIdx.x * 8 + wave; row < T; row += gridDim.x * 8) {
        int pos, seq; row_info(row, pos, seq);
        const float* xr = pos < 16 ? p.in[2] + (size_t)pos * 1024 : (seq < NBP ? p.in[0] + ((size_t)seq * 8192 + (pos - 16)) * 1024 : p.in[1] + ((size_t)(seq - NBP) * 2048 + (pos - 16)) * 1024);
        int bad = 0;
        for (int c = lane; c < 1024; c += 64) { const float e = xr[c]; const float st = bf2f(h0b[(size_t)row * 1024 + c]); if (!(fabsf(st - e) <= 0.01f * fabsf(e) + 0.001f)) bad = 1; }
        bad = __any(bad);
        if (lane == 0 && bad) atomicAdd(cnt + slot, 1u);
    }
}
#endif

#if DEBUG_CHECK == 8
__device__ __forceinline__ void check_p_golden(const Params& p) {
    unsigned char* ws = launder(p.ws); unsigned* cnt = (unsigned*)(ws + OFF_DBGW);
    const bf16_t* P = (const bf16_t*)(ws + OFF_P);
    const unsigned idx = blockIdx.x * 512u + (unsigned)tid_l();
    unsigned hsh = idx * 2654435761u + 8888u; hsh ^= hsh >> 15; hsh *= 2246822519u; hsh ^= hsh >> 13;
    const int row = (int)(hsh % (unsigned)T); hsh = hsh * 3266489917u + 668265263u; hsh ^= hsh >> 16;
    int pos, seq; row_info(row, pos, seq);
    const float* xr = pos < 16 ? p.in[2] + (size_t)pos * 1024 : (seq < NBP ? p.in[0] + ((size_t)seq * 8192 + (pos - 16)) * 1024 : p.in[1] + ((size_t)(seq - NBP) * 2048 + (pos - 16)) * 1024);
    const float* W = p.in[4]; const float* g = p.in[3];
    const int colA = 448 + (int)(hsh % 1536u), colB = (int)((hsh >> 7) % 384u);
    float ss = 0.f, a = 0.f, b = 0.f;
    for (int k = 0; k < 1024; ++k) { const float x = xr[k]; ss += x * x; a += x * g[k] * W[(size_t)k * 1984 + colA]; b += x * g[k] * W[(size_t)k * 1984 + colB]; }
    const float r0 = rsqrtf(ss * (1.f / 1024.f) + EPS); a *= r0; b *= r0;
    const float sa = bf2f(P[(size_t)row * NPP + colA]), sb = bf2f(P[(size_t)row * NPP + colB]);
    if (!(fabsf(sa - a) <= 0.03f * fabsf(a) + 0.03f)) atomicAdd(cnt + 8, 1u);
    if (!(fabsf(sb - b) <= 0.03f * fabsf(b) + 0.03f)) atomicAdd(cnt + 9, 1u);
}
#endif

#if DEBUG_CHECK == 9
__device__ __forceinline__ void check_win_r0(const Params& p) {
    unsigned char* ws = launder(p.ws); unsigned* cnt = (unsigned*)(ws + OFF_DBGW);
    const bf16_t* WT = (const bf16_t*)(ws + OFF_WIN); const float* W = p.in[4]; const float* g = p.in[3]; const float* R0 = (const float*)(ws + OFF_R0);
    const int tid = tid_l(), lane = tid & 63, wave = tid >> 6;
    const int gtid = blockIdx.x * 512 + tid, gthreads = gridDim.x * 512;
    for (int e = gtid; e < 1984 * 1024; e += gthreads) {
        const int n = e >> 10, k = e & 1023; const int sc = src_col(1, n);
        const float ex = W[(size_t)k * 1984 + sc] * g[k]; const float st = bf2f(WT[(size_t)n * 1024 + k]);
        if (!(fabsf(st - ex) <= 0.01f * fabsf(ex) + 1e-5f)) atomicAdd(cnt + 8, 1u);
    }
    for (int row = blockIdx.x * 8 + wave; row < T; row += gridDim.x * 8) {
        int pos, seq; row_info(row, pos, seq);
        const float* xr = pos < 16 ? p.in[2] + (size_t)pos * 1024 : (seq < NBP ? p.in[0] + ((size_t)seq * 8192 + (pos - 16)) * 1024 : p.in[1] + ((size_t)(seq - NBP) * 2048 + (pos - 16)) * 1024);
        float ss = 0.f;
        for (int c = lane; c < 1024; c += 64) ss += xr[c] * xr[c];
        ss = wave_sum(ss);
        const float ex = rsqrtf(ss * (1.f / 1024.f) + EPS); const float st = R0[row];
        if (lane == 0 && !(fabsf(st - ex) <= 0.001f * ex)) { atomicAdd(cnt + 9, 1u); atomicAdd(cnt + 12, (unsigned)(row >> 6)); }
    }
}
#endif

#if DEBUG_CHECK == 10
__device__ __forceinline__ void check_x(const Params& p, int mode) {
    unsigned char* ws = launder(p.ws); unsigned* cnt = (unsigned*)(ws + OFF_DBGW); unsigned* sums = (unsigned*)(ws + OFF_DBGW + MiB);
    const int tid = tid_l(), lane = tid & 63, wave = tid >> 6;
    for (int n = blockIdx.x * 8 + wave; n < TN; n += gridDim.x * 8) {
        const unsigned* xr = (const unsigned*)(n < 65536 ? p.in[0] + (size_t)n * 1024 : p.in[1] + (size_t)(n - 65536) * 1024);
        unsigned a = 0u;
        for (int c = lane; c < 1024; c += 64) a += xr[c] * (2u * (unsigned)c + 1u);
#pragma unroll
        for (int o = 1; o < 64; o <<= 1) a += __shfl_xor(a, o);
        if (lane == 0) {
            if (mode == 0) __hip_atomic_store(sums + n, a, __ATOMIC_RELAXED, __HIP_MEMORY_SCOPE_AGENT);
            else if (__hip_atomic_load(sums + n, __ATOMIC_RELAXED, __HIP_MEMORY_SCOPE_AGENT) != a) atomicAdd(cnt + 8, 1u);
        }
    }
}
#endif

#if DEBUG_CHECK == 11
__device__ __forceinline__ void check_filt_prep(const Params& p) {
    unsigned char* ws = launder(p.ws); unsigned* cnt = (unsigned*)(ws + OFF_DBGW);
    const unsigned idx = blockIdx.x * 512u + (unsigned)tid_l();
    unsigned hsh = idx * 2654435761u + 1111u; hsh ^= hsh >> 15; hsh *= 2246822519u; hsh ^= hsh >> 13;
    {
        const int set = (int)(hsh & 1u); const int L = set ? LS : LP; const int C0 = set ? LGS : LGP;
        const int n = (int)((hsh >> 1) % 2048u); hsh = hsh * 3266489917u + 668265263u; hsh ^= hsh >> 16;
        const int t = (int)(hsh % (unsigned)L);
        const float* f_w1 = p.in[10]; const float* f_b1 = p.in[11]; const float* f_freq = p.in[12]; const float* f_w2 = p.in[13];
        const float* f_b2 = p.in[14]; const float* f_w3 = p.in[15]; const float* f_decay = p.in[16];
        const float tn = (float)t / (float)(L - 1); const float w = (6.2831853071795865f * (float)t) / (float)L;
        float acc = 0.f;
        for (int j2 = 0; j2 < 64; ++j2) {
            float a2 = f_b2[j2];
            for (int j1 = 0; j1 < 64; ++j1) {
                float a1 = f_b1[j1] + tn * f_w1[j1];
                for (int k = 0; k < 16; ++k) { const float f = 1e-4f + (float)k * ((15.0f - 1e-4f) / 15.0f); float sn, cs; sincos_red(f * w, sn, cs);
                    a1 += cs * f_w1[(1 + k) * 64 + j1] - sn * f_w1[(17 + k) * 64 + j1]; }
                a2 += sin_red(f_freq[j1] * a1) * f_w2[j1 * 64 + j2];
            }
            acc += sin_red(f_freq[j2] * a2) * f_w3[j2 * 2048 + n];
        }
        const float e = acc * __expf(-tn * fabsf(f_decay[n]));
        const int order = n >> 10, dir = (n >> 9) & 1, c = n & 511;
        if (!(dir == 1 && t == 0)) {
            const bf16_t* row = (const bf16_t*)(ws + (set ? OFF_GR1 : OFF_GR0)) + (size_t)(order * 512 + c) * (2 * C0);
            const float st = bf2f(row[dir ? C0 + t : C0 - t]);
            if (!(fabsf(st - e) <= 0.02f * fabsf(e) + 0.003f)) atomicAdd(cnt + 8, 1u);
        }
    }
    {
        const int seq = (int)(hsh % 40u); const int set = seq < NBP ? 0 : 1; const int L = set ? LS : LP; const int Lg = set ? LGS : LGP; const int NB = set ? NBS : NBP;
        const int b = set ? seq - NBP : seq; const int row0 = set ? TPR + b * LS : b * LP;
        hsh = hsh * 3266489917u + 668265263u; hsh ^= hsh >> 16;
        const int pos = (int)(hsh % (unsigned)L); const int which = (int)((hsh >> 16) % 3u); const int c = (int)((hsh >> 20) % 512u);
        const bf16_t* P = (const bf16_t*)(ws + OFF_P); const float* cw = p.in[9]; const int col = 448 + which * 512 + c;
        const float um = pos > 0 ? bf2f(P[(size_t)(row0 + pos - 1) * NPP + col]) : 0.f, u0 = bf2f(P[(size_t)(row0 + pos) * NPP + col]), up = pos + 1 < L ? bf2f(P[(size_t)(row0 + pos + 1) * NPP + col]) : 0.f;
        const float e = um * cw[which * 512 + c] + u0 * cw[1536 + which * 512 + c] + up * cw[3072 + which * 512 + c];
        const bf16_t* XT = (const bf16_t*)(ws + (which == 0 ? OFF_X1T : (which == 1 ? OFF_X2T : OFF_V0T))) + (set ? XT_SET1 : 0) + ((size_t)c * NB + b) * Lg;
        const float st = bf2f(XT[pos + 48]);
        if (!(fabsf(st - e) <= 0.02f * fabsf(e) + 0.02f)) atomicAdd(cnt + 9, 1u);
    }
}
#endif
#ifndef SUB_MASK
#define SUB_MASK 15
#endif
#ifndef PHASE_MASK
#define PHASE_MASK 1023
#endif
__global__ void __launch_bounds__(512) hymba_fwd(Params p) {
    extern __shared__ __attribute__((aligned(16))) unsigned char lds_raw[];
    LAS unsigned char* lds = (LAS unsigned char*)lds_raw;
    cg::grid_group grid = cg::this_grid();
#define GSYNC() do { asm volatile("s_waitcnt vmcnt(0) lgkmcnt(0)" ::: "memory"); grid.sync(); } while (0)
    const int G = gridDim.x;
    __builtin_amdgcn_fence(__ATOMIC_SEQ_CST, "agent");
    asm volatile("buffer_inv sc1\n\ts_waitcnt vmcnt(0)" ::: "memory");
#if DEBUG_CHECK == 10
    check_x(p, 0);
#endif
#if PHASE_MASK & 1
    p0_prologue(p, lds);
#endif
    GSYNC();
#if DEBUG_CHECK == 3
    check_h0b(p, 8);
#endif
#if DEBUG_CHECK == 7
    check_h0b_full(p, 8);
#endif
#if DEBUG_CHECK == 4
    check_stale(p, (const unsigned*)(launder(p.ws) + OFF_H0B), (unsigned)((size_t)T * 512), 9);
#endif
#if PHASE_MASK & 2
    {
        unsigned char* ws = launder(p.ws); unsigned char* ob = launder((unsigned char*)p.out);
        pg8::Gemm g{(const bf16_t*)(ws + OFF_H0B), (const bf16_t*)(ws + OFF_WIN), TPAD, 2048, 1024, 1024, 1024};
        pg8::StaticOrder S; S.init(TPAD, 2048, G, blockIdx.x);
        Epi<0> E{(bf16_t*)(ws + OFF_P), NPP, (const float*)(ws + OFF_R0), (float*)(ws + OFF_SQQP), (float*)(ws + OFF_SQKVP), (bf16_t*)(ob + DO_KR), (const float2*)(ws + OFF_RT)};
        pg8::gemm_phase(lds, g, S, E);
    }
#endif
    GSYNC();
#if DEBUG_CHECK == 1
    { unsigned char* ws = launder(p.ws); check_gemm((const bf16_t*)(ws + OFF_H0B), 1024, (const bf16_t*)(ws + OFF_WIN), 1024, 1024, T, 1984, 0, (const bf16_t*)(ws + OFF_P), NPP, (const float*)(ws + OFF_R0), (unsigned*)(ws + OFF_DBG) + 0, 448); }
    GSYNC();
#endif
#if DEBUG_CHECK == 3
    check_h0b(p, 9);
#endif
#if DEBUG_CHECK == 8
    check_p_golden(p);
#endif
#if DEBUG_CHECK == 9
    check_win_r0(p);
#endif
#if DEBUG_CHECK == 7
    check_h0b_full(p, 9);
    GSYNC();
#endif
#if DEBUG_CHECK == 6
    { unsigned char* ws = launder(p.ws);
      check_gemm((const bf16_t*)(ws + OFF_H0B), 1024, (const bf16_t*)(ws + OFF_WIN), 1024, 1024, T, 448, 0, (const bf16_t*)(ws + OFF_P), NPP, (const float*)(ws + OFF_R0), (unsigned*)(ws + OFF_DBG) + 8, 384);
      check_gemm((const bf16_t*)(ws + OFF_H0B), 1024, (const bf16_t*)(ws + OFF_WIN), 1024, 1024, T, 384, 7, (const bf16_t*)(ws + OFF_P), NPP, (const float*)(ws + OFF_R0), (unsigned*)(ws + OFF_DBG) + 9, 0); }
    GSYNC();
#endif
#if DEBUG_CHECK == 4
    check_stale(p, (const unsigned*)(launder(p.ws) + OFF_P), (unsigned)((size_t)T * 1024), 8);
#endif
    rownorm_phase(p);
    krope_phase(p);
    GSYNC();
#if (PHASE_MASK & 4) && (SUB2 & 1)
    {
        unsigned char* ws = launder(p.ws); unsigned char* ob = launder((unsigned char*)p.out);
        pg8::Gemm g{(const bf16_t*)(ws + OFF_P), (const bf16_t*)(ws + OFF_WUQ), TPAD, 768, 256, NPP, 256};
        pg8::StaticOrder S; S.init(TPAD, 768, G, blockIdx.x);
        Epi<1> E{(bf16_t*)(ob + DO_Q), 768, (const float*)(ws + OFF_RQ), nullptr, nullptr, nullptr, (const float2*)(ws + OFF_RT)};
        pg8::gemm_phase(lds, g, S, E);
    }
#endif
#if (PHASE_MASK & 4) && (SUB2 & 2)
    {
        unsigned char* ws = launder(p.ws); unsigned char* ob = launder((unsigned char*)p.out);
        pg8::Gemm g{(const bf16_t*)(ws + OFF_P) + 256, (const bf16_t*)(ws + OFF_WKN), TPAD, 512, 128, NPP, 128};
        pg8::StaticOrder S; S.init(TPAD, 512, G, blockIdx.x);
        Epi<2> E{(bf16_t*)(ob + DO_KN), 512, (const float*)(ws + OFF_RKV), nullptr, nullptr, nullptr, nullptr};
        pg8::gemm_phase(lds, g, S, E);
    }
#endif
#if (PHASE_MASK & 4) && (SUB2 & 4)
    {
        unsigned char* ws = launder(p.ws); unsigned char* ob = launder((unsigned char*)p.out);
        pg8::Gemm g{(const bf16_t*)(ws + OFF_WV), (const bf16_t*)(ws + OFF_P) + 256, 512, TPAD, 128, 128, NPP};
        pg8::StaticOrder S; S.init(512, TPAD, G, blockIdx.x);
        Epi<3> E{(bf16_t*)(ob + DO_VT), TPAD, (const float*)(ws + OFF_RKV), nullptr, nullptr, nullptr, nullptr};
        pg8::gemm_phase(lds, g, S, E);
    }
#endif
#if PHASE_MASK & 8
    hyprep_phase(p, lds);
#endif
    GSYNC();
#if DEBUG_CHECK == 2
    check_proj(p);
    GSYNC();
#endif
#if DEBUG_CHECK == 11
    check_filt_prep(p);
    GSYNC();
#endif
#if PHASE_MASK & 16
    attn_phase(p, lds);
#endif
#if PHASE_MASK & 32
    hyena_phase(p, lds);
#endif
    GSYNC();
#if DEBUG_CHECK == 5
    check_attn(p);
    check_hyena(p, lds);
    GSYNC();
#endif
#if PHASE_MASK & 64
    mixnorm_phase(p, lds);
#endif
    GSYNC();
#if PHASE_MASK & 128
    {
        unsigned char* ws = launder(p.ws);
        pg8::Gemm g{(const bf16_t*)(ws + OFF_MIXN), (const bf16_t*)(ws + OFF_WO), TN, 1024, 1024, 1024, 1024};
        pg8::StaticOrder S; S.init(TN, 1024, G, blockIdx.x);
        Epi<4> E{(bf16_t*)(ws + OFF_MIX), 1024, nullptr, (float*)(ws + OFF_SQMIXP), nullptr, nullptr, nullptr};
        pg8::gemm_phase(lds, g, S, E);
    }
#endif
    GSYNC();
#if DEBUG_CHECK == 1
    { unsigned char* ws = launder(p.ws); check_gemm((const bf16_t*)(ws + OFF_MIXN), 1024, (const bf16_t*)(ws + OFF_WO), 1024, 1024, TN, 1024, 4, (const bf16_t*)(ws + OFF_MIX), 1024, nullptr, (unsigned*)(ws + OFF_DBG) + 1, 0); }
#endif
#if DEBUG_CHECK == 10
    check_x(p, 1);
#endif
#if PHASE_MASK & 256
    h1_phase(p);
#endif
    GSYNC();
#if PHASE_MASK & 512
#if DEBUG_CHECK == 1
#define DBG_FF1(half) if ((half) == 0) { unsigned char* ws = launder(p.ws); check_gemm((const bf16_t*)(ws + OFF_H1B), 1024, (const bf16_t*)(ws + OFF_WF1), 1024, 1024, 65536, 4096, 5, (const bf16_t*)(ws + OFF_M), 4096, (const float*)(ws + OFF_R1), (unsigned*)(ws + OFF_DBG) + 2, 0); }
#define DBG_FF2(half) if ((half) == 0) { unsigned char* ws = launder(p.ws); check_gemm((const bf16_t*)(ws + OFF_M), 4096, (const bf16_t*)(ws + OFF_WF2), 4096, 4096, 65536, 1024, 6, (const bf16_t*)(ws + OFF_M2), 1024, nullptr, (unsigned*)(ws + OFF_DBG) + 3, 0); } GSYNC();
#else
#define DBG_FF1(half)
#define DBG_FF2(half)
#endif
#define FFN_HALF(half) \
    { \
        unsigned char* ws = launder(p.ws); \
        pg8::Gemm g{(const bf16_t*)(ws + OFF_H1B) + (size_t)(half) * 65536 * 1024, (const bf16_t*)(ws + OFF_WF1), 65536, 4096, 1024, 1024, 1024}; \
        pg8::StaticOrder S; S.init(65536, 4096, G, blockIdx.x); \
        Epi<5> E{(bf16_t*)(ws + OFF_M), 4096, (const float*)(ws + OFF_R1) + (half) * 65536, nullptr, nullptr, nullptr, nullptr}; \
        pg8::gemm_phase(lds, g, S, E); \
    } \
    GSYNC(); \
    DBG_FF1(half) \
    { \
        unsigned char* ws = launder(p.ws); \
        pg8::Gemm g{(const bf16_t*)(ws + OFF_M), (const bf16_t*)(ws + OFF_WF2), 65536, 1024, 4096, 4096, 4096}; \
        pg8::StaticOrder S; S.init(65536, 1024, G, blockIdx.x); \
        Epi<6> E{(bf16_t*)(ws + OFF_M2), 1024, nullptr, (float*)(ws + OFF_SQM2P) + (size_t)(half) * 65536 * 16, nullptr, nullptr, nullptr}; \
        pg8::gemm_phase(lds, g, S, E); \
    } \
    GSYNC(); \
    DBG_FF2(half) \
    final_phase(p, half);
    FFN_HALF(0)
    FFN_HALF(1)
#undef FFN_HALF
#endif
}

extern "C" void kernel_launch(void* const* d_in, const int* in_sizes, int n_in, void* d_out, int out_size, void* d_ws, size_t ws_size, hipStream_t stream) {
    static int grid = 0;
    if (grid == 0) {
        int dev = 0, cus = 0, per_cu = 0;
        hipGetDevice(&dev);
        hipDeviceGetAttribute(&cus, hipDeviceAttributeMultiprocessorCount, dev);
        hipFuncSetAttribute((const void*)hymba_fwd, hipFuncAttributeMaxDynamicSharedMemorySize, LDS_BYTES);
        hipOccupancyMaxActiveBlocksPerMultiprocessor(&per_cu, (const void*)hymba_fwd, 512, LDS_BYTES);
        if (per_cu < 1) per_cu = 1;
        grid = cus * 1;
        if (n_in != 26 || ws_size < 1024 * MiB) fprintf(stderr, "kernel_launch: unexpected n_in %d / ws_size %zu\n", n_in, ws_size);
    }
    Params p{};
    for (int i = 0; i < 26; ++i) p.in[i] = (const float*)d_in[i];
    p.out = (float*)d_out; p.ws = (unsigned char*)d_ws;
    void* args[] = {&p};
    hipError_t e = hipLaunchCooperativeKernel((const void*)hymba_fwd, dim3(grid), dim3(512), args, LDS_BYTES, stream);
    if (e != hipSuccess) fprintf(stderr, "cooperative launch failed: %s (grid %d)\n", hipGetErrorString(e), grid);
}
```

```cpp
#include <hip/hip_runtime.h>
#include <hip/hip_cooperative_groups.h>
#include <cstdio>
#include <cstdint>
namespace cg = cooperative_groups;
#ifndef DBG_SEL0
#define DBG_SEL0 3
#endif
#ifndef DBG_SEL1
#define DBG_SEL1 0
#endif
#ifndef DEBUG_CHECK
#define DEBUG_CHECK 0
#endif
#ifndef EXPT
#define EXPT 0
#endif
#ifndef SUB_MASK
#define SUB_MASK 15
#endif
#ifndef SUB2
#define SUB2 7
#endif

#define LAS __attribute__((address_space(3)))
#define GAS __attribute__((address_space(1)))
typedef unsigned short bf16_t;
typedef short bf16x8 __attribute__((ext_vector_type(8)));
typedef float f32x4 __attribute__((ext_vector_type(4)));
typedef float f32x16 __attribute__((ext_vector_type(16)));
typedef unsigned u32x4 __attribute__((ext_vector_type(4)));
typedef unsigned u32x2 __attribute__((ext_vector_type(2)));

constexpr int DM = 1024, LP = 8208, LS = 2064, NBP = 8, NBS = 32;
constexpr int TPR = NBP * LP;
constexpr int TSR = NBS * LS;
constexpr int T = TPR + TSR;
constexpr int TPAD = 131840;
constexpr int TN = 131072;
constexpr int NPP = 2048;
constexpr int LGP = 8256, LGS = 2112;
constexpr float EPS = 1e-6f;
constexpr float QSCALE = 0.07216878364870322f * 1.4426950408889634f;

constexpr size_t MiB = 1ull << 20;
constexpr size_t OFF_H0B = 0;
constexpr size_t XT_SET1 = (size_t)512 * NBP * LGP;
constexpr size_t OFF_X1T = 0;
constexpr size_t OFF_X2T = 131 * MiB;
constexpr size_t OFF_P = 262 * MiB;
constexpr size_t OFF_V0T = 778 * MiB;
constexpr size_t OFF_MIXN = 262 * MiB;
constexpr size_t OFF_MIX = 518 * MiB;
constexpr size_t OFF_H1B = 0;
constexpr size_t OFF_M = 256 * MiB;
constexpr size_t OFF_M2 = 768 * MiB;
constexpr size_t OFF_SQMIXP = 896 * MiB;
constexpr size_t OFF_SQM2P = 904 * MiB;
constexpr size_t OFF_SMALL = 912 * MiB;
constexpr size_t OFF_WIN = OFF_SMALL;
constexpr size_t OFF_WUQ = OFF_SMALL + 4 * MiB;
constexpr size_t OFF_WKN = OFF_SMALL + 4 * MiB + 512 * 1024;
constexpr size_t OFF_WV = OFF_SMALL + 4 * MiB + 768 * 1024;
constexpr size_t OFF_WO = OFF_SMALL + 5 * MiB;
constexpr size_t OFF_WF1 = OFF_SMALL + 7 * MiB;
constexpr size_t OFF_WF2 = OFF_SMALL + 15 * MiB;
constexpr size_t OFF_GR0 = OFF_SMALL + 23 * MiB;
constexpr size_t OFF_GR1 = OFF_SMALL + 56 * MiB;
constexpr size_t OFF_RT = OFF_SMALL + 65 * MiB;
constexpr size_t OFF_R0 = OFF_SMALL + 68 * MiB;
constexpr size_t OFF_R1 = OFF_SMALL + 69 * MiB;
constexpr size_t OFF_RQ = OFF_SMALL + 70 * MiB;
constexpr size_t OFF_RKV = OFF_SMALL + 71 * MiB;
constexpr size_t OFF_SQQP = OFF_SMALL + 72 * MiB;
constexpr size_t OFF_SQKVP = OFF_SMALL + 75 * MiB;
constexpr size_t OFF_DBGW = OFF_SMALL + 78 * MiB;
constexpr size_t DO_Q = 0;
constexpr size_t DO_KN = 194 * MiB;
constexpr size_t DO_KR = 323 * MiB;
constexpr size_t DO_VT = 340 * MiB;

constexpr size_t OFF_ODBG = 518 * MiB;
constexpr size_t OFF_HDBG = 647 * MiB;
constexpr int LDS_BYTES = 147456;

struct Params {
    const float* in[26];
    float* out;
    unsigned char* ws;
};

__device__ __forceinline__ f32x4 ld_sys(const float* q) { f32x4 v; asm volatile("global_load_dwordx4 %0, %1, off sc0 sc1\n\ts_waitcnt vmcnt(0)" : "=v"(v) : "v"(q) : "memory"); return v; }
typedef float f32x2_ld __attribute__((ext_vector_type(2)));
__device__ __forceinline__ float ldco(const float* q) { return *(const GAS float*)q; }
__device__ __forceinline__ float2 ldco2(const float2* q) { const f32x2_ld v = *(const GAS f32x2_ld*)q; return make_float2(v[0], v[1]); }
template <class Tp> __device__ __forceinline__ Tp* launder(Tp* q) { asm volatile("" : "+s"(q)); return q; }
__device__ __forceinline__ int tid_l() { int t = threadIdx.x; asm volatile("" : "+v"(t)); return t; }
__device__ __forceinline__ unsigned cvt_pk_bf16(float lo, float hi) { unsigned r; asm volatile("v_cvt_pk_bf16_f32 %0, %1, %2" : "=v"(r) : "v"(lo), "v"(hi)); return r; }
__device__ __forceinline__ float bf2f(unsigned short b) { return __builtin_bit_cast(float, (unsigned)b << 16); }
__device__ __forceinline__ float bflo(unsigned w) { return __builtin_bit_cast(float, w << 16); }
__device__ __forceinline__ float bfhi(unsigned w) { return __builtin_bit_cast(float, w & 0xffff0000u); }
__device__ __forceinline__ float wave_sum(float v) {
#pragma unroll
    for (int o = 1; o < 64; o <<= 1) v += __shfl_xor(v, o);
    return v;
}
__device__ __forceinline__ void sincos_red(float x, float& s, float& c) {
    const double xd = (double)x; const double k = rint(xd * 0.15915494309189535); const float r = (float)(xd - k * 6.283185307179586);
    s = __sinf(r); c = __cosf(r);
}
__device__ __forceinline__ float sin_red(float x) { float s, c; sincos_red(x, s, c); return s; }
__device__ __forceinline__ void row_info(int r, int& pos, int& seq) {
    if (r < TPR) { seq = r / LP; pos = r - seq * LP; }
    else { int q = r - TPR; if (q >= TSR) q = TSR - 1; const int b = q / LS; pos = q - b * LS; seq = NBP + b; }
}
__device__ __forceinline__ int full_row(int n) {
    if (n < 65536) { const int b = n >> 13; return b * LP + 16 + (n & 8191); }
    const int q = n - 65536; const int b = q >> 11; return TPR + b * LS + 16 + (q & 2047);
}

namespace pg8 {
constexpr int BM = 256, BK = 64, HALF = 128, HTB = HALF * BK * 2, STAGE_BYTES = 8 * HTB, NXCD = 8, WGM = 8;
__host__ __device__ __forceinline__ int lds_byte(int r, int c) { const int st = (r >> 4) * 2 + (c >> 5), rr = r & 15, cc = c & 31, ob = rr * 64 + cc * 2; return st * 1024 + (ob ^ (((ob >> 9) & 1) << 5)); }
__host__ __device__ __forceinline__ void stage_rc(int b, int& R, int& C) { const int st = b / 1024, sb = b % 1024, swz = sb ^ (((sb >> 9) & 1) << 5); R = (st >> 1) * 16 + swz / 64; C = (st & 1) * 32 + (swz % 64) / 2; }
__host__ __device__ __forceinline__ int perm32(int rho) { const int n = rho >> 4, i = rho & 15; return 8 * (i >> 2) + 4 * n + (i & 3); }
struct Unit { int pm, pn; };
struct Gemm { const bf16_t* A; const bf16_t* Bt; int M, N, K, lda, ldb; };
struct StaticOrder {
    int nM, nN, nwg, G, c;
    __device__ void init(int M, int N, int G_, int c_) { nM = M / BM; nN = N / BM; nwg = nM * nN; G = G_; c = c_; }
    __device__ bool next(int i, Unit& u) const {
        const long L = (long)i * G + c; if (L >= nwg) return false;
        int wgid = (int)L; { const int q = nwg / NXCD, r = nwg % NXCD, xcd = wgid % NXCD, off = wgid / NXCD; wgid = (xcd < r ? xcd * (q + 1) : r * (q + 1) + (xcd - r) * q) + off; }
        const int nig = WGM * nN, gid = wgid / nig, fm = gid * WGM, gsz = (nM - fm) < WGM ? (nM - fm) : WGM;
        u.pm = fm + ((wgid % nig) % gsz); u.pn = (wgid % nig) / gsz; return true;
    }
};
template <class Epi>
__device__ __forceinline__ void gemm_phase(LAS unsigned char* lds, const Gemm g, const StaticOrder& S, const Epi& E) {
    const int tid = tid_l(), wid = __builtin_amdgcn_readfirstlane(tid >> 6), lane = tid & 63, wr = wid >> 2, wc = wid & 3, fr = lane & 15, fq = lane >> 4;
    const int K = g.K, nt = K / BK;
    unsigned voffA[2], voffB[2];
#pragma unroll
    for (int i = 0; i < 2; ++i) { int R, C; stage_rc(tid * 16 + i * 8192, R, C); const int Rb = (R & ~31) + perm32(R & 31);
        voffA[i] = (unsigned)(R * g.lda + C) * 2u; voffB[i] = (unsigned)(Rb * g.ldb + C) * 2u; }
    const size_t kstep = (size_t)(BK * 2);
    const size_t hstepA = (size_t)HALF * g.lda * 2, hstepB = (size_t)HALF * g.ldb * 2;
    const size_t tstepA = 2 * hstepA, tstepB = 2 * hstepB;
    const unsigned ldsw = (unsigned)wid * 1024u;
    const int aoff = lds_byte(wr * 64 + fr, fq * 8), boff = lds_byte(wc * 32 + fr, fq * 8);
#define PG8_SA(b, h) (((b) * 2 + (h)) * HTB)
#define PG8_SB(b, h) ((4 + (b) * 2 + (h)) * HTB)
#define PG8_STAGE(bufoff, gbase, voff) do { _Pragma("unroll") for (int _i = 0; _i < 2; ++_i) \
        __builtin_amdgcn_global_load_lds((const unsigned*)((const char*)(gbase) + (voff)[_i]), (LAS unsigned*)(lds + (bufoff) + ldsw + _i * 8192), 16, 0, 0); } while (0)
#define PG8_LDA(dst, b, h) do { _Pragma("unroll") for (int m = 0; m < 4; ++m) _Pragma("unroll") for (int k = 0; k < 2; ++k) dst[m][k] = *(const LAS bf16x8*)(lds + PG8_SA(b, h) + aoff + m * 2048 + k * 1024); } while (0)
#define PG8_LDB(dst, b, h) do { _Pragma("unroll") for (int n = 0; n < 2; ++n) _Pragma("unroll") for (int k = 0; k < 2; ++k) dst[n][k] = *(const LAS bf16x8*)(lds + PG8_SB(b, h) + boff + n * 2048 + k * 1024); } while (0)
#define PG8_MMA(ai, bj, At, Bt) do { __builtin_amdgcn_s_setprio(1); _Pragma("unroll") for (int m = 0; m < 4; ++m) _Pragma("unroll") for (int n = 0; n < 2; ++n) _Pragma("unroll") for (int k = 0; k < 2; ++k) \
        acc[ai][bj][m][n] = __builtin_amdgcn_mfma_f32_16x16x32_bf16(Bt[n][k], At[m][k], acc[ai][bj][m][n], 0, 0, 0); __builtin_amdgcn_s_setprio(0); } while (0)
#define PG8_WAIT_V(n) asm volatile("s_waitcnt vmcnt(" #n ")" ::: "memory")
#define PG8_WAIT_L(n) asm volatile("s_waitcnt lgkmcnt(" #n ")" ::: "memory")
#define PG8_BAR __builtin_amdgcn_s_barrier()
#define PG8_SCHED __builtin_amdgcn_sched_barrier(0)
    Unit cur, nxt; int ui = 0;
    if (!S.next(0, cur)) return;
    f32x4 acc[2][2][4][2];
#pragma unroll
    for (int a = 0; a < 2; ++a)
#pragma unroll
        for (int b = 0; b < 2; ++b)
#pragma unroll
            for (int m = 0; m < 4; ++m)
#pragma unroll
                for (int n = 0; n < 2; ++n) acc[a][b][m][n] = (f32x4){0.f, 0.f, 0.f, 0.f};
    bf16x8 At[4][2], B0[2][2], B1[2][2];
    const char* cA = (const char*)g.A + (size_t)cur.pm * tstepA; const char* cB = (const char*)g.Bt + (size_t)cur.pn * tstepB;
    PG8_STAGE(PG8_SB(0, 0), cB, voffB); PG8_STAGE(PG8_SB(0, 1), cB + hstepB, voffB); PG8_STAGE(PG8_SA(0, 0), cA, voffA); PG8_STAGE(PG8_SA(0, 1), cA + hstepA, voffA);
    if (wr == 1) PG8_BAR;
    PG8_WAIT_V(2); PG8_BAR;
    PG8_STAGE(PG8_SB(1, 0), cB + kstep, voffB); PG8_STAGE(PG8_SA(1, 0), cA + kstep, voffA); PG8_STAGE(PG8_SB(1, 1), cB + hstepB + kstep, voffB);
    PG8_WAIT_V(6); PG8_BAR;
    for (;;) {
        const bool has_next = S.next(ui + 1, nxt);
        const char* nA = has_next ? (const char*)g.A + (size_t)nxt.pm * tstepA : cA; const char* nB = has_next ? (const char*)g.Bt + (size_t)nxt.pn * tstepB : cB;
        for (int t = 0; t < nt; t += 2) {
            const bool last = (t == nt - 2);
            const char* a1 = cA + (size_t)(t + 1) * kstep;
            const char* a2 = last ? nA : cA + (size_t)(t + 2) * kstep; const char* b2 = last ? nB : cB + (size_t)(t + 2) * kstep;
            const char* a3 = a2 + kstep; const char* b3 = b2 + kstep;
            PG8_LDB(B0, 0, 0); PG8_LDB(B1, 0, 1); PG8_SCHED; PG8_LDA(At, 0, 0); PG8_STAGE(PG8_SA(1, 1), a1 + hstepA, voffA);
            PG8_WAIT_V(8); PG8_WAIT_L(0); PG8_BAR; PG8_MMA(0, 0, At, B0); PG8_MMA(0, 1, At, B1); PG8_BAR; PG8_SCHED;
            PG8_LDA(At, 0, 1); PG8_STAGE(PG8_SB(0, 0), b2, voffB); PG8_STAGE(PG8_SB(0, 1), b2 + hstepB, voffB); PG8_STAGE(PG8_SA(0, 0), a2, voffA);
            PG8_WAIT_V(8); PG8_WAIT_L(0); PG8_BAR; PG8_MMA(1, 0, At, B0); PG8_MMA(1, 1, At, B1); PG8_BAR; PG8_SCHED;
            PG8_LDB(B0, 1, 0); PG8_LDB(B1, 1, 1); PG8_SCHED; PG8_LDA(At, 1, 0); PG8_STAGE(PG8_SA(0, 1), a2 + hstepA, voffA);
            PG8_WAIT_V(8); PG8_WAIT_L(0); PG8_BAR; PG8_MMA(0, 0, At, B0); PG8_MMA(0, 1, At, B1); PG8_BAR; PG8_SCHED;
            PG8_LDA(At, 1, 1); PG8_STAGE(PG8_SB(1, 0), b3, voffB); PG8_STAGE(PG8_SB(1, 1), b3 + hstepB, voffB); PG8_STAGE(PG8_SA(1, 0), a3, voffA);
            PG8_WAIT_V(8); PG8_WAIT_L(0); PG8_BAR; PG8_MMA(1, 0, At, B0); PG8_MMA(1, 1, At, B1); PG8_BAR; PG8_SCHED;
        }
        if (wr == 0) PG8_BAR;
        E(acc, cur, wr, wc, fr, fq);
        if (!has_next) break;
#pragma unroll
        for (int a = 0; a < 2; ++a)
#pragma unroll
            for (int b = 0; b < 2; ++b)
#pragma unroll
                for (int m = 0; m < 4; ++m)
#pragma unroll
                    for (int n = 0; n < 2; ++n) acc[a][b][m][n] = (f32x4){0.f, 0.f, 0.f, 0.f};
        cur = nxt; cA = nA; cB = nB; ++ui;
        if (wr == 1) PG8_BAR;
    }
    PG8_WAIT_V(0);
    PG8_BAR;
#undef PG8_SA
#undef PG8_SB
#undef PG8_STAGE
#undef PG8_LDA
#undef PG8_LDB
#undef PG8_MMA
#undef PG8_WAIT_V
#undef PG8_WAIT_L
#undef PG8_BAR
#undef PG8_SCHED
}
}

__device__ __forceinline__ void rope8(f32x4& v0, f32x4& v1, const float2* rt  ) {
    const float2 c0 = ldco2(rt), c1 = ldco2(rt + 1), c2 = ldco2(rt + 2), c3 = ldco2(rt + 3);
    float a, b;
    a = v0[0]; b = v0[1]; v0[0] = a * c0.x - b * c0.y; v0[1] = b * c0.x + a * c0.y;
    a = v0[2]; b = v0[3]; v0[2] = a * c1.x - b * c1.y; v0[3] = b * c1.x + a * c1.y;
    a = v1[0]; b = v1[1]; v1[0] = a * c2.x - b * c2.y; v1[1] = b * c2.x + a * c2.y;
    a = v1[2]; b = v1[3]; v1[2] = a * c3.x - b * c3.y; v1[3] = b * c3.x + a * c3.y;
}
__device__ __forceinline__ u32x4 pack8(const f32x4& v0, const f32x4& v1) {
    u32x4 w; w.x = cvt_pk_bf16(v0[0], v0[1]); w.y = cvt_pk_bf16(v0[2], v0[3]); w.z = cvt_pk_bf16(v1[0], v1[1]); w.w = cvt_pk_bf16(v1[2], v1[3]); return w;
}
__device__ __forceinline__ float sq8(const f32x4& a, const f32x4& b) {
    return (a[0] * a[0] + a[1] * a[1]) + (a[2] * a[2] + a[3] * a[3]) + (b[0] * b[0] + b[1] * b[1]) + (b[2] * b[2] + b[3] * b[3]);
}
template <int MODE> struct Epi {
    bf16_t* O; int ldc; const float* rs; float* sq0; float* sq1; bf16_t* KR; const float2* RT;
    __device__ __forceinline__ void operator()(const f32x4 (&acc)[2][2][4][2], const pg8::Unit& u, int wr, int wc, int fr, int fq) const {
#pragma unroll
        for (int ai = 0; ai < 2; ++ai)
#pragma unroll
            for (int m = 0; m < 4; ++m) {
                const int row = u.pm * 256 + ai * 128 + wr * 64 + m * 16 + fr;
                float sc = 1.f;
                if (MODE == 0 || MODE == 1 || MODE == 2 || MODE == 5) sc = ldco(rs + row);
                float ssum[2];
#pragma unroll
                for (int bj = 0; bj < 2; ++bj) {
                    const int col0 = u.pn * 256 + bj * 128 + wc * 32 + 8 * fq;
                    f32x4 v0 = acc[ai][bj][m][0] * sc, v1 = acc[ai][bj][m][1] * sc;
                    if (MODE == 3) {
#pragma unroll
                        for (int j = 0; j < 4; ++j) { v0[j] *= ldco(rs + col0 + j); v1[j] *= ldco(rs + col0 + 4 + j); }
                    }
                    if (MODE == 5) {
#pragma unroll
                        for (int j = 0; j < 4; ++j) { const float a = fmaxf(v0[j], 0.f), b = fmaxf(v1[j], 0.f); v0[j] = a * a; v1[j] = b * b; }
                    }
                    ssum[bj] = sq8(v0, v1);
                    *(u32x4*)(O + (size_t)row * ldc + col0) = pack8(v0, v1);
                }
                if (MODE == 0) {
                    if (u.pn == 0) { float s = ssum[0] + ssum[1]; s += __shfl_xor(s, 16); s += __shfl_xor(s, 32); if (fq == 0) sq0[row * 4 + wc] = s; }
                    else if (u.pn == 1) { float s = ssum[0]; s += __shfl_xor(s, 16); s += __shfl_xor(s, 32); if (fq == 0) sq1[row * 4 + wc] = s; }
                }
                if (MODE == 4 || MODE == 6) { float s = ssum[0] + ssum[1]; s += __shfl_xor(s, 16); s += __shfl_xor(s, 32); if (fq == 0) sq0[(size_t)row * 16 + u.pn * 4 + wc] = s; }
            }
    }
};

__device__ __forceinline__ int src_col(int mode, int n) {
    if (mode == 0) return n;
    if (mode == 1) { if (n >= 1984) return -1; if (n >= 384 && n < 448) { const int j = n - 384; return 384 + ((j & 1) ? 32 + (j >> 1) : (j >> 1)); } return n; }
    if (mode == 2) { const int h = n / 192, w = n % 192; if (w < 128) return n; const int j = w - 128; return h * 192 + 128 + ((j & 1) ? 32 + (j >> 1) : (j >> 1)); }
    if (mode == 3) return (n >> 7) * 256 + (n & 127);
    return (n >> 7) * 256 + 128 + (n & 127);
}
__device__ __forceinline__ void conv_weight(const float* W, const float* g, bf16_t* out, int K, int Nsrc, int Nout, int mode, int gtid, int gthreads) {
    const int nch = Nout * (K / 8);
    for (int e = gtid; e < nch; e += gthreads) {
        const int n = e % Nout, kc = e / Nout, k0 = kc * 8; const int sc = src_col(mode, n);
        float v[8];
#pragma unroll
        for (int j = 0; j < 8; ++j) v[j] = (sc >= 0) ? W[(size_t)(k0 + j) * Nsrc + sc] * (g ? g[k0 + j] : 1.f) : 0.f;
        u32x4 w; w.x = cvt_pk_bf16(v[0], v[1]); w.y = cvt_pk_bf16(v[2], v[3]); w.z = cvt_pk_bf16(v[4], v[5]); w.w = cvt_pk_bf16(v[6], v[7]);
        *(u32x4*)(out + (size_t)n * K + k0) = w;
    }
}

__device__ __forceinline__ void p0_prologue(const Params& p, LAS unsigned char* lds) {
    unsigned char* ws = launder(p.ws);
    const int tid = tid_l(), lane = tid & 63, wave = tid >> 6, G = gridDim.x;
    const int gtid = blockIdx.x * 512 + tid, gthreads = G * 512;
    const int gw = blockIdx.x * 8 + wave, NGW = G * 8;
#if SUB_MASK & 1
    conv_weight(p.in[4], p.in[3], (bf16_t*)(ws + OFF_WIN), 1024, 1984, 2048, 1, gtid, gthreads);
    conv_weight(p.in[6], p.in[5], (bf16_t*)(ws + OFF_WUQ), 256, 768, 768, 2, gtid, gthreads);
    conv_weight(p.in[8], p.in[7], (bf16_t*)(ws + OFF_WKN), 128, 1024, 512, 3, gtid, gthreads);
    conv_weight(p.in[8], p.in[7], (bf16_t*)(ws + OFF_WV), 128, 1024, 512, 4, gtid, gthreads);
    conv_weight(p.in[20], nullptr, (bf16_t*)(ws + OFF_WO), 1024, 1024, 1024, 0, gtid, gthreads);
    conv_weight(p.in[23], p.in[22], (bf16_t*)(ws + OFF_WF1), 1024, 4096, 4096, 0, gtid, gthreads);
    conv_weight(p.in[24], nullptr, (bf16_t*)(ws + OFF_WF2), 4096, 1024, 1024, 0, gtid, gthreads);
#endif
#if SUB_MASK & 2
#if DEBUG_CHECK
    if (blockIdx.x == 0 && tid < 64) ((unsigned*)(ws + OFF_DBGW))[tid] = 0u;
#endif
    {
        float2* RT = (float2*)(ws + OFF_RT);
        for (int e = gtid; e < LP * 32; e += gthreads) {
            const int pos = e >> 5, i = e & 31;
            const float inv = 1.0f / exp2f((float)i * (13.287712379549449f / 32.f));
            float s, c; sincos_red((float)pos * inv, s, c);
            RT[e] = make_float2(c, s);
        }
    }
#endif
#if SUB_MASK & 4
    {
        bf16_t* h0b = (bf16_t*)(ws + OFF_H0B); float* r0 = (float*)(ws + OFF_R0);
        for (int r = gw; r < TPAD; r += NGW) {
            u32x2* o = (u32x2*)(h0b + (size_t)r * 1024) + lane;
            if (r >= T) {
#pragma unroll
                for (int j = 0; j < 4; ++j) o[64 * j] = (u32x2){0u, 0u};
                if (lane == 0) __hip_atomic_store(r0 + r, 0.f, __ATOMIC_RELAXED, __HIP_MEMORY_SCOPE_AGENT);
                continue;
            }
            int pos, seq; row_info(r, pos, seq);
            const float* src = pos < 16 ? p.in[2] + (size_t)pos * 1024
                                        : (seq < NBP ? p.in[0] + ((size_t)seq * 8192 + (pos - 16)) * 1024 : p.in[1] + ((size_t)(seq - NBP) * 2048 + (pos - 16)) * 1024);
            const f32x4* xr = (const f32x4*)src + lane;
            f32x4 v[4]; float ss = 0.f;
#pragma unroll
            for (int j = 0; j < 4; ++j) { v[j] = xr[64 * j]; ss += (v[j][0] * v[j][0] + v[j][1] * v[j][1]) + (v[j][2] * v[j][2] + v[j][3] * v[j][3]); }
            ss = wave_sum(ss);
#pragma unroll
            for (int j = 0; j < 4; ++j) o[64 * j] = (u32x2){cvt_pk_bf16(v[j][0], v[j][1]), cvt_pk_bf16(v[j][2], v[j][3])};
            if (lane == 0) __hip_atomic_store(r0 + r, rsqrtf(ss * (1.f / 1024.f) + EPS), __ATOMIC_RELAXED, __HIP_MEMORY_SCOPE_AGENT);
        }
    }
#endif
#if SUB_MASK & 8
    {
        const float* f_w1 = p.in[10]; const float* f_b1 = p.in[11]; const float* f_freq = p.in[12]; const float* f_w2 = p.in[13];
        const float* f_b2 = p.in[14]; const float* f_w3 = p.in[15]; const float* f_decay = p.in[16];
        LAS float* feats = (LAS float*)lds;
        LAS float* h1 = feats + 16 * 34;
        LAS float* h2 = h1 + 16 * 64;
        for (int u = blockIdx.x; u < 513 + 129; u += G) {
            const int set = u < 513 ? 0 : 1; const int t0 = 16 * (set ? u - 513 : u); const int L = set ? LS : LP; const int C0 = set ? LGS : LGP;
            bf16_t* GR = (bf16_t*)(ws + (set ? OFF_GR1 : OFF_GR0));
            const float invLm1 = 1.0f / (float)(L - 1);
            if (tid < 256) {
                const int tt = tid >> 4, k = tid & 15; const int t = t0 + tt;
                const float w = (6.2831853071795865f * (float)t) / (float)L;
                const float f = 1e-4f + (float)k * ((15.0f - 1e-4f) / 15.0f);
                float s, c; sincos_red(f * w, s, c);
                feats[tt * 34 + 1 + k] = c; feats[tt * 34 + 17 + k] = -s;
                if (k == 0) feats[tt * 34] = (float)t * invLm1;
            }
            __syncthreads();
#pragma unroll 1
            for (int q = 0; q < 2; ++q) {
                const int o = tid + 512 * q, tt = o >> 6, j = o & 63;
                float a = f_b1[j];
#pragma unroll 3
                for (int e = 0; e < 33; ++e) a += feats[tt * 34 + e] * f_w1[e * 64 + j];
                h1[tt * 64 + j] = sin_red(f_freq[j] * a);
            }
            __syncthreads();
#pragma unroll 1
            for (int q = 0; q < 2; ++q) {
                const int o = tid + 512 * q, tt = o >> 6, j = o & 63;
                float a = f_b2[j];
#pragma unroll 4
                for (int e = 0; e < 64; ++e) a += h1[tt * 64 + e] * f_w2[e * 64 + j];
                h2[tt * 64 + j] = sin_red(f_freq[j] * a);
            }
            __syncthreads();
            {
                float a[4][16];
#pragma unroll
                for (int q = 0; q < 4; ++q)
#pragma unroll
                    for (int i = 0; i < 16; ++i) a[q][i] = 0.f;
#pragma unroll 2
                for (int j = 0; j < 64; ++j) {
                    float hv[16];
#pragma unroll
                    for (int i = 0; i < 16; ++i) hv[i] = h2[i * 64 + j];
#pragma unroll
                    for (int q = 0; q < 4; ++q) {
                        const float w = f_w3[j * 2048 + tid + 512 * q];
#pragma unroll
                        for (int i = 0; i < 16; ++i) a[q][i] += hv[i] * w;
                    }
                }
#pragma unroll
                for (int q = 0; q < 4; ++q) {
                    const int n = tid + 512 * q;
                    const float dec = fabsf(f_decay[n]);
                    const int order = n >> 10, dir = (n >> 9) & 1, c = n & 511;
                    bf16_t* row = GR + (size_t)(order * 512 + c) * (2 * C0);
#pragma unroll
                    for (int i = 0; i < 16; ++i) {
                        const int t = t0 + i;
                        const float val = a[q][i] * __expf(-((float)t * invLm1) * dec);
                        const unsigned short b = (unsigned short)(cvt_pk_bf16(val, 0.f) & 0xffffu);
                        if (dir == 0) row[C0 - t] = b; else if (t > 0) row[C0 + t] = b;
                    }
                }
            }
            __syncthreads();
        }
        for (int e = gtid; e < 2 * 1024 * 97; e += gthreads) {
            const int set = e / (1024 * 97), r = (e / 97) % 1024, i = e % 97; const int L = set ? LS : LP; const int C0 = set ? LGS : LGP;
            bf16_t* row = (bf16_t*)(ws + (set ? OFF_GR1 : OFF_GR0)) + (size_t)r * (2 * C0);
            const int idx = i < 49 ? i : C0 + L + (i - 49);
            row[idx] = 0;
        }
    }
#endif
}

__device__ __forceinline__ void rownorm_phase(const Params& p) {
    unsigned char* ws = launder(p.ws); const int gtid = blockIdx.x * 512 + tid_l(), gthreads = gridDim.x * 512;
    const float* sqq = (const float*)(ws + OFF_SQQP); const float* sqkv = (const float*)(ws + OFF_SQKVP);
    float* rq = (float*)(ws + OFF_RQ); float* rkv = (float*)(ws + OFF_RKV);
    for (int r = gtid; r < TPAD; r += gthreads) {
        const float a = (ldco(sqq + r * 4) + ldco(sqq + r * 4 + 1)) + (ldco(sqq + r * 4 + 2) + ldco(sqq + r * 4 + 3));
        const float b = (ldco(sqkv + r * 4) + ldco(sqkv + r * 4 + 1)) + (ldco(sqkv + r * 4 + 2) + ldco(sqkv + r * 4 + 3));
        rq[r] = rsqrtf(a * (1.f / 256.f) + EPS) * QSCALE; rkv[r] = rsqrtf(b * (1.f / 128.f) + EPS);
    }
}
__device__ __forceinline__ void krope_phase(const Params& p) {
    unsigned char* ws = launder(p.ws); unsigned char* ob = launder((unsigned char*)p.out);
    const int gtid = blockIdx.x * 512 + tid_l(), gthreads = gridDim.x * 512;
    const bf16_t* P = (const bf16_t*)(ws + OFF_P); bf16_t* KR = (bf16_t*)(ob + DO_KR); const float2* RT = (const float2*)(ws + OFF_RT);
    for (int e = gtid; e < TPAD * 8; e += gthreads) {
        const int row = e >> 3, ch = e & 7;
        int pos, seq; row_info(row, pos, seq);
        const u32x4 v = *(const u32x4*)(P + (size_t)row * NPP + 384 + ch * 8);
        f32x4 v0 = (f32x4){bflo(v.x), bfhi(v.x), bflo(v.y), bfhi(v.y)}, v1 = (f32x4){bflo(v.z), bfhi(v.z), bflo(v.w), bfhi(v.w)};
        rope8(v0, v1, RT + pos * 32 + ch * 4);
        *(u32x4*)(KR + (size_t)row * 64 + ch * 8) = pack8(v0, v1);
    }
}
__device__ __forceinline__ void hyprep_phase(const Params& p, LAS unsigned char* lds) {
    unsigned char* ws = launder(p.ws); const int tid = tid_l(), G = gridDim.x;
    const bf16_t* P = (const bf16_t*)(ws + OFF_P); const float* conv_w = p.in[9];
    constexpr int RSB = 1040;
    for (int u = blockIdx.x; u < 3096 + 3168; u += G) {
        int seq, j, which;
        if (u < 3096) { seq = u / 387; const int rem = u % 387; j = rem / 3; which = rem % 3; }
        else { const int v = u - 3096; seq = NBP + v / 99; const int rem = v % 99; j = rem / 3; which = rem % 3; }
        const int set = seq < NBP ? 0 : 1; const int L = set ? LS : LP; const int Lg = set ? LGS : LGP; const int NB = set ? NBS : NBP;
        const int b = set ? seq - NBP : seq; const int row0 = set ? TPR + b * LS : b * LP;
        const int posb = 64 * j - 49;
        for (int i = 0; i < 9; ++i) {
            const int id = tid + 512 * i; if (id >= 66 * 64) break;
            const int rr = id >> 6, ch = id & 63; const int pos = posb + rr;
            u32x4 v = (u32x4){0u, 0u, 0u, 0u};
            if (pos >= 0 && pos < L) v = *(const GAS u32x4*)(P + (size_t)(row0 + pos) * NPP + 448 + which * 512 + ch * 8);
            *(LAS u32x4*)(lds + rr * RSB + ch * 16) = v;
        }
        __syncthreads();
        {
            const int c = tid; const float w0 = conv_w[which * 512 + c], w1 = conv_w[1536 + which * 512 + c], w2 = conv_w[3072 + which * 512 + c];
            bf16_t* XT = (bf16_t*)(ws + (which == 0 ? OFF_X1T : (which == 1 ? OFF_X2T : OFF_V0T))) + (set ? XT_SET1 : 0) + ((size_t)c * NB + b) * Lg + 64 * j;
            const LAS unsigned short* tl = (const LAS unsigned short*)lds + c;
            float prev = bf2f(tl[0]), cur = bf2f(tl[RSB / 2]);
            for (int o8 = 0; o8 < 8; ++o8) {
                float r[8];
#pragma unroll
                for (int k = 0; k < 8; ++k) {
                    const int o = o8 * 8 + k; const float nxt = bf2f(tl[(o + 2) * (RSB / 2)]);
                    const int pos = posb + 1 + o;
                    r[k] = (pos >= 0 && pos < L) ? (prev * w0 + cur * w1 + nxt * w2) : 0.f;
                    prev = cur; cur = nxt;
                }
                u32x4 w; w.x = cvt_pk_bf16(r[0], r[1]); w.y = cvt_pk_bf16(r[2], r[3]); w.z = cvt_pk_bf16(r[4], r[5]); w.w = cvt_pk_bf16(r[6], r[7]);
                *(GAS u32x4*)(XT + o8 * 8) = w;
            }
        }
        __syncthreads();
    }
}

__device__ __forceinline__ float max3f(float a, float b, float c) { float r; asm("v_max3_f32 %0, %1, %2, %3" : "=v"(r) : "v"(a), "v"(b), "v"(c)); return r; }
__device__ __forceinline__ f32x16 mfma32(bf16x8 a, bf16x8 b, f32x16 c) { return __builtin_amdgcn_mfma_f32_32x32x16_bf16(a, b, c, 0, 0, 0); }

__device__ __forceinline__ void attn_phase(const Params& p, LAS unsigned char* lds) {
    const int tid = tid_l(), lane = tid & 63, wave = tid >> 6, G = gridDim.x, h = lane >> 5, l32 = lane & 31;
    unsigned char* ob = launder((unsigned char*)p.out);
    bf16_t* Q = (bf16_t*)(ob + DO_Q);
    const bf16_t* KN = (const bf16_t*)(ob + DO_KN);
    const bf16_t* KR = (const bf16_t*)(ob + DO_KR);
    const bf16_t* VT = (const bf16_t*)(ob + DO_VT);
    constexpr int KROW = 400, VROW = 136, KBYTES = 64 * KROW, BUFB = KBYTES + 128 * VROW;
    const int vblk = (G % 8 == 0) ? (int)(blockIdx.x % 8) * (G / 8) + (int)(blockIdx.x / 8) : (int)blockIdx.x;
    for (int u = vblk; u < 2048; u += G) {
        int seq, head, qb;
        if (u < 1024) { seq = u >> 7; head = (u >> 5) & 3; qb = u & 31; } else { const int v = u - 1024; seq = NBP + (v >> 5); head = (v >> 3) & 3; qb = v & 7; }
        const int L = seq < NBP ? LP : LS; const int row0 = seq < NBP ? seq * LP : TPR + (seq - NBP) * LS;
        const int ntiles = (L + 63) >> 6;
        const int qrow = row0 + 16 + qb * 256 + wave * 32 + l32;
        bf16x8 qf[12];
#pragma unroll
        for (int ks = 0; ks < 12; ++ks) qf[ks] = *(const GAS bf16x8*)(Q + (size_t)qrow * 768 + head * 192 + 16 * ks + 8 * h);
        {
            const float2* RT = (const float2*)(launder(p.ws) + OFF_RT);
            const int qpos = 16 + qb * 256 + wave * 32 + l32;
#pragma unroll
            for (int ks = 8; ks < 12; ++ks) {
                const u32x4 v = __builtin_bit_cast(u32x4, qf[ks]);
                f32x4 v0 = (f32x4){bflo(v.x), bfhi(v.x), bflo(v.y), bfhi(v.y)}, v1 = (f32x4){bflo(v.z), bfhi(v.z), bflo(v.w), bfhi(v.w)};
                rope8(v0, v1, RT + qpos * 32 + 8 * (ks - 8) + 4 * h);
                qf[ks] = __builtin_bit_cast(bf16x8, pack8(v0, v1));
            }
        }
        const int kkey0 = tid >> 4, kch0 = tid & 15;
        const int rkey = tid >> 3, rch = tid & 7;
        const int vdv0 = tid >> 3, vch = tid & 7;
        const unsigned kn_off = (unsigned)(kkey0 * 512 + head * 128 + kch0 * 8) * 2u;
        const unsigned kr_off = (unsigned)(rkey * 64 + rch * 8) * 2u;
        const unsigned vt_off = (unsigned)(vdv0 * TPAD + vch * 8) * 2u;
        const unsigned char* knb = (const unsigned char*)KN + (size_t)row0 * 1024;
        const unsigned char* krb = (const unsigned char*)KR + (size_t)row0 * 128;
        const unsigned char* vtb = (const unsigned char*)VT + ((size_t)head * 128 * TPAD + row0) * 2;
        u32x4 g0, g1, g2, g3, g4;
#define ATT_LOAD(tile) do { const unsigned char* kb__ = knb + (size_t)(tile) * 65536; const unsigned char* rb__ = krb + (size_t)(tile) * 8192; const unsigned char* vb__ = vtb + (size_t)(tile) * 128; \
        g0 = *(const GAS u32x4*)(kb__ + kn_off); g1 = *(const GAS u32x4*)(kb__ + 32768 + kn_off); \
        g2 = *(const GAS u32x4*)(rb__ + kr_off); (void)vb__; } while (0)
#define ATT_LOADV(tile) do { const unsigned char* vb__ = vtb + (size_t)(tile) * 128; g3 = *(const GAS u32x4*)(vb__ + vt_off); g4 = *(const GAS u32x4*)(vb__ + (size_t)64 * TPAD * 2 + vt_off); } while (0)
#define ATT_STOREK(buf) do { LAS unsigned char* kb_ = lds + (buf) * BUFB; \
        *(LAS u32x4*)(kb_ + kkey0 * KROW + kch0 * 16) = g0; *(LAS u32x4*)(kb_ + (kkey0 + 32) * KROW + kch0 * 16) = g1; \
        *(LAS u32x4*)(kb_ + rkey * KROW + 256 + rch * 16) = g2; } while (0)
#define ATT_STORE(buf) do { LAS unsigned char* vb_ = lds + (buf) * BUFB + KBYTES; \
        *(LAS u32x2*)(vb_ + vdv0 * VROW + vch * 16) = (u32x2){g3.x, g3.y}; *(LAS u32x2*)(vb_ + vdv0 * VROW + vch * 16 + 8) = (u32x2){g3.z, g3.w}; \
        *(LAS u32x2*)(vb_ + (vdv0 + 64) * VROW + vch * 16) = (u32x2){g4.x, g4.y}; *(LAS u32x2*)(vb_ + (vdv0 + 64) * VROW + vch * 16 + 8) = (u32x2){g4.z, g4.w}; } while (0)
        ATT_LOAD(0); ATT_LOADV(0); ATT_STOREK(0); ATT_STORE(0);
        __syncthreads();
        f32x16 o[4];
#pragma unroll
        for (int d = 0; d < 4; ++d)
#pragma unroll
            for (int r = 0; r < 16; ++r) o[d][r] = 0.f;
        float m_run = -INFINITY, l_run = 0.f;
        for (int j = 0; j < ntiles; ++j) {
            const int buf = j & 1;
            if (j + 1 < ntiles) ATT_LOAD(j + 1);
            const LAS unsigned char* kb = lds + buf * BUFB;
            f32x16 s0, s1;
            const float c_init = (j == 0) ? 0.f : -m_run;
#pragma unroll
            for (int r = 0; r < 16; ++r) { s0[r] = c_init; s1[r] = c_init; }
            {
                bf16x8 kA[6], kB[6];
                const LAS unsigned char* kr0 = kb + l32 * KROW + h * 16; const LAS unsigned char* kr1 = kr0 + 32 * KROW;
#define ATT_LDK(dst, ksb) do { _Pragma("unroll") for (int i = 0; i < 3; ++i) { dst[2 * i] = *(const LAS bf16x8*)(kr0 + ((ksb) + i) * 32); dst[2 * i + 1] = *(const LAS bf16x8*)(kr1 + ((ksb) + i) * 32); } } while (0)
#define ATT_MMK(src, ksb) do { _Pragma("unroll") for (int i = 0; i < 3; ++i) { s0 = mfma32(src[2 * i], qf[(ksb) + i], s0); s1 = mfma32(src[2 * i + 1], qf[(ksb) + i], s1); } } while (0)
                ATT_LDK(kA, 0); __builtin_amdgcn_sched_barrier(0);
                ATT_MMK(kA, 0); __builtin_amdgcn_sched_barrier(0);
                ATT_LDK(kB, 3); __builtin_amdgcn_sched_barrier(0);
                ATT_MMK(kB, 3); __builtin_amdgcn_sched_barrier(0);
                ATT_LDK(kA, 6); __builtin_amdgcn_sched_barrier(0);
                ATT_MMK(kA, 6); __builtin_amdgcn_sched_barrier(0);
                ATT_LDK(kB, 9); __builtin_amdgcn_sched_barrier(0);
                ATT_MMK(kB, 9); __builtin_amdgcn_sched_barrier(0);
#undef ATT_LDK
#undef ATT_MMK
            }
            if (j + 1 < ntiles) ATT_STOREK(buf ^ 1);
            const int vc = L - j * 64;
            if (vc < 64) {
                const int vch = vc - 4 * h;
#pragma unroll
                for (int r = 0; r < 16; ++r) {
                    if ((r & 3) + 8 * (r >> 2) >= vch) s0[r] = -INFINITY;
                    if ((r & 3) + 8 * (r >> 2) + 32 >= vch) s1[r] = -INFINITY;
                }
            }
            float mx = fmaxf(s0[0], s1[0]);
#pragma unroll
            for (int r = 1; r < 16; ++r) mx = max3f(mx, s0[r], s1[r]);
            mx = fmaxf(mx, __shfl_xor(mx, 32));
            const float delta = (j == 0) ? mx : fmaxf(mx, 0.f);
            const float alpha = (j == 0) ? 1.0f : __builtin_amdgcn_exp2f(-delta);
            m_run = (j == 0) ? mx : m_run + delta;
            if (__any(delta != 0.f)) {
#pragma unroll
                for (int r = 0; r < 16; ++r) { s0[r] -= delta; s1[r] -= delta; }
            }
            float ls = 0.f;
#pragma unroll
            for (int r = 0; r < 16; ++r) { s0[r] = __builtin_amdgcn_exp2f(s0[r]); s1[r] = __builtin_amdgcn_exp2f(s1[r]); ls += s0[r] + s1[r]; }
            l_run = l_run * alpha + ls;
            if (__any(alpha != 1.0f)) {
#pragma unroll
                for (int d = 0; d < 4; ++d)
#pragma unroll
                    for (int r = 0; r < 16; ++r) o[d][r] *= alpha;
            }
            bf16x8 pb[4];
            {
                u32x4 w;
                w.x = cvt_pk_bf16(s0[0], s0[1]); w.y = cvt_pk_bf16(s0[2], s0[3]); w.z = cvt_pk_bf16(s0[4], s0[5]); w.w = cvt_pk_bf16(s0[6], s0[7]); pb[0] = __builtin_bit_cast(bf16x8, w);
                w.x = cvt_pk_bf16(s0[8], s0[9]); w.y = cvt_pk_bf16(s0[10], s0[11]); w.z = cvt_pk_bf16(s0[12], s0[13]); w.w = cvt_pk_bf16(s0[14], s0[15]); pb[1] = __builtin_bit_cast(bf16x8, w);
                w.x = cvt_pk_bf16(s1[0], s1[1]); w.y = cvt_pk_bf16(s1[2], s1[3]); w.z = cvt_pk_bf16(s1[4], s1[5]); w.w = cvt_pk_bf16(s1[6], s1[7]); pb[2] = __builtin_bit_cast(bf16x8, w);
                w.x = cvt_pk_bf16(s1[8], s1[9]); w.y = cvt_pk_bf16(s1[10], s1[11]); w.z = cvt_pk_bf16(s1[12], s1[13]); w.w = cvt_pk_bf16(s1[14], s1[15]); pb[3] = __builtin_bit_cast(bf16x8, w);
            }
            if (j + 1 < ntiles) ATT_LOADV(j + 1);
            const LAS unsigned char* vb = kb + KBYTES;
            {
                const LAS unsigned char* vrow = vb + l32 * VROW + 8 * h;
#pragma unroll
                for (int d = 0; d < 4; ++d) {
                    u32x4 vf[4];
#pragma unroll
                    for (int ks = 0; ks < 4; ++ks) {
                        const LAS unsigned char* ap = vrow + d * 32 * VROW + 32 * ks;
                        const u32x2 lo = *(const LAS u32x2*)ap, hi = *(const LAS u32x2*)(ap + 16);
                        vf[ks] = (u32x4){lo.x, lo.y, hi.x, hi.y};
                    }
                    __builtin_amdgcn_sched_barrier(0);
#pragma unroll
                    for (int ks = 0; ks < 4; ++ks) o[d] = mfma32(__builtin_bit_cast(bf16x8, vf[ks]), pb[ks], o[d]);
                    __builtin_amdgcn_sched_barrier(0);
                }
            }
            if (j + 1 < ntiles) ATT_STORE(buf ^ 1);
            __syncthreads();
        }
        l_run += __shfl_xor(l_run, 32);
        const float inv = 1.0f / l_run;
#if DEBUG_CHECK == 5
        bf16_t* orow = (bf16_t*)(launder(p.ws) + OFF_ODBG) + (size_t)qrow * 512 + head * 128;
#else
        bf16_t* orow = Q + (size_t)qrow * 768 + head * 192;
#endif
#pragma unroll
        for (int d = 0; d < 4; ++d)
#pragma unroll
            for (int rq = 0; rq < 4; ++rq) {
                const u32x2 w = (u32x2){cvt_pk_bf16(o[d][4 * rq] * inv, o[d][4 * rq + 1] * inv), cvt_pk_bf16(o[d][4 * rq + 2] * inv, o[d][4 * rq + 3] * inv)};
                *(GAS u32x2*)(orow + 32 * d + 8 * rq + 4 * h) = w;
            }
#undef ATT_LOAD
#undef ATT_LOADV
#undef ATT_STORE
#undef ATT_STOREK
    }
}

template <int SET> __device__ __forceinline__ void hyena_unit(const Params& p, LAS unsigned char* lds, int c, int bg) {
    constexpr int P = SET ? 32 : 128;
    constexpr int NBU = SET ? 16 : 4;
    constexpr int NBT = SET ? 8 : 2;
    constexpr int GP = SET ? 4 : 16;
    constexpr int LG = SET ? LGS : LGP;
    constexpr int NB = SET ? NBS : NBP;
    constexpr int RS = SET ? 4896 : 18816;
    constexpr int GBYTES = 2 * LG * 2;
    constexpr int G1OFF = 33220;
    constexpr int ZOFF = 66560;
    unsigned char* ws = launder(p.ws);
    const int tid = tid_l(), lane = tid & 63, wave = tid >> 6, h = lane >> 5, l32 = lane & 31;
    const bf16_t* X1T = (const bf16_t*)(ws + OFF_X1T) + (SET ? XT_SET1 : 0);
    bf16_t* X2T = (bf16_t*)(ws + OFF_X2T) + (SET ? XT_SET1 : 0);
    const bf16_t* V0T = (const bf16_t*)(ws + OFF_V0T) + (SET ? XT_SET1 : 0);
    const bf16_t* GR = (const bf16_t*)(ws + (SET ? OFF_GR1 : OFF_GR0));
    const float* hy_bias = launder(p.in[17]);
    LAS unsigned char* gL = lds; LAS unsigned char* zL = lds + ZOFF;
    const size_t rowbase = ((size_t)c * NB + bg * NBU) * LG;
    for (int id = tid; id < NBU * (P + 1) * 8; id += 512) {
        const int bl = id / ((P + 1) * 8), rem = id % ((P + 1) * 8), blk = rem >> 3, ch = rem & 7;
        *(LAS u32x4*)(zL + bl * RS + blk * 144 + ch * 16) = *(const GAS u32x4*)(V0T + rowbase + (size_t)bl * LG + blk * 64 + ch * 8);
    }
    for (int id = tid; id < NBU * 9; id += 512) { const int bl = id / 9, ch = id % 9; *(LAS u32x4*)(zL + bl * RS + (P + 1) * 144 + ch * 16) = (u32x4){0u, 0u, 0u, 0u}; }
#define HY_LOADG(rowidx) do { const unsigned* g32_ = (const unsigned*)(GR + (size_t)(rowidx) * (2 * LG)); \
        for (int id = tid; id < GBYTES / 4; id += 512) { const unsigned a_ = g32_[id], b_ = (id + 1 < GBYTES / 4) ? g32_[id + 1] : 0u; \
            *(LAS unsigned*)(gL + id * 4) = a_; *(LAS unsigned*)(gL + G1OFF + id * 4) = (a_ >> 16) | (b_ << 16); } } while (0)
    HY_LOADG(c);
    __syncthreads();
    const LAS unsigned short* g16 = (const LAS unsigned short*)gL;
    constexpr int PARTS = 512 / (NBU * 16);
    float zmeta = 0.f; int mo_bl, mo_m;
    {
        const int part = tid % PARTS, out = tid / PARTS; mo_bl = out >> 4; mo_m = out & 15;
        const LAS unsigned char* zr = zL + mo_bl * RS;
        float a = 0.f;
        const LAS unsigned char* gm = gL + (mo_m & 1) * G1OFF;
        for (int ci = part; ci < (LG - 48) / 8; ci += PARTS) {
            const int tt0 = 48 + 8 * ci;
            const u32x4 zv = *(const LAS u32x4*)(zr + (tt0 >> 6) * 144 + (tt0 & 63) * 2);
            const LAS unsigned* gp = (const LAS unsigned*)(gm + ((LG - mo_m - 48 + tt0) >> 1) * 4);
            const unsigned g0 = gp[0], g1 = gp[1], g2 = gp[2], g3 = gp[3];
            a += (bflo(zv.x) * bflo(g0) + bfhi(zv.x) * bfhi(g0)) + (bflo(zv.y) * bflo(g1) + bfhi(zv.y) * bfhi(g1))
               + (bflo(zv.z) * bflo(g2) + bfhi(zv.z) * bfhi(g2)) + (bflo(zv.w) * bflo(g3) + bfhi(zv.w) * bfhi(g3));
        }
#pragma unroll
        for (int o = 1; o < PARTS; o <<= 1) a += __shfl_xor(a, o);
        const float bias0 = hy_bias[c];
        const float z0 = bf2f(*(const LAS unsigned short*)(zr + (48 + mo_m) * 2));
        const float x1 = bf2f(X1T[rowbase + (size_t)mo_bl * LG + 48 + mo_m]);
        zmeta = x1 * (a + z0 * bias0);
    }
    const int p0 = GP * wave;
    const int pp = l32 / NBT, blA = l32 % NBT, blB = NBT + blA;
#pragma unroll 1
    for (int order = 0; order < 2; ++order) {
        f32x16 acc[2][2];
#pragma unroll
        for (int a = 0; a < 2; ++a)
#pragma unroll
            for (int b = 0; b < 2; ++b)
#pragma unroll
                for (int r = 0; r < 16; ++r) acc[a][b][r] = 0.f;
        bf16x8 Ep4, Ep5;
        {
            const int d0 = p0 - (P - 1); const int ib0 = LG - 64 * d0 - l32 + 8 * h;
            const LAS unsigned char* g0 = gL + (l32 & 1) * G1OFF + (ib0 >> 1) * 4;
            const LAS unsigned* ga = (const LAS unsigned*)(g0 + 96); const LAS unsigned* gb = (const LAS unsigned*)(g0 + 64);
            Ep4 = __builtin_bit_cast(bf16x8, (u32x4){ga[0], ga[1], ga[2], ga[3]}); Ep5 = __builtin_bit_cast(bf16x8, (u32x4){gb[0], gb[1], gb[2], gb[3]});
        }
#define HY_LOAD(dd, Bv, Ev) do { \
            const int ib_ = LG - 64 * (dd) - l32 + 8 * h; \
            const LAS unsigned char* gpl_ = gL + (l32 & 1) * G1OFF + (ib_ >> 1) * 4; \
            _Pragma("unroll") for (int e = 2; e < 6; ++e) { const LAS unsigned* gp_ = (const LAS unsigned*)(gpl_ - 32 * (e - 3)); \
                Ev[e - 2] = __builtin_bit_cast(bf16x8, (u32x4){gp_[0], gp_[1], gp_[2], gp_[3]}); } \
            const int q_ = p0 + pp - (dd); const int slot_ = ((unsigned)(q_ + 1) <= (unsigned)P) ? q_ + 1 : P + 1; \
            const LAS unsigned char* zA_ = zL + blA * RS + slot_ * 144 + h * 16; const LAS unsigned char* zB_ = zL + blB * RS + slot_ * 144 + h * 16; \
            _Pragma("unroll") for (int ks = 0; ks < 4; ++ks) { Bv[0][ks] = *(const LAS bf16x8*)(zA_ + ks * 32); Bv[1][ks] = *(const LAS bf16x8*)(zB_ + ks * 32); } } while (0)
#define HY_MMA(Bv, Ev) do { \
            _Pragma("unroll") for (int ks = 0; ks < 4; ++ks) { \
                const bf16x8 a0_ = (ks == 0) ? Ev[1] : (ks == 1) ? Ev[0] : (ks == 2) ? Ep5 : Ep4; \
                const bf16x8 a1_ = (ks == 0) ? Ev[3] : (ks == 1) ? Ev[2] : (ks == 2) ? Ev[1] : Ev[0]; \
                acc[0][0] = mfma32(a0_, Bv[0][ks], acc[0][0]); acc[1][0] = mfma32(a0_, Bv[1][ks], acc[1][0]); \
                acc[0][1] = mfma32(a1_, Bv[0][ks], acc[0][1]); acc[1][1] = mfma32(a1_, Bv[1][ks], acc[1][1]); } \
            Ep4 = Ev[2]; Ep5 = Ev[3]; } while (0)
        {
            bf16x8 BA[2][4], BB[2][4], EA[4], EB[4];
            const int dlo = p0 - (P - 1), dhi = p0 + GP;
            HY_LOAD(dlo, BA, EA);
#pragma unroll 1
            for (int d = dlo; d <= dhi; d += 2) {
                HY_LOAD(d + 1, BB, EB);
                HY_MMA(BA, EA);
                if (d + 2 <= dhi) HY_LOAD(d + 2, BA, EA);
                HY_MMA(BB, EB);
            }
        }
#undef HY_LOAD
#undef HY_MMA
        __syncthreads();
        const float bias = hy_bias[order * 512 + c];
#pragma unroll
        for (int tl = 0; tl < 2; ++tl) {
            const int bl = tl ? blB : blA;
            const size_t grow = rowbase + (size_t)bl * LG + 64 * (p0 + pp + 1);
            LAS unsigned char* zr = zL + bl * RS + (p0 + pp + 1) * 144;
#pragma unroll
            for (int m = 0; m < 2; ++m)
#pragma unroll
                for (int rq = 0; rq < 4; ++rq) {
                    const int off = 32 * m + 8 * rq + 4 * h;
                    const u32x2 zw = *(const LAS u32x2*)(zr + off * 2);
                    const u32x2 xw = *(const GAS u32x2*)((order ? (const bf16_t*)X2T : X1T) + grow + off);
                    const float y0 = acc[tl][m][4 * rq], y1 = acc[tl][m][4 * rq + 1], y2 = acc[tl][m][4 * rq + 2], y3 = acc[tl][m][4 * rq + 3];
                    const float r0 = bflo(xw.x) * (y0 + bflo(zw.x) * bias), r1 = bfhi(xw.x) * (y1 + bfhi(zw.x) * bias);
                    const float r2 = bflo(xw.y) * (y2 + bflo(zw.y) * bias), r3 = bfhi(xw.y) * (y3 + bfhi(zw.y) * bias);
                    const u32x2 w = (u32x2){cvt_pk_bf16(r0, r1), cvt_pk_bf16(r2, r3)};
#if DEBUG_CHECK == 5
                    if (order == 0) *(LAS u32x2*)(zr + off * 2) = w; else *(GAS u32x2*)((bf16_t*)(ws + OFF_HDBG) + (SET ? XT_SET1 : 0) + grow + off) = w;
#else
                    if (order == 0) *(LAS u32x2*)(zr + off * 2) = w; else *(GAS u32x2*)(X2T + grow + off) = w;
#endif
                }
        }
        if (order == 0) {
            if ((tid % PARTS) == 0) *(LAS unsigned short*)(zL + mo_bl * RS + (48 + mo_m) * 2) = (unsigned short)(cvt_pk_bf16(zmeta, 0.f) & 0xffffu);
            HY_LOADG(512 + c);
        }
        __syncthreads();
    }
}
#undef HY_LOADG
__device__ __forceinline__ void hyena_phase(const Params& p, LAS unsigned char* lds) {
    for (int u = blockIdx.x; u < 2048; u += gridDim.x) {
        if (u < 1024) hyena_unit<0>(p, lds, u >> 1, u & 1); else hyena_unit<1>(p, lds, (u - 1024) >> 1, u & 1);
    }
}

__device__ __forceinline__ void mixnorm_phase(const Params& p, LAS unsigned char* lds) {
    unsigned char* ws = launder(p.ws); const int tid = tid_l(), lane = tid & 63, wave = tid >> 6, G = gridDim.x;
    const bf16_t* Q = (const bf16_t*)(launder((unsigned char*)p.out) + DO_Q);
    bf16_t* MIXN = (bf16_t*)(ws + OFF_MIXN);
    const float* ga = launder(p.in[18]); const float* gh = launder(p.in[19]);
    constexpr int RSB = 1040;
    for (int u = blockIdx.x; u < 2048; u += G) {
        const int n0 = u * 64;
        int set, b, tok0;
        if (n0 < 65536) { set = 0; b = n0 >> 13; tok0 = n0 & 8191; } else { set = 1; const int q = n0 - 65536; b = q >> 11; tok0 = q & 2047; }
        const int Lg = set ? LGS : LGP, NB = set ? NBS : NBP;
        {
            const int c = tid;
#if DEBUG_CHECK == 5
            const bf16_t* src = (const bf16_t*)(ws + OFF_HDBG) + (set ? XT_SET1 : 0) + ((size_t)c * NB + b) * Lg + tok0 + 64;
#else
            const bf16_t* src = (const bf16_t*)(ws + OFF_X2T) + (set ? XT_SET1 : 0) + ((size_t)c * NB + b) * Lg + tok0 + 64;
#endif
            LAS unsigned short* tl = (LAS unsigned short*)lds + c;
#pragma unroll
            for (int k8 = 0; k8 < 8; ++k8) {
                const u32x4 v = *(const GAS u32x4*)(src + k8 * 8);
                tl[(k8 * 8 + 0) * (RSB / 2)] = (unsigned short)(v.x & 0xffffu); tl[(k8 * 8 + 1) * (RSB / 2)] = (unsigned short)(v.x >> 16);
                tl[(k8 * 8 + 2) * (RSB / 2)] = (unsigned short)(v.y & 0xffffu); tl[(k8 * 8 + 3) * (RSB / 2)] = (unsigned short)(v.y >> 16);
                tl[(k8 * 8 + 4) * (RSB / 2)] = (unsigned short)(v.z & 0xffffu); tl[(k8 * 8 + 5) * (RSB / 2)] = (unsigned short)(v.z >> 16);
                tl[(k8 * 8 + 6) * (RSB / 2)] = (unsigned short)(v.w & 0xffffu); tl[(k8 * 8 + 7) * (RSB / 2)] = (unsigned short)(v.w >> 16);
            }
        }
        __syncthreads();
        for (int i = 0; i < 8; ++i) {
            const int rr = wave + 8 * i; const int n = n0 + rr; const int r = full_row(n);
            const u32x4 hv = *(const LAS u32x4*)(lds + rr * RSB + lane * 16);
#if DEBUG_CHECK == 5
            const u32x4 av = *(const GAS u32x4*)((const bf16_t*)(ws + OFF_ODBG) + (size_t)r * 512 + lane * 8);
#else
            const u32x4 av = *(const GAS u32x4*)(Q + (size_t)r * 768 + (lane >> 4) * 192 + (lane & 15) * 8);
#endif
            float hf[8] = {bflo(hv.x), bfhi(hv.x), bflo(hv.y), bfhi(hv.y), bflo(hv.z), bfhi(hv.z), bflo(hv.w), bfhi(hv.w)};
            float af[8] = {bflo(av.x), bfhi(av.x), bflo(av.y), bfhi(av.y), bflo(av.z), bfhi(av.z), bflo(av.w), bfhi(av.w)};
            float sh = 0.f, sa = 0.f;
#pragma unroll
            for (int k = 0; k < 8; ++k) { sh += hf[k] * hf[k]; sa += af[k] * af[k]; }
            sh = wave_sum(sh); sa = wave_sum(sa);
            const float rh = rsqrtf(sh * (1.f / 512.f) + EPS), ra = rsqrtf(sa * (1.f / 512.f) + EPS);
            const f32x4 ga0 = *(const GAS f32x4*)(ga + lane * 8), ga1 = *(const GAS f32x4*)(ga + lane * 8 + 4);
            const f32x4 gh0 = *(const GAS f32x4*)(gh + lane * 8), gh1 = *(const GAS f32x4*)(gh + lane * 8 + 4);
            u32x4 wa, wh;
            wa.x = cvt_pk_bf16(af[0] * ra * ga0[0], af[1] * ra * ga0[1]); wa.y = cvt_pk_bf16(af[2] * ra * ga0[2], af[3] * ra * ga0[3]);
            wa.z = cvt_pk_bf16(af[4] * ra * ga1[0], af[5] * ra * ga1[1]); wa.w = cvt_pk_bf16(af[6] * ra * ga1[2], af[7] * ra * ga1[3]);
            wh.x = cvt_pk_bf16(hf[0] * rh * gh0[0], hf[1] * rh * gh0[1]); wh.y = cvt_pk_bf16(hf[2] * rh * gh0[2], hf[3] * rh * gh0[3]);
            wh.z = cvt_pk_bf16(hf[4] * rh * gh1[0], hf[5] * rh * gh1[1]); wh.w = cvt_pk_bf16(hf[6] * rh * gh1[2], hf[7] * rh * gh1[3]);
#if EXPT == 1
            wa = (u32x4){0u, 0u, 0u, 0u};
#endif
#if EXPT == 2
            wh = (u32x4){0u, 0u, 0u, 0u};
#endif
            *(GAS u32x4*)(MIXN + (size_t)n * 1024 + lane * 8) = wa;
            *(GAS u32x4*)(MIXN + (size_t)n * 1024 + 512 + lane * 8) = wh;
        }
        __syncthreads();
    }
}

__device__ __forceinline__ void h1_phase(const Params& p) {
    unsigned char* ws = launder(p.ws); const int tid = tid_l(), lane = tid & 63, wave = tid >> 6;
    const int gw = blockIdx.x * 8 + wave, NGW = gridDim.x * 8;
    const bf16_t* MIX = (const bf16_t*)(ws + OFF_MIX); bf16_t* H1B = (bf16_t*)(ws + OFF_H1B);
    const float* sqmix = (const float*)(ws + OFF_SQMIXP); float* r1 = (float*)(ws + OFF_R1); const float* g = p.in[21];
    for (int n = gw; n < TN; n += NGW) {
        const float* xrow = n < 65536 ? p.in[0] + (size_t)n * 1024 : p.in[1] + (size_t)(n - 65536) * 1024;
        const float rm = rsqrtf(wave_sum(lane < 16 ? ldco(sqmix + (size_t)n * 16 + lane) : 0.f) * (1.f / 1024.f) + EPS);
        float ss = 0.f;
#pragma unroll
        for (int hh = 0; hh < 2; ++hh) {
            const int c0 = hh * 512 + lane * 8;
            const u32x4 mv = *(const u32x4*)(MIX + (size_t)n * 1024 + c0);
            const f32x4 x0 = *(const f32x4*)(xrow + c0), x1 = *(const f32x4*)(xrow + c0 + 4);
            const f32x4 g0 = *(const f32x4*)(g + c0), g1 = *(const f32x4*)(g + c0 + 4);
            f32x4 h0, h1;
            h0[0] = x0[0] + bflo(mv.x) * rm * g0[0]; h0[1] = x0[1] + bfhi(mv.x) * rm * g0[1]; h0[2] = x0[2] + bflo(mv.y) * rm * g0[2]; h0[3] = x0[3] + bfhi(mv.y) * rm * g0[3];
            h1[0] = x1[0] + bflo(mv.z) * rm * g1[0]; h1[1] = x1[1] + bfhi(mv.z) * rm * g1[1]; h1[2] = x1[2] + bflo(mv.w) * rm * g1[2]; h1[3] = x1[3] + bfhi(mv.w) * rm * g1[3];
            ss += sq8(h0, h1);
            *(u32x4*)(H1B + (size_t)n * 1024 + c0) = pack8(h0, h1);
        }
        ss = wave_sum(ss);
        if (lane == 0) r1[n] = rsqrtf(ss * (1.f / 1024.f) + EPS);
    }
}
__device__ __forceinline__ void final_phase(const Params& p, int half) {
    unsigned char* ws = launder(p.ws); const int tid = tid_l(), lane = tid & 63, wave = tid >> 6;
    const int gw = blockIdx.x * 8 + wave, NGW = gridDim.x * 8;
    const bf16_t* M2 = (const bf16_t*)(ws + OFF_M2); const float* sqm2 = (const float*)(ws + OFF_SQM2P); const float* g = p.in[25];
    float dbg_off = 0.f, dbg_one = 0.f;
#if DEBUG_CHECK
    { const unsigned* dc = (const unsigned*)(ws + OFF_DBGW); dbg_off = 100.f * (float)dc[8] * (1.f / 131072.f); dbg_one = 1000.f * (float)dc[9] * (1.f / 131072.f); }
#endif
    for (int i = gw; i < 65536; i += NGW) {
        const int n = half * 65536 + i;
        const float rm = rsqrtf(wave_sum(lane < 16 ? ldco(sqm2 + (size_t)n * 16 + lane) : 0.f) * (1.f / 1024.f) + EPS);
#pragma unroll
        for (int hh = 0; hh < 2; ++hh) {
            const int c0 = hh * 512 + lane * 8;
            const u32x4 mv = *(const u32x4*)(M2 + (size_t)i * 1024 + c0);
            const u32x4 hv = *(const u32x4*)((const bf16_t*)(ws + OFF_H1B) + (size_t)n * 1024 + c0);
            f32x4 h0 = (f32x4){bflo(hv.x), bfhi(hv.x), bflo(hv.y), bfhi(hv.y)}, h1 = (f32x4){bflo(hv.z), bfhi(hv.z), bflo(hv.w), bfhi(hv.w)};
            const f32x4 g0 = *(const f32x4*)(g + c0), g1 = *(const f32x4*)(g + c0 + 4);
            h0 += dbg_off; h1 += dbg_off; if (n == 0 && c0 == 0) h0[0] += dbg_one;
            h0[0] += bflo(mv.x) * rm * g0[0]; h0[1] += bfhi(mv.x) * rm * g0[1]; h0[2] += bflo(mv.y) * rm * g0[2]; h0[3] += bfhi(mv.y) * rm * g0[3];
            h1[0] += bflo(mv.z) * rm * g1[0]; h1[1] += bfhi(mv.z) * rm * g1[1]; h1[2] += bflo(mv.w) * rm * g1[2]; h1[3] += bfhi(mv.w) * rm * g1[3];
            *(f32x4*)(p.out + (size_t)n * 1024 + c0) = h0; *(f32x4*)(p.out + (size_t)n * 1024 + c0 + 4) = h1;
        }
    }
}


#if DEBUG_CHECK
constexpr size_t OFF_DBG = OFF_DBGW;
__device__ __forceinline__ void check_gemm(const bf16_t* A, int lda, const bf16_t* Bt, int ldb, int K, int M, int N, int mode, const bf16_t* O, int ldc, const float* rs, unsigned* cnt, int col_lo) {
    const unsigned idx = blockIdx.x * 512u + (unsigned)tid_l();
    unsigned hsh = idx * 2654435761u + 12345u + (unsigned)mode * 977u; hsh ^= hsh >> 15; hsh *= 2246822519u; hsh ^= hsh >> 13;
    const int row = (int)(hsh % (unsigned)M); hsh = hsh * 3266489917u + 668265263u; hsh ^= hsh >> 16;
    const int col = col_lo + (int)(hsh % (unsigned)(N - col_lo));
    float d = 0.f;
    for (int k = 0; k < K; ++k) d += bf2f(A[(size_t)row * lda + k]) * bf2f(Bt[(size_t)col * ldb + k]);
    float e = d;
    if (mode == 0 || mode == 7) e = d * rs[row];
    if (mode == 5) { const float t = fmaxf(d * rs[row], 0.f); e = t * t; }
    const float st = bf2f(O[(size_t)row * ldc + col]);
    if (!(fabsf(st - e) <= 0.03f * fabsf(e) + 0.03f)) atomicAdd(cnt, 1u);
}
#endif

#if DEBUG_CHECK == 2
__device__ __forceinline__ void check_proj(const Params& p) {
    unsigned char* ws = launder(p.ws); unsigned char* ob = launder((unsigned char*)p.out);
    const bf16_t* P = (const bf16_t*)(ws + OFF_P); unsigned* cnt = (unsigned*)(ws + OFF_DBG);
    const unsigned idx = blockIdx.x * 512u + (unsigned)tid_l();
    unsigned hsh = idx * 2654435761u + 777u; hsh ^= hsh >> 15; hsh *= 2246822519u; hsh ^= hsh >> 13;
    const int row = (int)(hsh % (unsigned)T); hsh = hsh * 3266489917u + 668265263u; hsh ^= hsh >> 16;
    int pos, seq; row_info(row, pos, seq);
    {
        const int n = (int)(hsh % 768u); const int hh = n / 192, w = n % 192;
        float ss = 0.f, x1 = 0.f, x2 = 0.f; const float* W = p.in[6]; const float* g = p.in[5];
        const int j = w - 128, i = j >> 1;
        const int c1 = w < 128 ? hh * 192 + w : hh * 192 + 128 + i, c2 = hh * 192 + 160 + (w < 128 ? 0 : i);
        for (int k = 0; k < 256; ++k) { const float a = bf2f(P[(size_t)row * NPP + k]); ss += a * a; x1 += a * g[k] * W[k * 768 + c1]; x2 += a * g[k] * W[k * 768 + c2]; }
        const float rq = rsqrtf(ss * (1.f / 256.f) + EPS) * QSCALE; x1 *= rq; x2 *= rq;
        float e = x1;
        if (w >= 128) { const float inv = 1.0f / exp2f((float)i * (13.287712379549449f / 32.f)); float sn, cs; sincos_red((float)pos * inv, sn, cs); e = (j & 1) ? x2 * cs + x1 * sn : x1 * cs - x2 * sn; }
        const float st = bf2f(((const bf16_t*)(ob + DO_Q))[(size_t)row * 768 + n]);
        if (!(fabsf(st - e) <= 0.03f * fabsf(e) + 0.01f)) atomicAdd(cnt + (w < 128 ? 0 : 4), 1u);
    }
    {
        const int n = (int)((hsh >> 3) % 512u); const int hh = n >> 7, i = n & 127;
        float ss = 0.f, x1 = 0.f, x2 = 0.f; const float* W = p.in[8]; const float* g = p.in[7];
        for (int k = 0; k < 128; ++k) { const float a = bf2f(P[(size_t)row * NPP + 256 + k]); ss += a * a; x1 += a * g[k] * W[k * 1024 + hh * 256 + i]; x2 += a * g[k] * W[k * 1024 + hh * 256 + 128 + i]; }
        const float rk = rsqrtf(ss * (1.f / 128.f) + EPS); x1 *= rk; x2 *= rk;
        const float s1 = bf2f(((const bf16_t*)(ob + DO_KN))[(size_t)row * 512 + n]);
        const float s2 = bf2f(((const bf16_t*)(ob + DO_VT))[(size_t)n * TPAD + row]);
        if (!(fabsf(s1 - x1) <= 0.03f * fabsf(x1) + 0.03f)) atomicAdd(cnt + 1, 1u);
        if (!(fabsf(s2 - x2) <= 0.03f * fabsf(x2) + 0.03f)) atomicAdd(cnt + 2, 1u);
    }
    {
        const int jj = (int)((hsh >> 5) % 64u); const int i = jj >> 1;
        const float* xr = pos < 16 ? p.in[2] + (size_t)pos * 1024 : (seq < NBP ? p.in[0] + ((size_t)seq * 8192 + (pos - 16)) * 1024 : p.in[1] + ((size_t)(seq - NBP) * 2048 + (pos - 16)) * 1024);
        const float* W = p.in[4]; const float* g = p.in[3]; float x1 = 0.f, x2 = 0.f;
        for (int k = 0; k < 1024; ++k) { const float a = xr[k] * g[k]; x1 += a * W[(size_t)k * 1984 + 384 + i]; x2 += a * W[(size_t)k * 1984 + 416 + i]; }
        const float r0 = ((const float*)(ws + OFF_R0))[row]; x1 *= r0; x2 *= r0;
        const float inv = 1.0f / exp2f((float)i * (13.287712379549449f / 32.f)); float sn, cs; sincos_red((float)pos * inv, sn, cs);
        const float e = (jj & 1) ? x2 * cs + x1 * sn : x1 * cs - x2 * sn;
        const float st = bf2f(((const bf16_t*)(ob + DO_KR))[(size_t)row * 64 + jj]);
        if (!(fabsf(st - e) <= 0.03f * fabsf(e) + 0.03f)) { atomicAdd(cnt + 3, 1u); atomicAdd(cnt + 5, (unsigned)i); atomicAdd(cnt + 6, (unsigned)(pos >> 3)); }
    }
}
#endif

#if DEBUG_CHECK == 3
__device__ __forceinline__ void check_h0b(const Params& p, int slot) {
    unsigned char* ws = launder(p.ws); unsigned* cnt = (unsigned*)(ws + OFF_DBGW);
    const bf16_t* h0b = (const bf16_t*)(ws + OFF_H0B);
    const unsigned idx = blockIdx.x * 512u + (unsigned)tid_l();
    unsigned hsh = idx * 2654435761u + 4242u + (unsigned)slot * 31u; hsh ^= hsh >> 15; hsh *= 2246822519u; hsh ^= hsh >> 13;
    const int row = (int)(hsh % (unsigned)T); hsh = hsh * 3266489917u + 668265263u; hsh ^= hsh >> 16;
    const int col = (int)(hsh % 1024u);
    int pos, seq; row_info(row, pos, seq);
    const float* xr = pos < 16 ? p.in[2] + (size_t)pos * 1024 : (seq < NBP ? p.in[0] + ((size_t)seq * 8192 + (pos - 16)) * 1024 : p.in[1] + ((size_t)(seq - NBP) * 2048 + (pos - 16)) * 1024);
    const float e = xr[col]; const float st = bf2f(h0b[(size_t)row * 1024 + col]);
    if (!(fabsf(st - e) <= 0.01f * fabsf(e) + 0.001f)) atomicAdd(cnt + slot, 1u);
}
#endif

#if DEBUG_CHECK == 4
__device__ __forceinline__ void check_stale(const Params& p, const unsigned* base, unsigned ndw, int slot) {
    unsigned* cnt = (unsigned*)(launder(p.ws) + OFF_DBGW);
    const unsigned idx = blockIdx.x * 512u + (unsigned)tid_l();
    unsigned hsh = idx * 2654435761u + 999u + (unsigned)slot * 131u; hsh ^= hsh >> 15; hsh *= 2246822519u; hsh ^= hsh >> 13;
#pragma unroll 1
    for (int it = 0; it < 16; ++it) {
        hsh = hsh * 3266489917u + 668265263u; hsh ^= hsh >> 16;
        const unsigned i = hsh % ndw;
        const unsigned a = base[i];
        const unsigned b = __hip_atomic_load(base + i, __ATOMIC_RELAXED, __HIP_MEMORY_SCOPE_AGENT);
        if (a != b) atomicAdd(cnt + slot, 1u);
    }
}
#endif

#if DEBUG_CHECK == 5
__device__ __forceinline__ void check_attn(const Params& p) {
    unsigned char* ws = launder(p.ws); unsigned char* ob = launder((unsigned char*)p.out); unsigned* cnt = (unsigned*)(ws + OFF_DBGW);
    const int tid = tid_l(), lane = tid & 63, wave = tid >> 6;
    const bf16_t* Q = (const bf16_t*)(ob + DO_Q); const bf16_t* KN = (const bf16_t*)(ob + DO_KN); const bf16_t* KR = (const bf16_t*)(ob + DO_KR); const bf16_t* VT = (const bf16_t*)(ob + DO_VT);
    const bf16_t* OD = (const bf16_t*)(ws + OFF_ODBG); const float2* RT = (const float2*)(ws + OFF_RT);
    unsigned hsh = (unsigned)(blockIdx.x * 8 + wave) * 2654435761u + 31337u; hsh ^= hsh >> 15; hsh *= 2246822519u; hsh ^= hsh >> 13;
    const int n = (int)(hsh % (unsigned)TN); const int head = (int)((hsh >> 20) & 3u); const int r = full_row(n);
    int pos, seq; row_info(r, pos, seq);
    const int L = seq < NBP ? LP : LS; const int row0 = r - pos;
    const bf16_t* qp = Q + (size_t)r * 768 + head * 192;
    float mx = -INFINITY;
    for (int k = lane; k < L; k += 64) {
        float sdot = 0.f;
        for (int d = 0; d < 128; ++d) sdot += bf2f(qp[d]) * bf2f(KN[(size_t)(row0 + k) * 512 + head * 128 + d]);
        for (int i = 0; i < 32; ++i) { const float2 cs = ldco2(RT + pos * 32 + i); const float a = bf2f(qp[128 + 2 * i]), b = bf2f(qp[129 + 2 * i]);
            sdot += (a * cs.x - b * cs.y) * bf2f(KR[(size_t)(row0 + k) * 64 + 2 * i]) + (b * cs.x + a * cs.y) * bf2f(KR[(size_t)(row0 + k) * 64 + 2 * i + 1]); }
        mx = fmaxf(mx, sdot);
    }
#pragma unroll
    for (int o = 1; o < 64; o <<= 1) mx = fmaxf(mx, __shfl_xor(mx, o));
    float sw = 0.f, o0 = 0.f, o1 = 0.f; const int dv0 = (int)((hsh >> 8) & 127u), dv1 = (dv0 + 37) & 127;
    for (int k = lane; k < L; k += 64) {
        float sdot = 0.f;
        for (int d = 0; d < 128; ++d) sdot += bf2f(qp[d]) * bf2f(KN[(size_t)(row0 + k) * 512 + head * 128 + d]);
        for (int i = 0; i < 32; ++i) { const float2 cs = ldco2(RT + pos * 32 + i); const float a = bf2f(qp[128 + 2 * i]), b = bf2f(qp[129 + 2 * i]);
            sdot += (a * cs.x - b * cs.y) * bf2f(KR[(size_t)(row0 + k) * 64 + 2 * i]) + (b * cs.x + a * cs.y) * bf2f(KR[(size_t)(row0 + k) * 64 + 2 * i + 1]); }
        const float w = exp2f(sdot - mx); sw += w;
        o0 += w * bf2f(VT[(size_t)(head * 128 + dv0) * TPAD + row0 + k]); o1 += w * bf2f(VT[(size_t)(head * 128 + dv1) * TPAD + row0 + k]);
    }
    sw = wave_sum(sw); o0 = wave_sum(o0) / sw; o1 = wave_sum(o1) / sw;
    if (lane == 0) {
        const float s0 = bf2f(OD[(size_t)r * 512 + head * 128 + dv0]), s1 = bf2f(OD[(size_t)r * 512 + head * 128 + dv1]);
        atomicAdd(cnt + 10, 2u);
        if (!(fabsf(s0 - o0) <= 0.05f * fabsf(o0) + 0.002f)) atomicAdd(cnt + 8, 1u);
        if (!(fabsf(s1 - o1) <= 0.05f * fabsf(o1) + 0.002f)) atomicAdd(cnt + 8, 1u);
    }
}
__device__ __forceinline__ void check_hyena(const Params& p, LAS unsigned char* lds) {
    unsigned char* ws = launder(p.ws); unsigned* cnt = (unsigned*)(ws + OFF_DBGW);
    const int tid = tid_l();
    unsigned hsh = (unsigned)blockIdx.x * 2654435761u + 555u; hsh ^= hsh >> 15; hsh *= 2246822519u; hsh ^= hsh >> 13;
    const int set = (int)(blockIdx.x & 1u); const int c = (int)(hsh % 512u); const int NB = set ? NBS : NBP; const int b = (int)((hsh >> 12) % (unsigned)NB);
    const int LG = set ? LGS : LGP;
    const size_t base = (set ? XT_SET1 : 0) + ((size_t)c * NB + b) * LG;
    const bf16_t* X1 = (const bf16_t*)(ws + OFF_X1T) + base; const bf16_t* X2 = (const bf16_t*)(ws + OFF_X2T) + base; const bf16_t* V0 = (const bf16_t*)(ws + OFF_V0T) + base;
    const bf16_t* HD = (const bf16_t*)(ws + OFF_HDBG) + base;
    const bf16_t* G0 = (const bf16_t*)(ws + (set ? OFF_GR1 : OFF_GR0)) + (size_t)c * (2 * LG); const bf16_t* G1 = G0 + (size_t)512 * (2 * LG);
    const float bias0 = p.in[17][c], bias1 = p.in[17][512 + c];
    LAS float* z1 = (LAS float*)lds;
    for (int t = tid; t < LG; t += 512) {
        float y = 0.f;
        for (int s2 = 48; s2 < LG; ++s2) y += bf2f(G0[LG - (t - s2)]) * bf2f(V0[s2]);
        const float v = bf2f(X1[t]) * (y + bf2f(V0[t]) * bias0);
        z1[t] = (t >= 48) ? bf2f((unsigned short)(cvt_pk_bf16(v, 0.f) & 0xffffu)) : 0.f;
    }
    __syncthreads();
    {
        unsigned h2 = hsh * 3266489917u + (unsigned)tid * 2246822519u; h2 ^= h2 >> 15; h2 *= 2654435761u; h2 ^= h2 >> 13;
        const int t = 64 + (int)(h2 % (unsigned)(LG - 64));
        float y = 0.f;
        for (int s2 = 48; s2 < LG; ++s2) y += bf2f(G1[LG - (t - s2)]) * z1[s2];
        const float e = bf2f(X2[t]) * (y + z1[t] * bias1);
        const float st = bf2f(HD[t]);
        atomicAdd(cnt + 11, 1u);
        if (!(fabsf(st - e) <= 0.05f * fabsf(e) + 1.0f)) atomicAdd(cnt + 9, 1u);
    }
    __syncthreads();
}
#endif

#if DEBUG_CHECK == 7
__device__ __forceinline__ void check_h0b_full(const Params& p, int slot) {
    unsigned char* ws = launder(p.ws); unsigned* cnt = (unsigned*)(ws + OFF_DBGW);
    const bf16_t* h0b = (const bf16_t*)(ws + OFF_H0B);
    const int tid = tid_l(), lane = tid & 63, wave = tid >> 6;
    for (int row = blockIdx.x * 8 + wave; row < T; row += gridDim.x * 8) {
        int pos, seq; row_info(row, pos, seq);
        const float* xr = pos < 16 ? p.in[2] + (size_t)pos * 1024 : (seq < NBP ? p.in[0] + ((size_t)seq * 8192 + (pos - 16)) * 1024 : p.in[1] + ((size_t)(seq - NBP) * 2048 + (pos - 16)) * 1024);
        int bad = 0;
        for (int c = lane; c < 1024; c += 64) { const float e = xr[c]; const float st = bf2f(h0b[(size_t)row * 1024 + c]); if (!(fabsf(st - e) <= 0.01f * fabsf(e) + 0.001f)) bad = 1; }
        bad = __any(bad);
        if (lane == 0 && bad) atomicAdd(cnt + slot, 1u);
    }
}
#endif

#if DEBUG_CHECK == 8
__device__ __forceinline__ void check_p_golden(const Params& p) {
    unsigned char* ws = launder(p.ws); unsigned* cnt = (unsigned*)(ws + OFF_DBGW);
    const bf16_t* P = (const bf16_t*)(ws + OFF_P);
    const unsigned idx = blockIdx.x * 512u + (unsigned)tid_l();
    unsigned hsh = idx * 2654435761u + 8888u; hsh ^= hsh >> 15; hsh *= 2246822519u; hsh ^= hsh >> 13;
    const int row = (int)(hsh % (unsigned)T); hsh = hsh * 3266489917u + 668265263u; hsh ^= hsh >> 16;
    int pos, seq; row_info(row, pos, seq);
    const float* xr = pos < 16 ? p.in[2] + (size_t)pos * 1024 : (seq < NBP ? p.in[0] + ((size_t)seq * 8192 + (pos - 16)) * 1024 : p.in[1] + ((size_t)(seq - NBP) * 2048 + (pos - 16)) * 1024);
    const float* W = p.in[4]; const float* g = p.in[3];
    const int colA = 448 + (int)(hsh % 1536u), colB = (int)((hsh >> 7) % 384u);
    float ss = 0.f, a = 0.f, b = 0.f;
    for (int k = 0; k < 1024; ++k) { const float x = xr[k]; ss += x * x; a += x * g[k] * W[(size_t)k * 1984 + colA]; b += x * g[k] * W[(size_t)k * 1984 + colB]; }
    const float r0 = rsqrtf(ss * (1.f / 1024.f) + EPS); a *= r0; b *= r0;
    const float sa = bf2f(P[(size_t)row * NPP + colA]), sb = bf2f(P[(size_t)row * NPP + colB]);
    if (!(fabsf(sa - a) <= 0.03f * fabsf(a) + 0.03f)) atomicAdd(cnt + 8, 1u);
    if (!(fabsf(sb - b) <= 0.03f * fabsf(b) + 0.03f)) atomicAdd(cnt + 9, 1u);
}
#endif

#if DEBUG_CHECK == 9
__device__ __forceinline__ void check_win_r0(const Params& p) {
    unsigned char* ws = launder(p.ws); unsigned* cnt = (unsigned*)(ws + OFF_DBGW);
    const bf16_t* WT = (const bf16_t*)(ws + OFF_WIN); const float* W = p.in[4]; const float* g = p.in[3]; const float* R0 = (const float*)(ws + OFF_R0);
    const int tid = tid_l(), lane = tid & 63, wave = tid >> 6;
    const int gtid = blockIdx.x * 512 + tid, gthreads = gridDim.x * 512;
    for (int e = gtid; e < 1984 * 1024; e += gthreads) {
        const int n = e >> 10, k = e & 1023; const int sc = src_col(1, n);
        const float ex = W[(size_t)k * 1984 + sc] * g[k]; const float st = bf2f(WT[(size_t)n * 1024 + k]);
        if (!(fabsf(st - ex) <= 0.01f * fabsf(ex) + 1e-5f)) atomicAdd(cnt + 8, 1u);
    }
    for (int row = blockIdx.x * 8 + wave; row < T; row += gridDim.x * 8) {
        int pos, seq; row_info(row, pos, seq);
        const float* xr = pos < 16 ? p.in[2] + (size_t)pos * 1024 : (seq < NBP ? p.in[0] + ((size_t)seq * 8192 + (pos - 16)) * 1024 : p.in[1] + ((size_t)(seq - NBP) * 2048 + (pos - 16)) * 1024);
        float ss = 0.f;
        for (int c = lane; c < 1024; c += 64) ss += xr[c] * xr[c];
        ss = wave_sum(ss);
        const float ex = rsqrtf(ss * (1.f / 1024.f) + EPS); const float st = R0[row];
        if (lane == 0 && !(fabsf(st - ex) <= 0.001f * ex)) { atomicAdd(cnt + 9, 1u); atomicAdd(cnt + 12, (unsigned)(row >> 6)); }
    }
}
#endif

#if DEBUG_CHECK == 10
__device__ __forceinline__ void check_x(const Params& p, int mode) {
    unsigned char* ws = launder(p.ws); unsigned* cnt = (unsigned*)(ws + OFF_DBGW); unsigned* sums = (unsigned*)(ws + OFF_DBGW + MiB);
    const int tid = tid_l(), lane = tid & 63, wave = tid >> 6;
    for (int n = blockIdx.x * 8 + wave; n < TN; n += gridDim.x * 8) {
        const unsigned* xr = (const unsigned*)(n < 65536 ? p.in[0] + (size_t)n * 1024 : p.in[1] + (size_t)(n - 65536) * 1024);
        unsigned a = 0u;
        for (int c = lane; c < 1024; c += 64) a += xr[c] * (2u * (unsigned)c + 1u);
#pragma unroll
        for (int o = 1; o < 64; o <<= 1) a += __shfl_xor(a, o);
        if (lane == 0) {
            if (mode == 0) __hip_atomic_store(sums + n, a, __ATOMIC_RELAXED, __HIP_MEMORY_SCOPE_AGENT);
            else if (__hip_atomic_load(sums + n, __ATOMIC_RELAXED, __HIP_MEMORY_SCOPE_AGENT) != a) atomicAdd(cnt + 8, 1u);
        }
    }
}
#endif

#if DEBUG_CHECK == 11
__device__ __forceinline__ void check_filt_prep(const Params& p) {
    unsigned char* ws = launder(p.ws); unsigned* cnt = (unsigned*)(ws + OFF_DBGW);
    const unsigned idx = blockIdx.x * 512u + (unsigned)tid_l();
    unsigned hsh = idx * 2654435761u + 1111u; hsh ^= hsh >> 15; hsh *= 2246822519u; hsh ^= hsh >> 13;
    {
        const int set = (int)(hsh & 1u); const int L = set ? LS : LP; const int C0 = set ? LGS : LGP;
        const int n = (int)((hsh >> 1) % 2048u); hsh = hsh * 3266489917u + 668265263u; hsh ^= hsh >> 16;
        const int t = (int)(hsh % (unsigned)L);
        const float* f_w1 = p.in[10]; const float* f_b1 = p.in[11]; const float* f_freq = p.in[12]; const float* f_w2 = p.in[13];
        const float* f_b2 = p.in[14]; const float* f_w3 = p.in[15]; const float* f_decay = p.in[16];
        const float tn = (float)t / (float)(L - 1); const float w = (6.2831853071795865f * (float)t) / (float)L;
        float acc = 0.f;
        for (int j2 = 0; j2 < 64; ++j2) {
            float a2 = f_b2[j2];
            for (int j1 = 0; j1 < 64; ++j1) {
                float a1 = f_b1[j1] + tn * f_w1[j1];
                for (int k = 0; k < 16; ++k) { const float f = 1e-4f + (float)k * ((15.0f - 1e-4f) / 15.0f); float sn, cs; sincos_red(f * w, sn, cs);
                    a1 += cs * f_w1[(1 + k) * 64 + j1] - sn * f_w1[(17 + k) * 64 + j1]; }
                a2 += sin_red(f_freq[j1] * a1) * f_w2[j1 * 64 + j2];
            }
            acc += sin_red(f_freq[j2] * a2) * f_w3[j2 * 2048 + n];
        }
        const float e = acc * __expf(-tn * fabsf(f_decay[n]));
        const int order = n >> 10, dir = (n >> 9) & 1, c = n & 511;
        if (!(dir == 1 && t == 0)) {
            const bf16_t* row = (const bf16_t*)(ws + (set ? OFF_GR1 : OFF_GR0)) + (size_t)(order * 512 + c) * (2 * C0);
            const float st = bf2f(row[dir ? C0 + t : C0 - t]);
            if (!(fabsf(st - e) <= 0.02f * fabsf(e) + 0.003f)) atomicAdd(cnt + 8, 1u);
        }
    }
    {
        const int seq = (int)(hsh % 40u); const int set = seq < NBP ? 0 : 1; const int L = set ? LS : LP; const int Lg = set ? LGS : LGP; const int NB = set ? NBS : NBP;
        const int b = set ? seq - NBP : seq; const int row0 = set ? TPR + b * LS : b * LP;
        hsh = hsh * 3266489917u + 668265263u; hsh ^= hsh >> 16;
        const int pos = (int)(hsh % (unsigned)L); const int which = (int)((hsh >> 16) % 3u); const int c = (int)((hsh >> 20) % 512u);
        const bf16_t* P = (const bf16_t*)(ws + OFF_P); const float* cw = p.in[9]; const int col = 448 + which * 512 + c;
        const float um = pos > 0 ? bf2f(P[(size_t)(row0 + pos - 1) * NPP + col]) : 0.f, u0 = bf2f(P[(size_t)(row0 + pos) * NPP + col]), up = pos + 1 < L ? bf2f(P[(size_t)(row0 + pos + 1) * NPP + col]) : 0.f;
        const float e = um * cw[which * 512 + c] + u0 * cw[1536 + which * 512 + c] + up * cw[3072 + which * 512 + c];
        const bf16_t* XT = (const bf16_t*)(ws + (which == 0 ? OFF_X1T : (which == 1 ? OFF_X2T : OFF_V0T))) + (set ? XT_SET1 : 0) + ((size_t)c * NB + b) * Lg;
        const float st = bf2f(XT[pos + 48]);
        if (!(fabsf(st - e) <= 0.02f * fabsf(e) + 0.02f)) atomicAdd(cnt + 9, 1u);
    }
}
#endif
#ifndef SUB_MASK
#define SUB_MASK 15
#endif
#ifndef PHASE_MASK
#define PHASE_MASK 1023
#endif
__global__ void __launch_bounds__(512) hymba_fwd(Params p) {
    extern __shared__ __attribute__((aligned(16))) unsigned char lds_raw[];
    LAS unsigned char* lds = (LAS unsigned char*)lds_raw;
    cg::grid_group grid = cg::this_grid();
#define GSYNC() do { asm volatile("s_waitcnt vmcnt(0) lgkmcnt(0)" ::: "memory"); grid.sync(); } while (0)
    const int G = gridDim.x;
    __builtin_amdgcn_fence(__ATOMIC_SEQ_CST, "agent");
    asm volatile("buffer_inv sc1\n\ts_waitcnt vmcnt(0)" ::: "memory");
#if DEBUG_CHECK == 10
    check_x(p, 0);
#endif
#if PHASE_MASK & 1
    p0_prologue(p, lds);
#endif
    GSYNC();
#if DEBUG_CHECK == 3
    check_h0b(p, 8);
#endif
#if DEBUG_CHECK == 7
    check_h0b_full(p, 8);
#endif
#if DEBUG_CHECK == 4
    check_stale(p, (const unsigned*)(launder(p.ws) + OFF_H0B), (unsigned)((size_t)T * 512), 9);
#endif
#if PHASE_MASK & 2
    {
        unsigned char* ws = launder(p.ws); unsigned char* ob = launder((unsigned char*)p.out);
        pg8::Gemm g{(const bf16_t*)(ws + OFF_H0B), (const bf16_t*)(ws + OFF_WIN), TPAD, 2048, 1024, 1024, 1024};
        pg8::StaticOrder S; S.init(TPAD, 2048, G, blockIdx.x);
        Epi<0> E{(bf16_t*)(ws + OFF_P), NPP, (const float*)(ws + OFF_R0), (float*)(ws + OFF_SQQP), (float*)(ws + OFF_SQKVP), (bf16_t*)(ob + DO_KR), (const float2*)(ws + OFF_RT)};
        pg8::gemm_phase(lds, g, S, E);
    }
#endif
    GSYNC();
#if DEBUG_CHECK == 1
    { unsigned char* ws = launder(p.ws); check_gemm((const bf16_t*)(ws + OFF_H0B), 1024, (const bf16_t*)(ws + OFF_WIN), 1024, 1024, T, 1984, 0, (const bf16_t*)(ws + OFF_P), NPP, (const float*)(ws + OFF_R0), (unsigned*)(ws + OFF_DBG) + 0, 448); }
    GSYNC();
#endif
#if DEBUG_CHECK == 3
    check_h0b(p, 9);
#endif
#if DEBUG_CHECK == 8
    check_p_golden(p);
#endif
#if DEBUG_CHECK == 9
    check_win_r0(p);
#endif
#if DEBUG_CHECK == 7
    check_h0b_full(p, 9);
    GSYNC();
#endif
#if DEBUG_CHECK == 6
    { unsigned char* ws = launder(p.ws);
      check_gemm((const bf16_t*)(ws + OFF_H0B), 1024, (const bf16_t*)(ws + OFF_WIN), 1024, 1024, T, 448, 0, (const bf16_t*)(ws + OFF_P), NPP, (const float*)(ws + OFF_R0), (unsigned*)(ws + OFF_DBG) + 8, 384);
      check_gemm((const bf16_t*)(ws + OFF_H0B), 1024, (const bf16_t*)(ws + OFF_WIN), 1024, 1024, T, 384, 7, (const bf16_t*)(ws + OFF_P), NPP, (const float*)(ws + OFF_R0), (unsigned*)(ws + OFF_DBG) + 9, 0); }
    GSYNC();
#endif
#if DEBUG_CHECK == 4
    check_stale(p, (const unsigned*)(launder(p.ws) + OFF_P), (unsigned)((size_t)T * 1024), 8);
#endif
    rownorm_phase(p);
    krope_phase(p);
    GSYNC();
#if (PHASE_MASK & 4) && (SUB2 & 1)
    {
        unsigned char* ws = launder(p.ws); unsigned char* ob = launder((unsigned char*)p.out);
        pg8::Gemm g{(const bf16_t*)(ws + OFF_P), (const bf16_t*)(ws + OFF_WUQ), TPAD, 768, 256, NPP, 256};
        pg8::StaticOrder S; S.init(TPAD, 768, G, blockIdx.x);
        Epi<1> E{(bf16_t*)(ob + DO_Q), 768, (const float*)(ws + OFF_RQ), nullptr, nullptr, nullptr, (const float2*)(ws + OFF_RT)};
        pg8::gemm_phase(lds, g, S, E);
    }
#endif
#if (PHASE_MASK & 4) && (SUB2 & 2)
    {
        unsigned char* ws = launder(p.ws); unsigned char* ob = launder((unsigned char*)p.out);
        pg8::Gemm g{(const bf16_t*)(ws + OFF_P) + 256, (const bf16_t*)(ws + OFF_WKN), TPAD, 512, 128, NPP, 128};
        pg8::StaticOrder S; S.init(TPAD, 512, G, blockIdx.x);
        Epi<2> E{(bf16_t*)(ob + DO_KN), 512, (const float*)(ws + OFF_RKV), nullptr, nullptr, nullptr, nullptr};
        pg8::gemm_phase(lds, g, S, E);
    }
#endif
#if (PHASE_MASK & 4) && (SUB2 & 4)
    {
        unsigned char* ws = launder(p.ws); unsigned char* ob = launder((unsigned char*)p.out);
        pg8::Gemm g{(const bf16_t*)(ws + OFF_WV), (const bf16_t*)(ws + OFF_P) + 256, 512, TPAD, 128, 128, NPP};
        pg8::StaticOrder S; S.init(512, TPAD, G, blockIdx.x);
        Epi<3> E{(bf16_t*)(ob + DO_VT), TPAD, (const float*)(ws + OFF_RKV), nullptr, nullptr, nullptr, nullptr};
        pg8::gemm_phase(lds, g, S, E);
    }
#endif
#if PHASE_MASK & 8
    hyprep_phase(p, lds);
#endif
    GSYNC();
#if DEBUG_CHECK == 2
    check_proj(p);
    GSYNC();
#endif
#if DEBUG_CHECK == 11
    check_filt_prep(p);
    GSYNC();
#endif
#if PHASE_MASK & 16
    attn_phase(p, lds);
#endif
#if PHASE_MASK & 32
    hyena_phase(p, lds);
#endif
    GSYNC();
#if DEBUG_CHECK == 5
    check_attn(p);
    check_hyena(p, lds);
    GSYNC();
#endif
#if PHASE_MASK & 64
    mixnorm_phase(p, lds);
#endif
    GSYNC();
#if PHASE_MASK & 128
    {
        unsigned char* ws = launder(p.ws);
        pg8::Gemm g{(const bf16_t*)(ws + OFF_MIXN), (const bf16_t*)(ws + OFF_WO), TN, 1024, 1024, 1024, 1024};
        pg8::StaticOrder S; S.init(TN, 1024, G, blockIdx.x);
        Epi<4> E{(bf16_t*)(ws + OFF_MIX), 1024, nullptr, (float*)(ws + OFF_SQMIXP), nullptr, nullptr, nullptr};
        pg8::gemm_phase(lds, g, S, E);
    }
#endif
    GSYNC();
#if DEBUG_CHECK == 1
    { unsigned char* ws = launder(p.ws); check_gemm((const bf16_t*)(ws + OFF_MIXN), 1024, (const bf16_t*)(ws + OFF_WO), 1024, 1024, TN, 1024, 4, (const bf16_t*)(ws + OFF_MIX), 1024, nullptr, (unsigned*)(ws + OFF_DBG) + 1, 0); }
#endif
#if DEBUG_CHECK == 10
    check_x(p, 1);
#endif
#if PHASE_MASK & 256
    h1_phase(p);
#endif
    GSYNC();
#if PHASE_MASK & 512
#if DEBUG_CHECK == 1
#define DBG_FF1(half) if ((half) == 0) { unsigned char* ws = launder(p.ws); check_gemm((const bf16_t*)(ws + OFF_H1B), 1024, (const bf16_t*)(ws + OFF_WF1), 1024, 1024, 65536, 4096, 5, (const bf16_t*)(ws + OFF_M), 4096, (const float*)(ws + OFF_R1), (unsigned*)(ws + OFF_DBG) + 2, 0); }
#define DBG_FF2(half) if ((half) == 0) { unsigned char* ws = launder(p.ws); check_gemm((const bf16_t*)(ws + OFF_M), 4096, (const bf16_t*)(ws + OFF_WF2), 4096, 4096, 65536, 1024, 6, (const bf16_t*)(ws + OFF_M2), 1024, nullptr, (unsigned*)(ws + OFF_DBG) + 3, 0); } GSYNC();
#else
#define DBG_FF1(half)
#define DBG_FF2(half)
#endif
#define FFN_HALF(half) \
    { \
        unsigned char* ws = launder(p.ws); \
        pg8::Gemm g{(const bf16_t*)(ws + OFF_H1B) + (size_t)(half) * 65536 * 1024, (const bf16_t*)(ws + OFF_WF1), 65536, 4096, 1024, 1024, 1024}; \
        pg8::StaticOrder S; S.init(65536, 4096, G, blockIdx.x); \
        Epi<5> E{(bf16_t*)(ws + OFF_M), 4096, (const float*)(ws + OFF_R1) + (half) * 65536, nullptr, nullptr, nullptr, nullptr}; \
        pg8::gemm_phase(lds, g, S, E); \
    } \
    GSYNC(); \
    DBG_FF1(half) \
    { \
        unsigned char* ws = launder(p.ws); \
        pg8::Gemm g{(const bf16_t*)(ws + OFF_M), (const bf16_t*)(ws + OFF_WF2), 65536, 1024, 4096, 4096, 4096}; \
        pg8::StaticOrder S; S.init(65536, 1024, G, blockIdx.x); \
        Epi<6> E{(bf16_t*)(ws + OFF_M2), 1024, nullptr, (float*)(ws + OFF_SQM2P) + (size_t)(half) * 65536 * 16, nullptr, nullptr, nullptr}; \
        pg8::gemm_phase(lds, g, S, E); \
    } \
    GSYNC(); \
    DBG_FF2(half) \
    final_phase(p, half);
    FFN_HALF(0)
    FFN_HALF(1)
#undef FFN_HALF
#endif
}

extern "C" void kernel_launch(void* const* d_in, const int* in_sizes, int n_in, void* d_out, int out_size, void* d_ws, size_t ws_size, hipStream_t stream) {
    static int grid = 0;
    if (grid == 0) {
        int dev = 0, cus = 0, per_cu = 0;
        hipGetDevice(&dev);
        hipDeviceGetAttribute(&cus, hipDeviceAttributeMultiprocessorCount, dev);
        hipFuncSetAttribute((const void*)hymba_fwd, hipFuncAttributeMaxDynamicSharedMemorySize, LDS_BYTES);
        hipOccupancyMaxActiveBlocksPerMultiprocessor(&per_cu, (const void*)hymba_fwd, 512, LDS_BYTES);
        if (per_cu < 1) per_cu = 1;
        grid = cus * 1;
        if (n_in != 26 || ws_size < 1024 * MiB) fprintf(stderr, "kernel_launch: unexpected n_in %d / ws_size %zu\n", n_in, ws_size);
    }
    Params p{};
    for (int i = 0; i < 26; ++i) p.in[i] = (const float*)d_in[i];
    p.out = (float*)d_out; p.ws = (unsigned char*)d_ws;
    void* args[] = {&p};
    hipError_t e = hipLaunchCooperativeKernel((const void*)hymba_fwd, dim3(grid), dim3(512), args, LDS_BYTES, stream);
    if (e != hipSuccess) fprintf(stderr, "cooperative launch failed: %s (grid %d)\n", hipGetErrorString(e), grid);
}
```
